# Optimizing an MI355X kernel written in HIP

```python
import math
import jax, jax.numpy as jnp
from jax import lax
import numpy as np

D_MODEL = 2048
BATCH = 1
SEQ = 8192
DEPTH = 1

N_HEADS_A = 8
HEAD_DIM_A = 128
N_IDX_HEADS = 16
IDX_DIM = 64
TOPK_MAX = 256
N_HEADS_B = 8
DIFF_DIM = 64
N_MEM = 256
N_MEM_HEADS = 4
MEM_HEAD_DIM = 256
N_BRANCH = 3

WIDTH_A = N_HEADS_A * HEAD_DIM_A
WIDTH_B = N_HEADS_B * 2 * DIFF_DIM
WIDTH_M = N_MEM_HEADS * MEM_HEAD_DIM
Q_BLOCK = 128
RMS_EPS = 1e-6
NEG_INF = -1e30

SPLITS = (
    WIDTH_A, WIDTH_A, WIDTH_A, WIDTH_A,
    N_IDX_HEADS * IDX_DIM, IDX_DIM, N_IDX_HEADS,
    WIDTH_B, WIDTH_B, WIDTH_B, WIDTH_B,
    WIDTH_M, WIDTH_M,
    N_BRANCH * D_MODEL,
)
D_IN = sum(SPLITS)

kernel_name = "hybrid_dsa_diffattn_memory_gated_block"


def rms_norm(x, g):
    xf = x.astype(jnp.float32)
    y = xf * lax.rsqrt(jnp.mean(xf * xf, axis=-1, keepdims=True) + RMS_EPS)
    return (y * g.astype(jnp.float32)).astype(x.dtype)


def alibi_slopes(n):
    return 2.0 ** (-8.0 * jnp.arange(1, n + 1, dtype=jnp.float32) / n)


def to_blocks(a):
    b, s = a.shape[:2]
    return jnp.moveaxis(a.reshape(b, s // Q_BLOCK, Q_BLOCK, *a.shape[2:]), 1, 0)


def from_blocks(a):
    nb, b, q = a.shape[:3]
    return jnp.moveaxis(a, 0, 1).reshape(b, nb * q, *a.shape[3:])


def dsa_attention(q, k, v, q_idx, k_idx, w_idx, topk):
    s_len = k.shape[1]
    slopes = alibi_slopes(N_HEADS_A)
    key_pos = jnp.arange(s_len, dtype=jnp.int32)
    qpos_blocks = key_pos.reshape(-1, Q_BLOCK)
    scale = HEAD_DIM_A ** -0.5
    idx_scale = IDX_DIM ** -0.5
    gather = jax.vmap(lambda a, i: a[i])

    def block(args):
        qb, qib, wb, tpos = args
        s_h = jnp.einsum('bqjd,bsd->bqjs', qib, k_idx).astype(jnp.float32) * idx_scale
        score = jnp.einsum('bqjs,bqj->bqs', jax.nn.relu(s_h), wb.astype(jnp.float32))
        causal = key_pos[None, :] <= tpos[:, None]
        score = jnp.where(causal[None], score, -jnp.inf)
        _, sel = lax.top_k(score, topk)
        valid = sel <= tpos[None, :, None]
        k_sel = gather(k, sel)
        v_sel = gather(v, sel)
        logits = jnp.einsum('bqhd,bqkhd->bhqk', qb, k_sel).astype(jnp.float32) * scale
        dist = (tpos[None, :, None] - sel).astype(jnp.float32)
        logits = logits - slopes[None, :, None, None] * dist[:, None]
        logits = jnp.where(valid[:, None], logits, NEG_INF)
        p = jax.nn.softmax(logits, axis=-1).astype(v.dtype)
        return jnp.einsum('bhqk,bqkhd->bqhd', p, v_sel)

    out = lax.map(block, (to_blocks(q), to_blocks(q_idx), to_blocks(w_idx), qpos_blocks))
    return from_blocks(out)


def diff_attention(q, k, v, lam, lam_init, g_subln):
    s_len = k.shape[1]
    slopes = alibi_slopes(N_HEADS_B)
    key_pos = jnp.arange(s_len, dtype=jnp.int32)
    qpos_blocks = key_pos.reshape(-1, Q_BLOCK)
    scale = DIFF_DIM ** -0.5

    def block(args):
        qb, tpos = args
        logits = jnp.einsum('bqhcd,bshcd->bhcqs', qb, k).astype(jnp.float32) * scale
        dist = (tpos[:, None] - key_pos[None, :]).astype(jnp.float32)
        logits = logits - slopes[None, :, None, None, None] * dist
        logits = jnp.where(dist >= 0, logits, NEG_INF)
        p = jax.nn.softmax(logits, axis=-1)
        a = p[:, :, 0] - lam * p[:, :, 1]
        return jnp.einsum('bhqs,bshe->bqhe', a.astype(v.dtype), v)

    out = from_blocks(lax.map(block, (to_blocks(q), qpos_blocks)))
    return rms_norm(out, g_subln) * (1.0 - lam_init)


def memory_attention(q, k, v):
    logits = jnp.einsum('bshd,bmhd->bhsm', q, k).astype(jnp.float32) * (MEM_HEAD_DIM ** -0.5)
    p = jax.nn.softmax(logits, axis=-1).astype(v.dtype)
    return jnp.einsum('bhsm,bmhd->bshd', p, v)


def setup_inputs(seed: int = 0) -> dict:
    key = jax.random.key(seed)
    ks = jax.random.split(key, 18)
    f32 = jnp.float32

    def nrm(k, shape, scale):
        return jax.random.normal(k, shape, f32) * scale

    return {
        "x": nrm(ks[0], (BATCH, SEQ, D_MODEL), 1.0),
        "mem": nrm(ks[1], (BATCH, N_MEM, D_MODEL), 1.0),
        "g_in": 1.0 + nrm(ks[2], (DEPTH, D_MODEL), 0.02),
        "w_in": nrm(ks[3], (DEPTH, D_MODEL, D_IN), D_MODEL ** -0.5),
        "b_gate": nrm(ks[4], (DEPTH, N_BRANCH * D_MODEL), 0.02),
        "lam_q1": nrm(ks[5], (DEPTH, DIFF_DIM), 0.1),
        "lam_k1": nrm(ks[6], (DEPTH, DIFF_DIM), 0.1),
        "lam_q2": nrm(ks[7], (DEPTH, DIFF_DIM), 0.1),
        "lam_k2": nrm(ks[8], (DEPTH, DIFF_DIM), 0.1),
        "g_subln": 1.0 + nrm(ks[9], (DEPTH, 2 * DIFF_DIM), 0.02),
        "g_mem": 1.0 + nrm(ks[10], (DEPTH, D_MODEL), 0.02),
        "w_mem_kv": nrm(ks[11], (DEPTH, D_MODEL, 2 * WIDTH_M), D_MODEL ** -0.5),
        "w_br_a": nrm(ks[12], (DEPTH, WIDTH_A, D_MODEL), WIDTH_A ** -0.5),
        "w_br_b": nrm(ks[13], (DEPTH, WIDTH_B, D_MODEL), WIDTH_B ** -0.5),
        "w_br_m": nrm(ks[14], (DEPTH, WIDTH_M, D_MODEL), WIDTH_M ** -0.5),
        "w_out": nrm(ks[15], (DEPTH, D_MODEL, D_MODEL), D_MODEL ** -0.5),
        "g_final": 1.0 + nrm(ks[16], (D_MODEL,), 0.02),
    }


def reference(x, mem, g_in, w_in, b_gate, lam_q1, lam_k1, lam_q2, lam_k2, g_subln,
              g_mem, w_mem_kv, w_br_a, w_br_b, w_br_m, w_out, g_final):
    bsz, s_len, _ = x.shape
    topk = min(TOPK_MAX, s_len // 4)
    split_points = np.cumsum(SPLITS)[:-1].tolist()
    for l in range(DEPTH):
        h = rms_norm(x, g_in[l])
        proj = h @ w_in[l]
        (qa, ka, va, za, qi, ki, wi, qb, kb, vb, zb, qm, zm, gl) = jnp.split(proj, split_points, axis=-1)

        ya = dsa_attention(
            qa.reshape(bsz, s_len, N_HEADS_A, HEAD_DIM_A),
            ka.reshape(bsz, s_len, N_HEADS_A, HEAD_DIM_A),
            va.reshape(bsz, s_len, N_HEADS_A, HEAD_DIM_A),
            qi.reshape(bsz, s_len, N_IDX_HEADS, IDX_DIM),
            ki,
            wi * (N_IDX_HEADS ** -0.5),
            topk,
        )
        ua = ya.reshape(bsz, s_len, WIDTH_A) * jax.nn.silu(za)

        lam_init = 0.8 - 0.6 * math.exp(-0.3 * l)
        lam = (jnp.exp(jnp.sum(lam_q1[l].astype(jnp.float32) * lam_k1[l].astype(jnp.float32)))
               - jnp.exp(jnp.sum(lam_q2[l].astype(jnp.float32) * lam_k2[l].astype(jnp.float32)))
               + lam_init)
        yb = diff_attention(
            qb.reshape(bsz, s_len, N_HEADS_B, 2, DIFF_DIM),
            kb.reshape(bsz, s_len, N_HEADS_B, 2, DIFF_DIM),
            vb.reshape(bsz, s_len, N_HEADS_B, 2 * DIFF_DIM),
            lam, lam_init, g_subln[l],
        )
        ub = yb.reshape(bsz, s_len, WIDTH_B) * jax.nn.silu(zb)

        mkv = rms_norm(mem, g_mem[l]) @ w_mem_kv[l]
        km, vm = jnp.split(mkv, 2, axis=-1)
        n_mem = mem.shape[1]
        ym = memory_attention(
            qm.reshape(bsz, s_len, N_MEM_HEADS, MEM_HEAD_DIM),
            km.reshape(bsz, n_mem, N_MEM_HEADS, MEM_HEAD_DIM),
            vm.reshape(bsz, n_mem, N_MEM_HEADS, MEM_HEAD_DIM),
        )
        um = ym.reshape(bsz, s_len, WIDTH_M) * jax.nn.silu(zm)

        gates = jax.nn.sigmoid((gl + b_gate[l]).astype(jnp.float32)).astype(x.dtype)
        gates = gates.reshape(bsz, s_len, N_BRANCH, D_MODEL)
        merged = (gates[:, :, 0] * (ua @ w_br_a[l])
                  + gates[:, :, 1] * (ub @ w_br_b[l])
                  + gates[:, :, 2] * (um @ w_br_m[l]))
        x = x + merged @ w_out[l]
    return rms_norm(x, g_final)
```

```cpp
#define N_LAUNCH_MODE 1
#include <hip/hip_runtime.h>
#include <hip/hip_cooperative_groups.h>
#include <cstdio>
#include <cstdint>
namespace cg = cooperative_groups;

namespace pg8 {
#define PG8_LAS __attribute__((address_space(3)))
typedef unsigned short bf16_t;
typedef short bf16x8 __attribute__((ext_vector_type(8)));
typedef float f32x4 __attribute__((ext_vector_type(4)));
typedef unsigned u32x4 __attribute__((ext_vector_type(4)));
constexpr int BM = 256, BK = 64, HALF = 128, HTB = HALF * BK * 2  , STAGE_BYTES = 8 * HTB, NXCD = 8, WGM = 8;

__host__ __device__ __forceinline__ int lds_byte(int r, int c) { const int st = (r >> 4) * 2 + (c >> 5), rr = r & 15, cc = c & 31, ob = rr * 64 + cc * 2; return st * 1024 + (ob ^ (((ob >> 9) & 1) << 5)); }
__host__ __device__ __forceinline__ void stage_rc(int b, int& R, int& C) { const int st = b / 1024, sb = b % 1024, swz = sb ^ (((sb >> 9) & 1) << 5); R = (st >> 1) * 16 + swz / 64; C = (st & 1) * 32 + (swz % 64) / 2; }
__host__ __device__ __forceinline__ int perm32(int rho) { const int n = rho >> 4, i = rho & 15; return 8 * (i >> 2) + 4 * n + (i & 3); }

struct Unit { int pm, pn, z; };
struct Gemm { const bf16_t* A; const bf16_t* Bt; int M, N, K; long zA, zB; };

struct StaticOrder {
    int nM, nN, nwg, G, c;
    __host__ __device__ void init(int M, int N, int G_, int c_) { nM = M / BM; nN = N / BM; nwg = nM * nN; G = G_; c = c_; }
    __host__ __device__ bool next(int i, Unit& u) const {
        const long L = (long)i * G + c; if (L >= nwg) return false;
        int wgid = (int)L; { const int q = nwg / NXCD, r = nwg % NXCD, xcd = wgid % NXCD, off = wgid / NXCD; wgid = (xcd < r ? xcd * (q + 1) : r * (q + 1) + (xcd - r) * q) + off; }
        const int nig = WGM * nN, gid = wgid / nig, fm = gid * WGM, gsz = (nM - fm) < WGM ? (nM - fm) : WGM;
        u.pm = fm + ((wgid % nig) % gsz); u.pn = (wgid % nig) / gsz; u.z = 0; return true;
    }
    __device__ __forceinline__ void a_ready(const Unit&) const {}
    __device__ __forceinline__ void done(const Unit&) const {}
};

typedef float f32x2_t __attribute__((ext_vector_type(2))); typedef __bf16 bf16x2_t __attribute__((ext_vector_type(2)));
__device__ __forceinline__ unsigned cvt_pk_bf16(float lo, float hi) { f32x2_t v = {lo, hi}; bf16x2_t b = __builtin_convertvector(v, bf16x2_t); return __builtin_bit_cast(unsigned, b); }

__device__ __forceinline__ float bf2f(unsigned short u) { return __uint_as_float((unsigned)u << 16); }
__device__ __forceinline__ float sigmoidf_(float v) { return __builtin_amdgcn_rcpf(1.0f + __builtin_amdgcn_exp2f(-1.4426950408889634f * v)); }
template <int MODE> __device__ __forceinline__ float act_(float v, float b) {
    if (MODE == 1) return v * sigmoidf_(v);
    if (MODE == 2) return sigmoidf_(v + b);
    return v;
}
struct EpiProj {
    static constexpr bool PERM = true, AFTER_DRAIN = false;
    bf16_t* O; int ldc; bf16_t* O1; int ldc1; const float* bgate; int gate_tile0;
    template <int MODE> __device__ __forceinline__ void put(const f32x4 (&acc)[2][2][4][2], bf16_t* base, int ld, int row0, int col0, const float* bias) const {
        f32x4 bv[2][2];
#pragma unroll
        for (int bj = 0; bj < 2; ++bj)
#pragma unroll
            for (int n = 0; n < 2; ++n) bv[bj][n] = (MODE == 2) ? *(const f32x4*)(bias + bj * HALF + 4 * n) : (f32x4){0.f, 0.f, 0.f, 0.f};
#pragma unroll
        for (int ai = 0; ai < 2; ++ai)
#pragma unroll
            for (int m = 0; m < 4; ++m) { bf16_t* rowp = base + (size_t)(row0 + ai * HALF + m * 16) * ld + col0;
#pragma unroll
                for (int bj = 0; bj < 2; ++bj) { f32x4 v0 = acc[ai][bj][m][0], v1 = acc[ai][bj][m][1];
#pragma unroll
                    for (int e = 0; e < 4; ++e) { v0[e] = act_<MODE>(v0[e], bv[bj][0][e]); v1[e] = act_<MODE>(v1[e], bv[bj][1][e]); }
                    u32x4 w; w.x = cvt_pk_bf16(v0[0], v0[1]); w.y = cvt_pk_bf16(v0[2], v0[3]); w.z = cvt_pk_bf16(v1[0], v1[1]); w.w = cvt_pk_bf16(v1[2], v1[3]);
                    *(u32x4*)(rowp + bj * HALF) = w; } }
    }
    __device__ __forceinline__ void operator()(const f32x4 (&acc)[2][2][4][2], const Unit& u, int wr, int wc, int fr, int fq) const {
        const int row0 = u.pm * BM + wr * 64 + fr, col0 = u.pn * BM + wc * 32 + 8 * fq;
        if (u.z == 1) { put<0>(acc, O1, ldc1, row0, col0, nullptr); return; }
        const int t = u.pn;
        const bool is_silu = (t >= 12 && t < 16) || (t >= 32 && t < 36) || (t >= 40 && t < 44);
        if (t >= gate_tile0 && t < 68) put<2>(acc, O, ldc, row0, col0, bgate + (col0 - gate_tile0 * BM));
        else if (is_silu) put<1>(acc, O, ldc, row0, col0, nullptr);
        else put<0>(acc, O, ldc, row0, col0, nullptr);
    }
};
struct EpiMerge {
    static constexpr bool PERM = true, AFTER_DRAIN = false;
    const bf16_t* G; int ldg;
    float* T; bf16_t* O; int ldc;
    __device__ __forceinline__ void operator()(const f32x4 (&acc)[2][2][4][2], const Unit& u, int wr, int wc, int fr, int fq) const {
        const int row0 = u.pm * BM + wr * 64 + fr, col0 = u.pn * BM + wc * 32 + 8 * fq;
#pragma unroll
        for (int ai = 0; ai < 2; ++ai)
#pragma unroll
            for (int m = 0; m < 4; ++m) { const size_t row = (size_t)(row0 + ai * HALF + m * 16);
#pragma unroll
                for (int bj = 0; bj < 2; ++bj) { const int col = col0 + bj * HALF;
                    const u32x4 gw = *(const u32x4*)(G + row * ldg + (size_t)u.z * 2048 + col);
                    f32x4 g0, g1;
                    g0[0] = __uint_as_float(gw.x << 16); g0[1] = __uint_as_float(gw.x & 0xffff0000u); g0[2] = __uint_as_float(gw.y << 16); g0[3] = __uint_as_float(gw.y & 0xffff0000u);
                    g1[0] = __uint_as_float(gw.z << 16); g1[1] = __uint_as_float(gw.z & 0xffff0000u); g1[2] = __uint_as_float(gw.w << 16); g1[3] = __uint_as_float(gw.w & 0xffff0000u);
                    f32x4 v0 = acc[ai][bj][m][0] * g0, v1 = acc[ai][bj][m][1] * g1;
                    float* tp = T + row * ldc + col;
                    if (u.z > 0) { v0 += __builtin_nontemporal_load((const f32x4*)tp); v1 += __builtin_nontemporal_load((const f32x4*)(tp + 4)); }
                    if (u.z < 2) { *(f32x4*)tp = v0; *(f32x4*)(tp + 4) = v1; }
                    else { u32x4 w; w.x = cvt_pk_bf16(v0[0], v0[1]); w.y = cvt_pk_bf16(v0[2], v0[3]); w.z = cvt_pk_bf16(v1[0], v1[1]); w.w = cvt_pk_bf16(v1[2], v1[3]);
                        *(u32x4*)(O + row * ldc + col) = w; } } }
    }
};
struct EpiOut {
    static constexpr bool PERM = false, AFTER_DRAIN = false;
    const float* X; float* Y; int ldc; float* part; int M;
    __device__ __forceinline__ void operator()(const f32x4 (&acc)[2][2][4][2], const Unit& u, int wr, int wc, int fr, int fq) const {
        const int row0 = u.pm * BM + wr * 64 + fr, col0 = u.pn * BM + wc * 32 + 4 * fq;
#pragma unroll
        for (int ai = 0; ai < 2; ++ai)
#pragma unroll
            for (int m = 0; m < 4; ++m) { const size_t row = (size_t)(row0 + ai * HALF + m * 16); float ss = 0.f;
#pragma unroll
                for (int bj = 0; bj < 2; ++bj)
#pragma unroll
                    for (int n = 0; n < 2; ++n) { const size_t off = row * ldc + col0 + bj * HALF + n * 16;
                        const f32x4 y = *(const f32x4*)(X + off) + acc[ai][bj][m][n]; *(f32x4*)(Y + off) = y;
                        ss += (y[0] * y[0] + y[1] * y[1]) + (y[2] * y[2] + y[3] * y[3]); }
                ss += __shfl_xor(ss, 16); ss += __shfl_xor(ss, 32);
                if (fq == 0) part[(size_t)(u.pn * 4 + wc) * M + row] = ss; }
    }
};
struct ProjOrder {
    StaticOrder so; int nmain, extra;
    __device__ void init(int M, int N, int G, int c) { so.init(M, N, G, c); nmain = (so.nwg - c + G - 1) / G; extra = (c >= G - 8) ? c - (G - 8) : -1; }
    __device__ bool next(int i, Unit& u) const {
        if (i < nmain) return so.next(i, u);
        if (i == nmain && extra >= 0) { u.pm = 0; u.pn = extra; u.z = 1; return true; }
        return false;
    }
    __device__ __forceinline__ void a_ready(const Unit&) const {}
    __device__ __forceinline__ void done(const Unit&) const {}
};
struct MergeOrder {
    StaticOrder so;
    __device__ void init(int M, int N, int G, int c) { so.init(M, N, G, c); }
    __device__ bool next(int i, Unit& u) const { if (i >= 3) return false; if (!so.next(0, u)) return false; u.z = i; return true; }
    __device__ __forceinline__ void a_ready(const Unit&) const {}
    __device__ __forceinline__ void done(const Unit&) const {}
};

template <class Epi, class Sched, bool ALIGN_EPI = false, bool SP2 = false>
__device__ __forceinline__ void gemm_phase(PG8_LAS unsigned char* lds, const Gemm g, const Sched& S, const Epi& E) {
    const int tid = threadIdx.x, wid = __builtin_amdgcn_readfirstlane(tid >> 6), lane = tid & 63, wr = wid >> 2, wc = wid & 3, fr = lane & 15, fq = lane >> 4;
    const int K = g.K, nt = K / BK;
    unsigned voffA[2], voffB[2];
#pragma unroll
    for (int i = 0; i < 2; ++i) { int R, C; stage_rc(tid * 16 + i * 8192, R, C); const int Rb = Epi::PERM ? ((R & ~31) + perm32(R & 31)) : R;
        voffA[i] = (unsigned)(R * K + C) * 2u; voffB[i] = (unsigned)(Rb * K + C) * 2u; }
    const size_t kstep = (size_t)(BK * 2);
    const size_t hstep = (size_t)HALF * K * 2;
    const size_t tstep = 2 * hstep;
    const unsigned ldsw = (unsigned)wid * 1024u;
    const int aoff = lds_byte(wr * 64 + fr, fq * 8), boff = lds_byte(wc * 32 + fr, fq * 8);
#define PG8_SA(b, h) (((b) * 2 + (h)) * HTB)
#define PG8_SB(b, h) ((4 + (b) * 2 + (h)) * HTB)
#define PG8_STAGE(bufoff, gbase, voff) do { _Pragma("unroll") for (int _i = 0; _i < 2; ++_i) \
        __builtin_amdgcn_global_load_lds((const unsigned*)((const char*)(gbase) + (voff)[_i]), (PG8_LAS unsigned*)(lds + (bufoff) + ldsw + _i * 8192), 16, 0, 0); } while (0)
#define PG8_LDA(dst, b, h) do { _Pragma("unroll") for (int m = 0; m < 4; ++m) _Pragma("unroll") for (int k = 0; k < 2; ++k) dst[m][k] = *(const PG8_LAS bf16x8*)(lds + PG8_SA(b, h) + aoff + m * 2048 + k * 1024); } while (0)
#define PG8_LDB(dst, b, h) do { _Pragma("unroll") for (int n = 0; n < 2; ++n) _Pragma("unroll") for (int k = 0; k < 2; ++k) dst[n][k] = *(const PG8_LAS bf16x8*)(lds + PG8_SB(b, h) + boff + n * 2048 + k * 1024); } while (0)
#define PG8_MMA(ai, bj, At, Bt) do { __builtin_amdgcn_s_setprio(1); _Pragma("unroll") for (int m = 0; m < 4; ++m) _Pragma("unroll") for (int n = 0; n < 2; ++n) _Pragma("unroll") for (int k = 0; k < 2; ++k) \
        acc[ai][bj][m][n] = __builtin_amdgcn_mfma_f32_16x16x32_bf16(Bt[n][k], At[m][k], acc[ai][bj][m][n], 0, 0, 0); __builtin_amdgcn_s_setprio(0); } while (0)
#define PG8_WAIT_V(n) asm volatile("s_waitcnt vmcnt(" #n ")" ::: "memory")
#define PG8_WAIT_L(n) asm volatile("s_waitcnt lgkmcnt(" #n ")" ::: "memory")
#define PG8_BAR __builtin_amdgcn_s_barrier()
#define PG8_SCHED __builtin_amdgcn_sched_barrier(0)
    Unit cur, nxt; int ui = 0;
    if (!S.next(0, cur)) return;
    f32x4 acc[2][2][4][2];
#pragma unroll
    for (int a = 0; a < 2; ++a)
#pragma unroll
        for (int b = 0; b < 2; ++b)
#pragma unroll
            for (int m = 0; m < 4; ++m)
#pragma unroll
                for (int n = 0; n < 2; ++n) acc[a][b][m][n] = (f32x4){0.f, 0.f, 0.f, 0.f};
    bf16x8 At[4][2], B0[2][2], B1[2][2];
    const char* cA = (const char*)g.A + (long)cur.z * g.zA + (size_t)cur.pm * tstep; const char* cB = (const char*)g.Bt + (long)cur.z * g.zB + (size_t)cur.pn * tstep;
    S.a_ready(cur);
    if constexpr (SP2) {
        PG8_STAGE(PG8_SB(0, 0), cB, voffB); PG8_STAGE(PG8_SB(0, 1), cB + hstep, voffB); PG8_STAGE(PG8_SA(0, 0), cA, voffA); PG8_STAGE(PG8_SA(0, 1), cA + hstep, voffA);
        if (wr == 1) PG8_BAR;
        PG8_WAIT_V(2); PG8_BAR;
        PG8_STAGE(PG8_SB(1, 0), cB + kstep, voffB); PG8_STAGE(PG8_SA(1, 0), cA + kstep, voffA); PG8_STAGE(PG8_SB(1, 1), cB + hstep + kstep, voffB);
        PG8_WAIT_V(6); PG8_BAR;
    } else {
        PG8_STAGE(PG8_SB(0, 0), cB, voffB); PG8_STAGE(PG8_SA(0, 0), cA, voffA); PG8_STAGE(PG8_SB(0, 1), cB + hstep, voffB); PG8_STAGE(PG8_SA(0, 1), cA + hstep, voffA);
        if (wr == 1) PG8_BAR;
        PG8_WAIT_V(4); PG8_BAR;
        PG8_STAGE(PG8_SB(1, 0), cB + kstep, voffB); PG8_STAGE(PG8_SA(1, 0), cA + kstep, voffA); PG8_STAGE(PG8_SB(1, 1), cB + hstep + kstep, voffB);
        PG8_WAIT_V(6); PG8_BAR;
    }
    for (;;) {
        const bool has_next = S.next(ui + 1, nxt);
        const char* nA = has_next ? (const char*)g.A + (long)nxt.z * g.zA + (size_t)nxt.pm * tstep : cA; const char* nB = has_next ? (const char*)g.Bt + (long)nxt.z * g.zB + (size_t)nxt.pn * tstep : cB;
        for (int t = 0; t < nt; t += 2) {
            const bool last = (t == nt - 2);
            const char* a1 = cA + (size_t)(t + 1) * kstep;
            const char* a2 = last ? nA : cA + (size_t)(t + 2) * kstep; const char* b2 = last ? nB : cB + (size_t)(t + 2) * kstep;
            const char* a3 = a2 + kstep; const char* b3 = b2 + kstep;
            if (last && has_next) S.a_ready(nxt);
            if constexpr (SP2) {
            PG8_LDB(B0, 0, 0); PG8_LDB(B1, 0, 1); PG8_SCHED; PG8_LDA(At, 0, 0); PG8_STAGE(PG8_SA(1, 1), a1 + hstep, voffA);
            PG8_WAIT_V(8); PG8_WAIT_L(0); PG8_BAR; PG8_MMA(0, 0, At, B0); PG8_MMA(0, 1, At, B1); PG8_BAR; PG8_SCHED;
            PG8_LDA(At, 0, 1); PG8_STAGE(PG8_SB(0, 0), b2, voffB); PG8_STAGE(PG8_SB(0, 1), b2 + hstep, voffB); PG8_STAGE(PG8_SA(0, 0), a2, voffA);
            PG8_WAIT_V(8); PG8_WAIT_L(0); PG8_BAR; PG8_MMA(1, 0, At, B0); PG8_MMA(1, 1, At, B1); PG8_BAR; PG8_SCHED;
            PG8_LDB(B0, 1, 0); PG8_LDB(B1, 1, 1); PG8_SCHED; PG8_LDA(At, 1, 0); PG8_STAGE(PG8_SA(0, 1), a2 + hstep, voffA);
            PG8_WAIT_V(8); PG8_WAIT_L(0); PG8_BAR; PG8_MMA(0, 0, At, B0); PG8_MMA(0, 1, At, B1); PG8_BAR; PG8_SCHED;
            PG8_LDA(At, 1, 1); PG8_STAGE(PG8_SB(1, 0), b3, voffB); PG8_STAGE(PG8_SB(1, 1), b3 + hstep, voffB); PG8_STAGE(PG8_SA(1, 0), a3, voffA);
            PG8_WAIT_V(8); PG8_WAIT_L(0); PG8_BAR; PG8_MMA(1, 0, At, B0); PG8_MMA(1, 1, At, B1); PG8_BAR; PG8_SCHED;
            } else {
            PG8_LDB(B0, 0, 0); PG8_SCHED; PG8_LDA(At, 0, 0); PG8_STAGE(PG8_SA(1, 1), a1 + hstep, voffA);
            PG8_WAIT_L(8); PG8_BAR; PG8_WAIT_L(0); PG8_MMA(0, 0, At, B0); PG8_BAR; PG8_SCHED;
            PG8_LDB(B1, 0, 1); PG8_STAGE(PG8_SB(0, 0), b2, voffB);
            PG8_BAR; PG8_WAIT_L(0); PG8_MMA(0, 1, At, B1); PG8_BAR;
            PG8_LDA(At, 0, 1); PG8_STAGE(PG8_SA(0, 0), a2, voffA);
            PG8_BAR; PG8_WAIT_L(0); PG8_MMA(1, 0, At, B0); PG8_BAR; PG8_SCHED;
            PG8_STAGE(PG8_SB(0, 1), b2 + hstep, voffB);
            PG8_WAIT_V(6); PG8_BAR; PG8_MMA(1, 1, At, B1); PG8_BAR;
            PG8_LDB(B0, 1, 0); PG8_SCHED; PG8_LDA(At, 1, 0); PG8_STAGE(PG8_SA(0, 1), a2 + hstep, voffA);
            PG8_WAIT_L(8); PG8_BAR; PG8_WAIT_L(0); PG8_MMA(0, 0, At, B0); PG8_BAR; PG8_SCHED;
            PG8_LDB(B1, 1, 1); PG8_STAGE(PG8_SB(1, 0), b3, voffB);
            PG8_BAR; PG8_WAIT_L(0); PG8_MMA(0, 1, At, B1); PG8_BAR;
            PG8_LDA(At, 1, 1); PG8_STAGE(PG8_SA(1, 0), a3, voffA);
            PG8_BAR; PG8_WAIT_L(0); PG8_MMA(1, 0, At, B0); PG8_BAR; PG8_SCHED;
            PG8_STAGE(PG8_SB(1, 1), b3 + hstep, voffB);
            PG8_WAIT_V(6); PG8_BAR; PG8_MMA(1, 1, At, B1); PG8_BAR;
            }
        }
        if constexpr (ALIGN_EPI) { if (wr == 0) PG8_BAR; }
        if constexpr (!Epi::AFTER_DRAIN) { E(acc, cur, wr, wc, fr, fq); S.done(cur); }
        if (!has_next) break;
#pragma unroll
        for (int a = 0; a < 2; ++a)
#pragma unroll
            for (int b = 0; b < 2; ++b)
#pragma unroll
                for (int m = 0; m < 4; ++m)
#pragma unroll
                    for (int n = 0; n < 2; ++n) acc[a][b][m][n] = (f32x4){0.f, 0.f, 0.f, 0.f};
        cur = nxt; cA = nA; cB = nB; ++ui;
        if constexpr (ALIGN_EPI) { if (wr == 1) PG8_BAR; }
    }
    PG8_WAIT_V(0);
    if constexpr (!ALIGN_EPI) { if (wr == 0) PG8_BAR; }
    PG8_BAR;
    if constexpr (Epi::AFTER_DRAIN) { E.fused(acc, cur, wr, wc, fr, fq, lds, wid, lane); S.done(cur); }
#undef PG8_SA
#undef PG8_SB
#undef PG8_STAGE
#undef PG8_LDA
#undef PG8_LDB
#undef PG8_MMA
#undef PG8_WAIT_V
#undef PG8_WAIT_L
#undef PG8_BAR
#undef PG8_SCHED
}
}

constexpr int S = 8192, DM = 2048, DIN = 17488, NPAD = 17664, NMEM = 256;
constexpr int C_QA = 0, C_KA = 1024, C_VA = 2048, C_ZA = 3072, C_QI = 4096, C_QB = 5120, C_KB = 6144, C_VB = 7168, C_ZB = 8192, C_QM = 9216, C_ZM = 10240, C_GL = 11264, C_KI = 17408, C_WI = 17472;
constexpr int TOPK = 256;
constexpr float RMS_EPS = 1e-6f;
constexpr size_t MiB = 1u << 20;
constexpr size_t WS_CTL = 0;
constexpr size_t WS_WTIN = 1 * MiB;
constexpr size_t WS_U = 1 * MiB;
constexpr size_t WS_WTMKV = 70 * MiB;
constexpr size_t WS_WTBR = 78 * MiB;
constexpr size_t WS_WTOUT = 90 * MiB;
constexpr size_t WS_MEMN = 98 * MiB;
constexpr size_t WS_MKV = 99 * MiB;
constexpr size_t WS_PROJ = 100 * MiB;
constexpr size_t WS_SC = 376 * MiB;
constexpr size_t WS_MERGED = 376 * MiB;
constexpr size_t WS_H = 376 * MiB;
constexpr size_t WS_T = 408 * MiB;
constexpr size_t WS_SEL = 508 * MiB;
constexpr size_t WS_PART = 516 * MiB;
constexpr size_t WS_END = 517 * MiB;

typedef unsigned short bf16_t;
typedef unsigned u32x4 __attribute__((ext_vector_type(4)));
typedef unsigned u32x2 __attribute__((ext_vector_type(2)));
typedef float f32x4 __attribute__((ext_vector_type(4)));
#define LAS __attribute__((address_space(3)))
__device__ __forceinline__ float bf2f(unsigned short u) { return __uint_as_float((unsigned)u << 16); }
__device__ __forceinline__ float bflo(unsigned w) { return __uint_as_float(w << 16); }
__device__ __forceinline__ float bfhi(unsigned w) { return __uint_as_float(w & 0xffff0000u); }
__device__ __forceinline__ unsigned f2bf(float f) { unsigned u = __float_as_uint(f); return (u + 0x7fffu + ((u >> 16) & 1u)) >> 16; }
__device__ __forceinline__ unsigned pk2(float lo, float hi) { return f2bf(lo) | (f2bf(hi) << 16); }
__device__ __forceinline__ float wave_sum(float v) {
#pragma unroll
    for (int o = 1; o < 64; o <<= 1) v += __shfl_xor(v, o);
    return v;
}
__device__ __forceinline__ size_t sc_off(int r) { const size_t i = (size_t)(r >> 8); return 65536ull * (i * (i + 1) / 2) + (size_t)(r & 255) * 256ull * (i + 1); }

struct Args { const float* in[17]; float* out; unsigned char* ws; int ph_lo, ph_hi; };

template <bool MAPIN>
__device__ __forceinline__ void transpose_item(const float* __restrict__ W, int K, int srcN, bf16_t* WT, LAS float* scr, int item, int ndst, int lane) {
    const int nblk = ndst / 32, kb = item / nblk, nb = item % nblk, k0 = 64 * kb, n0 = 32 * nb;
    const int n = n0 + (lane & 31);
    int src = n;
    if (MAPIN) { src = (n < 5120) ? n : (n < 17408) ? n + 80 : (n < 17488) ? n - 17408 + 5120 : -1; }
#pragma unroll 8
    for (int i = 0; i < 32; ++i) { const int kk = 2 * i + (lane >> 5); scr[kk * 33 + (lane & 31)] = (src >= 0) ? W[(size_t)(k0 + kk) * srcN + src] : 0.f; }
    asm volatile("s_waitcnt lgkmcnt(0)" ::: "memory");
    const int c = lane & 7;
#pragma unroll
    for (int j = 0; j < 4; ++j) { const int nn = (lane >> 3) + 8 * j; const LAS float* s = scr + (8 * c) * 33 + nn;
        u32x4 o; o.x = pk2(s[0 * 33], s[1 * 33]); o.y = pk2(s[2 * 33], s[3 * 33]); o.z = pk2(s[4 * 33], s[5 * 33]); o.w = pk2(s[6 * 33], s[7 * 33]);
        *(u32x4*)(WT + (size_t)(n0 + nn) * K + k0 + 8 * c) = o; }
    asm volatile("s_waitcnt lgkmcnt(0)" ::: "memory");
}
__device__ __forceinline__ void rms_row_to_bf16(const float* __restrict__ xrow, const float* __restrict__ g, bf16_t* orow, int lane) {
    const f32x4* xr = (const f32x4*)xrow + lane; const f32x4* gr = (const f32x4*)g + lane;
    f32x4 v[8]; float s = 0.f;
#pragma unroll
    for (int j = 0; j < 8; ++j) { v[j] = xr[64 * j]; s += (v[j].x * v[j].x + v[j].y * v[j].y) + (v[j].z * v[j].z + v[j].w * v[j].w); }
    const float rs = 1.0f / sqrtf(wave_sum(s) * (1.f / DM) + RMS_EPS);
    u32x2* o8 = (u32x2*)orow + lane;
#pragma unroll
    for (int j = 0; j < 8; ++j) { const f32x4 gg = gr[64 * j]; u32x2 w; w.x = pk2(v[j].x * rs * gg.x, v[j].y * rs * gg.y); w.y = pk2(v[j].z * rs * gg.z, v[j].w * rs * gg.w); o8[64 * j] = w; }
}
__device__ __forceinline__ void p0_prologue(const Args& a, LAS unsigned char* lds, int blk, int nblk) {
    const int tid = threadIdx.x, lane = tid & 63, wave = tid >> 6;
    LAS float* scr = (LAS float*)(lds + wave * 16384);
    const int gw = blk * 8 + wave, NGW = nblk * 8;
    unsigned char* ws = a.ws;
    constexpr int I_IN = (DM / 64) * (NPAD / 32), I_MKV = (DM / 64) * (2048 / 32), I_BR = (1024 / 64) * (2048 / 32), I_OUT = (DM / 64) * (2048 / 32);
    constexpr int NITEMS = I_IN + I_MKV + 3 * I_BR + I_OUT;
    for (int it = gw; it < NITEMS; it += NGW) {
        int r = it;
        if (r < I_IN) { transpose_item<true>(a.in[3], DM, DIN, (bf16_t*)(ws + WS_WTIN), scr, r, NPAD, lane); continue; } r -= I_IN;
        if (r < I_MKV) { transpose_item<false>(a.in[11], DM, 2048, (bf16_t*)(ws + WS_WTMKV), scr, r, 2048, lane); continue; } r -= I_MKV;
        if (r < 3 * I_BR) { const int z = r / I_BR; transpose_item<false>(a.in[12 + z], 1024, 2048, (bf16_t*)(ws + WS_WTBR) + (size_t)z * 2048 * 1024, scr, r % I_BR, 2048, lane); continue; } r -= 3 * I_BR;
        transpose_item<false>(a.in[15], DM, 2048, (bf16_t*)(ws + WS_WTOUT), scr, r, 2048, lane);
    }
    bf16_t* H = (bf16_t*)(ws + WS_H);
    for (int m = gw; m < S + NMEM; m += NGW) {
        if (m < S) rms_row_to_bf16(a.in[0] + (size_t)m * DM, a.in[2], H + (size_t)m * DM, lane);
        else rms_row_to_bf16(a.in[1] + (size_t)(m - S) * DM, a.in[10], (bf16_t*)(ws + WS_MEMN) + (size_t)(m - S) * DM, lane);
    }
    if (blk == 0 && wave == 0) {
        const float s1 = wave_sum(a.in[5][lane] * a.in[6][lane]), s2 = wave_sum(a.in[7][lane] * a.in[8][lane]);
        if (lane == 0) ((float*)(ws + WS_CTL))[0] = expf(s1) - expf(s2) + 0.2f;
    }
}

__device__ __forceinline__ void idx_scores_naive(const bf16_t* __restrict__ PROJ, float* SC, LAS unsigned char* lds, int blk, int nblk) {
    const int tid = threadIdx.x, lane = tid & 63, wave = tid >> 6;
    LAS float* qs = (LAS float*)lds + wave * 1088;
    constexpr int NITEM = 128 * 129 / 2;
    for (int it = blk; it < NITEM; it += nblk) {
        int kb = 0, rem = it; while (rem >= 128 - kb) { rem -= 128 - kb; ++kb; }
        const int qc = kb + rem, s = 64 * kb + lane;
        float kreg[64];
        { const u32x4* kp = (const u32x4*)(PROJ + (size_t)s * NPAD + C_KI);
#pragma unroll
          for (int i = 0; i < 8; ++i) { const u32x4 w = kp[i]; kreg[8 * i + 0] = bflo(w.x); kreg[8 * i + 1] = bfhi(w.x); kreg[8 * i + 2] = bflo(w.y); kreg[8 * i + 3] = bfhi(w.y);
              kreg[8 * i + 4] = bflo(w.z); kreg[8 * i + 5] = bfhi(w.z); kreg[8 * i + 6] = bflo(w.w); kreg[8 * i + 7] = bfhi(w.w); } }
        for (int qq = 0; qq < 8; ++qq) {
            const int q = 64 * qc + wave * 8 + qq;
            { const u32x4* qp = (const u32x4*)(PROJ + (size_t)q * NPAD + C_QI) + 2 * lane;
              const u32x4 w0 = qp[0], w1 = qp[1];
              LAS f32x4* dst = (LAS f32x4*)(qs + 16 * lane);
              dst[0] = (f32x4){bflo(w0.x), bfhi(w0.x), bflo(w0.y), bfhi(w0.y)}; dst[1] = (f32x4){bflo(w0.z), bfhi(w0.z), bflo(w0.w), bfhi(w0.w)};
              dst[2] = (f32x4){bflo(w1.x), bfhi(w1.x), bflo(w1.y), bfhi(w1.y)}; dst[3] = (f32x4){bflo(w1.z), bfhi(w1.z), bflo(w1.w), bfhi(w1.w)};
              if (lane < 16) qs[1024 + lane] = bf2f(PROJ[(size_t)q * NPAD + C_WI + lane]) * 0.25f; }
            asm volatile("s_waitcnt lgkmcnt(0)" ::: "memory"); __builtin_amdgcn_wave_barrier();
            float score = 0.f;
            for (int j = 0; j < 16; ++j) {
                float acc = 0.f; const LAS f32x4* qj = (const LAS f32x4*)(qs + 64 * j);
#pragma unroll
                for (int d = 0; d < 16; ++d) { const f32x4 qv = qj[d]; acc += qv.x * kreg[4 * d] + qv.y * kreg[4 * d + 1] + qv.z * kreg[4 * d + 2] + qv.w * kreg[4 * d + 3]; }
                score += fmaxf(acc * 0.125f, 0.f) * qs[1024 + j];
            }
            if (s <= q) SC[sc_off(q) + s] = score;
            asm volatile("s_waitcnt lgkmcnt(0)" ::: "memory"); __builtin_amdgcn_wave_barrier();
        }
    }
}
__device__ __forceinline__ unsigned ordkey(float f) { const unsigned u = __float_as_uint(f); return (u & 0x80000000u) ? ~u : (u | 0x80000000u); }
__device__ __forceinline__ void topk_select(const float* SC, int* SEL, LAS unsigned char* lds, int blk, int nblk) {
    const int tid = threadIdx.x, lane = tid & 63, wave = tid >> 6;
    LAS unsigned* hist = (LAS unsigned*)lds + wave * 256;
    for (int r = blk * 8 + wave; r < S; r += nblk * 8) {
        const int n = r + 1; int* sel = SEL + (size_t)r * TOPK;
        if (n <= TOPK) { for (int i = lane; i < TOPK; i += 64) sel[i] = (i < n) ? i : -1; continue; }
        const float* row = SC + sc_off(r);
        unsigned prefix = 0u; int remaining = TOPK;
        for (int pass = 0; pass < 4; ++pass) {
            const int shift = 24 - 8 * pass;
#pragma unroll
            for (int i = 0; i < 4; ++i) hist[lane + 64 * i] = 0u;
            asm volatile("s_waitcnt lgkmcnt(0)" ::: "memory"); __builtin_amdgcn_wave_barrier();
            for (int i = lane; i < n; i += 64) { const unsigned u = ordkey(row[i]);
                if (pass == 0 || (u >> (shift + 8)) == prefix) atomicAdd((unsigned*)&hist[(u >> shift) & 255u], 1u); }
            asm volatile("s_waitcnt lgkmcnt(0)" ::: "memory"); __builtin_amdgcn_wave_barrier();
            const unsigned c0 = hist[4 * lane], c1 = hist[4 * lane + 1], c2 = hist[4 * lane + 2], c3 = hist[4 * lane + 3];
            const unsigned mine = c0 + c1 + c2 + c3;
            unsigned suf = mine;
#pragma unroll
            for (int o = 1; o < 64; o <<= 1) { const unsigned t = __shfl_down(suf, o); if (lane + o < 64) suf += t; }
            const unsigned long long bal = __ballot(suf >= (unsigned)remaining);
            const int Ls = 63 - __builtin_clzll(bal);
            const unsigned above = __shfl(suf, Ls) - __shfl(mine, Ls);
            const unsigned b3 = __shfl(c3, Ls), b2 = __shfl(c2, Ls), b1 = __shfl(c1, Ls);
            unsigned rem = (unsigned)remaining - above; int bin;
            if (rem <= b3) { bin = 4 * Ls + 3; } else { rem -= b3; if (rem <= b2) { bin = 4 * Ls + 2; } else { rem -= b2; if (rem <= b1) { bin = 4 * Ls + 1; } else { rem -= b1; bin = 4 * Ls; } } }
            prefix = (prefix << 8) | (unsigned)bin; remaining = (int)rem;
            asm volatile("s_waitcnt lgkmcnt(0)" ::: "memory"); __builtin_amdgcn_wave_barrier();
        }
        int cnt = 0, eqc = 0; const unsigned long long lt = (lane == 0) ? 0ull : (~0ull >> (64 - lane));
        for (int base = 0; base < n; base += 64) {
            const int i = base + lane; const unsigned u = (i < n) ? ordkey(row[i]) : 0u;
            const bool gt = (i < n) && (u > prefix), eq = (i < n) && (u == prefix);
            const unsigned long long bg = __ballot(gt), be = __ballot(eq);
            if (gt) sel[cnt + __builtin_popcountll(bg & lt)] = i;
            if (eq) { const int rk = eqc + __builtin_popcountll(be & lt); if (rk < remaining) sel[TOPK - remaining + rk] = i; }
            cnt += __builtin_popcountll(bg); eqc += __builtin_popcountll(be);
        }
    }
}
template <int DQ, int DV, bool GATHER>
__device__ __forceinline__ void naive_attn(const bf16_t* __restrict__ qp, const bf16_t* __restrict__ kb, const bf16_t* __restrict__ vb, size_t kvpitch,
                                           int nkeys, int nmax, const int* __restrict__ sel, int r, float scale, float slope, float (&o)[DV / 8]) {
    constexpr int QN = DQ / 8, VN = DV / 8;
    float q[QN];
#pragma unroll
    for (int i = 0; i < QN / 2; ++i) { const unsigned w = ((const unsigned*)qp)[i]; q[2 * i] = bflo(w) * scale; q[2 * i + 1] = bfhi(w) * scale; }
#pragma unroll
    for (int i = 0; i < VN; ++i) o[i] = 0.f;
    float m = -1e30f, l = 0.f;
    for (int i = 0; i < nmax; ++i) {
        bool valid = i < nkeys; int key = i;
        if (GATHER) { key = sel[valid ? i : 0]; valid = valid && key >= 0; }
        if (!valid) key = 0;
        const unsigned* kp = (const unsigned*)(kb + (size_t)key * kvpitch);
        float d = 0.f;
#pragma unroll
        for (int j = 0; j < QN / 2; ++j) { const unsigned w = kp[j]; d += q[2 * j] * bflo(w) + q[2 * j + 1] * bfhi(w); }
        d += __shfl_xor(d, 1); d += __shfl_xor(d, 2); d += __shfl_xor(d, 4);
        const float logit = d - slope * (float)(r - key);
        if (valid) {
            if (logit > m) { const float c = __expf(m - logit); l *= c;
#pragma unroll
                for (int j = 0; j < VN; ++j) o[j] *= c;
                m = logit; }
            const float p = __expf(logit - m); l += p;
            const unsigned* vp = (const unsigned*)(vb + (size_t)key * kvpitch);
#pragma unroll
            for (int j = 0; j < VN / 2; ++j) { const unsigned w = vp[j]; o[2 * j] += p * bflo(w); o[2 * j + 1] += p * bfhi(w); }
        }
    }
    const float il = 1.0f / l;
#pragma unroll
    for (int j = 0; j < VN; ++j) o[j] *= il;
}
__device__ __forceinline__ void attn_b_naive(const Args& a, int blk, int nblk) {
    const int tid = threadIdx.x, lane = tid & 63, wave = tid >> 6, sub = lane & 7;
    const bf16_t* PROJ = (const bf16_t*)(a.ws + WS_PROJ); bf16_t* UB = (bf16_t*)(a.ws + WS_U) + (size_t)1 * S * 1024;
    const float lam = ((const float*)(a.ws + WS_CTL))[0];
    for (int wi = blk * 8 + wave; wi < 1024 * 8; wi += nblk * 8) {
        const int h = wi & 7, rg = wi >> 3, r = rg * 8 + (lane >> 3), nmax = rg * 8 + 8;
        const float slope = exp2f(-(float)(h + 1));
        float o0[16], o1[16];
        const bf16_t* rowp = PROJ + (size_t)r * NPAD;
        naive_attn<64, 128, false>(rowp + C_QB + h * 128 + sub * 8, PROJ + C_KB + h * 128 + sub * 8, PROJ + C_VB + h * 128 + sub * 16, NPAD, r + 1, nmax, nullptr, r, 0.125f, slope, o0);
        naive_attn<64, 128, false>(rowp + C_QB + h * 128 + 64 + sub * 8, PROJ + C_KB + h * 128 + 64 + sub * 8, PROJ + C_VB + h * 128 + sub * 16, NPAD, r + 1, nmax, nullptr, r, 0.125f, slope, o1);
        float ss = 0.f;
#pragma unroll
        for (int j = 0; j < 16; ++j) { o0[j] -= lam * o1[j]; ss += o0[j] * o0[j]; }
        ss += __shfl_xor(ss, 1); ss += __shfl_xor(ss, 2); ss += __shfl_xor(ss, 4);
        const float rs = 1.0f / sqrtf(ss * (1.f / 128.f) + RMS_EPS) * 0.8f;
        const float* g = a.in[9] + sub * 16; const bf16_t* zp = rowp + C_ZB + h * 128 + sub * 16;
        unsigned w[8];
#pragma unroll
        for (int j = 0; j < 8; ++j) w[j] = pk2(o0[2 * j] * rs * g[2 * j] * bf2f(zp[2 * j]), o0[2 * j + 1] * rs * g[2 * j + 1] * bf2f(zp[2 * j + 1]));
        u32x4* dst = (u32x4*)(UB + (size_t)r * 1024 + h * 128 + sub * 16);
        dst[0] = (u32x4){w[0], w[1], w[2], w[3]}; dst[1] = (u32x4){w[4], w[5], w[6], w[7]};
    }
}
__device__ __forceinline__ void attn_m_naive(const Args& a, int blk, int nblk) {
    const int tid = threadIdx.x, lane = tid & 63, wave = tid >> 6, sub = lane & 7;
    const bf16_t* PROJ = (const bf16_t*)(a.ws + WS_PROJ); const bf16_t* MKV = (const bf16_t*)(a.ws + WS_MKV); bf16_t* UM = (bf16_t*)(a.ws + WS_U) + (size_t)2 * S * 1024;
    for (int wi = blk * 8 + wave; wi < 1024 * 4; wi += nblk * 8) {
        const int h = wi & 3, rg = wi >> 2, r = rg * 8 + (lane >> 3);
        float o[32];
        const bf16_t* rowp = PROJ + (size_t)r * NPAD;
        naive_attn<256, 256, false>(rowp + C_QM + h * 256 + sub * 32, MKV + h * 256 + sub * 32, MKV + 1024 + h * 256 + sub * 32, 2048, NMEM, NMEM, nullptr, 0, 0.0625f, 0.f, o);
        const bf16_t* zp = rowp + C_ZM + h * 256 + sub * 32;
        u32x4* dst = (u32x4*)(UM + (size_t)r * 1024 + h * 256 + sub * 32);
#pragma unroll
        for (int j = 0; j < 4; ++j) { u32x4 w;
            w.x = pk2(o[8 * j + 0] * bf2f(zp[8 * j + 0]), o[8 * j + 1] * bf2f(zp[8 * j + 1])); w.y = pk2(o[8 * j + 2] * bf2f(zp[8 * j + 2]), o[8 * j + 3] * bf2f(zp[8 * j + 3]));
            w.z = pk2(o[8 * j + 4] * bf2f(zp[8 * j + 4]), o[8 * j + 5] * bf2f(zp[8 * j + 5])); w.w = pk2(o[8 * j + 6] * bf2f(zp[8 * j + 6]), o[8 * j + 7] * bf2f(zp[8 * j + 7]));
            dst[j] = w; }
    }
}
__device__ __forceinline__ void attn_a_naive(const Args& a, int blk, int nblk) {
    const int tid = threadIdx.x, lane = tid & 63, wave = tid >> 6, sub = lane & 7;
    const bf16_t* PROJ = (const bf16_t*)(a.ws + WS_PROJ); const int* SEL = (const int*)(a.ws + WS_SEL); bf16_t* UA = (bf16_t*)(a.ws + WS_U);
    for (int wi = blk * 8 + wave; wi < 1024 * 8; wi += nblk * 8) {
        const int h = wi & 7, rg = wi >> 3, r = rg * 8 + (lane >> 3);
        const float slope = exp2f(-(float)(h + 1));
        float o[16];
        const bf16_t* rowp = PROJ + (size_t)r * NPAD;
        naive_attn<128, 128, true>(rowp + C_QA + h * 128 + sub * 16, PROJ + C_KA + h * 128 + sub * 16, PROJ + C_VA + h * 128 + sub * 16, NPAD, TOPK, TOPK, SEL + (size_t)r * TOPK, r, 0.08838834764831845f, slope, o);
        const bf16_t* zp = rowp + C_ZA + h * 128 + sub * 16;
        unsigned w[8];
#pragma unroll
        for (int j = 0; j < 8; ++j) w[j] = pk2(o[2 * j] * bf2f(zp[2 * j]), o[2 * j + 1] * bf2f(zp[2 * j + 1]));
        u32x4* dst = (u32x4*)(UA + (size_t)r * 1024 + h * 128 + sub * 16);
        dst[0] = (u32x4){w[0], w[1], w[2], w[3]}; dst[1] = (u32x4){w[4], w[5], w[6], w[7]};
    }
}
__device__ __forceinline__ void final_norm(const Args& a, int blk, int nblk) {
    const int tid = threadIdx.x, lane = tid & 63, wave = tid >> 6;
    const float* part = (const float*)(a.ws + WS_PART); const f32x4* g = (const f32x4*)a.in[16] + lane;
    for (int r = blk * 8 + wave; r < S; r += nblk * 8) {
        float s = (lane < 32) ? part[(size_t)lane * S + r] : 0.f;
        const float rs = 1.0f / sqrtf(wave_sum(s) * (1.f / DM) + RMS_EPS);
        f32x4* y = (f32x4*)(a.out + (size_t)r * DM) + lane;
#pragma unroll
        for (int j = 0; j < 8; ++j) { f32x4 v = y[64 * j]; const f32x4 gg = g[64 * j]; v = v * rs * gg; y[64 * j] = v; }
    }
}


#ifdef DBG_STAGE
__device__ __forceinline__ void dbg_dump(const Args& a, int blk, int nblk) {
    const bf16_t* PROJ = (const bf16_t*)(a.ws + WS_PROJ);
    for (size_t idx = (size_t)blk * 512 + threadIdx.x; idx < (size_t)S * DM; idx += (size_t)nblk * 512) {
        const int r = (int)(idx / DM), c = (int)(idx % DM); float v = 0.f;
#if DBG_STAGE == 1 && defined(DBG_WEIGHTS)
        for (int z = 0; z < 3; ++z) v += bf2f(((const bf16_t*)(a.ws + WS_WTBR))[((size_t)z * 2048 + (r & 2047)) * 1024 + (c & 1023)]);
        v += bf2f(((const bf16_t*)(a.ws + WS_WTOUT))[(size_t)(r & 2047) * 2048 + c]);
#elif DBG_STAGE == 1 && defined(DBG_GATES)
        for (int j = 0; j < 3; ++j) v += bf2f(PROJ[(size_t)r * NPAD + C_GL + c + 2048 * j]);
#elif DBG_STAGE == 1
        for (int j = 0; j < 8; ++j) v += bf2f(PROJ[(size_t)r * NPAD + c + 2048 * j]);
        if (c < 1280) v += bf2f(PROJ[(size_t)r * NPAD + 16384 + c]);
        if (r < 256) v += bf2f(((const bf16_t*)(a.ws + WS_MKV))[(size_t)r * 2048 + c]);
        for (int z = 0; z < 3; ++z) v += bf2f(((const bf16_t*)(a.ws + WS_WTBR))[((size_t)z * 2048 + (r & 2047)) * 1024 + (c & 1023)]);
        v += bf2f(((const bf16_t*)(a.ws + WS_WTOUT))[(size_t)(r & 2047) * 2048 + c]);
#elif DBG_STAGE == 2
        if (c < 1024) v = bf2f(((const bf16_t*)(a.ws + WS_U))[(size_t)(S + r) * 1024 + c]) + bf2f(((const bf16_t*)(a.ws + WS_U))[(size_t)(2 * S + r) * 1024 + c]);
        else { const float* row = (const float*)(a.ws + WS_SC) + sc_off(r); for (int j = c - 1024; j <= r; j += 1024) v += row[j]; }
#elif DBG_STAGE == 3
        if (c < 256) v = (float)((const int*)(a.ws + WS_SEL))[(size_t)r * 256 + c];
#elif DBG_STAGE == 4
        if (c < 1024) v = bf2f(((const bf16_t*)(a.ws + WS_U))[(size_t)r * 1024 + c]);
#elif DBG_STAGE == 5
        v = bf2f(((const bf16_t*)(a.ws + WS_MERGED))[(size_t)r * DM + c]);
#endif
        a.out[idx] = v;
    }
}
#endif

constexpr int LDS_BYTES = 147456;
constexpr int NPHASE = 8;
__global__ void __launch_bounds__(512, 2) fwd(Args a) {
    extern __shared__ __attribute__((aligned(16))) unsigned char lds_raw[];
    LAS unsigned char* lds = (LAS unsigned char*)lds_raw;
    cg::grid_group grid = cg::this_grid();
    const int blk = blockIdx.x, nblk = gridDim.x;
    unsigned char* ws = a.ws;
    const bf16_t* PROJ = (const bf16_t*)(ws + WS_PROJ);
#define IN(k) (a.ph_lo <= (k) && (k) < a.ph_hi)
#define SEAM(k) do { if (IN(k) && IN((k) + 1)) grid.sync(); } while (0)
    if (IN(0)) { p0_prologue(a, lds, blk, nblk); } SEAM(0);
    if (IN(1)) {
        pg8::Gemm g{(const bf16_t*)(ws + WS_H), (const bf16_t*)(ws + WS_WTIN), S, NPAD, DM, (long)WS_MEMN - (long)WS_H, (long)WS_WTMKV - (long)WS_WTIN};
        pg8::ProjOrder so; so.init(S, NPAD, nblk, blk);
        pg8::EpiProj E{(bf16_t*)(ws + WS_PROJ), NPAD, (bf16_t*)(ws + WS_MKV), 2048, a.in[4], C_GL / 256};
        pg8::gemm_phase<pg8::EpiProj, pg8::ProjOrder, true, true>(lds, g, so, E);
    } SEAM(1);
    if (IN(2)) { idx_scores_naive(PROJ, (float*)(ws + WS_SC), lds, blk, nblk); attn_b_naive(a, blk, nblk); attn_m_naive(a, blk, nblk); } SEAM(2);
    if (IN(3)) { topk_select((const float*)(ws + WS_SC), (int*)(ws + WS_SEL), lds, blk, nblk); } SEAM(3);
    if (IN(4)) { attn_a_naive(a, blk, nblk); } SEAM(4);
    if (IN(5)) {
        pg8::Gemm g{(const bf16_t*)(ws + WS_U), (const bf16_t*)(ws + WS_WTBR), S, DM, 1024, (long)S * 1024 * 2, (long)2048 * 1024 * 2};
        pg8::MergeOrder so; so.init(S, DM, nblk, blk);
        pg8::EpiMerge E{PROJ + C_GL, NPAD, (float*)(ws + WS_T), (bf16_t*)(ws + WS_MERGED), DM};
        pg8::gemm_phase<pg8::EpiMerge, pg8::MergeOrder, true, true>(lds, g, so, E);
    } SEAM(5);
    if (IN(6)) {
        pg8::Gemm g{(const bf16_t*)(ws + WS_MERGED), (const bf16_t*)(ws + WS_WTOUT), S, DM, DM, 0, 0};
        pg8::StaticOrder so; so.init(S, DM, nblk, blk);
        pg8::EpiOut E{a.in[0], a.out, DM, (float*)(ws + WS_PART), S};
        pg8::gemm_phase<pg8::EpiOut, pg8::StaticOrder, false, true>(lds, g, so, E);
    } SEAM(6);
    if (IN(7)) { final_norm(a, blk, nblk); }
#ifdef DBG_STAGE
    if (IN(8)) { dbg_dump(a, blk, nblk); }
#endif
#undef IN
#undef SEAM
}

#ifndef N_LAUNCH_MODE
#define N_LAUNCH_MODE 0
#endif
extern "C" void kernel_launch(void* const* d_in, const int* in_sizes, int n_in, void* d_out, int out_size, void* d_ws, size_t ws_size, hipStream_t stream) {
    static int grid = 0;
    if (grid == 0) {
        if (n_in != 17 || in_sizes[0] != S * DM || in_sizes[3] != DM * DIN || out_size != S * DM || ws_size < WS_END) {
            fprintf(stderr, "kernel_launch: unexpected shapes (n_in %d, in0 %d, in3 %d, out %d, ws %zu < %zu)\n", n_in, n_in > 0 ? in_sizes[0] : -1, n_in > 3 ? in_sizes[3] : -1, out_size, ws_size, (size_t)WS_END); grid = -1; return; }
        int dev = 0, cus = 0, per_cu = 0;
        (void)hipGetDevice(&dev); (void)hipDeviceGetAttribute(&cus, hipDeviceAttributeMultiprocessorCount, dev);
        if (hipFuncSetAttribute((const void*)fwd, hipFuncAttributeMaxDynamicSharedMemorySize, LDS_BYTES) != hipSuccess) { fprintf(stderr, "kernel_launch: hipFuncSetAttribute failed\n"); grid = -1; return; }
        if (hipOccupancyMaxActiveBlocksPerMultiprocessor(&per_cu, (const void*)fwd, 512, LDS_BYTES) != hipSuccess || per_cu < 1) { fprintf(stderr, "kernel_launch: occupancy query gave %d\n", per_cu); per_cu = 1; }
        (void)hipGetLastError();
        grid = cus * 1;
        if (grid > cus * per_cu) grid = cus * per_cu;
        if (grid < 8) grid = -1;
    }
    if (grid < 0) return;
    Args a{};
    for (int i = 0; i < 17; ++i) a.in[i] = (const float*)d_in[i];
    a.out = (float*)d_out; a.ws = (unsigned char*)d_ws;
#if N_LAUNCH_MODE == 1
    a.ph_lo = 0; a.ph_hi = NPHASE;
    void* kargs[] = {&a};
    hipError_t e = hipLaunchCooperativeKernel((const void*)fwd, dim3(grid), dim3(512), kargs, LDS_BYTES, stream);
    if (e != hipSuccess) fprintf(stderr, "cooperative launch failed: %s (grid %d)\n", hipGetErrorString(e), grid);
#else
#ifdef DBG_STAGE
    #ifdef DBG_WEIGHTS
    constexpr int last_ph[6] = {0, 0, 2, 3, 4, 5};
#else
    constexpr int last_ph[6] = {0, 1, 2, 3, 4, 5};
#endif
    for (int p = 0; p <= last_ph[DBG_STAGE]; ++p) { a.ph_lo = p; a.ph_hi = p + 1; hipLaunchKernelGGL(fwd, dim3(grid), dim3(512), LDS_BYTES, stream, a); }
    a.ph_lo = 8; a.ph_hi = 9; hipLaunchKernelGGL(fwd, dim3(grid), dim3(512), LDS_BYTES, stream, a);
#else
    for (int p = 0; p < NPHASE; ++p) {
        a.ph_lo = p; a.ph_hi = p + 1;
        hipLaunchKernelGGL(fwd, dim3(grid), dim3(512), LDS_BYTES, stream, a);
    }
#endif
#endif
}
```

```cpp
#define N_LAUNCH_MODE 1
#include <hip/hip_runtime.h>
#include <hip/hip_cooperative_groups.h>
#include <cstdio>
#include <cstdint>
namespace cg = cooperative_groups;

namespace pg8 {
#define PG8_LAS __attribute__((address_space(3)))
typedef unsigned short bf16_t;
typedef short bf16x8 __attribute__((ext_vector_type(8)));
typedef float f32x4 __attribute__((ext_vector_type(4)));
typedef unsigned u32x4 __attribute__((ext_vector_type(4)));
constexpr int BM = 256, BK = 64, HALF = 128, HTB = HALF * BK * 2  , STAGE_BYTES = 8 * HTB, NXCD = 8, WGM = 8;

__host__ __device__ __forceinline__ int lds_byte(int r, int c) { const int st = (r >> 4) * 2 + (c >> 5), rr = r & 15, cc = c & 31, ob = rr * 64 + cc * 2; return st * 1024 + (ob ^ (((ob >> 9) & 1) << 5)); }
__host__ __device__ __forceinline__ void stage_rc(int b, int& R, int& C) { const int st = b / 1024, sb = b % 1024, swz = sb ^ (((sb >> 9) & 1) << 5); R = (st >> 1) * 16 + swz / 64; C = (st & 1) * 32 + (swz % 64) / 2; }
__host__ __device__ __forceinline__ int perm32(int rho) { const int n = rho >> 4, i = rho & 15; return 8 * (i >> 2) + 4 * n + (i & 3); }

struct Unit { int pm, pn, z; };
struct Gemm { const bf16_t* A; const bf16_t* Bt; int M, N, K; long zA, zB; };

struct StaticOrder {
    int nM, nN, nwg, G, c;
    __host__ __device__ void init(int M, int N, int G_, int c_) { nM = M / BM; nN = N / BM; nwg = nM * nN; G = G_; c = c_; }
    __host__ __device__ bool next(int i, Unit& u) const {
        const long L = (long)i * G + c; if (L >= nwg) return false;
        int wgid = (int)L; { const int q = nwg / NXCD, r = nwg % NXCD, xcd = wgid % NXCD, off = wgid / NXCD; wgid = (xcd < r ? xcd * (q + 1) : r * (q + 1) + (xcd - r) * q) + off; }
        const int nig = WGM * nN, gid = wgid / nig, fm = gid * WGM, gsz = (nM - fm) < WGM ? (nM - fm) : WGM;
        u.pm = fm + ((wgid % nig) % gsz); u.pn = (wgid % nig) / gsz; u.z = 0; return true;
    }
    __device__ __forceinline__ void a_ready(const Unit&) const {}
    __device__ __forceinline__ void done(const Unit&) const {}
};

typedef float f32x2_t __attribute__((ext_vector_type(2))); typedef __bf16 bf16x2_t __attribute__((ext_vector_type(2)));
__device__ __forceinline__ unsigned cvt_pk_bf16(float lo, float hi) { f32x2_t v = {lo, hi}; bf16x2_t b = __builtin_convertvector(v, bf16x2_t); return __builtin_bit_cast(unsigned, b); }

__device__ __forceinline__ float bf2f(unsigned short u) { return __uint_as_float((unsigned)u << 16); }
__device__ __forceinline__ float sigmoidf_(float v) { return __builtin_amdgcn_rcpf(1.0f + __builtin_amdgcn_exp2f(-1.4426950408889634f * v)); }
template <int MODE> __device__ __forceinline__ float act_(float v, float b) {
    if (MODE == 1) return v * sigmoidf_(v);
    if (MODE == 2) return sigmoidf_(v + b);
    return v;
}
struct EpiProj {
    static constexpr bool PERM = true, AFTER_DRAIN = false;
    bf16_t* O; int ldc; bf16_t* O1; int ldc1; const float* bgate; int gate_tile0;
    template <int MODE> __device__ __forceinline__ void put(const f32x4 (&acc)[2][2][4][2], bf16_t* base, int ld, int row0, int col0, const float* bias) const {
        f32x4 bv[2][2];
#pragma unroll
        for (int bj = 0; bj < 2; ++bj)
#pragma unroll
            for (int n = 0; n < 2; ++n) bv[bj][n] = (MODE == 2) ? *(const f32x4*)(bias + bj * HALF + 4 * n) : (f32x4){0.f, 0.f, 0.f, 0.f};
#pragma unroll
        for (int ai = 0; ai < 2; ++ai)
#pragma unroll
            for (int m = 0; m < 4; ++m) { bf16_t* rowp = base + (size_t)(row0 + ai * HALF + m * 16) * ld + col0;
#pragma unroll
                for (int bj = 0; bj < 2; ++bj) { f32x4 v0 = acc[ai][bj][m][0], v1 = acc[ai][bj][m][1];
#pragma unroll
                    for (int e = 0; e < 4; ++e) { v0[e] = act_<MODE>(v0[e], bv[bj][0][e]); v1[e] = act_<MODE>(v1[e], bv[bj][1][e]); }
                    u32x4 w; w.x = cvt_pk_bf16(v0[0], v0[1]); w.y = cvt_pk_bf16(v0[2], v0[3]); w.z = cvt_pk_bf16(v1[0], v1[1]); w.w = cvt_pk_bf16(v1[2], v1[3]);
                    *(u32x4*)(rowp + bj * HALF) = w; } }
    }
    __device__ __forceinline__ void operator()(const f32x4 (&acc)[2][2][4][2], const Unit& u, int wr, int wc, int fr, int fq) const {
        const int row0 = u.pm * BM + wr * 64 + fr, col0 = u.pn * BM + wc * 32 + 8 * fq;
        if (u.z == 1) { put<0>(acc, O1, ldc1, row0, col0, nullptr); return; }
        const int t = u.pn;
        const bool is_silu = (t >= 12 && t < 16) || (t >= 32 && t < 36) || (t >= 40 && t < 44);
        if (t >= gate_tile0 && t < 68) put<2>(acc, O, ldc, row0, col0, bgate + (col0 - gate_tile0 * BM));
        else if (is_silu) put<1>(acc, O, ldc, row0, col0, nullptr);
        else put<0>(acc, O, ldc, row0, col0, nullptr);
    }
};
struct EpiMerge {
    static constexpr bool PERM = true, AFTER_DRAIN = false;
    const bf16_t* G; int ldg;
    float* T; bf16_t* O; int ldc;
    __device__ __forceinline__ void operator()(const f32x4 (&acc)[2][2][4][2], const Unit& u, int wr, int wc, int fr, int fq) const {
        const int row0 = u.pm * BM + wr * 64 + fr, col0 = u.pn * BM + wc * 32 + 8 * fq;
#pragma unroll
        for (int ai = 0; ai < 2; ++ai)
#pragma unroll
            for (int m = 0; m < 4; ++m) { const size_t row = (size_t)(row0 + ai * HALF + m * 16);
#pragma unroll
                for (int bj = 0; bj < 2; ++bj) { const int col = col0 + bj * HALF;
                    const u32x4 gw = *(const u32x4*)(G + row * ldg + (size_t)u.z * 2048 + col);
                    f32x4 g0, g1;
                    g0[0] = __uint_as_float(gw.x << 16); g0[1] = __uint_as_float(gw.x & 0xffff0000u); g0[2] = __uint_as_float(gw.y << 16); g0[3] = __uint_as_float(gw.y & 0xffff0000u);
                    g1[0] = __uint_as_float(gw.z << 16); g1[1] = __uint_as_float(gw.z & 0xffff0000u); g1[2] = __uint_as_float(gw.w << 16); g1[3] = __uint_as_float(gw.w & 0xffff0000u);
                    f32x4 v0 = acc[ai][bj][m][0] * g0, v1 = acc[ai][bj][m][1] * g1;
                    float* tp = T + row * ldc + col;
                    if (u.z > 0) { v0 += __builtin_nontemporal_load((const f32x4*)tp); v1 += __builtin_nontemporal_load((const f32x4*)(tp + 4)); }
                    if (u.z < 2) { *(f32x4*)tp = v0; *(f32x4*)(tp + 4) = v1; }
                    else { u32x4 w; w.x = cvt_pk_bf16(v0[0], v0[1]); w.y = cvt_pk_bf16(v0[2], v0[3]); w.z = cvt_pk_bf16(v1[0], v1[1]); w.w = cvt_pk_bf16(v1[2], v1[3]);
                        *(u32x4*)(O + row * ldc + col) = w; } } }
    }
};
struct EpiOut {
    static constexpr bool PERM = false, AFTER_DRAIN = false;
    const float* X; float* Y; int ldc; float* part; int M;
    __device__ __forceinline__ void operator()(const f32x4 (&acc)[2][2][4][2], const Unit& u, int wr, int wc, int fr, int fq) const {
        const int row0 = u.pm * BM + wr * 64 + fr, col0 = u.pn * BM + wc * 32 + 4 * fq;
#pragma unroll
        for (int ai = 0; ai < 2; ++ai)
#pragma unroll
            for (int m = 0; m < 4; ++m) { const size_t row = (size_t)(row0 + ai * HALF + m * 16); float ss = 0.f;
#pragma unroll
                for (int bj = 0; bj < 2; ++bj)
#pragma unroll
                    for (int n = 0; n < 2; ++n) { const size_t off = row * ldc + col0 + bj * HALF + n * 16;
                        const f32x4 y = *(const f32x4*)(X + off) + acc[ai][bj][m][n]; *(f32x4*)(Y + off) = y;
                        ss += (y[0] * y[0] + y[1] * y[1]) + (y[2] * y[2] + y[3] * y[3]); }
                ss += __shfl_xor(ss, 16); ss += __shfl_xor(ss, 32);
                if (fq == 0) part[(size_t)(u.pn * 4 + wc) * M + row] = ss; }
    }
};
struct ProjOrder {
    StaticOrder so; int nmain, extra;
    __device__ void init(int M, int N, int G, int c) { so.init(M, N, G, c); nmain = (so.nwg - c + G - 1) / G; extra = (c >= G - 8) ? c - (G - 8) : -1; }
    __device__ bool next(int i, Unit& u) const {
        if (i < nmain) return so.next(i, u);
        if (i == nmain && extra >= 0) { u.pm = 0; u.pn = extra; u.z = 1; return true; }
        return false;
    }
    __device__ __forceinline__ void a_ready(const Unit&) const {}
    __device__ __forceinline__ void done(const Unit&) const {}
};
struct MergeOrder {
    StaticOrder so;
    __device__ void init(int M, int N, int G, int c) { so.init(M, N, G, c); }
    __device__ bool next(int i, Unit& u) const { if (i >= 3) return false; if (!so.next(0, u)) return false; u.z = i; return true; }
    __device__ __forceinline__ void a_ready(const Unit&) const {}
    __device__ __forceinline__ void done(const Unit&) const {}
};

template <class Epi, class Sched, bool ALIGN_EPI = false, bool SP2 = false>
__device__ __forceinline__ void gemm_phase(PG8_LAS unsigned char* lds, const Gemm g, const Sched& S, const Epi& E) {
    const int tid = threadIdx.x, wid = __builtin_amdgcn_readfirstlane(tid >> 6), lane = tid & 63, wr = wid >> 2, wc = wid & 3, fr = lane & 15, fq = lane >> 4;
    const int K = g.K, nt = K / BK;
    unsigned voffA[2], voffB[2];
#pragma unroll
    for (int i = 0; i < 2; ++i) { int R, C; stage_rc(tid * 16 + i * 8192, R, C); const int Rb = Epi::PERM ? ((R & ~31) + perm32(R & 31)) : R;
        voffA[i] = (unsigned)(R * K + C) * 2u; voffB[i] = (unsigned)(Rb * K + C) * 2u; }
    const size_t kstep = (size_t)(BK * 2);
    const size_t hstep = (size_t)HALF * K * 2;
    const size_t tstep = 2 * hstep;
    const unsigned ldsw = (unsigned)wid * 1024u;
    const int aoff = lds_byte(wr * 64 + fr, fq * 8), boff = lds_byte(wc * 32 + fr, fq * 8);
#define PG8_SA(b, h) (((b) * 2 + (h)) * HTB)
#define PG8_SB(b, h) ((4 + (b) * 2 + (h)) * HTB)
#define PG8_STAGE(bufoff, gbase, voff) do { _Pragma("unroll") for (int _i = 0; _i < 2; ++_i) \
        __builtin_amdgcn_global_load_lds((const unsigned*)((const char*)(gbase) + (voff)[_i]), (PG8_LAS unsigned*)(lds + (bufoff) + ldsw + _i * 8192), 16, 0, 0); } while (0)
#define PG8_LDA(dst, b, h) do { _Pragma("unroll") for (int m = 0; m < 4; ++m) _Pragma("unroll") for (int k = 0; k < 2; ++k) dst[m][k] = *(const PG8_LAS bf16x8*)(lds + PG8_SA(b, h) + aoff + m * 2048 + k * 1024); } while (0)
#define PG8_LDB(dst, b, h) do { _Pragma("unroll") for (int n = 0; n < 2; ++n) _Pragma("unroll") for (int k = 0; k < 2; ++k) dst[n][k] = *(const PG8_LAS bf16x8*)(lds + PG8_SB(b, h) + boff + n * 2048 + k * 1024); } while (0)
#define PG8_MMA(ai, bj, At, Bt) do { __builtin_amdgcn_s_setprio(1); _Pragma("unroll") for (int m = 0; m < 4; ++m) _Pragma("unroll") for (int n = 0; n < 2; ++n) _Pragma("unroll") for (int k = 0; k < 2; ++k) \
        acc[ai][bj][m][n] = __builtin_amdgcn_mfma_f32_16x16x32_bf16(Bt[n][k], At[m][k], acc[ai][bj][m][n], 0, 0, 0); __builtin_amdgcn_s_setprio(0); } while (0)
#define PG8_WAIT_V(n) asm volatile("s_waitcnt vmcnt(" #n ")" ::: "memory")
#define PG8_WAIT_L(n) asm volatile("s_waitcnt lgkmcnt(" #n ")" ::: "memory")
#define PG8_BAR __builtin_amdgcn_s_barrier()
#define PG8_SCHED __builtin_amdgcn_sched_barrier(0)
    Unit cur, nxt; int ui = 0;
    if (!S.next(0, cur)) return;
    f32x4 acc[2][2][4][2];
#pragma unroll
    for (int a = 0; a < 2; ++a)
#pragma unroll
        for (int b = 0; b < 2; ++b)
#pragma unroll
            for (int m = 0; m < 4; ++m)
#pragma unroll
                for (int n = 0; n < 2; ++n) acc[a][b][m][n] = (f32x4){0.f, 0.f, 0.f, 0.f};
    bf16x8 At[4][2], B0[2][2], B1[2][2];
    const char* cA = (const char*)g.A + (long)cur.z * g.zA + (size_t)cur.pm * tstep; const char* cB = (const char*)g.Bt + (long)cur.z * g.zB + (size_t)cur.pn * tstep;
    S.a_ready(cur);
    if constexpr (SP2) {
        PG8_STAGE(PG8_SB(0, 0), cB, voffB); PG8_STAGE(PG8_SB(0, 1), cB + hstep, voffB); PG8_STAGE(PG8_SA(0, 0), cA, voffA); PG8_STAGE(PG8_SA(0, 1), cA + hstep, voffA);
        if (wr == 1) PG8_BAR;
        PG8_WAIT_V(2); PG8_BAR;
        PG8_STAGE(PG8_SB(1, 0), cB + kstep, voffB); PG8_STAGE(PG8_SA(1, 0), cA + kstep, voffA); PG8_STAGE(PG8_SB(1, 1), cB + hstep + kstep, voffB);
        PG8_WAIT_V(6); PG8_BAR;
    } else {
        PG8_STAGE(PG8_SB(0, 0), cB, voffB); PG8_STAGE(PG8_SA(0, 0), cA, voffA); PG8_STAGE(PG8_SB(0, 1), cB + hstep, voffB); PG8_STAGE(PG8_SA(0, 1), cA + hstep, voffA);
        if (wr == 1) PG8_BAR;
        PG8_WAIT_V(4); PG8_BAR;
        PG8_STAGE(PG8_SB(1, 0), cB + kstep, voffB); PG8_STAGE(PG8_SA(1, 0), cA + kstep, voffA); PG8_STAGE(PG8_SB(1, 1), cB + hstep + kstep, voffB);
        PG8_WAIT_V(6); PG8_BAR;
    }
    for (;;) {
        const bool has_next = S.next(ui + 1, nxt);
        const char* nA = has_next ? (const char*)g.A + (long)nxt.z * g.zA + (size_t)nxt.pm * tstep : cA; const char* nB = has_next ? (const char*)g.Bt + (long)nxt.z * g.zB + (size_t)nxt.pn * tstep : cB;
        for (int t = 0; t < nt; t += 2) {
            const bool last = (t == nt - 2);
            const char* a1 = cA + (size_t)(t + 1) * kstep;
            const char* a2 = last ? nA : cA + (size_t)(t + 2) * kstep; const char* b2 = last ? nB : cB + (size_t)(t + 2) * kstep;
            const char* a3 = a2 + kstep; const char* b3 = b2 + kstep;
            if (last && has_next) S.a_ready(nxt);
            if constexpr (SP2) {
            PG8_LDB(B0, 0, 0); PG8_LDB(B1, 0, 1); PG8_SCHED; PG8_LDA(At, 0, 0); PG8_STAGE(PG8_SA(1, 1), a1 + hstep, voffA);
            PG8_WAIT_V(8); PG8_WAIT_L(0); PG8_BAR; PG8_MMA(0, 0, At, B0); PG8_MMA(0, 1, At, B1); PG8_BAR; PG8_SCHED;
            PG8_LDA(At, 0, 1); PG8_STAGE(PG8_SB(0, 0), b2, voffB); PG8_STAGE(PG8_SB(0, 1), b2 + hstep, voffB); PG8_STAGE(PG8_SA(0, 0), a2, voffA);
            PG8_WAIT_V(8); PG8_WAIT_L(0); PG8_BAR; PG8_MMA(1, 0, At, B0); PG8_MMA(1, 1, At, B1); PG8_BAR; PG8_SCHED;
            PG8_LDB(B0, 1, 0); PG8_LDB(B1, 1, 1); PG8_SCHED; PG8_LDA(At, 1, 0); PG8_STAGE(PG8_SA(0, 1), a2 + hstep, voffA);
            PG8_WAIT_V(8); PG8_WAIT_L(0); PG8_BAR; PG8_MMA(0, 0, At, B0); PG8_MMA(0, 1, At, B1); PG8_BAR; PG8_SCHED;
            PG8_LDA(At, 1, 1); PG8_STAGE(PG8_SB(1, 0), b3, voffB); PG8_STAGE(PG8_SB(1, 1), b3 + hstep, voffB); PG8_STAGE(PG8_SA(1, 0), a3, voffA);
            PG8_WAIT_V(8); PG8_WAIT_L(0); PG8_BAR; PG8_MMA(1, 0, At, B0); PG8_MMA(1, 1, At, B1); PG8_BAR; PG8_SCHED;
            } else {
            PG8_LDB(B0, 0, 0); PG8_SCHED; PG8_LDA(At, 0, 0); PG8_STAGE(PG8_SA(1, 1), a1 + hstep, voffA);
            PG8_WAIT_L(8); PG8_BAR; PG8_WAIT_L(0); PG8_MMA(0, 0, At, B0); PG8_BAR; PG8_SCHED;
            PG8_LDB(B1, 0, 1); PG8_STAGE(PG8_SB(0, 0), b2, voffB);
            PG8_BAR; PG8_WAIT_L(0); PG8_MMA(0, 1, At, B1); PG8_BAR;
            PG8_LDA(At, 0, 1); PG8_STAGE(PG8_SA(0, 0), a2, voffA);
            PG8_BAR; PG8_WAIT_L(0); PG8_MMA(1, 0, At, B0); PG8_BAR; PG8_SCHED;
            PG8_STAGE(PG8_SB(0, 1), b2 + hstep, voffB);
            PG8_WAIT_V(6); PG8_BAR; PG8_MMA(1, 1, At, B1); PG8_BAR;
            PG8_LDB(B0, 1, 0); PG8_SCHED; PG8_LDA(At, 1, 0); PG8_STAGE(PG8_SA(0, 1), a2 + hstep, voffA);
            PG8_WAIT_L(8); PG8_BAR; PG8_WAIT_L(0); PG8_MMA(0, 0, At, B0); PG8_BAR; PG8_SCHED;
            PG8_LDB(B1, 1, 1); PG8_STAGE(PG8_SB(1, 0), b3, voffB);
            PG8_BAR; PG8_WAIT_L(0); PG8_MMA(0, 1, At, B1); PG8_BAR;
            PG8_LDA(At, 1, 1); PG8_STAGE(PG8_SA(1, 0), a3, voffA);
            PG8_BAR; PG8_WAIT_L(0); PG8_MMA(1, 0, At, B0); PG8_BAR; PG8_SCHED;
            PG8_STAGE(PG8_SB(1, 1), b3 + hstep, voffB);
            PG8_WAIT_V(6); PG8_BAR; PG8_MMA(1, 1, At, B1); PG8_BAR;
            }
        }
        if constexpr (ALIGN_EPI) { if (wr == 0) PG8_BAR; }
        if constexpr (!Epi::AFTER_DRAIN) { E(acc, cur, wr, wc, fr, fq); S.done(cur); }
        if (!has_next) break;
#pragma unroll
        for (int a = 0; a < 2; ++a)
#pragma unroll
            for (int b = 0; b < 2; ++b)
#pragma unroll
                for (int m = 0; m < 4; ++m)
#pragma unroll
                    for (int n = 0; n < 2; ++n) acc[a][b][m][n] = (f32x4){0.f, 0.f, 0.f, 0.f};
        cur = nxt; cA = nA; cB = nB; ++ui;
        if constexpr (ALIGN_EPI) { if (wr == 1) PG8_BAR; }
    }
    PG8_WAIT_V(0);
    if constexpr (!ALIGN_EPI) { if (wr == 0) PG8_BAR; }
    PG8_BAR;
    if constexpr (Epi::AFTER_DRAIN) { E.fused(acc, cur, wr, wc, fr, fq, lds, wid, lane); S.done(cur); }
#undef PG8_SA
#undef PG8_SB
#undef PG8_STAGE
#undef PG8_LDA
#undef PG8_LDB
#undef PG8_MMA
#undef PG8_WAIT_V
#undef PG8_WAIT_L
#undef PG8_BAR
#undef PG8_SCHED
}
}

constexpr int S = 8192, DM = 2048, DIN = 17488, NPAD = 17664, NMEM = 256;
constexpr int C_QA = 0, C_KA = 1024, C_VA = 2048, C_ZA = 3072, C_QI = 4096, C_QB = 5120, C_KB = 6144, C_VB = 7168, C_ZB = 8192, C_QM = 9216, C_ZM = 10240, C_GL = 11264, C_KI = 17408, C_WI = 17472;
constexpr int TOPK = 256;
constexpr float RMS_EPS = 1e-6f;
constexpr size_t MiB = 1u << 20;
constexpr size_t WS_CTL = 0;
constexpr size_t WS_WTIN = 1 * MiB;
constexpr size_t WS_U = 1 * MiB;
constexpr size_t WS_WTMKV = 70 * MiB;
constexpr size_t WS_WTBR = 78 * MiB;
constexpr size_t WS_WTOUT = 90 * MiB;
constexpr size_t WS_MEMN = 98 * MiB;
constexpr size_t WS_MKV = 99 * MiB;
constexpr size_t WS_PROJ = 100 * MiB;
constexpr size_t WS_SC = 376 * MiB;
constexpr size_t WS_MERGED = 376 * MiB;
constexpr size_t WS_H = 376 * MiB;
constexpr size_t WS_T = 408 * MiB;
constexpr size_t WS_SEL = 508 * MiB;
constexpr size_t WS_PART = 516 * MiB;
constexpr size_t WS_END = 517 * MiB;

typedef unsigned short bf16_t;
typedef unsigned u32x4 __attribute__((ext_vector_type(4)));
typedef unsigned u32x2 __attribute__((ext_vector_type(2)));
typedef float f32x4 __attribute__((ext_vector_type(4)));
#define LAS __attribute__((address_space(3)))
__device__ __forceinline__ float bf2f(unsigned short u) { return __uint_as_float((unsigned)u << 16); }
__device__ __forceinline__ float bflo(unsigned w) { return __uint_as_float(w << 16); }
__device__ __forceinline__ float bfhi(unsigned w) { return __uint_as_float(w & 0xffff0000u); }
__device__ __forceinline__ unsigned f2bf(float f) { unsigned u = __float_as_uint(f); return (u + 0x7fffu + ((u >> 16) & 1u)) >> 16; }
__device__ __forceinline__ unsigned pk2(float lo, float hi) { return f2bf(lo) | (f2bf(hi) << 16); }
__device__ __forceinline__ float wave_sum(float v) {
#pragma unroll
    for (int o = 1; o < 64; o <<= 1) v += __shfl_xor(v, o);
    return v;
}
__device__ __forceinline__ size_t sc_off(int r) { const size_t i = (size_t)(r >> 8); return 65536ull * (i * (i + 1) / 2) + (size_t)(r & 255) * 256ull * (i + 1); }

struct Args { const float* in[17]; float* out; unsigned char* ws; int ph_lo, ph_hi; };

template <bool MAPIN>
__device__ __forceinline__ void transpose_item(const float* __restrict__ W, int K, int srcN, bf16_t* WT, LAS float* scr, int item, int ndst, int lane) {
    const int nblk = ndst / 32, kb = item / nblk, nb = item % nblk, k0 = 64 * kb, n0 = 32 * nb;
    const int n = n0 + (lane & 31);
    int src = n;
    if (MAPIN) { src = (n < 5120) ? n : (n < 17408) ? n + 80 : (n < 17488) ? n - 17408 + 5120 : -1; }
#pragma unroll 8
    for (int i = 0; i < 32; ++i) { const int kk = 2 * i + (lane >> 5); scr[kk * 33 + (lane & 31)] = (src >= 0) ? W[(size_t)(k0 + kk) * srcN + src] : 0.f; }
    asm volatile("s_waitcnt lgkmcnt(0)" ::: "memory");
    const int c = lane & 7;
#pragma unroll
    for (int j = 0; j < 4; ++j) { const int nn = (lane >> 3) + 8 * j; const LAS float* s = scr + (8 * c) * 33 + nn;
        u32x4 o; o.x = pk2(s[0 * 33], s[1 * 33]); o.y = pk2(s[2 * 33], s[3 * 33]); o.z = pk2(s[4 * 33], s[5 * 33]); o.w = pk2(s[6 * 33], s[7 * 33]);
        *(u32x4*)(WT + (size_t)(n0 + nn) * K + k0 + 8 * c) = o; }
    asm volatile("s_waitcnt lgkmcnt(0)" ::: "memory");
}
__device__ __forceinline__ void rms_row_to_bf16(const float* __restrict__ xrow, const float* __restrict__ g, bf16_t* orow, int lane) {
    const f32x4* xr = (const f32x4*)xrow + lane; const f32x4* gr = (const f32x4*)g + lane;
    f32x4 v[8]; float s = 0.f;
#pragma unroll
    for (int j = 0; j < 8; ++j) { v[j] = xr[64 * j]; s += (v[j].x * v[j].x + v[j].y * v[j].y) + (v[j].z * v[j].z + v[j].w * v[j].w); }
    const float rs = 1.0f / sqrtf(wave_sum(s) * (1.f / DM) + RMS_EPS);
    u32x2* o8 = (u32x2*)orow + lane;
#pragma unroll
    for (int j = 0; j < 8; ++j) { const f32x4 gg = gr[64 * j]; u32x2 w; w.x = pk2(v[j].x * rs * gg.x, v[j].y * rs * gg.y); w.y = pk2(v[j].z * rs * gg.z, v[j].w * rs * gg.w); o8[64 * j] = w; }
}
__device__ __forceinline__ void p0_prologue(const Args& a, LAS unsigned char* lds, int blk, int nblk) {
    const int tid = threadIdx.x, lane = tid & 63, wave = tid >> 6;
    LAS float* scr = (LAS float*)(lds + wave * 16384);
    const int gw = blk * 8 + wave, NGW = nblk * 8;
    unsigned char* ws = a.ws;
    constexpr int I_IN = (DM / 64) * (NPAD / 32), I_MKV = (DM / 64) * (2048 / 32), I_BR = (1024 / 64) * (2048 / 32), I_OUT = (DM / 64) * (2048 / 32);
    constexpr int NITEMS = I_IN + I_MKV + 3 * I_BR + I_OUT;
    for (int it = gw; it < NITEMS; it += NGW) {
        int r = it;
        if (r < I_IN) { transpose_item<true>(a.in[3], DM, DIN, (bf16_t*)(ws + WS_WTIN), scr, r, NPAD, lane); continue; } r -= I_IN;
        if (r < I_MKV) { transpose_item<false>(a.in[11], DM, 2048, (bf16_t*)(ws + WS_WTMKV), scr, r, 2048, lane); continue; } r -= I_MKV;
        if (r < 3 * I_BR) { const int z = r / I_BR; transpose_item<false>(a.in[12 + z], 1024, 2048, (bf16_t*)(ws + WS_WTBR) + (size_t)z * 2048 * 1024, scr, r % I_BR, 2048, lane); continue; } r -= 3 * I_BR;
        transpose_item<false>(a.in[15], DM, 2048, (bf16_t*)(ws + WS_WTOUT), scr, r, 2048, lane);
    }
    bf16_t* H = (bf16_t*)(ws + WS_H);
    for (int m = gw; m < S + NMEM; m += NGW) {
        if (m < S) rms_row_to_bf16(a.in[0] + (size_t)m * DM, a.in[2], H + (size_t)m * DM, lane);
        else rms_row_to_bf16(a.in[1] + (size_t)(m - S) * DM, a.in[10], (bf16_t*)(ws + WS_MEMN) + (size_t)(m - S) * DM, lane);
    }
    if (blk == 0 && wave == 0) {
        const float s1 = wave_sum(a.in[5][lane] * a.in[6][lane]), s2 = wave_sum(a.in[7][lane] * a.in[8][lane]);
        if (lane == 0) ((float*)(ws + WS_CTL))[0] = expf(s1) - expf(s2) + 0.2f;
    }
}

__device__ __forceinline__ void idx_scores_naive(const bf16_t* __restrict__ PROJ, float* SC, LAS unsigned char* lds, int blk, int nblk) {
    const int tid = threadIdx.x, lane = tid & 63, wave = tid >> 6;
    LAS float* qs = (LAS float*)lds + wave * 1088;
    constexpr int NITEM = 128 * 129 / 2;
    for (int it = blk; it < NITEM; it += nblk) {
        int kb = 0, rem = it; while (rem >= 128 - kb) { rem -= 128 - kb; ++kb; }
        const int qc = kb + rem, s = 64 * kb + lane;
        float kreg[64];
        { const u32x4* kp = (const u32x4*)(PROJ + (size_t)s * NPAD + C_KI);
#pragma unroll
          for (int i = 0; i < 8; ++i) { const u32x4 w = kp[i]; kreg[8 * i + 0] = bflo(w.x); kreg[8 * i + 1] = bfhi(w.x); kreg[8 * i + 2] = bflo(w.y); kreg[8 * i + 3] = bfhi(w.y);
              kreg[8 * i + 4] = bflo(w.z); kreg[8 * i + 5] = bfhi(w.z); kreg[8 * i + 6] = bflo(w.w); kreg[8 * i + 7] = bfhi(w.w); } }
        for (int qq = 0; qq < 8; ++qq) {
            const int q = 64 * qc + wave * 8 + qq;
            { const u32x4* qp = (const u32x4*)(PROJ + (size_t)q * NPAD + C_QI) + 2 * lane;
              const u32x4 w0 = qp[0], w1 = qp[1];
              LAS f32x4* dst = (LAS f32x4*)(qs + 16 * lane);
              dst[0] = (f32x4){bflo(w0.x), bfhi(w0.x), bflo(w0.y), bfhi(w0.y)}; dst[1] = (f32x4){bflo(w0.z), bfhi(w0.z), bflo(w0.w), bfhi(w0.w)};
              dst[2] = (f32x4){bflo(w1.x), bfhi(w1.x), bflo(w1.y), bfhi(w1.y)}; dst[3] = (f32x4){bflo(w1.z), bfhi(w1.z), bflo(w1.w), bfhi(w1.w)};
              if (lane < 16) qs[1024 + lane] = bf2f(PROJ[(size_t)q * NPAD + C_WI + lane]) * 0.25f; }
            asm volatile("s_waitcnt lgkmcnt(0)" ::: "memory"); __builtin_amdgcn_wave_barrier();
            float score = 0.f;
            for (int j = 0; j < 16; ++j) {
                float acc = 0.f; const LAS f32x4* qj = (const LAS f32x4*)(qs + 64 * j);
#pragma unroll
                for (int d = 0; d < 16; ++d) { const f32x4 qv = qj[d]; acc += qv.x * kreg[4 * d] + qv.y * kreg[4 * d + 1] + qv.z * kreg[4 * d + 2] + qv.w * kreg[4 * d + 3]; }
                score += fmaxf(acc * 0.125f, 0.f) * qs[1024 + j];
            }
            if (s <= q) SC[sc_off(q) + s] = score;
            asm volatile("s_waitcnt lgkmcnt(0)" ::: "memory"); __builtin_amdgcn_wave_barrier();
        }
    }
}
__device__ __forceinline__ unsigned ordkey(float f) { const unsigned u = __float_as_uint(f); return (u & 0x80000000u) ? ~u : (u | 0x80000000u); }
__device__ __forceinline__ void topk_select(const float* SC, int* SEL, LAS unsigned char* lds, int blk, int nblk) {
    const int tid = threadIdx.x, lane = tid & 63, wave = tid >> 6;
    LAS unsigned* hist = (LAS unsigned*)lds + wave * 256;
    for (int r = blk * 8 + wave; r < S; r += nblk * 8) {
        const int n = r + 1; int* sel = SEL + (size_t)r * TOPK;
        if (n <= TOPK) { for (int i = lane; i < TOPK; i += 64) sel[i] = (i < n) ? i : -1; continue; }
        const float* row = SC + sc_off(r);
        unsigned prefix = 0u; int remaining = TOPK;
        for (int pass = 0; pass < 4; ++pass) {
            const int shift = 24 - 8 * pass;
#pragma unroll
            for (int i = 0; i < 4; ++i) hist[lane + 64 * i] = 0u;
            asm volatile("s_waitcnt lgkmcnt(0)" ::: "memory"); __builtin_amdgcn_wave_barrier();
            for (int i = lane; i < n; i += 64) { const unsigned u = ordkey(row[i]);
                if (pass == 0 || (u >> (shift + 8)) == prefix) atomicAdd((unsigned*)&hist[(u >> shift) & 255u], 1u); }
            asm volatile("s_waitcnt lgkmcnt(0)" ::: "memory"); __builtin_amdgcn_wave_barrier();
            const unsigned c0 = hist[4 * lane], c1 = hist[4 * lane + 1], c2 = hist[4 * lane + 2], c3 = hist[4 * lane + 3];
            const unsigned mine = c0 + c1 + c2 + c3;
            unsigned suf = mine;
#pragma unroll
            for (int o = 1; o < 64; o <<= 1) { const unsigned t = __shfl_down(suf, o); if (lane + o < 64) suf += t; }
            const unsigned long long bal = __ballot(suf >= (unsigned)remaining);
            const int Ls = 63 - __builtin_clzll(bal);
            const unsigned above = __shfl(suf, Ls) - __shfl(mine, Ls);
            const unsigned b3 = __shfl(c3, Ls), b2 = __shfl(c2, Ls), b1 = __shfl(c1, Ls);
            unsigned rem = (unsigned)remaining - above; int bin;
            if (rem <= b3) { bin = 4 * Ls + 3; } else { rem -= b3; if (rem <= b2) { bin = 4 * Ls + 2; } else { rem -= b2; if (rem <= b1) { bin = 4 * Ls + 1; } else { rem -= b1; bin = 4 * Ls; } } }
            prefix = (prefix << 8) | (unsigned)bin; remaining = (int)rem;
            asm volatile("s_waitcnt lgkmcnt(0)" ::: "memory"); __builtin_amdgcn_wave_barrier();
        }
        int cnt = 0, eqc = 0; const unsigned long long lt = (lane == 0) ? 0ull : (~0ull >> (64 - lane));
        for (int base = 0; base < n; base += 64) {
            const int i = base + lane; const unsigned u = (i < n) ? ordkey(row[i]) : 0u;
            const bool gt = (i < n) && (u > prefix), eq = (i < n) && (u == prefix);
            const unsigned long long bg = __ballot(gt), be = __ballot(eq);
            if (gt) sel[cnt + __builtin_popcountll(bg & lt)] = i;
            if (eq) { const int rk = eqc + __builtin_popcountll(be & lt); if (rk < remaining) sel[TOPK - remaining + rk] = i; }
            cnt += __builtin_popcountll(bg); eqc += __builtin_popcountll(be);
        }
    }
}
template <int DQ, int DV, bool GATHER>
__device__ __forceinline__ void naive_attn(const bf16_t* __restrict__ qp, const bf16_t* __restrict__ kb, const bf16_t* __restrict__ vb, size_t kvpitch,
                                           int nkeys, int nmax, const int* __restrict__ sel, int r, float scale, float slope, float (&o)[DV / 8]) {
    constexpr int QN = DQ / 8, VN = DV / 8;
    float q[QN];
#pragma unroll
    for (int i = 0; i < QN / 2; ++i) { const unsigned w = ((const unsigned*)qp)[i]; q[2 * i] = bflo(w) * scale; q[2 * i + 1] = bfhi(w) * scale; }
#pragma unroll
    for (int i = 0; i < VN; ++i) o[i] = 0.f;
    float m = -1e30f, l = 0.f;
    for (int i = 0; i < nmax; ++i) {
        bool valid = i < nkeys; int key = i;
        if (GATHER) { key = sel[valid ? i : 0]; valid = valid && key >= 0; }
        if (!valid) key = 0;
        const unsigned* kp = (const unsigned*)(kb + (size_t)key * kvpitch);
        float d = 0.f;
#pragma unroll
        for (int j = 0; j < QN / 2; ++j) { const unsigned w = kp[j]; d += q[2 * j] * bflo(w) + q[2 * j + 1] * bfhi(w); }
        d += __shfl_xor(d, 1); d += __shfl_xor(d, 2); d += __shfl_xor(d, 4);
        const float logit = d - slope * (float)(r - key);
        if (valid) {
            if (logit > m) { const float c = __expf(m - logit); l *= c;
#pragma unroll
                for (int j = 0; j < VN; ++j) o[j] *= c;
                m = logit; }
            const float p = __expf(logit - m); l += p;
            const unsigned* vp = (const unsigned*)(vb + (size_t)key * kvpitch);
#pragma unroll
            for (int j = 0; j < VN / 2; ++j) { const unsigned w = vp[j]; o[2 * j] += p * bflo(w); o[2 * j + 1] += p * bfhi(w); }
        }
    }
    const float il = 1.0f / l;
#pragma unroll
    for (int j = 0; j < VN; ++j) o[j] *= il;
}
__device__ __forceinline__ void attn_b_naive(const Args& a, int blk, int nblk) {
    const int tid = threadIdx.x, lane = tid & 63, wave = tid >> 6, sub = lane & 7;
    const bf16_t* PROJ = (const bf16_t*)(a.ws + WS_PROJ); bf16_t* UB = (bf16_t*)(a.ws + WS_U) + (size_t)1 * S * 1024;
    const float lam = ((const float*)(a.ws + WS_CTL))[0];
    for (int wi = blk * 8 + wave; wi < 1024 * 8; wi += nblk * 8) {
        const int h = wi & 7, rg = wi >> 3, r = rg * 8 + (lane >> 3), nmax = rg * 8 + 8;
        const float slope = exp2f(-(float)(h + 1));
        float o0[16], o1[16];
        const bf16_t* rowp = PROJ + (size_t)r * NPAD;
        naive_attn<64, 128, false>(rowp + C_QB + h * 128 + sub * 8, PROJ + C_KB + h * 128 + sub * 8, PROJ + C_VB + h * 128 + sub * 16, NPAD, r + 1, nmax, nullptr, r, 0.125f, slope, o0);
        naive_attn<64, 128, false>(rowp + C_QB + h * 128 + 64 + sub * 8, PROJ + C_KB + h * 128 + 64 + sub * 8, PROJ + C_VB + h * 128 + sub * 16, NPAD, r + 1, nmax, nullptr, r, 0.125f, slope, o1);
        float ss = 0.f;
#pragma unroll
        for (int j = 0; j < 16; ++j) { o0[j] -= lam * o1[j]; ss += o0[j] * o0[j]; }
        ss += __shfl_xor(ss, 1); ss += __shfl_xor(ss, 2); ss += __shfl_xor(ss, 4);
        const float rs = 1.0f / sqrtf(ss * (1.f / 128.f) + RMS_EPS) * 0.8f;
        const float* g = a.in[9] + sub * 16; const bf16_t* zp = rowp + C_ZB + h * 128 + sub * 16;
        unsigned w[8];
#pragma unroll
        for (int j = 0; j < 8; ++j) w[j] = pk2(o0[2 * j] * rs * g[2 * j] * bf2f(zp[2 * j]), o0[2 * j + 1] * rs * g[2 * j + 1] * bf2f(zp[2 * j + 1]));
        u32x4* dst = (u32x4*)(UB + (size_t)r * 1024 + h * 128 + sub * 16);
        dst[0] = (u32x4){w[0], w[1], w[2], w[3]}; dst[1] = (u32x4){w[4], w[5], w[6], w[7]};
    }
}
__device__ __forceinline__ void attn_m_naive(const Args& a, int blk, int nblk) {
    const int tid = threadIdx.x, lane = tid & 63, wave = tid >> 6, sub = lane & 7;
    const bf16_t* PROJ = (const bf16_t*)(a.ws + WS_PROJ); const bf16_t* MKV = (const bf16_t*)(a.ws + WS_MKV); bf16_t* UM = (bf16_t*)(a.ws + WS_U) + (size_t)2 * S * 1024;
    for (int wi = blk * 8 + wave; wi < 1024 * 4; wi += nblk * 8) {
        const int h = wi & 3, rg = wi >> 2, r = rg * 8 + (lane >> 3);
        float o[32];
        const bf16_t* rowp = PROJ + (size_t)r * NPAD;
        naive_attn<256, 256, false>(rowp + C_QM + h * 256 + sub * 32, MKV + h * 256 + sub * 32, MKV + 1024 + h * 256 + sub * 32, 2048, NMEM, NMEM, nullptr, 0, 0.0625f, 0.f, o);
        const bf16_t* zp = rowp + C_ZM + h * 256 + sub * 32;
        u32x4* dst = (u32x4*)(UM + (size_t)r * 1024 + h * 256 + sub * 32);
#pragma unroll
        for (int j = 0; j < 4; ++j) { u32x4 w;
            w.x = pk2(o[8 * j + 0] * bf2f(zp[8 * j + 0]), o[8 * j + 1] * bf2f(zp[8 * j + 1])); w.y = pk2(o[8 * j + 2] * bf2f(zp[8 * j + 2]), o[8 * j + 3] * bf2f(zp[8 * j + 3]));
            w.z = pk2(o[8 * j + 4] * bf2f(zp[8 * j + 4]), o[8 * j + 5] * bf2f(zp[8 * j + 5])); w.w = pk2(o[8 * j + 6] * bf2f(zp[8 * j + 6]), o[8 * j + 7] * bf2f(zp[8 * j + 7]));
            dst[j] = w; }
    }
}
__device__ __forceinline__ void attn_a_naive(const Args& a, int blk, int nblk) {
    const int tid = threadIdx.x, lane = tid & 63, wave = tid >> 6, sub = lane & 7;
    const bf16_t* PROJ = (const bf16_t*)(a.ws + WS_PROJ); const int* SEL = (const int*)(a.ws + WS_SEL); bf16_t* UA = (bf16_t*)(a.ws + WS_U);
    for (int wi = blk * 8 + wave; wi < 1024 * 8; wi += nblk * 8) {
        const int h = wi & 7, rg = wi >> 3, r = rg * 8 + (lane >> 3);
        const float slope = exp2f(-(float)(h + 1));
        float o[16];
        const bf16_t* rowp = PROJ + (size_t)r * NPAD;
        naive_attn<128, 128, true>(rowp + C_QA + h * 128 + sub * 16, PROJ + C_KA + h * 128 + sub * 16, PROJ + C_VA + h * 128 + sub * 16, NPAD, TOPK, TOPK, SEL + (size_t)r * TOPK, r, 0.08838834764831845f, slope, o);
        const bf16_t* zp = rowp + C_ZA + h * 128 + sub * 16;
        unsigned w[8];
#pragma unroll
        for (int j = 0; j < 8; ++j) w[j] = pk2(o[2 * j] * bf2f(zp[2 * j]), o[2 * j + 1] * bf2f(zp[2 * j + 1]));
        u32x4* dst = (u32x4*)(UA + (size_t)r * 1024 + h * 128 + sub * 16);
        dst[0] = (u32x4){w[0], w[1], w[2], w[3]}; dst[1] = (u32x4){w[4], w[5], w[6], w[7]};
    }
}
__device__ __forceinline__ void final_norm(const Args& a, int blk, int nblk) {
    const int tid = threadIdx.x, lane = tid & 63, wave = tid >> 6;
    const float* part = (const float*)(a.ws + WS_PART); const f32x4* g = (const f32x4*)a.in[16] + lane;
    for (int r = blk * 8 + wave; r < S; r += nblk * 8) {
        float s = (lane < 32) ? part[(size_t)lane * S + r] : 0.f;
        const float rs = 1.0f / sqrtf(wave_sum(s) * (1.f / DM) + RMS_EPS);
        f32x4* y = (f32x4*)(a.out + (size_t)r * DM) + lane;
#pragma unroll
        for (int j = 0; j < 8; ++j) { f32x4 v = y[64 * j]; const f32x4 gg = g[64 * j]; v = v * rs * gg; y[64 * j] = v; }
    }
}


namespace att {
typedef short bf16x8 __attribute__((ext_vector_type(8)));
typedef short s16x4 __attribute__((ext_vector_type(4)));
typedef float f32x16 __attribute__((ext_vector_type(16)));
typedef float f32x2_t __attribute__((ext_vector_type(2)));
typedef __bf16 bf16x2_t __attribute__((ext_vector_type(2)));
constexpr int SHM_V = 16384, SHM_K = 16384;
constexpr float LOG2E = 1.4426950408889634f;
constexpr float THR2 = 8.f * LOG2E;
#define KSWZ(row, colB) ((row) * 256 + ((colB) ^ (((row) & 7) << 4)))
#define SBAR() __builtin_amdgcn_sched_barrier(0)
__device__ __forceinline__ int crow(int r, int hi) { return (r & 3) + 8 * (r >> 2) + 4 * hi; }
__device__ __forceinline__ unsigned cvtpk(float lo, float hi) { f32x2_t v = {lo, hi}; bf16x2_t b = __builtin_convertvector(v, bf16x2_t); return __builtin_bit_cast(unsigned, b); }
__device__ __forceinline__ int v_st(int k, int c) { const int kk = (k & ~0xC) | ((k & 4) << 1) | ((k & 8) >> 1); return ((kk >> 3) * 4 + (c >> 5)) * 512 + ((kk & 7) * 32 + (c & 31)) * 2; }
__device__ __forceinline__ int v_rd_base(int lane) { return ((lane & 3) << 3) | (((lane >> 2) & 3) << 6) | (((lane >> 4) & 1) << 5) | (((lane >> 5) & 1) << 8); }
constexpr int v_rd_off(int d0, int ks, int half) { return d0 * 512 + ks * 4096 + half * 2048; }
typedef short v4i16_t __attribute__((ext_vector_type(4)));
__device__ __forceinline__ s16x4 tr_read(LAS const unsigned char* p) { return __builtin_bit_cast(s16x4, __builtin_amdgcn_ds_read_tr16_b64_v4i16((LAS v4i16_t*)p)); }

template <int NQ> __device__ __forceinline__ void qkt(f32x16& p0, f32x16& p1, LAS const unsigned char* Ks, const bf16x8* qr, int cbyte0, int r32, int hi) {
  p0 = f32x16{}; p1 = f32x16{};
#pragma unroll
  for (int d0 = 0; d0 < NQ; ++d0) { const int cb = cbyte0 + (d0 * 16 + hi * 8) * 2;
    const bf16x8 b0 = *(LAS const bf16x8*)(Ks + KSWZ(r32, cb));
    const bf16x8 b1 = *(LAS const bf16x8*)(Ks + KSWZ(32 + r32, cb));
    p0 = __builtin_amdgcn_mfma_f32_32x32x16_bf16(b0, qr[d0], p0, 0, 0, 0);
    p1 = __builtin_amdgcn_mfma_f32_32x32x16_bf16(b1, qr[d0], p1, 0, 0, 0); }
}
template <int D0> __device__ __forceinline__ void pv_one(f32x16& od, LAS const unsigned char* vb, bf16x8 pa0, bf16x8 pa1, bf16x8 pa2, bf16x8 pa3) {
  const s16x4 l0 = tr_read(vb + v_rd_off(D0, 0, 0)), h0 = tr_read(vb + v_rd_off(D0, 0, 1)), l1 = tr_read(vb + v_rd_off(D0, 1, 0)), h1 = tr_read(vb + v_rd_off(D0, 1, 1));
  const s16x4 l2 = tr_read(vb + v_rd_off(D0, 2, 0)), h2 = tr_read(vb + v_rd_off(D0, 2, 1)), l3 = tr_read(vb + v_rd_off(D0, 3, 0)), h3 = tr_read(vb + v_rd_off(D0, 3, 1));
#define PK(L, H) (bf16x8){L[0], L[1], L[2], L[3], H[0], H[1], H[2], H[3]}
  od = __builtin_amdgcn_mfma_f32_32x32x16_bf16(pa0, PK(l0, h0), od, 0, 0, 0);
  od = __builtin_amdgcn_mfma_f32_32x32x16_bf16(pa1, PK(l1, h1), od, 0, 0, 0);
  od = __builtin_amdgcn_mfma_f32_32x32x16_bf16(pa2, PK(l2, h2), od, 0, 0, 0);
  od = __builtin_amdgcn_mfma_f32_32x32x16_bf16(pa3, PK(l3, h3), od, 0, 0, 0);
#undef PK
}
__device__ __forceinline__ void pv_d0(f32x16* o, LAS const unsigned char* vb, bf16x8 pa0, bf16x8 pa1, bf16x8 pa2, bf16x8 pa3) {
  pv_one<0>(o[0], vb, pa0, pa1, pa2, pa3); pv_one<1>(o[1], vb, pa0, pa1, pa2, pa3); pv_one<2>(o[2], vb, pa0, pa1, pa2, pa3); pv_one<3>(o[3], vb, pa0, pa1, pa2, pa3);
}
template <bool CAUSAL> __device__ __forceinline__ void partialSM(f32x16& p0, f32x16& p1, float& m_reg, float& alpha, const float (&cb)[16], float C, float slope2, int delta) {
  const float tb0 = slope2 * (float)delta, tb1 = slope2 * (float)(delta + 32);
#pragma unroll
  for (int r = 0; r < 16; ++r) { p0[r] = fmaf(p0[r], C, cb[r]); p1[r] = fmaf(p1[r], C, cb[r]); }
  if (CAUSAL && delta + 63 > 0) {
    const float t0 = -tb0, t1 = -tb1;
#pragma unroll
    for (int r = 0; r < 16; ++r) { if (cb[r] > t0) p0[r] = -INFINITY; if (cb[r] > t1) p1[r] = -INFINITY; }
  }
  float pm0 = p0[0], pm1 = p1[0];
#pragma unroll
  for (int r = 1; r < 16; ++r) { pm0 = fmaxf(pm0, p0[r]); pm1 = fmaxf(pm1, p1[r]); }
  float pmax = fmaxf(pm0 + tb0, pm1 + tb1);
  { auto rr = __builtin_amdgcn_permlane32_swap(__float_as_uint(pmax), __float_as_uint(pmax), false, false);
    pmax = fmaxf(__uint_as_float(rr[0]), __uint_as_float(rr[1])); }
  float mn;
  if (__builtin_expect(__all(pmax - m_reg <= THR2), 1)) { mn = m_reg; alpha = 1.f; }
  else { mn = fmaxf(m_reg, pmax); alpha = __builtin_amdgcn_exp2f(m_reg - mn); m_reg = mn; }
  const float a0 = tb0 - mn, a1 = tb1 - mn;
#pragma unroll
  for (int r = 0; r < 16; ++r) { p0[r] += a0; p1[r] += a1; }
#pragma unroll
  for (int r = 0; r < 16; ++r) p0[r] = __builtin_amdgcn_exp2f(p0[r]);
}
__device__ __forceinline__ void finishSM(f32x16& p0, f32x16& p1, float alpha, float& l_reg, bf16x8& pa0, bf16x8& pa1, bf16x8& pa2, bf16x8& pa3) {
#pragma unroll
  for (int r = 0; r < 16; ++r) p1[r] = __builtin_amdgcn_exp2f(p1[r]);
  float ps = 0;
#pragma unroll
  for (int r = 0; r < 16; ++r) ps += p0[r];
#pragma unroll
  for (int r = 0; r < 16; ++r) ps += p1[r];
  { auto rr = __builtin_amdgcn_permlane32_swap(__float_as_uint(ps), __float_as_uint(ps), false, false);
    ps = __uint_as_float(rr[0]) + __uint_as_float(rr[1]); }
  l_reg = l_reg * alpha + ps;
#define PK4(P, BASE, OUT) do { unsigned a0 = cvtpk(P[BASE + 0], P[BASE + 1]), a1 = cvtpk(P[BASE + 2], P[BASE + 3]);   \
    unsigned b0 = cvtpk(P[BASE + 4], P[BASE + 5]), b1 = cvtpk(P[BASE + 6], P[BASE + 7]);                              \
    auto r0 = __builtin_amdgcn_permlane32_swap(a0, b0, false, false); auto r1 = __builtin_amdgcn_permlane32_swap(a1, b1, false, false); \
    u32x4 w = {r0[0], r1[0], r0[1], r1[1]}; OUT = __builtin_bit_cast(bf16x8, w); } while (0)
  PK4(p0, 0, pa0); PK4(p0, 8, pa1); PK4(p1, 0, pa2); PK4(p1, 8, pa3);
#undef PK4
}

__device__ __forceinline__ void attn_b_unit(const bf16_t* __restrict__ PROJ, bf16_t* UB, const float* __restrict__ gsub, float lam, int h, int qb, LAS unsigned char* lds) {
  const int tid = threadIdx.x, wid = tid >> 6, lane = tid & 63, r32 = lane & 31, hi = lane >> 5, comp = wid >> 2, wq = wid & 3;
  const int R0 = qb * 128, qrow0 = R0 + wq * 32, NT = 2 * qb + 2;
  LAS unsigned char* V_lds = lds; LAS unsigned char* K_lds = lds + 2 * SHM_V;
  LAS float* ws = (LAS float*)(lds + 2 * SHM_V + 2 * SHM_K) + wid * 64; LAS float* li_l = ws; LAS float* al_l = ws + 32;
  LAS float* xch = (LAS float*)(lds + 2 * SHM_V + 2 * SHM_K + 2048);
  const float slope2 = __builtin_amdgcn_exp2f(-(float)(h + 1)) * LOG2E, C = 0.125f * LOG2E;
  float cb[16];
#pragma unroll
  for (int r = 0; r < 16; ++r) cb[r] = slope2 * (float)(crow(r, hi) - r32);
  float m_reg = -1e30f, l_reg = 0; f32x16 o[4] = {}; bf16x8 qr[4];
  { const bf16_t* Qw = PROJ + (size_t)(qrow0 + r32) * NPAD + C_QB + h * 128 + comp * 64 + hi * 8;
#pragma unroll
    for (int d0 = 0; d0 < 4; ++d0) qr[d0] = *(const bf16x8*)(Qw + d0 * 16); }
  const bf16_t* Kh = PROJ + C_KB + h * 128; const bf16_t* Vh = PROJ + C_VB + h * 128;
  const int sr = tid >> 4, sc = (tid & 15) * 8, vst0 = v_st(sr, sc), vst1 = v_st(32 + sr, sc), cq = comp * 128;
  LAS const unsigned char* vb0 = V_lds + v_rd_base(lane);
  struct { bf16x8 vs0, vs1, ks0, ks1; } sr_;
#define KEY0(t) (64 * (NT - 1 - (t)))
#define SLOAD(k0) do { sr_.vs0 = *(const bf16x8*)(Vh + (size_t)((k0) + sr) * NPAD + sc); sr_.vs1 = *(const bf16x8*)(Vh + (size_t)((k0) + 32 + sr) * NPAD + sc); \
    sr_.ks0 = *(const bf16x8*)(Kh + (size_t)((k0) + sr) * NPAD + sc); sr_.ks1 = *(const bf16x8*)(Kh + (size_t)((k0) + 32 + sr) * NPAD + sc); } while (0)
#define SWRITE(b) do { *(LAS bf16x8*)(V_lds + (b) * SHM_V + vst0) = sr_.vs0; *(LAS bf16x8*)(V_lds + (b) * SHM_V + vst1) = sr_.vs1; const int kc = sc * 2; \
    *(LAS bf16x8*)(K_lds + (b) * SHM_K + KSWZ(sr, kc)) = sr_.ks0; *(LAS bf16x8*)(K_lds + (b) * SHM_K + KSWZ(32 + sr, kc)) = sr_.ks1; } while (0)
#define RESC(a) do { if (__any((a) < 1.f)) { if (hi == 0) al_l[r32] = (a); asm volatile("s_waitcnt lgkmcnt(0)" ::: "memory"); \
    _Pragma("unroll") for (int d = 0; d < 4; ++d) _Pragma("unroll") for (int r = 0; r < 16; ++r) o[d][r] *= al_l[crow(r, hi)]; } } while (0)
  f32x16 pA0, pA1, pB0, pB1; float alA, alB; bf16x8 pa0, pa1, pa2, pa3;
  SLOAD(KEY0(0)); SWRITE(0); __syncthreads();
  qkt<4>(pA0, pA1, K_lds, qr, cq, r32, hi); partialSM<true>(pA0, pA1, m_reg, alA, cb, C, slope2, KEY0(0) - qrow0);
  SLOAD(KEY0(1)); SWRITE(1); __syncthreads();
  for (int j = 1; j + 1 < NT; j += 2) {
    SBAR(); qkt<4>(pB0, pB1, K_lds + SHM_K, qr, cq, r32, hi);
    finishSM(pA0, pA1, alA, l_reg, pa0, pa1, pa2, pa3); SBAR();
    SLOAD(KEY0(j + 1)); SBAR();
    pv_d0(o, vb0, pa0, pa1, pa2, pa3); partialSM<true>(pB0, pB1, m_reg, alB, cb, C, slope2, KEY0(j) - qrow0);
    __syncthreads(); SWRITE(0);
    RESC(alB); __syncthreads();
    SBAR(); qkt<4>(pA0, pA1, K_lds, qr, cq, r32, hi);
    finishSM(pB0, pB1, alB, l_reg, pa0, pa1, pa2, pa3); SBAR();
    SLOAD(KEY0(j + 2)); SBAR();
    pv_d0(o, vb0 + SHM_V, pa0, pa1, pa2, pa3); partialSM<true>(pA0, pA1, m_reg, alA, cb, C, slope2, KEY0(j + 1) - qrow0);
    __syncthreads(); SWRITE(1);
    RESC(alA); __syncthreads();
  }
  SBAR(); qkt<4>(pB0, pB1, K_lds + SHM_K, qr, cq, r32, hi);
  finishSM(pA0, pA1, alA, l_reg, pa0, pa1, pa2, pa3); SBAR();
  pv_d0(o, vb0, pa0, pa1, pa2, pa3); partialSM<true>(pB0, pB1, m_reg, alB, cb, C, slope2, KEY0(NT - 1) - qrow0);
  __syncthreads(); RESC(alB);
  finishSM(pB0, pB1, alB, l_reg, pa0, pa1, pa2, pa3); SBAR();
  pv_d0(o, vb0 + SHM_V, pa0, pa1, pa2, pa3);
#undef KEY0
#undef SLOAD
#undef SWRITE
#undef RESC
  if (hi == 0) li_l[r32] = l_reg; asm volatile("s_waitcnt lgkmcnt(0)" ::: "memory");
  float rli[16];
#pragma unroll
  for (int r = 0; r < 16; ++r) rli[r] = __builtin_amdgcn_rcpf(li_l[crow(r, hi)]);
  if (comp == 1) {
#pragma unroll
    for (int d0 = 0; d0 < 4; ++d0)
#pragma unroll
      for (int r = 0; r < 16; ++r) xch[(wq * 64 + d0 * 16 + r) * 64 + lane] = o[d0][r] * rli[r] * lam;
  }
  __syncthreads();
  if (comp == 0) {
    float ss[16];
#pragma unroll
    for (int r = 0; r < 16; ++r) ss[r] = 0.f;
#pragma unroll
    for (int d0 = 0; d0 < 4; ++d0)
#pragma unroll
      for (int r = 0; r < 16; ++r) { const float d = o[d0][r] * rli[r] - xch[(wq * 64 + d0 * 16 + r) * 64 + lane]; o[d0][r] = d; ss[r] += d * d; }
#pragma unroll
    for (int r = 0; r < 16; ++r) { float s = ss[r]; s += __shfl_xor(s, 1); s += __shfl_xor(s, 2); s += __shfl_xor(s, 4); s += __shfl_xor(s, 8); s += __shfl_xor(s, 16);
      ss[r] = 0.8f / sqrtf(s * (1.f / 128.f) + RMS_EPS); }
#pragma unroll
    for (int d0 = 0; d0 < 4; ++d0) { const int col = d0 * 32 + r32; const float g = gsub[col];
#pragma unroll
      for (int r = 0; r < 16; ++r) { const size_t row = (size_t)(qrow0 + crow(r, hi));
        const float z = bf2f(PROJ[row * NPAD + C_ZB + h * 128 + col]);
        UB[row * 1024 + h * 128 + col] = (bf16_t)f2bf(o[d0][r] * ss[r] * g * z); } }
  }
  __syncthreads();
}
__device__ __forceinline__ void attn_b_phase(const Args& a, LAS unsigned char* lds, int blk, int nblk) {
  const bf16_t* PROJ = (const bf16_t*)(a.ws + WS_PROJ); bf16_t* UB = (bf16_t*)(a.ws + WS_U) + (size_t)1 * S * 1024;
  const float lam = ((const float*)(a.ws + WS_CTL))[0];
  for (int u = blk; u < 256; u += nblk) {
    const int h = u & 7, p = u >> 3;
    attn_b_unit(PROJ, UB, a.in[9], lam, h, 63 - p, lds);
    attn_b_unit(PROJ, UB, a.in[9], lam, h, p, lds);
  }
}
#undef KSWZ
#undef SBAR
}

#ifdef DBG_STAGE
__device__ __forceinline__ void dbg_dump(const Args& a, int blk, int nblk) {
    const bf16_t* PROJ = (const bf16_t*)(a.ws + WS_PROJ);
    for (size_t idx = (size_t)blk * 512 + threadIdx.x; idx < (size_t)S * DM; idx += (size_t)nblk * 512) {
        const int r = (int)(idx / DM), c = (int)(idx % DM); float v = 0.f;
#if DBG_STAGE == 1 && defined(DBG_WEIGHTS)
        for (int z = 0; z < 3; ++z) v += bf2f(((const bf16_t*)(a.ws + WS_WTBR))[((size_t)z * 2048 + (r & 2047)) * 1024 + (c & 1023)]);
        v += bf2f(((const bf16_t*)(a.ws + WS_WTOUT))[(size_t)(r & 2047) * 2048 + c]);
#elif DBG_STAGE == 1 && defined(DBG_GATES)
        for (int j = 0; j < 3; ++j) v += bf2f(PROJ[(size_t)r * NPAD + C_GL + c + 2048 * j]);
#elif DBG_STAGE == 1
        for (int j = 0; j < 8; ++j) v += bf2f(PROJ[(size_t)r * NPAD + c + 2048 * j]);
        if (c < 1280) v += bf2f(PROJ[(size_t)r * NPAD + 16384 + c]);
        if (r < 256) v += bf2f(((const bf16_t*)(a.ws + WS_MKV))[(size_t)r * 2048 + c]);
        for (int z = 0; z < 3; ++z) v += bf2f(((const bf16_t*)(a.ws + WS_WTBR))[((size_t)z * 2048 + (r & 2047)) * 1024 + (c & 1023)]);
        v += bf2f(((const bf16_t*)(a.ws + WS_WTOUT))[(size_t)(r & 2047) * 2048 + c]);
#elif DBG_STAGE == 2
        if (c < 1024) v = bf2f(((const bf16_t*)(a.ws + WS_U))[(size_t)(S + r) * 1024 + c]) + bf2f(((const bf16_t*)(a.ws + WS_U))[(size_t)(2 * S + r) * 1024 + c]);
        else { const float* row = (const float*)(a.ws + WS_SC) + sc_off(r); for (int j = c - 1024; j <= r; j += 1024) v += row[j]; }
#elif DBG_STAGE == 3
        if (c < 256) v = (float)((const int*)(a.ws + WS_SEL))[(size_t)r * 256 + c];
#elif DBG_STAGE == 4
        if (c < 1024) v = bf2f(((const bf16_t*)(a.ws + WS_U))[(size_t)r * 1024 + c]);
#elif DBG_STAGE == 5
        v = bf2f(((const bf16_t*)(a.ws + WS_MERGED))[(size_t)r * DM + c]);
#endif
        a.out[idx] = v;
    }
}
#endif

constexpr int LDS_BYTES = 147456;
constexpr int NPHASE = 8;
__global__ void __launch_bounds__(512, 2) fwd(Args a) {
    extern __shared__ __attribute__((aligned(16))) unsigned char lds_raw[];
    LAS unsigned char* lds = (LAS unsigned char*)lds_raw;
    cg::grid_group grid = cg::this_grid();
    const int blk = blockIdx.x, nblk = gridDim.x;
    unsigned char* ws = a.ws;
    const bf16_t* PROJ = (const bf16_t*)(ws + WS_PROJ);
#define IN(k) (a.ph_lo <= (k) && (k) < a.ph_hi)
#define SEAM(k) do { if (IN(k) && IN((k) + 1)) grid.sync(); } while (0)
    if (IN(0)) { p0_prologue(a, lds, blk, nblk); } SEAM(0);
    if (IN(1)) {
        pg8::Gemm g{(const bf16_t*)(ws + WS_H), (const bf16_t*)(ws + WS_WTIN), S, NPAD, DM, (long)WS_MEMN - (long)WS_H, (long)WS_WTMKV - (long)WS_WTIN};
        pg8::ProjOrder so; so.init(S, NPAD, nblk, blk);
        pg8::EpiProj E{(bf16_t*)(ws + WS_PROJ), NPAD, (bf16_t*)(ws + WS_MKV), 2048, a.in[4], C_GL / 256};
        pg8::gemm_phase<pg8::EpiProj, pg8::ProjOrder, true, true>(lds, g, so, E);
    } SEAM(1);
    if (IN(2)) { idx_scores_naive(PROJ, (float*)(ws + WS_SC), lds, blk, nblk); __syncthreads(); att::attn_b_phase(a, lds, blk, nblk); attn_m_naive(a, blk, nblk); } SEAM(2);
    if (IN(3)) { topk_select((const float*)(ws + WS_SC), (int*)(ws + WS_SEL), lds, blk, nblk); } SEAM(3);
    if (IN(4)) { attn_a_naive(a, blk, nblk); } SEAM(4);
    if (IN(5)) {
        pg8::Gemm g{(const bf16_t*)(ws + WS_U), (const bf16_t*)(ws + WS_WTBR), S, DM, 1024, (long)S * 1024 * 2, (long)2048 * 1024 * 2};
        pg8::MergeOrder so; so.init(S, DM, nblk, blk);
        pg8::EpiMerge E{PROJ + C_GL, NPAD, (float*)(ws + WS_T), (bf16_t*)(ws + WS_MERGED), DM};
        pg8::gemm_phase<pg8::EpiMerge, pg8::MergeOrder, true, true>(lds, g, so, E);
    } SEAM(5);
    if (IN(6)) {
        pg8::Gemm g{(const bf16_t*)(ws + WS_MERGED), (const bf16_t*)(ws + WS_WTOUT), S, DM, DM, 0, 0};
        pg8::StaticOrder so; so.init(S, DM, nblk, blk);
        pg8::EpiOut E{a.in[0], a.out, DM, (float*)(ws + WS_PART), S};
        pg8::gemm_phase<pg8::EpiOut, pg8::StaticOrder, false, true>(lds, g, so, E);
    } SEAM(6);
    if (IN(7)) { final_norm(a, blk, nblk); }
#ifdef DBG_STAGE
    if (IN(8)) { dbg_dump(a, blk, nblk); }
#endif
#undef IN
#undef SEAM
}

#ifndef N_LAUNCH_MODE
#define N_LAUNCH_MODE 0
#endif
extern "C" void kernel_launch(void* const* d_in, const int* in_sizes, int n_in, void* d_out, int out_size, void* d_ws, size_t ws_size, hipStream_t stream) {
    static int grid = 0;
    if (grid == 0) {
        if (n_in != 17 || in_sizes[0] != S * DM || in_sizes[3] != DM * DIN || out_size != S * DM || ws_size < WS_END) {
            fprintf(stderr, "kernel_launch: unexpected shapes (n_in %d, in0 %d, in3 %d, out %d, ws %zu < %zu)\n", n_in, n_in > 0 ? in_sizes[0] : -1, n_in > 3 ? in_sizes[3] : -1, out_size, ws_size, (size_t)WS_END); grid = -1; return; }
        int dev = 0, cus = 0, per_cu = 0;
        (void)hipGetDevice(&dev); (void)hipDeviceGetAttribute(&cus, hipDeviceAttributeMultiprocessorCount, dev);
        if (hipFuncSetAttribute((const void*)fwd, hipFuncAttributeMaxDynamicSharedMemorySize, LDS_BYTES) != hipSuccess) { fprintf(stderr, "kernel_launch: hipFuncSetAttribute failed\n"); grid = -1; return; }
        if (hipOccupancyMaxActiveBlocksPerMultiprocessor(&per_cu, (const void*)fwd, 512, LDS_BYTES) != hipSuccess || per_cu < 1) { fprintf(stderr, "kernel_launch: occupancy query gave %d\n", per_cu); per_cu = 1; }
        (void)hipGetLastError();
        grid = cus * 1;
        if (grid > cus * per_cu) grid = cus * per_cu;
        if (grid < 8) grid = -1;
    }
    if (grid < 0) return;
    Args a{};
    for (int i = 0; i < 17; ++i) a.in[i] = (const float*)d_in[i];
    a.out = (float*)d_out; a.ws = (unsigned char*)d_ws;
#if N_LAUNCH_MODE == 1
    a.ph_lo = 0; a.ph_hi = NPHASE;
    void* kargs[] = {&a};
    hipError_t e = hipLaunchCooperativeKernel((const void*)fwd, dim3(grid), dim3(512), kargs, LDS_BYTES, stream);
    if (e != hipSuccess) fprintf(stderr, "cooperative launch failed: %s (grid %d)\n", hipGetErrorString(e), grid);
#else
#ifdef DBG_STAGE
    #ifdef DBG_WEIGHTS
    constexpr int last_ph[6] = {0, 0, 2, 3, 4, 5};
#else
    constexpr int last_ph[6] = {0, 1, 2, 3, 4, 5};
#endif
    for (int p = 0; p <= last_ph[DBG_STAGE]; ++p) { a.ph_lo = p; a.ph_hi = p + 1; hipLaunchKernelGGL(fwd, dim3(grid), dim3(512), LDS_BYTES, stream, a); }
    a.ph_lo = 8; a.ph_hi = 9; hipLaunchKernelGGL(fwd, dim3(grid), dim3(512), LDS_BYTES, stream, a);
#else
    for (int p = 0; p < NPHASE; ++p) {
        a.ph_lo = p; a.ph_hi = p + 1;
        hipLaunchKernelGGL(fwd, dim3(grid), dim3(512), LDS_BYTES, stream, a);
    }
#endif
#endif
}
```

```cpp
#define N_LAUNCH_MODE 1
#include <hip/hip_runtime.h>
#include <hip/hip_cooperative_groups.h>
#include <cstdio>
#include <cstdint>
namespace cg = cooperative_groups;

__device__ __forceinline__ int lane_id_v() { int l; asm volatile("v_mbcnt_lo_u32_b32 %0, -1, 0\n\tv_mbcnt_hi_u32_b32 %0, -1, %0" : "=v"(l)); return l; }
namespace pg8 {
#define PG8_LAS __attribute__((address_space(3)))
typedef unsigned short bf16_t;
typedef short bf16x8 __attribute__((ext_vector_type(8)));
typedef float f32x4 __attribute__((ext_vector_type(4)));
typedef unsigned u32x4 __attribute__((ext_vector_type(4)));
constexpr int BM = 256, BK = 64, HALF = 128, HTB = HALF * BK * 2  , STAGE_BYTES = 8 * HTB, NXCD = 8, WGM = 8;

__host__ __device__ __forceinline__ int lds_byte(int r, int c) { const int st = (r >> 4) * 2 + (c >> 5), rr = r & 15, cc = c & 31, ob = rr * 64 + cc * 2; return st * 1024 + (ob ^ (((ob >> 9) & 1) << 5)); }
__host__ __device__ __forceinline__ void stage_rc(int b, int& R, int& C) { const int st = b / 1024, sb = b % 1024, swz = sb ^ (((sb >> 9) & 1) << 5); R = (st >> 1) * 16 + swz / 64; C = (st & 1) * 32 + (swz % 64) / 2; }
__host__ __device__ __forceinline__ int perm32(int rho) { const int n = rho >> 4, i = rho & 15; return 8 * (i >> 2) + 4 * n + (i & 3); }

struct Unit { int pm, pn, z; };
struct Gemm { const bf16_t* A; const bf16_t* Bt; int M, N, K; long zA, zB; };

struct StaticOrder {
    int nM, nN, nwg, G, c;
    __host__ __device__ void init(int M, int N, int G_, int c_) { nM = M / BM; nN = N / BM; nwg = nM * nN; G = G_; c = c_; }
    __host__ __device__ bool next(int i, Unit& u) const {
        const long L = (long)i * G + c; if (L >= nwg) return false;
        int wgid = (int)L; { const int q = nwg / NXCD, r = nwg % NXCD, xcd = wgid % NXCD, off = wgid / NXCD; wgid = (xcd < r ? xcd * (q + 1) : r * (q + 1) + (xcd - r) * q) + off; }
        const int nig = WGM * nN, gid = wgid / nig, fm = gid * WGM, gsz = (nM - fm) < WGM ? (nM - fm) : WGM;
        u.pm = fm + ((wgid % nig) % gsz); u.pn = (wgid % nig) / gsz; u.z = 0; return true;
    }
    __device__ __forceinline__ void a_ready(const Unit&) const {}
    __device__ __forceinline__ void done(const Unit&) const {}
};

typedef float f32x2_t __attribute__((ext_vector_type(2))); typedef __bf16 bf16x2_t __attribute__((ext_vector_type(2)));
__device__ __forceinline__ unsigned cvt_pk_bf16(float lo, float hi) { f32x2_t v = {lo, hi}; bf16x2_t b = __builtin_convertvector(v, bf16x2_t); return __builtin_bit_cast(unsigned, b); }

__device__ __forceinline__ float bf2f(unsigned short u) { return __uint_as_float((unsigned)u << 16); }
__device__ __forceinline__ float sigmoidf_(float v) { return __builtin_amdgcn_rcpf(1.0f + __builtin_amdgcn_exp2f(-1.4426950408889634f * v)); }
template <int MODE> __device__ __forceinline__ float act_(float v, float b) {
    if (MODE == 1) return v * sigmoidf_(v);
    if (MODE == 2) return sigmoidf_(v + b);
    return v;
}
struct EpiProj {
    static constexpr bool PERM = true, AFTER_DRAIN = false;
    bf16_t* O; int ldc; bf16_t* O1; int ldc1; const float* bgate; int gate_tile0;
    template <int MODE> __device__ __forceinline__ void put(const f32x4 (&acc)[2][2][4][2], bf16_t* base, int ld, int row0, int col0, const float* bias) const {
        f32x4 bv[2][2];
#pragma unroll
        for (int bj = 0; bj < 2; ++bj)
#pragma unroll
            for (int n = 0; n < 2; ++n) bv[bj][n] = (MODE == 2) ? *(const f32x4*)(bias + bj * HALF + 4 * n) : (f32x4){0.f, 0.f, 0.f, 0.f};
#pragma unroll
        for (int ai = 0; ai < 2; ++ai)
#pragma unroll
            for (int m = 0; m < 4; ++m) { bf16_t* rowp = base + (size_t)(row0 + ai * HALF + m * 16) * ld + col0;
#pragma unroll
                for (int bj = 0; bj < 2; ++bj) { f32x4 v0 = acc[ai][bj][m][0], v1 = acc[ai][bj][m][1];
#pragma unroll
                    for (int e = 0; e < 4; ++e) { v0[e] = act_<MODE>(v0[e], bv[bj][0][e]); v1[e] = act_<MODE>(v1[e], bv[bj][1][e]); }
                    u32x4 w; w.x = cvt_pk_bf16(v0[0], v0[1]); w.y = cvt_pk_bf16(v0[2], v0[3]); w.z = cvt_pk_bf16(v1[0], v1[1]); w.w = cvt_pk_bf16(v1[2], v1[3]);
                    *(u32x4*)(rowp + bj * HALF) = w; } }
    }
    __device__ __forceinline__ void operator()(const f32x4 (&acc)[2][2][4][2], const Unit& u, int wr, int wc, int fr, int fq) const {
        const int row0 = u.pm * BM + wr * 64 + fr, col0 = u.pn * BM + wc * 32 + 8 * fq;
        if (u.z == 1) { put<0>(acc, O1, ldc1, row0, col0, nullptr); return; }
        const int t = u.pn;
        const bool is_silu = (t >= 12 && t < 16) || (t >= 32 && t < 36) || (t >= 40 && t < 44);
        if (t >= gate_tile0 && t < 68) put<2>(acc, O, ldc, row0, col0, bgate + (col0 - gate_tile0 * BM));
        else if (is_silu) put<1>(acc, O, ldc, row0, col0, nullptr);
        else put<0>(acc, O, ldc, row0, col0, nullptr);
    }
};
struct EpiMerge {
    static constexpr bool PERM = true, AFTER_DRAIN = false;
    const bf16_t* G; int ldg;
    float* T; bf16_t* O; int ldc;
    __device__ __forceinline__ void operator()(const f32x4 (&acc)[2][2][4][2], const Unit& u, int wr, int wc, int fr, int fq) const {
        const int row0 = u.pm * BM + wr * 64 + fr, col0 = u.pn * BM + wc * 32 + 8 * fq;
#pragma unroll
        for (int ai = 0; ai < 2; ++ai)
#pragma unroll
            for (int m = 0; m < 4; ++m) { const size_t row = (size_t)(row0 + ai * HALF + m * 16);
#pragma unroll
                for (int bj = 0; bj < 2; ++bj) { const int col = col0 + bj * HALF;
                    const u32x4 gw = *(const u32x4*)(G + row * ldg + (size_t)u.z * 2048 + col);
                    f32x4 g0, g1;
                    g0[0] = __uint_as_float(gw.x << 16); g0[1] = __uint_as_float(gw.x & 0xffff0000u); g0[2] = __uint_as_float(gw.y << 16); g0[3] = __uint_as_float(gw.y & 0xffff0000u);
                    g1[0] = __uint_as_float(gw.z << 16); g1[1] = __uint_as_float(gw.z & 0xffff0000u); g1[2] = __uint_as_float(gw.w << 16); g1[3] = __uint_as_float(gw.w & 0xffff0000u);
                    f32x4 v0 = acc[ai][bj][m][0] * g0, v1 = acc[ai][bj][m][1] * g1;
                    float* tp = T + row * ldc + col;
                    if (u.z > 0) { v0 += __builtin_nontemporal_load((const f32x4*)tp); v1 += __builtin_nontemporal_load((const f32x4*)(tp + 4)); }
                    if (u.z < 2) { *(f32x4*)tp = v0; *(f32x4*)(tp + 4) = v1; }
                    else { u32x4 w; w.x = cvt_pk_bf16(v0[0], v0[1]); w.y = cvt_pk_bf16(v0[2], v0[3]); w.z = cvt_pk_bf16(v1[0], v1[1]); w.w = cvt_pk_bf16(v1[2], v1[3]);
                        *(u32x4*)(O + row * ldc + col) = w; } } }
    }
};
struct EpiOut {
    static constexpr bool PERM = false, AFTER_DRAIN = false;
    const float* X; float* Y; int ldc; float* part; int M;
    __device__ __forceinline__ void operator()(const f32x4 (&acc)[2][2][4][2], const Unit& u, int wr, int wc, int fr, int fq) const {
        const int row0 = u.pm * BM + wr * 64 + fr, col0 = u.pn * BM + wc * 32 + 4 * fq;
#pragma unroll
        for (int ai = 0; ai < 2; ++ai)
#pragma unroll
            for (int m = 0; m < 4; ++m) { const size_t row = (size_t)(row0 + ai * HALF + m * 16); float ss = 0.f;
#pragma unroll
                for (int bj = 0; bj < 2; ++bj)
#pragma unroll
                    for (int n = 0; n < 2; ++n) { const size_t off = row * ldc + col0 + bj * HALF + n * 16;
                        const f32x4 y = *(const f32x4*)(X + off) + acc[ai][bj][m][n]; *(f32x4*)(Y + off) = y;
                        ss += (y[0] * y[0] + y[1] * y[1]) + (y[2] * y[2] + y[3] * y[3]); }
                ss += __shfl_xor(ss, 16); ss += __shfl_xor(ss, 32);
                if (fq == 0) part[(size_t)(u.pn * 4 + wc) * M + row] = ss; }
    }
};
struct ProjOrder {
    StaticOrder so; int nmain, extra;
    __device__ void init(int M, int N, int G, int c) { so.init(M, N, G, c); nmain = (so.nwg - c + G - 1) / G; extra = (c >= G - 8) ? c - (G - 8) : -1; }
    __device__ bool next(int i, Unit& u) const {
        if (i < nmain) return so.next(i, u);
        if (i == nmain && extra >= 0) { u.pm = 0; u.pn = extra; u.z = 1; return true; }
        return false;
    }
    __device__ __forceinline__ void a_ready(const Unit&) const {}
    __device__ __forceinline__ void done(const Unit&) const {}
};
struct MergeOrder {
    StaticOrder so;
    __device__ void init(int M, int N, int G, int c) { so.init(M, N, G, c); }
    __device__ bool next(int i, Unit& u) const { if (i >= 3) return false; if (!so.next(0, u)) return false; u.z = i; return true; }
    __device__ __forceinline__ void a_ready(const Unit&) const {}
    __device__ __forceinline__ void done(const Unit&) const {}
};

template <class Epi, class Sched, bool ALIGN_EPI = false, bool SP2 = false>
__device__ __forceinline__ void gemm_phase(PG8_LAS unsigned char* lds, const Gemm g, const Sched& S, const Epi& E, const int wid  ) {
    const int lane = lane_id_v(), tid = wid * 64 + lane, wr = wid >> 2, wc = wid & 3, fr = lane & 15, fq = lane >> 4;
    const int K = g.K, nt = K / BK;
    unsigned voffA[2], voffB[2];
#pragma unroll
    for (int i = 0; i < 2; ++i) { int R, C; stage_rc(tid * 16 + i * 8192, R, C); const int Rb = Epi::PERM ? ((R & ~31) + perm32(R & 31)) : R;
        voffA[i] = (unsigned)(R * K + C) * 2u; voffB[i] = (unsigned)(Rb * K + C) * 2u; }
    const size_t kstep = (size_t)(BK * 2);
    const size_t hstep = (size_t)HALF * K * 2;
    const size_t tstep = 2 * hstep;
    const unsigned ldsw = (unsigned)wid * 1024u;
    const int aoff = lds_byte(wr * 64 + fr, fq * 8), boff = lds_byte(wc * 32 + fr, fq * 8);
#define PG8_SA(b, h) (((b) * 2 + (h)) * HTB)
#define PG8_SB(b, h) ((4 + (b) * 2 + (h)) * HTB)
#define PG8_STAGE(bufoff, gbase, voff) do { _Pragma("unroll") for (int _i = 0; _i < 2; ++_i) \
        __builtin_amdgcn_global_load_lds((const unsigned*)((const char*)(gbase) + (voff)[_i]), (PG8_LAS unsigned*)(lds + (bufoff) + ldsw + _i * 8192), 16, 0, 0); } while (0)
#define PG8_LDA(dst, b, h) do { _Pragma("unroll") for (int m = 0; m < 4; ++m) _Pragma("unroll") for (int k = 0; k < 2; ++k) dst[m][k] = *(const PG8_LAS bf16x8*)(lds + PG8_SA(b, h) + aoff + m * 2048 + k * 1024); } while (0)
#define PG8_LDB(dst, b, h) do { _Pragma("unroll") for (int n = 0; n < 2; ++n) _Pragma("unroll") for (int k = 0; k < 2; ++k) dst[n][k] = *(const PG8_LAS bf16x8*)(lds + PG8_SB(b, h) + boff + n * 2048 + k * 1024); } while (0)
#define PG8_MMA(ai, bj, At, Bt) do { __builtin_amdgcn_s_setprio(1); _Pragma("unroll") for (int m = 0; m < 4; ++m) _Pragma("unroll") for (int n = 0; n < 2; ++n) _Pragma("unroll") for (int k = 0; k < 2; ++k) \
        acc[ai][bj][m][n] = __builtin_amdgcn_mfma_f32_16x16x32_bf16(Bt[n][k], At[m][k], acc[ai][bj][m][n], 0, 0, 0); __builtin_amdgcn_s_setprio(0); } while (0)
#define PG8_WAIT_V(n) asm volatile("s_waitcnt vmcnt(" #n ")" ::: "memory")
#define PG8_WAIT_L(n) asm volatile("s_waitcnt lgkmcnt(" #n ")" ::: "memory")
#define PG8_BAR __builtin_amdgcn_s_barrier()
#define PG8_SCHED __builtin_amdgcn_sched_barrier(0)
    Unit cur, nxt; int ui = 0;
    if (!S.next(0, cur)) return;
    f32x4 acc[2][2][4][2];
#pragma unroll
    for (int a = 0; a < 2; ++a)
#pragma unroll
        for (int b = 0; b < 2; ++b)
#pragma unroll
            for (int m = 0; m < 4; ++m)
#pragma unroll
                for (int n = 0; n < 2; ++n) acc[a][b][m][n] = (f32x4){0.f, 0.f, 0.f, 0.f};
    bf16x8 At[4][2], B0[2][2], B1[2][2];
    const char* cA = (const char*)g.A + (long)cur.z * g.zA + (size_t)cur.pm * tstep; const char* cB = (const char*)g.Bt + (long)cur.z * g.zB + (size_t)cur.pn * tstep;
    S.a_ready(cur);
    if constexpr (SP2) {
        PG8_STAGE(PG8_SB(0, 0), cB, voffB); PG8_STAGE(PG8_SB(0, 1), cB + hstep, voffB); PG8_STAGE(PG8_SA(0, 0), cA, voffA); PG8_STAGE(PG8_SA(0, 1), cA + hstep, voffA);
        if (wr == 1) PG8_BAR;
        PG8_WAIT_V(2); PG8_BAR;
        PG8_STAGE(PG8_SB(1, 0), cB + kstep, voffB); PG8_STAGE(PG8_SA(1, 0), cA + kstep, voffA); PG8_STAGE(PG8_SB(1, 1), cB + hstep + kstep, voffB);
        PG8_WAIT_V(6); PG8_BAR;
    } else {
        PG8_STAGE(PG8_SB(0, 0), cB, voffB); PG8_STAGE(PG8_SA(0, 0), cA, voffA); PG8_STAGE(PG8_SB(0, 1), cB + hstep, voffB); PG8_STAGE(PG8_SA(0, 1), cA + hstep, voffA);
        if (wr == 1) PG8_BAR;
        PG8_WAIT_V(4); PG8_BAR;
        PG8_STAGE(PG8_SB(1, 0), cB + kstep, voffB); PG8_STAGE(PG8_SA(1, 0), cA + kstep, voffA); PG8_STAGE(PG8_SB(1, 1), cB + hstep + kstep, voffB);
        PG8_WAIT_V(6); PG8_BAR;
    }
    for (;;) {
        const bool has_next = S.next(ui + 1, nxt);
        const char* nA = has_next ? (const char*)g.A + (long)nxt.z * g.zA + (size_t)nxt.pm * tstep : cA; const char* nB = has_next ? (const char*)g.Bt + (long)nxt.z * g.zB + (size_t)nxt.pn * tstep : cB;
        for (int t = 0; t < nt; t += 2) {
            const bool last = (t == nt - 2);
            const char* a1 = cA + (size_t)(t + 1) * kstep;
            const char* a2 = last ? nA : cA + (size_t)(t + 2) * kstep; const char* b2 = last ? nB : cB + (size_t)(t + 2) * kstep;
            const char* a3 = a2 + kstep; const char* b3 = b2 + kstep;
            if (last && has_next) S.a_ready(nxt);
            if constexpr (SP2) {
            PG8_LDB(B0, 0, 0); PG8_LDB(B1, 0, 1); PG8_SCHED; PG8_LDA(At, 0, 0); PG8_STAGE(PG8_SA(1, 1), a1 + hstep, voffA);
            PG8_WAIT_V(8); PG8_WAIT_L(0); PG8_BAR; PG8_MMA(0, 0, At, B0); PG8_MMA(0, 1, At, B1); PG8_BAR; PG8_SCHED;
            PG8_LDA(At, 0, 1); PG8_STAGE(PG8_SB(0, 0), b2, voffB); PG8_STAGE(PG8_SB(0, 1), b2 + hstep, voffB); PG8_STAGE(PG8_SA(0, 0), a2, voffA);
            PG8_WAIT_V(8); PG8_WAIT_L(0); PG8_BAR; PG8_MMA(1, 0, At, B0); PG8_MMA(1, 1, At, B1); PG8_BAR; PG8_SCHED;
            PG8_LDB(B0, 1, 0); PG8_LDB(B1, 1, 1); PG8_SCHED; PG8_LDA(At, 1, 0); PG8_STAGE(PG8_SA(0, 1), a2 + hstep, voffA);
            PG8_WAIT_V(8); PG8_WAIT_L(0); PG8_BAR; PG8_MMA(0, 0, At, B0); PG8_MMA(0, 1, At, B1); PG8_BAR; PG8_SCHED;
            PG8_LDA(At, 1, 1); PG8_STAGE(PG8_SB(1, 0), b3, voffB); PG8_STAGE(PG8_SB(1, 1), b3 + hstep, voffB); PG8_STAGE(PG8_SA(1, 0), a3, voffA);
            PG8_WAIT_V(8); PG8_WAIT_L(0); PG8_BAR; PG8_MMA(1, 0, At, B0); PG8_MMA(1, 1, At, B1); PG8_BAR; PG8_SCHED;
            } else {
            PG8_LDB(B0, 0, 0); PG8_SCHED; PG8_LDA(At, 0, 0); PG8_STAGE(PG8_SA(1, 1), a1 + hstep, voffA);
            PG8_WAIT_L(8); PG8_BAR; PG8_WAIT_L(0); PG8_MMA(0, 0, At, B0); PG8_BAR; PG8_SCHED;
            PG8_LDB(B1, 0, 1); PG8_STAGE(PG8_SB(0, 0), b2, voffB);
            PG8_BAR; PG8_WAIT_L(0); PG8_MMA(0, 1, At, B1); PG8_BAR;
            PG8_LDA(At, 0, 1); PG8_STAGE(PG8_SA(0, 0), a2, voffA);
            PG8_BAR; PG8_WAIT_L(0); PG8_MMA(1, 0, At, B0); PG8_BAR; PG8_SCHED;
            PG8_STAGE(PG8_SB(0, 1), b2 + hstep, voffB);
            PG8_WAIT_V(6); PG8_BAR; PG8_MMA(1, 1, At, B1); PG8_BAR;
            PG8_LDB(B0, 1, 0); PG8_SCHED; PG8_LDA(At, 1, 0); PG8_STAGE(PG8_SA(0, 1), a2 + hstep, voffA);
            PG8_WAIT_L(8); PG8_BAR; PG8_WAIT_L(0); PG8_MMA(0, 0, At, B0); PG8_BAR; PG8_SCHED;
            PG8_LDB(B1, 1, 1); PG8_STAGE(PG8_SB(1, 0), b3, voffB);
            PG8_BAR; PG8_WAIT_L(0); PG8_MMA(0, 1, At, B1); PG8_BAR;
            PG8_LDA(At, 1, 1); PG8_STAGE(PG8_SA(1, 0), a3, voffA);
            PG8_BAR; PG8_WAIT_L(0); PG8_MMA(1, 0, At, B0); PG8_BAR; PG8_SCHED;
            PG8_STAGE(PG8_SB(1, 1), b3 + hstep, voffB);
            PG8_WAIT_V(6); PG8_BAR; PG8_MMA(1, 1, At, B1); PG8_BAR;
            }
        }
        if constexpr (ALIGN_EPI) { if (wr == 0) PG8_BAR; }
        if constexpr (!Epi::AFTER_DRAIN) { E(acc, cur, wr, wc, fr, fq); S.done(cur); }
        if (!has_next) break;
#pragma unroll
        for (int a = 0; a < 2; ++a)
#pragma unroll
            for (int b = 0; b < 2; ++b)
#pragma unroll
                for (int m = 0; m < 4; ++m)
#pragma unroll
                    for (int n = 0; n < 2; ++n) acc[a][b][m][n] = (f32x4){0.f, 0.f, 0.f, 0.f};
        cur = nxt; cA = nA; cB = nB; ++ui;
        if constexpr (ALIGN_EPI) { if (wr == 1) PG8_BAR; }
    }
    PG8_WAIT_V(0);
    if constexpr (!ALIGN_EPI) { if (wr == 0) PG8_BAR; }
    PG8_BAR;
    if constexpr (Epi::AFTER_DRAIN) { E.fused(acc, cur, wr, wc, fr, fq, lds, wid, lane); S.done(cur); }
#undef PG8_SA
#undef PG8_SB
#undef PG8_STAGE
#undef PG8_LDA
#undef PG8_LDB
#undef PG8_MMA
#undef PG8_WAIT_V
#undef PG8_WAIT_L
#undef PG8_BAR
#undef PG8_SCHED
}
}

constexpr int S = 8192, DM = 2048, DIN = 17488, NPAD = 17664, NMEM = 256;
constexpr int C_QA = 0, C_KA = 1024, C_VA = 2048, C_ZA = 3072, C_QI = 4096, C_QB = 5120, C_KB = 6144, C_VB = 7168, C_ZB = 8192, C_QM = 9216, C_ZM = 10240, C_GL = 11264, C_KI = 17408, C_WI = 17472;
constexpr int TOPK = 256;
constexpr float RMS_EPS = 1e-6f;
constexpr size_t MiB = 1u << 20;
constexpr size_t WS_CTL = 0;
constexpr size_t WS_WTIN = 1 * MiB;
constexpr size_t WS_U = 1 * MiB;
constexpr size_t WS_WTMKV = 70 * MiB;
constexpr size_t WS_WTBR = 78 * MiB;
constexpr size_t WS_WTOUT = 90 * MiB;
constexpr size_t WS_MEMN = 98 * MiB;
constexpr size_t WS_MKV = 99 * MiB;
constexpr size_t WS_PROJ = 100 * MiB;
constexpr size_t WS_SC = 376 * MiB;
constexpr size_t WS_MERGED = 376 * MiB;
constexpr size_t WS_H = 376 * MiB;
constexpr size_t WS_T = 408 * MiB;
constexpr size_t WS_SEL = 508 * MiB;
constexpr size_t WS_PART = 516 * MiB;
constexpr size_t WS_END = 517 * MiB;

typedef unsigned short bf16_t;
typedef unsigned u32x4 __attribute__((ext_vector_type(4)));
typedef unsigned u32x2 __attribute__((ext_vector_type(2)));
typedef float f32x4 __attribute__((ext_vector_type(4)));
#define LAS __attribute__((address_space(3)))
__device__ __forceinline__ float bf2f(unsigned short u) { return __uint_as_float((unsigned)u << 16); }
__device__ __forceinline__ float bflo(unsigned w) { return __uint_as_float(w << 16); }
__device__ __forceinline__ float bfhi(unsigned w) { return __uint_as_float(w & 0xffff0000u); }
__device__ __forceinline__ unsigned f2bf(float f) { unsigned u = __float_as_uint(f); return (u + 0x7fffu + ((u >> 16) & 1u)) >> 16; }
__device__ __forceinline__ unsigned pk2(float lo, float hi) { return f2bf(lo) | (f2bf(hi) << 16); }
__device__ __forceinline__ float wave_sum(float v) {
#pragma unroll
    for (int o = 1; o < 64; o <<= 1) v += __shfl_xor(v, o);
    return v;
}
__device__ __forceinline__ size_t sc_off(int r) { const size_t i = (size_t)(r >> 8); return 65536ull * (i * (i + 1) / 2) + (size_t)(r & 255) * 256ull * (i + 1); }

struct Args { const float* in[17]; float* out; unsigned char* ws; int ph_lo, ph_hi; };

template <bool MAPIN>
__device__ __forceinline__ void transpose_item(const float* __restrict__ W, int K, int srcN, bf16_t* WT, LAS float* scr, int item, int ndst, int lane) {
    const int nblk = ndst / 32, kb = item / nblk, nb = item % nblk, k0 = 64 * kb, n0 = 32 * nb;
    const int n = n0 + (lane & 31);
    int src = n;
    if (MAPIN) { src = (n < 5120) ? n : (n < 17408) ? n + 80 : (n < 17488) ? n - 17408 + 5120 : -1; }
#pragma unroll 8
    for (int i = 0; i < 32; ++i) { const int kk = 2 * i + (lane >> 5); scr[kk * 33 + (lane & 31)] = (src >= 0) ? W[(size_t)(k0 + kk) * srcN + src] : 0.f; }
    asm volatile("s_waitcnt lgkmcnt(0)" ::: "memory");
    const int c = lane & 7;
#pragma unroll
    for (int j = 0; j < 4; ++j) { const int nn = (lane >> 3) + 8 * j; const LAS float* s = scr + (8 * c) * 33 + nn;
        u32x4 o; o.x = pk2(s[0 * 33], s[1 * 33]); o.y = pk2(s[2 * 33], s[3 * 33]); o.z = pk2(s[4 * 33], s[5 * 33]); o.w = pk2(s[6 * 33], s[7 * 33]);
        *(u32x4*)(WT + (size_t)(n0 + nn) * K + k0 + 8 * c) = o; }
    asm volatile("s_waitcnt lgkmcnt(0)" ::: "memory");
}
__device__ __forceinline__ void rms_row_to_bf16(const float* __restrict__ xrow, const float* __restrict__ g, bf16_t* orow, int lane) {
    const f32x4* xr = (const f32x4*)xrow + lane; const f32x4* gr = (const f32x4*)g + lane;
    f32x4 v[8]; float s = 0.f;
#pragma unroll
    for (int j = 0; j < 8; ++j) { v[j] = xr[64 * j]; s += (v[j].x * v[j].x + v[j].y * v[j].y) + (v[j].z * v[j].z + v[j].w * v[j].w); }
    const float rs = 1.0f / sqrtf(wave_sum(s) * (1.f / DM) + RMS_EPS);
    u32x2* o8 = (u32x2*)orow + lane;
#pragma unroll
    for (int j = 0; j < 8; ++j) { const f32x4 gg = gr[64 * j]; u32x2 w; w.x = pk2(v[j].x * rs * gg.x, v[j].y * rs * gg.y); w.y = pk2(v[j].z * rs * gg.z, v[j].w * rs * gg.w); o8[64 * j] = w; }
}
__device__ __forceinline__ void p0_prologue(const Args& a, LAS unsigned char* lds, int blk, int nblk, const int wave) {
    const int lane = lane_id_v(), tid = wave * 64 + lane;
    LAS float* scr = (LAS float*)(lds + wave * 16384);
    const int gw = blk * 8 + wave, NGW = nblk * 8;
    unsigned char* ws = a.ws;
    constexpr int I_IN = (DM / 64) * (NPAD / 32), I_MKV = (DM / 64) * (2048 / 32), I_BR = (1024 / 64) * (2048 / 32), I_OUT = (DM / 64) * (2048 / 32);
    constexpr int NITEMS = I_IN + I_MKV + 3 * I_BR + I_OUT;
    for (int it = gw; it < NITEMS; it += NGW) {
        int r = it;
        if (r < I_IN) { transpose_item<true>(a.in[3], DM, DIN, (bf16_t*)(ws + WS_WTIN), scr, r, NPAD, lane); continue; } r -= I_IN;
        if (r < I_MKV) { transpose_item<false>(a.in[11], DM, 2048, (bf16_t*)(ws + WS_WTMKV), scr, r, 2048, lane); continue; } r -= I_MKV;
        if (r < 3 * I_BR) { const int z = r / I_BR; transpose_item<false>(a.in[12 + z], 1024, 2048, (bf16_t*)(ws + WS_WTBR) + (size_t)z * 2048 * 1024, scr, r % I_BR, 2048, lane); continue; } r -= 3 * I_BR;
        transpose_item<false>(a.in[15], DM, 2048, (bf16_t*)(ws + WS_WTOUT), scr, r, 2048, lane);
    }
    bf16_t* H = (bf16_t*)(ws + WS_H);
    for (int m = gw; m < S + NMEM; m += NGW) {
        if (m < S) rms_row_to_bf16(a.in[0] + (size_t)m * DM, a.in[2], H + (size_t)m * DM, lane);
        else rms_row_to_bf16(a.in[1] + (size_t)(m - S) * DM, a.in[10], (bf16_t*)(ws + WS_MEMN) + (size_t)(m - S) * DM, lane);
    }
    if (blk == 0 && wave == 0) {
        const float s1 = wave_sum(a.in[5][lane] * a.in[6][lane]), s2 = wave_sum(a.in[7][lane] * a.in[8][lane]);
        if (lane == 0) ((float*)(ws + WS_CTL))[0] = expf(s1) - expf(s2) + 0.2f;
    }
}

__device__ __forceinline__ void idx_scores_naive(const bf16_t* __restrict__ PROJ, float* SC, LAS unsigned char* lds, int blk, int nblk, const int wave) {
    const int lane = lane_id_v(), tid = wave * 64 + lane;
    LAS float* qs = (LAS float*)lds + wave * 1088;
    constexpr int NITEM = 128 * 129 / 2;
    for (int it = blk; it < NITEM; it += nblk) {
        int kb = 0, rem = it; while (rem >= 128 - kb) { rem -= 128 - kb; ++kb; }
        const int qc = kb + rem, s = 64 * kb + lane;
        float kreg[64];
        { const u32x4* kp = (const u32x4*)(PROJ + (size_t)s * NPAD + C_KI);
#pragma unroll
          for (int i = 0; i < 8; ++i) { const u32x4 w = kp[i]; kreg[8 * i + 0] = bflo(w.x); kreg[8 * i + 1] = bfhi(w.x); kreg[8 * i + 2] = bflo(w.y); kreg[8 * i + 3] = bfhi(w.y);
              kreg[8 * i + 4] = bflo(w.z); kreg[8 * i + 5] = bfhi(w.z); kreg[8 * i + 6] = bflo(w.w); kreg[8 * i + 7] = bfhi(w.w); } }
        for (int qq = 0; qq < 8; ++qq) {
            const int q = 64 * qc + wave * 8 + qq;
            { const u32x4* qp = (const u32x4*)(PROJ + (size_t)q * NPAD + C_QI) + 2 * lane;
              const u32x4 w0 = qp[0], w1 = qp[1];
              LAS f32x4* dst = (LAS f32x4*)(qs + 16 * lane);
              dst[0] = (f32x4){bflo(w0.x), bfhi(w0.x), bflo(w0.y), bfhi(w0.y)}; dst[1] = (f32x4){bflo(w0.z), bfhi(w0.z), bflo(w0.w), bfhi(w0.w)};
              dst[2] = (f32x4){bflo(w1.x), bfhi(w1.x), bflo(w1.y), bfhi(w1.y)}; dst[3] = (f32x4){bflo(w1.z), bfhi(w1.z), bflo(w1.w), bfhi(w1.w)};
              if (lane < 16) qs[1024 + lane] = bf2f(PROJ[(size_t)q * NPAD + C_WI + lane]) * 0.25f; }
            asm volatile("s_waitcnt lgkmcnt(0)" ::: "memory"); __builtin_amdgcn_wave_barrier();
            float score = 0.f;
            for (int j = 0; j < 16; ++j) {
                float acc = 0.f; const LAS f32x4* qj = (const LAS f32x4*)(qs + 64 * j);
#pragma unroll
                for (int d = 0; d < 16; ++d) { const f32x4 qv = qj[d]; acc += qv.x * kreg[4 * d] + qv.y * kreg[4 * d + 1] + qv.z * kreg[4 * d + 2] + qv.w * kreg[4 * d + 3]; }
                score += fmaxf(acc * 0.125f, 0.f) * qs[1024 + j];
            }
            if (s <= q) SC[sc_off(q) + s] = score;
            asm volatile("s_waitcnt lgkmcnt(0)" ::: "memory"); __builtin_amdgcn_wave_barrier();
        }
    }
}
__device__ __forceinline__ unsigned ordkey(float f) { const unsigned u = __float_as_uint(f); return (u & 0x80000000u) ? ~u : (u | 0x80000000u); }
__device__ __forceinline__ void topk_select(const float* SC, int* SEL, LAS unsigned char* lds, int blk, int nblk, const int wave) {
    const int lane = lane_id_v(), tid = wave * 64 + lane;
    LAS unsigned* hist = (LAS unsigned*)lds + wave * 256;
    for (int r = blk * 8 + wave; r < S; r += nblk * 8) {
        const int n = r + 1; int* sel = SEL + (size_t)r * TOPK;
        if (n <= TOPK) { for (int i = lane; i < TOPK; i += 64) sel[i] = (i < n) ? i : -1; continue; }
        const float* row = SC + sc_off(r);
        unsigned prefix = 0u; int remaining = TOPK;
        for (int pass = 0; pass < 4; ++pass) {
            const int shift = 24 - 8 * pass;
#pragma unroll
            for (int i = 0; i < 4; ++i) hist[lane + 64 * i] = 0u;
            asm volatile("s_waitcnt lgkmcnt(0)" ::: "memory"); __builtin_amdgcn_wave_barrier();
            for (int i = lane; i < n; i += 64) { const unsigned u = ordkey(row[i]);
                if (pass == 0 || (u >> (shift + 8)) == prefix) atomicAdd((unsigned*)&hist[(u >> shift) & 255u], 1u); }
            asm volatile("s_waitcnt lgkmcnt(0)" ::: "memory"); __builtin_amdgcn_wave_barrier();
            const unsigned c0 = hist[4 * lane], c1 = hist[4 * lane + 1], c2 = hist[4 * lane + 2], c3 = hist[4 * lane + 3];
            const unsigned mine = c0 + c1 + c2 + c3;
            unsigned suf = mine;
#pragma unroll
            for (int o = 1; o < 64; o <<= 1) { const unsigned t = __shfl_down(suf, o); if (lane + o < 64) suf += t; }
            const unsigned long long bal = __ballot(suf >= (unsigned)remaining);
            const int Ls = 63 - __builtin_clzll(bal);
            const unsigned above = __shfl(suf, Ls) - __shfl(mine, Ls);
            const unsigned b3 = __shfl(c3, Ls), b2 = __shfl(c2, Ls), b1 = __shfl(c1, Ls);
            unsigned rem = (unsigned)remaining - above; int bin;
            if (rem <= b3) { bin = 4 * Ls + 3; } else { rem -= b3; if (rem <= b2) { bin = 4 * Ls + 2; } else { rem -= b2; if (rem <= b1) { bin = 4 * Ls + 1; } else { rem -= b1; bin = 4 * Ls; } } }
            prefix = (prefix << 8) | (unsigned)bin; remaining = (int)rem;
            asm volatile("s_waitcnt lgkmcnt(0)" ::: "memory"); __builtin_amdgcn_wave_barrier();
        }
        int cnt = 0, eqc = 0; const unsigned long long lt = (lane == 0) ? 0ull : (~0ull >> (64 - lane));
        for (int base = 0; base < n; base += 64) {
            const int i = base + lane; const unsigned u = (i < n) ? ordkey(row[i]) : 0u;
            const bool gt = (i < n) && (u > prefix), eq = (i < n) && (u == prefix);
            const unsigned long long bg = __ballot(gt), be = __ballot(eq);
            if (gt) sel[cnt + __builtin_popcountll(bg & lt)] = i;
            if (eq) { const int rk = eqc + __builtin_popcountll(be & lt); if (rk < remaining) sel[TOPK - remaining + rk] = i; }
            cnt += __builtin_popcountll(bg); eqc += __builtin_popcountll(be);
        }
    }
}
template <int DQ, int DV, bool GATHER>
__device__ __forceinline__ void naive_attn(const bf16_t* __restrict__ qp, const bf16_t* __restrict__ kb, const bf16_t* __restrict__ vb, size_t kvpitch,
                                           int nkeys, int nmax, const int* __restrict__ sel, int r, float scale, float slope, float (&o)[DV / 8]) {
    constexpr int QN = DQ / 8, VN = DV / 8;
    float q[QN];
#pragma unroll
    for (int i = 0; i < QN / 2; ++i) { const unsigned w = ((const unsigned*)qp)[i]; q[2 * i] = bflo(w) * scale; q[2 * i + 1] = bfhi(w) * scale; }
#pragma unroll
    for (int i = 0; i < VN; ++i) o[i] = 0.f;
    float m = -1e30f, l = 0.f;
    for (int i = 0; i < nmax; ++i) {
        bool valid = i < nkeys; int key = i;
        if (GATHER) { key = sel[valid ? i : 0]; valid = valid && key >= 0; }
        if (!valid) key = 0;
        const unsigned* kp = (const unsigned*)(kb + (size_t)key * kvpitch);
        float d = 0.f;
#pragma unroll
        for (int j = 0; j < QN / 2; ++j) { const unsigned w = kp[j]; d += q[2 * j] * bflo(w) + q[2 * j + 1] * bfhi(w); }
        d += __shfl_xor(d, 1); d += __shfl_xor(d, 2); d += __shfl_xor(d, 4);
        const float logit = d - slope * (float)(r - key);
        if (valid) {
            if (logit > m) { const float c = __expf(m - logit); l *= c;
#pragma unroll
                for (int j = 0; j < VN; ++j) o[j] *= c;
                m = logit; }
            const float p = __expf(logit - m); l += p;
            const unsigned* vp = (const unsigned*)(vb + (size_t)key * kvpitch);
#pragma unroll
            for (int j = 0; j < VN / 2; ++j) { const unsigned w = vp[j]; o[2 * j] += p * bflo(w); o[2 * j + 1] += p * bfhi(w); }
        }
    }
    const float il = 1.0f / l;
#pragma unroll
    for (int j = 0; j < VN; ++j) o[j] *= il;
}
__device__ __forceinline__ void attn_b_naive(const Args& a, int blk, int nblk, const int wave) {
    const int lane = lane_id_v(), tid = wave * 64 + lane, sub = lane & 7;
    const bf16_t* PROJ = (const bf16_t*)(a.ws + WS_PROJ); bf16_t* UB = (bf16_t*)(a.ws + WS_U) + (size_t)1 * S * 1024;
    const float lam = ((const float*)(a.ws + WS_CTL))[0];
    for (int wi = blk * 8 + wave; wi < 1024 * 8; wi += nblk * 8) {
        const int h = wi & 7, rg = wi >> 3, r = rg * 8 + (lane >> 3), nmax = rg * 8 + 8;
        const float slope = exp2f(-(float)(h + 1));
        float o0[16], o1[16];
        const bf16_t* rowp = PROJ + (size_t)r * NPAD;
        naive_attn<64, 128, false>(rowp + C_QB + h * 128 + sub * 8, PROJ + C_KB + h * 128 + sub * 8, PROJ + C_VB + h * 128 + sub * 16, NPAD, r + 1, nmax, nullptr, r, 0.125f, slope, o0);
        naive_attn<64, 128, false>(rowp + C_QB + h * 128 + 64 + sub * 8, PROJ + C_KB + h * 128 + 64 + sub * 8, PROJ + C_VB + h * 128 + sub * 16, NPAD, r + 1, nmax, nullptr, r, 0.125f, slope, o1);
        float ss = 0.f;
#pragma unroll
        for (int j = 0; j < 16; ++j) { o0[j] -= lam * o1[j]; ss += o0[j] * o0[j]; }
        ss += __shfl_xor(ss, 1); ss += __shfl_xor(ss, 2); ss += __shfl_xor(ss, 4);
        const float rs = 1.0f / sqrtf(ss * (1.f / 128.f) + RMS_EPS) * 0.8f;
        const float* g = a.in[9] + sub * 16; const bf16_t* zp = rowp + C_ZB + h * 128 + sub * 16;
        unsigned w[8];
#pragma unroll
        for (int j = 0; j < 8; ++j) w[j] = pk2(o0[2 * j] * rs * g[2 * j] * bf2f(zp[2 * j]), o0[2 * j + 1] * rs * g[2 * j + 1] * bf2f(zp[2 * j + 1]));
        u32x4* dst = (u32x4*)(UB + (size_t)r * 1024 + h * 128 + sub * 16);
        dst[0] = (u32x4){w[0], w[1], w[2], w[3]}; dst[1] = (u32x4){w[4], w[5], w[6], w[7]};
    }
}
__device__ __forceinline__ void attn_m_naive(const Args& a, int blk, int nblk, const int wave) {
    const int lane = lane_id_v(), tid = wave * 64 + lane, sub = lane & 7;
    const bf16_t* PROJ = (const bf16_t*)(a.ws + WS_PROJ); const bf16_t* MKV = (const bf16_t*)(a.ws + WS_MKV); bf16_t* UM = (bf16_t*)(a.ws + WS_U) + (size_t)2 * S * 1024;
    for (int wi = blk * 8 + wave; wi < 1024 * 4; wi += nblk * 8) {
        const int h = wi & 3, rg = wi >> 2, r = rg * 8 + (lane >> 3);
        float o[32];
        const bf16_t* rowp = PROJ + (size_t)r * NPAD;
        naive_attn<256, 256, false>(rowp + C_QM + h * 256 + sub * 32, MKV + h * 256 + sub * 32, MKV + 1024 + h * 256 + sub * 32, 2048, NMEM, NMEM, nullptr, 0, 0.0625f, 0.f, o);
        const bf16_t* zp = rowp + C_ZM + h * 256 + sub * 32;
        u32x4* dst = (u32x4*)(UM + (size_t)r * 1024 + h * 256 + sub * 32);
#pragma unroll
        for (int j = 0; j < 4; ++j) { u32x4 w;
            w.x = pk2(o[8 * j + 0] * bf2f(zp[8 * j + 0]), o[8 * j + 1] * bf2f(zp[8 * j + 1])); w.y = pk2(o[8 * j + 2] * bf2f(zp[8 * j + 2]), o[8 * j + 3] * bf2f(zp[8 * j + 3]));
            w.z = pk2(o[8 * j + 4] * bf2f(zp[8 * j + 4]), o[8 * j + 5] * bf2f(zp[8 * j + 5])); w.w = pk2(o[8 * j + 6] * bf2f(zp[8 * j + 6]), o[8 * j + 7] * bf2f(zp[8 * j + 7]));
            dst[j] = w; }
    }
}
__device__ __forceinline__ void attn_a_naive(const Args& a, int blk, int nblk, const int wave) {
    const int lane = lane_id_v(), tid = wave * 64 + lane, sub = lane & 7;
    const bf16_t* PROJ = (const bf16_t*)(a.ws + WS_PROJ); const int* SEL = (const int*)(a.ws + WS_SEL); bf16_t* UA = (bf16_t*)(a.ws + WS_U);
    for (int wi = blk * 8 + wave; wi < 1024 * 8; wi += nblk * 8) {
        const int h = wi & 7, rg = wi >> 3, r = rg * 8 + (lane >> 3);
        const float slope = exp2f(-(float)(h + 1));
        float o[16];
        const bf16_t* rowp = PROJ + (size_t)r * NPAD;
        naive_attn<128, 128, true>(rowp + C_QA + h * 128 + sub * 16, PROJ + C_KA + h * 128 + sub * 16, PROJ + C_VA + h * 128 + sub * 16, NPAD, TOPK, TOPK, SEL + (size_t)r * TOPK, r, 0.08838834764831845f, slope, o);
        const bf16_t* zp = rowp + C_ZA + h * 128 + sub * 16;
        unsigned w[8];
#pragma unroll
        for (int j = 0; j < 8; ++j) w[j] = pk2(o[2 * j] * bf2f(zp[2 * j]), o[2 * j + 1] * bf2f(zp[2 * j + 1]));
        u32x4* dst = (u32x4*)(UA + (size_t)r * 1024 + h * 128 + sub * 16);
        dst[0] = (u32x4){w[0], w[1], w[2], w[3]}; dst[1] = (u32x4){w[4], w[5], w[6], w[7]};
    }
}
__device__ __forceinline__ void final_norm(const Args& a, int blk, int nblk, const int wave) {
    const int lane = lane_id_v(), tid = wave * 64 + lane;
    const float* part = (const float*)(a.ws + WS_PART); const f32x4* g = (const f32x4*)a.in[16] + lane;
    for (int r = blk * 8 + wave; r < S; r += nblk * 8) {
        float s = (lane < 32) ? part[(size_t)lane * S + r] : 0.f;
        const float rs = 1.0f / sqrtf(wave_sum(s) * (1.f / DM) + RMS_EPS);
        f32x4* y = (f32x4*)(a.out + (size_t)r * DM) + lane;
#pragma unroll
        for (int j = 0; j < 8; ++j) { f32x4 v = y[64 * j]; const f32x4 gg = g[64 * j]; v = v * rs * gg; y[64 * j] = v; }
    }
}


namespace att {
typedef short bf16x8 __attribute__((ext_vector_type(8)));
typedef short s16x4 __attribute__((ext_vector_type(4)));
typedef float f32x16 __attribute__((ext_vector_type(16)));
typedef float f32x2_t __attribute__((ext_vector_type(2)));
typedef __bf16 bf16x2_t __attribute__((ext_vector_type(2)));
constexpr int SHM_V = 16384, SHM_K = 16384;
constexpr float LOG2E = 1.4426950408889634f;
constexpr float THR2 = 8.f * LOG2E;
#define KSWZ(row, colB) ((row) * 256 + ((colB) ^ (((row) & 7) << 4)))
#define SBAR() __builtin_amdgcn_sched_barrier(0)
__device__ __forceinline__ int crow(int r, int hi) { return (r & 3) + 8 * (r >> 2) + 4 * hi; }
__device__ __forceinline__ unsigned cvtpk(float lo, float hi) { f32x2_t v = {lo, hi}; bf16x2_t b = __builtin_convertvector(v, bf16x2_t); return __builtin_bit_cast(unsigned, b); }
__device__ __forceinline__ int v_st(int k, int c) { const int kk = (k & ~0xC) | ((k & 4) << 1) | ((k & 8) >> 1); return ((kk >> 3) * 4 + (c >> 5)) * 512 + ((kk & 7) * 32 + (c & 31)) * 2; }
__device__ __forceinline__ int v_rd_base(int lane) { return ((lane & 3) << 3) | (((lane >> 2) & 3) << 6) | (((lane >> 4) & 1) << 5) | (((lane >> 5) & 1) << 8); }
constexpr int v_rd_off(int d0, int ks, int half) { return d0 * 512 + ks * 4096 + half * 2048; }
typedef short v4i16_t __attribute__((ext_vector_type(4)));
__device__ __forceinline__ s16x4 tr_read(LAS const unsigned char* p) { return __builtin_bit_cast(s16x4, __builtin_amdgcn_ds_read_tr16_b64_v4i16((LAS v4i16_t*)p)); }

template <int NQ> __device__ __forceinline__ void qkt(f32x16& p0, f32x16& p1, LAS const unsigned char* Ks, const bf16x8* qr, int cbyte0, int r32, int hi) {
  p0 = f32x16{}; p1 = f32x16{};
#pragma unroll
  for (int d0 = 0; d0 < NQ; ++d0) { const int cb = cbyte0 + (d0 * 16 + hi * 8) * 2;
    const bf16x8 b0 = *(LAS const bf16x8*)(Ks + KSWZ(r32, cb));
    const bf16x8 b1 = *(LAS const bf16x8*)(Ks + KSWZ(32 + r32, cb));
    p0 = __builtin_amdgcn_mfma_f32_32x32x16_bf16(b0, qr[d0], p0, 0, 0, 0);
    p1 = __builtin_amdgcn_mfma_f32_32x32x16_bf16(b1, qr[d0], p1, 0, 0, 0); }
}
template <int D0> __device__ __forceinline__ void pv_one(f32x16& od, LAS const unsigned char* vb, bf16x8 pa0, bf16x8 pa1, bf16x8 pa2, bf16x8 pa3) {
  const s16x4 l0 = tr_read(vb + v_rd_off(D0, 0, 0)), h0 = tr_read(vb + v_rd_off(D0, 0, 1)), l1 = tr_read(vb + v_rd_off(D0, 1, 0)), h1 = tr_read(vb + v_rd_off(D0, 1, 1));
  const s16x4 l2 = tr_read(vb + v_rd_off(D0, 2, 0)), h2 = tr_read(vb + v_rd_off(D0, 2, 1)), l3 = tr_read(vb + v_rd_off(D0, 3, 0)), h3 = tr_read(vb + v_rd_off(D0, 3, 1));
#define PK(L, H) (bf16x8){L[0], L[1], L[2], L[3], H[0], H[1], H[2], H[3]}
  od = __builtin_amdgcn_mfma_f32_32x32x16_bf16(pa0, PK(l0, h0), od, 0, 0, 0);
  od = __builtin_amdgcn_mfma_f32_32x32x16_bf16(pa1, PK(l1, h1), od, 0, 0, 0);
  od = __builtin_amdgcn_mfma_f32_32x32x16_bf16(pa2, PK(l2, h2), od, 0, 0, 0);
  od = __builtin_amdgcn_mfma_f32_32x32x16_bf16(pa3, PK(l3, h3), od, 0, 0, 0);
#undef PK
}
__device__ __forceinline__ void pv_d0(f32x16* o, LAS const unsigned char* vb, bf16x8 pa0, bf16x8 pa1, bf16x8 pa2, bf16x8 pa3) {
  pv_one<0>(o[0], vb, pa0, pa1, pa2, pa3); pv_one<1>(o[1], vb, pa0, pa1, pa2, pa3); pv_one<2>(o[2], vb, pa0, pa1, pa2, pa3); pv_one<3>(o[3], vb, pa0, pa1, pa2, pa3);
}
template <bool CAUSAL> __device__ __forceinline__ void partialSM(f32x16& p0, f32x16& p1, float& m_reg, float& alpha, const float (&cs)[16], float base, int lim, float C, float slope2, int delta) {
  const float tb0 = slope2 * (float)delta + base, tb1 = slope2 * (float)(delta + 32) + base;
#pragma unroll
  for (int r = 0; r < 16; ++r) { p0[r] = fmaf(p0[r], C, cs[r]); p1[r] = fmaf(p1[r], C, cs[r]); }
  if (CAUSAL && delta + 63 > 0) {
    const int l0 = lim - delta, l1 = l0 - 32;
#pragma unroll
    for (int r = 0; r < 16; ++r) { const int K = (r & 3) + 8 * (r >> 2); if (K > l0) p0[r] = -INFINITY; if (K > l1) p1[r] = -INFINITY; }
  }
  float pm0 = p0[0], pm1 = p1[0];
#pragma unroll
  for (int r = 1; r < 16; ++r) { pm0 = fmaxf(pm0, p0[r]); pm1 = fmaxf(pm1, p1[r]); }
  float pmax = fmaxf(pm0 + tb0, pm1 + tb1);
  { auto rr = __builtin_amdgcn_permlane32_swap(__float_as_uint(pmax), __float_as_uint(pmax), false, false);
    pmax = fmaxf(__uint_as_float(rr[0]), __uint_as_float(rr[1])); }
  float mn;
  if (__builtin_expect(__all(pmax - m_reg <= THR2), 1)) { mn = m_reg; alpha = 1.f; }
  else { mn = fmaxf(m_reg, pmax); alpha = __builtin_amdgcn_exp2f(m_reg - mn); m_reg = mn; }
  const float a0 = tb0 - mn, a1 = tb1 - mn;
#pragma unroll
  for (int r = 0; r < 16; ++r) { p0[r] += a0; p1[r] += a1; }
#pragma unroll
  for (int r = 0; r < 16; ++r) p0[r] = __builtin_amdgcn_exp2f(p0[r]);
}
__device__ __forceinline__ void finishSM(f32x16& p0, f32x16& p1, float alpha, float& l_reg, bf16x8& pa0, bf16x8& pa1, bf16x8& pa2, bf16x8& pa3) {
#pragma unroll
  for (int r = 0; r < 16; ++r) p1[r] = __builtin_amdgcn_exp2f(p1[r]);
  float ps = 0;
#pragma unroll
  for (int r = 0; r < 16; ++r) ps += p0[r];
#pragma unroll
  for (int r = 0; r < 16; ++r) ps += p1[r];
  { auto rr = __builtin_amdgcn_permlane32_swap(__float_as_uint(ps), __float_as_uint(ps), false, false);
    ps = __uint_as_float(rr[0]) + __uint_as_float(rr[1]); }
  l_reg = l_reg * alpha + ps;
#define PK4(P, BASE, OUT) do { unsigned a0 = cvtpk(P[BASE + 0], P[BASE + 1]), a1 = cvtpk(P[BASE + 2], P[BASE + 3]);   \
    unsigned b0 = cvtpk(P[BASE + 4], P[BASE + 5]), b1 = cvtpk(P[BASE + 6], P[BASE + 7]);                              \
    auto r0 = __builtin_amdgcn_permlane32_swap(a0, b0, false, false); auto r1 = __builtin_amdgcn_permlane32_swap(a1, b1, false, false); \
    u32x4 w = {r0[0], r1[0], r0[1], r1[1]}; OUT = __builtin_bit_cast(bf16x8, w); } while (0)
  PK4(p0, 0, pa0); PK4(p0, 8, pa1); PK4(p1, 0, pa2); PK4(p1, 8, pa3);
#undef PK4
}

__device__ __forceinline__ void attn_b_unit(const bf16_t* __restrict__ PROJ, bf16_t* UB, const float* __restrict__ gsub, float lam, int h, int qb, LAS unsigned char* lds, const int wid) {
  const int lane = lane_id_v(), tid = wid * 64 + lane, r32 = lane & 31, hi = lane >> 5, comp = wid >> 2, wq = wid & 3;
  const int R0 = qb * 128, qrow0 = R0 + wq * 32, NT = 2 * qb + 2;
  LAS unsigned char* V_lds = lds; LAS unsigned char* K_lds = lds + 2 * SHM_V;
  LAS float* ws = (LAS float*)(lds + 2 * SHM_V + 2 * SHM_K) + wid * 64; LAS float* li_l = ws; LAS float* al_l = ws + 32;
  LAS float* xch = (LAS float*)(lds + 2 * SHM_V + 2 * SHM_K + 2048);
  const float slope2 = __builtin_amdgcn_exp2f(-(float)(h + 1)) * LOG2E, C = 0.125f * LOG2E;
  float cs[16];
#pragma unroll
  for (int r = 0; r < 16; ++r) cs[r] = __uint_as_float(__builtin_amdgcn_readfirstlane(__float_as_uint(slope2 * (float)((r & 3) + 8 * (r >> 2)))));
  const float base = slope2 * (float)(4 * hi - r32); const int lim = r32 - 4 * hi;
  float m_reg = -1e30f, l_reg = 0; f32x16 o[4] = {}; bf16x8 qr[4];
  { const bf16_t* Qw = PROJ + (size_t)(qrow0 + r32) * NPAD + C_QB + h * 128 + comp * 64 + hi * 8;
#pragma unroll
    for (int d0 = 0; d0 < 4; ++d0) qr[d0] = *(const bf16x8*)(Qw + d0 * 16); }
  const bf16_t* Kh = PROJ + C_KB + h * 128; const bf16_t* Vh = PROJ + C_VB + h * 128;
  const int sr = tid >> 4, sc = (tid & 15) * 8, vst0 = v_st(sr, sc), vst1 = v_st(32 + sr, sc), cq = comp * 128;
  LAS const unsigned char* vb0 = V_lds + v_rd_base(lane);
  struct { bf16x8 vs0, vs1, ks0, ks1; } sr_;
#define KEY0(t) (64 * (NT - 1 - (t)))
#define SLOAD(k0) do { sr_.vs0 = *(const bf16x8*)(Vh + (size_t)((k0) + sr) * NPAD + sc); sr_.vs1 = *(const bf16x8*)(Vh + (size_t)((k0) + 32 + sr) * NPAD + sc); \
    sr_.ks0 = *(const bf16x8*)(Kh + (size_t)((k0) + sr) * NPAD + sc); sr_.ks1 = *(const bf16x8*)(Kh + (size_t)((k0) + 32 + sr) * NPAD + sc); } while (0)
#define SWRITE(b) do { *(LAS bf16x8*)(V_lds + (b) * SHM_V + vst0) = sr_.vs0; *(LAS bf16x8*)(V_lds + (b) * SHM_V + vst1) = sr_.vs1; const int kc = sc * 2; \
    *(LAS bf16x8*)(K_lds + (b) * SHM_K + KSWZ(sr, kc)) = sr_.ks0; *(LAS bf16x8*)(K_lds + (b) * SHM_K + KSWZ(32 + sr, kc)) = sr_.ks1; } while (0)
#define RESC(a) do { if (__any((a) < 1.f)) { if (hi == 0) al_l[r32] = (a); asm volatile("s_waitcnt lgkmcnt(0)" ::: "memory"); \
    _Pragma("unroll") for (int d = 0; d < 4; ++d) _Pragma("unroll") for (int r = 0; r < 16; ++r) o[d][r] *= al_l[crow(r, hi)]; } } while (0)
  f32x16 pA0, pA1, pB0, pB1; float alA, alB; bf16x8 pa0, pa1, pa2, pa3;
  SLOAD(KEY0(0)); SWRITE(0); __syncthreads();
  qkt<4>(pA0, pA1, K_lds, qr, cq, r32, hi); partialSM<true>(pA0, pA1, m_reg, alA, cs, base, lim, C, slope2, KEY0(0) - qrow0);
  SLOAD(KEY0(1)); SWRITE(1); __syncthreads();
  for (int j = 1; j + 1 < NT; j += 2) {
    SBAR(); qkt<4>(pB0, pB1, K_lds + SHM_K, qr, cq, r32, hi);
    finishSM(pA0, pA1, alA, l_reg, pa0, pa1, pa2, pa3); SBAR();
    SLOAD(KEY0(j + 1)); SBAR();
    pv_d0(o, vb0, pa0, pa1, pa2, pa3); partialSM<true>(pB0, pB1, m_reg, alB, cs, base, lim, C, slope2, KEY0(j) - qrow0);
    __syncthreads(); SWRITE(0);
    RESC(alB); __syncthreads();
    SBAR(); qkt<4>(pA0, pA1, K_lds, qr, cq, r32, hi);
    finishSM(pB0, pB1, alB, l_reg, pa0, pa1, pa2, pa3); SBAR();
    SLOAD(KEY0(j + 2)); SBAR();
    pv_d0(o, vb0 + SHM_V, pa0, pa1, pa2, pa3); partialSM<true>(pA0, pA1, m_reg, alA, cs, base, lim, C, slope2, KEY0(j + 1) - qrow0);
    __syncthreads(); SWRITE(1);
    RESC(alA); __syncthreads();
  }
  SBAR(); qkt<4>(pB0, pB1, K_lds + SHM_K, qr, cq, r32, hi);
  finishSM(pA0, pA1, alA, l_reg, pa0, pa1, pa2, pa3); SBAR();
  pv_d0(o, vb0, pa0, pa1, pa2, pa3); partialSM<true>(pB0, pB1, m_reg, alB, cs, base, lim, C, slope2, KEY0(NT - 1) - qrow0);
  __syncthreads(); RESC(alB);
  finishSM(pB0, pB1, alB, l_reg, pa0, pa1, pa2, pa3); SBAR();
  pv_d0(o, vb0 + SHM_V, pa0, pa1, pa2, pa3);
#undef KEY0
#undef SLOAD
#undef SWRITE
#undef RESC
  if (hi == 0) li_l[r32] = l_reg; asm volatile("s_waitcnt lgkmcnt(0)" ::: "memory");
  float rli[16];
#pragma unroll
  for (int r = 0; r < 16; ++r) rli[r] = __builtin_amdgcn_rcpf(li_l[crow(r, hi)]);
  if (comp == 1) {
#pragma unroll
    for (int d0 = 0; d0 < 4; ++d0)
#pragma unroll
      for (int r = 0; r < 16; ++r) xch[(wq * 64 + d0 * 16 + r) * 64 + lane] = o[d0][r] * rli[r] * lam;
  }
  __syncthreads();
  if (comp == 0) {
    float ss[16];
#pragma unroll
    for (int r = 0; r < 16; ++r) ss[r] = 0.f;
#pragma unroll
    for (int d0 = 0; d0 < 4; ++d0)
#pragma unroll
      for (int r = 0; r < 16; ++r) { const float d = o[d0][r] * rli[r] - xch[(wq * 64 + d0 * 16 + r) * 64 + lane]; o[d0][r] = d; ss[r] += d * d; }
#pragma unroll
    for (int r = 0; r < 16; ++r) { float s = ss[r]; s += __shfl_xor(s, 1); s += __shfl_xor(s, 2); s += __shfl_xor(s, 4); s += __shfl_xor(s, 8); s += __shfl_xor(s, 16);
      ss[r] = 0.8f / sqrtf(s * (1.f / 128.f) + RMS_EPS); }
#pragma unroll
    for (int d0 = 0; d0 < 4; ++d0) { const int col = d0 * 32 + r32; const float g = gsub[col];
#pragma unroll
      for (int r = 0; r < 16; ++r) { const size_t row = (size_t)(qrow0 + crow(r, hi));
        const float z = bf2f(PROJ[row * NPAD + C_ZB + h * 128 + col]);
        UB[row * 1024 + h * 128 + col] = (bf16_t)f2bf(o[d0][r] * ss[r] * g * z); } }
  }
  __syncthreads();
}
__device__ __forceinline__ void attn_b_phase(const Args& a, LAS unsigned char* lds, int blk, int nblk, const int wid) {
  const bf16_t* PROJ = (const bf16_t*)(a.ws + WS_PROJ); bf16_t* UB = (bf16_t*)(a.ws + WS_U) + (size_t)1 * S * 1024;
  const float lam = ((const float*)(a.ws + WS_CTL))[0];
  for (int u = blk; u < 256; u += nblk) {
    const int h = u & 7, p = u >> 3;
    attn_b_unit(PROJ, UB, a.in[9], lam, h, 63 - p, lds, wid);
    attn_b_unit(PROJ, UB, a.in[9], lam, h, p, lds, wid);
  }
}
#undef KSWZ
#undef SBAR
}


namespace idx {
typedef short bf16x8 __attribute__((ext_vector_type(8)));
typedef float f32x16 __attribute__((ext_vector_type(16)));
constexpr int NUNIT = 8 * (16 * 17 / 2);
__device__ __forceinline__ void scores_phase(const bf16_t* __restrict__ PROJ, float* SC, LAS unsigned char* lds, int blk, int nblk, const int wid) {
  const int lane = lane_id_v(), tid = wid * 64 + lane, n32 = lane & 31, hi = lane >> 5;
  const int skey = tid >> 3, schunk = tid & 7;
  const int swr = skey * 128 + ((schunk ^ (skey & 7)) << 4);
  for (int u = blk; u < NUNIT; u += nblk) {
    int g = 0, rem = u; while (rem >= 8 * (g + 1)) { rem -= 8 * (g + 1); ++g; }
    const int qc = 8 * g + rem / (g + 1), kc = rem % (g + 1);
    const int q0 = 64 * qc + 8 * wid, k_begin = 512 * kc, k_end = min(512 * kc + 512, 64 * qc + 64), ntile = (k_end - k_begin) / 64;
    bf16x8 af[4][4]; float w[4][16];
    const int head = (n32 & 3) + 4 * (n32 >> 3), qbit = (n32 >> 2) & 1;
#pragma unroll
    for (int t = 0; t < 4; ++t) {
      const bf16_t* qp = PROJ + (size_t)(q0 + 2 * t + qbit) * NPAD + C_QI + head * 64 + hi * 8;
#pragma unroll
      for (int ks = 0; ks < 4; ++ks) af[t][ks] = *(const bf16x8*)(qp + ks * 16);
      const bf16_t* wp = PROJ + (size_t)(q0 + 2 * t + hi) * NPAD + C_WI;
      const u32x4 w0 = *(const u32x4*)wp, w1 = *(const u32x4*)(wp + 8);
      const unsigned ww[8] = {w0.x, w0.y, w0.z, w0.w, w1.x, w1.y, w1.z, w1.w};
#pragma unroll
      for (int i = 0; i < 8; ++i) { w[t][2 * i] = bflo(ww[i]) * 0.03125f; w[t][2 * i + 1] = bfhi(ww[i]) * 0.03125f; }
    }
    u32x4 st = *(const u32x4*)(PROJ + (size_t)(k_begin + skey) * NPAD + C_KI + schunk * 8);
    __syncthreads();
    *(LAS u32x4*)(lds + swr) = st;
    __syncthreads();
    for (int tl = 0; tl < ntile; ++tl) {
      LAS const unsigned char* kb = lds + (tl & 1) * 8192;
      if (tl + 1 < ntile) st = *(const u32x4*)(PROJ + (size_t)(k_begin + 64 * (tl + 1) + skey) * NPAD + C_KI + schunk * 8);
#pragma unroll
      for (int kh = 0; kh < 2; ++kh) {
        const int krow = kh * 32 + n32;
        bf16x8 bfr[4];
#pragma unroll
        for (int ks = 0; ks < 4; ++ks) bfr[ks] = *(LAS const bf16x8*)(kb + krow * 128 + (((2 * ks + hi) ^ (krow & 7)) << 4));
        const int s = k_begin + 64 * tl + krow;
#pragma unroll
        for (int t = 0; t < 4; ++t) {
          f32x16 acc = {};
#pragma unroll
          for (int ks = 0; ks < 4; ++ks) acc = __builtin_amdgcn_mfma_f32_32x32x16_bf16(af[t][ks], bfr[ks], acc, 0, 0, 0);
          float sc = 0.f;
#pragma unroll
          for (int r = 0; r < 16; ++r) sc = fmaf(fmaxf(acc[r], 0.f), w[t][r], sc);
          const int q = q0 + 2 * t + hi;
          if (s <= q) SC[sc_off(q) + s] = sc;
        }
      }
      if (tl + 1 < ntile) { *(LAS u32x4*)(lds + ((tl + 1) & 1) * 8192 + swr) = st; }
      __syncthreads();
    }
  }
}
}

#ifdef DBG_STAGE
__device__ __forceinline__ void dbg_dump(const Args& a, int blk, int nblk) {
    const bf16_t* PROJ = (const bf16_t*)(a.ws + WS_PROJ);
    for (size_t idx = (size_t)blk * 512 + threadIdx.x; idx < (size_t)S * DM; idx += (size_t)nblk * 512) {
        const int r = (int)(idx / DM), c = (int)(idx % DM); float v = 0.f;
#if DBG_STAGE == 1 && defined(DBG_WEIGHTS)
        for (int z = 0; z < 3; ++z) v += bf2f(((const bf16_t*)(a.ws + WS_WTBR))[((size_t)z * 2048 + (r & 2047)) * 1024 + (c & 1023)]);
        v += bf2f(((const bf16_t*)(a.ws + WS_WTOUT))[(size_t)(r & 2047) * 2048 + c]);
#elif DBG_STAGE == 1 && defined(DBG_GATES)
        for (int j = 0; j < 3; ++j) v += bf2f(PROJ[(size_t)r * NPAD + C_GL + c + 2048 * j]);
#elif DBG_STAGE == 1
        for (int j = 0; j < 8; ++j) v += bf2f(PROJ[(size_t)r * NPAD + c + 2048 * j]);
        if (c < 1280) v += bf2f(PROJ[(size_t)r * NPAD + 16384 + c]);
        if (r < 256) v += bf2f(((const bf16_t*)(a.ws + WS_MKV))[(size_t)r * 2048 + c]);
        for (int z = 0; z < 3; ++z) v += bf2f(((const bf16_t*)(a.ws + WS_WTBR))[((size_t)z * 2048 + (r & 2047)) * 1024 + (c & 1023)]);
        v += bf2f(((const bf16_t*)(a.ws + WS_WTOUT))[(size_t)(r & 2047) * 2048 + c]);
#elif DBG_STAGE == 2
        if (c < 1024) v = bf2f(((const bf16_t*)(a.ws + WS_U))[(size_t)(S + r) * 1024 + c]) + bf2f(((const bf16_t*)(a.ws + WS_U))[(size_t)(2 * S + r) * 1024 + c]);
        else { const float* row = (const float*)(a.ws + WS_SC) + sc_off(r); for (int j = c - 1024; j <= r; j += 1024) v += row[j]; }
#elif DBG_STAGE == 3
        if (c < 256) v = (float)((const int*)(a.ws + WS_SEL))[(size_t)r * 256 + c];
#elif DBG_STAGE == 4
        if (c < 1024) v = bf2f(((const bf16_t*)(a.ws + WS_U))[(size_t)r * 1024 + c]);
#elif DBG_STAGE == 5
        v = bf2f(((const bf16_t*)(a.ws + WS_MERGED))[(size_t)r * DM + c]);
#endif
        a.out[idx] = v;
    }
}
#endif

constexpr int LDS_BYTES = 147456;
constexpr int NPHASE = 8;
__global__ void __launch_bounds__(512, 2) fwd(Args a) {
    extern __shared__ __attribute__((aligned(16))) unsigned char lds_raw[];
    LAS unsigned char* lds = (LAS unsigned char*)lds_raw;
    cg::grid_group grid = cg::this_grid();
    const int blk = blockIdx.x, nblk = gridDim.x, wave = __builtin_amdgcn_readfirstlane(threadIdx.x >> 6);
    unsigned char* ws = a.ws;
    const bf16_t* PROJ = (const bf16_t*)(ws + WS_PROJ);
#define IN(k) (a.ph_lo <= (k) && (k) < a.ph_hi)
#define SEAM(k) do { if (IN(k) && IN((k) + 1)) grid.sync(); } while (0)
    if (IN(0)) { p0_prologue(a, lds, blk, nblk, wave); } SEAM(0);
    if (IN(1)) {
        pg8::Gemm g{(const bf16_t*)(ws + WS_H), (const bf16_t*)(ws + WS_WTIN), S, NPAD, DM, (long)WS_MEMN - (long)WS_H, (long)WS_WTMKV - (long)WS_WTIN};
        pg8::ProjOrder so; so.init(S, NPAD, nblk, blk);
        pg8::EpiProj E{(bf16_t*)(ws + WS_PROJ), NPAD, (bf16_t*)(ws + WS_MKV), 2048, a.in[4], C_GL / 256};
        pg8::gemm_phase<pg8::EpiProj, pg8::ProjOrder, true, true>(lds, g, so, E, wave);
    } SEAM(1);
    if (IN(2)) { idx::scores_phase(PROJ, (float*)(ws + WS_SC), lds, blk, nblk, wave); __syncthreads(); att::attn_b_phase(a, lds, blk, nblk, wave); attn_m_naive(a, blk, nblk, wave); } SEAM(2);
    if (IN(3)) { topk_select((const float*)(ws + WS_SC), (int*)(ws + WS_SEL), lds, blk, nblk, wave); } SEAM(3);
    if (IN(4)) { attn_a_naive(a, blk, nblk, wave); } SEAM(4);
    if (IN(5)) {
        pg8::Gemm g{(const bf16_t*)(ws + WS_U), (const bf16_t*)(ws + WS_WTBR), S, DM, 1024, (long)S * 1024 * 2, (long)2048 * 1024 * 2};
        pg8::MergeOrder so; so.init(S, DM, nblk, blk);
        pg8::EpiMerge E{PROJ + C_GL, NPAD, (float*)(ws + WS_T), (bf16_t*)(ws + WS_MERGED), DM};
        pg8::gemm_phase<pg8::EpiMerge, pg8::MergeOrder, true, true>(lds, g, so, E, wave);
    } SEAM(5);
    if (IN(6)) {
        pg8::Gemm g{(const bf16_t*)(ws + WS_MERGED), (const bf16_t*)(ws + WS_WTOUT), S, DM, DM, 0, 0};
        pg8::StaticOrder so; so.init(S, DM, nblk, blk);
        pg8::EpiOut E{a.in[0], a.out, DM, (float*)(ws + WS_PART), S};
        pg8::gemm_phase<pg8::EpiOut, pg8::StaticOrder, false, true>(lds, g, so, E, wave);
    } SEAM(6);
    if (IN(7)) { final_norm(a, blk, nblk, wave); }
#ifdef DBG_STAGE
    if (IN(8)) { dbg_dump(a, blk, nblk); }
#endif
#undef IN
#undef SEAM
}

#ifndef N_LAUNCH_MODE
#define N_LAUNCH_MODE 0
#endif
extern "C" void kernel_launch(void* const* d_in, const int* in_sizes, int n_in, void* d_out, int out_size, void* d_ws, size_t ws_size, hipStream_t stream) {
    static int grid = 0;
    if (grid == 0) {
        if (n_in != 17 || in_sizes[0] != S * DM || in_sizes[3] != DM * DIN || out_size != S * DM || ws_size < WS_END) {
            fprintf(stderr, "kernel_launch: unexpected shapes (n_in %d, in0 %d, in3 %d, out %d, ws %zu < %zu)\n", n_in, n_in > 0 ? in_sizes[0] : -1, n_in > 3 ? in_sizes[3] : -1, out_size, ws_size, (size_t)WS_END); grid = -1; return; }
        int dev = 0, cus = 0, per_cu = 0;
        (void)hipGetDevice(&dev); (void)hipDeviceGetAttribute(&cus, hipDeviceAttributeMultiprocessorCount, dev);
        if (hipFuncSetAttribute((const void*)fwd, hipFuncAttributeMaxDynamicSharedMemorySize, LDS_BYTES) != hipSuccess) { fprintf(stderr, "kernel_launch: hipFuncSetAttribute failed\n"); grid = -1; return; }
        if (hipOccupancyMaxActiveBlocksPerMultiprocessor(&per_cu, (const void*)fwd, 512, LDS_BYTES) != hipSuccess || per_cu < 1) { fprintf(stderr, "kernel_launch: occupancy query gave %d\n", per_cu); per_cu = 1; }
        (void)hipGetLastError();
        grid = cus * 1;
        if (grid > cus * per_cu) grid = cus * per_cu;
        if (grid < 8) grid = -1;
    }
    if (grid < 0) return;
    Args a{};
    for (int i = 0; i < 17; ++i) a.in[i] = (const float*)d_in[i];
    a.out = (float*)d_out; a.ws = (unsigned char*)d_ws;
#if N_LAUNCH_MODE == 1
    a.ph_lo = 0; a.ph_hi = NPHASE;
    void* kargs[] = {&a};
    hipError_t e = hipLaunchCooperativeKernel((const void*)fwd, dim3(grid), dim3(512), kargs, LDS_BYTES, stream);
    if (e != hipSuccess) fprintf(stderr, "cooperative launch failed: %s (grid %d)\n", hipGetErrorString(e), grid);
#else
#ifdef DBG_STAGE
    #ifdef DBG_WEIGHTS
    constexpr int last_ph[6] = {0, 0, 2, 3, 4, 5};
#else
    constexpr int last_ph[6] = {0, 1, 2, 3, 4, 5};
#endif
    for (int p = 0; p <= last_ph[DBG_STAGE]; ++p) { a.ph_lo = p; a.ph_hi = p + 1; hipLaunchKernelGGL(fwd, dim3(grid), dim3(512), LDS_BYTES, stream, a); }
    a.ph_lo = 8; a.ph_hi = 9; hipLaunchKernelGGL(fwd, dim3(grid), dim3(512), LDS_BYTES, stream, a);
#else
    for (int p = 0; p < NPHASE; ++p) {
        a.ph_lo = p; a.ph_hi = p + 1;
        hipLaunchKernelGGL(fwd, dim3(grid), dim3(512), LDS_BYTES, stream, a);
    }
#endif
#endif
}
```

```cpp
#define N_LAUNCH_MODE 1
#include <hip/hip_runtime.h>
#include <hip/hip_cooperative_groups.h>
#include <cstdio>
#include <cstdint>
namespace cg = cooperative_groups;

__device__ __forceinline__ int lane_id_v() { int l; asm volatile("v_mbcnt_lo_u32_b32 %0, -1, 0\n\tv_mbcnt_hi_u32_b32 %0, -1, %0" : "=v"(l)); return l; }
namespace pg8 {
#define PG8_LAS __attribute__((address_space(3)))
typedef unsigned short bf16_t;
typedef short bf16x8 __attribute__((ext_vector_type(8)));
typedef float f32x4 __attribute__((ext_vector_type(4)));
typedef unsigned u32x4 __attribute__((ext_vector_type(4)));
constexpr int BM = 256, BK = 64, HALF = 128, HTB = HALF * BK * 2  , STAGE_BYTES = 8 * HTB, NXCD = 8, WGM = 8;

__host__ __device__ __forceinline__ int lds_byte(int r, int c) { const int st = (r >> 4) * 2 + (c >> 5), rr = r & 15, cc = c & 31, ob = rr * 64 + cc * 2; return st * 1024 + (ob ^ (((ob >> 9) & 1) << 5)); }
__host__ __device__ __forceinline__ void stage_rc(int b, int& R, int& C) { const int st = b / 1024, sb = b % 1024, swz = sb ^ (((sb >> 9) & 1) << 5); R = (st >> 1) * 16 + swz / 64; C = (st & 1) * 32 + (swz % 64) / 2; }
__host__ __device__ __forceinline__ int perm32(int rho) { const int n = rho >> 4, i = rho & 15; return 8 * (i >> 2) + 4 * n + (i & 3); }

struct Unit { int pm, pn, z; };
struct Gemm { const bf16_t* A; const bf16_t* Bt; int M, N, K; long zA, zB; };

struct StaticOrder {
    int nM, nN, nwg, G, c;
    __host__ __device__ void init(int M, int N, int G_, int c_) { nM = M / BM; nN = N / BM; nwg = nM * nN; G = G_; c = c_; }
    __host__ __device__ bool next(int i, Unit& u) const {
        const long L = (long)i * G + c; if (L >= nwg) return false;
        int wgid = (int)L; { const int q = nwg / NXCD, r = nwg % NXCD, xcd = wgid % NXCD, off = wgid / NXCD; wgid = (xcd < r ? xcd * (q + 1) : r * (q + 1) + (xcd - r) * q) + off; }
        const int nig = WGM * nN, gid = wgid / nig, fm = gid * WGM, gsz = (nM - fm) < WGM ? (nM - fm) : WGM;
        u.pm = fm + ((wgid % nig) % gsz); u.pn = (wgid % nig) / gsz; u.z = 0; return true;
    }
    __device__ __forceinline__ void a_ready(const Unit&) const {}
    __device__ __forceinline__ void done(const Unit&) const {}
};

typedef float f32x2_t __attribute__((ext_vector_type(2))); typedef __bf16 bf16x2_t __attribute__((ext_vector_type(2)));
__device__ __forceinline__ unsigned cvt_pk_bf16(float lo, float hi) { f32x2_t v = {lo, hi}; bf16x2_t b = __builtin_convertvector(v, bf16x2_t); return __builtin_bit_cast(unsigned, b); }

__device__ __forceinline__ float bf2f(unsigned short u) { return __uint_as_float((unsigned)u << 16); }
__device__ __forceinline__ float sigmoidf_(float v) { return __builtin_amdgcn_rcpf(1.0f + __builtin_amdgcn_exp2f(-1.4426950408889634f * v)); }
template <int MODE> __device__ __forceinline__ float act_(float v, float b) {
    if (MODE == 1) return v * sigmoidf_(v);
    if (MODE == 2) return sigmoidf_(v + b);
    return v;
}
struct EpiProj {
    static constexpr bool PERM = true, AFTER_DRAIN = false;
    bf16_t* O; int ldc; bf16_t* O1; int ldc1; const float* bgate; int gate_tile0;
    template <int MODE> __device__ __forceinline__ void put(const f32x4 (&acc)[2][2][4][2], bf16_t* base, int ld, int row0, int col0, const float* bias) const {
        f32x4 bv[2][2];
#pragma unroll
        for (int bj = 0; bj < 2; ++bj)
#pragma unroll
            for (int n = 0; n < 2; ++n) bv[bj][n] = (MODE == 2) ? *(const f32x4*)(bias + bj * HALF + 4 * n) : (f32x4){0.f, 0.f, 0.f, 0.f};
#pragma unroll
        for (int ai = 0; ai < 2; ++ai)
#pragma unroll
            for (int m = 0; m < 4; ++m) { bf16_t* rowp = base + (size_t)(row0 + ai * HALF + m * 16) * ld + col0;
#pragma unroll
                for (int bj = 0; bj < 2; ++bj) { f32x4 v0 = acc[ai][bj][m][0], v1 = acc[ai][bj][m][1];
#pragma unroll
                    for (int e = 0; e < 4; ++e) { v0[e] = act_<MODE>(v0[e], bv[bj][0][e]); v1[e] = act_<MODE>(v1[e], bv[bj][1][e]); }
                    u32x4 w; w.x = cvt_pk_bf16(v0[0], v0[1]); w.y = cvt_pk_bf16(v0[2], v0[3]); w.z = cvt_pk_bf16(v1[0], v1[1]); w.w = cvt_pk_bf16(v1[2], v1[3]);
                    *(u32x4*)(rowp + bj * HALF) = w; } }
    }
    __device__ __forceinline__ void operator()(const f32x4 (&acc)[2][2][4][2], const Unit& u, int wr, int wc, int fr, int fq) const {
        const int row0 = u.pm * BM + wr * 64 + fr, col0 = u.pn * BM + wc * 32 + 8 * fq;
        if (u.z == 1) { put<0>(acc, O1, ldc1, row0, col0, nullptr); return; }
        const int t = u.pn;
        const bool is_silu = (t >= 12 && t < 16) || (t >= 32 && t < 36) || (t >= 40 && t < 44);
        if (t >= gate_tile0 && t < 68) put<2>(acc, O, ldc, row0, col0, bgate + (col0 - gate_tile0 * BM));
        else if (is_silu) put<1>(acc, O, ldc, row0, col0, nullptr);
        else put<0>(acc, O, ldc, row0, col0, nullptr);
    }
};
struct EpiMerge {
    static constexpr bool PERM = true, AFTER_DRAIN = false;
    const bf16_t* G; int ldg;
    float* T; bf16_t* O; int ldc;
    __device__ __forceinline__ void operator()(const f32x4 (&acc)[2][2][4][2], const Unit& u, int wr, int wc, int fr, int fq) const {
        const int row0 = u.pm * BM + wr * 64 + fr, col0 = u.pn * BM + wc * 32 + 8 * fq;
#pragma unroll
        for (int ai = 0; ai < 2; ++ai)
#pragma unroll
            for (int m = 0; m < 4; ++m) { const size_t row = (size_t)(row0 + ai * HALF + m * 16);
#pragma unroll
                for (int bj = 0; bj < 2; ++bj) { const int col = col0 + bj * HALF;
                    const u32x4 gw = *(const u32x4*)(G + row * ldg + (size_t)u.z * 2048 + col);
                    f32x4 g0, g1;
                    g0[0] = __uint_as_float(gw.x << 16); g0[1] = __uint_as_float(gw.x & 0xffff0000u); g0[2] = __uint_as_float(gw.y << 16); g0[3] = __uint_as_float(gw.y & 0xffff0000u);
                    g1[0] = __uint_as_float(gw.z << 16); g1[1] = __uint_as_float(gw.z & 0xffff0000u); g1[2] = __uint_as_float(gw.w << 16); g1[3] = __uint_as_float(gw.w & 0xffff0000u);
                    f32x4 v0 = acc[ai][bj][m][0] * g0, v1 = acc[ai][bj][m][1] * g1;
                    float* tp = T + row * ldc + col;
                    if (u.z > 0) { v0 += __builtin_nontemporal_load((const f32x4*)tp); v1 += __builtin_nontemporal_load((const f32x4*)(tp + 4)); }
                    if (u.z < 2) { *(f32x4*)tp = v0; *(f32x4*)(tp + 4) = v1; }
                    else { u32x4 w; w.x = cvt_pk_bf16(v0[0], v0[1]); w.y = cvt_pk_bf16(v0[2], v0[3]); w.z = cvt_pk_bf16(v1[0], v1[1]); w.w = cvt_pk_bf16(v1[2], v1[3]);
                        *(u32x4*)(O + row * ldc + col) = w; } } }
    }
};
struct EpiOut {
    static constexpr bool PERM = false, AFTER_DRAIN = false;
    const float* X; float* Y; int ldc; float* part; int M;
    __device__ __forceinline__ void operator()(const f32x4 (&acc)[2][2][4][2], const Unit& u, int wr, int wc, int fr, int fq) const {
        const int row0 = u.pm * BM + wr * 64 + fr, col0 = u.pn * BM + wc * 32 + 4 * fq;
#pragma unroll
        for (int ai = 0; ai < 2; ++ai)
#pragma unroll
            for (int m = 0; m < 4; ++m) { const size_t row = (size_t)(row0 + ai * HALF + m * 16); float ss = 0.f;
#pragma unroll
                for (int bj = 0; bj < 2; ++bj)
#pragma unroll
                    for (int n = 0; n < 2; ++n) { const size_t off = row * ldc + col0 + bj * HALF + n * 16;
                        const f32x4 y = *(const f32x4*)(X + off) + acc[ai][bj][m][n]; *(f32x4*)(Y + off) = y;
                        ss += (y[0] * y[0] + y[1] * y[1]) + (y[2] * y[2] + y[3] * y[3]); }
                ss += __shfl_xor(ss, 16); ss += __shfl_xor(ss, 32);
                if (fq == 0) part[(size_t)(u.pn * 4 + wc) * M + row] = ss; }
    }
};
struct ProjOrder {
    StaticOrder so; int nmain, extra;
    __device__ void init(int M, int N, int G, int c) { so.init(M, N, G, c); nmain = (so.nwg - c + G - 1) / G; extra = (c >= G - 8) ? c - (G - 8) : -1; }
    __device__ bool next(int i, Unit& u) const {
        if (i < nmain) return so.next(i, u);
        if (i == nmain && extra >= 0) { u.pm = 0; u.pn = extra; u.z = 1; return true; }
        return false;
    }
    __device__ __forceinline__ void a_ready(const Unit&) const {}
    __device__ __forceinline__ void done(const Unit&) const {}
};
struct MergeOrder {
    StaticOrder so;
    __device__ void init(int M, int N, int G, int c) { so.init(M, N, G, c); }
    __device__ bool next(int i, Unit& u) const { if (i >= 3) return false; if (!so.next(0, u)) return false; u.z = i; return true; }
    __device__ __forceinline__ void a_ready(const Unit&) const {}
    __device__ __forceinline__ void done(const Unit&) const {}
};

template <class Epi, class Sched, bool ALIGN_EPI = false, bool SP2 = false>
__device__ __forceinline__ void gemm_phase(PG8_LAS unsigned char* lds, const Gemm g, const Sched& S, const Epi& E, const int wid  ) {
    const int lane = lane_id_v(), tid = wid * 64 + lane, wr = wid >> 2, wc = wid & 3, fr = lane & 15, fq = lane >> 4;
    const int K = g.K, nt = K / BK;
    unsigned voffA[2], voffB[2];
#pragma unroll
    for (int i = 0; i < 2; ++i) { int R, C; stage_rc(tid * 16 + i * 8192, R, C); const int Rb = Epi::PERM ? ((R & ~31) + perm32(R & 31)) : R;
        voffA[i] = (unsigned)(R * K + C) * 2u; voffB[i] = (unsigned)(Rb * K + C) * 2u; }
    const size_t kstep = (size_t)(BK * 2);
    const size_t hstep = (size_t)HALF * K * 2;
    const size_t tstep = 2 * hstep;
    const unsigned ldsw = (unsigned)wid * 1024u;
    const int aoff = lds_byte(wr * 64 + fr, fq * 8), boff = lds_byte(wc * 32 + fr, fq * 8);
#define PG8_SA(b, h) (((b) * 2 + (h)) * HTB)
#define PG8_SB(b, h) ((4 + (b) * 2 + (h)) * HTB)
#define PG8_STAGE(bufoff, gbase, voff) do { _Pragma("unroll") for (int _i = 0; _i < 2; ++_i) \
        __builtin_amdgcn_global_load_lds((const unsigned*)((const char*)(gbase) + (voff)[_i]), (PG8_LAS unsigned*)(lds + (bufoff) + ldsw + _i * 8192), 16, 0, 0); } while (0)
#define PG8_LDA(dst, b, h) do { _Pragma("unroll") for (int m = 0; m < 4; ++m) _Pragma("unroll") for (int k = 0; k < 2; ++k) dst[m][k] = *(const PG8_LAS bf16x8*)(lds + PG8_SA(b, h) + aoff + m * 2048 + k * 1024); } while (0)
#define PG8_LDB(dst, b, h) do { _Pragma("unroll") for (int n = 0; n < 2; ++n) _Pragma("unroll") for (int k = 0; k < 2; ++k) dst[n][k] = *(const PG8_LAS bf16x8*)(lds + PG8_SB(b, h) + boff + n * 2048 + k * 1024); } while (0)
#define PG8_MMA(ai, bj, At, Bt) do { __builtin_amdgcn_s_setprio(1); _Pragma("unroll") for (int m = 0; m < 4; ++m) _Pragma("unroll") for (int n = 0; n < 2; ++n) _Pragma("unroll") for (int k = 0; k < 2; ++k) \
        acc[ai][bj][m][n] = __builtin_amdgcn_mfma_f32_16x16x32_bf16(Bt[n][k], At[m][k], acc[ai][bj][m][n], 0, 0, 0); __builtin_amdgcn_s_setprio(0); } while (0)
#define PG8_WAIT_V(n) asm volatile("s_waitcnt vmcnt(" #n ")" ::: "memory")
#define PG8_WAIT_L(n) asm volatile("s_waitcnt lgkmcnt(" #n ")" ::: "memory")
#define PG8_BAR __builtin_amdgcn_s_barrier()
#define PG8_SCHED __builtin_amdgcn_sched_barrier(0)
    Unit cur, nxt; int ui = 0;
    if (!S.next(0, cur)) return;
    f32x4 acc[2][2][4][2];
#pragma unroll
    for (int a = 0; a < 2; ++a)
#pragma unroll
        for (int b = 0; b < 2; ++b)
#pragma unroll
            for (int m = 0; m < 4; ++m)
#pragma unroll
                for (int n = 0; n < 2; ++n) acc[a][b][m][n] = (f32x4){0.f, 0.f, 0.f, 0.f};
    bf16x8 At[4][2], B0[2][2], B1[2][2];
    const char* cA = (const char*)g.A + (long)cur.z * g.zA + (size_t)cur.pm * tstep; const char* cB = (const char*)g.Bt + (long)cur.z * g.zB + (size_t)cur.pn * tstep;
    S.a_ready(cur);
    if constexpr (SP2) {
        PG8_STAGE(PG8_SB(0, 0), cB, voffB); PG8_STAGE(PG8_SB(0, 1), cB + hstep, voffB); PG8_STAGE(PG8_SA(0, 0), cA, voffA); PG8_STAGE(PG8_SA(0, 1), cA + hstep, voffA);
        if (wr == 1) PG8_BAR;
        PG8_WAIT_V(2); PG8_BAR;
        PG8_STAGE(PG8_SB(1, 0), cB + kstep, voffB); PG8_STAGE(PG8_SA(1, 0), cA + kstep, voffA); PG8_STAGE(PG8_SB(1, 1), cB + hstep + kstep, voffB);
        PG8_WAIT_V(6); PG8_BAR;
    } else {
        PG8_STAGE(PG8_SB(0, 0), cB, voffB); PG8_STAGE(PG8_SA(0, 0), cA, voffA); PG8_STAGE(PG8_SB(0, 1), cB + hstep, voffB); PG8_STAGE(PG8_SA(0, 1), cA + hstep, voffA);
        if (wr == 1) PG8_BAR;
        PG8_WAIT_V(4); PG8_BAR;
        PG8_STAGE(PG8_SB(1, 0), cB + kstep, voffB); PG8_STAGE(PG8_SA(1, 0), cA + kstep, voffA); PG8_STAGE(PG8_SB(1, 1), cB + hstep + kstep, voffB);
        PG8_WAIT_V(6); PG8_BAR;
    }
    for (;;) {
        const bool has_next = S.next(ui + 1, nxt);
        const char* nA = has_next ? (const char*)g.A + (long)nxt.z * g.zA + (size_t)nxt.pm * tstep : cA; const char* nB = has_next ? (const char*)g.Bt + (long)nxt.z * g.zB + (size_t)nxt.pn * tstep : cB;
        for (int t = 0; t < nt; t += 2) {
            const bool last = (t == nt - 2);
            const char* a1 = cA + (size_t)(t + 1) * kstep;
            const char* a2 = last ? nA : cA + (size_t)(t + 2) * kstep; const char* b2 = last ? nB : cB + (size_t)(t + 2) * kstep;
            const char* a3 = a2 + kstep; const char* b3 = b2 + kstep;
            if (last && has_next) S.a_ready(nxt);
            if constexpr (SP2) {
            PG8_LDB(B0, 0, 0); PG8_LDB(B1, 0, 1); PG8_SCHED; PG8_LDA(At, 0, 0); PG8_STAGE(PG8_SA(1, 1), a1 + hstep, voffA);
            PG8_WAIT_V(8); PG8_WAIT_L(0); PG8_BAR; PG8_MMA(0, 0, At, B0); PG8_MMA(0, 1, At, B1); PG8_BAR; PG8_SCHED;
            PG8_LDA(At, 0, 1); PG8_STAGE(PG8_SB(0, 0), b2, voffB); PG8_STAGE(PG8_SB(0, 1), b2 + hstep, voffB); PG8_STAGE(PG8_SA(0, 0), a2, voffA);
            PG8_WAIT_V(8); PG8_WAIT_L(0); PG8_BAR; PG8_MMA(1, 0, At, B0); PG8_MMA(1, 1, At, B1); PG8_BAR; PG8_SCHED;
            PG8_LDB(B0, 1, 0); PG8_LDB(B1, 1, 1); PG8_SCHED; PG8_LDA(At, 1, 0); PG8_STAGE(PG8_SA(0, 1), a2 + hstep, voffA);
            PG8_WAIT_V(8); PG8_WAIT_L(0); PG8_BAR; PG8_MMA(0, 0, At, B0); PG8_MMA(0, 1, At, B1); PG8_BAR; PG8_SCHED;
            PG8_LDA(At, 1, 1); PG8_STAGE(PG8_SB(1, 0), b3, voffB); PG8_STAGE(PG8_SB(1, 1), b3 + hstep, voffB); PG8_STAGE(PG8_SA(1, 0), a3, voffA);
            PG8_WAIT_V(8); PG8_WAIT_L(0); PG8_BAR; PG8_MMA(1, 0, At, B0); PG8_MMA(1, 1, At, B1); PG8_BAR; PG8_SCHED;
            } else {
            PG8_LDB(B0, 0, 0); PG8_SCHED; PG8_LDA(At, 0, 0); PG8_STAGE(PG8_SA(1, 1), a1 + hstep, voffA);
            PG8_WAIT_L(8); PG8_BAR; PG8_WAIT_L(0); PG8_MMA(0, 0, At, B0); PG8_BAR; PG8_SCHED;
            PG8_LDB(B1, 0, 1); PG8_STAGE(PG8_SB(0, 0), b2, voffB);
            PG8_BAR; PG8_WAIT_L(0); PG8_MMA(0, 1, At, B1); PG8_BAR;
            PG8_LDA(At, 0, 1); PG8_STAGE(PG8_SA(0, 0), a2, voffA);
            PG8_BAR; PG8_WAIT_L(0); PG8_MMA(1, 0, At, B0); PG8_BAR; PG8_SCHED;
            PG8_STAGE(PG8_SB(0, 1), b2 + hstep, voffB);
            PG8_WAIT_V(6); PG8_BAR; PG8_MMA(1, 1, At, B1); PG8_BAR;
            PG8_LDB(B0, 1, 0); PG8_SCHED; PG8_LDA(At, 1, 0); PG8_STAGE(PG8_SA(0, 1), a2 + hstep, voffA);
            PG8_WAIT_L(8); PG8_BAR; PG8_WAIT_L(0); PG8_MMA(0, 0, At, B0); PG8_BAR; PG8_SCHED;
            PG8_LDB(B1, 1, 1); PG8_STAGE(PG8_SB(1, 0), b3, voffB);
            PG8_BAR; PG8_WAIT_L(0); PG8_MMA(0, 1, At, B1); PG8_BAR;
            PG8_LDA(At, 1, 1); PG8_STAGE(PG8_SA(1, 0), a3, voffA);
            PG8_BAR; PG8_WAIT_L(0); PG8_MMA(1, 0, At, B0); PG8_BAR; PG8_SCHED;
            PG8_STAGE(PG8_SB(1, 1), b3 + hstep, voffB);
            PG8_WAIT_V(6); PG8_BAR; PG8_MMA(1, 1, At, B1); PG8_BAR;
            }
        }
        if constexpr (ALIGN_EPI) { if (wr == 0) PG8_BAR; }
        if constexpr (!Epi::AFTER_DRAIN) { E(acc, cur, wr, wc, fr, fq); S.done(cur); }
        if (!has_next) break;
#pragma unroll
        for (int a = 0; a < 2; ++a)
#pragma unroll
            for (int b = 0; b < 2; ++b)
#pragma unroll
                for (int m = 0; m < 4; ++m)
#pragma unroll
                    for (int n = 0; n < 2; ++n) acc[a][b][m][n] = (f32x4){0.f, 0.f, 0.f, 0.f};
        cur = nxt; cA = nA; cB = nB; ++ui;
        if constexpr (ALIGN_EPI) { if (wr == 1) PG8_BAR; }
    }
    PG8_WAIT_V(0);
    if constexpr (!ALIGN_EPI) { if (wr == 0) PG8_BAR; }
    PG8_BAR;
    if constexpr (Epi::AFTER_DRAIN) { E.fused(acc, cur, wr, wc, fr, fq, lds, wid, lane); S.done(cur); }
#undef PG8_SA
#undef PG8_SB
#undef PG8_STAGE
#undef PG8_LDA
#undef PG8_LDB
#undef PG8_MMA
#undef PG8_WAIT_V
#undef PG8_WAIT_L
#undef PG8_BAR
#undef PG8_SCHED
}
}

constexpr int S = 8192, DM = 2048, DIN = 17488, NPAD = 17664, NMEM = 256;
constexpr int C_QA = 0, C_KA = 1024, C_VA = 2048, C_ZA = 3072, C_QI = 4096, C_QB = 5120, C_KB = 6144, C_VB = 7168, C_ZB = 8192, C_QM = 9216, C_ZM = 10240, C_GL = 11264, C_KI = 17408, C_WI = 17472;
constexpr int TOPK = 256;
constexpr float RMS_EPS = 1e-6f;
constexpr size_t MiB = 1u << 20;
constexpr size_t WS_CTL = 0;
constexpr size_t WS_WTIN = 1 * MiB;
constexpr size_t WS_U = 1 * MiB;
constexpr size_t WS_WTMKV = 70 * MiB;
constexpr size_t WS_WTBR = 78 * MiB;
constexpr size_t WS_WTOUT = 90 * MiB;
constexpr size_t WS_MEMN = 98 * MiB;
constexpr size_t WS_MKV = 99 * MiB;
constexpr size_t WS_PROJ = 100 * MiB;
constexpr size_t WS_SC = 376 * MiB;
constexpr size_t WS_MERGED = 376 * MiB;
constexpr size_t WS_H = 376 * MiB;
constexpr size_t WS_T = 408 * MiB;
constexpr size_t WS_SEL = 508 * MiB;
constexpr size_t WS_PART = 516 * MiB;
constexpr size_t WS_END = 517 * MiB;

typedef unsigned short bf16_t;
typedef unsigned u32x4 __attribute__((ext_vector_type(4)));
typedef unsigned u32x2 __attribute__((ext_vector_type(2)));
typedef float f32x4 __attribute__((ext_vector_type(4)));
#define LAS __attribute__((address_space(3)))
__device__ __forceinline__ float bf2f(unsigned short u) { return __uint_as_float((unsigned)u << 16); }
__device__ __forceinline__ float bflo(unsigned w) { return __uint_as_float(w << 16); }
__device__ __forceinline__ float bfhi(unsigned w) { return __uint_as_float(w & 0xffff0000u); }
__device__ __forceinline__ unsigned f2bf(float f) { unsigned u = __float_as_uint(f); return (u + 0x7fffu + ((u >> 16) & 1u)) >> 16; }
__device__ __forceinline__ unsigned pk2(float lo, float hi) { return f2bf(lo) | (f2bf(hi) << 16); }
__device__ __forceinline__ float wave_sum(float v) {
#pragma unroll
    for (int o = 1; o < 64; o <<= 1) v += __shfl_xor(v, o);
    return v;
}
__device__ __forceinline__ size_t sc_off(int r) { const size_t i = (size_t)(r >> 8); return 65536ull * (i * (i + 1) / 2) + (size_t)(r & 255) * 256ull * (i + 1); }

struct Args { const float* in[17]; float* out; unsigned char* ws; int ph_lo, ph_hi; };

template <bool MAPIN>
__device__ __forceinline__ void transpose_item(const float* __restrict__ W, int K, int srcN, bf16_t* WT, LAS float* scr, int item, int ndst, int lane) {
    const int nblk = ndst / 32, kb = item / nblk, nb = item % nblk, k0 = 64 * kb, n0 = 32 * nb;
    const int n = n0 + (lane & 31);
    int src = n;
    if (MAPIN) { src = (n < 5120) ? n : (n < 17408) ? n + 80 : (n < 17488) ? n - 17408 + 5120 : -1; }
#pragma unroll 8
    for (int i = 0; i < 32; ++i) { const int kk = 2 * i + (lane >> 5); scr[kk * 33 + (lane & 31)] = (src >= 0) ? W[(size_t)(k0 + kk) * srcN + src] : 0.f; }
    asm volatile("s_waitcnt lgkmcnt(0)" ::: "memory");
    const int c = lane & 7;
#pragma unroll
    for (int j = 0; j < 4; ++j) { const int nn = (lane >> 3) + 8 * j; const LAS float* s = scr + (8 * c) * 33 + nn;
        u32x4 o; o.x = pk2(s[0 * 33], s[1 * 33]); o.y = pk2(s[2 * 33], s[3 * 33]); o.z = pk2(s[4 * 33], s[5 * 33]); o.w = pk2(s[6 * 33], s[7 * 33]);
        *(u32x4*)(WT + (size_t)(n0 + nn) * K + k0 + 8 * c) = o; }
    asm volatile("s_waitcnt lgkmcnt(0)" ::: "memory");
}
__device__ __forceinline__ void rms_row_to_bf16(const float* __restrict__ xrow, const float* __restrict__ g, bf16_t* orow, int lane) {
    const f32x4* xr = (const f32x4*)xrow + lane; const f32x4* gr = (const f32x4*)g + lane;
    f32x4 v[8]; float s = 0.f;
#pragma unroll
    for (int j = 0; j < 8; ++j) { v[j] = xr[64 * j]; s += (v[j].x * v[j].x + v[j].y * v[j].y) + (v[j].z * v[j].z + v[j].w * v[j].w); }
    const float rs = 1.0f / sqrtf(wave_sum(s) * (1.f / DM) + RMS_EPS);
    u32x2* o8 = (u32x2*)orow + lane;
#pragma unroll
    for (int j = 0; j < 8; ++j) { const f32x4 gg = gr[64 * j]; u32x2 w; w.x = pk2(v[j].x * rs * gg.x, v[j].y * rs * gg.y); w.y = pk2(v[j].z * rs * gg.z, v[j].w * rs * gg.w); o8[64 * j] = w; }
}
__device__ __forceinline__ void p0_prologue(const Args& a, LAS unsigned char* lds, int blk, int nblk, const int wave) {
    const int lane = lane_id_v(), tid = wave * 64 + lane;
    LAS float* scr = (LAS float*)(lds + wave * 16384);
    const int gw = blk * 8 + wave, NGW = nblk * 8;
    unsigned char* ws = a.ws;
    constexpr int I_IN = (DM / 64) * (NPAD / 32), I_MKV = (DM / 64) * (2048 / 32), I_BR = (1024 / 64) * (2048 / 32), I_OUT = (DM / 64) * (2048 / 32);
    constexpr int NITEMS = I_IN + I_MKV + 3 * I_BR + I_OUT;
    for (int it = gw; it < NITEMS; it += NGW) {
        int r = it;
        if (r < I_IN) { transpose_item<true>(a.in[3], DM, DIN, (bf16_t*)(ws + WS_WTIN), scr, r, NPAD, lane); continue; } r -= I_IN;
        if (r < I_MKV) { transpose_item<false>(a.in[11], DM, 2048, (bf16_t*)(ws + WS_WTMKV), scr, r, 2048, lane); continue; } r -= I_MKV;
        if (r < 3 * I_BR) { const int z = r / I_BR; transpose_item<false>(a.in[12 + z], 1024, 2048, (bf16_t*)(ws + WS_WTBR) + (size_t)z * 2048 * 1024, scr, r % I_BR, 2048, lane); continue; } r -= 3 * I_BR;
        transpose_item<false>(a.in[15], DM, 2048, (bf16_t*)(ws + WS_WTOUT), scr, r, 2048, lane);
    }
    bf16_t* H = (bf16_t*)(ws + WS_H);
    for (int m = gw; m < S + NMEM; m += NGW) {
        if (m < S) rms_row_to_bf16(a.in[0] + (size_t)m * DM, a.in[2], H + (size_t)m * DM, lane);
        else rms_row_to_bf16(a.in[1] + (size_t)(m - S) * DM, a.in[10], (bf16_t*)(ws + WS_MEMN) + (size_t)(m - S) * DM, lane);
    }
    if (blk == 0 && wave == 0) {
        const float s1 = wave_sum(a.in[5][lane] * a.in[6][lane]), s2 = wave_sum(a.in[7][lane] * a.in[8][lane]);
        if (lane == 0) ((float*)(ws + WS_CTL))[0] = expf(s1) - expf(s2) + 0.2f;
    }
}

__device__ __forceinline__ void idx_scores_naive(const bf16_t* __restrict__ PROJ, float* SC, LAS unsigned char* lds, int blk, int nblk, const int wave) {
    const int lane = lane_id_v(), tid = wave * 64 + lane;
    LAS float* qs = (LAS float*)lds + wave * 1088;
    constexpr int NITEM = 128 * 129 / 2;
    for (int it = blk; it < NITEM; it += nblk) {
        int kb = 0, rem = it; while (rem >= 128 - kb) { rem -= 128 - kb; ++kb; }
        const int qc = kb + rem, s = 64 * kb + lane;
        float kreg[64];
        { const u32x4* kp = (const u32x4*)(PROJ + (size_t)s * NPAD + C_KI);
#pragma unroll
          for (int i = 0; i < 8; ++i) { const u32x4 w = kp[i]; kreg[8 * i + 0] = bflo(w.x); kreg[8 * i + 1] = bfhi(w.x); kreg[8 * i + 2] = bflo(w.y); kreg[8 * i + 3] = bfhi(w.y);
              kreg[8 * i + 4] = bflo(w.z); kreg[8 * i + 5] = bfhi(w.z); kreg[8 * i + 6] = bflo(w.w); kreg[8 * i + 7] = bfhi(w.w); } }
        for (int qq = 0; qq < 8; ++qq) {
            const int q = 64 * qc + wave * 8 + qq;
            { const u32x4* qp = (const u32x4*)(PROJ + (size_t)q * NPAD + C_QI) + 2 * lane;
              const u32x4 w0 = qp[0], w1 = qp[1];
              LAS f32x4* dst = (LAS f32x4*)(qs + 16 * lane);
              dst[0] = (f32x4){bflo(w0.x), bfhi(w0.x), bflo(w0.y), bfhi(w0.y)}; dst[1] = (f32x4){bflo(w0.z), bfhi(w0.z), bflo(w0.w), bfhi(w0.w)};
              dst[2] = (f32x4){bflo(w1.x), bfhi(w1.x), bflo(w1.y), bfhi(w1.y)}; dst[3] = (f32x4){bflo(w1.z), bfhi(w1.z), bflo(w1.w), bfhi(w1.w)};
              if (lane < 16) qs[1024 + lane] = bf2f(PROJ[(size_t)q * NPAD + C_WI + lane]) * 0.25f; }
            asm volatile("s_waitcnt lgkmcnt(0)" ::: "memory"); __builtin_amdgcn_wave_barrier();
            float score = 0.f;
            for (int j = 0; j < 16; ++j) {
                float acc = 0.f; const LAS f32x4* qj = (const LAS f32x4*)(qs + 64 * j);
#pragma unroll
                for (int d = 0; d < 16; ++d) { const f32x4 qv = qj[d]; acc += qv.x * kreg[4 * d] + qv.y * kreg[4 * d + 1] + qv.z * kreg[4 * d + 2] + qv.w * kreg[4 * d + 3]; }
                score += fmaxf(acc * 0.125f, 0.f) * qs[1024 + j];
            }
            if (s <= q) SC[sc_off(q) + s] = score;
            asm volatile("s_waitcnt lgkmcnt(0)" ::: "memory"); __builtin_amdgcn_wave_barrier();
        }
    }
}
__device__ __forceinline__ unsigned ordkey(float f) { const unsigned u = __float_as_uint(f); return (u & 0x80000000u) ? ~u : (u | 0x80000000u); }
__device__ __forceinline__ void topk_select(const float* SC, int* SEL, LAS unsigned char* lds, int blk, int nblk, const int wave) {
    const int lane = lane_id_v(), tid = wave * 64 + lane;
    LAS unsigned* hist = (LAS unsigned*)lds + wave * 256;
    for (int r = blk * 8 + wave; r < S; r += nblk * 8) {
        const int n = r + 1; unsigned long long* mrow = (unsigned long long*)SEL + (size_t)r * 128;
        unsigned long long w0 = 0ull, w1 = 0ull;
        const int nwords = 4 * ((r >> 8) + 1);
        if (n <= TOPK) { const int lo = 64 * lane; w0 = (r < lo) ? 0ull : ((r - lo >= 63) ? ~0ull : ((2ull << (r - lo)) - 1ull)); }
        else {
        const float* row = SC + sc_off(r);
        unsigned prefix = 0u; int remaining = TOPK;
        for (int pass = 0; pass < 4; ++pass) {
            const int shift = 24 - 8 * pass;
#pragma unroll
            for (int i = 0; i < 4; ++i) hist[lane + 64 * i] = 0u;
            asm volatile("s_waitcnt lgkmcnt(0)" ::: "memory"); __builtin_amdgcn_wave_barrier();
            for (int i = lane; i < n; i += 64) { const unsigned u = ordkey(row[i]);
                if (pass == 0 || (u >> (shift + 8)) == prefix) atomicAdd((unsigned*)&hist[(u >> shift) & 255u], 1u); }
            asm volatile("s_waitcnt lgkmcnt(0)" ::: "memory"); __builtin_amdgcn_wave_barrier();
            const unsigned c0 = hist[4 * lane], c1 = hist[4 * lane + 1], c2 = hist[4 * lane + 2], c3 = hist[4 * lane + 3];
            const unsigned mine = c0 + c1 + c2 + c3;
            unsigned suf = mine;
#pragma unroll
            for (int o = 1; o < 64; o <<= 1) { const unsigned t = __shfl_down(suf, o); if (lane + o < 64) suf += t; }
            const unsigned long long bal = __ballot(suf >= (unsigned)remaining);
            const int Ls = 63 - __builtin_clzll(bal);
            const unsigned above = __shfl(suf, Ls) - __shfl(mine, Ls);
            const unsigned b3 = __shfl(c3, Ls), b2 = __shfl(c2, Ls), b1 = __shfl(c1, Ls);
            unsigned rem = (unsigned)remaining - above; int bin;
            if (rem <= b3) { bin = 4 * Ls + 3; } else { rem -= b3; if (rem <= b2) { bin = 4 * Ls + 2; } else { rem -= b2; if (rem <= b1) { bin = 4 * Ls + 1; } else { rem -= b1; bin = 4 * Ls; } } }
            prefix = (prefix << 8) | (unsigned)bin; remaining = (int)rem;
            asm volatile("s_waitcnt lgkmcnt(0)" ::: "memory"); __builtin_amdgcn_wave_barrier();
        }
        int eqc = 0; const unsigned long long lt = (lane == 0) ? 0ull : (~0ull >> (64 - lane));
        for (int base = 0, it = 0; base < n; base += 64, ++it) {
            const int i = base + lane; const unsigned u = (i < n) ? ordkey(row[i]) : 0u;
            const bool gt = (i < n) && (u > prefix), eq = (i < n) && (u == prefix);
            const unsigned long long be = __ballot(eq);
            const bool take = gt || (eq && (eqc + __builtin_popcountll(be & lt) < remaining));
            const unsigned long long bs = __ballot(take);
            if ((it & 63) == lane) { if (it < 64) w0 = bs; else w1 = bs; }
            eqc += __builtin_popcountll(be);
        }
        }
        if (lane < nwords) mrow[lane] = w0;
        if (64 + lane < nwords) mrow[64 + lane] = w1;
    }
}
template <int DQ, int DV, bool GATHER>
__device__ __forceinline__ void naive_attn(const bf16_t* __restrict__ qp, const bf16_t* __restrict__ kb, const bf16_t* __restrict__ vb, size_t kvpitch,
                                           int nkeys, int nmax, const int* __restrict__ sel, int r, float scale, float slope, float (&o)[DV / 8]) {
    constexpr int QN = DQ / 8, VN = DV / 8;
    float q[QN];
#pragma unroll
    for (int i = 0; i < QN / 2; ++i) { const unsigned w = ((const unsigned*)qp)[i]; q[2 * i] = bflo(w) * scale; q[2 * i + 1] = bfhi(w) * scale; }
#pragma unroll
    for (int i = 0; i < VN; ++i) o[i] = 0.f;
    float m = -1e30f, l = 0.f;
    for (int i = 0; i < nmax; ++i) {
        bool valid = i < nkeys; int key = i;
        if (GATHER) { key = sel[valid ? i : 0]; valid = valid && key >= 0; }
        if (!valid) key = 0;
        const unsigned* kp = (const unsigned*)(kb + (size_t)key * kvpitch);
        float d = 0.f;
#pragma unroll
        for (int j = 0; j < QN / 2; ++j) { const unsigned w = kp[j]; d += q[2 * j] * bflo(w) + q[2 * j + 1] * bfhi(w); }
        d += __shfl_xor(d, 1); d += __shfl_xor(d, 2); d += __shfl_xor(d, 4);
        const float logit = d - slope * (float)(r - key);
        if (valid) {
            if (logit > m) { const float c = __expf(m - logit); l *= c;
#pragma unroll
                for (int j = 0; j < VN; ++j) o[j] *= c;
                m = logit; }
            const float p = __expf(logit - m); l += p;
            const unsigned* vp = (const unsigned*)(vb + (size_t)key * kvpitch);
#pragma unroll
            for (int j = 0; j < VN / 2; ++j) { const unsigned w = vp[j]; o[2 * j] += p * bflo(w); o[2 * j + 1] += p * bfhi(w); }
        }
    }
    const float il = 1.0f / l;
#pragma unroll
    for (int j = 0; j < VN; ++j) o[j] *= il;
}
__device__ __forceinline__ void attn_b_naive(const Args& a, int blk, int nblk, const int wave) {
    const int lane = lane_id_v(), tid = wave * 64 + lane, sub = lane & 7;
    const bf16_t* PROJ = (const bf16_t*)(a.ws + WS_PROJ); bf16_t* UB = (bf16_t*)(a.ws + WS_U) + (size_t)1 * S * 1024;
    const float lam = ((const float*)(a.ws + WS_CTL))[0];
    for (int wi = blk * 8 + wave; wi < 1024 * 8; wi += nblk * 8) {
        const int h = wi & 7, rg = wi >> 3, r = rg * 8 + (lane >> 3), nmax = rg * 8 + 8;
        const float slope = exp2f(-(float)(h + 1));
        float o0[16], o1[16];
        const bf16_t* rowp = PROJ + (size_t)r * NPAD;
        naive_attn<64, 128, false>(rowp + C_QB + h * 128 + sub * 8, PROJ + C_KB + h * 128 + sub * 8, PROJ + C_VB + h * 128 + sub * 16, NPAD, r + 1, nmax, nullptr, r, 0.125f, slope, o0);
        naive_attn<64, 128, false>(rowp + C_QB + h * 128 + 64 + sub * 8, PROJ + C_KB + h * 128 + 64 + sub * 8, PROJ + C_VB + h * 128 + sub * 16, NPAD, r + 1, nmax, nullptr, r, 0.125f, slope, o1);
        float ss = 0.f;
#pragma unroll
        for (int j = 0; j < 16; ++j) { o0[j] -= lam * o1[j]; ss += o0[j] * o0[j]; }
        ss += __shfl_xor(ss, 1); ss += __shfl_xor(ss, 2); ss += __shfl_xor(ss, 4);
        const float rs = 1.0f / sqrtf(ss * (1.f / 128.f) + RMS_EPS) * 0.8f;
        const float* g = a.in[9] + sub * 16; const bf16_t* zp = rowp + C_ZB + h * 128 + sub * 16;
        unsigned w[8];
#pragma unroll
        for (int j = 0; j < 8; ++j) w[j] = pk2(o0[2 * j] * rs * g[2 * j] * bf2f(zp[2 * j]), o0[2 * j + 1] * rs * g[2 * j + 1] * bf2f(zp[2 * j + 1]));
        u32x4* dst = (u32x4*)(UB + (size_t)r * 1024 + h * 128 + sub * 16);
        dst[0] = (u32x4){w[0], w[1], w[2], w[3]}; dst[1] = (u32x4){w[4], w[5], w[6], w[7]};
    }
}
__device__ __forceinline__ void attn_m_naive(const Args& a, int blk, int nblk, const int wave) {
    const int lane = lane_id_v(), tid = wave * 64 + lane, sub = lane & 7;
    const bf16_t* PROJ = (const bf16_t*)(a.ws + WS_PROJ); const bf16_t* MKV = (const bf16_t*)(a.ws + WS_MKV); bf16_t* UM = (bf16_t*)(a.ws + WS_U) + (size_t)2 * S * 1024;
    for (int wi = blk * 8 + wave; wi < 1024 * 4; wi += nblk * 8) {
        const int h = wi & 3, rg = wi >> 2, r = rg * 8 + (lane >> 3);
        float o[32];
        const bf16_t* rowp = PROJ + (size_t)r * NPAD;
        naive_attn<256, 256, false>(rowp + C_QM + h * 256 + sub * 32, MKV + h * 256 + sub * 32, MKV + 1024 + h * 256 + sub * 32, 2048, NMEM, NMEM, nullptr, 0, 0.0625f, 0.f, o);
        const bf16_t* zp = rowp + C_ZM + h * 256 + sub * 32;
        u32x4* dst = (u32x4*)(UM + (size_t)r * 1024 + h * 256 + sub * 32);
#pragma unroll
        for (int j = 0; j < 4; ++j) { u32x4 w;
            w.x = pk2(o[8 * j + 0] * bf2f(zp[8 * j + 0]), o[8 * j + 1] * bf2f(zp[8 * j + 1])); w.y = pk2(o[8 * j + 2] * bf2f(zp[8 * j + 2]), o[8 * j + 3] * bf2f(zp[8 * j + 3]));
            w.z = pk2(o[8 * j + 4] * bf2f(zp[8 * j + 4]), o[8 * j + 5] * bf2f(zp[8 * j + 5])); w.w = pk2(o[8 * j + 6] * bf2f(zp[8 * j + 6]), o[8 * j + 7] * bf2f(zp[8 * j + 7]));
            dst[j] = w; }
    }
}
__device__ __forceinline__ void attn_a_naive(const Args& a, int blk, int nblk, const int wave) {
    const int lane = lane_id_v(), tid = wave * 64 + lane, sub = lane & 7;
    const bf16_t* PROJ = (const bf16_t*)(a.ws + WS_PROJ); const int* SEL = (const int*)(a.ws + WS_SEL); bf16_t* UA = (bf16_t*)(a.ws + WS_U);
    for (int wi = blk * 8 + wave; wi < 1024 * 8; wi += nblk * 8) {
        const int h = wi & 7, rg = wi >> 3, r = rg * 8 + (lane >> 3);
        const float slope = exp2f(-(float)(h + 1));
        float o[16];
        const bf16_t* rowp = PROJ + (size_t)r * NPAD;
        naive_attn<128, 128, true>(rowp + C_QA + h * 128 + sub * 16, PROJ + C_KA + h * 128 + sub * 16, PROJ + C_VA + h * 128 + sub * 16, NPAD, TOPK, TOPK, SEL + (size_t)r * TOPK, r, 0.08838834764831845f, slope, o);
        const bf16_t* zp = rowp + C_ZA + h * 128 + sub * 16;
        unsigned w[8];
#pragma unroll
        for (int j = 0; j < 8; ++j) w[j] = pk2(o[2 * j] * bf2f(zp[2 * j]), o[2 * j + 1] * bf2f(zp[2 * j + 1]));
        u32x4* dst = (u32x4*)(UA + (size_t)r * 1024 + h * 128 + sub * 16);
        dst[0] = (u32x4){w[0], w[1], w[2], w[3]}; dst[1] = (u32x4){w[4], w[5], w[6], w[7]};
    }
}
__device__ __forceinline__ void final_norm(const Args& a, int blk, int nblk, const int wave) {
    const int lane = lane_id_v(), tid = wave * 64 + lane;
    const float* part = (const float*)(a.ws + WS_PART); const f32x4* g = (const f32x4*)a.in[16] + lane;
    for (int r = blk * 8 + wave; r < S; r += nblk * 8) {
        float s = (lane < 32) ? part[(size_t)lane * S + r] : 0.f;
        const float rs = 1.0f / sqrtf(wave_sum(s) * (1.f / DM) + RMS_EPS);
        f32x4* y = (f32x4*)(a.out + (size_t)r * DM) + lane;
#pragma unroll
        for (int j = 0; j < 8; ++j) { f32x4 v = y[64 * j]; const f32x4 gg = g[64 * j]; v = v * rs * gg; y[64 * j] = v; }
    }
}


namespace att {
typedef short bf16x8 __attribute__((ext_vector_type(8)));
typedef short s16x4 __attribute__((ext_vector_type(4)));
typedef float f32x16 __attribute__((ext_vector_type(16)));
typedef float f32x2_t __attribute__((ext_vector_type(2)));
typedef __bf16 bf16x2_t __attribute__((ext_vector_type(2)));
constexpr int SHM_V = 16384, SHM_K = 16384;
constexpr float LOG2E = 1.4426950408889634f;
constexpr float THR2 = 8.f * LOG2E;
#define KSWZ(row, colB) ((row) * 256 + ((colB) ^ (((row) & 7) << 4)))
#define SBAR() __builtin_amdgcn_sched_barrier(0)
__device__ __forceinline__ int crow(int r, int hi) { return (r & 3) + 8 * (r >> 2) + 4 * hi; }
__device__ __forceinline__ unsigned cvtpk(float lo, float hi) { f32x2_t v = {lo, hi}; bf16x2_t b = __builtin_convertvector(v, bf16x2_t); return __builtin_bit_cast(unsigned, b); }
__device__ __forceinline__ int v_st(int k, int c) { const int kk = (k & ~0xC) | ((k & 4) << 1) | ((k & 8) >> 1); return ((kk >> 3) * 4 + (c >> 5)) * 512 + ((kk & 7) * 32 + (c & 31)) * 2; }
__device__ __forceinline__ int v_rd_base(int lane) { return ((lane & 3) << 3) | (((lane >> 2) & 3) << 6) | (((lane >> 4) & 1) << 5) | (((lane >> 5) & 1) << 8); }
constexpr int v_rd_off(int d0, int ks, int half) { return d0 * 512 + ks * 4096 + half * 2048; }
typedef short v4i16_t __attribute__((ext_vector_type(4)));
__device__ __forceinline__ s16x4 tr_read(LAS const unsigned char* p) { return __builtin_bit_cast(s16x4, __builtin_amdgcn_ds_read_tr16_b64_v4i16((LAS v4i16_t*)p)); }

template <int NQ> __device__ __forceinline__ void qkt(f32x16& p0, f32x16& p1, LAS const unsigned char* Ks, const bf16x8* qr, int cbyte0, int r32, int hi) {
  p0 = f32x16{}; p1 = f32x16{};
#pragma unroll
  for (int d0 = 0; d0 < NQ; ++d0) { const int cb = cbyte0 + (d0 * 16 + hi * 8) * 2;
    const bf16x8 b0 = *(LAS const bf16x8*)(Ks + KSWZ(r32, cb));
    const bf16x8 b1 = *(LAS const bf16x8*)(Ks + KSWZ(32 + r32, cb));
    p0 = __builtin_amdgcn_mfma_f32_32x32x16_bf16(b0, qr[d0], p0, 0, 0, 0);
    p1 = __builtin_amdgcn_mfma_f32_32x32x16_bf16(b1, qr[d0], p1, 0, 0, 0); }
}
template <int D0> __device__ __forceinline__ void pv_one(f32x16& od, LAS const unsigned char* vb, bf16x8 pa0, bf16x8 pa1, bf16x8 pa2, bf16x8 pa3) {
  const s16x4 l0 = tr_read(vb + v_rd_off(D0, 0, 0)), h0 = tr_read(vb + v_rd_off(D0, 0, 1)), l1 = tr_read(vb + v_rd_off(D0, 1, 0)), h1 = tr_read(vb + v_rd_off(D0, 1, 1));
  const s16x4 l2 = tr_read(vb + v_rd_off(D0, 2, 0)), h2 = tr_read(vb + v_rd_off(D0, 2, 1)), l3 = tr_read(vb + v_rd_off(D0, 3, 0)), h3 = tr_read(vb + v_rd_off(D0, 3, 1));
#define PK(L, H) (bf16x8){L[0], L[1], L[2], L[3], H[0], H[1], H[2], H[3]}
  od = __builtin_amdgcn_mfma_f32_32x32x16_bf16(pa0, PK(l0, h0), od, 0, 0, 0);
  od = __builtin_amdgcn_mfma_f32_32x32x16_bf16(pa1, PK(l1, h1), od, 0, 0, 0);
  od = __builtin_amdgcn_mfma_f32_32x32x16_bf16(pa2, PK(l2, h2), od, 0, 0, 0);
  od = __builtin_amdgcn_mfma_f32_32x32x16_bf16(pa3, PK(l3, h3), od, 0, 0, 0);
#undef PK
}
__device__ __forceinline__ void pv_d0(f32x16* o, LAS const unsigned char* vb, bf16x8 pa0, bf16x8 pa1, bf16x8 pa2, bf16x8 pa3) {
  pv_one<0>(o[0], vb, pa0, pa1, pa2, pa3); pv_one<1>(o[1], vb, pa0, pa1, pa2, pa3); pv_one<2>(o[2], vb, pa0, pa1, pa2, pa3); pv_one<3>(o[3], vb, pa0, pa1, pa2, pa3);
}
template <bool CAUSAL> __device__ __forceinline__ void partialSM(f32x16& p0, f32x16& p1, float& m_reg, float& alpha, const float (&cs)[16], float base, int lim, float C, float slope2, int delta) {
  const float tb0 = slope2 * (float)delta + base, tb1 = slope2 * (float)(delta + 32) + base;
#pragma unroll
  for (int r = 0; r < 16; ++r) { p0[r] = fmaf(p0[r], C, cs[r]); p1[r] = fmaf(p1[r], C, cs[r]); }
  if (CAUSAL && delta + 63 > 0) {
    const int l0 = lim - delta, l1 = l0 - 32;
#pragma unroll
    for (int r = 0; r < 16; ++r) { const int K = (r & 3) + 8 * (r >> 2); if (K > l0) p0[r] = -INFINITY; if (K > l1) p1[r] = -INFINITY; }
  }
  float pm0 = p0[0], pm1 = p1[0];
#pragma unroll
  for (int r = 1; r < 16; ++r) { pm0 = fmaxf(pm0, p0[r]); pm1 = fmaxf(pm1, p1[r]); }
  float pmax = fmaxf(pm0 + tb0, pm1 + tb1);
  { auto rr = __builtin_amdgcn_permlane32_swap(__float_as_uint(pmax), __float_as_uint(pmax), false, false);
    pmax = fmaxf(__uint_as_float(rr[0]), __uint_as_float(rr[1])); }
  float mn;
  if (__builtin_expect(__all(pmax - m_reg <= THR2), 1)) { mn = m_reg; alpha = 1.f; }
  else { mn = fmaxf(m_reg, pmax); alpha = __builtin_amdgcn_exp2f(m_reg - mn); m_reg = mn; }
  const float a0 = tb0 - mn, a1 = tb1 - mn;
#pragma unroll
  for (int r = 0; r < 16; ++r) { p0[r] += a0; p1[r] += a1; }
#pragma unroll
  for (int r = 0; r < 16; ++r) p0[r] = __builtin_amdgcn_exp2f(p0[r]);
}
__device__ __forceinline__ void finishSM(f32x16& p0, f32x16& p1, float alpha, float& l_reg, bf16x8& pa0, bf16x8& pa1, bf16x8& pa2, bf16x8& pa3) {
#pragma unroll
  for (int r = 0; r < 16; ++r) p1[r] = __builtin_amdgcn_exp2f(p1[r]);
  float ps = 0;
#pragma unroll
  for (int r = 0; r < 16; ++r) ps += p0[r];
#pragma unroll
  for (int r = 0; r < 16; ++r) ps += p1[r];
  { auto rr = __builtin_amdgcn_permlane32_swap(__float_as_uint(ps), __float_as_uint(ps), false, false);
    ps = __uint_as_float(rr[0]) + __uint_as_float(rr[1]); }
  l_reg = l_reg * alpha + ps;
#define PK4(P, BASE, OUT) do { unsigned a0 = cvtpk(P[BASE + 0], P[BASE + 1]), a1 = cvtpk(P[BASE + 2], P[BASE + 3]);   \
    unsigned b0 = cvtpk(P[BASE + 4], P[BASE + 5]), b1 = cvtpk(P[BASE + 6], P[BASE + 7]);                              \
    auto r0 = __builtin_amdgcn_permlane32_swap(a0, b0, false, false); auto r1 = __builtin_amdgcn_permlane32_swap(a1, b1, false, false); \
    u32x4 w = {r0[0], r1[0], r0[1], r1[1]}; OUT = __builtin_bit_cast(bf16x8, w); } while (0)
  PK4(p0, 0, pa0); PK4(p0, 8, pa1); PK4(p1, 0, pa2); PK4(p1, 8, pa3);
#undef PK4
}

__device__ __forceinline__ void attn_b_unit(const bf16_t* __restrict__ PROJ, bf16_t* UB, const float* __restrict__ gsub, float lam, int h, int qb, LAS unsigned char* lds, const int wid) {
  const int lane = lane_id_v(), tid = wid * 64 + lane, r32 = lane & 31, hi = lane >> 5, comp = wid >> 2, wq = wid & 3;
  const int R0 = qb * 128, qrow0 = R0 + wq * 32, NT = 2 * qb + 2;
  LAS unsigned char* V_lds = lds; LAS unsigned char* K_lds = lds + 2 * SHM_V;
  LAS float* ws = (LAS float*)(lds + 2 * SHM_V + 2 * SHM_K) + wid * 64; LAS float* li_l = ws; LAS float* al_l = ws + 32;
  LAS float* xch = (LAS float*)(lds + 2 * SHM_V + 2 * SHM_K + 2048);
  const float slope2 = __builtin_amdgcn_exp2f(-(float)(h + 1)) * LOG2E, C = 0.125f * LOG2E;
  float cs[16];
#pragma unroll
  for (int r = 0; r < 16; ++r) cs[r] = __uint_as_float(__builtin_amdgcn_readfirstlane(__float_as_uint(slope2 * (float)((r & 3) + 8 * (r >> 2)))));
  const float base = slope2 * (float)(4 * hi - r32); const int lim = r32 - 4 * hi;
  float m_reg = -1e30f, l_reg = 0; f32x16 o[4] = {}; bf16x8 qr[4];
  { const bf16_t* Qw = PROJ + (size_t)(qrow0 + r32) * NPAD + C_QB + h * 128 + comp * 64 + hi * 8;
#pragma unroll
    for (int d0 = 0; d0 < 4; ++d0) qr[d0] = *(const bf16x8*)(Qw + d0 * 16); }
  const unsigned offK = (unsigned)((tid >> 4) * NPAD + C_KB + h * 128 + (tid & 15) * 8) * 2u, offV = offK + (unsigned)(C_VB - C_KB) * 2u;
  const int sr = tid >> 4, sc = (tid & 15) * 8, vst0 = v_st(sr, sc), vst1 = v_st(32 + sr, sc), cq = comp * 128;
  LAS const unsigned char* vb0 = V_lds + v_rd_base(lane);
  struct { bf16x8 vs0, vs1, ks0, ks1; } sr_;
#define KEY0(t) (64 * (NT - 1 - (t)))
#define GLD16(off) (*(const bf16x8*)((const char*)PROJ + (unsigned)(off)))
#define SLOAD(k0) do { const unsigned kb_ = (unsigned)(k0) * (unsigned)(NPAD * 2); sr_.vs0 = GLD16(offV + kb_); sr_.vs1 = GLD16(offV + kb_ + 32u * NPAD * 2u); \
    sr_.ks0 = GLD16(offK + kb_); sr_.ks1 = GLD16(offK + kb_ + 32u * NPAD * 2u); } while (0)
#define SWRITE(b) do { *(LAS bf16x8*)(V_lds + (b) * SHM_V + vst0) = sr_.vs0; *(LAS bf16x8*)(V_lds + (b) * SHM_V + vst1) = sr_.vs1; const int kc = sc * 2; \
    *(LAS bf16x8*)(K_lds + (b) * SHM_K + KSWZ(sr, kc)) = sr_.ks0; *(LAS bf16x8*)(K_lds + (b) * SHM_K + KSWZ(32 + sr, kc)) = sr_.ks1; } while (0)
#define RESC(a) do { if (__any((a) < 1.f)) { if (hi == 0) al_l[r32] = (a); asm volatile("s_waitcnt lgkmcnt(0)" ::: "memory"); \
    _Pragma("unroll") for (int d = 0; d < 4; ++d) _Pragma("unroll") for (int r = 0; r < 16; ++r) o[d][r] *= al_l[crow(r, hi)]; } } while (0)
  f32x16 pA0, pA1, pB0, pB1; float alA, alB; bf16x8 pa0, pa1, pa2, pa3;
  SLOAD(KEY0(0)); SWRITE(0); __syncthreads();
  qkt<4>(pA0, pA1, K_lds, qr, cq, r32, hi); partialSM<true>(pA0, pA1, m_reg, alA, cs, base, lim, C, slope2, KEY0(0) - qrow0);
  SLOAD(KEY0(1)); SWRITE(1); __syncthreads();
  for (int j = 1; j + 1 < NT; j += 2) {
    SBAR(); qkt<4>(pB0, pB1, K_lds + SHM_K, qr, cq, r32, hi);
    finishSM(pA0, pA1, alA, l_reg, pa0, pa1, pa2, pa3); SBAR();
    SLOAD(KEY0(j + 1)); SBAR();
    pv_d0(o, vb0, pa0, pa1, pa2, pa3); partialSM<true>(pB0, pB1, m_reg, alB, cs, base, lim, C, slope2, KEY0(j) - qrow0);
    __syncthreads(); SWRITE(0);
    RESC(alB); __syncthreads();
    SBAR(); qkt<4>(pA0, pA1, K_lds, qr, cq, r32, hi);
    finishSM(pB0, pB1, alB, l_reg, pa0, pa1, pa2, pa3); SBAR();
    SLOAD(KEY0(j + 2)); SBAR();
    pv_d0(o, vb0 + SHM_V, pa0, pa1, pa2, pa3); partialSM<true>(pA0, pA1, m_reg, alA, cs, base, lim, C, slope2, KEY0(j + 1) - qrow0);
    __syncthreads(); SWRITE(1);
    RESC(alA); __syncthreads();
  }
  SBAR(); qkt<4>(pB0, pB1, K_lds + SHM_K, qr, cq, r32, hi);
  finishSM(pA0, pA1, alA, l_reg, pa0, pa1, pa2, pa3); SBAR();
  pv_d0(o, vb0, pa0, pa1, pa2, pa3); partialSM<true>(pB0, pB1, m_reg, alB, cs, base, lim, C, slope2, KEY0(NT - 1) - qrow0);
  __syncthreads(); RESC(alB);
  finishSM(pB0, pB1, alB, l_reg, pa0, pa1, pa2, pa3); SBAR();
  pv_d0(o, vb0 + SHM_V, pa0, pa1, pa2, pa3);
#undef KEY0
#undef SLOAD
#undef GLD16
#undef SWRITE
#undef RESC
  if (hi == 0) li_l[r32] = l_reg; asm volatile("s_waitcnt lgkmcnt(0)" ::: "memory");
  float rli[16];
#pragma unroll
  for (int r = 0; r < 16; ++r) rli[r] = __builtin_amdgcn_rcpf(li_l[crow(r, hi)]);
  if (comp == 1) {
#pragma unroll
    for (int d0 = 0; d0 < 4; ++d0)
#pragma unroll
      for (int r = 0; r < 16; ++r) xch[(wq * 64 + d0 * 16 + r) * 64 + lane] = o[d0][r] * rli[r] * lam;
  }
  __syncthreads();
  if (comp == 0) {
    float ss[16];
#pragma unroll
    for (int r = 0; r < 16; ++r) ss[r] = 0.f;
#pragma unroll
    for (int d0 = 0; d0 < 4; ++d0)
#pragma unroll
      for (int r = 0; r < 16; ++r) { const float d = o[d0][r] * rli[r] - xch[(wq * 64 + d0 * 16 + r) * 64 + lane]; o[d0][r] = d; ss[r] += d * d; }
#pragma unroll
    for (int r = 0; r < 16; ++r) { float s = ss[r]; s += __shfl_xor(s, 1); s += __shfl_xor(s, 2); s += __shfl_xor(s, 4); s += __shfl_xor(s, 8); s += __shfl_xor(s, 16);
      ss[r] = 0.8f / sqrtf(s * (1.f / 128.f) + RMS_EPS); }
#pragma unroll
    for (int d0 = 0; d0 < 4; ++d0) { const int col = d0 * 32 + r32; const float g = gsub[col];
#pragma unroll
      for (int r = 0; r < 16; ++r) { const size_t row = (size_t)(qrow0 + crow(r, hi));
        const float z = bf2f(PROJ[row * NPAD + C_ZB + h * 128 + col]);
        UB[row * 1024 + h * 128 + col] = (bf16_t)f2bf(o[d0][r] * ss[r] * g * z); } }
  }
  __syncthreads();
}
__device__ __forceinline__ void attn_b_phase(const Args& a, LAS unsigned char* lds, int blk, int nblk, const int wid) {
  const bf16_t* PROJ = (const bf16_t*)(a.ws + WS_PROJ); bf16_t* UB = (bf16_t*)(a.ws + WS_U) + (size_t)1 * S * 1024;
  const float lam = ((const float*)(a.ws + WS_CTL))[0];
  for (int u = blk; u < 256; u += nblk) {
    const int h = u & 7, p = u >> 3;
    attn_b_unit(PROJ, UB, a.in[9], lam, h, 63 - p, lds, wid);
    attn_b_unit(PROJ, UB, a.in[9], lam, h, p, lds, wid);
  }
}
template <bool DUMMY> __device__ __forceinline__ void partialSM_A(f32x16& p0, f32x16& p1, float& m_reg, float& alpha, const float (&cs)[16], float base, float C, float slope2, int delta, unsigned long long mw, int hi) {
  const float tb0 = slope2 * (float)delta + base, tb1 = slope2 * (float)(delta + 32) + base;
  const unsigned wl = (unsigned)mw >> (4 * hi), wh = (unsigned)(mw >> 32) >> (4 * hi);
#pragma unroll
  for (int r = 0; r < 16; ++r) { const int K = (r & 3) + 8 * (r >> 2);
    const float y0 = fmaf(p0[r], C, cs[r]), y1 = fmaf(p1[r], C, cs[r]);
    const unsigned t0 = (unsigned)((int)(wl << (31 - K)) >> 31), t1 = (unsigned)((int)(wh << (31 - K)) >> 31);
    p0[r] = __uint_as_float((__float_as_uint(y0) & t0) | (~t0 & 0xff800000u));
    p1[r] = __uint_as_float((__float_as_uint(y1) & t1) | (~t1 & 0xff800000u)); }
  float pm0 = p0[0], pm1 = p1[0];
#pragma unroll
  for (int r = 1; r < 16; ++r) { pm0 = fmaxf(pm0, p0[r]); pm1 = fmaxf(pm1, p1[r]); }
  float pmax = fmaxf(pm0 + tb0, pm1 + tb1);
  { auto rr = __builtin_amdgcn_permlane32_swap(__float_as_uint(pmax), __float_as_uint(pmax), false, false);
    pmax = fmaxf(__uint_as_float(rr[0]), __uint_as_float(rr[1])); }
  float mn;
  if (__builtin_expect(__all(pmax - m_reg <= THR2), 1)) { mn = m_reg; alpha = 1.f; }
  else { mn = fmaxf(m_reg, pmax); alpha = __builtin_amdgcn_exp2f(m_reg - mn); m_reg = mn; }
  const float a0 = tb0 - mn, a1 = tb1 - mn;
#pragma unroll
  for (int r = 0; r < 16; ++r) { p0[r] += a0; p1[r] += a1; }
#pragma unroll
  for (int r = 0; r < 16; ++r) p0[r] = __builtin_amdgcn_exp2f(p0[r]);
}
__device__ __forceinline__ void attn_a_unit(const bf16_t* __restrict__ PROJ, const unsigned long long* __restrict__ MASK, bf16_t* UA, int h, int qb, LAS unsigned char* lds, const int wid) {
  const int lane = lane_id_v(), tid = wid * 64 + lane, r32 = lane & 31, hi = lane >> 5;
  const int R0 = qb * 256, qrow0 = R0 + wid * 32, NT = 4 * qb + 4;
  LAS unsigned char* V_lds = lds; LAS unsigned char* K_lds = lds + 2 * SHM_V;
  LAS float* ws = (LAS float*)(lds + 2 * SHM_V + 2 * SHM_K) + wid * 64; LAS float* li_l = ws; LAS float* al_l = ws + 32;
  const float slope2 = __builtin_amdgcn_exp2f(-(float)(h + 1)) * LOG2E, C = 0.08838834764831845f * LOG2E;
  float cs[16];
#pragma unroll
  for (int r = 0; r < 16; ++r) cs[r] = __uint_as_float(__builtin_amdgcn_readfirstlane(__float_as_uint(slope2 * (float)((r & 3) + 8 * (r >> 2)))));
  const float base = slope2 * (float)(4 * hi - r32);
  float m_reg = -1e30f, l_reg = 0; f32x16 o[4] = {}; bf16x8 qr[8];
  { const bf16_t* Qw = PROJ + (size_t)(qrow0 + r32) * NPAD + C_QA + h * 128 + hi * 8;
#pragma unroll
    for (int d0 = 0; d0 < 8; ++d0) qr[d0] = *(const bf16x8*)(Qw + d0 * 16); }
  const unsigned offK = (unsigned)((tid >> 4) * NPAD + C_KA + h * 128 + (tid & 15) * 8) * 2u, offV = offK + (unsigned)(C_VA - C_KA) * 2u;
  const unsigned moff = (unsigned)(qrow0 + r32) * 1024u;
#define MLD(tj) (*(const unsigned long long*)((const char*)MASK + (moff + 8u * (unsigned)(tj))))
  const int sr = tid >> 4, sc = (tid & 15) * 8, vst0 = v_st(sr, sc), vst1 = v_st(32 + sr, sc);
  LAS const unsigned char* vb0 = V_lds + v_rd_base(lane);
  struct { bf16x8 vs0, vs1, ks0, ks1; } sr_;
#define TJ(t) (NT - 1 - (t))
#define KEY0(t) (64 * TJ(t))
#define GLD16(off) (*(const bf16x8*)((const char*)PROJ + (unsigned)(off)))
#define SLOAD(k0) do { const unsigned kb_ = (unsigned)(k0) * (unsigned)(NPAD * 2); sr_.vs0 = GLD16(offV + kb_); sr_.vs1 = GLD16(offV + kb_ + 32u * NPAD * 2u); \
    sr_.ks0 = GLD16(offK + kb_); sr_.ks1 = GLD16(offK + kb_ + 32u * NPAD * 2u); } while (0)
#define SWRITE(b) do { *(LAS bf16x8*)(V_lds + (b) * SHM_V + vst0) = sr_.vs0; *(LAS bf16x8*)(V_lds + (b) * SHM_V + vst1) = sr_.vs1; const int kc = sc * 2; \
    *(LAS bf16x8*)(K_lds + (b) * SHM_K + KSWZ(sr, kc)) = sr_.ks0; *(LAS bf16x8*)(K_lds + (b) * SHM_K + KSWZ(32 + sr, kc)) = sr_.ks1; } while (0)
#define RESC(a) do { if (__any((a) < 1.f)) { if (hi == 0) al_l[r32] = (a); asm volatile("s_waitcnt lgkmcnt(0)" ::: "memory"); \
    _Pragma("unroll") for (int d = 0; d < 4; ++d) _Pragma("unroll") for (int r = 0; r < 16; ++r) o[d][r] *= al_l[crow(r, hi)]; } } while (0)
  f32x16 pA0, pA1, pB0, pB1; float alA, alB; bf16x8 pa0, pa1, pa2, pa3; unsigned long long mwA, mwB;
  SLOAD(KEY0(0)); mwA = MLD(TJ(0)); SWRITE(0); __syncthreads();
  qkt<8>(pA0, pA1, K_lds, qr, 0, r32, hi); partialSM_A<true>(pA0, pA1, m_reg, alA, cs, base, C, slope2, KEY0(0) - qrow0, mwA, hi);
  SLOAD(KEY0(1)); mwB = MLD(TJ(1)); SWRITE(1); __syncthreads();
  for (int j = 1; j + 1 < NT; j += 2) {
    SBAR(); qkt<8>(pB0, pB1, K_lds + SHM_K, qr, 0, r32, hi);
    finishSM(pA0, pA1, alA, l_reg, pa0, pa1, pa2, pa3); SBAR();
    SLOAD(KEY0(j + 1)); mwA = MLD(TJ(j + 1)); SBAR();
    pv_d0(o, vb0, pa0, pa1, pa2, pa3); partialSM_A<true>(pB0, pB1, m_reg, alB, cs, base, C, slope2, KEY0(j) - qrow0, mwB, hi);
    __syncthreads(); SWRITE(0);
    RESC(alB); __syncthreads();
    SBAR(); qkt<8>(pA0, pA1, K_lds, qr, 0, r32, hi);
    finishSM(pB0, pB1, alB, l_reg, pa0, pa1, pa2, pa3); SBAR();
    SLOAD(KEY0(j + 2)); mwB = MLD(TJ(j + 2)); SBAR();
    pv_d0(o, vb0 + SHM_V, pa0, pa1, pa2, pa3); partialSM_A<true>(pA0, pA1, m_reg, alA, cs, base, C, slope2, KEY0(j + 1) - qrow0, mwA, hi);
    __syncthreads(); SWRITE(1);
    RESC(alA); __syncthreads();
  }
  SBAR(); qkt<8>(pB0, pB1, K_lds + SHM_K, qr, 0, r32, hi);
  finishSM(pA0, pA1, alA, l_reg, pa0, pa1, pa2, pa3); SBAR();
  pv_d0(o, vb0, pa0, pa1, pa2, pa3); partialSM_A<true>(pB0, pB1, m_reg, alB, cs, base, C, slope2, KEY0(NT - 1) - qrow0, mwB, hi);
  __syncthreads(); RESC(alB);
  finishSM(pB0, pB1, alB, l_reg, pa0, pa1, pa2, pa3); SBAR();
  pv_d0(o, vb0 + SHM_V, pa0, pa1, pa2, pa3);
#undef TJ
#undef MLD
#undef KEY0
#undef SLOAD
#undef GLD16
#undef SWRITE
#undef RESC
  if (hi == 0) li_l[r32] = l_reg; asm volatile("s_waitcnt lgkmcnt(0)" ::: "memory");
  float rli[16];
#pragma unroll
  for (int r = 0; r < 16; ++r) rli[r] = __builtin_amdgcn_rcpf(li_l[crow(r, hi)]);
#pragma unroll
  for (int d0 = 0; d0 < 4; ++d0) { const int col = h * 128 + d0 * 32 + r32;
#pragma unroll
    for (int r = 0; r < 16; ++r) { const size_t row = (size_t)(qrow0 + crow(r, hi));
      const float z = bf2f(PROJ[row * NPAD + C_ZA + col]);
      UA[row * 1024 + col] = (bf16_t)f2bf(o[d0][r] * rli[r] * z); } }
  __syncthreads();
}
__device__ __forceinline__ void attn_a_phase(const Args& a, LAS unsigned char* lds, int blk, int nblk, const int wid) {
  const bf16_t* PROJ = (const bf16_t*)(a.ws + WS_PROJ); bf16_t* UA = (bf16_t*)(a.ws + WS_U);
  const unsigned long long* MASK = (const unsigned long long*)(a.ws + WS_SEL);
  for (int u = blk; u < 256; u += nblk) { const int h = u & 7, qb = 31 - (u >> 3); attn_a_unit(PROJ, MASK, UA, h, qb, lds, wid); }
}
#undef KSWZ
#undef SBAR
}


namespace idx {
typedef short bf16x8 __attribute__((ext_vector_type(8)));
typedef float f32x16 __attribute__((ext_vector_type(16)));
constexpr int NUNIT = 8 * (16 * 17 / 2);
__device__ __forceinline__ void scores_phase(const bf16_t* __restrict__ PROJ, float* SC, LAS unsigned char* lds, int blk, int nblk, const int wid) {
  const int lane = lane_id_v(), tid = wid * 64 + lane, n32 = lane & 31, hi = lane >> 5;
  const int skey = tid >> 3, schunk = tid & 7;
  const int swr = skey * 128 + ((schunk ^ (skey & 7)) << 4);
  for (int u = blk; u < NUNIT; u += nblk) {
    int g = 0, rem = u; while (rem >= 8 * (g + 1)) { rem -= 8 * (g + 1); ++g; }
    const int qc = 8 * g + rem / (g + 1), kc = rem % (g + 1);
    const int q0 = 64 * qc + 8 * wid, k_begin = 512 * kc, k_end = min(512 * kc + 512, 64 * qc + 64), ntile = (k_end - k_begin) / 64;
    bf16x8 af[4][4]; float w[4][16];
    const int head = (n32 & 3) + 4 * (n32 >> 3), qbit = (n32 >> 2) & 1;
#pragma unroll
    for (int t = 0; t < 4; ++t) {
      const bf16_t* qp = PROJ + (size_t)(q0 + 2 * t + qbit) * NPAD + C_QI + head * 64 + hi * 8;
#pragma unroll
      for (int ks = 0; ks < 4; ++ks) af[t][ks] = *(const bf16x8*)(qp + ks * 16);
      const bf16_t* wp = PROJ + (size_t)(q0 + 2 * t + hi) * NPAD + C_WI;
      const u32x4 w0 = *(const u32x4*)wp, w1 = *(const u32x4*)(wp + 8);
      const unsigned ww[8] = {w0.x, w0.y, w0.z, w0.w, w1.x, w1.y, w1.z, w1.w};
#pragma unroll
      for (int i = 0; i < 8; ++i) { w[t][2 * i] = bflo(ww[i]) * 0.03125f; w[t][2 * i + 1] = bfhi(ww[i]) * 0.03125f; }
    }
    u32x4 st = *(const u32x4*)(PROJ + (size_t)(k_begin + skey) * NPAD + C_KI + schunk * 8);
    __syncthreads();
    *(LAS u32x4*)(lds + swr) = st;
    __syncthreads();
    for (int tl = 0; tl < ntile; ++tl) {
      LAS const unsigned char* kb = lds + (tl & 1) * 8192;
      if (tl + 1 < ntile) st = *(const u32x4*)(PROJ + (size_t)(k_begin + 64 * (tl + 1) + skey) * NPAD + C_KI + schunk * 8);
#pragma unroll
      for (int kh = 0; kh < 2; ++kh) {
        const int krow = kh * 32 + n32;
        bf16x8 bfr[4];
#pragma unroll
        for (int ks = 0; ks < 4; ++ks) bfr[ks] = *(LAS const bf16x8*)(kb + krow * 128 + (((2 * ks + hi) ^ (krow & 7)) << 4));
        const int s = k_begin + 64 * tl + krow;
#pragma unroll
        for (int t = 0; t < 4; ++t) {
          f32x16 acc = {};
#pragma unroll
          for (int ks = 0; ks < 4; ++ks) acc = __builtin_amdgcn_mfma_f32_32x32x16_bf16(af[t][ks], bfr[ks], acc, 0, 0, 0);
          float sc = 0.f;
#pragma unroll
          for (int r = 0; r < 16; ++r) sc = fmaf(fmaxf(acc[r], 0.f), w[t][r], sc);
          const int q = q0 + 2 * t + hi;
          if (s <= q) SC[sc_off(q) + s] = sc;
        }
      }
      if (tl + 1 < ntile) { *(LAS u32x4*)(lds + ((tl + 1) & 1) * 8192 + swr) = st; }
      __syncthreads();
    }
  }
}
}

#ifdef DBG_STAGE
__device__ __forceinline__ void dbg_dump(const Args& a, int blk, int nblk) {
    const bf16_t* PROJ = (const bf16_t*)(a.ws + WS_PROJ);
    for (size_t idx = (size_t)blk * 512 + threadIdx.x; idx < (size_t)S * DM; idx += (size_t)nblk * 512) {
        const int r = (int)(idx / DM), c = (int)(idx % DM); float v = 0.f;
#if DBG_STAGE == 1 && defined(DBG_WEIGHTS)
        for (int z = 0; z < 3; ++z) v += bf2f(((const bf16_t*)(a.ws + WS_WTBR))[((size_t)z * 2048 + (r & 2047)) * 1024 + (c & 1023)]);
        v += bf2f(((const bf16_t*)(a.ws + WS_WTOUT))[(size_t)(r & 2047) * 2048 + c]);
#elif DBG_STAGE == 1 && defined(DBG_GATES)
        for (int j = 0; j < 3; ++j) v += bf2f(PROJ[(size_t)r * NPAD + C_GL + c + 2048 * j]);
#elif DBG_STAGE == 1
        for (int j = 0; j < 8; ++j) v += bf2f(PROJ[(size_t)r * NPAD + c + 2048 * j]);
        if (c < 1280) v += bf2f(PROJ[(size_t)r * NPAD + 16384 + c]);
        if (r < 256) v += bf2f(((const bf16_t*)(a.ws + WS_MKV))[(size_t)r * 2048 + c]);
        for (int z = 0; z < 3; ++z) v += bf2f(((const bf16_t*)(a.ws + WS_WTBR))[((size_t)z * 2048 + (r & 2047)) * 1024 + (c & 1023)]);
        v += bf2f(((const bf16_t*)(a.ws + WS_WTOUT))[(size_t)(r & 2047) * 2048 + c]);
#elif DBG_STAGE == 2
        if (c < 1024) v = bf2f(((const bf16_t*)(a.ws + WS_U))[(size_t)(S + r) * 1024 + c]) + bf2f(((const bf16_t*)(a.ws + WS_U))[(size_t)(2 * S + r) * 1024 + c]);
        else { const float* row = (const float*)(a.ws + WS_SC) + sc_off(r); for (int j = c - 1024; j <= r; j += 1024) v += row[j]; }
#elif DBG_STAGE == 3
        if (c < 256) v = (float)((const int*)(a.ws + WS_SEL))[(size_t)r * 256 + c];
#elif DBG_STAGE == 4
        if (c < 1024) v = bf2f(((const bf16_t*)(a.ws + WS_U))[(size_t)r * 1024 + c]);
#elif DBG_STAGE == 5
        v = bf2f(((const bf16_t*)(a.ws + WS_MERGED))[(size_t)r * DM + c]);
#endif
        a.out[idx] = v;
    }
}
#endif

__device__ __forceinline__ void grid_bar(unsigned* cnt, unsigned target, const int wave) {
    asm volatile("s_waitcnt vmcnt(0)" ::: "memory");
    __syncthreads();
    if (wave == 0) {
        if (lane_id_v() == 0) {
            __builtin_amdgcn_fence(__ATOMIC_RELEASE, "agent");
            asm volatile("s_waitcnt vmcnt(0)" ::: "memory");
            __hip_atomic_fetch_add(cnt, 1u, __ATOMIC_RELAXED, __HIP_MEMORY_SCOPE_AGENT);
            while (__hip_atomic_load(cnt, __ATOMIC_RELAXED, __HIP_MEMORY_SCOPE_AGENT) < target) __builtin_amdgcn_s_sleep(2);
            __builtin_amdgcn_fence(__ATOMIC_ACQUIRE, "agent");
            asm volatile("s_waitcnt vmcnt(0)" ::: "memory");
        }
    }
    __syncthreads();
}

constexpr int LDS_BYTES = 147456;
constexpr int NPHASE = 8;
__global__ void __launch_bounds__(512, 2) fwd(Args a) {
    extern __shared__ __attribute__((aligned(16))) unsigned char lds_raw[];
    LAS unsigned char* lds = (LAS unsigned char*)lds_raw;
    cg::grid_group grid = cg::this_grid();
    const int blk = blockIdx.x, nblk = gridDim.x, wave = __builtin_amdgcn_readfirstlane(threadIdx.x >> 6);
    unsigned char* ws = a.ws;
    const bf16_t* PROJ = (const bf16_t*)(ws + WS_PROJ);
#define IN(k) (a.ph_lo <= (k) && (k) < a.ph_hi)
#define SEAM(k) do { if (IN(k) && IN((k) + 1)) { if ((k) == 0) grid.sync(); else grid_bar((unsigned*)(ws + WS_CTL + 256), (unsigned)nblk * (unsigned)(k), wave); } } while (0)
    if (IN(0)) { p0_prologue(a, lds, blk, nblk, wave); } SEAM(0);
    if (IN(1)) {
        pg8::Gemm g{(const bf16_t*)(ws + WS_H), (const bf16_t*)(ws + WS_WTIN), S, NPAD, DM, (long)WS_MEMN - (long)WS_H, (long)WS_WTMKV - (long)WS_WTIN};
        pg8::ProjOrder so; so.init(S, NPAD, nblk, blk);
        pg8::EpiProj E{(bf16_t*)(ws + WS_PROJ), NPAD, (bf16_t*)(ws + WS_MKV), 2048, a.in[4], C_GL / 256};
        pg8::gemm_phase<pg8::EpiProj, pg8::ProjOrder, true, true>(lds, g, so, E, wave);
    } SEAM(1);
    if (IN(2)) { idx::scores_phase(PROJ, (float*)(ws + WS_SC), lds, blk, nblk, wave); __syncthreads(); att::attn_b_phase(a, lds, blk, nblk, wave); attn_m_naive(a, blk, nblk, wave); } SEAM(2);
    if (IN(3)) { topk_select((const float*)(ws + WS_SC), (int*)(ws + WS_SEL), lds, blk, nblk, wave); } SEAM(3);
    if (IN(4)) { att::attn_a_phase(a, lds, blk, nblk, wave); } SEAM(4);
    if (IN(5)) {
        pg8::Gemm g{(const bf16_t*)(ws + WS_U), (const bf16_t*)(ws + WS_WTBR), S, DM, 1024, (long)S * 1024 * 2, (long)2048 * 1024 * 2};
        pg8::MergeOrder so; so.init(S, DM, nblk, blk);
        pg8::EpiMerge E{PROJ + C_GL, NPAD, (float*)(ws + WS_T), (bf16_t*)(ws + WS_MERGED), DM};
        pg8::gemm_phase<pg8::EpiMerge, pg8::MergeOrder, true, true>(lds, g, so, E, wave);
    } SEAM(5);
    if (IN(6)) {
        pg8::Gemm g{(const bf16_t*)(ws + WS_MERGED), (const bf16_t*)(ws + WS_WTOUT), S, DM, DM, 0, 0};
        pg8::StaticOrder so; so.init(S, DM, nblk, blk);
        pg8::EpiOut E{a.in[0], a.out, DM, (float*)(ws + WS_PART), S};
        pg8::gemm_phase<pg8::EpiOut, pg8::StaticOrder, false, true>(lds, g, so, E, wave);
    } SEAM(6);
    if (IN(7)) { final_norm(a, blk, nblk, wave); }
#ifdef DBG_STAGE
    if (IN(8)) { dbg_dump(a, blk, nblk); }
#endif
#undef IN
#undef SEAM
}

#ifndef N_LAUNCH_MODE
#define N_LAUNCH_MODE 0
#endif
extern "C" void kernel_launch(void* const* d_in, const int* in_sizes, int n_in, void* d_out, int out_size, void* d_ws, size_t ws_size, hipStream_t stream) {
    static int grid = 0;
    if (grid == 0) {
        if (n_in != 17 || in_sizes[0] != S * DM || in_sizes[3] != DM * DIN || out_size != S * DM || ws_size < WS_END) {
            fprintf(stderr, "kernel_launch: unexpected shapes (n_in %d, in0 %d, in3 %d, out %d, ws %zu < %zu)\n", n_in, n_in > 0 ? in_sizes[0] : -1, n_in > 3 ? in_sizes[3] : -1, out_size, ws_size, (size_t)WS_END); grid = -1; return; }
        int dev = 0, cus = 0, per_cu = 0;
        (void)hipGetDevice(&dev); (void)hipDeviceGetAttribute(&cus, hipDeviceAttributeMultiprocessorCount, dev);
        if (hipFuncSetAttribute((const void*)fwd, hipFuncAttributeMaxDynamicSharedMemorySize, LDS_BYTES) != hipSuccess) { fprintf(stderr, "kernel_launch: hipFuncSetAttribute failed\n"); grid = -1; return; }
        if (hipOccupancyMaxActiveBlocksPerMultiprocessor(&per_cu, (const void*)fwd, 512, LDS_BYTES) != hipSuccess || per_cu < 1) { fprintf(stderr, "kernel_launch: occupancy query gave %d\n", per_cu); per_cu = 1; }
        (void)hipGetLastError();
        grid = cus * 1;
        if (grid > cus * per_cu) grid = cus * per_cu;
        if (grid < 8) grid = -1;
    }
    if (grid < 0) return;
    Args a{};
    for (int i = 0; i < 17; ++i) a.in[i] = (const float*)d_in[i];
    a.out = (float*)d_out; a.ws = (unsigned char*)d_ws;
#if N_LAUNCH_MODE == 1
    (void)hipMemsetAsync((unsigned char*)d_ws + WS_CTL + 256, 0, 256, stream);
    a.ph_lo = 0; a.ph_hi = NPHASE;
    void* kargs[] = {&a};
    hipError_t e = hipLaunchCooperativeKernel((const void*)fwd, dim3(grid), dim3(512), kargs, LDS_BYTES, stream);
    if (e != hipSuccess) fprintf(stderr, "cooperative launch failed: %s (grid %d)\n", hipGetErrorString(e), grid);
#else
#ifdef DBG_STAGE
    #ifdef DBG_WEIGHTS
    constexpr int last_ph[6] = {0, 0, 2, 3, 4, 5};
#else
    constexpr int last_ph[6] = {0, 1, 2, 3, 4, 5};
#endif
    for (int p = 0; p <= last_ph[DBG_STAGE]; ++p) { a.ph_lo = p; a.ph_hi = p + 1; hipLaunchKernelGGL(fwd, dim3(grid), dim3(512), LDS_BYTES, stream, a); }
    a.ph_lo = 8; a.ph_hi = 9; hipLaunchKernelGGL(fwd, dim3(grid), dim3(512), LDS_BYTES, stream, a);
#else
    for (int p = 0; p < NPHASE; ++p) {
        a.ph_lo = p; a.ph_hi = p + 1;
        hipLaunchKernelGGL(fwd, dim3(grid), dim3(512), LDS_BYTES, stream, a);
    }
#endif
#endif
}
```

```cpp
#define N_LAUNCH_MODE 1
#include <hip/hip_runtime.h>
#include <hip/hip_cooperative_groups.h>
#include <cstdio>
#include <cstdint>
namespace cg = cooperative_groups;

__device__ __forceinline__ int lane_id_v() { int l; asm volatile("v_mbcnt_lo_u32_b32 %0, -1, 0\n\tv_mbcnt_hi_u32_b32 %0, -1, %0" : "=v"(l)); return l; }
namespace pg8 {
#define PG8_LAS __attribute__((address_space(3)))
typedef unsigned short bf16_t;
typedef short bf16x8 __attribute__((ext_vector_type(8)));
typedef float f32x4 __attribute__((ext_vector_type(4)));
typedef unsigned u32x4 __attribute__((ext_vector_type(4)));
constexpr int BM = 256, BK = 64, HALF = 128, HTB = HALF * BK * 2  , STAGE_BYTES = 8 * HTB, NXCD = 8, WGM = 8;

__host__ __device__ __forceinline__ int lds_byte(int r, int c) { const int st = (r >> 4) * 2 + (c >> 5), rr = r & 15, cc = c & 31, ob = rr * 64 + cc * 2; return st * 1024 + (ob ^ (((ob >> 9) & 1) << 5)); }
__host__ __device__ __forceinline__ void stage_rc(int b, int& R, int& C) { const int st = b / 1024, sb = b % 1024, swz = sb ^ (((sb >> 9) & 1) << 5); R = (st >> 1) * 16 + swz / 64; C = (st & 1) * 32 + (swz % 64) / 2; }
__host__ __device__ __forceinline__ int perm32(int rho) { const int n = rho >> 4, i = rho & 15; return 8 * (i >> 2) + 4 * n + (i & 3); }

struct Unit { int pm, pn, z; };
struct Gemm { const bf16_t* A; const bf16_t* Bt; int M, N, K; long zA, zB; };

struct StaticOrder {
    int nM, nN, nwg, G, c;
    __host__ __device__ void init(int M, int N, int G_, int c_) { nM = M / BM; nN = N / BM; nwg = nM * nN; G = G_; c = c_; }
    __host__ __device__ bool next(int i, Unit& u) const {
        const long L = (long)i * G + c; if (L >= nwg) return false;
        int wgid = (int)L; { const int q = nwg / NXCD, r = nwg % NXCD, xcd = wgid % NXCD, off = wgid / NXCD; wgid = (xcd < r ? xcd * (q + 1) : r * (q + 1) + (xcd - r) * q) + off; }
        const int nig = WGM * nN, gid = wgid / nig, fm = gid * WGM, gsz = (nM - fm) < WGM ? (nM - fm) : WGM;
        u.pm = fm + ((wgid % nig) % gsz); u.pn = (wgid % nig) / gsz; u.z = 0; return true;
    }
    __device__ __forceinline__ void a_ready(const Unit&) const {}
    __device__ __forceinline__ void done(const Unit&) const {}
};

typedef float f32x2_t __attribute__((ext_vector_type(2))); typedef __bf16 bf16x2_t __attribute__((ext_vector_type(2)));
__device__ __forceinline__ unsigned cvt_pk_bf16(float lo, float hi) { f32x2_t v = {lo, hi}; bf16x2_t b = __builtin_convertvector(v, bf16x2_t); return __builtin_bit_cast(unsigned, b); }

__device__ __forceinline__ float bf2f(unsigned short u) { return __uint_as_float((unsigned)u << 16); }
__device__ __forceinline__ float sigmoidf_(float v) { return __builtin_amdgcn_rcpf(1.0f + __builtin_amdgcn_exp2f(-1.4426950408889634f * v)); }
template <int MODE> __device__ __forceinline__ float act_(float v, float b) {
    if (MODE == 1) return v * sigmoidf_(v);
    if (MODE == 2) return sigmoidf_(v + b);
    return v;
}
struct EpiProj {
    static constexpr bool PERM = true, AFTER_DRAIN = false;
    bf16_t* O; int ldc; bf16_t* O1; int ldc1; const float* bgate; int gate_tile0;
    template <int MODE> __device__ __forceinline__ void put(const f32x4 (&acc)[2][2][4][2], bf16_t* base, int ld, int row0, int col0, const float* bias) const {
        f32x4 bv[2][2];
#pragma unroll
        for (int bj = 0; bj < 2; ++bj)
#pragma unroll
            for (int n = 0; n < 2; ++n) bv[bj][n] = (MODE == 2) ? *(const f32x4*)(bias + bj * HALF + 4 * n) : (f32x4){0.f, 0.f, 0.f, 0.f};
#pragma unroll
        for (int ai = 0; ai < 2; ++ai)
#pragma unroll
            for (int m = 0; m < 4; ++m) { bf16_t* rowp = base + (size_t)(row0 + ai * HALF + m * 16) * ld + col0;
#pragma unroll
                for (int bj = 0; bj < 2; ++bj) { f32x4 v0 = acc[ai][bj][m][0], v1 = acc[ai][bj][m][1];
#pragma unroll
                    for (int e = 0; e < 4; ++e) { v0[e] = act_<MODE>(v0[e], bv[bj][0][e]); v1[e] = act_<MODE>(v1[e], bv[bj][1][e]); }
                    u32x4 w; w.x = cvt_pk_bf16(v0[0], v0[1]); w.y = cvt_pk_bf16(v0[2], v0[3]); w.z = cvt_pk_bf16(v1[0], v1[1]); w.w = cvt_pk_bf16(v1[2], v1[3]);
                    *(u32x4*)(rowp + bj * HALF) = w; } }
    }
    __device__ __forceinline__ void operator()(const f32x4 (&acc)[2][2][4][2], const Unit& u, int wr, int wc, int fr, int fq) const {
        const int row0 = u.pm * BM + wr * 64 + fr, col0 = u.pn * BM + wc * 32 + 8 * fq;
        if (u.z == 1) { put<0>(acc, O1, ldc1, row0, col0, nullptr); return; }
        const int t = u.pn;
        const bool is_silu = (t >= 12 && t < 16) || (t >= 32 && t < 36) || (t >= 40 && t < 44);
        if (t >= gate_tile0 && t < 68) put<2>(acc, O, ldc, row0, col0, bgate + (col0 - gate_tile0 * BM));
        else if (is_silu) put<1>(acc, O, ldc, row0, col0, nullptr);
        else put<0>(acc, O, ldc, row0, col0, nullptr);
    }
};
struct EpiMerge {
    static constexpr bool PERM = true, AFTER_DRAIN = false;
    const bf16_t* G; int ldg;
    float* T; bf16_t* O; int ldc;
    __device__ __forceinline__ void operator()(const f32x4 (&acc)[2][2][4][2], const Unit& u, int wr, int wc, int fr, int fq) const {
        const int row0 = u.pm * BM + wr * 64 + fr, col0 = u.pn * BM + wc * 32 + 8 * fq;
#pragma unroll
        for (int ai = 0; ai < 2; ++ai)
#pragma unroll
            for (int m = 0; m < 4; ++m) { const size_t row = (size_t)(row0 + ai * HALF + m * 16);
#pragma unroll
                for (int bj = 0; bj < 2; ++bj) { const int col = col0 + bj * HALF;
                    const u32x4 gw = *(const u32x4*)(G + row * ldg + (size_t)u.z * 2048 + col);
                    f32x4 g0, g1;
                    g0[0] = __uint_as_float(gw.x << 16); g0[1] = __uint_as_float(gw.x & 0xffff0000u); g0[2] = __uint_as_float(gw.y << 16); g0[3] = __uint_as_float(gw.y & 0xffff0000u);
                    g1[0] = __uint_as_float(gw.z << 16); g1[1] = __uint_as_float(gw.z & 0xffff0000u); g1[2] = __uint_as_float(gw.w << 16); g1[3] = __uint_as_float(gw.w & 0xffff0000u);
                    f32x4 v0 = acc[ai][bj][m][0] * g0, v1 = acc[ai][bj][m][1] * g1;
                    float* tp = T + row * ldc + col;
                    if (u.z > 0) { v0 += __builtin_nontemporal_load((const f32x4*)tp); v1 += __builtin_nontemporal_load((const f32x4*)(tp + 4)); }
                    if (u.z < 2) { *(f32x4*)tp = v0; *(f32x4*)(tp + 4) = v1; }
                    else { u32x4 w; w.x = cvt_pk_bf16(v0[0], v0[1]); w.y = cvt_pk_bf16(v0[2], v0[3]); w.z = cvt_pk_bf16(v1[0], v1[1]); w.w = cvt_pk_bf16(v1[2], v1[3]);
                        *(u32x4*)(O + row * ldc + col) = w; } } }
    }
};
struct EpiOut {
    static constexpr bool PERM = false, AFTER_DRAIN = false;
    const float* X; float* Y; int ldc; float* part; int M;
    __device__ __forceinline__ void operator()(const f32x4 (&acc)[2][2][4][2], const Unit& u, int wr, int wc, int fr, int fq) const {
        const int row0 = u.pm * BM + wr * 64 + fr, col0 = u.pn * BM + wc * 32 + 4 * fq;
#pragma unroll
        for (int ai = 0; ai < 2; ++ai)
#pragma unroll
            for (int m = 0; m < 4; ++m) { const size_t row = (size_t)(row0 + ai * HALF + m * 16); float ss = 0.f;
#pragma unroll
                for (int bj = 0; bj < 2; ++bj)
#pragma unroll
                    for (int n = 0; n < 2; ++n) { const size_t off = row * ldc + col0 + bj * HALF + n * 16;
                        const f32x4 y = *(const f32x4*)(X + off) + acc[ai][bj][m][n]; *(f32x4*)(Y + off) = y;
                        ss += (y[0] * y[0] + y[1] * y[1]) + (y[2] * y[2] + y[3] * y[3]); }
                ss += __shfl_xor(ss, 16); ss += __shfl_xor(ss, 32);
                if (fq == 0) part[(size_t)(u.pn * 4 + wc) * M + row] = ss; }
    }
};
struct ProjOrder {
    StaticOrder so; int nmain, extra;
    __device__ void init(int M, int N, int G, int c) { so.init(M, N, G, c); nmain = (so.nwg - c + G - 1) / G; extra = (c >= G - 8) ? c - (G - 8) : -1; }
    __device__ bool next(int i, Unit& u) const {
        if (i < nmain) return so.next(i, u);
        if (i == nmain && extra >= 0) { u.pm = 0; u.pn = extra; u.z = 1; return true; }
        return false;
    }
    __device__ __forceinline__ void a_ready(const Unit&) const {}
    __device__ __forceinline__ void done(const Unit&) const {}
};
struct MergeOrder {
    StaticOrder so;
    __device__ void init(int M, int N, int G, int c) { so.init(M, N, G, c); }
    __device__ bool next(int i, Unit& u) const { if (i >= 3) return false; if (!so.next(0, u)) return false; u.z = i; return true; }
    __device__ __forceinline__ void a_ready(const Unit&) const {}
    __device__ __forceinline__ void done(const Unit&) const {}
};

template <class Epi, class Sched, bool ALIGN_EPI = false, bool SP2 = false>
__device__ __forceinline__ void gemm_phase(PG8_LAS unsigned char* lds, const Gemm g, const Sched& S, const Epi& E, const int wid  ) {
    const int lane = lane_id_v(), tid = wid * 64 + lane, wr = wid >> 2, wc = wid & 3, fr = lane & 15, fq = lane >> 4;
    const int K = g.K, nt = K / BK;
    unsigned voffA[2], voffB[2];
#pragma unroll
    for (int i = 0; i < 2; ++i) { int R, C; stage_rc(tid * 16 + i * 8192, R, C); const int Rb = Epi::PERM ? ((R & ~31) + perm32(R & 31)) : R;
        voffA[i] = (unsigned)(R * K + C) * 2u; voffB[i] = (unsigned)(Rb * K + C) * 2u; }
    const size_t kstep = (size_t)(BK * 2);
    const size_t hstep = (size_t)HALF * K * 2;
    const size_t tstep = 2 * hstep;
    const unsigned ldsw = (unsigned)wid * 1024u;
    const int aoff = lds_byte(wr * 64 + fr, fq * 8), boff = lds_byte(wc * 32 + fr, fq * 8);
#define PG8_SA(b, h) (((b) * 2 + (h)) * HTB)
#define PG8_SB(b, h) ((4 + (b) * 2 + (h)) * HTB)
#define PG8_STAGE(bufoff, gbase, voff) do { _Pragma("unroll") for (int _i = 0; _i < 2; ++_i) \
        __builtin_amdgcn_global_load_lds((const unsigned*)((const char*)(gbase) + (voff)[_i]), (PG8_LAS unsigned*)(lds + (bufoff) + ldsw + _i * 8192), 16, 0, 0); } while (0)
#define PG8_LDA(dst, b, h) do { _Pragma("unroll") for (int m = 0; m < 4; ++m) _Pragma("unroll") for (int k = 0; k < 2; ++k) dst[m][k] = *(const PG8_LAS bf16x8*)(lds + PG8_SA(b, h) + aoff + m * 2048 + k * 1024); } while (0)
#define PG8_LDB(dst, b, h) do { _Pragma("unroll") for (int n = 0; n < 2; ++n) _Pragma("unroll") for (int k = 0; k < 2; ++k) dst[n][k] = *(const PG8_LAS bf16x8*)(lds + PG8_SB(b, h) + boff + n * 2048 + k * 1024); } while (0)
#define PG8_MMA(ai, bj, At, Bt) do { __builtin_amdgcn_s_setprio(1); _Pragma("unroll") for (int m = 0; m < 4; ++m) _Pragma("unroll") for (int n = 0; n < 2; ++n) _Pragma("unroll") for (int k = 0; k < 2; ++k) \
        acc[ai][bj][m][n] = __builtin_amdgcn_mfma_f32_16x16x32_bf16(Bt[n][k], At[m][k], acc[ai][bj][m][n], 0, 0, 0); __builtin_amdgcn_s_setprio(0); } while (0)
#define PG8_WAIT_V(n) asm volatile("s_waitcnt vmcnt(" #n ")" ::: "memory")
#define PG8_WAIT_L(n) asm volatile("s_waitcnt lgkmcnt(" #n ")" ::: "memory")
#define PG8_BAR __builtin_amdgcn_s_barrier()
#define PG8_SCHED __builtin_amdgcn_sched_barrier(0)
    Unit cur, nxt; int ui = 0;
    if (!S.next(0, cur)) return;
    f32x4 acc[2][2][4][2];
#pragma unroll
    for (int a = 0; a < 2; ++a)
#pragma unroll
        for (int b = 0; b < 2; ++b)
#pragma unroll
            for (int m = 0; m < 4; ++m)
#pragma unroll
                for (int n = 0; n < 2; ++n) acc[a][b][m][n] = (f32x4){0.f, 0.f, 0.f, 0.f};
    bf16x8 At[4][2], B0[2][2], B1[2][2];
    const char* cA = (const char*)g.A + (long)cur.z * g.zA + (size_t)cur.pm * tstep; const char* cB = (const char*)g.Bt + (long)cur.z * g.zB + (size_t)cur.pn * tstep;
    S.a_ready(cur);
    if constexpr (SP2) {
        PG8_STAGE(PG8_SB(0, 0), cB, voffB); PG8_STAGE(PG8_SB(0, 1), cB + hstep, voffB); PG8_STAGE(PG8_SA(0, 0), cA, voffA); PG8_STAGE(PG8_SA(0, 1), cA + hstep, voffA);
        if (wr == 1) PG8_BAR;
        PG8_WAIT_V(2); PG8_BAR;
        PG8_STAGE(PG8_SB(1, 0), cB + kstep, voffB); PG8_STAGE(PG8_SA(1, 0), cA + kstep, voffA); PG8_STAGE(PG8_SB(1, 1), cB + hstep + kstep, voffB);
        PG8_WAIT_V(6); PG8_BAR;
    } else {
        PG8_STAGE(PG8_SB(0, 0), cB, voffB); PG8_STAGE(PG8_SA(0, 0), cA, voffA); PG8_STAGE(PG8_SB(0, 1), cB + hstep, voffB); PG8_STAGE(PG8_SA(0, 1), cA + hstep, voffA);
        if (wr == 1) PG8_BAR;
        PG8_WAIT_V(4); PG8_BAR;
        PG8_STAGE(PG8_SB(1, 0), cB + kstep, voffB); PG8_STAGE(PG8_SA(1, 0), cA + kstep, voffA); PG8_STAGE(PG8_SB(1, 1), cB + hstep + kstep, voffB);
        PG8_WAIT_V(6); PG8_BAR;
    }
    for (;;) {
        const bool has_next = S.next(ui + 1, nxt);
        const char* nA = has_next ? (const char*)g.A + (long)nxt.z * g.zA + (size_t)nxt.pm * tstep : cA; const char* nB = has_next ? (const char*)g.Bt + (long)nxt.z * g.zB + (size_t)nxt.pn * tstep : cB;
        for (int t = 0; t < nt; t += 2) {
            const bool last = (t == nt - 2);
            const char* a1 = cA + (size_t)(t + 1) * kstep;
            const char* a2 = last ? nA : cA + (size_t)(t + 2) * kstep; const char* b2 = last ? nB : cB + (size_t)(t + 2) * kstep;
            const char* a3 = a2 + kstep; const char* b3 = b2 + kstep;
            if (last && has_next) S.a_ready(nxt);
            if constexpr (SP2) {
            PG8_LDB(B0, 0, 0); PG8_LDB(B1, 0, 1); PG8_SCHED; PG8_LDA(At, 0, 0); PG8_STAGE(PG8_SA(1, 1), a1 + hstep, voffA);
            PG8_WAIT_V(8); PG8_WAIT_L(0); PG8_BAR; PG8_MMA(0, 0, At, B0); PG8_MMA(0, 1, At, B1); PG8_BAR; PG8_SCHED;
            PG8_LDA(At, 0, 1); PG8_STAGE(PG8_SB(0, 0), b2, voffB); PG8_STAGE(PG8_SB(0, 1), b2 + hstep, voffB); PG8_STAGE(PG8_SA(0, 0), a2, voffA);
            PG8_WAIT_V(8); PG8_WAIT_L(0); PG8_BAR; PG8_MMA(1, 0, At, B0); PG8_MMA(1, 1, At, B1); PG8_BAR; PG8_SCHED;
            PG8_LDB(B0, 1, 0); PG8_LDB(B1, 1, 1); PG8_SCHED; PG8_LDA(At, 1, 0); PG8_STAGE(PG8_SA(0, 1), a2 + hstep, voffA);
            PG8_WAIT_V(8); PG8_WAIT_L(0); PG8_BAR; PG8_MMA(0, 0, At, B0); PG8_MMA(0, 1, At, B1); PG8_BAR; PG8_SCHED;
            PG8_LDA(At, 1, 1); PG8_STAGE(PG8_SB(1, 0), b3, voffB); PG8_STAGE(PG8_SB(1, 1), b3 + hstep, voffB); PG8_STAGE(PG8_SA(1, 0), a3, voffA);
            PG8_WAIT_V(8); PG8_WAIT_L(0); PG8_BAR; PG8_MMA(1, 0, At, B0); PG8_MMA(1, 1, At, B1); PG8_BAR; PG8_SCHED;
            } else {
            PG8_LDB(B0, 0, 0); PG8_SCHED; PG8_LDA(At, 0, 0); PG8_STAGE(PG8_SA(1, 1), a1 + hstep, voffA);
            PG8_WAIT_L(8); PG8_BAR; PG8_WAIT_L(0); PG8_MMA(0, 0, At, B0); PG8_BAR; PG8_SCHED;
            PG8_LDB(B1, 0, 1); PG8_STAGE(PG8_SB(0, 0), b2, voffB);
            PG8_BAR; PG8_WAIT_L(0); PG8_MMA(0, 1, At, B1); PG8_BAR;
            PG8_LDA(At, 0, 1); PG8_STAGE(PG8_SA(0, 0), a2, voffA);
            PG8_BAR; PG8_WAIT_L(0); PG8_MMA(1, 0, At, B0); PG8_BAR; PG8_SCHED;
            PG8_STAGE(PG8_SB(0, 1), b2 + hstep, voffB);
            PG8_WAIT_V(6); PG8_BAR; PG8_MMA(1, 1, At, B1); PG8_BAR;
            PG8_LDB(B0, 1, 0); PG8_SCHED; PG8_LDA(At, 1, 0); PG8_STAGE(PG8_SA(0, 1), a2 + hstep, voffA);
            PG8_WAIT_L(8); PG8_BAR; PG8_WAIT_L(0); PG8_MMA(0, 0, At, B0); PG8_BAR; PG8_SCHED;
            PG8_LDB(B1, 1, 1); PG8_STAGE(PG8_SB(1, 0), b3, voffB);
            PG8_BAR; PG8_WAIT_L(0); PG8_MMA(0, 1, At, B1); PG8_BAR;
            PG8_LDA(At, 1, 1); PG8_STAGE(PG8_SA(1, 0), a3, voffA);
            PG8_BAR; PG8_WAIT_L(0); PG8_MMA(1, 0, At, B0); PG8_BAR; PG8_SCHED;
            PG8_STAGE(PG8_SB(1, 1), b3 + hstep, voffB);
            PG8_WAIT_V(6); PG8_BAR; PG8_MMA(1, 1, At, B1); PG8_BAR;
            }
        }
        if constexpr (ALIGN_EPI) { if (wr == 0) PG8_BAR; }
        if constexpr (!Epi::AFTER_DRAIN) { E(acc, cur, wr, wc, fr, fq); S.done(cur); }
        if (!has_next) break;
#pragma unroll
        for (int a = 0; a < 2; ++a)
#pragma unroll
            for (int b = 0; b < 2; ++b)
#pragma unroll
                for (int m = 0; m < 4; ++m)
#pragma unroll
                    for (int n = 0; n < 2; ++n) acc[a][b][m][n] = (f32x4){0.f, 0.f, 0.f, 0.f};
        cur = nxt; cA = nA; cB = nB; ++ui;
        if constexpr (ALIGN_EPI) { if (wr == 1) PG8_BAR; }
    }
    PG8_WAIT_V(0);
    if constexpr (!ALIGN_EPI) { if (wr == 0) PG8_BAR; }
    PG8_BAR;
    if constexpr (Epi::AFTER_DRAIN) { E.fused(acc, cur, wr, wc, fr, fq, lds, wid, lane); S.done(cur); }
#undef PG8_SA
#undef PG8_SB
#undef PG8_STAGE
#undef PG8_LDA
#undef PG8_LDB
#undef PG8_MMA
#undef PG8_WAIT_V
#undef PG8_WAIT_L
#undef PG8_BAR
#undef PG8_SCHED
}
}

constexpr int S = 8192, DM = 2048, DIN = 17488, NPAD = 17664, NMEM = 256;
constexpr int C_QA = 0, C_KA = 1024, C_VA = 2048, C_ZA = 3072, C_QI = 4096, C_QB = 5120, C_KB = 6144, C_VB = 7168, C_ZB = 8192, C_QM = 9216, C_ZM = 10240, C_GL = 11264, C_KI = 17408, C_WI = 17472;
constexpr int TOPK = 256;
constexpr float RMS_EPS = 1e-6f;
constexpr size_t MiB = 1u << 20;
constexpr size_t WS_CTL = 0;
constexpr size_t WS_WTIN = 1 * MiB;
constexpr size_t WS_U = 1 * MiB;
constexpr size_t WS_WTMKV = 70 * MiB;
constexpr size_t WS_WTBR = 78 * MiB;
constexpr size_t WS_WTOUT = 90 * MiB;
constexpr size_t WS_MEMN = 98 * MiB;
constexpr size_t WS_MKV = 99 * MiB;
constexpr size_t WS_PROJ = 100 * MiB;
constexpr size_t WS_SC = 376 * MiB;
constexpr size_t WS_MERGED = 376 * MiB;
constexpr size_t WS_H = 376 * MiB;
constexpr size_t WS_T = 408 * MiB;
constexpr size_t WS_SEL = 508 * MiB;
constexpr size_t WS_PART = 516 * MiB;
constexpr size_t WS_END = 517 * MiB;

typedef unsigned short bf16_t;
typedef unsigned u32x4 __attribute__((ext_vector_type(4)));
typedef unsigned u32x2 __attribute__((ext_vector_type(2)));
typedef float f32x4 __attribute__((ext_vector_type(4)));
#define LAS __attribute__((address_space(3)))
__device__ __forceinline__ float bf2f(unsigned short u) { return __uint_as_float((unsigned)u << 16); }
__device__ __forceinline__ float bflo(unsigned w) { return __uint_as_float(w << 16); }
__device__ __forceinline__ float bfhi(unsigned w) { return __uint_as_float(w & 0xffff0000u); }
__device__ __forceinline__ unsigned f2bf(float f) { unsigned u = __float_as_uint(f); return (u + 0x7fffu + ((u >> 16) & 1u)) >> 16; }
__device__ __forceinline__ unsigned pk2(float lo, float hi) { return f2bf(lo) | (f2bf(hi) << 16); }
__device__ __forceinline__ float wave_sum(float v) {
#pragma unroll
    for (int o = 1; o < 64; o <<= 1) v += __shfl_xor(v, o);
    return v;
}
__device__ __forceinline__ size_t sc_off(int r) { const size_t i = (size_t)(r >> 8); return 65536ull * (i * (i + 1) / 2) + (size_t)(r & 255) * 256ull * (i + 1); }

struct Args { const float* in[17]; float* out; unsigned char* ws; int ph_lo, ph_hi; };

template <bool MAPIN>
__device__ __forceinline__ void transpose_item(const float* __restrict__ W, int K, int srcN, bf16_t* WT, LAS float* scr, int item, int ndst, int lane) {
    const int nblk = ndst / 32, kb = item / nblk, nb = item % nblk, k0 = 64 * kb, n0 = 32 * nb;
    const int n = n0 + (lane & 31);
    int src = n;
    if (MAPIN) { src = (n < 5120) ? n : (n < 17408) ? n + 80 : (n < 17488) ? n - 17408 + 5120 : -1; }
#pragma unroll 8
    for (int i = 0; i < 32; ++i) { const int kk = 2 * i + (lane >> 5); scr[kk * 33 + (lane & 31)] = (src >= 0) ? W[(size_t)(k0 + kk) * srcN + src] : 0.f; }
    asm volatile("s_waitcnt lgkmcnt(0)" ::: "memory");
    const int c = lane & 7;
#pragma unroll
    for (int j = 0; j < 4; ++j) { const int nn = (lane >> 3) + 8 * j; const LAS float* s = scr + (8 * c) * 33 + nn;
        u32x4 o; o.x = pk2(s[0 * 33], s[1 * 33]); o.y = pk2(s[2 * 33], s[3 * 33]); o.z = pk2(s[4 * 33], s[5 * 33]); o.w = pk2(s[6 * 33], s[7 * 33]);
        *(u32x4*)(WT + (size_t)(n0 + nn) * K + k0 + 8 * c) = o; }
    asm volatile("s_waitcnt lgkmcnt(0)" ::: "memory");
}
__device__ __forceinline__ void rms_row_to_bf16(const float* __restrict__ xrow, const float* __restrict__ g, bf16_t* orow, int lane) {
    const f32x4* xr = (const f32x4*)xrow + lane; const f32x4* gr = (const f32x4*)g + lane;
    f32x4 v[8]; float s = 0.f;
#pragma unroll
    for (int j = 0; j < 8; ++j) { v[j] = xr[64 * j]; s += (v[j].x * v[j].x + v[j].y * v[j].y) + (v[j].z * v[j].z + v[j].w * v[j].w); }
    const float rs = 1.0f / sqrtf(wave_sum(s) * (1.f / DM) + RMS_EPS);
    u32x2* o8 = (u32x2*)orow + lane;
#pragma unroll
    for (int j = 0; j < 8; ++j) { const f32x4 gg = gr[64 * j]; u32x2 w; w.x = pk2(v[j].x * rs * gg.x, v[j].y * rs * gg.y); w.y = pk2(v[j].z * rs * gg.z, v[j].w * rs * gg.w); o8[64 * j] = w; }
}
__device__ __forceinline__ void p0_prologue(const Args& a, LAS unsigned char* lds, int blk, int nblk, const int wave) {
    const int lane = lane_id_v(), tid = wave * 64 + lane;
    LAS float* scr = (LAS float*)(lds + wave * 16384);
    const int gw = blk * 8 + wave, NGW = nblk * 8;
    unsigned char* ws = a.ws;
    constexpr int I_IN = (DM / 64) * (NPAD / 32), I_MKV = (DM / 64) * (2048 / 32), I_BR = (1024 / 64) * (2048 / 32), I_OUT = (DM / 64) * (2048 / 32);
    constexpr int NITEMS = I_IN + I_MKV + 3 * I_BR + I_OUT;
    for (int it = gw; it < NITEMS; it += NGW) {
        int r = it;
        if (r < I_IN) { transpose_item<true>(a.in[3], DM, DIN, (bf16_t*)(ws + WS_WTIN), scr, r, NPAD, lane); continue; } r -= I_IN;
        if (r < I_MKV) { transpose_item<false>(a.in[11], DM, 2048, (bf16_t*)(ws + WS_WTMKV), scr, r, 2048, lane); continue; } r -= I_MKV;
        if (r < 3 * I_BR) { const int z = r / I_BR; transpose_item<false>(a.in[12 + z], 1024, 2048, (bf16_t*)(ws + WS_WTBR) + (size_t)z * 2048 * 1024, scr, r % I_BR, 2048, lane); continue; } r -= 3 * I_BR;
        transpose_item<false>(a.in[15], DM, 2048, (bf16_t*)(ws + WS_WTOUT), scr, r, 2048, lane);
    }
    bf16_t* H = (bf16_t*)(ws + WS_H);
    for (int m = gw; m < S + NMEM; m += NGW) {
        if (m < S) rms_row_to_bf16(a.in[0] + (size_t)m * DM, a.in[2], H + (size_t)m * DM, lane);
        else rms_row_to_bf16(a.in[1] + (size_t)(m - S) * DM, a.in[10], (bf16_t*)(ws + WS_MEMN) + (size_t)(m - S) * DM, lane);
    }
    if (blk == 0 && wave == 0) {
        const float s1 = wave_sum(a.in[5][lane] * a.in[6][lane]), s2 = wave_sum(a.in[7][lane] * a.in[8][lane]);
        if (lane == 0) ((float*)(ws + WS_CTL))[0] = expf(s1) - expf(s2) + 0.2f;
    }
}

__device__ __forceinline__ void idx_scores_naive(const bf16_t* __restrict__ PROJ, float* SC, LAS unsigned char* lds, int blk, int nblk, const int wave) {
    const int lane = lane_id_v(), tid = wave * 64 + lane;
    LAS float* qs = (LAS float*)lds + wave * 1088;
    constexpr int NITEM = 128 * 129 / 2;
    for (int it = blk; it < NITEM; it += nblk) {
        int kb = 0, rem = it; while (rem >= 128 - kb) { rem -= 128 - kb; ++kb; }
        const int qc = kb + rem, s = 64 * kb + lane;
        float kreg[64];
        { const u32x4* kp = (const u32x4*)(PROJ + (size_t)s * NPAD + C_KI);
#pragma unroll
          for (int i = 0; i < 8; ++i) { const u32x4 w = kp[i]; kreg[8 * i + 0] = bflo(w.x); kreg[8 * i + 1] = bfhi(w.x); kreg[8 * i + 2] = bflo(w.y); kreg[8 * i + 3] = bfhi(w.y);
              kreg[8 * i + 4] = bflo(w.z); kreg[8 * i + 5] = bfhi(w.z); kreg[8 * i + 6] = bflo(w.w); kreg[8 * i + 7] = bfhi(w.w); } }
        for (int qq = 0; qq < 8; ++qq) {
            const int q = 64 * qc + wave * 8 + qq;
            { const u32x4* qp = (const u32x4*)(PROJ + (size_t)q * NPAD + C_QI) + 2 * lane;
              const u32x4 w0 = qp[0], w1 = qp[1];
              LAS f32x4* dst = (LAS f32x4*)(qs + 16 * lane);
              dst[0] = (f32x4){bflo(w0.x), bfhi(w0.x), bflo(w0.y), bfhi(w0.y)}; dst[1] = (f32x4){bflo(w0.z), bfhi(w0.z), bflo(w0.w), bfhi(w0.w)};
              dst[2] = (f32x4){bflo(w1.x), bfhi(w1.x), bflo(w1.y), bfhi(w1.y)}; dst[3] = (f32x4){bflo(w1.z), bfhi(w1.z), bflo(w1.w), bfhi(w1.w)};
              if (lane < 16) qs[1024 + lane] = bf2f(PROJ[(size_t)q * NPAD + C_WI + lane]) * 0.25f; }
            asm volatile("s_waitcnt lgkmcnt(0)" ::: "memory"); __builtin_amdgcn_wave_barrier();
            float score = 0.f;
            for (int j = 0; j < 16; ++j) {
                float acc = 0.f; const LAS f32x4* qj = (const LAS f32x4*)(qs + 64 * j);
#pragma unroll
                for (int d = 0; d < 16; ++d) { const f32x4 qv = qj[d]; acc += qv.x * kreg[4 * d] + qv.y * kreg[4 * d + 1] + qv.z * kreg[4 * d + 2] + qv.w * kreg[4 * d + 3]; }
                score += fmaxf(acc * 0.125f, 0.f) * qs[1024 + j];
            }
            if (s <= q) SC[sc_off(q) + s] = score;
            asm volatile("s_waitcnt lgkmcnt(0)" ::: "memory"); __builtin_amdgcn_wave_barrier();
        }
    }
}
__device__ __forceinline__ unsigned ordkey(float f) { const unsigned u = __float_as_uint(f); return (u & 0x80000000u) ? ~u : (u | 0x80000000u); }
template <int NR, int NL> __device__ __forceinline__ bool topk_row(const float* __restrict__ row, int n, int lane, LAS u32x4* xl, unsigned long long& w0, unsigned long long& w1, unsigned& Tout, int& need_out) {
#pragma unroll
    for (int q = 0; q < NL / 4; ++q) { u32x4 v;
#pragma unroll
        for (int e = 0; e < 4; ++e) { const int i = 4096 + (4 * q + e) * 64 + lane; v[e] = (ordkey(*(const float*)((const char*)row + 4u * (unsigned)min(i, n - 1))) >> 1) & (unsigned)((i - n) >> 31); }
        xl[q * 64 + lane] = v;
        if ((q & 3) == 3) __builtin_amdgcn_sched_barrier(0); }
    unsigned u[NR];
#pragma unroll
    for (int k = 0; k < NR; ++k) { const int i = k * 64 + lane; u[k] = (ordkey(*(const float*)((const char*)row + 4u * (unsigned)min(i, n - 1))) >> 1) & (unsigned)((i - n) >> 31);
        if ((k & 15) == 15) __builtin_amdgcn_sched_barrier(0); }
    unsigned T = 0u;
    for (int bit = 30; bit >= 0; --bit) {
        const unsigned cand = T | (1u << bit); unsigned lt = 0u;
        asm volatile("" ::: "memory");
#pragma unroll
        for (int k = 0; k < NR; ++k) lt += (u[k] - cand) >> 31;
#pragma unroll
        for (int q = 0; q < NL / 4; ++q) { const u32x4 v = xl[q * 64 + lane]; lt += ((v[0] - cand) >> 31) + ((v[1] - cand) >> 31) + ((v[2] - cand) >> 31) + ((v[3] - cand) >> 31);
            if ((q & 3) == 3) __builtin_amdgcn_sched_barrier(0); }
#pragma unroll
        for (int o = 1; o < 64; o <<= 1) lt += __shfl_xor(lt, o);
        if ((int)((NR + NL) * 64 - lt) >= TOPK) T = cand;
    }
    unsigned c_hi = 0u, c_lt = 0u;
#pragma unroll
    for (int k = 0; k < NR; ++k) { c_hi += (T - u[k]) >> 31; c_lt += (u[k] - T) >> 31; }
#pragma unroll
    for (int q = 0; q < NL / 4; ++q) { const u32x4 v = xl[q * 64 + lane];
#pragma unroll
        for (int e = 0; e < 4; ++e) { c_hi += (T - v[e]) >> 31; c_lt += (v[e] - T) >> 31; } }
#pragma unroll
    for (int o = 1; o < 64; o <<= 1) { c_hi += __shfl_xor(c_hi, o); c_lt += __shfl_xor(c_lt, o); }
    const int need = TOPK - (int)c_hi, c_eq = (NR + NL) * 64 - (int)c_lt - (int)c_hi;
    Tout = T; need_out = need;
    if (c_eq != need) return false;
    int ln; asm volatile("v_mbcnt_lo_u32_b32 %0, -1, 0\n\tv_mbcnt_hi_u32_b32 %0, -1, %0" : "=v"(ln));
#pragma unroll
    for (int k = 0; k < NR; ++k) {
        const unsigned long long bs = __ballot(u[k] >= T);
        if (k == ln) w0 = bs;
        __builtin_amdgcn_sched_barrier(0); }
#pragma unroll
    for (int q = 0; q < NL / 4; ++q) { const u32x4 v = xl[q * 64 + lane];
#pragma unroll
        for (int e = 0; e < 4; ++e) { const unsigned long long bs = __ballot(v[e] >= T);
            if (4 * q + e == ln) w1 = bs;
            __builtin_amdgcn_sched_barrier(0); } }
    return true;
}
__device__ __forceinline__ void topk_select(const float* SC, int* SEL, LAS unsigned char* lds, int blk, int nblk, const int wave) {
    const int lane = lane_id_v();
    LAS u32x4* xl = (LAS u32x4*)(lds + wave * 16384);
    for (int r = blk * 8 + wave; r < S; r += nblk * 8) {
        const int n = r + 1; unsigned long long* mrow = (unsigned long long*)SEL + (size_t)r * 128;
        unsigned long long w0 = 0ull, w1 = 0ull;
        const int nwords = 4 * ((r >> 8) + 1);
        if (n <= TOPK) { const int lo = 64 * lane; w0 = (r < lo) ? 0ull : ((r - lo >= 63) ? ~0ull : ((2ull << (r - lo)) - 1ull)); }
        else { const float* row = SC + sc_off(r);
            unsigned T; int need; bool ok;
            if (n <= 2048) ok = topk_row<32, 0>(row, n, lane, xl, w0, w1, T, need); else if (n <= 4096) ok = topk_row<64, 0>(row, n, lane, xl, w0, w1, T, need); else ok = topk_row<64, 64>(row, n, lane, xl, w0, w1, T, need);
            if (!ok) { int eqc = 0; const unsigned long long lt = (lane == 0) ? 0ull : (~0ull >> (64 - lane));
                for (int base = 0, it = 0; base < n; base += 64, ++it) {
                    const int i = base + lane; const unsigned v = (i < n) ? (ordkey(row[i]) >> 1) : 0u;
                    const bool gt = v > T, eq = (i < n) && (v == T);
                    const unsigned long long be = __ballot(eq);
                    const bool take = gt || (eq && (eqc + __builtin_popcountll(be & lt) < need));
                    const unsigned long long bs = __ballot(take);
                    if ((it & 63) == lane) { if (it < 64) w0 = bs; else w1 = bs; }
                    eqc += __builtin_popcountll(be); } } }
        if (lane < nwords) mrow[lane] = w0;
        if (64 + lane < nwords) mrow[64 + lane] = w1;
    }
}
template <int DQ, int DV, bool GATHER>
__device__ __forceinline__ void naive_attn(const bf16_t* __restrict__ qp, const bf16_t* __restrict__ kb, const bf16_t* __restrict__ vb, size_t kvpitch,
                                           int nkeys, int nmax, const int* __restrict__ sel, int r, float scale, float slope, float (&o)[DV / 8]) {
    constexpr int QN = DQ / 8, VN = DV / 8;
    float q[QN];
#pragma unroll
    for (int i = 0; i < QN / 2; ++i) { const unsigned w = ((const unsigned*)qp)[i]; q[2 * i] = bflo(w) * scale; q[2 * i + 1] = bfhi(w) * scale; }
#pragma unroll
    for (int i = 0; i < VN; ++i) o[i] = 0.f;
    float m = -1e30f, l = 0.f;
    for (int i = 0; i < nmax; ++i) {
        bool valid = i < nkeys; int key = i;
        if (GATHER) { key = sel[valid ? i : 0]; valid = valid && key >= 0; }
        if (!valid) key = 0;
        const unsigned* kp = (const unsigned*)(kb + (size_t)key * kvpitch);
        float d = 0.f;
#pragma unroll
        for (int j = 0; j < QN / 2; ++j) { const unsigned w = kp[j]; d += q[2 * j] * bflo(w) + q[2 * j + 1] * bfhi(w); }
        d += __shfl_xor(d, 1); d += __shfl_xor(d, 2); d += __shfl_xor(d, 4);
        const float logit = d - slope * (float)(r - key);
        if (valid) {
            if (logit > m) { const float c = __expf(m - logit); l *= c;
#pragma unroll
                for (int j = 0; j < VN; ++j) o[j] *= c;
                m = logit; }
            const float p = __expf(logit - m); l += p;
            const unsigned* vp = (const unsigned*)(vb + (size_t)key * kvpitch);
#pragma unroll
            for (int j = 0; j < VN / 2; ++j) { const unsigned w = vp[j]; o[2 * j] += p * bflo(w); o[2 * j + 1] += p * bfhi(w); }
        }
    }
    const float il = 1.0f / l;
#pragma unroll
    for (int j = 0; j < VN; ++j) o[j] *= il;
}
__device__ __forceinline__ void attn_b_naive(const Args& a, int blk, int nblk, const int wave) {
    const int lane = lane_id_v(), tid = wave * 64 + lane, sub = lane & 7;
    const bf16_t* PROJ = (const bf16_t*)(a.ws + WS_PROJ); bf16_t* UB = (bf16_t*)(a.ws + WS_U) + (size_t)1 * S * 1024;
    const float lam = ((const float*)(a.ws + WS_CTL))[0];
    for (int wi = blk * 8 + wave; wi < 1024 * 8; wi += nblk * 8) {
        const int h = wi & 7, rg = wi >> 3, r = rg * 8 + (lane >> 3), nmax = rg * 8 + 8;
        const float slope = exp2f(-(float)(h + 1));
        float o0[16], o1[16];
        const bf16_t* rowp = PROJ + (size_t)r * NPAD;
        naive_attn<64, 128, false>(rowp + C_QB + h * 128 + sub * 8, PROJ + C_KB + h * 128 + sub * 8, PROJ + C_VB + h * 128 + sub * 16, NPAD, r + 1, nmax, nullptr, r, 0.125f, slope, o0);
        naive_attn<64, 128, false>(rowp + C_QB + h * 128 + 64 + sub * 8, PROJ + C_KB + h * 128 + 64 + sub * 8, PROJ + C_VB + h * 128 + sub * 16, NPAD, r + 1, nmax, nullptr, r, 0.125f, slope, o1);
        float ss = 0.f;
#pragma unroll
        for (int j = 0; j < 16; ++j) { o0[j] -= lam * o1[j]; ss += o0[j] * o0[j]; }
        ss += __shfl_xor(ss, 1); ss += __shfl_xor(ss, 2); ss += __shfl_xor(ss, 4);
        const float rs = 1.0f / sqrtf(ss * (1.f / 128.f) + RMS_EPS) * 0.8f;
        const float* g = a.in[9] + sub * 16; const bf16_t* zp = rowp + C_ZB + h * 128 + sub * 16;
        unsigned w[8];
#pragma unroll
        for (int j = 0; j < 8; ++j) w[j] = pk2(o0[2 * j] * rs * g[2 * j] * bf2f(zp[2 * j]), o0[2 * j + 1] * rs * g[2 * j + 1] * bf2f(zp[2 * j + 1]));
        u32x4* dst = (u32x4*)(UB + (size_t)r * 1024 + h * 128 + sub * 16);
        dst[0] = (u32x4){w[0], w[1], w[2], w[3]}; dst[1] = (u32x4){w[4], w[5], w[6], w[7]};
    }
}
__device__ __forceinline__ void attn_m_naive(const Args& a, int blk, int nblk, const int wave) {
    const int lane = lane_id_v(), tid = wave * 64 + lane, sub = lane & 7;
    const bf16_t* PROJ = (const bf16_t*)(a.ws + WS_PROJ); const bf16_t* MKV = (const bf16_t*)(a.ws + WS_MKV); bf16_t* UM = (bf16_t*)(a.ws + WS_U) + (size_t)2 * S * 1024;
    for (int wi = blk * 8 + wave; wi < 1024 * 4; wi += nblk * 8) {
        const int h = wi & 3, rg = wi >> 2, r = rg * 8 + (lane >> 3);
        float o[32];
        const bf16_t* rowp = PROJ + (size_t)r * NPAD;
        naive_attn<256, 256, false>(rowp + C_QM + h * 256 + sub * 32, MKV + h * 256 + sub * 32, MKV + 1024 + h * 256 + sub * 32, 2048, NMEM, NMEM, nullptr, 0, 0.0625f, 0.f, o);
        const bf16_t* zp = rowp + C_ZM + h * 256 + sub * 32;
        u32x4* dst = (u32x4*)(UM + (size_t)r * 1024 + h * 256 + sub * 32);
#pragma unroll
        for (int j = 0; j < 4; ++j) { u32x4 w;
            w.x = pk2(o[8 * j + 0] * bf2f(zp[8 * j + 0]), o[8 * j + 1] * bf2f(zp[8 * j + 1])); w.y = pk2(o[8 * j + 2] * bf2f(zp[8 * j + 2]), o[8 * j + 3] * bf2f(zp[8 * j + 3]));
            w.z = pk2(o[8 * j + 4] * bf2f(zp[8 * j + 4]), o[8 * j + 5] * bf2f(zp[8 * j + 5])); w.w = pk2(o[8 * j + 6] * bf2f(zp[8 * j + 6]), o[8 * j + 7] * bf2f(zp[8 * j + 7]));
            dst[j] = w; }
    }
}
__device__ __forceinline__ void attn_a_naive(const Args& a, int blk, int nblk, const int wave) {
    const int lane = lane_id_v(), tid = wave * 64 + lane, sub = lane & 7;
    const bf16_t* PROJ = (const bf16_t*)(a.ws + WS_PROJ); const int* SEL = (const int*)(a.ws + WS_SEL); bf16_t* UA = (bf16_t*)(a.ws + WS_U);
    for (int wi = blk * 8 + wave; wi < 1024 * 8; wi += nblk * 8) {
        const int h = wi & 7, rg = wi >> 3, r = rg * 8 + (lane >> 3);
        const float slope = exp2f(-(float)(h + 1));
        float o[16];
        const bf16_t* rowp = PROJ + (size_t)r * NPAD;
        naive_attn<128, 128, true>(rowp + C_QA + h * 128 + sub * 16, PROJ + C_KA + h * 128 + sub * 16, PROJ + C_VA + h * 128 + sub * 16, NPAD, TOPK, TOPK, SEL + (size_t)r * TOPK, r, 0.08838834764831845f, slope, o);
        const bf16_t* zp = rowp + C_ZA + h * 128 + sub * 16;
        unsigned w[8];
#pragma unroll
        for (int j = 0; j < 8; ++j) w[j] = pk2(o[2 * j] * bf2f(zp[2 * j]), o[2 * j + 1] * bf2f(zp[2 * j + 1]));
        u32x4* dst = (u32x4*)(UA + (size_t)r * 1024 + h * 128 + sub * 16);
        dst[0] = (u32x4){w[0], w[1], w[2], w[3]}; dst[1] = (u32x4){w[4], w[5], w[6], w[7]};
    }
}
__device__ __forceinline__ void final_norm(const Args& a, int blk, int nblk, const int wave) {
    const int lane = lane_id_v(), tid = wave * 64 + lane;
    const float* part = (const float*)(a.ws + WS_PART); const f32x4* g = (const f32x4*)a.in[16] + lane;
    for (int r = blk * 8 + wave; r < S; r += nblk * 8) {
        float s = (lane < 32) ? part[(size_t)lane * S + r] : 0.f;
        const float rs = 1.0f / sqrtf(wave_sum(s) * (1.f / DM) + RMS_EPS);
        f32x4* y = (f32x4*)(a.out + (size_t)r * DM) + lane;
#pragma unroll
        for (int j = 0; j < 8; ++j) { f32x4 v = y[64 * j]; const f32x4 gg = g[64 * j]; v = v * rs * gg; y[64 * j] = v; }
    }
}


namespace att {
typedef short bf16x8 __attribute__((ext_vector_type(8)));
typedef short s16x4 __attribute__((ext_vector_type(4)));
typedef float f32x16 __attribute__((ext_vector_type(16)));
typedef float f32x2_t __attribute__((ext_vector_type(2)));
typedef __bf16 bf16x2_t __attribute__((ext_vector_type(2)));
constexpr int SHM_V = 16384, SHM_K = 16384;
constexpr float LOG2E = 1.4426950408889634f;
constexpr float THR2 = 8.f * LOG2E;
#define KSWZ(row, colB) ((row) * 256 + ((colB) ^ (((row) & 7) << 4)))
#define SBAR() __builtin_amdgcn_sched_barrier(0)
__device__ __forceinline__ int crow(int r, int hi) { return (r & 3) + 8 * (r >> 2) + 4 * hi; }
__device__ __forceinline__ unsigned cvtpk(float lo, float hi) { f32x2_t v = {lo, hi}; bf16x2_t b = __builtin_convertvector(v, bf16x2_t); return __builtin_bit_cast(unsigned, b); }
__device__ __forceinline__ int v_st(int k, int c) { const int kk = (k & ~0xC) | ((k & 4) << 1) | ((k & 8) >> 1); return ((kk >> 3) * 4 + (c >> 5)) * 512 + ((kk & 7) * 32 + (c & 31)) * 2; }
__device__ __forceinline__ int v_rd_base(int lane) { return ((lane & 3) << 3) | (((lane >> 2) & 3) << 6) | (((lane >> 4) & 1) << 5) | (((lane >> 5) & 1) << 8); }
constexpr int v_rd_off(int d0, int ks, int half) { return d0 * 512 + ks * 4096 + half * 2048; }
typedef short v4i16_t __attribute__((ext_vector_type(4)));
__device__ __forceinline__ s16x4 tr_read(LAS const unsigned char* p) { return __builtin_bit_cast(s16x4, __builtin_amdgcn_ds_read_tr16_b64_v4i16((LAS v4i16_t*)p)); }

template <int NQ> __device__ __forceinline__ void qkt(f32x16& p0, f32x16& p1, LAS const unsigned char* Ks, const bf16x8* qr, int cbyte0, int r32, int hi) {
  p0 = f32x16{}; p1 = f32x16{};
#pragma unroll
  for (int d0 = 0; d0 < NQ; ++d0) { const int cb = cbyte0 + (d0 * 16 + hi * 8) * 2;
    const bf16x8 b0 = *(LAS const bf16x8*)(Ks + KSWZ(r32, cb));
    const bf16x8 b1 = *(LAS const bf16x8*)(Ks + KSWZ(32 + r32, cb));
    p0 = __builtin_amdgcn_mfma_f32_32x32x16_bf16(b0, qr[d0], p0, 0, 0, 0);
    p1 = __builtin_amdgcn_mfma_f32_32x32x16_bf16(b1, qr[d0], p1, 0, 0, 0); }
}
template <int D0> __device__ __forceinline__ void pv_one(f32x16& od, LAS const unsigned char* vb, bf16x8 pa0, bf16x8 pa1, bf16x8 pa2, bf16x8 pa3) {
  const s16x4 l0 = tr_read(vb + v_rd_off(D0, 0, 0)), h0 = tr_read(vb + v_rd_off(D0, 0, 1)), l1 = tr_read(vb + v_rd_off(D0, 1, 0)), h1 = tr_read(vb + v_rd_off(D0, 1, 1));
  const s16x4 l2 = tr_read(vb + v_rd_off(D0, 2, 0)), h2 = tr_read(vb + v_rd_off(D0, 2, 1)), l3 = tr_read(vb + v_rd_off(D0, 3, 0)), h3 = tr_read(vb + v_rd_off(D0, 3, 1));
#define PK(L, H) (bf16x8){L[0], L[1], L[2], L[3], H[0], H[1], H[2], H[3]}
  od = __builtin_amdgcn_mfma_f32_32x32x16_bf16(pa0, PK(l0, h0), od, 0, 0, 0);
  od = __builtin_amdgcn_mfma_f32_32x32x16_bf16(pa1, PK(l1, h1), od, 0, 0, 0);
  od = __builtin_amdgcn_mfma_f32_32x32x16_bf16(pa2, PK(l2, h2), od, 0, 0, 0);
  od = __builtin_amdgcn_mfma_f32_32x32x16_bf16(pa3, PK(l3, h3), od, 0, 0, 0);
#undef PK
}
__device__ __forceinline__ void pv_d0(f32x16* o, LAS const unsigned char* vb, bf16x8 pa0, bf16x8 pa1, bf16x8 pa2, bf16x8 pa3) {
  pv_one<0>(o[0], vb, pa0, pa1, pa2, pa3); pv_one<1>(o[1], vb, pa0, pa1, pa2, pa3); pv_one<2>(o[2], vb, pa0, pa1, pa2, pa3); pv_one<3>(o[3], vb, pa0, pa1, pa2, pa3);
}
template <bool CAUSAL> __device__ __forceinline__ void partialSM(f32x16& p0, f32x16& p1, float& m_reg, float& alpha, const float (&cs)[16], float base, int lim, float C, float slope2, int delta) {
  const float tb0 = slope2 * (float)delta + base, tb1 = slope2 * (float)(delta + 32) + base;
#pragma unroll
  for (int r = 0; r < 16; ++r) { p0[r] = fmaf(p0[r], C, cs[r]); p1[r] = fmaf(p1[r], C, cs[r]); }
  if (CAUSAL && delta + 63 > 0) {
    const int l0 = lim - delta, l1 = l0 - 32;
#pragma unroll
    for (int r = 0; r < 16; ++r) { const int K = (r & 3) + 8 * (r >> 2); if (K > l0) p0[r] = -INFINITY; if (K > l1) p1[r] = -INFINITY; }
  }
  float pm0 = p0[0], pm1 = p1[0];
#pragma unroll
  for (int r = 1; r < 16; ++r) { pm0 = fmaxf(pm0, p0[r]); pm1 = fmaxf(pm1, p1[r]); }
  float pmax = fmaxf(pm0 + tb0, pm1 + tb1);
  { auto rr = __builtin_amdgcn_permlane32_swap(__float_as_uint(pmax), __float_as_uint(pmax), false, false);
    pmax = fmaxf(__uint_as_float(rr[0]), __uint_as_float(rr[1])); }
  float mn;
  if (__builtin_expect(__all(pmax - m_reg <= THR2), 1)) { mn = m_reg; alpha = 1.f; }
  else { mn = fmaxf(m_reg, pmax); alpha = __builtin_amdgcn_exp2f(m_reg - mn); m_reg = mn; }
  const float a0 = tb0 - mn, a1 = tb1 - mn;
#pragma unroll
  for (int r = 0; r < 16; ++r) { p0[r] += a0; p1[r] += a1; }
#pragma unroll
  for (int r = 0; r < 16; ++r) p0[r] = __builtin_amdgcn_exp2f(p0[r]);
}
__device__ __forceinline__ void finishSM(f32x16& p0, f32x16& p1, float alpha, float& l_reg, bf16x8& pa0, bf16x8& pa1, bf16x8& pa2, bf16x8& pa3) {
#pragma unroll
  for (int r = 0; r < 16; ++r) p1[r] = __builtin_amdgcn_exp2f(p1[r]);
  float ps = 0;
#pragma unroll
  for (int r = 0; r < 16; ++r) ps += p0[r];
#pragma unroll
  for (int r = 0; r < 16; ++r) ps += p1[r];
  { auto rr = __builtin_amdgcn_permlane32_swap(__float_as_uint(ps), __float_as_uint(ps), false, false);
    ps = __uint_as_float(rr[0]) + __uint_as_float(rr[1]); }
  l_reg = l_reg * alpha + ps;
#define PK4(P, BASE, OUT) do { unsigned a0 = cvtpk(P[BASE + 0], P[BASE + 1]), a1 = cvtpk(P[BASE + 2], P[BASE + 3]);   \
    unsigned b0 = cvtpk(P[BASE + 4], P[BASE + 5]), b1 = cvtpk(P[BASE + 6], P[BASE + 7]);                              \
    auto r0 = __builtin_amdgcn_permlane32_swap(a0, b0, false, false); auto r1 = __builtin_amdgcn_permlane32_swap(a1, b1, false, false); \
    u32x4 w = {r0[0], r1[0], r0[1], r1[1]}; OUT = __builtin_bit_cast(bf16x8, w); } while (0)
  PK4(p0, 0, pa0); PK4(p0, 8, pa1); PK4(p1, 0, pa2); PK4(p1, 8, pa3);
#undef PK4
}

__device__ __forceinline__ void attn_b_unit(const bf16_t* __restrict__ PROJ, bf16_t* UB, const float* __restrict__ gsub, float lam, int h, int qb, LAS unsigned char* lds, const int wid) {
  const int lane = lane_id_v(), tid = wid * 64 + lane, r32 = lane & 31, hi = lane >> 5, comp = wid >> 2, wq = wid & 3;
  const int R0 = qb * 128, qrow0 = R0 + wq * 32, NT = 2 * qb + 2;
  LAS unsigned char* V_lds = lds; LAS unsigned char* K_lds = lds + 2 * SHM_V;
  LAS float* ws = (LAS float*)(lds + 2 * SHM_V + 2 * SHM_K) + wid * 64; LAS float* li_l = ws; LAS float* al_l = ws + 32;
  LAS float* xch = (LAS float*)(lds + 2 * SHM_V + 2 * SHM_K + 2048);
  const float slope2 = __builtin_amdgcn_exp2f(-(float)(h + 1)) * LOG2E, C = 0.125f * LOG2E;
  float cs[16];
#pragma unroll
  for (int r = 0; r < 16; ++r) cs[r] = __uint_as_float(__builtin_amdgcn_readfirstlane(__float_as_uint(slope2 * (float)((r & 3) + 8 * (r >> 2)))));
  const float base = slope2 * (float)(4 * hi - r32); const int lim = r32 - 4 * hi;
  float m_reg = -1e30f, l_reg = 0; f32x16 o[4] = {}; bf16x8 qr[4];
  { const bf16_t* Qw = PROJ + (size_t)(qrow0 + r32) * NPAD + C_QB + h * 128 + comp * 64 + hi * 8;
#pragma unroll
    for (int d0 = 0; d0 < 4; ++d0) qr[d0] = *(const bf16x8*)(Qw + d0 * 16); }
  const unsigned offK = (unsigned)((tid >> 4) * NPAD + C_KB + h * 128 + (tid & 15) * 8) * 2u, offV = offK + (unsigned)(C_VB - C_KB) * 2u;
  const int sr = tid >> 4, sc = (tid & 15) * 8, vst0 = v_st(sr, sc), vst1 = v_st(32 + sr, sc), cq = comp * 128;
  LAS const unsigned char* vb0 = V_lds + v_rd_base(lane);
  struct { bf16x8 vs0, vs1, ks0, ks1; } sr_;
#define KEY0(t) (64 * (NT - 1 - (t)))
#define GLD16(off) (*(const bf16x8*)((const char*)PROJ + (unsigned)(off)))
#define SLOAD(k0) do { const unsigned kb_ = (unsigned)(k0) * (unsigned)(NPAD * 2); sr_.vs0 = GLD16(offV + kb_); sr_.vs1 = GLD16(offV + kb_ + 32u * NPAD * 2u); \
    sr_.ks0 = GLD16(offK + kb_); sr_.ks1 = GLD16(offK + kb_ + 32u * NPAD * 2u); } while (0)
#define SWRITE(b) do { *(LAS bf16x8*)(V_lds + (b) * SHM_V + vst0) = sr_.vs0; *(LAS bf16x8*)(V_lds + (b) * SHM_V + vst1) = sr_.vs1; const int kc = sc * 2; \
    *(LAS bf16x8*)(K_lds + (b) * SHM_K + KSWZ(sr, kc)) = sr_.ks0; *(LAS bf16x8*)(K_lds + (b) * SHM_K + KSWZ(32 + sr, kc)) = sr_.ks1; } while (0)
#define RESC(a) do { if (__any((a) < 1.f)) { if (hi == 0) al_l[r32] = (a); asm volatile("s_waitcnt lgkmcnt(0)" ::: "memory"); \
    _Pragma("unroll") for (int d = 0; d < 4; ++d) _Pragma("unroll") for (int r = 0; r < 16; ++r) o[d][r] *= al_l[crow(r, hi)]; } } while (0)
  f32x16 pA0, pA1, pB0, pB1; float alA, alB; bf16x8 pa0, pa1, pa2, pa3;
  SLOAD(KEY0(0)); SWRITE(0); __syncthreads();
  qkt<4>(pA0, pA1, K_lds, qr, cq, r32, hi); partialSM<true>(pA0, pA1, m_reg, alA, cs, base, lim, C, slope2, KEY0(0) - qrow0);
  SLOAD(KEY0(1)); SWRITE(1); __syncthreads();
  for (int j = 1; j + 1 < NT; j += 2) {
    SBAR(); qkt<4>(pB0, pB1, K_lds + SHM_K, qr, cq, r32, hi);
    finishSM(pA0, pA1, alA, l_reg, pa0, pa1, pa2, pa3); SBAR();
    SLOAD(KEY0(j + 1)); SBAR();
    pv_d0(o, vb0, pa0, pa1, pa2, pa3); partialSM<true>(pB0, pB1, m_reg, alB, cs, base, lim, C, slope2, KEY0(j) - qrow0);
    __syncthreads(); SWRITE(0);
    RESC(alB); __syncthreads();
    SBAR(); qkt<4>(pA0, pA1, K_lds, qr, cq, r32, hi);
    finishSM(pB0, pB1, alB, l_reg, pa0, pa1, pa2, pa3); SBAR();
    SLOAD(KEY0(j + 2)); SBAR();
    pv_d0(o, vb0 + SHM_V, pa0, pa1, pa2, pa3); partialSM<true>(pA0, pA1, m_reg, alA, cs, base, lim, C, slope2, KEY0(j + 1) - qrow0);
    __syncthreads(); SWRITE(1);
    RESC(alA); __syncthreads();
  }
  SBAR(); qkt<4>(pB0, pB1, K_lds + SHM_K, qr, cq, r32, hi);
  finishSM(pA0, pA1, alA, l_reg, pa0, pa1, pa2, pa3); SBAR();
  pv_d0(o, vb0, pa0, pa1, pa2, pa3); partialSM<true>(pB0, pB1, m_reg, alB, cs, base, lim, C, slope2, KEY0(NT - 1) - qrow0);
  __syncthreads(); RESC(alB);
  finishSM(pB0, pB1, alB, l_reg, pa0, pa1, pa2, pa3); SBAR();
  pv_d0(o, vb0 + SHM_V, pa0, pa1, pa2, pa3);
#undef KEY0
#undef SLOAD
#undef GLD16
#undef SWRITE
#undef RESC
  if (hi == 0) li_l[r32] = l_reg; asm volatile("s_waitcnt lgkmcnt(0)" ::: "memory");
  float rli[16];
#pragma unroll
  for (int r = 0; r < 16; ++r) rli[r] = __builtin_amdgcn_rcpf(li_l[crow(r, hi)]);
  if (comp == 1) {
#pragma unroll
    for (int d0 = 0; d0 < 4; ++d0)
#pragma unroll
      for (int r = 0; r < 16; ++r) xch[(wq * 64 + d0 * 16 + r) * 64 + lane] = o[d0][r] * rli[r] * lam;
  }
  __syncthreads();
  if (comp == 0) {
    float ss[16];
#pragma unroll
    for (int r = 0; r < 16; ++r) ss[r] = 0.f;
#pragma unroll
    for (int d0 = 0; d0 < 4; ++d0)
#pragma unroll
      for (int r = 0; r < 16; ++r) { const float d = o[d0][r] * rli[r] - xch[(wq * 64 + d0 * 16 + r) * 64 + lane]; o[d0][r] = d; ss[r] += d * d; }
#pragma unroll
    for (int r = 0; r < 16; ++r) { float s = ss[r]; s += __shfl_xor(s, 1); s += __shfl_xor(s, 2); s += __shfl_xor(s, 4); s += __shfl_xor(s, 8); s += __shfl_xor(s, 16);
      ss[r] = 0.8f / sqrtf(s * (1.f / 128.f) + RMS_EPS); }
#pragma unroll
    for (int d0 = 0; d0 < 4; ++d0) { const int col = d0 * 32 + r32; const float g = gsub[col];
#pragma unroll
      for (int r = 0; r < 16; ++r) { const size_t row = (size_t)(qrow0 + crow(r, hi));
        const float z = bf2f(PROJ[row * NPAD + C_ZB + h * 128 + col]);
        UB[row * 1024 + h * 128 + col] = (bf16_t)f2bf(o[d0][r] * ss[r] * g * z); } }
  }
  __syncthreads();
}
__device__ __forceinline__ void attn_b_phase(const Args& a, LAS unsigned char* lds, int blk, int nblk, const int wid) {
  const bf16_t* PROJ = (const bf16_t*)(a.ws + WS_PROJ); bf16_t* UB = (bf16_t*)(a.ws + WS_U) + (size_t)1 * S * 1024;
  const float lam = ((const float*)(a.ws + WS_CTL))[0];
  for (int u = blk; u < 256; u += nblk) {
    const int h = u & 7, p = u >> 3;
    attn_b_unit(PROJ, UB, a.in[9], lam, h, 63 - p, lds, wid);
    attn_b_unit(PROJ, UB, a.in[9], lam, h, p, lds, wid);
  }
}
template <bool DUMMY> __device__ __forceinline__ void partialSM_A(f32x16& p0, f32x16& p1, float& m_reg, float& alpha, const float (&cs)[16], float base, float C, float slope2, int delta, unsigned long long mw, int hi) {
  const float tb0 = slope2 * (float)delta + base, tb1 = slope2 * (float)(delta + 32) + base;
  const unsigned wl = (unsigned)mw >> (4 * hi), wh = (unsigned)(mw >> 32) >> (4 * hi);
#pragma unroll
  for (int r = 0; r < 16; ++r) { const int K = (r & 3) + 8 * (r >> 2);
    const float y0 = fmaf(p0[r], C, cs[r]), y1 = fmaf(p1[r], C, cs[r]);
    const unsigned t0 = (unsigned)((int)(wl << (31 - K)) >> 31), t1 = (unsigned)((int)(wh << (31 - K)) >> 31);
    p0[r] = __uint_as_float((__float_as_uint(y0) & t0) | (~t0 & 0xff800000u));
    p1[r] = __uint_as_float((__float_as_uint(y1) & t1) | (~t1 & 0xff800000u)); }
  float pm0 = p0[0], pm1 = p1[0];
#pragma unroll
  for (int r = 1; r < 16; ++r) { pm0 = fmaxf(pm0, p0[r]); pm1 = fmaxf(pm1, p1[r]); }
  float pmax = fmaxf(pm0 + tb0, pm1 + tb1);
  { auto rr = __builtin_amdgcn_permlane32_swap(__float_as_uint(pmax), __float_as_uint(pmax), false, false);
    pmax = fmaxf(__uint_as_float(rr[0]), __uint_as_float(rr[1])); }
  float mn;
  if (__builtin_expect(__all(pmax - m_reg <= THR2), 1)) { mn = m_reg; alpha = 1.f; }
  else { mn = fmaxf(m_reg, pmax); alpha = __builtin_amdgcn_exp2f(m_reg - mn); m_reg = mn; }
  const float a0 = tb0 - mn, a1 = tb1 - mn;
#pragma unroll
  for (int r = 0; r < 16; ++r) { p0[r] += a0; p1[r] += a1; }
#pragma unroll
  for (int r = 0; r < 16; ++r) p0[r] = __builtin_amdgcn_exp2f(p0[r]);
}
__device__ __forceinline__ void attn_a_unit(const bf16_t* __restrict__ PROJ, const unsigned long long* __restrict__ MASK, bf16_t* UA, int h, int qb, LAS unsigned char* lds, const int wid) {
  const int lane = lane_id_v(), tid = wid * 64 + lane, r32 = lane & 31, hi = lane >> 5;
  const int R0 = qb * 256, qrow0 = R0 + wid * 32, NT = 4 * qb + 4;
  LAS unsigned char* V_lds = lds; LAS unsigned char* K_lds = lds + 2 * SHM_V;
  LAS float* ws = (LAS float*)(lds + 2 * SHM_V + 2 * SHM_K) + wid * 64; LAS float* li_l = ws; LAS float* al_l = ws + 32;
  const float slope2 = __builtin_amdgcn_exp2f(-(float)(h + 1)) * LOG2E, C = 0.08838834764831845f * LOG2E;
  float cs[16];
#pragma unroll
  for (int r = 0; r < 16; ++r) cs[r] = __uint_as_float(__builtin_amdgcn_readfirstlane(__float_as_uint(slope2 * (float)((r & 3) + 8 * (r >> 2)))));
  const float base = slope2 * (float)(4 * hi - r32);
  float m_reg = -1e30f, l_reg = 0; f32x16 o[4] = {}; bf16x8 qr[8];
  { const bf16_t* Qw = PROJ + (size_t)(qrow0 + r32) * NPAD + C_QA + h * 128 + hi * 8;
#pragma unroll
    for (int d0 = 0; d0 < 8; ++d0) qr[d0] = *(const bf16x8*)(Qw + d0 * 16); }
  const unsigned offK = (unsigned)((tid >> 4) * NPAD + C_KA + h * 128 + (tid & 15) * 8) * 2u, offV = offK + (unsigned)(C_VA - C_KA) * 2u;
  const unsigned moff = (unsigned)(qrow0 + r32) * 1024u;
#define MLD(tj) (*(const unsigned long long*)((const char*)MASK + (moff + 8u * (unsigned)(tj))))
  const int sr = tid >> 4, sc = (tid & 15) * 8, vst0 = v_st(sr, sc), vst1 = v_st(32 + sr, sc);
  LAS const unsigned char* vb0 = V_lds + v_rd_base(lane);
  struct { bf16x8 vs0, vs1, ks0, ks1; } sr_;
#define TJ(t) (NT - 1 - (t))
#define KEY0(t) (64 * TJ(t))
#define GLD16(off) (*(const bf16x8*)((const char*)PROJ + (unsigned)(off)))
#define SLOAD(k0) do { const unsigned kb_ = (unsigned)(k0) * (unsigned)(NPAD * 2); sr_.vs0 = GLD16(offV + kb_); sr_.vs1 = GLD16(offV + kb_ + 32u * NPAD * 2u); \
    sr_.ks0 = GLD16(offK + kb_); sr_.ks1 = GLD16(offK + kb_ + 32u * NPAD * 2u); } while (0)
#define SWRITE(b) do { *(LAS bf16x8*)(V_lds + (b) * SHM_V + vst0) = sr_.vs0; *(LAS bf16x8*)(V_lds + (b) * SHM_V + vst1) = sr_.vs1; const int kc = sc * 2; \
    *(LAS bf16x8*)(K_lds + (b) * SHM_K + KSWZ(sr, kc)) = sr_.ks0; *(LAS bf16x8*)(K_lds + (b) * SHM_K + KSWZ(32 + sr, kc)) = sr_.ks1; } while (0)
#define RESC(a) do { if (__any((a) < 1.f)) { if (hi == 0) al_l[r32] = (a); asm volatile("s_waitcnt lgkmcnt(0)" ::: "memory"); \
    _Pragma("unroll") for (int d = 0; d < 4; ++d) _Pragma("unroll") for (int r = 0; r < 16; ++r) o[d][r] *= al_l[crow(r, hi)]; } } while (0)
  f32x16 pA0, pA1, pB0, pB1; float alA, alB; bf16x8 pa0, pa1, pa2, pa3; unsigned long long mwA, mwB;
  SLOAD(KEY0(0)); mwA = MLD(TJ(0)); SWRITE(0); __syncthreads();
  qkt<8>(pA0, pA1, K_lds, qr, 0, r32, hi); partialSM_A<true>(pA0, pA1, m_reg, alA, cs, base, C, slope2, KEY0(0) - qrow0, mwA, hi);
  SLOAD(KEY0(1)); mwB = MLD(TJ(1)); SWRITE(1); __syncthreads();
  for (int j = 1; j + 1 < NT; j += 2) {
    SBAR(); qkt<8>(pB0, pB1, K_lds + SHM_K, qr, 0, r32, hi);
    finishSM(pA0, pA1, alA, l_reg, pa0, pa1, pa2, pa3); SBAR();
    SLOAD(KEY0(j + 1)); mwA = MLD(TJ(j + 1)); SBAR();
    pv_d0(o, vb0, pa0, pa1, pa2, pa3); partialSM_A<true>(pB0, pB1, m_reg, alB, cs, base, C, slope2, KEY0(j) - qrow0, mwB, hi);
    __syncthreads(); SWRITE(0);
    RESC(alB); __syncthreads();
    SBAR(); qkt<8>(pA0, pA1, K_lds, qr, 0, r32, hi);
    finishSM(pB0, pB1, alB, l_reg, pa0, pa1, pa2, pa3); SBAR();
    SLOAD(KEY0(j + 2)); mwB = MLD(TJ(j + 2)); SBAR();
    pv_d0(o, vb0 + SHM_V, pa0, pa1, pa2, pa3); partialSM_A<true>(pA0, pA1, m_reg, alA, cs, base, C, slope2, KEY0(j + 1) - qrow0, mwA, hi);
    __syncthreads(); SWRITE(1);
    RESC(alA); __syncthreads();
  }
  SBAR(); qkt<8>(pB0, pB1, K_lds + SHM_K, qr, 0, r32, hi);
  finishSM(pA0, pA1, alA, l_reg, pa0, pa1, pa2, pa3); SBAR();
  pv_d0(o, vb0, pa0, pa1, pa2, pa3); partialSM_A<true>(pB0, pB1, m_reg, alB, cs, base, C, slope2, KEY0(NT - 1) - qrow0, mwB, hi);
  __syncthreads(); RESC(alB);
  finishSM(pB0, pB1, alB, l_reg, pa0, pa1, pa2, pa3); SBAR();
  pv_d0(o, vb0 + SHM_V, pa0, pa1, pa2, pa3);
#undef TJ
#undef MLD
#undef KEY0
#undef SLOAD
#undef GLD16
#undef SWRITE
#undef RESC
  if (hi == 0) li_l[r32] = l_reg; asm volatile("s_waitcnt lgkmcnt(0)" ::: "memory");
  float rli[16];
#pragma unroll
  for (int r = 0; r < 16; ++r) rli[r] = __builtin_amdgcn_rcpf(li_l[crow(r, hi)]);
#pragma unroll
  for (int d0 = 0; d0 < 4; ++d0) { const int col = h * 128 + d0 * 32 + r32;
#pragma unroll
    for (int r = 0; r < 16; ++r) { const size_t row = (size_t)(qrow0 + crow(r, hi));
      const float z = bf2f(PROJ[row * NPAD + C_ZA + col]);
      UA[row * 1024 + col] = (bf16_t)f2bf(o[d0][r] * rli[r] * z); } }
  __syncthreads();
}
__device__ __forceinline__ void attn_a_phase(const Args& a, LAS unsigned char* lds, int blk, int nblk, const int wid) {
  const bf16_t* PROJ = (const bf16_t*)(a.ws + WS_PROJ); bf16_t* UA = (bf16_t*)(a.ws + WS_U);
  const unsigned long long* MASK = (const unsigned long long*)(a.ws + WS_SEL);
  for (int u = blk; u < 256; u += nblk) { const int h = u & 7, qb = 31 - (u >> 3); attn_a_unit(PROJ, MASK, UA, h, qb, lds, wid); }
}
template <int NQ, bool ACC> __device__ __forceinline__ void qkt_acc(f32x16& p0, f32x16& p1, LAS const unsigned char* Ks, const bf16x8* qr, int r32, int hi) {
  if (!ACC) { p0 = f32x16{}; p1 = f32x16{}; }
#pragma unroll
  for (int d0 = 0; d0 < NQ; ++d0) { const int cb = (d0 * 16 + hi * 8) * 2;
    const bf16x8 b0 = *(LAS const bf16x8*)(Ks + KSWZ(r32, cb));
    const bf16x8 b1 = *(LAS const bf16x8*)(Ks + KSWZ(32 + r32, cb));
    p0 = __builtin_amdgcn_mfma_f32_32x32x16_bf16(b0, qr[d0], p0, 0, 0, 0);
    p1 = __builtin_amdgcn_mfma_f32_32x32x16_bf16(b1, qr[d0], p1, 0, 0, 0); }
}
__device__ __forceinline__ void attn_m_unit(const bf16_t* __restrict__ PROJ, const bf16_t* __restrict__ MKV, bf16_t* UM, int h, int qb, int vh, LAS unsigned char* lds, const int wid) {
  const int lane = lane_id_v(), tid = wid * 64 + lane, r32 = lane & 31, hi = lane >> 5;
  const int qrow0 = qb * 256 + wid * 32;
  LAS unsigned char* V_lds = lds; LAS unsigned char* K_lds = lds + 2 * SHM_V;
  LAS float* ws = (LAS float*)(lds + 2 * SHM_V + 2 * SHM_K) + wid * 64; LAS float* li_l = ws; LAS float* al_l = ws + 32;
  const float C = 0.0625f * LOG2E;
  const float cs[16] = {0.f, 0.f, 0.f, 0.f, 0.f, 0.f, 0.f, 0.f, 0.f, 0.f, 0.f, 0.f, 0.f, 0.f, 0.f, 0.f};
  float m_reg = -1e30f, l_reg = 0; f32x16 o[4] = {}; bf16x8 qr[16];
  { const bf16_t* Qw = PROJ + (size_t)(qrow0 + r32) * NPAD + C_QM + h * 256 + hi * 8;
#pragma unroll
    for (int d0 = 0; d0 < 16; ++d0) qr[d0] = *(const bf16x8*)(Qw + d0 * 16); }
  const int sr = tid >> 4, sc = (tid & 15) * 8, vst0 = v_st(sr, sc), vst1 = v_st(32 + sr, sc);
  const unsigned offK = (unsigned)(sr * 2048 + h * 256 + sc) * 2u, offV = offK + (unsigned)(1024 + vh * 128) * 2u;
  LAS const unsigned char* vb0 = V_lds + v_rd_base(lane);
#define GLD16(off) (*(const bf16x8*)((const char*)MKV + (unsigned)(off)))
  for (int t = 0; t < 4; ++t) {
    const unsigned kb_ = (unsigned)(64 * t) * 4096u;
    const bf16x8 ka0 = GLD16(offK + kb_), ka1 = GLD16(offK + kb_ + 32u * 4096u), kb0 = GLD16(offK + kb_ + 256u), kb1 = GLD16(offK + kb_ + 32u * 4096u + 256u);
    const bf16x8 vs0 = GLD16(offV + kb_), vs1 = GLD16(offV + kb_ + 32u * 4096u);
    const int kc = sc * 2;
    *(LAS bf16x8*)(K_lds + KSWZ(sr, kc)) = ka0; *(LAS bf16x8*)(K_lds + KSWZ(32 + sr, kc)) = ka1;
    *(LAS bf16x8*)(K_lds + SHM_K + KSWZ(sr, kc)) = kb0; *(LAS bf16x8*)(K_lds + SHM_K + KSWZ(32 + sr, kc)) = kb1;
    *(LAS bf16x8*)(V_lds + vst0) = vs0; *(LAS bf16x8*)(V_lds + vst1) = vs1;
    __syncthreads();
    f32x16 p0, p1; float al; bf16x8 pa0, pa1, pa2, pa3;
    qkt_acc<8, false>(p0, p1, K_lds, qr, r32, hi); qkt_acc<8, true>(p0, p1, K_lds + SHM_K, qr + 8, r32, hi);
    partialSM<false>(p0, p1, m_reg, al, cs, 0.f, 0, C, 0.f, 0);
    if (__any(al < 1.f)) { if (hi == 0) al_l[r32] = al; asm volatile("s_waitcnt lgkmcnt(0)" ::: "memory");
#pragma unroll
      for (int d = 0; d < 4; ++d)
#pragma unroll
        for (int r = 0; r < 16; ++r) o[d][r] *= al_l[crow(r, hi)]; }
    finishSM(p0, p1, al, l_reg, pa0, pa1, pa2, pa3);
    pv_d0(o, vb0, pa0, pa1, pa2, pa3);
    __syncthreads();
  }
#undef GLD16
  if (hi == 0) li_l[r32] = l_reg; asm volatile("s_waitcnt lgkmcnt(0)" ::: "memory");
  float rli[16];
#pragma unroll
  for (int r = 0; r < 16; ++r) rli[r] = __builtin_amdgcn_rcpf(li_l[crow(r, hi)]);
#pragma unroll
  for (int d0 = 0; d0 < 4; ++d0) { const int col = h * 256 + vh * 128 + d0 * 32 + r32;
#pragma unroll
    for (int r = 0; r < 16; ++r) { const size_t row = (size_t)(qrow0 + crow(r, hi));
      const float z = bf2f(PROJ[row * NPAD + C_ZM + col]);
      UM[row * 1024 + col] = (bf16_t)f2bf(o[d0][r] * rli[r] * z); } }
  __syncthreads();
}
__device__ __forceinline__ void attn_m_phase(const Args& a, LAS unsigned char* lds, int blk, int nblk, const int wid) {
  const bf16_t* PROJ = (const bf16_t*)(a.ws + WS_PROJ); const bf16_t* MKV = (const bf16_t*)(a.ws + WS_MKV); bf16_t* UM = (bf16_t*)(a.ws + WS_U) + (size_t)2 * S * 1024;
  for (int u = blk; u < 256; u += nblk) attn_m_unit(PROJ, MKV, UM, u & 3, u >> 3, (u >> 2) & 1, lds, wid);
}
#undef KSWZ
#undef SBAR
}


namespace idx {
typedef short bf16x8 __attribute__((ext_vector_type(8)));
typedef float f32x16 __attribute__((ext_vector_type(16)));
constexpr int NUNIT = 8 * (16 * 17 / 2);
__device__ __forceinline__ void scores_phase(const bf16_t* __restrict__ PROJ, float* SC, LAS unsigned char* lds, int blk, int nblk, const int wid) {
  const int lane = lane_id_v(), tid = wid * 64 + lane, n32 = lane & 31, hi = lane >> 5;
  const int skey = tid >> 3, schunk = tid & 7;
  const int swr = skey * 128 + ((schunk ^ (skey & 7)) << 4);
  for (int u = blk; u < NUNIT; u += nblk) {
    int g = 0, rem = u; while (rem >= 8 * (g + 1)) { rem -= 8 * (g + 1); ++g; }
    const int qc = 8 * g + rem / (g + 1), kc = rem % (g + 1);
    const int q0 = 64 * qc + 8 * wid, k_begin = 512 * kc, k_end = min(512 * kc + 512, 64 * qc + 64), ntile = (k_end - k_begin) / 64;
    bf16x8 af[4][4]; float w[4][16];
    const int head = (n32 & 3) + 4 * (n32 >> 3), qbit = (n32 >> 2) & 1;
#pragma unroll
    for (int t = 0; t < 4; ++t) {
      const bf16_t* qp = PROJ + (size_t)(q0 + 2 * t + qbit) * NPAD + C_QI + head * 64 + hi * 8;
#pragma unroll
      for (int ks = 0; ks < 4; ++ks) af[t][ks] = *(const bf16x8*)(qp + ks * 16);
      const bf16_t* wp = PROJ + (size_t)(q0 + 2 * t + hi) * NPAD + C_WI;
      const u32x4 w0 = *(const u32x4*)wp, w1 = *(const u32x4*)(wp + 8);
      const unsigned ww[8] = {w0.x, w0.y, w0.z, w0.w, w1.x, w1.y, w1.z, w1.w};
#pragma unroll
      for (int i = 0; i < 8; ++i) { w[t][2 * i] = bflo(ww[i]) * 0.03125f; w[t][2 * i + 1] = bfhi(ww[i]) * 0.03125f; }
    }
    u32x4 st = *(const u32x4*)(PROJ + (size_t)(k_begin + skey) * NPAD + C_KI + schunk * 8);
    __syncthreads();
    *(LAS u32x4*)(lds + swr) = st;
    __syncthreads();
    for (int tl = 0; tl < ntile; ++tl) {
      LAS const unsigned char* kb = lds + (tl & 1) * 8192;
      if (tl + 1 < ntile) st = *(const u32x4*)(PROJ + (size_t)(k_begin + 64 * (tl + 1) + skey) * NPAD + C_KI + schunk * 8);
#pragma unroll
      for (int kh = 0; kh < 2; ++kh) {
        const int krow = kh * 32 + n32;
        bf16x8 bfr[4];
#pragma unroll
        for (int ks = 0; ks < 4; ++ks) bfr[ks] = *(LAS const bf16x8*)(kb + krow * 128 + (((2 * ks + hi) ^ (krow & 7)) << 4));
        const int s = k_begin + 64 * tl + krow;
#pragma unroll
        for (int t = 0; t < 4; ++t) {
          f32x16 acc = {};
#pragma unroll
          for (int ks = 0; ks < 4; ++ks) acc = __builtin_amdgcn_mfma_f32_32x32x16_bf16(af[t][ks], bfr[ks], acc, 0, 0, 0);
          float sc = 0.f;
#pragma unroll
          for (int r = 0; r < 16; ++r) sc = fmaf(fmaxf(acc[r], 0.f), w[t][r], sc);
          const int q = q0 + 2 * t + hi;
          if (s <= q) SC[sc_off(q) + s] = sc;
        }
      }
      if (tl + 1 < ntile) { *(LAS u32x4*)(lds + ((tl + 1) & 1) * 8192 + swr) = st; }
      __syncthreads();
    }
  }
}
}

#ifdef DBG_STAGE
__device__ __forceinline__ void dbg_dump(const Args& a, int blk, int nblk) {
    const bf16_t* PROJ = (const bf16_t*)(a.ws + WS_PROJ);
    for (size_t idx = (size_t)blk * 512 + threadIdx.x; idx < (size_t)S * DM; idx += (size_t)nblk * 512) {
        const int r = (int)(idx / DM), c = (int)(idx % DM); float v = 0.f;
#if DBG_STAGE == 1 && defined(DBG_WEIGHTS)
        for (int z = 0; z < 3; ++z) v += bf2f(((const bf16_t*)(a.ws + WS_WTBR))[((size_t)z * 2048 + (r & 2047)) * 1024 + (c & 1023)]);
        v += bf2f(((const bf16_t*)(a.ws + WS_WTOUT))[(size_t)(r & 2047) * 2048 + c]);
#elif DBG_STAGE == 1 && defined(DBG_GATES)
        for (int j = 0; j < 3; ++j) v += bf2f(PROJ[(size_t)r * NPAD + C_GL + c + 2048 * j]);
#elif DBG_STAGE == 1
        for (int j = 0; j < 8; ++j) v += bf2f(PROJ[(size_t)r * NPAD + c + 2048 * j]);
        if (c < 1280) v += bf2f(PROJ[(size_t)r * NPAD + 16384 + c]);
        if (r < 256) v += bf2f(((const bf16_t*)(a.ws + WS_MKV))[(size_t)r * 2048 + c]);
        for (int z = 0; z < 3; ++z) v += bf2f(((const bf16_t*)(a.ws + WS_WTBR))[((size_t)z * 2048 + (r & 2047)) * 1024 + (c & 1023)]);
        v += bf2f(((const bf16_t*)(a.ws + WS_WTOUT))[(size_t)(r & 2047) * 2048 + c]);
#elif DBG_STAGE == 2
        if (c < 1024) v = bf2f(((const bf16_t*)(a.ws + WS_U))[(size_t)(S + r) * 1024 + c]) + bf2f(((const bf16_t*)(a.ws + WS_U))[(size_t)(2 * S + r) * 1024 + c]);
        else { const float* row = (const float*)(a.ws + WS_SC) + sc_off(r); for (int j = c - 1024; j <= r; j += 1024) v += row[j]; }
#elif DBG_STAGE == 3
        if (c < 256) v = (float)((const int*)(a.ws + WS_SEL))[(size_t)r * 256 + c];
#elif DBG_STAGE == 4
        if (c < 1024) v = bf2f(((const bf16_t*)(a.ws + WS_U))[(size_t)r * 1024 + c]);
#elif DBG_STAGE == 5
        v = bf2f(((const bf16_t*)(a.ws + WS_MERGED))[(size_t)r * DM + c]);
#endif
        a.out[idx] = v;
    }
}
#endif

__device__ __forceinline__ void grid_bar(unsigned* cnt, unsigned target, const int wave) {
    asm volatile("s_waitcnt vmcnt(0)" ::: "memory");
    __syncthreads();
    if (wave == 0) {
        if (lane_id_v() == 0) {
            __builtin_amdgcn_fence(__ATOMIC_RELEASE, "agent");
            asm volatile("s_waitcnt vmcnt(0)" ::: "memory");
            __hip_atomic_fetch_add(cnt, 1u, __ATOMIC_RELAXED, __HIP_MEMORY_SCOPE_AGENT);
            while (__hip_atomic_load(cnt, __ATOMIC_RELAXED, __HIP_MEMORY_SCOPE_AGENT) < target) __builtin_amdgcn_s_sleep(2);
            __builtin_amdgcn_fence(__ATOMIC_ACQUIRE, "agent");
            asm volatile("s_waitcnt vmcnt(0)" ::: "memory");
        }
    }
    __syncthreads();
}

constexpr int LDS_BYTES = 147456;
constexpr int NPHASE = 8;
__global__ void __launch_bounds__(512, 2) fwd(Args a) {
    extern __shared__ __attribute__((aligned(16))) unsigned char lds_raw[];
    LAS unsigned char* lds = (LAS unsigned char*)lds_raw;
    cg::grid_group grid = cg::this_grid();
    const int blk = blockIdx.x, nblk = gridDim.x, wave = __builtin_amdgcn_readfirstlane(threadIdx.x >> 6);
    unsigned char* ws = a.ws;
    const bf16_t* PROJ = (const bf16_t*)(ws + WS_PROJ);
#define IN(k) (a.ph_lo <= (k) && (k) < a.ph_hi)
#define SEAM(k) do { if (IN(k) && IN((k) + 1)) { if ((k) == 0) grid.sync(); else grid_bar((unsigned*)(ws + WS_CTL + 256), (unsigned)nblk * (unsigned)(k), wave); } } while (0)
    if (IN(0)) { p0_prologue(a, lds, blk, nblk, wave); } SEAM(0);
    if (IN(1)) {
        pg8::Gemm g{(const bf16_t*)(ws + WS_H), (const bf16_t*)(ws + WS_WTIN), S, NPAD, DM, (long)WS_MEMN - (long)WS_H, (long)WS_WTMKV - (long)WS_WTIN};
        pg8::ProjOrder so; so.init(S, NPAD, nblk, blk);
        pg8::EpiProj E{(bf16_t*)(ws + WS_PROJ), NPAD, (bf16_t*)(ws + WS_MKV), 2048, a.in[4], C_GL / 256};
        pg8::gemm_phase<pg8::EpiProj, pg8::ProjOrder, true, true>(lds, g, so, E, wave);
    } SEAM(1);
    if (IN(2)) { idx::scores_phase(PROJ, (float*)(ws + WS_SC), lds, blk, nblk, wave); __syncthreads(); att::attn_b_phase(a, lds, blk, nblk, wave); att::attn_m_phase(a, lds, blk, nblk, wave); } SEAM(2);
    if (IN(3)) { topk_select((const float*)(ws + WS_SC), (int*)(ws + WS_SEL), lds, blk, nblk, wave); } SEAM(3);
    if (IN(4)) { att::attn_a_phase(a, lds, blk, nblk, wave); } SEAM(4);
    if (IN(5)) {
        pg8::Gemm g{(const bf16_t*)(ws + WS_U), (const bf16_t*)(ws + WS_WTBR), S, DM, 1024, (long)S * 1024 * 2, (long)2048 * 1024 * 2};
        pg8::MergeOrder so; so.init(S, DM, nblk, blk);
        pg8::EpiMerge E{PROJ + C_GL, NPAD, (float*)(ws + WS_T), (bf16_t*)(ws + WS_MERGED), DM};
        pg8::gemm_phase<pg8::EpiMerge, pg8::MergeOrder, true, true>(lds, g, so, E, wave);
    } SEAM(5);
    if (IN(6)) {
        pg8::Gemm g{(const bf16_t*)(ws + WS_MERGED), (const bf16_t*)(ws + WS_WTOUT), S, DM, DM, 0, 0};
        pg8::StaticOrder so; so.init(S, DM, nblk, blk);
        pg8::EpiOut E{a.in[0], a.out, DM, (float*)(ws + WS_PART), S};
        pg8::gemm_phase<pg8::EpiOut, pg8::StaticOrder, false, true>(lds, g, so, E, wave);
    } SEAM(6);
    if (IN(7)) { final_norm(a, blk, nblk, wave); }
#ifdef DBG_STAGE
    if (IN(8)) { dbg_dump(a, blk, nblk); }
#endif
#undef IN
#undef SEAM
}

#ifndef N_LAUNCH_MODE
#define N_LAUNCH_MODE 0
#endif
extern "C" void kernel_launch(void* const* d_in, const int* in_sizes, int n_in, void* d_out, int out_size, void* d_ws, size_t ws_size, hipStream_t stream) {
    static int grid = 0;
    if (grid == 0) {
        if (n_in != 17 || in_sizes[0] != S * DM || in_sizes[3] != DM * DIN || out_size != S * DM || ws_size < WS_END) {
            fprintf(stderr, "kernel_launch: unexpected shapes (n_in %d, in0 %d, in3 %d, out %d, ws %zu < %zu)\n", n_in, n_in > 0 ? in_sizes[0] : -1, n_in > 3 ? in_sizes[3] : -1, out_size, ws_size, (size_t)WS_END); grid = -1; return; }
        int dev = 0, cus = 0, per_cu = 0;
        (void)hipGetDevice(&dev); (void)hipDeviceGetAttribute(&cus, hipDeviceAttributeMultiprocessorCount, dev);
        if (hipFuncSetAttribute((const void*)fwd, hipFuncAttributeMaxDynamicSharedMemorySize, LDS_BYTES) != hipSuccess) { fprintf(stderr, "kernel_launch: hipFuncSetAttribute failed\n"); grid = -1; return; }
        if (hipOccupancyMaxActiveBlocksPerMultiprocessor(&per_cu, (const void*)fwd, 512, LDS_BYTES) != hipSuccess || per_cu < 1) { fprintf(stderr, "kernel_launch: occupancy query gave %d\n", per_cu); per_cu = 1; }
        (void)hipGetLastError();
        grid = cus * 1;
        if (grid > cus * per_cu) grid = cus * per_cu;
        if (grid < 8) grid = -1;
    }
    if (grid < 0) return;
    Args a{};
    for (int i = 0; i < 17; ++i) a.in[i] = (const float*)d_in[i];
    a.out = (float*)d_out; a.ws = (unsigned char*)d_ws;
#if N_LAUNCH_MODE == 1
    (void)hipMemsetAsync((unsigned char*)d_ws + WS_CTL + 256, 0, 256, stream);
    a.ph_lo = 0; a.ph_hi = NPHASE;
    void* kargs[] = {&a};
    hipError_t e = hipLaunchCooperativeKernel((const void*)fwd, dim3(grid), dim3(512), kargs, LDS_BYTES, stream);
    if (e != hipSuccess) fprintf(stderr, "cooperative launch failed: %s (grid %d)\n", hipGetErrorString(e), grid);
#else
#ifdef DBG_STAGE
    #ifdef DBG_WEIGHTS
    constexpr int last_ph[6] = {0, 0, 2, 3, 4, 5};
#else
    constexpr int last_ph[6] = {0, 1, 2, 3, 4, 5};
#endif
    for (int p = 0; p <= last_ph[DBG_STAGE]; ++p) { a.ph_lo = p; a.ph_hi = p + 1; hipLaunchKernelGGL(fwd, dim3(grid), dim3(512), LDS_BYTES, stream, a); }
    a.ph_lo = 8; a.ph_hi = 9; hipLaunchKernelGGL(fwd, dim3(grid), dim3(512), LDS_BYTES, stream, a);
#else
    for (int p = 0; p < NPHASE; ++p) {
        a.ph_lo = p; a.ph_hi = p + 1;
        hipLaunchKernelGGL(fwd, dim3(grid), dim3(512), LDS_BYTES, stream, a);
    }
#endif
#endif
}
```

```cpp
#define N_LAUNCH_MODE 1
#include <hip/hip_runtime.h>
#include <hip/hip_cooperative_groups.h>
#include <cstdio>
#include <cstdint>
namespace cg = cooperative_groups;

__device__ __forceinline__ int lane_id_v() { int l; asm volatile("v_mbcnt_lo_u32_b32 %0, -1, 0\n\tv_mbcnt_hi_u32_b32 %0, -1, %0" : "=v"(l)); return l; }
namespace pg8 {
#define PG8_LAS __attribute__((address_space(3)))
typedef unsigned short bf16_t;
typedef short bf16x8 __attribute__((ext_vector_type(8)));
typedef float f32x4 __attribute__((ext_vector_type(4)));
typedef unsigned u32x4 __attribute__((ext_vector_type(4)));
constexpr int BM = 256, BK = 64, HALF = 128, HTB = HALF * BK * 2  , STAGE_BYTES = 8 * HTB, NXCD = 8, WGM = 8;

__host__ __device__ __forceinline__ int lds_byte(int r, int c) { const int st = (r >> 4) * 2 + (c >> 5), rr = r & 15, cc = c & 31, ob = rr * 64 + cc * 2; return st * 1024 + (ob ^ (((ob >> 9) & 1) << 5)); }
__host__ __device__ __forceinline__ void stage_rc(int b, int& R, int& C) { const int st = b / 1024, sb = b % 1024, swz = sb ^ (((sb >> 9) & 1) << 5); R = (st >> 1) * 16 + swz / 64; C = (st & 1) * 32 + (swz % 64) / 2; }
__host__ __device__ __forceinline__ int perm32(int rho) { const int n = rho >> 4, i = rho & 15; return 8 * (i >> 2) + 4 * n + (i & 3); }

struct Unit { int pm, pn, z; };
struct Gemm { const bf16_t* A; const bf16_t* Bt; int M, N, K; long zA, zB; };

struct StaticOrder {
    int nM, nN, nwg, G, c;
    __host__ __device__ void init(int M, int N, int G_, int c_) { nM = M / BM; nN = N / BM; nwg = nM * nN; G = G_; c = c_; }
    __host__ __device__ bool next(int i, Unit& u) const {
        const long L = (long)i * G + c; if (L >= nwg) return false;
        int wgid = (int)L; { const int q = nwg / NXCD, r = nwg % NXCD, xcd = wgid % NXCD, off = wgid / NXCD; wgid = (xcd < r ? xcd * (q + 1) : r * (q + 1) + (xcd - r) * q) + off; }
        const int nig = WGM * nN, gid = wgid / nig, fm = gid * WGM, gsz = (nM - fm) < WGM ? (nM - fm) : WGM;
        u.pm = fm + ((wgid % nig) % gsz); u.pn = (wgid % nig) / gsz; u.z = 0; return true;
    }
    __device__ __forceinline__ void a_ready(const Unit&) const {}
    __device__ __forceinline__ void done(const Unit&) const {}
};

typedef float f32x2_t __attribute__((ext_vector_type(2))); typedef __bf16 bf16x2_t __attribute__((ext_vector_type(2)));
__device__ __forceinline__ unsigned cvt_pk_bf16(float lo, float hi) { f32x2_t v = {lo, hi}; bf16x2_t b = __builtin_convertvector(v, bf16x2_t); return __builtin_bit_cast(unsigned, b); }

__device__ __forceinline__ float bf2f(unsigned short u) { return __uint_as_float((unsigned)u << 16); }
__device__ __forceinline__ float sigmoidf_(float v) { return __builtin_amdgcn_rcpf(1.0f + __builtin_amdgcn_exp2f(-1.4426950408889634f * v)); }
template <int MODE> __device__ __forceinline__ float act_(float v, float b) {
    if (MODE == 1) return v * sigmoidf_(v);
    if (MODE == 2) return sigmoidf_(v + b);
    return v;
}
struct EpiProj {
    static constexpr bool PERM = true, AFTER_DRAIN = false;
    bf16_t* O; int ldc; bf16_t* O1; int ldc1; const float* bgate; int gate_tile0;
    unsigned* nslot;
    __device__ __forceinline__ void norms(const f32x4 (&acc)[2][2][4][2], const Unit& u, int wc, int lane) const {
        float wm[2] = {0.f, 0.f};
#pragma unroll
        for (int ai = 0; ai < 2; ++ai)
#pragma unroll
            for (int m = 0; m < 4; ++m)
#pragma unroll
                for (int bj = 0; bj < 2; ++bj) { const f32x4 a = acc[ai][bj][m][0], c = acc[ai][bj][m][1];
                    float s = (a[0] * a[0] + a[1] * a[1]) + (a[2] * a[2] + a[3] * a[3]) + (c[0] * c[0] + c[1] * c[1]) + (c[2] * c[2] + c[3] * c[3]);
                    s += __shfl_xor(s, 16); s += __shfl_xor(s, 32); wm[bj] = fmaxf(wm[bj], s); }
#pragma unroll
        for (int bj = 0; bj < 2; ++bj) { float v = wm[bj]; v = fmaxf(v, __shfl_xor(v, 1)); v = fmaxf(v, __shfl_xor(v, 2)); v = fmaxf(v, __shfl_xor(v, 4)); v = fmaxf(v, __shfl_xor(v, 8));
            if (lane == 0) atomicMax(nslot + (u.pn * 2 + bj) * 4 + wc, __float_as_uint(v)); }
    }
    template <int MODE> __device__ __forceinline__ void put(const f32x4 (&acc)[2][2][4][2], bf16_t* base, int ld, int row0, int col0, const float* bias) const {
        f32x4 bv[2][2];
#pragma unroll
        for (int bj = 0; bj < 2; ++bj)
#pragma unroll
            for (int n = 0; n < 2; ++n) bv[bj][n] = (MODE == 2) ? *(const f32x4*)(bias + bj * HALF + 4 * n) : (f32x4){0.f, 0.f, 0.f, 0.f};
#pragma unroll
        for (int ai = 0; ai < 2; ++ai)
#pragma unroll
            for (int m = 0; m < 4; ++m) { bf16_t* rowp = base + (size_t)(row0 + ai * HALF + m * 16) * ld + col0;
#pragma unroll
                for (int bj = 0; bj < 2; ++bj) { f32x4 v0 = acc[ai][bj][m][0], v1 = acc[ai][bj][m][1];
#pragma unroll
                    for (int e = 0; e < 4; ++e) { v0[e] = act_<MODE>(v0[e], bv[bj][0][e]); v1[e] = act_<MODE>(v1[e], bv[bj][1][e]); }
                    u32x4 w; w.x = cvt_pk_bf16(v0[0], v0[1]); w.y = cvt_pk_bf16(v0[2], v0[3]); w.z = cvt_pk_bf16(v1[0], v1[1]); w.w = cvt_pk_bf16(v1[2], v1[3]);
                    *(u32x4*)(rowp + bj * HALF) = w; } }
    }
    __device__ __forceinline__ void operator()(const f32x4 (&acc)[2][2][4][2], const Unit& u, int wr, int wc, int fr, int fq) const {
        const int row0 = u.pm * BM + wr * 64 + fr, col0 = u.pn * BM + wc * 32 + 8 * fq;
        if (u.z == 1) { put<0>(acc, O1, ldc1, row0, col0, nullptr); return; }
        const int t = u.pn;
        if (t < 8 || (t >= 20 && t < 28)) norms(acc, u, wc, fr + 16 * fq);
        const bool is_silu = (t >= 12 && t < 16) || (t >= 32 && t < 36) || (t >= 40 && t < 44);
        if (t >= gate_tile0 && t < 68) put<2>(acc, O, ldc, row0, col0, bgate + (col0 - gate_tile0 * BM));
        else if (is_silu) put<1>(acc, O, ldc, row0, col0, nullptr);
        else put<0>(acc, O, ldc, row0, col0, nullptr);
    }
};
struct EpiMerge {
    static constexpr bool PERM = true, AFTER_DRAIN = false;
    const bf16_t* G; int ldg;
    float* T; bf16_t* O; int ldc;
    __device__ __forceinline__ void operator()(const f32x4 (&acc)[2][2][4][2], const Unit& u, int wr, int wc, int fr, int fq) const {
        const int row0 = u.pm * BM + wr * 64 + fr, col0 = u.pn * BM + wc * 32 + 8 * fq;
#pragma unroll
        for (int ai = 0; ai < 2; ++ai)
#pragma unroll
            for (int m = 0; m < 4; ++m) { const size_t row = (size_t)(row0 + ai * HALF + m * 16);
#pragma unroll
                for (int bj = 0; bj < 2; ++bj) { const int col = col0 + bj * HALF;
                    const u32x4 gw = *(const u32x4*)(G + row * ldg + (size_t)u.z * 2048 + col);
                    f32x4 g0, g1;
                    g0[0] = __uint_as_float(gw.x << 16); g0[1] = __uint_as_float(gw.x & 0xffff0000u); g0[2] = __uint_as_float(gw.y << 16); g0[3] = __uint_as_float(gw.y & 0xffff0000u);
                    g1[0] = __uint_as_float(gw.z << 16); g1[1] = __uint_as_float(gw.z & 0xffff0000u); g1[2] = __uint_as_float(gw.w << 16); g1[3] = __uint_as_float(gw.w & 0xffff0000u);
                    f32x4 v0 = acc[ai][bj][m][0] * g0, v1 = acc[ai][bj][m][1] * g1;
                    float* tp = T + row * ldc + col;
                    if (u.z > 0) { v0 += __builtin_nontemporal_load((const f32x4*)tp); v1 += __builtin_nontemporal_load((const f32x4*)(tp + 4)); }
                    if (u.z < 2) { *(f32x4*)tp = v0; *(f32x4*)(tp + 4) = v1; }
                    else { u32x4 w; w.x = cvt_pk_bf16(v0[0], v0[1]); w.y = cvt_pk_bf16(v0[2], v0[3]); w.z = cvt_pk_bf16(v1[0], v1[1]); w.w = cvt_pk_bf16(v1[2], v1[3]);
                        *(u32x4*)(O + row * ldc + col) = w; } } }
    }
};
struct EpiOut {
    static constexpr bool PERM = false, AFTER_DRAIN = false;
    const float* X; float* Y; int ldc; float* part; int M;
    __device__ __forceinline__ void operator()(const f32x4 (&acc)[2][2][4][2], const Unit& u, int wr, int wc, int fr, int fq) const {
        const int row0 = u.pm * BM + wr * 64 + fr, col0 = u.pn * BM + wc * 32 + 4 * fq;
#pragma unroll
        for (int ai = 0; ai < 2; ++ai)
#pragma unroll
            for (int m = 0; m < 4; ++m) { const size_t row = (size_t)(row0 + ai * HALF + m * 16); float ss = 0.f;
#pragma unroll
                for (int bj = 0; bj < 2; ++bj)
#pragma unroll
                    for (int n = 0; n < 2; ++n) { const size_t off = row * ldc + col0 + bj * HALF + n * 16;
                        const f32x4 y = *(const f32x4*)(X + off) + acc[ai][bj][m][n]; *(f32x4*)(Y + off) = y;
                        ss += (y[0] * y[0] + y[1] * y[1]) + (y[2] * y[2] + y[3] * y[3]); }
                ss += __shfl_xor(ss, 16); ss += __shfl_xor(ss, 32);
                if (fq == 0) part[(size_t)(u.pn * 4 + wc) * M + row] = ss; }
    }
};
struct ProjOrder {
    StaticOrder so; int nmain, extra;
    __device__ void init(int M, int N, int G, int c) { so.init(M, N, G, c); nmain = (so.nwg - c + G - 1) / G; extra = (c >= G - 8) ? c - (G - 8) : -1; }
    __device__ bool next(int i, Unit& u) const {
        if (i < nmain) return so.next(i, u);
        if (i == nmain && extra >= 0) { u.pm = 0; u.pn = extra; u.z = 1; return true; }
        return false;
    }
    __device__ __forceinline__ void a_ready(const Unit&) const {}
    __device__ __forceinline__ void done(const Unit&) const {}
};
struct MergeOrder {
    StaticOrder so;
    __device__ void init(int M, int N, int G, int c) { so.init(M, N, G, c); }
    __device__ bool next(int i, Unit& u) const { if (i >= 3) return false; if (!so.next(0, u)) return false; u.z = i; return true; }
    __device__ __forceinline__ void a_ready(const Unit&) const {}
    __device__ __forceinline__ void done(const Unit&) const {}
};

template <class Epi, class Sched, bool ALIGN_EPI = false, bool SP2 = false>
__device__ __forceinline__ void gemm_phase(PG8_LAS unsigned char* lds, const Gemm g, const Sched& S, const Epi& E, const int wid  ) {
    const int lane = lane_id_v(), tid = wid * 64 + lane, wr = wid >> 2, wc = wid & 3, fr = lane & 15, fq = lane >> 4;
    const int K = g.K, nt = K / BK;
    unsigned voffA[2], voffB[2];
#pragma unroll
    for (int i = 0; i < 2; ++i) { int R, C; stage_rc(tid * 16 + i * 8192, R, C); const int Rb = Epi::PERM ? ((R & ~31) + perm32(R & 31)) : R;
        voffA[i] = (unsigned)(R * K + C) * 2u; voffB[i] = (unsigned)(Rb * K + C) * 2u; }
    const size_t kstep = (size_t)(BK * 2);
    const size_t hstep = (size_t)HALF * K * 2;
    const size_t tstep = 2 * hstep;
    const unsigned ldsw = (unsigned)wid * 1024u;
    const int aoff = lds_byte(wr * 64 + fr, fq * 8), boff = lds_byte(wc * 32 + fr, fq * 8);
#define PG8_SA(b, h) (((b) * 2 + (h)) * HTB)
#define PG8_SB(b, h) ((4 + (b) * 2 + (h)) * HTB)
#define PG8_STAGE(bufoff, gbase, voff) do { _Pragma("unroll") for (int _i = 0; _i < 2; ++_i) \
        __builtin_amdgcn_global_load_lds((const unsigned*)((const char*)(gbase) + (voff)[_i]), (PG8_LAS unsigned*)(lds + (bufoff) + ldsw + _i * 8192), 16, 0, 0); } while (0)
#define PG8_LDA(dst, b, h) do { _Pragma("unroll") for (int m = 0; m < 4; ++m) _Pragma("unroll") for (int k = 0; k < 2; ++k) dst[m][k] = *(const PG8_LAS bf16x8*)(lds + PG8_SA(b, h) + aoff + m * 2048 + k * 1024); } while (0)
#define PG8_LDB(dst, b, h) do { _Pragma("unroll") for (int n = 0; n < 2; ++n) _Pragma("unroll") for (int k = 0; k < 2; ++k) dst[n][k] = *(const PG8_LAS bf16x8*)(lds + PG8_SB(b, h) + boff + n * 2048 + k * 1024); } while (0)
#define PG8_MMA(ai, bj, At, Bt) do { __builtin_amdgcn_s_setprio(1); _Pragma("unroll") for (int m = 0; m < 4; ++m) _Pragma("unroll") for (int n = 0; n < 2; ++n) _Pragma("unroll") for (int k = 0; k < 2; ++k) \
        acc[ai][bj][m][n] = __builtin_amdgcn_mfma_f32_16x16x32_bf16(Bt[n][k], At[m][k], acc[ai][bj][m][n], 0, 0, 0); __builtin_amdgcn_s_setprio(0); } while (0)
#define PG8_WAIT_V(n) asm volatile("s_waitcnt vmcnt(" #n ")" ::: "memory")
#define PG8_WAIT_L(n) asm volatile("s_waitcnt lgkmcnt(" #n ")" ::: "memory")
#define PG8_BAR __builtin_amdgcn_s_barrier()
#define PG8_SCHED __builtin_amdgcn_sched_barrier(0)
    Unit cur, nxt; int ui = 0;
    if (!S.next(0, cur)) return;
    f32x4 acc[2][2][4][2];
#pragma unroll
    for (int a = 0; a < 2; ++a)
#pragma unroll
        for (int b = 0; b < 2; ++b)
#pragma unroll
            for (int m = 0; m < 4; ++m)
#pragma unroll
                for (int n = 0; n < 2; ++n) acc[a][b][m][n] = (f32x4){0.f, 0.f, 0.f, 0.f};
    bf16x8 At[4][2], B0[2][2], B1[2][2];
    const char* cA = (const char*)g.A + (long)cur.z * g.zA + (size_t)cur.pm * tstep; const char* cB = (const char*)g.Bt + (long)cur.z * g.zB + (size_t)cur.pn * tstep;
    S.a_ready(cur);
    if constexpr (SP2) {
        PG8_STAGE(PG8_SB(0, 0), cB, voffB); PG8_STAGE(PG8_SB(0, 1), cB + hstep, voffB); PG8_STAGE(PG8_SA(0, 0), cA, voffA); PG8_STAGE(PG8_SA(0, 1), cA + hstep, voffA);
        if (wr == 1) PG8_BAR;
        PG8_WAIT_V(2); PG8_BAR;
        PG8_STAGE(PG8_SB(1, 0), cB + kstep, voffB); PG8_STAGE(PG8_SA(1, 0), cA + kstep, voffA); PG8_STAGE(PG8_SB(1, 1), cB + hstep + kstep, voffB);
        PG8_WAIT_V(6); PG8_BAR;
    } else {
        PG8_STAGE(PG8_SB(0, 0), cB, voffB); PG8_STAGE(PG8_SA(0, 0), cA, voffA); PG8_STAGE(PG8_SB(0, 1), cB + hstep, voffB); PG8_STAGE(PG8_SA(0, 1), cA + hstep, voffA);
        if (wr == 1) PG8_BAR;
        PG8_WAIT_V(4); PG8_BAR;
        PG8_STAGE(PG8_SB(1, 0), cB + kstep, voffB); PG8_STAGE(PG8_SA(1, 0), cA + kstep, voffA); PG8_STAGE(PG8_SB(1, 1), cB + hstep + kstep, voffB);
        PG8_WAIT_V(6); PG8_BAR;
    }
    for (;;) {
        const bool has_next = S.next(ui + 1, nxt);
        const char* nA = has_next ? (const char*)g.A + (long)nxt.z * g.zA + (size_t)nxt.pm * tstep : cA; const char* nB = has_next ? (const char*)g.Bt + (long)nxt.z * g.zB + (size_t)nxt.pn * tstep : cB;
        for (int t = 0; t < nt; t += 2) {
            const bool last = (t == nt - 2);
            const char* a1 = cA + (size_t)(t + 1) * kstep;
            const char* a2 = last ? nA : cA + (size_t)(t + 2) * kstep; const char* b2 = last ? nB : cB + (size_t)(t + 2) * kstep;
            const char* a3 = a2 + kstep; const char* b3 = b2 + kstep;
            if (last && has_next) S.a_ready(nxt);
            if constexpr (SP2) {
            PG8_LDB(B0, 0, 0); PG8_LDB(B1, 0, 1); PG8_SCHED; PG8_LDA(At, 0, 0); PG8_STAGE(PG8_SA(1, 1), a1 + hstep, voffA);
            PG8_WAIT_V(8); PG8_WAIT_L(0); PG8_BAR; PG8_MMA(0, 0, At, B0); PG8_MMA(0, 1, At, B1); PG8_BAR; PG8_SCHED;
            PG8_LDA(At, 0, 1); PG8_STAGE(PG8_SB(0, 0), b2, voffB); PG8_STAGE(PG8_SB(0, 1), b2 + hstep, voffB); PG8_STAGE(PG8_SA(0, 0), a2, voffA);
            PG8_WAIT_V(8); PG8_WAIT_L(0); PG8_BAR; PG8_MMA(1, 0, At, B0); PG8_MMA(1, 1, At, B1); PG8_BAR; PG8_SCHED;
            PG8_LDB(B0, 1, 0); PG8_LDB(B1, 1, 1); PG8_SCHED; PG8_LDA(At, 1, 0); PG8_STAGE(PG8_SA(0, 1), a2 + hstep, voffA);
            PG8_WAIT_V(8); PG8_WAIT_L(0); PG8_BAR; PG8_MMA(0, 0, At, B0); PG8_MMA(0, 1, At, B1); PG8_BAR; PG8_SCHED;
            PG8_LDA(At, 1, 1); PG8_STAGE(PG8_SB(1, 0), b3, voffB); PG8_STAGE(PG8_SB(1, 1), b3 + hstep, voffB); PG8_STAGE(PG8_SA(1, 0), a3, voffA);
            PG8_WAIT_V(8); PG8_WAIT_L(0); PG8_BAR; PG8_MMA(1, 0, At, B0); PG8_MMA(1, 1, At, B1); PG8_BAR; PG8_SCHED;
            } else {
            PG8_LDB(B0, 0, 0); PG8_SCHED; PG8_LDA(At, 0, 0); PG8_STAGE(PG8_SA(1, 1), a1 + hstep, voffA);
            PG8_WAIT_L(8); PG8_BAR; PG8_WAIT_L(0); PG8_MMA(0, 0, At, B0); PG8_BAR; PG8_SCHED;
            PG8_LDB(B1, 0, 1); PG8_STAGE(PG8_SB(0, 0), b2, voffB);
            PG8_BAR; PG8_WAIT_L(0); PG8_MMA(0, 1, At, B1); PG8_BAR;
            PG8_LDA(At, 0, 1); PG8_STAGE(PG8_SA(0, 0), a2, voffA);
            PG8_BAR; PG8_WAIT_L(0); PG8_MMA(1, 0, At, B0); PG8_BAR; PG8_SCHED;
            PG8_STAGE(PG8_SB(0, 1), b2 + hstep, voffB);
            PG8_WAIT_V(6); PG8_BAR; PG8_MMA(1, 1, At, B1); PG8_BAR;
            PG8_LDB(B0, 1, 0); PG8_SCHED; PG8_LDA(At, 1, 0); PG8_STAGE(PG8_SA(0, 1), a2 + hstep, voffA);
            PG8_WAIT_L(8); PG8_BAR; PG8_WAIT_L(0); PG8_MMA(0, 0, At, B0); PG8_BAR; PG8_SCHED;
            PG8_LDB(B1, 1, 1); PG8_STAGE(PG8_SB(1, 0), b3, voffB);
            PG8_BAR; PG8_WAIT_L(0); PG8_MMA(0, 1, At, B1); PG8_BAR;
            PG8_LDA(At, 1, 1); PG8_STAGE(PG8_SA(1, 0), a3, voffA);
            PG8_BAR; PG8_WAIT_L(0); PG8_MMA(1, 0, At, B0); PG8_BAR; PG8_SCHED;
            PG8_STAGE(PG8_SB(1, 1), b3 + hstep, voffB);
            PG8_WAIT_V(6); PG8_BAR; PG8_MMA(1, 1, At, B1); PG8_BAR;
            }
        }
        if constexpr (ALIGN_EPI) { if (wr == 0) PG8_BAR; }
        if constexpr (!Epi::AFTER_DRAIN) { E(acc, cur, wr, wc, fr, fq); S.done(cur); }
        if (!has_next) break;
#pragma unroll
        for (int a = 0; a < 2; ++a)
#pragma unroll
            for (int b = 0; b < 2; ++b)
#pragma unroll
                for (int m = 0; m < 4; ++m)
#pragma unroll
                    for (int n = 0; n < 2; ++n) acc[a][b][m][n] = (f32x4){0.f, 0.f, 0.f, 0.f};
        cur = nxt; cA = nA; cB = nB; ++ui;
        if constexpr (ALIGN_EPI) { if (wr == 1) PG8_BAR; }
    }
    PG8_WAIT_V(0);
    if constexpr (!ALIGN_EPI) { if (wr == 0) PG8_BAR; }
    PG8_BAR;
    if constexpr (Epi::AFTER_DRAIN) { E.fused(acc, cur, wr, wc, fr, fq, lds, wid, lane); S.done(cur); }
#undef PG8_SA
#undef PG8_SB
#undef PG8_STAGE
#undef PG8_LDA
#undef PG8_LDB
#undef PG8_MMA
#undef PG8_WAIT_V
#undef PG8_WAIT_L
#undef PG8_BAR
#undef PG8_SCHED
}
}

constexpr int S = 8192, DM = 2048, DIN = 17488, NPAD = 17664, NMEM = 256;
constexpr int C_QA = 0, C_KA = 1024, C_VA = 2048, C_ZA = 3072, C_QI = 4096, C_QB = 5120, C_KB = 6144, C_VB = 7168, C_ZB = 8192, C_QM = 9216, C_ZM = 10240, C_GL = 11264, C_KI = 17408, C_WI = 17472;
constexpr int TOPK = 256;
constexpr float RMS_EPS = 1e-6f;
constexpr size_t MiB = 1u << 20;
constexpr size_t WS_CTL = 0;
constexpr size_t WS_WTIN = 1 * MiB;
constexpr size_t WS_U = 1 * MiB;
constexpr size_t WS_WTMKV = 70 * MiB;
constexpr size_t WS_WTBR = 78 * MiB;
constexpr size_t WS_WTOUT = 90 * MiB;
constexpr size_t WS_MEMN = 98 * MiB;
constexpr size_t WS_MKV = 99 * MiB;
constexpr size_t WS_PROJ = 100 * MiB;
constexpr size_t WS_SC = 376 * MiB;
constexpr size_t WS_MERGED = 376 * MiB;
constexpr size_t WS_H = 376 * MiB;
constexpr size_t WS_T = 408 * MiB;
constexpr size_t WS_SEL = 508 * MiB;
constexpr size_t WS_PART = 516 * MiB;
constexpr size_t WS_END = 517 * MiB;

typedef unsigned short bf16_t;
typedef unsigned u32x4 __attribute__((ext_vector_type(4)));
typedef unsigned u32x2 __attribute__((ext_vector_type(2)));
typedef float f32x4 __attribute__((ext_vector_type(4)));
#define LAS __attribute__((address_space(3)))
__device__ __forceinline__ float bf2f(unsigned short u) { return __uint_as_float((unsigned)u << 16); }
__device__ __forceinline__ float bflo(unsigned w) { return __uint_as_float(w << 16); }
__device__ __forceinline__ float bfhi(unsigned w) { return __uint_as_float(w & 0xffff0000u); }
__device__ __forceinline__ unsigned f2bf(float f) { unsigned u = __float_as_uint(f); return (u + 0x7fffu + ((u >> 16) & 1u)) >> 16; }
__device__ __forceinline__ unsigned pk2(float lo, float hi) { return f2bf(lo) | (f2bf(hi) << 16); }
__device__ __forceinline__ float wave_sum(float v) {
#pragma unroll
    for (int o = 1; o < 64; o <<= 1) v += __shfl_xor(v, o);
    return v;
}
__device__ __forceinline__ size_t sc_off(int r) { const size_t i = (size_t)(r >> 8); return 65536ull * (i * (i + 1) / 2) + (size_t)(r & 255) * 256ull * (i + 1); }

struct Args { const float* in[17]; float* out; unsigned char* ws; int ph_lo, ph_hi; };

template <bool MAPIN>
__device__ __forceinline__ void transpose_item(const float* __restrict__ W, int K, int srcN, bf16_t* WT, LAS float* scr, int item, int ndst, int lane) {
    const int nblk = ndst / 32, kb = item / nblk, nb = item % nblk, k0 = 64 * kb, n0 = 32 * nb;
    const int n = n0 + (lane & 31);
    int src = n;
    if (MAPIN) { src = (n < 5120) ? n : (n < 17408) ? n + 80 : (n < 17488) ? n - 17408 + 5120 : -1; }
#pragma unroll 8
    for (int i = 0; i < 32; ++i) { const int kk = 2 * i + (lane >> 5); scr[kk * 33 + (lane & 31)] = (src >= 0) ? W[(size_t)(k0 + kk) * srcN + src] : 0.f; }
    asm volatile("s_waitcnt lgkmcnt(0)" ::: "memory");
    const int c = lane & 7;
#pragma unroll
    for (int j = 0; j < 4; ++j) { const int nn = (lane >> 3) + 8 * j; const LAS float* s = scr + (8 * c) * 33 + nn;
        u32x4 o; o.x = pk2(s[0 * 33], s[1 * 33]); o.y = pk2(s[2 * 33], s[3 * 33]); o.z = pk2(s[4 * 33], s[5 * 33]); o.w = pk2(s[6 * 33], s[7 * 33]);
        *(u32x4*)(WT + (size_t)(n0 + nn) * K + k0 + 8 * c) = o; }
    asm volatile("s_waitcnt lgkmcnt(0)" ::: "memory");
}
__device__ __forceinline__ void rms_row_to_bf16(const float* __restrict__ xrow, const float* __restrict__ g, bf16_t* orow, int lane) {
    const f32x4* xr = (const f32x4*)xrow + lane; const f32x4* gr = (const f32x4*)g + lane;
    f32x4 v[8]; float s = 0.f;
#pragma unroll
    for (int j = 0; j < 8; ++j) { v[j] = xr[64 * j]; s += (v[j].x * v[j].x + v[j].y * v[j].y) + (v[j].z * v[j].z + v[j].w * v[j].w); }
    const float rs = 1.0f / sqrtf(wave_sum(s) * (1.f / DM) + RMS_EPS);
    u32x2* o8 = (u32x2*)orow + lane;
#pragma unroll
    for (int j = 0; j < 8; ++j) { const f32x4 gg = gr[64 * j]; u32x2 w; w.x = pk2(v[j].x * rs * gg.x, v[j].y * rs * gg.y); w.y = pk2(v[j].z * rs * gg.z, v[j].w * rs * gg.w); o8[64 * j] = w; }
}
__device__ __forceinline__ void p0_prologue(const Args& a, LAS unsigned char* lds, int blk, int nblk, const int wave) {
    const int lane = lane_id_v(), tid = wave * 64 + lane;
    LAS float* scr = (LAS float*)(lds + wave * 16384);
    const int gw = blk * 8 + wave, NGW = nblk * 8;
    unsigned char* ws = a.ws;
    constexpr int I_IN = (DM / 64) * (NPAD / 32), I_MKV = (DM / 64) * (2048 / 32), I_BR = (1024 / 64) * (2048 / 32), I_OUT = (DM / 64) * (2048 / 32);
    constexpr int NITEMS = I_IN + I_MKV + 3 * I_BR + I_OUT;
    for (int it = gw; it < NITEMS; it += NGW) {
        int r = it;
        if (r < I_IN) { transpose_item<true>(a.in[3], DM, DIN, (bf16_t*)(ws + WS_WTIN), scr, r, NPAD, lane); continue; } r -= I_IN;
        if (r < I_MKV) { transpose_item<false>(a.in[11], DM, 2048, (bf16_t*)(ws + WS_WTMKV), scr, r, 2048, lane); continue; } r -= I_MKV;
        if (r < 3 * I_BR) { const int z = r / I_BR; transpose_item<false>(a.in[12 + z], 1024, 2048, (bf16_t*)(ws + WS_WTBR) + (size_t)z * 2048 * 1024, scr, r % I_BR, 2048, lane); continue; } r -= 3 * I_BR;
        transpose_item<false>(a.in[15], DM, 2048, (bf16_t*)(ws + WS_WTOUT), scr, r, 2048, lane);
    }
    bf16_t* H = (bf16_t*)(ws + WS_H);
    for (int m = gw; m < S + NMEM; m += NGW) {
        if (m < S) rms_row_to_bf16(a.in[0] + (size_t)m * DM, a.in[2], H + (size_t)m * DM, lane);
        else rms_row_to_bf16(a.in[1] + (size_t)(m - S) * DM, a.in[10], (bf16_t*)(ws + WS_MEMN) + (size_t)(m - S) * DM, lane);
    }
    if (blk == 0) { for (int i = tid; i < 640; i += 512) ((unsigned*)(ws + WS_CTL + 1024))[i] = 0u; }
    if (blk == 0 && wave == 0) {
        const float s1 = wave_sum(a.in[5][lane] * a.in[6][lane]), s2 = wave_sum(a.in[7][lane] * a.in[8][lane]);
        if (lane == 0) ((float*)(ws + WS_CTL))[0] = expf(s1) - expf(s2) + 0.2f;
    }
}

__device__ __forceinline__ void idx_scores_naive(const bf16_t* __restrict__ PROJ, float* SC, LAS unsigned char* lds, int blk, int nblk, const int wave) {
    const int lane = lane_id_v(), tid = wave * 64 + lane;
    LAS float* qs = (LAS float*)lds + wave * 1088;
    constexpr int NITEM = 128 * 129 / 2;
    for (int it = blk; it < NITEM; it += nblk) {
        int kb = 0, rem = it; while (rem >= 128 - kb) { rem -= 128 - kb; ++kb; }
        const int qc = kb + rem, s = 64 * kb + lane;
        float kreg[64];
        { const u32x4* kp = (const u32x4*)(PROJ + (size_t)s * NPAD + C_KI);
#pragma unroll
          for (int i = 0; i < 8; ++i) { const u32x4 w = kp[i]; kreg[8 * i + 0] = bflo(w.x); kreg[8 * i + 1] = bfhi(w.x); kreg[8 * i + 2] = bflo(w.y); kreg[8 * i + 3] = bfhi(w.y);
              kreg[8 * i + 4] = bflo(w.z); kreg[8 * i + 5] = bfhi(w.z); kreg[8 * i + 6] = bflo(w.w); kreg[8 * i + 7] = bfhi(w.w); } }
        for (int qq = 0; qq < 8; ++qq) {
            const int q = 64 * qc + wave * 8 + qq;
            { const u32x4* qp = (const u32x4*)(PROJ + (size_t)q * NPAD + C_QI) + 2 * lane;
              const u32x4 w0 = qp[0], w1 = qp[1];
              LAS f32x4* dst = (LAS f32x4*)(qs + 16 * lane);
              dst[0] = (f32x4){bflo(w0.x), bfhi(w0.x), bflo(w0.y), bfhi(w0.y)}; dst[1] = (f32x4){bflo(w0.z), bfhi(w0.z), bflo(w0.w), bfhi(w0.w)};
              dst[2] = (f32x4){bflo(w1.x), bfhi(w1.x), bflo(w1.y), bfhi(w1.y)}; dst[3] = (f32x4){bflo(w1.z), bfhi(w1.z), bflo(w1.w), bfhi(w1.w)};
              if (lane < 16) qs[1024 + lane] = bf2f(PROJ[(size_t)q * NPAD + C_WI + lane]) * 0.25f; }
            asm volatile("s_waitcnt lgkmcnt(0)" ::: "memory"); __builtin_amdgcn_wave_barrier();
            float score = 0.f;
            for (int j = 0; j < 16; ++j) {
                float acc = 0.f; const LAS f32x4* qj = (const LAS f32x4*)(qs + 64 * j);
#pragma unroll
                for (int d = 0; d < 16; ++d) { const f32x4 qv = qj[d]; acc += qv.x * kreg[4 * d] + qv.y * kreg[4 * d + 1] + qv.z * kreg[4 * d + 2] + qv.w * kreg[4 * d + 3]; }
                score += fmaxf(acc * 0.125f, 0.f) * qs[1024 + j];
            }
            if (s <= q) SC[sc_off(q) + s] = score;
            asm volatile("s_waitcnt lgkmcnt(0)" ::: "memory"); __builtin_amdgcn_wave_barrier();
        }
    }
}
__device__ __forceinline__ unsigned ordkey(float f) { const unsigned u = __float_as_uint(f); return (u & 0x80000000u) ? ~u : (u | 0x80000000u); }
template <int NR, int NL> __device__ __forceinline__ bool topk_row(const float* __restrict__ row, int n, int lane, LAS u32x4* xl, unsigned long long& w0, unsigned long long& w1, unsigned& Tout, int& need_out) {
#pragma unroll
    for (int q = 0; q < NL / 4; ++q) { u32x4 v;
#pragma unroll
        for (int e = 0; e < 4; ++e) { const int i = 4096 + (4 * q + e) * 64 + lane; v[e] = (ordkey(*(const float*)((const char*)row + 4u * (unsigned)min(i, n - 1))) >> 1) & (unsigned)((i - n) >> 31); }
        xl[q * 64 + lane] = v;
        if ((q & 3) == 3) __builtin_amdgcn_sched_barrier(0); }
    unsigned u[NR];
#pragma unroll
    for (int k = 0; k < NR; ++k) { const int i = k * 64 + lane; u[k] = (ordkey(*(const float*)((const char*)row + 4u * (unsigned)min(i, n - 1))) >> 1) & (unsigned)((i - n) >> 31);
        if ((k & 15) == 15) __builtin_amdgcn_sched_barrier(0); }
    unsigned T = 0u;
    for (int bit = 30; bit >= 0; --bit) {
        const unsigned cand = T | (1u << bit); unsigned lt = 0u;
        asm volatile("" ::: "memory");
#pragma unroll
        for (int k = 0; k < NR; ++k) lt += (u[k] - cand) >> 31;
#pragma unroll
        for (int q = 0; q < NL / 4; ++q) { const u32x4 v = xl[q * 64 + lane]; lt += ((v[0] - cand) >> 31) + ((v[1] - cand) >> 31) + ((v[2] - cand) >> 31) + ((v[3] - cand) >> 31);
            if ((q & 3) == 3) __builtin_amdgcn_sched_barrier(0); }
#pragma unroll
        for (int o = 1; o < 64; o <<= 1) lt += __shfl_xor(lt, o);
        if ((int)((NR + NL) * 64 - lt) >= TOPK) T = cand;
    }
    unsigned c_hi = 0u, c_lt = 0u;
#pragma unroll
    for (int k = 0; k < NR; ++k) { c_hi += (T - u[k]) >> 31; c_lt += (u[k] - T) >> 31; }
#pragma unroll
    for (int q = 0; q < NL / 4; ++q) { const u32x4 v = xl[q * 64 + lane];
#pragma unroll
        for (int e = 0; e < 4; ++e) { c_hi += (T - v[e]) >> 31; c_lt += (v[e] - T) >> 31; } }
#pragma unroll
    for (int o = 1; o < 64; o <<= 1) { c_hi += __shfl_xor(c_hi, o); c_lt += __shfl_xor(c_lt, o); }
    const int need = TOPK - (int)c_hi, c_eq = (NR + NL) * 64 - (int)c_lt - (int)c_hi;
    Tout = T; need_out = need;
    if (c_eq != need) return false;
    int ln; asm volatile("v_mbcnt_lo_u32_b32 %0, -1, 0\n\tv_mbcnt_hi_u32_b32 %0, -1, %0" : "=v"(ln));
#pragma unroll
    for (int k = 0; k < NR; ++k) {
        const unsigned long long bs = __ballot(u[k] >= T);
        if (k == ln) w0 = bs;
        __builtin_amdgcn_sched_barrier(0); }
#pragma unroll
    for (int q = 0; q < NL / 4; ++q) { const u32x4 v = xl[q * 64 + lane];
#pragma unroll
        for (int e = 0; e < 4; ++e) { const unsigned long long bs = __ballot(v[e] >= T);
            if (4 * q + e == ln) w1 = bs;
            __builtin_amdgcn_sched_barrier(0); } }
    return true;
}
__device__ __forceinline__ void topk_select(const float* SC, int* SEL, LAS unsigned char* lds, int blk, int nblk, const int wave) {
    const int lane = lane_id_v();
    LAS u32x4* xl = (LAS u32x4*)(lds + wave * 16384);
    for (int r = blk * 8 + wave; r < S; r += nblk * 8) {
        const int n = r + 1; unsigned long long* mrow = (unsigned long long*)SEL + (size_t)r * 128;
        unsigned long long w0 = 0ull, w1 = 0ull;
        const int nwords = 4 * ((r >> 8) + 1);
        if (n <= TOPK) { const int lo = 64 * lane; w0 = (r < lo) ? 0ull : ((r - lo >= 63) ? ~0ull : ((2ull << (r - lo)) - 1ull)); }
        else { const float* row = SC + sc_off(r);
            unsigned T; int need; bool ok;
            if (n <= 2048) ok = topk_row<32, 0>(row, n, lane, xl, w0, w1, T, need); else if (n <= 4096) ok = topk_row<64, 0>(row, n, lane, xl, w0, w1, T, need); else ok = topk_row<64, 64>(row, n, lane, xl, w0, w1, T, need);
            if (!ok) { int eqc = 0; const unsigned long long lt = (lane == 0) ? 0ull : (~0ull >> (64 - lane));
                for (int base = 0, it = 0; base < n; base += 64, ++it) {
                    const int i = base + lane; const unsigned v = (i < n) ? (ordkey(row[i]) >> 1) : 0u;
                    const bool gt = v > T, eq = (i < n) && (v == T);
                    const unsigned long long be = __ballot(eq);
                    const bool take = gt || (eq && (eqc + __builtin_popcountll(be & lt) < need));
                    const unsigned long long bs = __ballot(take);
                    if ((it & 63) == lane) { if (it < 64) w0 = bs; else w1 = bs; }
                    eqc += __builtin_popcountll(be); } } }
        if (lane < nwords) mrow[lane] = w0;
        if (64 + lane < nwords) mrow[64 + lane] = w1;
    }
}
template <int DQ, int DV, bool GATHER>
__device__ __forceinline__ void naive_attn(const bf16_t* __restrict__ qp, const bf16_t* __restrict__ kb, const bf16_t* __restrict__ vb, size_t kvpitch,
                                           int nkeys, int nmax, const int* __restrict__ sel, int r, float scale, float slope, float (&o)[DV / 8]) {
    constexpr int QN = DQ / 8, VN = DV / 8;
    float q[QN];
#pragma unroll
    for (int i = 0; i < QN / 2; ++i) { const unsigned w = ((const unsigned*)qp)[i]; q[2 * i] = bflo(w) * scale; q[2 * i + 1] = bfhi(w) * scale; }
#pragma unroll
    for (int i = 0; i < VN; ++i) o[i] = 0.f;
    float m = -1e30f, l = 0.f;
    for (int i = 0; i < nmax; ++i) {
        bool valid = i < nkeys; int key = i;
        if (GATHER) { key = sel[valid ? i : 0]; valid = valid && key >= 0; }
        if (!valid) key = 0;
        const unsigned* kp = (const unsigned*)(kb + (size_t)key * kvpitch);
        float d = 0.f;
#pragma unroll
        for (int j = 0; j < QN / 2; ++j) { const unsigned w = kp[j]; d += q[2 * j] * bflo(w) + q[2 * j + 1] * bfhi(w); }
        d += __shfl_xor(d, 1); d += __shfl_xor(d, 2); d += __shfl_xor(d, 4);
        const float logit = d - slope * (float)(r - key);
        if (valid) {
            if (logit > m) { const float c = __expf(m - logit); l *= c;
#pragma unroll
                for (int j = 0; j < VN; ++j) o[j] *= c;
                m = logit; }
            const float p = __expf(logit - m); l += p;
            const unsigned* vp = (const unsigned*)(vb + (size_t)key * kvpitch);
#pragma unroll
            for (int j = 0; j < VN / 2; ++j) { const unsigned w = vp[j]; o[2 * j] += p * bflo(w); o[2 * j + 1] += p * bfhi(w); }
        }
    }
    const float il = 1.0f / l;
#pragma unroll
    for (int j = 0; j < VN; ++j) o[j] *= il;
}
__device__ __forceinline__ void attn_b_naive(const Args& a, int blk, int nblk, const int wave) {
    const int lane = lane_id_v(), tid = wave * 64 + lane, sub = lane & 7;
    const bf16_t* PROJ = (const bf16_t*)(a.ws + WS_PROJ); bf16_t* UB = (bf16_t*)(a.ws + WS_U) + (size_t)1 * S * 1024;
    const float lam = ((const float*)(a.ws + WS_CTL))[0];
    for (int wi = blk * 8 + wave; wi < 1024 * 8; wi += nblk * 8) {
        const int h = wi & 7, rg = wi >> 3, r = rg * 8 + (lane >> 3), nmax = rg * 8 + 8;
        const float slope = exp2f(-(float)(h + 1));
        float o0[16], o1[16];
        const bf16_t* rowp = PROJ + (size_t)r * NPAD;
        naive_attn<64, 128, false>(rowp + C_QB + h * 128 + sub * 8, PROJ + C_KB + h * 128 + sub * 8, PROJ + C_VB + h * 128 + sub * 16, NPAD, r + 1, nmax, nullptr, r, 0.125f, slope, o0);
        naive_attn<64, 128, false>(rowp + C_QB + h * 128 + 64 + sub * 8, PROJ + C_KB + h * 128 + 64 + sub * 8, PROJ + C_VB + h * 128 + sub * 16, NPAD, r + 1, nmax, nullptr, r, 0.125f, slope, o1);
        float ss = 0.f;
#pragma unroll
        for (int j = 0; j < 16; ++j) { o0[j] -= lam * o1[j]; ss += o0[j] * o0[j]; }
        ss += __shfl_xor(ss, 1); ss += __shfl_xor(ss, 2); ss += __shfl_xor(ss, 4);
        const float rs = 1.0f / sqrtf(ss * (1.f / 128.f) + RMS_EPS) * 0.8f;
        const float* g = a.in[9] + sub * 16; const bf16_t* zp = rowp + C_ZB + h * 128 + sub * 16;
        unsigned w[8];
#pragma unroll
        for (int j = 0; j < 8; ++j) w[j] = pk2(o0[2 * j] * rs * g[2 * j] * bf2f(zp[2 * j]), o0[2 * j + 1] * rs * g[2 * j + 1] * bf2f(zp[2 * j + 1]));
        u32x4* dst = (u32x4*)(UB + (size_t)r * 1024 + h * 128 + sub * 16);
        dst[0] = (u32x4){w[0], w[1], w[2], w[3]}; dst[1] = (u32x4){w[4], w[5], w[6], w[7]};
    }
}
__device__ __forceinline__ void attn_m_naive(const Args& a, int blk, int nblk, const int wave) {
    const int lane = lane_id_v(), tid = wave * 64 + lane, sub = lane & 7;
    const bf16_t* PROJ = (const bf16_t*)(a.ws + WS_PROJ); const bf16_t* MKV = (const bf16_t*)(a.ws + WS_MKV); bf16_t* UM = (bf16_t*)(a.ws + WS_U) + (size_t)2 * S * 1024;
    for (int wi = blk * 8 + wave; wi < 1024 * 4; wi += nblk * 8) {
        const int h = wi & 3, rg = wi >> 2, r = rg * 8 + (lane >> 3);
        float o[32];
        const bf16_t* rowp = PROJ + (size_t)r * NPAD;
        naive_attn<256, 256, false>(rowp + C_QM + h * 256 + sub * 32, MKV + h * 256 + sub * 32, MKV + 1024 + h * 256 + sub * 32, 2048, NMEM, NMEM, nullptr, 0, 0.0625f, 0.f, o);
        const bf16_t* zp = rowp + C_ZM + h * 256 + sub * 32;
        u32x4* dst = (u32x4*)(UM + (size_t)r * 1024 + h * 256 + sub * 32);
#pragma unroll
        for (int j = 0; j < 4; ++j) { u32x4 w;
            w.x = pk2(o[8 * j + 0] * bf2f(zp[8 * j + 0]), o[8 * j + 1] * bf2f(zp[8 * j + 1])); w.y = pk2(o[8 * j + 2] * bf2f(zp[8 * j + 2]), o[8 * j + 3] * bf2f(zp[8 * j + 3]));
            w.z = pk2(o[8 * j + 4] * bf2f(zp[8 * j + 4]), o[8 * j + 5] * bf2f(zp[8 * j + 5])); w.w = pk2(o[8 * j + 6] * bf2f(zp[8 * j + 6]), o[8 * j + 7] * bf2f(zp[8 * j + 7]));
            dst[j] = w; }
    }
}
__device__ __forceinline__ void attn_a_naive(const Args& a, int blk, int nblk, const int wave) {
    const int lane = lane_id_v(), tid = wave * 64 + lane, sub = lane & 7;
    const bf16_t* PROJ = (const bf16_t*)(a.ws + WS_PROJ); const int* SEL = (const int*)(a.ws + WS_SEL); bf16_t* UA = (bf16_t*)(a.ws + WS_U);
    for (int wi = blk * 8 + wave; wi < 1024 * 8; wi += nblk * 8) {
        const int h = wi & 7, rg = wi >> 3, r = rg * 8 + (lane >> 3);
        const float slope = exp2f(-(float)(h + 1));
        float o[16];
        const bf16_t* rowp = PROJ + (size_t)r * NPAD;
        naive_attn<128, 128, true>(rowp + C_QA + h * 128 + sub * 16, PROJ + C_KA + h * 128 + sub * 16, PROJ + C_VA + h * 128 + sub * 16, NPAD, TOPK, TOPK, SEL + (size_t)r * TOPK, r, 0.08838834764831845f, slope, o);
        const bf16_t* zp = rowp + C_ZA + h * 128 + sub * 16;
        unsigned w[8];
#pragma unroll
        for (int j = 0; j < 8; ++j) w[j] = pk2(o[2 * j] * bf2f(zp[2 * j]), o[2 * j + 1] * bf2f(zp[2 * j + 1]));
        u32x4* dst = (u32x4*)(UA + (size_t)r * 1024 + h * 128 + sub * 16);
        dst[0] = (u32x4){w[0], w[1], w[2], w[3]}; dst[1] = (u32x4){w[4], w[5], w[6], w[7]};
    }
}
__device__ __forceinline__ void final_norm(const Args& a, int blk, int nblk, const int wave) {
    const int lane = lane_id_v(), tid = wave * 64 + lane;
    const float* part = (const float*)(a.ws + WS_PART); const f32x4* g = (const f32x4*)a.in[16] + lane;
    for (int r = blk * 8 + wave; r < S; r += nblk * 8) {
        float s = (lane < 32) ? part[(size_t)lane * S + r] : 0.f;
        const float rs = 1.0f / sqrtf(wave_sum(s) * (1.f / DM) + RMS_EPS);
        f32x4* y = (f32x4*)(a.out + (size_t)r * DM) + lane;
#pragma unroll
        for (int j = 0; j < 8; ++j) { f32x4 v = y[64 * j]; const f32x4 gg = g[64 * j]; v = v * rs * gg; y[64 * j] = v; }
    }
}


namespace att {
typedef short bf16x8 __attribute__((ext_vector_type(8)));
typedef short s16x4 __attribute__((ext_vector_type(4)));
typedef float f32x16 __attribute__((ext_vector_type(16)));
typedef float f32x2_t __attribute__((ext_vector_type(2)));
typedef __bf16 bf16x2_t __attribute__((ext_vector_type(2)));
constexpr int SHM_V = 16384, SHM_K = 16384;
constexpr float LOG2E = 1.4426950408889634f;
constexpr float THR2 = 8.f * LOG2E;
#define KSWZ(row, colB) ((row) * 256 + ((colB) ^ (((row) & 7) << 4)))
#define SBAR() __builtin_amdgcn_sched_barrier(0)
__device__ __forceinline__ int crow(int r, int hi) { return (r & 3) + 8 * (r >> 2) + 4 * hi; }
__device__ __forceinline__ unsigned cvtpk(float lo, float hi) { f32x2_t v = {lo, hi}; bf16x2_t b = __builtin_convertvector(v, bf16x2_t); return __builtin_bit_cast(unsigned, b); }
__device__ __forceinline__ int v_st(int k, int c) { const int kk = (k & ~0xC) | ((k & 4) << 1) | ((k & 8) >> 1); return ((kk >> 3) * 4 + (c >> 5)) * 512 + ((kk & 7) * 32 + (c & 31)) * 2; }
__device__ __forceinline__ int v_rd_base(int lane) { return ((lane & 3) << 3) | (((lane >> 2) & 3) << 6) | (((lane >> 4) & 1) << 5) | (((lane >> 5) & 1) << 8); }
constexpr int v_rd_off(int d0, int ks, int half) { return d0 * 512 + ks * 4096 + half * 2048; }
typedef short v4i16_t __attribute__((ext_vector_type(4)));
__device__ __forceinline__ s16x4 tr_read(LAS const unsigned char* p) { return __builtin_bit_cast(s16x4, __builtin_amdgcn_ds_read_tr16_b64_v4i16((LAS v4i16_t*)p)); }

template <int NQ> __device__ __forceinline__ void qkt(f32x16& p0, f32x16& p1, LAS const unsigned char* Ks, const bf16x8* qr, int cbyte0, int r32, int hi) {
  p0 = f32x16{}; p1 = f32x16{};
#pragma unroll
  for (int d0 = 0; d0 < NQ; ++d0) { const int cb = cbyte0 + (d0 * 16 + hi * 8) * 2;
    const bf16x8 b0 = *(LAS const bf16x8*)(Ks + KSWZ(r32, cb));
    const bf16x8 b1 = *(LAS const bf16x8*)(Ks + KSWZ(32 + r32, cb));
    p0 = __builtin_amdgcn_mfma_f32_32x32x16_bf16(b0, qr[d0], p0, 0, 0, 0);
    p1 = __builtin_amdgcn_mfma_f32_32x32x16_bf16(b1, qr[d0], p1, 0, 0, 0); }
}
template <int NQ> __device__ __forceinline__ void qkt_l(f32x16& p0, f32x16& p1, LAS const unsigned char* Ks, LAS const unsigned char* Qs, int cbyte0, int r32, int hi) {
  p0 = f32x16{}; p1 = f32x16{};
  asm volatile("" : "+v"(Qs));
#pragma unroll
  for (int d0 = 0; d0 < NQ; ++d0) { const int cb = cbyte0 + (d0 * 16 + hi * 8) * 2;
    const bf16x8 q = *(LAS const bf16x8*)(Qs + d0 * 1024);
    const bf16x8 b0 = *(LAS const bf16x8*)(Ks + KSWZ(r32, cb));
    const bf16x8 b1 = *(LAS const bf16x8*)(Ks + KSWZ(32 + r32, cb));
    p0 = __builtin_amdgcn_mfma_f32_32x32x16_bf16(b0, q, p0, 0, 0, 0);
    p1 = __builtin_amdgcn_mfma_f32_32x32x16_bf16(b1, q, p1, 0, 0, 0); }
}
template <int D0> __device__ __forceinline__ void pv_one(f32x16& od, LAS const unsigned char* vb, bf16x8 pa0, bf16x8 pa1, bf16x8 pa2, bf16x8 pa3) {
  const s16x4 l0 = tr_read(vb + v_rd_off(D0, 0, 0)), h0 = tr_read(vb + v_rd_off(D0, 0, 1)), l1 = tr_read(vb + v_rd_off(D0, 1, 0)), h1 = tr_read(vb + v_rd_off(D0, 1, 1));
  const s16x4 l2 = tr_read(vb + v_rd_off(D0, 2, 0)), h2 = tr_read(vb + v_rd_off(D0, 2, 1)), l3 = tr_read(vb + v_rd_off(D0, 3, 0)), h3 = tr_read(vb + v_rd_off(D0, 3, 1));
#define PK(L, H) (bf16x8){L[0], L[1], L[2], L[3], H[0], H[1], H[2], H[3]}
  od = __builtin_amdgcn_mfma_f32_32x32x16_bf16(pa0, PK(l0, h0), od, 0, 0, 0);
  od = __builtin_amdgcn_mfma_f32_32x32x16_bf16(pa1, PK(l1, h1), od, 0, 0, 0);
  od = __builtin_amdgcn_mfma_f32_32x32x16_bf16(pa2, PK(l2, h2), od, 0, 0, 0);
  od = __builtin_amdgcn_mfma_f32_32x32x16_bf16(pa3, PK(l3, h3), od, 0, 0, 0);
#undef PK
}
__device__ __forceinline__ void pv_d0(f32x16* o, LAS const unsigned char* vb, bf16x8 pa0, bf16x8 pa1, bf16x8 pa2, bf16x8 pa3) {
  pv_one<0>(o[0], vb, pa0, pa1, pa2, pa3); pv_one<1>(o[1], vb, pa0, pa1, pa2, pa3); pv_one<2>(o[2], vb, pa0, pa1, pa2, pa3); pv_one<3>(o[3], vb, pa0, pa1, pa2, pa3);
}
template <bool CAUSAL> __device__ __forceinline__ void partialSM(f32x16& p0, f32x16& p1, float& m_reg, float& alpha, const float (&cs)[16], float base, int lim, float C, float slope2, int delta) {
  const float tb0 = slope2 * (float)delta + base, tb1 = slope2 * (float)(delta + 32) + base;
#pragma unroll
  for (int r = 0; r < 16; ++r) { p0[r] = fmaf(p0[r], C, cs[r]); p1[r] = fmaf(p1[r], C, cs[r]); }
  if (CAUSAL && delta + 63 > 0) {
    const int l0 = lim - delta, l1 = l0 - 32;
#pragma unroll
    for (int r = 0; r < 16; ++r) { const int K = (r & 3) + 8 * (r >> 2); if (K > l0) p0[r] = -INFINITY; if (K > l1) p1[r] = -INFINITY; }
  }
  float pm0 = p0[0], pm1 = p1[0];
#pragma unroll
  for (int r = 1; r < 16; ++r) { pm0 = fmaxf(pm0, p0[r]); pm1 = fmaxf(pm1, p1[r]); }
  float pmax = fmaxf(pm0 + tb0, pm1 + tb1);
  { auto rr = __builtin_amdgcn_permlane32_swap(__float_as_uint(pmax), __float_as_uint(pmax), false, false);
    pmax = fmaxf(__uint_as_float(rr[0]), __uint_as_float(rr[1])); }
  float mn;
  if (__builtin_expect(__all(pmax - m_reg <= THR2), 1)) { mn = m_reg; alpha = 1.f; }
  else { mn = fmaxf(m_reg, pmax); alpha = __builtin_amdgcn_exp2f(m_reg - mn); m_reg = mn; }
  const float a0 = tb0 - mn, a1 = tb1 - mn;
#pragma unroll
  for (int r = 0; r < 16; ++r) { p0[r] += a0; p1[r] += a1; }
#pragma unroll
  for (int r = 0; r < 16; ++r) p0[r] = __builtin_amdgcn_exp2f(p0[r]);
}
__device__ __forceinline__ void finishSM(f32x16& p0, f32x16& p1, float alpha, float& l_reg, bf16x8& pa0, bf16x8& pa1, bf16x8& pa2, bf16x8& pa3) {
#pragma unroll
  for (int r = 0; r < 16; ++r) p1[r] = __builtin_amdgcn_exp2f(p1[r]);
  float ps = 0;
#pragma unroll
  for (int r = 0; r < 16; ++r) ps += p0[r];
#pragma unroll
  for (int r = 0; r < 16; ++r) ps += p1[r];
  { auto rr = __builtin_amdgcn_permlane32_swap(__float_as_uint(ps), __float_as_uint(ps), false, false);
    ps = __uint_as_float(rr[0]) + __uint_as_float(rr[1]); }
  l_reg = l_reg * alpha + ps;
#define PK4(P, BASE, OUT) do { unsigned a0 = cvtpk(P[BASE + 0], P[BASE + 1]), a1 = cvtpk(P[BASE + 2], P[BASE + 3]);   \
    unsigned b0 = cvtpk(P[BASE + 4], P[BASE + 5]), b1 = cvtpk(P[BASE + 6], P[BASE + 7]);                              \
    auto r0 = __builtin_amdgcn_permlane32_swap(a0, b0, false, false); auto r1 = __builtin_amdgcn_permlane32_swap(a1, b1, false, false); \
    u32x4 w = {r0[0], r1[0], r0[1], r1[1]}; OUT = __builtin_bit_cast(bf16x8, w); } while (0)
  PK4(p0, 0, pa0); PK4(p0, 8, pa1); PK4(p1, 0, pa2); PK4(p1, 8, pa3);
#undef PK4
}

__device__ __forceinline__ void attn_b_unit(const bf16_t* __restrict__ PROJ, bf16_t* UB, const float* __restrict__ gsub, float lam, int h, int qb, int jmin, LAS unsigned char* lds, const int wid) {
  const int lane = lane_id_v(), tid = wid * 64 + lane, r32 = lane & 31, hi = lane >> 5, comp = wid >> 2, wq = wid & 3;
  const int R0 = qb * 128, qrow0 = R0 + wq * 32, NT = 2 * qb + 2, NTe = NT - jmin;
  LAS unsigned char* V_lds = lds; LAS unsigned char* K_lds = lds + 2 * SHM_V;
  LAS float* ws = (LAS float*)(lds + 2 * SHM_V + 2 * SHM_K) + wid * 64; LAS float* li_l = ws; LAS float* al_l = ws + 32;
  LAS float* xch = (LAS float*)(lds + 2 * SHM_V + 2 * SHM_K + 2048);
  const float slope2 = __builtin_amdgcn_exp2f(-(float)(h + 1)) * LOG2E, C = 0.125f * LOG2E;
  float cs[16];
#pragma unroll
  for (int r = 0; r < 16; ++r) cs[r] = __uint_as_float(__builtin_amdgcn_readfirstlane(__float_as_uint(slope2 * (float)((r & 3) + 8 * (r >> 2)))));
  const float base = slope2 * (float)(4 * hi - r32); const int lim = r32 - 4 * hi;
  float m_reg = -1e30f, l_reg = 0; f32x16 o[4] = {};
  LAS unsigned char* Qs = lds + 2 * SHM_V + 2 * SHM_K + 2048 + wid * 4096 + lane * 16;
  { const bf16_t* Qw = PROJ + (size_t)(qrow0 + r32) * NPAD + C_QB + h * 128 + comp * 64 + hi * 8;
#pragma unroll
    for (int d0 = 0; d0 < 4; ++d0) *(LAS bf16x8*)(Qs + d0 * 1024) = *(const bf16x8*)(Qw + d0 * 16); }
  const unsigned offK = (unsigned)((tid >> 4) * NPAD + C_KB + h * 128 + (tid & 15) * 8) * 2u, offV = offK + (unsigned)(C_VB - C_KB) * 2u;
  const int sr = tid >> 4, sc = (tid & 15) * 8, vst0 = v_st(sr, sc), vst1 = v_st(32 + sr, sc), cq = comp * 128;
  LAS const unsigned char* vb0 = V_lds + v_rd_base(lane);
  struct { bf16x8 vs0, vs1, ks0, ks1; } sr_[2];
#define KEY0(t) (64 * (NT - 1 - (t)))
#define GLD16(off) (*(const bf16x8*)((const char*)PROJ + (unsigned)(off)))
#define SLOAD(i, k0) do { const unsigned kb_ = (unsigned)(k0) * (unsigned)(NPAD * 2); sr_[i].vs0 = GLD16(offV + kb_); sr_[i].vs1 = GLD16(offV + kb_ + 32u * NPAD * 2u); \
    sr_[i].ks0 = GLD16(offK + kb_); sr_[i].ks1 = GLD16(offK + kb_ + 32u * NPAD * 2u); } while (0)
#define SWRITE(b) do { *(LAS bf16x8*)(V_lds + (b) * SHM_V + vst0) = sr_[b].vs0; *(LAS bf16x8*)(V_lds + (b) * SHM_V + vst1) = sr_[b].vs1; const int kc = sc * 2; \
    *(LAS bf16x8*)(K_lds + (b) * SHM_K + KSWZ(sr, kc)) = sr_[b].ks0; *(LAS bf16x8*)(K_lds + (b) * SHM_K + KSWZ(32 + sr, kc)) = sr_[b].ks1; } while (0)
#define RESC(a) do { if (__any((a) < 1.f)) { if (hi == 0) al_l[r32] = (a); asm volatile("s_waitcnt lgkmcnt(0)" ::: "memory"); \
    _Pragma("unroll") for (int d = 0; d < 4; ++d) _Pragma("unroll") for (int r = 0; r < 16; ++r) o[d][r] *= al_l[crow(r, hi)]; } } while (0)
  f32x16 pA0, pA1, pB0, pB1; float alA, alB; bf16x8 pa0, pa1, pa2, pa3;
  SLOAD(0, KEY0(0)); SWRITE(0); __syncthreads();
  qkt_l<4>(pA0, pA1, K_lds, Qs, cq, r32, hi); partialSM<true>(pA0, pA1, m_reg, alA, cs, base, lim, C, slope2, KEY0(0) - qrow0);
  SLOAD(1, KEY0(1)); if (2 < NTe) SLOAD(0, KEY0(2));
  SWRITE(1); __syncthreads();
  for (int j = 1; j + 1 < NTe; j += 2) {
    SBAR(); qkt_l<4>(pB0, pB1, K_lds + SHM_K, Qs, cq, r32, hi);
    finishSM(pA0, pA1, alA, l_reg, pa0, pa1, pa2, pa3); SBAR();
    SLOAD(1, KEY0(j + 2)); SBAR();
    pv_d0(o, vb0, pa0, pa1, pa2, pa3); partialSM<true>(pB0, pB1, m_reg, alB, cs, base, lim, C, slope2, KEY0(j) - qrow0);
    __syncthreads(); SWRITE(0);
    RESC(alB); __syncthreads();
    SBAR(); qkt_l<4>(pA0, pA1, K_lds, Qs, cq, r32, hi);
    finishSM(pB0, pB1, alB, l_reg, pa0, pa1, pa2, pa3); SBAR();
    SLOAD(0, KEY0(min(j + 3, NTe - 1))); SBAR();
    pv_d0(o, vb0 + SHM_V, pa0, pa1, pa2, pa3); partialSM<true>(pA0, pA1, m_reg, alA, cs, base, lim, C, slope2, KEY0(j + 1) - qrow0);
    __syncthreads(); SWRITE(1);
    RESC(alA); __syncthreads();
  }
  SBAR(); qkt_l<4>(pB0, pB1, K_lds + SHM_K, Qs, cq, r32, hi);
  finishSM(pA0, pA1, alA, l_reg, pa0, pa1, pa2, pa3); SBAR();
  pv_d0(o, vb0, pa0, pa1, pa2, pa3); partialSM<true>(pB0, pB1, m_reg, alB, cs, base, lim, C, slope2, KEY0(NTe - 1) - qrow0);
  __syncthreads(); RESC(alB);
  finishSM(pB0, pB1, alB, l_reg, pa0, pa1, pa2, pa3); SBAR();
  pv_d0(o, vb0 + SHM_V, pa0, pa1, pa2, pa3);
#undef KEY0
#undef SLOAD
#undef GLD16
#undef SWRITE
#undef RESC
  if (hi == 0) li_l[r32] = l_reg; asm volatile("s_waitcnt lgkmcnt(0)" ::: "memory");
  float rli[16];
#pragma unroll
  for (int r = 0; r < 16; ++r) rli[r] = __builtin_amdgcn_rcpf(li_l[crow(r, hi)]);
  __syncthreads();
  if (comp == 1) {
#pragma unroll
    for (int d0 = 0; d0 < 4; ++d0)
#pragma unroll
      for (int r = 0; r < 16; ++r) xch[(wq * 64 + d0 * 16 + r) * 64 + lane] = o[d0][r] * rli[r] * lam;
  }
  __syncthreads();
  if (comp == 0) {
    float ss[16];
#pragma unroll
    for (int r = 0; r < 16; ++r) ss[r] = 0.f;
#pragma unroll
    for (int d0 = 0; d0 < 4; ++d0)
#pragma unroll
      for (int r = 0; r < 16; ++r) { const float d = o[d0][r] * rli[r] - xch[(wq * 64 + d0 * 16 + r) * 64 + lane]; o[d0][r] = d; ss[r] += d * d; }
#pragma unroll
    for (int r = 0; r < 16; ++r) { float s = ss[r]; s += __shfl_xor(s, 1); s += __shfl_xor(s, 2); s += __shfl_xor(s, 4); s += __shfl_xor(s, 8); s += __shfl_xor(s, 16);
      ss[r] = 0.8f / sqrtf(s * (1.f / 128.f) + RMS_EPS); }
#pragma unroll
    for (int d0 = 0; d0 < 4; ++d0) { const int col = d0 * 32 + r32; const float g = gsub[col];
#pragma unroll
      for (int r = 0; r < 16; ++r) { const size_t row = (size_t)(qrow0 + crow(r, hi));
        const float z = bf2f(PROJ[row * NPAD + C_ZB + h * 128 + col]);
        UB[row * 1024 + h * 128 + col] = (bf16_t)f2bf(o[d0][r] * ss[r] * g * z); } }
  }
  __syncthreads();
}
template <bool DUMMY> __device__ __forceinline__ void partialSM_A(f32x16& p0, f32x16& p1, float& m_reg, float& alpha, const float (&cs)[16], float base, float C, float slope2, int delta, unsigned long long mw, int hi) {
  const float tb0 = slope2 * (float)delta + base, tb1 = slope2 * (float)(delta + 32) + base;
  const unsigned wl = (unsigned)mw >> (4 * hi), wh = (unsigned)(mw >> 32) >> (4 * hi);
#pragma unroll
  for (int r = 0; r < 16; ++r) { const int K = (r & 3) + 8 * (r >> 2);
    const float y0 = fmaf(p0[r], C, cs[r]), y1 = fmaf(p1[r], C, cs[r]);
    const unsigned t0 = (unsigned)((int)(wl << (31 - K)) >> 31), t1 = (unsigned)((int)(wh << (31 - K)) >> 31);
    p0[r] = __uint_as_float((__float_as_uint(y0) & t0) | (~t0 & 0xff800000u));
    p1[r] = __uint_as_float((__float_as_uint(y1) & t1) | (~t1 & 0xff800000u)); }
  float pm0 = p0[0], pm1 = p1[0];
#pragma unroll
  for (int r = 1; r < 16; ++r) { pm0 = fmaxf(pm0, p0[r]); pm1 = fmaxf(pm1, p1[r]); }
  float pmax = fmaxf(pm0 + tb0, pm1 + tb1);
  { auto rr = __builtin_amdgcn_permlane32_swap(__float_as_uint(pmax), __float_as_uint(pmax), false, false);
    pmax = fmaxf(__uint_as_float(rr[0]), __uint_as_float(rr[1])); }
  float mn;
  if (__builtin_expect(__all(pmax - m_reg <= THR2), 1)) { mn = m_reg; alpha = 1.f; }
  else { mn = fmaxf(m_reg, pmax); alpha = __builtin_amdgcn_exp2f(m_reg - mn); m_reg = mn; }
  const float a0 = tb0 - mn, a1 = tb1 - mn;
#pragma unroll
  for (int r = 0; r < 16; ++r) { p0[r] += a0; p1[r] += a1; }
#pragma unroll
  for (int r = 0; r < 16; ++r) p0[r] = __builtin_amdgcn_exp2f(p0[r]);
}
__device__ __forceinline__ void attn_a_unit(const bf16_t* __restrict__ PROJ, const unsigned long long* __restrict__ MASK, bf16_t* UA, int h, int qb, int jmin, LAS unsigned char* lds, const int wid) {
  const int lane = lane_id_v(), tid = wid * 64 + lane, r32 = lane & 31, hi = lane >> 5;
  const int R0 = qb * 256, qrow0 = R0 + wid * 32, NT = 4 * qb + 4, NTe = NT - jmin;
  LAS unsigned char* V_lds = lds; LAS unsigned char* K_lds = lds + 2 * SHM_V;
  LAS float* ws = (LAS float*)(lds + 2 * SHM_V + 2 * SHM_K) + wid * 64; LAS float* li_l = ws; LAS float* al_l = ws + 32;
  const float slope2 = __builtin_amdgcn_exp2f(-(float)(h + 1)) * LOG2E, C = 0.08838834764831845f * LOG2E;
  float cs[16];
#pragma unroll
  for (int r = 0; r < 16; ++r) cs[r] = __uint_as_float(__builtin_amdgcn_readfirstlane(__float_as_uint(slope2 * (float)((r & 3) + 8 * (r >> 2)))));
  const float base = slope2 * (float)(4 * hi - r32);
  float m_reg = -1e30f, l_reg = 0; f32x16 o[4] = {}; bf16x8 qr[8];
  { const bf16_t* Qw = PROJ + (size_t)(qrow0 + r32) * NPAD + C_QA + h * 128 + hi * 8;
#pragma unroll
    for (int d0 = 0; d0 < 8; ++d0) qr[d0] = *(const bf16x8*)(Qw + d0 * 16); }
  const unsigned offK = (unsigned)((tid >> 4) * NPAD + C_KA + h * 128 + (tid & 15) * 8) * 2u, offV = offK + (unsigned)(C_VA - C_KA) * 2u;
  const unsigned moff = (unsigned)(qrow0 + r32) * 1024u;
#define MLD(tj) (*(const unsigned long long*)((const char*)MASK + (moff + 8u * (unsigned)(tj))))
  const int sr = tid >> 4, sc = (tid & 15) * 8, vst0 = v_st(sr, sc), vst1 = v_st(32 + sr, sc);
  LAS const unsigned char* vb0 = V_lds + v_rd_base(lane);
  struct { bf16x8 vs0, vs1, ks0, ks1; } sr_;
#define TJ(t) (NT - 1 - (t))
#define KEY0(t) (64 * TJ(t))
#define GLD16(off) (*(const bf16x8*)((const char*)PROJ + (unsigned)(off)))
#define SLOAD(k0) do { const unsigned kb_ = (unsigned)(k0) * (unsigned)(NPAD * 2); sr_.vs0 = GLD16(offV + kb_); sr_.vs1 = GLD16(offV + kb_ + 32u * NPAD * 2u); \
    sr_.ks0 = GLD16(offK + kb_); sr_.ks1 = GLD16(offK + kb_ + 32u * NPAD * 2u); } while (0)
#define SWRITE(b) do { *(LAS bf16x8*)(V_lds + (b) * SHM_V + vst0) = sr_.vs0; *(LAS bf16x8*)(V_lds + (b) * SHM_V + vst1) = sr_.vs1; const int kc = sc * 2; \
    *(LAS bf16x8*)(K_lds + (b) * SHM_K + KSWZ(sr, kc)) = sr_.ks0; *(LAS bf16x8*)(K_lds + (b) * SHM_K + KSWZ(32 + sr, kc)) = sr_.ks1; } while (0)
#define RESC(a) do { if (__any((a) < 1.f)) { if (hi == 0) al_l[r32] = (a); asm volatile("s_waitcnt lgkmcnt(0)" ::: "memory"); \
    _Pragma("unroll") for (int d = 0; d < 4; ++d) _Pragma("unroll") for (int r = 0; r < 16; ++r) o[d][r] *= al_l[crow(r, hi)]; } } while (0)
  f32x16 pA0, pA1, pB0, pB1; float alA, alB; bf16x8 pa0, pa1, pa2, pa3; unsigned long long mwA, mwB;
  SLOAD(KEY0(0)); mwA = MLD(TJ(0)); SWRITE(0); __syncthreads();
  qkt<8>(pA0, pA1, K_lds, qr, 0, r32, hi); partialSM_A<true>(pA0, pA1, m_reg, alA, cs, base, C, slope2, KEY0(0) - qrow0, mwA, hi);
  SLOAD(KEY0(1)); mwB = MLD(TJ(1)); SWRITE(1); __syncthreads();
  for (int j = 1; j + 1 < NTe; j += 2) {
    SBAR(); qkt<8>(pB0, pB1, K_lds + SHM_K, qr, 0, r32, hi);
    finishSM(pA0, pA1, alA, l_reg, pa0, pa1, pa2, pa3); SBAR();
    SLOAD(KEY0(j + 1)); mwA = MLD(TJ(j + 1)); SBAR();
    pv_d0(o, vb0, pa0, pa1, pa2, pa3); partialSM_A<true>(pB0, pB1, m_reg, alB, cs, base, C, slope2, KEY0(j) - qrow0, mwB, hi);
    __syncthreads(); SWRITE(0);
    RESC(alB); __syncthreads();
    SBAR(); qkt<8>(pA0, pA1, K_lds, qr, 0, r32, hi);
    finishSM(pB0, pB1, alB, l_reg, pa0, pa1, pa2, pa3); SBAR();
    SLOAD(KEY0(j + 2)); mwB = MLD(TJ(j + 2)); SBAR();
    pv_d0(o, vb0 + SHM_V, pa0, pa1, pa2, pa3); partialSM_A<true>(pA0, pA1, m_reg, alA, cs, base, C, slope2, KEY0(j + 1) - qrow0, mwA, hi);
    __syncthreads(); SWRITE(1);
    RESC(alA); __syncthreads();
  }
  SBAR(); qkt<8>(pB0, pB1, K_lds + SHM_K, qr, 0, r32, hi);
  finishSM(pA0, pA1, alA, l_reg, pa0, pa1, pa2, pa3); SBAR();
  pv_d0(o, vb0, pa0, pa1, pa2, pa3); partialSM_A<true>(pB0, pB1, m_reg, alB, cs, base, C, slope2, KEY0(NTe - 1) - qrow0, mwB, hi);
  __syncthreads(); RESC(alB);
  finishSM(pB0, pB1, alB, l_reg, pa0, pa1, pa2, pa3); SBAR();
  pv_d0(o, vb0 + SHM_V, pa0, pa1, pa2, pa3);
#undef TJ
#undef MLD
#undef KEY0
#undef SLOAD
#undef GLD16
#undef SWRITE
#undef RESC
  if (hi == 0) li_l[r32] = l_reg; asm volatile("s_waitcnt lgkmcnt(0)" ::: "memory");
  float rli[16];
#pragma unroll
  for (int r = 0; r < 16; ++r) rli[r] = __builtin_amdgcn_rcpf(li_l[crow(r, hi)]);
#pragma unroll
  for (int d0 = 0; d0 < 4; ++d0) { const int col = h * 128 + d0 * 32 + r32;
#pragma unroll
    for (int r = 0; r < 16; ++r) { const size_t row = (size_t)(qrow0 + crow(r, hi));
      const float z = bf2f(PROJ[row * NPAD + C_ZA + col]);
      UA[row * 1024 + col] = (bf16_t)f2bf(o[d0][r] * rli[r] * z); } }
  __syncthreads();
}
template <int NQ, bool ACC> __device__ __forceinline__ void qkt_acc(f32x16& p0, f32x16& p1, LAS const unsigned char* Ks, const bf16x8* qr, int r32, int hi) {
  if (!ACC) { p0 = f32x16{}; p1 = f32x16{}; }
#pragma unroll
  for (int d0 = 0; d0 < NQ; ++d0) { const int cb = (d0 * 16 + hi * 8) * 2;
    const bf16x8 b0 = *(LAS const bf16x8*)(Ks + KSWZ(r32, cb));
    const bf16x8 b1 = *(LAS const bf16x8*)(Ks + KSWZ(32 + r32, cb));
    p0 = __builtin_amdgcn_mfma_f32_32x32x16_bf16(b0, qr[d0], p0, 0, 0, 0);
    p1 = __builtin_amdgcn_mfma_f32_32x32x16_bf16(b1, qr[d0], p1, 0, 0, 0); }
}
__device__ __forceinline__ void attn_m_unit(const bf16_t* __restrict__ PROJ, const bf16_t* __restrict__ MKV, bf16_t* UM, int h, int qb, int vh, LAS unsigned char* lds, const int wid) {
  const int lane = lane_id_v(), tid = wid * 64 + lane, r32 = lane & 31, hi = lane >> 5;
  const int qrow0 = qb * 256 + wid * 32;
  LAS unsigned char* V_lds = lds; LAS unsigned char* K_lds = lds + 2 * SHM_V;
  LAS float* ws = (LAS float*)(lds + 2 * SHM_V + 2 * SHM_K) + wid * 64; LAS float* li_l = ws; LAS float* al_l = ws + 32;
  const float C = 0.0625f * LOG2E;
  const float cs[16] = {0.f, 0.f, 0.f, 0.f, 0.f, 0.f, 0.f, 0.f, 0.f, 0.f, 0.f, 0.f, 0.f, 0.f, 0.f, 0.f};
  float m_reg = -1e30f, l_reg = 0; f32x16 o[4] = {}; bf16x8 qr[16];
  { const bf16_t* Qw = PROJ + (size_t)(qrow0 + r32) * NPAD + C_QM + h * 256 + hi * 8;
#pragma unroll
    for (int d0 = 0; d0 < 16; ++d0) qr[d0] = *(const bf16x8*)(Qw + d0 * 16); }
  const int sr = tid >> 4, sc = (tid & 15) * 8, vst0 = v_st(sr, sc), vst1 = v_st(32 + sr, sc);
  const unsigned offK = (unsigned)(sr * 2048 + h * 256 + sc) * 2u, offV = offK + (unsigned)(1024 + vh * 128) * 2u;
  LAS const unsigned char* vb0 = V_lds + v_rd_base(lane);
#define GLD16(off) (*(const bf16x8*)((const char*)MKV + (unsigned)(off)))
  for (int t = 0; t < 4; ++t) {
    const unsigned kb_ = (unsigned)(64 * t) * 4096u;
    const bf16x8 ka0 = GLD16(offK + kb_), ka1 = GLD16(offK + kb_ + 32u * 4096u), kb0 = GLD16(offK + kb_ + 256u), kb1 = GLD16(offK + kb_ + 32u * 4096u + 256u);
    const bf16x8 vs0 = GLD16(offV + kb_), vs1 = GLD16(offV + kb_ + 32u * 4096u);
    const int kc = sc * 2;
    *(LAS bf16x8*)(K_lds + KSWZ(sr, kc)) = ka0; *(LAS bf16x8*)(K_lds + KSWZ(32 + sr, kc)) = ka1;
    *(LAS bf16x8*)(K_lds + SHM_K + KSWZ(sr, kc)) = kb0; *(LAS bf16x8*)(K_lds + SHM_K + KSWZ(32 + sr, kc)) = kb1;
    *(LAS bf16x8*)(V_lds + vst0) = vs0; *(LAS bf16x8*)(V_lds + vst1) = vs1;
    __syncthreads();
    f32x16 p0, p1; float al; bf16x8 pa0, pa1, pa2, pa3;
    qkt_acc<8, false>(p0, p1, K_lds, qr, r32, hi); qkt_acc<8, true>(p0, p1, K_lds + SHM_K, qr + 8, r32, hi);
    partialSM<false>(p0, p1, m_reg, al, cs, 0.f, 0, C, 0.f, 0);
    if (__any(al < 1.f)) { if (hi == 0) al_l[r32] = al; asm volatile("s_waitcnt lgkmcnt(0)" ::: "memory");
#pragma unroll
      for (int d = 0; d < 4; ++d)
#pragma unroll
        for (int r = 0; r < 16; ++r) o[d][r] *= al_l[crow(r, hi)]; }
    finishSM(p0, p1, al, l_reg, pa0, pa1, pa2, pa3);
    pv_d0(o, vb0, pa0, pa1, pa2, pa3);
    __syncthreads();
  }
#undef GLD16
  if (hi == 0) li_l[r32] = l_reg; asm volatile("s_waitcnt lgkmcnt(0)" ::: "memory");
  float rli[16];
#pragma unroll
  for (int r = 0; r < 16; ++r) rli[r] = __builtin_amdgcn_rcpf(li_l[crow(r, hi)]);
#pragma unroll
  for (int d0 = 0; d0 < 4; ++d0) { const int col = h * 256 + vh * 128 + d0 * 32 + r32;
#pragma unroll
    for (int r = 0; r < 16; ++r) { const size_t row = (size_t)(qrow0 + crow(r, hi));
      const float z = bf2f(PROJ[row * NPAD + C_ZM + col]);
      UM[row * 1024 + col] = (bf16_t)f2bf(o[d0][r] * rli[r] * z); } }
  __syncthreads();
}
__device__ __forceinline__ void attn_m_phase(const Args& a, LAS unsigned char* lds, int blk, int nblk, const int wid) {
  const bf16_t* PROJ = (const bf16_t*)(a.ws + WS_PROJ); const bf16_t* MKV = (const bf16_t*)(a.ws + WS_MKV); bf16_t* UM = (bf16_t*)(a.ws + WS_U) + (size_t)2 * S * 1024;
  for (int u = blk; u < 256; u += nblk) attn_m_unit(PROJ, MKV, UM, u & 3, u >> 3, (u >> 2) & 1, lds, wid);
}
__device__ __forceinline__ float slot_sum(const unsigned* ns, int tile, int bj, int wc0, int nwc) { float s = 0.f;
  for (int w = 0; w < nwc; ++w) s += __uint_as_float(__hip_atomic_load(ns + (tile * 2 + bj) * 4 + wc0 + w, __ATOMIC_RELAXED, __HIP_MEMORY_SCOPE_AGENT)); return s; }
__device__ __forceinline__ int window_jmin(float q2k2, float scale, int h, int R0, int NT) {
  const float slope2 = __builtin_amdgcn_exp2f(-(float)(h + 1)) * LOG2E, L = sqrtf(q2k2) * scale * LOG2E * 1.02f, D = (2.f * L + 48.f) / slope2;
  const float x = ((float)R0 - D - 63.f) * (1.f / 64.f);
  int jm = (int)floorf(x) - 1; jm = jm < 0 ? 0 : jm; jm &= ~1; return jm > NT - 2 ? NT - 2 : jm;
}
__device__ __forceinline__ int jmin_b(const unsigned* ns, int h, int qb) {
  const int bj = h & 1; float m = 0.f;
  for (int c = 0; c < 2; ++c) { const float v = slot_sum(ns, 20 + (h >> 1), bj, 2 * c, 2) * slot_sum(ns, 24 + (h >> 1), bj, 2 * c, 2); m = fmaxf(m, v); }
  return window_jmin(m, 0.125f, h, qb * 128, 2 * qb + 2);
}
constexpr int NUNITS_AB = 512;
__device__ __forceinline__ void build_order(const unsigned* ns, unsigned* order, LAS unsigned char* lds, const int lane) {
  LAS int* cost = (LAS int*)lds;
  for (int u = lane; u < NUNITS_AB; u += 64) { int jm, cst;
    { const int h = u & 7, qb = u >> 3; jm = jmin_b(ns, h, qb); cst = 2 * qb + 2 - jm; }
    cost[u] = cst; cost[NUNITS_AB + u] = jm; }
  asm volatile("s_waitcnt lgkmcnt(0)" ::: "memory"); __builtin_amdgcn_wave_barrier();
  for (int u = lane; u < NUNITS_AB; u += 64) { const int cu = cost[u]; int rank = 0;
    for (int v = 0; v < NUNITS_AB; ++v) { const int cv = cost[v]; rank += (cv > cu || (cv == cu && v < u)) ? 1 : 0; }
    order[rank] = (unsigned)u | ((unsigned)cost[NUNITS_AB + u] << 16); }
}
__device__ __forceinline__ void attn_ab_phase(const Args& a, LAS unsigned char* lds, int blk, int nblk, const int wid) {
  const bf16_t* PROJ = (const bf16_t*)(a.ws + WS_PROJ); bf16_t* UA = (bf16_t*)(a.ws + WS_U); bf16_t* UB = UA + (size_t)S * 1024;
  { const unsigned long long* MASK = (const unsigned long long*)(a.ws + WS_SEL);
    for (int u = blk; u < 256; u += nblk) attn_a_unit(PROJ, MASK, UA, u & 7, 31 - (u >> 3), 0, lds, wid); }
  const unsigned* order = (const unsigned*)(a.ws + WS_CTL + 4096); unsigned* qctr = (unsigned*)(a.ws + WS_CTL + 320);
  LAS unsigned* slot = (LAS unsigned*)(lds + 147456 - 64);
  for (;;) {
    if (wid == 0) { if (lane_id_v() == 0) slot[0] = __hip_atomic_fetch_add(qctr, 1u, __ATOMIC_RELAXED, __HIP_MEMORY_SCOPE_AGENT); }
    __syncthreads();
    const unsigned i = slot[0];
    __syncthreads();
    if (i >= 512u) break;
    const unsigned e = order[i]; const int u = (int)(e & 0xffffu), jm = (int)(e >> 16);
    attn_b_unit(PROJ, UB, a.in[9], ((const float*)(a.ws + WS_CTL))[0], u & 7, u >> 3, jm, lds, wid);
  }
}
#undef KSWZ
#undef SBAR
}


namespace idx {
typedef short bf16x8 __attribute__((ext_vector_type(8)));
typedef float f32x16 __attribute__((ext_vector_type(16)));
constexpr int NUNIT = 8 * (16 * 17 / 2);
__device__ __forceinline__ void scores_phase(const bf16_t* __restrict__ PROJ, float* SC, LAS unsigned char* lds, int blk, int nblk, const int wid) {
  const int lane = lane_id_v(), tid = wid * 64 + lane, n32 = lane & 31, hi = lane >> 5;
  const int skey = tid >> 3, schunk = tid & 7;
  const int swr = skey * 128 + ((schunk ^ (skey & 7)) << 4);
  for (int u = blk; u < NUNIT; u += nblk) {
    int g = 0, rem = u; while (rem >= 8 * (g + 1)) { rem -= 8 * (g + 1); ++g; }
    const int qc = 8 * g + rem / (g + 1), kc = rem % (g + 1);
    const int q0 = 64 * qc + 8 * wid, k_begin = 512 * kc, k_end = min(512 * kc + 512, 64 * qc + 64), ntile = (k_end - k_begin) / 64;
    bf16x8 af[4][4]; float w[4][16];
    const int head = (n32 & 3) + 4 * (n32 >> 3), qbit = (n32 >> 2) & 1;
#pragma unroll
    for (int t = 0; t < 4; ++t) {
      const bf16_t* qp = PROJ + (size_t)(q0 + 2 * t + qbit) * NPAD + C_QI + head * 64 + hi * 8;
#pragma unroll
      for (int ks = 0; ks < 4; ++ks) af[t][ks] = *(const bf16x8*)(qp + ks * 16);
      const bf16_t* wp = PROJ + (size_t)(q0 + 2 * t + hi) * NPAD + C_WI;
      const u32x4 w0 = *(const u32x4*)wp, w1 = *(const u32x4*)(wp + 8);
      const unsigned ww[8] = {w0.x, w0.y, w0.z, w0.w, w1.x, w1.y, w1.z, w1.w};
#pragma unroll
      for (int i = 0; i < 8; ++i) { w[t][2 * i] = bflo(ww[i]) * 0.03125f; w[t][2 * i + 1] = bfhi(ww[i]) * 0.03125f; }
    }
    u32x4 st = *(const u32x4*)(PROJ + (size_t)(k_begin + skey) * NPAD + C_KI + schunk * 8);
    __syncthreads();
    *(LAS u32x4*)(lds + swr) = st;
    __syncthreads();
    for (int tl = 0; tl < ntile; ++tl) {
      LAS const unsigned char* kb = lds + (tl & 1) * 8192;
      if (tl + 1 < ntile) st = *(const u32x4*)(PROJ + (size_t)(k_begin + 64 * (tl + 1) + skey) * NPAD + C_KI + schunk * 8);
#pragma unroll
      for (int kh = 0; kh < 2; ++kh) {
        const int krow = kh * 32 + n32;
        bf16x8 bfr[4];
#pragma unroll
        for (int ks = 0; ks < 4; ++ks) bfr[ks] = *(LAS const bf16x8*)(kb + krow * 128 + (((2 * ks + hi) ^ (krow & 7)) << 4));
        const int s = k_begin + 64 * tl + krow;
#pragma unroll
        for (int t = 0; t < 4; ++t) {
          f32x16 acc = {};
#pragma unroll
          for (int ks = 0; ks < 4; ++ks) acc = __builtin_amdgcn_mfma_f32_32x32x16_bf16(af[t][ks], bfr[ks], acc, 0, 0, 0);
          float sc = 0.f;
#pragma unroll
          for (int r = 0; r < 16; ++r) sc = fmaf(fmaxf(acc[r], 0.f), w[t][r], sc);
          const int q = q0 + 2 * t + hi;
          if (s <= q) SC[sc_off(q) + s] = sc;
        }
      }
      if (tl + 1 < ntile) { *(LAS u32x4*)(lds + ((tl + 1) & 1) * 8192 + swr) = st; }
      __syncthreads();
    }
  }
}
}

#ifdef DBG_STAGE
__device__ __forceinline__ void dbg_dump(const Args& a, int blk, int nblk) {
    const bf16_t* PROJ = (const bf16_t*)(a.ws + WS_PROJ);
    for (size_t idx = (size_t)blk * 512 + threadIdx.x; idx < (size_t)S * DM; idx += (size_t)nblk * 512) {
        const int r = (int)(idx / DM), c = (int)(idx % DM); float v = 0.f;
#if DBG_STAGE == 1 && defined(DBG_WEIGHTS)
        for (int z = 0; z < 3; ++z) v += bf2f(((const bf16_t*)(a.ws + WS_WTBR))[((size_t)z * 2048 + (r & 2047)) * 1024 + (c & 1023)]);
        v += bf2f(((const bf16_t*)(a.ws + WS_WTOUT))[(size_t)(r & 2047) * 2048 + c]);
#elif DBG_STAGE == 1 && defined(DBG_GATES)
        for (int j = 0; j < 3; ++j) v += bf2f(PROJ[(size_t)r * NPAD + C_GL + c + 2048 * j]);
#elif DBG_STAGE == 1
        for (int j = 0; j < 8; ++j) v += bf2f(PROJ[(size_t)r * NPAD + c + 2048 * j]);
        if (c < 1280) v += bf2f(PROJ[(size_t)r * NPAD + 16384 + c]);
        if (r < 256) v += bf2f(((const bf16_t*)(a.ws + WS_MKV))[(size_t)r * 2048 + c]);
        for (int z = 0; z < 3; ++z) v += bf2f(((const bf16_t*)(a.ws + WS_WTBR))[((size_t)z * 2048 + (r & 2047)) * 1024 + (c & 1023)]);
        v += bf2f(((const bf16_t*)(a.ws + WS_WTOUT))[(size_t)(r & 2047) * 2048 + c]);
#elif DBG_STAGE == 2
        if (c < 1024) v = bf2f(((const bf16_t*)(a.ws + WS_U))[(size_t)(S + r) * 1024 + c]) + bf2f(((const bf16_t*)(a.ws + WS_U))[(size_t)(2 * S + r) * 1024 + c]);
        else { const float* row = (const float*)(a.ws + WS_SC) + sc_off(r); for (int j = c - 1024; j <= r; j += 1024) v += row[j]; }
#elif DBG_STAGE == 3
        if (c < 256) v = (float)((const int*)(a.ws + WS_SEL))[(size_t)r * 256 + c];
#elif DBG_STAGE == 4
        if (c < 1024) v = bf2f(((const bf16_t*)(a.ws + WS_U))[(size_t)r * 1024 + c]);
#elif DBG_STAGE == 5
        v = bf2f(((const bf16_t*)(a.ws + WS_MERGED))[(size_t)r * DM + c]);
#endif
        a.out[idx] = v;
    }
}
#endif

__device__ __forceinline__ void grid_bar(unsigned* cnt, unsigned target, const int wave) {
    asm volatile("s_waitcnt vmcnt(0)" ::: "memory");
    __syncthreads();
    if (wave == 0) {
        if (lane_id_v() == 0) {
            __builtin_amdgcn_fence(__ATOMIC_RELEASE, "agent");
            asm volatile("s_waitcnt vmcnt(0)" ::: "memory");
            __hip_atomic_fetch_add(cnt, 1u, __ATOMIC_RELAXED, __HIP_MEMORY_SCOPE_AGENT);
            while (__hip_atomic_load(cnt, __ATOMIC_RELAXED, __HIP_MEMORY_SCOPE_AGENT) < target) __builtin_amdgcn_s_sleep(2);
            __builtin_amdgcn_fence(__ATOMIC_ACQUIRE, "agent");
            asm volatile("s_waitcnt vmcnt(0)" ::: "memory");
        }
    }
    __syncthreads();
}

constexpr int LDS_BYTES = 147456;
constexpr int NPHASE = 8;
__global__ void __launch_bounds__(512, 2) fwd(Args a) {
    extern __shared__ __attribute__((aligned(16))) unsigned char lds_raw[];
    LAS unsigned char* lds = (LAS unsigned char*)lds_raw;
    cg::grid_group grid = cg::this_grid();
    const int blk = blockIdx.x, nblk = gridDim.x, wave = __builtin_amdgcn_readfirstlane(threadIdx.x >> 6);
    unsigned char* ws = a.ws;
    const bf16_t* PROJ = (const bf16_t*)(ws + WS_PROJ);
#define IN(k) (a.ph_lo <= (k) && (k) < a.ph_hi)
#define SEAM(k) do { if (IN(k) && IN((k) + 1)) { if ((k) == 0) grid.sync(); else grid_bar((unsigned*)(ws + WS_CTL + 256), (unsigned)nblk * (unsigned)(k), wave); } } while (0)
    if (IN(0)) { p0_prologue(a, lds, blk, nblk, wave); } SEAM(0);
    if (IN(1)) {
        pg8::Gemm g{(const bf16_t*)(ws + WS_H), (const bf16_t*)(ws + WS_WTIN), S, NPAD, DM, (long)WS_MEMN - (long)WS_H, (long)WS_WTMKV - (long)WS_WTIN};
        pg8::ProjOrder so; so.init(S, NPAD, nblk, blk);
        pg8::EpiProj E{(bf16_t*)(ws + WS_PROJ), NPAD, (bf16_t*)(ws + WS_MKV), 2048, a.in[4], C_GL / 256, (unsigned*)(ws + WS_CTL + 1024)};
        pg8::gemm_phase<pg8::EpiProj, pg8::ProjOrder, true, true>(lds, g, so, E, wave);
    } SEAM(1);
    if (IN(2)) { idx::scores_phase(PROJ, (float*)(ws + WS_SC), lds, blk, nblk, wave); __syncthreads(); att::attn_m_phase(a, lds, blk, nblk, wave); } SEAM(2);
    if (IN(3)) { if (blk == nblk - 1) { if (wave == 7) att::build_order((const unsigned*)(ws + WS_CTL + 1024), (unsigned*)(ws + WS_CTL + 4096), lds + 131072, lane_id_v()); }
                 topk_select((const float*)(ws + WS_SC), (int*)(ws + WS_SEL), lds, blk, nblk, wave); } SEAM(3);
    if (IN(4)) { att::attn_ab_phase(a, lds, blk, nblk, wave); } SEAM(4);
    if (IN(5)) {
        pg8::Gemm g{(const bf16_t*)(ws + WS_U), (const bf16_t*)(ws + WS_WTBR), S, DM, 1024, (long)S * 1024 * 2, (long)2048 * 1024 * 2};
        pg8::MergeOrder so; so.init(S, DM, nblk, blk);
        pg8::EpiMerge E{PROJ + C_GL, NPAD, (float*)(ws + WS_T), (bf16_t*)(ws + WS_MERGED), DM};
        pg8::gemm_phase<pg8::EpiMerge, pg8::MergeOrder, true, true>(lds, g, so, E, wave);
    } SEAM(5);
    if (IN(6)) {
        pg8::Gemm g{(const bf16_t*)(ws + WS_MERGED), (const bf16_t*)(ws + WS_WTOUT), S, DM, DM, 0, 0};
        pg8::StaticOrder so; so.init(S, DM, nblk, blk);
        pg8::EpiOut E{a.in[0], a.out, DM, (float*)(ws + WS_PART), S};
        pg8::gemm_phase<pg8::EpiOut, pg8::StaticOrder, false, true>(lds, g, so, E, wave);
    } SEAM(6);
    if (IN(7)) { final_norm(a, blk, nblk, wave); }
#ifdef DBG_STAGE
    if (IN(8)) { dbg_dump(a, blk, nblk); }
#endif
#undef IN
#undef SEAM
}

#ifndef N_LAUNCH_MODE
#define N_LAUNCH_MODE 0
#endif
extern "C" void kernel_launch(void* const* d_in, const int* in_sizes, int n_in, void* d_out, int out_size, void* d_ws, size_t ws_size, hipStream_t stream) {
    static int grid = 0;
    if (grid == 0) {
        if (n_in != 17 || in_sizes[0] != S * DM || in_sizes[3] != DM * DIN || out_size != S * DM || ws_size < WS_END) {
            fprintf(stderr, "kernel_launch: unexpected shapes (n_in %d, in0 %d, in3 %d, out %d, ws %zu < %zu)\n", n_in, n_in > 0 ? in_sizes[0] : -1, n_in > 3 ? in_sizes[3] : -1, out_size, ws_size, (size_t)WS_END); grid = -1; return; }
        int dev = 0, cus = 0, per_cu = 0;
        (void)hipGetDevice(&dev); (void)hipDeviceGetAttribute(&cus, hipDeviceAttributeMultiprocessorCount, dev);
        if (hipFuncSetAttribute((const void*)fwd, hipFuncAttributeMaxDynamicSharedMemorySize, LDS_BYTES) != hipSuccess) { fprintf(stderr, "kernel_launch: hipFuncSetAttribute failed\n"); grid = -1; return; }
        if (hipOccupancyMaxActiveBlocksPerMultiprocessor(&per_cu, (const void*)fwd, 512, LDS_BYTES) != hipSuccess || per_cu < 1) { fprintf(stderr, "kernel_launch: occupancy query gave %d\n", per_cu); per_cu = 1; }
        (void)hipGetLastError();
        grid = cus * 1;
        if (grid > cus * per_cu) grid = cus * per_cu;
        if (grid < 8) grid = -1;
    }
    if (grid < 0) return;
    Args a{};
    for (int i = 0; i < 17; ++i) a.in[i] = (const float*)d_in[i];
    a.out = (float*)d_out; a.ws = (unsigned char*)d_ws;
#if N_LAUNCH_MODE == 1
    (void)hipMemsetAsync((unsigned char*)d_ws + WS_CTL + 256, 0, 256, stream);
    a.ph_lo = 0; a.ph_hi = NPHASE;
    void* kargs[] = {&a};
    hipError_t e = hipLaunchCooperativeKernel((const void*)fwd, dim3(grid), dim3(512), kargs, LDS_BYTES, stream);
    if (e != hipSuccess) fprintf(stderr, "cooperative launch failed: %s (grid %d)\n", hipGetErrorString(e), grid);
#else
#ifdef DBG_STAGE
    #ifdef DBG_WEIGHTS
    constexpr int last_ph[6] = {0, 0, 2, 3, 4, 5};
#else
    constexpr int last_ph[6] = {0, 1, 2, 3, 4, 5};
#endif
    for (int p = 0; p <= last_ph[DBG_STAGE]; ++p) { a.ph_lo = p; a.ph_hi = p + 1; hipLaunchKernelGGL(fwd, dim3(grid), dim3(512), LDS_BYTES, stream, a); }
    a.ph_lo = 8; a.ph_hi = 9; hipLaunchKernelGGL(fwd, dim3(grid), dim3(512), LDS_BYTES, stream, a);
#else
    for (int p = 0; p < NPHASE; ++p) {
        a.ph_lo = p; a.ph_hi = p + 1;
        hipLaunchKernelGGL(fwd, dim3(grid), dim3(512), LDS_BYTES, stream, a);
    }
#endif
#endif
}
```

```cpp
#define N_LAUNCH_MODE 1
#include <hip/hip_runtime.h>
#include <hip/hip_cooperative_groups.h>
#include <cstdio>
#include <cstdint>
namespace cg = cooperative_groups;

__device__ __forceinline__ int lane_id_v() { int l; asm volatile("v_mbcnt_lo_u32_b32 %0, -1, 0\n\tv_mbcnt_hi_u32_b32 %0, -1, %0" : "=v"(l)); return l; }
namespace pg8 {
#define PG8_LAS __attribute__((address_space(3)))
typedef unsigned short bf16_t;
typedef short bf16x8 __attribute__((ext_vector_type(8)));
typedef float f32x4 __attribute__((ext_vector_type(4)));
typedef unsigned u32x4 __attribute__((ext_vector_type(4)));
constexpr int BM = 256, BK = 64, HALF = 128, HTB = HALF * BK * 2  , STAGE_BYTES = 8 * HTB, NXCD = 8, WGM = 8;

__host__ __device__ __forceinline__ int lds_byte(int r, int c) { const int st = (r >> 4) * 2 + (c >> 5), rr = r & 15, cc = c & 31, ob = rr * 64 + cc * 2; return st * 1024 + (ob ^ (((ob >> 9) & 1) << 5)); }
__host__ __device__ __forceinline__ void stage_rc(int b, int& R, int& C) { const int st = b / 1024, sb = b % 1024, swz = sb ^ (((sb >> 9) & 1) << 5); R = (st >> 1) * 16 + swz / 64; C = (st & 1) * 32 + (swz % 64) / 2; }
__host__ __device__ __forceinline__ int perm32(int rho) { const int n = rho >> 4, i = rho & 15; return 8 * (i >> 2) + 4 * n + (i & 3); }

struct Unit { int pm, pn, z; };
struct Gemm { const bf16_t* A; const bf16_t* Bt; int M, N, K; long zA, zB; };

struct StaticOrder {
    int nM, nN, nwg, G, c;
    __host__ __device__ void init(int M, int N, int G_, int c_) { nM = M / BM; nN = N / BM; nwg = nM * nN; G = G_; c = c_; }
    __host__ __device__ bool next(int i, Unit& u) const {
        const long L = (long)i * G + c; if (L >= nwg) return false;
        int wgid = (int)L; { const int q = nwg / NXCD, r = nwg % NXCD, xcd = wgid % NXCD, off = wgid / NXCD; wgid = (xcd < r ? xcd * (q + 1) : r * (q + 1) + (xcd - r) * q) + off; }
        const int nig = WGM * nN, gid = wgid / nig, fm = gid * WGM, gsz = (nM - fm) < WGM ? (nM - fm) : WGM;
        u.pm = fm + ((wgid % nig) % gsz); u.pn = (wgid % nig) / gsz; u.z = 0; return true;
    }
    __device__ __forceinline__ void a_ready(const Unit&) const {}
    __device__ __forceinline__ void done(const Unit&) const {}
};

typedef float f32x2_t __attribute__((ext_vector_type(2))); typedef __bf16 bf16x2_t __attribute__((ext_vector_type(2)));
__device__ __forceinline__ unsigned cvt_pk_bf16(float lo, float hi) { f32x2_t v = {lo, hi}; bf16x2_t b = __builtin_convertvector(v, bf16x2_t); return __builtin_bit_cast(unsigned, b); }

__device__ __forceinline__ float bf2f(unsigned short u) { return __uint_as_float((unsigned)u << 16); }
__device__ __forceinline__ float sigmoidf_(float v) { return __builtin_amdgcn_rcpf(1.0f + __builtin_amdgcn_exp2f(-1.4426950408889634f * v)); }
template <int MODE> __device__ __forceinline__ float act_(float v, float b) {
    if (MODE == 1) return v * sigmoidf_(v);
    if (MODE == 2) return sigmoidf_(v + b);
    return v;
}
struct EpiProj {
    static constexpr bool PERM = true, AFTER_DRAIN = false;
    bf16_t* O; int ldc; bf16_t* O1; int ldc1; const float* bgate; int gate_tile0;
    unsigned* nslot;
    __device__ __forceinline__ void norms(const f32x4 (&acc)[2][2][4][2], const Unit& u, int wc, int lane) const {
        float wm[2] = {0.f, 0.f};
#pragma unroll
        for (int ai = 0; ai < 2; ++ai)
#pragma unroll
            for (int m = 0; m < 4; ++m)
#pragma unroll
                for (int bj = 0; bj < 2; ++bj) { const f32x4 a = acc[ai][bj][m][0], c = acc[ai][bj][m][1];
                    float s = (a[0] * a[0] + a[1] * a[1]) + (a[2] * a[2] + a[3] * a[3]) + (c[0] * c[0] + c[1] * c[1]) + (c[2] * c[2] + c[3] * c[3]);
                    s += __shfl_xor(s, 16); s += __shfl_xor(s, 32); wm[bj] = fmaxf(wm[bj], s); }
#pragma unroll
        for (int bj = 0; bj < 2; ++bj) { float v = wm[bj]; v = fmaxf(v, __shfl_xor(v, 1)); v = fmaxf(v, __shfl_xor(v, 2)); v = fmaxf(v, __shfl_xor(v, 4)); v = fmaxf(v, __shfl_xor(v, 8));
            if (lane == 0) atomicMax(nslot + (u.pn * 2 + bj) * 4 + wc, __float_as_uint(v)); }
    }
    template <int MODE> __device__ __forceinline__ void put(const f32x4 (&acc)[2][2][4][2], bf16_t* base, int ld, int row0, int col0, const float* bias) const {
        f32x4 bv[2][2];
#pragma unroll
        for (int bj = 0; bj < 2; ++bj)
#pragma unroll
            for (int n = 0; n < 2; ++n) bv[bj][n] = (MODE == 2) ? *(const f32x4*)(bias + bj * HALF + 4 * n) : (f32x4){0.f, 0.f, 0.f, 0.f};
#pragma unroll
        for (int ai = 0; ai < 2; ++ai)
#pragma unroll
            for (int m = 0; m < 4; ++m) { bf16_t* rowp = base + (size_t)(row0 + ai * HALF + m * 16) * ld + col0;
#pragma unroll
                for (int bj = 0; bj < 2; ++bj) { f32x4 v0 = acc[ai][bj][m][0], v1 = acc[ai][bj][m][1];
#pragma unroll
                    for (int e = 0; e < 4; ++e) { v0[e] = act_<MODE>(v0[e], bv[bj][0][e]); v1[e] = act_<MODE>(v1[e], bv[bj][1][e]); }
                    u32x4 w; w.x = cvt_pk_bf16(v0[0], v0[1]); w.y = cvt_pk_bf16(v0[2], v0[3]); w.z = cvt_pk_bf16(v1[0], v1[1]); w.w = cvt_pk_bf16(v1[2], v1[3]);
                    *(u32x4*)(rowp + bj * HALF) = w; } }
    }
    __device__ __forceinline__ void operator()(const f32x4 (&acc)[2][2][4][2], const Unit& u, int wr, int wc, int fr, int fq) const {
        const int row0 = u.pm * BM + wr * 64 + fr, col0 = u.pn * BM + wc * 32 + 8 * fq;
        if (u.z == 1) { put<0>(acc, O1, ldc1, row0, col0, nullptr); return; }
        const int t = u.pn;
        if (t < 8 || (t >= 20 && t < 28)) norms(acc, u, wc, fr + 16 * fq);
        const bool is_silu = (t >= 12 && t < 16) || (t >= 32 && t < 36) || (t >= 40 && t < 44);
        if (t >= gate_tile0 && t < 68) put<2>(acc, O, ldc, row0, col0, bgate + (col0 - gate_tile0 * BM));
        else if (is_silu) put<1>(acc, O, ldc, row0, col0, nullptr);
        else put<0>(acc, O, ldc, row0, col0, nullptr);
    }
};
struct EpiMerge {
    static constexpr bool PERM = true, AFTER_DRAIN = false;
    const bf16_t* G; int ldg;
    float* T; bf16_t* O; int ldc;
    __device__ __forceinline__ void operator()(const f32x4 (&acc)[2][2][4][2], const Unit& u, int wr, int wc, int fr, int fq) const {
        const int row0 = u.pm * BM + wr * 64 + fr, col0 = u.pn * BM + wc * 32 + 8 * fq;
#pragma unroll
        for (int ai = 0; ai < 2; ++ai)
#pragma unroll
            for (int m = 0; m < 4; ++m) { const size_t row = (size_t)(row0 + ai * HALF + m * 16);
#pragma unroll
                for (int bj = 0; bj < 2; ++bj) { const int col = col0 + bj * HALF;
                    const u32x4 gw = *(const u32x4*)(G + row * ldg + (size_t)u.z * 2048 + col);
                    f32x4 g0, g1;
                    g0[0] = __uint_as_float(gw.x << 16); g0[1] = __uint_as_float(gw.x & 0xffff0000u); g0[2] = __uint_as_float(gw.y << 16); g0[3] = __uint_as_float(gw.y & 0xffff0000u);
                    g1[0] = __uint_as_float(gw.z << 16); g1[1] = __uint_as_float(gw.z & 0xffff0000u); g1[2] = __uint_as_float(gw.w << 16); g1[3] = __uint_as_float(gw.w & 0xffff0000u);
                    f32x4 v0 = acc[ai][bj][m][0] * g0, v1 = acc[ai][bj][m][1] * g1;
                    float* tp = T + row * ldc + col;
                    if (u.z > 0) { v0 += __builtin_nontemporal_load((const f32x4*)tp); v1 += __builtin_nontemporal_load((const f32x4*)(tp + 4)); }
                    if (u.z < 2) { *(f32x4*)tp = v0; *(f32x4*)(tp + 4) = v1; }
                    else { u32x4 w; w.x = cvt_pk_bf16(v0[0], v0[1]); w.y = cvt_pk_bf16(v0[2], v0[3]); w.z = cvt_pk_bf16(v1[0], v1[1]); w.w = cvt_pk_bf16(v1[2], v1[3]);
                        *(u32x4*)(O + row * ldc + col) = w; } } }
    }
};
struct EpiOut {
    static constexpr bool PERM = false, AFTER_DRAIN = false;
    const float* X; float* Y; int ldc; float* part; int M;
    __device__ __forceinline__ void operator()(const f32x4 (&acc)[2][2][4][2], const Unit& u, int wr, int wc, int fr, int fq) const {
        const int row0 = u.pm * BM + wr * 64 + fr, col0 = u.pn * BM + wc * 32 + 4 * fq;
#pragma unroll
        for (int ai = 0; ai < 2; ++ai)
#pragma unroll
            for (int m = 0; m < 4; ++m) { const size_t row = (size_t)(row0 + ai * HALF + m * 16); float ss = 0.f;
#pragma unroll
                for (int bj = 0; bj < 2; ++bj)
#pragma unroll
                    for (int n = 0; n < 2; ++n) { const size_t off = row * ldc + col0 + bj * HALF + n * 16;
                        const f32x4 y = *(const f32x4*)(X + off) + acc[ai][bj][m][n]; *(f32x4*)(Y + off) = y;
                        ss += (y[0] * y[0] + y[1] * y[1]) + (y[2] * y[2] + y[3] * y[3]); }
                ss += __shfl_xor(ss, 16); ss += __shfl_xor(ss, 32);
                if (fq == 0) part[(size_t)(u.pn * 4 + wc) * M + row] = ss; }
    }
};
struct ProjOrder {
    StaticOrder so; int nmain, extra;
    __device__ void init(int M, int N, int G, int c) { so.init(M, N, G, c); nmain = (so.nwg - c + G - 1) / G; extra = (c >= G - 8) ? c - (G - 8) : -1; }
    __device__ bool next(int i, Unit& u) const {
        if (i < nmain) return so.next(i, u);
        if (i == nmain && extra >= 0) { u.pm = 0; u.pn = extra; u.z = 1; return true; }
        return false;
    }
    __device__ __forceinline__ void a_ready(const Unit&) const {}
    __device__ __forceinline__ void done(const Unit&) const {}
};
struct MergeOrder {
    StaticOrder so;
    __device__ void init(int M, int N, int G, int c) { so.init(M, N, G, c); }
    __device__ bool next(int i, Unit& u) const { if (i >= 3) return false; if (!so.next(0, u)) return false; u.z = i; return true; }
    __device__ __forceinline__ void a_ready(const Unit&) const {}
    __device__ __forceinline__ void done(const Unit&) const {}
};

template <class Epi, class Sched, bool ALIGN_EPI = false, bool SP2 = false>
__device__ __forceinline__ void gemm_phase(PG8_LAS unsigned char* lds, const Gemm g, const Sched& S, const Epi& E, const int wid  ) {
    const int lane = lane_id_v(), tid = wid * 64 + lane, wr = wid >> 2, wc = wid & 3, fr = lane & 15, fq = lane >> 4;
    const int K = g.K, nt = K / BK;
    unsigned voffA[2], voffB[2];
#pragma unroll
    for (int i = 0; i < 2; ++i) { int R, C; stage_rc(tid * 16 + i * 8192, R, C); const int Rb = Epi::PERM ? ((R & ~31) + perm32(R & 31)) : R;
        voffA[i] = (unsigned)(R * K + C) * 2u; voffB[i] = (unsigned)(Rb * K + C) * 2u; }
    const size_t kstep = (size_t)(BK * 2);
    const size_t hstep = (size_t)HALF * K * 2;
    const size_t tstep = 2 * hstep;
    const unsigned ldsw = (unsigned)wid * 1024u;
    const int aoff = lds_byte(wr * 64 + fr, fq * 8), boff = lds_byte(wc * 32 + fr, fq * 8);
#define PG8_SA(b, h) (((b) * 2 + (h)) * HTB)
#define PG8_SB(b, h) ((4 + (b) * 2 + (h)) * HTB)
#define PG8_STAGE(bufoff, gbase, voff) do { _Pragma("unroll") for (int _i = 0; _i < 2; ++_i) \
        __builtin_amdgcn_global_load_lds((const unsigned*)((const char*)(gbase) + (voff)[_i]), (PG8_LAS unsigned*)(lds + (bufoff) + ldsw + _i * 8192), 16, 0, 0); } while (0)
#define PG8_LDA(dst, b, h) do { _Pragma("unroll") for (int m = 0; m < 4; ++m) _Pragma("unroll") for (int k = 0; k < 2; ++k) dst[m][k] = *(const PG8_LAS bf16x8*)(lds + PG8_SA(b, h) + aoff + m * 2048 + k * 1024); } while (0)
#define PG8_LDB(dst, b, h) do { _Pragma("unroll") for (int n = 0; n < 2; ++n) _Pragma("unroll") for (int k = 0; k < 2; ++k) dst[n][k] = *(const PG8_LAS bf16x8*)(lds + PG8_SB(b, h) + boff + n * 2048 + k * 1024); } while (0)
#define PG8_MMA(ai, bj, At, Bt) do { __builtin_amdgcn_s_setprio(1); _Pragma("unroll") for (int m = 0; m < 4; ++m) _Pragma("unroll") for (int n = 0; n < 2; ++n) _Pragma("unroll") for (int k = 0; k < 2; ++k) \
        acc[ai][bj][m][n] = __builtin_amdgcn_mfma_f32_16x16x32_bf16(Bt[n][k], At[m][k], acc[ai][bj][m][n], 0, 0, 0); __builtin_amdgcn_s_setprio(0); } while (0)
#define PG8_WAIT_V(n) asm volatile("s_waitcnt vmcnt(" #n ")" ::: "memory")
#define PG8_WAIT_L(n) asm volatile("s_waitcnt lgkmcnt(" #n ")" ::: "memory")
#define PG8_BAR __builtin_amdgcn_s_barrier()
#define PG8_SCHED __builtin_amdgcn_sched_barrier(0)
    Unit cur, nxt; int ui = 0;
    if (!S.next(0, cur)) return;
    f32x4 acc[2][2][4][2];
#pragma unroll
    for (int a = 0; a < 2; ++a)
#pragma unroll
        for (int b = 0; b < 2; ++b)
#pragma unroll
            for (int m = 0; m < 4; ++m)
#pragma unroll
                for (int n = 0; n < 2; ++n) acc[a][b][m][n] = (f32x4){0.f, 0.f, 0.f, 0.f};
    bf16x8 At[4][2], B0[2][2], B1[2][2];
    const char* cA = (const char*)g.A + (long)cur.z * g.zA + (size_t)cur.pm * tstep; const char* cB = (const char*)g.Bt + (long)cur.z * g.zB + (size_t)cur.pn * tstep;
    S.a_ready(cur);
    if constexpr (SP2) {
        PG8_STAGE(PG8_SB(0, 0), cB, voffB); PG8_STAGE(PG8_SB(0, 1), cB + hstep, voffB); PG8_STAGE(PG8_SA(0, 0), cA, voffA); PG8_STAGE(PG8_SA(0, 1), cA + hstep, voffA);
        if (wr == 1) PG8_BAR;
        PG8_WAIT_V(2); PG8_BAR;
        PG8_STAGE(PG8_SB(1, 0), cB + kstep, voffB); PG8_STAGE(PG8_SA(1, 0), cA + kstep, voffA); PG8_STAGE(PG8_SB(1, 1), cB + hstep + kstep, voffB);
        PG8_WAIT_V(6); PG8_BAR;
    } else {
        PG8_STAGE(PG8_SB(0, 0), cB, voffB); PG8_STAGE(PG8_SA(0, 0), cA, voffA); PG8_STAGE(PG8_SB(0, 1), cB + hstep, voffB); PG8_STAGE(PG8_SA(0, 1), cA + hstep, voffA);
        if (wr == 1) PG8_BAR;
        PG8_WAIT_V(4); PG8_BAR;
        PG8_STAGE(PG8_SB(1, 0), cB + kstep, voffB); PG8_STAGE(PG8_SA(1, 0), cA + kstep, voffA); PG8_STAGE(PG8_SB(1, 1), cB + hstep + kstep, voffB);
        PG8_WAIT_V(6); PG8_BAR;
    }
    for (;;) {
        const bool has_next = S.next(ui + 1, nxt);
        const char* nA = has_next ? (const char*)g.A + (long)nxt.z * g.zA + (size_t)nxt.pm * tstep : cA; const char* nB = has_next ? (const char*)g.Bt + (long)nxt.z * g.zB + (size_t)nxt.pn * tstep : cB;
        for (int t = 0; t < nt; t += 2) {
            const bool last = (t == nt - 2);
            const char* a1 = cA + (size_t)(t + 1) * kstep;
            const char* a2 = last ? nA : cA + (size_t)(t + 2) * kstep; const char* b2 = last ? nB : cB + (size_t)(t + 2) * kstep;
            const char* a3 = a2 + kstep; const char* b3 = b2 + kstep;
            if (last && has_next) S.a_ready(nxt);
            if constexpr (SP2) {
            PG8_LDB(B0, 0, 0); PG8_LDB(B1, 0, 1); PG8_SCHED; PG8_LDA(At, 0, 0); PG8_STAGE(PG8_SA(1, 1), a1 + hstep, voffA);
            PG8_WAIT_V(8); PG8_WAIT_L(0); PG8_BAR; PG8_MMA(0, 0, At, B0); PG8_MMA(0, 1, At, B1); PG8_BAR; PG8_SCHED;
            PG8_LDA(At, 0, 1); PG8_STAGE(PG8_SB(0, 0), b2, voffB); PG8_STAGE(PG8_SB(0, 1), b2 + hstep, voffB); PG8_STAGE(PG8_SA(0, 0), a2, voffA);
            PG8_WAIT_V(8); PG8_WAIT_L(0); PG8_BAR; PG8_MMA(1, 0, At, B0); PG8_MMA(1, 1, At, B1); PG8_BAR; PG8_SCHED;
            PG8_LDB(B0, 1, 0); PG8_LDB(B1, 1, 1); PG8_SCHED; PG8_LDA(At, 1, 0); PG8_STAGE(PG8_SA(0, 1), a2 + hstep, voffA);
            PG8_WAIT_V(8); PG8_WAIT_L(0); PG8_BAR; PG8_MMA(0, 0, At, B0); PG8_MMA(0, 1, At, B1); PG8_BAR; PG8_SCHED;
            PG8_LDA(At, 1, 1); PG8_STAGE(PG8_SB(1, 0), b3, voffB); PG8_STAGE(PG8_SB(1, 1), b3 + hstep, voffB); PG8_STAGE(PG8_SA(1, 0), a3, voffA);
            PG8_WAIT_V(8); PG8_WAIT_L(0); PG8_BAR; PG8_MMA(1, 0, At, B0); PG8_MMA(1, 1, At, B1); PG8_BAR; PG8_SCHED;
            } else {
            PG8_LDB(B0, 0, 0); PG8_SCHED; PG8_LDA(At, 0, 0); PG8_STAGE(PG8_SA(1, 1), a1 + hstep, voffA);
            PG8_WAIT_L(8); PG8_BAR; PG8_WAIT_L(0); PG8_MMA(0, 0, At, B0); PG8_BAR; PG8_SCHED;
            PG8_LDB(B1, 0, 1); PG8_STAGE(PG8_SB(0, 0), b2, voffB);
            PG8_BAR; PG8_WAIT_L(0); PG8_MMA(0, 1, At, B1); PG8_BAR;
            PG8_LDA(At, 0, 1); PG8_STAGE(PG8_SA(0, 0), a2, voffA);
            PG8_BAR; PG8_WAIT_L(0); PG8_MMA(1, 0, At, B0); PG8_BAR; PG8_SCHED;
            PG8_STAGE(PG8_SB(0, 1), b2 + hstep, voffB);
            PG8_WAIT_V(6); PG8_BAR; PG8_MMA(1, 1, At, B1); PG8_BAR;
            PG8_LDB(B0, 1, 0); PG8_SCHED; PG8_LDA(At, 1, 0); PG8_STAGE(PG8_SA(0, 1), a2 + hstep, voffA);
            PG8_WAIT_L(8); PG8_BAR; PG8_WAIT_L(0); PG8_MMA(0, 0, At, B0); PG8_BAR; PG8_SCHED;
            PG8_LDB(B1, 1, 1); PG8_STAGE(PG8_SB(1, 0), b3, voffB);
            PG8_BAR; PG8_WAIT_L(0); PG8_MMA(0, 1, At, B1); PG8_BAR;
            PG8_LDA(At, 1, 1); PG8_STAGE(PG8_SA(1, 0), a3, voffA);
            PG8_BAR; PG8_WAIT_L(0); PG8_MMA(1, 0, At, B0); PG8_BAR; PG8_SCHED;
            PG8_STAGE(PG8_SB(1, 1), b3 + hstep, voffB);
            PG8_WAIT_V(6); PG8_BAR; PG8_MMA(1, 1, At, B1); PG8_BAR;
            }
        }
        if constexpr (ALIGN_EPI) { if (wr == 0) PG8_BAR; }
        if constexpr (!Epi::AFTER_DRAIN) { E(acc, cur, wr, wc, fr, fq); S.done(cur); }
        if (!has_next) break;
#pragma unroll
        for (int a = 0; a < 2; ++a)
#pragma unroll
            for (int b = 0; b < 2; ++b)
#pragma unroll
                for (int m = 0; m < 4; ++m)
#pragma unroll
                    for (int n = 0; n < 2; ++n) acc[a][b][m][n] = (f32x4){0.f, 0.f, 0.f, 0.f};
        cur = nxt; cA = nA; cB = nB; ++ui;
        if constexpr (ALIGN_EPI) { if (wr == 1) PG8_BAR; }
    }
    PG8_WAIT_V(0);
    if constexpr (!ALIGN_EPI) { if (wr == 0) PG8_BAR; }
    PG8_BAR;
    if constexpr (Epi::AFTER_DRAIN) { E.fused(acc, cur, wr, wc, fr, fq, lds, wid, lane); S.done(cur); }
#undef PG8_SA
#undef PG8_SB
#undef PG8_STAGE
#undef PG8_LDA
#undef PG8_LDB
#undef PG8_MMA
#undef PG8_WAIT_V
#undef PG8_WAIT_L
#undef PG8_BAR
#undef PG8_SCHED
}
}

constexpr int S = 8192, DM = 2048, DIN = 17488, NPAD = 17664, NMEM = 256;
constexpr int C_QA = 0, C_KA = 1024, C_VA = 2048, C_ZA = 3072, C_QI = 4096, C_QB = 5120, C_KB = 6144, C_VB = 7168, C_ZB = 8192, C_QM = 9216, C_ZM = 10240, C_GL = 11264, C_KI = 17408, C_WI = 17472;
constexpr int TOPK = 256;
constexpr float RMS_EPS = 1e-6f;
constexpr size_t MiB = 1u << 20;
constexpr size_t WS_CTL = 0;
constexpr size_t WS_WTIN = 1 * MiB;
constexpr size_t WS_U = 1 * MiB;
constexpr size_t WS_WTMKV = 70 * MiB;
constexpr size_t WS_WTBR = 78 * MiB;
constexpr size_t WS_WTOUT = 90 * MiB;
constexpr size_t WS_MEMN = 98 * MiB;
constexpr size_t WS_MKV = 99 * MiB;
constexpr size_t WS_PROJ = 100 * MiB;
constexpr size_t WS_SC = 376 * MiB;
constexpr size_t WS_MERGED = 376 * MiB;
constexpr size_t WS_H = 376 * MiB;
constexpr size_t WS_T = 408 * MiB;
constexpr size_t WS_SEL = 508 * MiB;
constexpr size_t WS_PART = 516 * MiB;
constexpr size_t WS_END = 517 * MiB;

typedef unsigned short bf16_t;
typedef unsigned u32x4 __attribute__((ext_vector_type(4)));
typedef unsigned u32x2 __attribute__((ext_vector_type(2)));
typedef float f32x4 __attribute__((ext_vector_type(4)));
#define LAS __attribute__((address_space(3)))
__device__ __forceinline__ float bf2f(unsigned short u) { return __uint_as_float((unsigned)u << 16); }
__device__ __forceinline__ float bflo(unsigned w) { return __uint_as_float(w << 16); }
__device__ __forceinline__ float bfhi(unsigned w) { return __uint_as_float(w & 0xffff0000u); }
__device__ __forceinline__ unsigned f2bf(float f) { unsigned u = __float_as_uint(f); return (u + 0x7fffu + ((u >> 16) & 1u)) >> 16; }
__device__ __forceinline__ unsigned pk2(float lo, float hi) { return f2bf(lo) | (f2bf(hi) << 16); }
__device__ __forceinline__ float wave_sum(float v) {
#pragma unroll
    for (int o = 1; o < 64; o <<= 1) v += __shfl_xor(v, o);
    return v;
}
__device__ __forceinline__ size_t sc_off(int r) { const size_t i = (size_t)(r >> 8); return 65536ull * (i * (i + 1) / 2) + (size_t)(r & 255) * 256ull * (i + 1); }

struct Args { const float* in[17]; float* out; unsigned char* ws; int ph_lo, ph_hi; };

template <bool MAPIN>
__device__ __forceinline__ void transpose_item(const float* __restrict__ W, int K, int srcN, bf16_t* WT, LAS float* scr, int item, int ndst, int lane) {
    const int nblk = ndst / 32, kb = item / nblk, nb = item % nblk, k0 = 64 * kb, n0 = 32 * nb;
    const int n = n0 + (lane & 31);
    int src = n;
    if (MAPIN) { src = (n < 5120) ? n : (n < 17408) ? n + 80 : (n < 17488) ? n - 17408 + 5120 : -1; }
    float tv[32];
#pragma unroll
    for (int i = 0; i < 32; ++i) { const int kk = 2 * i + (lane >> 5); tv[i] = (src >= 0) ? W[(size_t)(k0 + kk) * srcN + src] : 0.f; }
#pragma unroll
    for (int i = 0; i < 32; ++i) { const int kk = 2 * i + (lane >> 5); scr[kk * 33 + (lane & 31)] = tv[i]; }
    asm volatile("s_waitcnt lgkmcnt(0)" ::: "memory");
    const int c = lane & 7;
#pragma unroll
    for (int j = 0; j < 4; ++j) { const int nn = (lane >> 3) + 8 * j; const LAS float* s = scr + (8 * c) * 33 + nn;
        u32x4 o; o.x = pk2(s[0 * 33], s[1 * 33]); o.y = pk2(s[2 * 33], s[3 * 33]); o.z = pk2(s[4 * 33], s[5 * 33]); o.w = pk2(s[6 * 33], s[7 * 33]);
        *(u32x4*)(WT + (size_t)(n0 + nn) * K + k0 + 8 * c) = o; }
    asm volatile("s_waitcnt lgkmcnt(0)" ::: "memory");
}
__device__ __forceinline__ void rms_row_to_bf16(const float* __restrict__ xrow, const float* __restrict__ g, bf16_t* orow, int lane) {
    const f32x4* xr = (const f32x4*)xrow + lane; const f32x4* gr = (const f32x4*)g + lane;
    f32x4 v[8]; float s = 0.f;
#pragma unroll
    for (int j = 0; j < 8; ++j) { v[j] = xr[64 * j]; s += (v[j].x * v[j].x + v[j].y * v[j].y) + (v[j].z * v[j].z + v[j].w * v[j].w); }
    const float rs = 1.0f / sqrtf(wave_sum(s) * (1.f / DM) + RMS_EPS);
    u32x2* o8 = (u32x2*)orow + lane;
#pragma unroll
    for (int j = 0; j < 8; ++j) { const f32x4 gg = gr[64 * j]; u32x2 w; w.x = pk2(v[j].x * rs * gg.x, v[j].y * rs * gg.y); w.y = pk2(v[j].z * rs * gg.z, v[j].w * rs * gg.w); o8[64 * j] = w; }
}
__device__ __forceinline__ void p0_prologue(const Args& a, LAS unsigned char* lds, int blk, int nblk, const int wave) {
    const int lane = lane_id_v(), tid = wave * 64 + lane;
    LAS float* scr = (LAS float*)(lds + wave * 16384);
    const int gw = blk * 8 + wave, NGW = nblk * 8;
    unsigned char* ws = a.ws;
    constexpr int I_IN = (DM / 64) * (NPAD / 32), I_MKV = (DM / 64) * (2048 / 32), I_BR = (1024 / 64) * (2048 / 32), I_OUT = (DM / 64) * (2048 / 32);
    constexpr int NITEMS = I_IN + I_MKV + 3 * I_BR + I_OUT;
    for (int it = gw; it < NITEMS; it += NGW) {
        int r = it;
        if (r < I_IN) { transpose_item<true>(a.in[3], DM, DIN, (bf16_t*)(ws + WS_WTIN), scr, r, NPAD, lane); continue; } r -= I_IN;
        if (r < I_MKV) { transpose_item<false>(a.in[11], DM, 2048, (bf16_t*)(ws + WS_WTMKV), scr, r, 2048, lane); continue; } r -= I_MKV;
        if (r < 3 * I_BR) { const int z = r / I_BR; transpose_item<false>(a.in[12 + z], 1024, 2048, (bf16_t*)(ws + WS_WTBR) + (size_t)z * 2048 * 1024, scr, r % I_BR, 2048, lane); continue; } r -= 3 * I_BR;
        transpose_item<false>(a.in[15], DM, 2048, (bf16_t*)(ws + WS_WTOUT), scr, r, 2048, lane);
    }
    bf16_t* H = (bf16_t*)(ws + WS_H);
    for (int m = gw; m < S + NMEM; m += NGW) {
        if (m < S) rms_row_to_bf16(a.in[0] + (size_t)m * DM, a.in[2], H + (size_t)m * DM, lane);
        else rms_row_to_bf16(a.in[1] + (size_t)(m - S) * DM, a.in[10], (bf16_t*)(ws + WS_MEMN) + (size_t)(m - S) * DM, lane);
    }
    if (blk == 0) { for (int i = tid; i < 640; i += 512) ((unsigned*)(ws + WS_CTL + 1024))[i] = 0u; }
    if (blk == 0 && wave == 0) {
        const float s1 = wave_sum(a.in[5][lane] * a.in[6][lane]), s2 = wave_sum(a.in[7][lane] * a.in[8][lane]);
        if (lane == 0) ((float*)(ws + WS_CTL))[0] = expf(s1) - expf(s2) + 0.2f;
    }
}

__device__ __forceinline__ void idx_scores_naive(const bf16_t* __restrict__ PROJ, float* SC, LAS unsigned char* lds, int blk, int nblk, const int wave) {
    const int lane = lane_id_v(), tid = wave * 64 + lane;
    LAS float* qs = (LAS float*)lds + wave * 1088;
    constexpr int NITEM = 128 * 129 / 2;
    for (int it = blk; it < NITEM; it += nblk) {
        int kb = 0, rem = it; while (rem >= 128 - kb) { rem -= 128 - kb; ++kb; }
        const int qc = kb + rem, s = 64 * kb + lane;
        float kreg[64];
        { const u32x4* kp = (const u32x4*)(PROJ + (size_t)s * NPAD + C_KI);
#pragma unroll
          for (int i = 0; i < 8; ++i) { const u32x4 w = kp[i]; kreg[8 * i + 0] = bflo(w.x); kreg[8 * i + 1] = bfhi(w.x); kreg[8 * i + 2] = bflo(w.y); kreg[8 * i + 3] = bfhi(w.y);
              kreg[8 * i + 4] = bflo(w.z); kreg[8 * i + 5] = bfhi(w.z); kreg[8 * i + 6] = bflo(w.w); kreg[8 * i + 7] = bfhi(w.w); } }
        for (int qq = 0; qq < 8; ++qq) {
            const int q = 64 * qc + wave * 8 + qq;
            { const u32x4* qp = (const u32x4*)(PROJ + (size_t)q * NPAD + C_QI) + 2 * lane;
              const u32x4 w0 = qp[0], w1 = qp[1];
              LAS f32x4* dst = (LAS f32x4*)(qs + 16 * lane);
              dst[0] = (f32x4){bflo(w0.x), bfhi(w0.x), bflo(w0.y), bfhi(w0.y)}; dst[1] = (f32x4){bflo(w0.z), bfhi(w0.z), bflo(w0.w), bfhi(w0.w)};
              dst[2] = (f32x4){bflo(w1.x), bfhi(w1.x), bflo(w1.y), bfhi(w1.y)}; dst[3] = (f32x4){bflo(w1.z), bfhi(w1.z), bflo(w1.w), bfhi(w1.w)};
              if (lane < 16) qs[1024 + lane] = bf2f(PROJ[(size_t)q * NPAD + C_WI + lane]) * 0.25f; }
            asm volatile("s_waitcnt lgkmcnt(0)" ::: "memory"); __builtin_amdgcn_wave_barrier();
            float score = 0.f;
            for (int j = 0; j < 16; ++j) {
                float acc = 0.f; const LAS f32x4* qj = (const LAS f32x4*)(qs + 64 * j);
#pragma unroll
                for (int d = 0; d < 16; ++d) { const f32x4 qv = qj[d]; acc += qv.x * kreg[4 * d] + qv.y * kreg[4 * d + 1] + qv.z * kreg[4 * d + 2] + qv.w * kreg[4 * d + 3]; }
                score += fmaxf(acc * 0.125f, 0.f) * qs[1024 + j];
            }
            if (s <= q) SC[sc_off(q) + s] = score;
            asm volatile("s_waitcnt lgkmcnt(0)" ::: "memory"); __builtin_amdgcn_wave_barrier();
        }
    }
}
__device__ __forceinline__ unsigned ordkey(float f) { const unsigned u = __float_as_uint(f); return (u & 0x80000000u) ? ~u : (u | 0x80000000u); }
template <int NR, int NL> __device__ __forceinline__ bool topk_row(const float* __restrict__ row, int n, int lane, LAS u32x4* xl, unsigned long long& w0, unsigned long long& w1, unsigned& Tout, int& need_out) {
#pragma unroll
    for (int q = 0; q < NL / 4; ++q) { u32x4 v;
#pragma unroll
        for (int e = 0; e < 4; ++e) { const int i = 4096 + (4 * q + e) * 64 + lane; v[e] = (ordkey(*(const float*)((const char*)row + 4u * (unsigned)min(i, n - 1))) >> 1) & (unsigned)((i - n) >> 31); }
        xl[q * 64 + lane] = v;
        if ((q & 3) == 3) __builtin_amdgcn_sched_barrier(0); }
    unsigned u[NR];
#pragma unroll
    for (int k = 0; k < NR; ++k) { const int i = k * 64 + lane; u[k] = (ordkey(*(const float*)((const char*)row + 4u * (unsigned)min(i, n - 1))) >> 1) & (unsigned)((i - n) >> 31);
        if ((k & 15) == 15) __builtin_amdgcn_sched_barrier(0); }
    unsigned T = 0u; bool cut = false;
    for (int bit = 30; bit >= 0; --bit) {
        const unsigned cand = T | (1u << bit); unsigned lt = 0u;
        asm volatile("" ::: "memory");
#pragma unroll
        for (int k = 0; k < NR; ++k) lt += (u[k] - cand) >> 31;
#pragma unroll
        for (int q = 0; q < NL / 4; ++q) { const u32x4 v = xl[q * 64 + lane]; lt += ((v[0] - cand) >> 31) + ((v[1] - cand) >> 31) + ((v[2] - cand) >> 31) + ((v[3] - cand) >> 31);
            if ((q & 3) == 3) __builtin_amdgcn_sched_barrier(0); }
#pragma unroll
        for (int o = 1; o < 64; o <<= 1) lt += __shfl_xor(lt, o);
        const int ge = (int)((NR + NL) * 64 - lt);
        if (ge >= TOPK) T = cand;
        if (ge == TOPK) { cut = true; break; }
    }
    unsigned c_hi = 0u, c_lt = 0u;
#pragma unroll
    for (int k = 0; k < NR; ++k) { c_hi += (T - u[k]) >> 31; c_lt += (u[k] - T) >> 31; }
#pragma unroll
    for (int q = 0; q < NL / 4; ++q) { const u32x4 v = xl[q * 64 + lane];
#pragma unroll
        for (int e = 0; e < 4; ++e) { c_hi += (T - v[e]) >> 31; c_lt += (v[e] - T) >> 31; } }
#pragma unroll
    for (int o = 1; o < 64; o <<= 1) { c_hi += __shfl_xor(c_hi, o); c_lt += __shfl_xor(c_lt, o); }
    const int need = TOPK - (int)c_hi, c_eq = (NR + NL) * 64 - (int)c_lt - (int)c_hi;
    Tout = T; need_out = need;
    if (!cut && c_eq != need) return false;
    int ln; asm volatile("v_mbcnt_lo_u32_b32 %0, -1, 0\n\tv_mbcnt_hi_u32_b32 %0, -1, %0" : "=v"(ln));
#pragma unroll
    for (int k = 0; k < NR; ++k) {
        const unsigned long long bs = __ballot(u[k] >= T);
        if (k == ln) w0 = bs;
        __builtin_amdgcn_sched_barrier(0); }
#pragma unroll
    for (int q = 0; q < NL / 4; ++q) { const u32x4 v = xl[q * 64 + lane];
#pragma unroll
        for (int e = 0; e < 4; ++e) { const unsigned long long bs = __ballot(v[e] >= T);
            if (4 * q + e == ln) w1 = bs;
            __builtin_amdgcn_sched_barrier(0); } }
    return true;
}
__device__ __forceinline__ void topk_select(const float* SC, int* SEL, LAS unsigned char* lds, int blk, int nblk, const int wave) {
    const int lane = lane_id_v();
    LAS u32x4* xl = (LAS u32x4*)(lds + wave * 16384);
    for (int r = blk * 8 + wave; r < S; r += nblk * 8) {
        const int n = r + 1; unsigned long long* mrow = (unsigned long long*)SEL + (size_t)r * 128;
        unsigned long long w0 = 0ull, w1 = 0ull;
        const int nwords = 4 * ((r >> 8) + 1);
        if (n <= TOPK) { const int lo = 64 * lane; w0 = (r < lo) ? 0ull : ((r - lo >= 63) ? ~0ull : ((2ull << (r - lo)) - 1ull)); }
        else { const float* row = SC + sc_off(r);
            unsigned T; int need; bool ok;
            if (n <= 2048) ok = topk_row<32, 0>(row, n, lane, xl, w0, w1, T, need); else if (n <= 4096) ok = topk_row<64, 0>(row, n, lane, xl, w0, w1, T, need); else ok = topk_row<64, 64>(row, n, lane, xl, w0, w1, T, need);
            if (!ok) { int eqc = 0; const unsigned long long lt = (lane == 0) ? 0ull : (~0ull >> (64 - lane));
                for (int base = 0, it = 0; base < n; base += 64, ++it) {
                    const int i = base + lane; const unsigned v = (i < n) ? (ordkey(row[i]) >> 1) : 0u;
                    const bool gt = v > T, eq = (i < n) && (v == T);
                    const unsigned long long be = __ballot(eq);
                    const bool take = gt || (eq && (eqc + __builtin_popcountll(be & lt) < need));
                    const unsigned long long bs = __ballot(take);
                    if ((it & 63) == lane) { if (it < 64) w0 = bs; else w1 = bs; }
                    eqc += __builtin_popcountll(be); } } }
        if (lane < nwords) mrow[lane] = w0;
        if (64 + lane < nwords) mrow[64 + lane] = w1;
    }
}
template <int DQ, int DV, bool GATHER>
__device__ __forceinline__ void naive_attn(const bf16_t* __restrict__ qp, const bf16_t* __restrict__ kb, const bf16_t* __restrict__ vb, size_t kvpitch,
                                           int nkeys, int nmax, const int* __restrict__ sel, int r, float scale, float slope, float (&o)[DV / 8]) {
    constexpr int QN = DQ / 8, VN = DV / 8;
    float q[QN];
#pragma unroll
    for (int i = 0; i < QN / 2; ++i) { const unsigned w = ((const unsigned*)qp)[i]; q[2 * i] = bflo(w) * scale; q[2 * i + 1] = bfhi(w) * scale; }
#pragma unroll
    for (int i = 0; i < VN; ++i) o[i] = 0.f;
    float m = -1e30f, l = 0.f;
    for (int i = 0; i < nmax; ++i) {
        bool valid = i < nkeys; int key = i;
        if (GATHER) { key = sel[valid ? i : 0]; valid = valid && key >= 0; }
        if (!valid) key = 0;
        const unsigned* kp = (const unsigned*)(kb + (size_t)key * kvpitch);
        float d = 0.f;
#pragma unroll
        for (int j = 0; j < QN / 2; ++j) { const unsigned w = kp[j]; d += q[2 * j] * bflo(w) + q[2 * j + 1] * bfhi(w); }
        d += __shfl_xor(d, 1); d += __shfl_xor(d, 2); d += __shfl_xor(d, 4);
        const float logit = d - slope * (float)(r - key);
        if (valid) {
            if (logit > m) { const float c = __expf(m - logit); l *= c;
#pragma unroll
                for (int j = 0; j < VN; ++j) o[j] *= c;
                m = logit; }
            const float p = __expf(logit - m); l += p;
            const unsigned* vp = (const unsigned*)(vb + (size_t)key * kvpitch);
#pragma unroll
            for (int j = 0; j < VN / 2; ++j) { const unsigned w = vp[j]; o[2 * j] += p * bflo(w); o[2 * j + 1] += p * bfhi(w); }
        }
    }
    const float il = 1.0f / l;
#pragma unroll
    for (int j = 0; j < VN; ++j) o[j] *= il;
}
__device__ __forceinline__ void attn_b_naive(const Args& a, int blk, int nblk, const int wave) {
    const int lane = lane_id_v(), tid = wave * 64 + lane, sub = lane & 7;
    const bf16_t* PROJ = (const bf16_t*)(a.ws + WS_PROJ); bf16_t* UB = (bf16_t*)(a.ws + WS_U) + (size_t)1 * S * 1024;
    const float lam = ((const float*)(a.ws + WS_CTL))[0];
    for (int wi = blk * 8 + wave; wi < 1024 * 8; wi += nblk * 8) {
        const int h = wi & 7, rg = wi >> 3, r = rg * 8 + (lane >> 3), nmax = rg * 8 + 8;
        const float slope = exp2f(-(float)(h + 1));
        float o0[16], o1[16];
        const bf16_t* rowp = PROJ + (size_t)r * NPAD;
        naive_attn<64, 128, false>(rowp + C_QB + h * 128 + sub * 8, PROJ + C_KB + h * 128 + sub * 8, PROJ + C_VB + h * 128 + sub * 16, NPAD, r + 1, nmax, nullptr, r, 0.125f, slope, o0);
        naive_attn<64, 128, false>(rowp + C_QB + h * 128 + 64 + sub * 8, PROJ + C_KB + h * 128 + 64 + sub * 8, PROJ + C_VB + h * 128 + sub * 16, NPAD, r + 1, nmax, nullptr, r, 0.125f, slope, o1);
        float ss = 0.f;
#pragma unroll
        for (int j = 0; j < 16; ++j) { o0[j] -= lam * o1[j]; ss += o0[j] * o0[j]; }
        ss += __shfl_xor(ss, 1); ss += __shfl_xor(ss, 2); ss += __shfl_xor(ss, 4);
        const float rs = 1.0f / sqrtf(ss * (1.f / 128.f) + RMS_EPS) * 0.8f;
        const float* g = a.in[9] + sub * 16; const bf16_t* zp = rowp + C_ZB + h * 128 + sub * 16;
        unsigned w[8];
#pragma unroll
        for (int j = 0; j < 8; ++j) w[j] = pk2(o0[2 * j] * rs * g[2 * j] * bf2f(zp[2 * j]), o0[2 * j + 1] * rs * g[2 * j + 1] * bf2f(zp[2 * j + 1]));
        u32x4* dst = (u32x4*)(UB + (size_t)r * 1024 + h * 128 + sub * 16);
        dst[0] = (u32x4){w[0], w[1], w[2], w[3]}; dst[1] = (u32x4){w[4], w[5], w[6], w[7]};
    }
}
__device__ __forceinline__ void attn_m_naive(const Args& a, int blk, int nblk, const int wave) {
    const int lane = lane_id_v(), tid = wave * 64 + lane, sub = lane & 7;
    const bf16_t* PROJ = (const bf16_t*)(a.ws + WS_PROJ); const bf16_t* MKV = (const bf16_t*)(a.ws + WS_MKV); bf16_t* UM = (bf16_t*)(a.ws + WS_U) + (size_t)2 * S * 1024;
    for (int wi = blk * 8 + wave; wi < 1024 * 4; wi += nblk * 8) {
        const int h = wi & 3, rg = wi >> 2, r = rg * 8 + (lane >> 3);
        float o[32];
        const bf16_t* rowp = PROJ + (size_t)r * NPAD;
        naive_attn<256, 256, false>(rowp + C_QM + h * 256 + sub * 32, MKV + h * 256 + sub * 32, MKV + 1024 + h * 256 + sub * 32, 2048, NMEM, NMEM, nullptr, 0, 0.0625f, 0.f, o);
        const bf16_t* zp = rowp + C_ZM + h * 256 + sub * 32;
        u32x4* dst = (u32x4*)(UM + (size_t)r * 1024 + h * 256 + sub * 32);
#pragma unroll
        for (int j = 0; j < 4; ++j) { u32x4 w;
            w.x = pk2(o[8 * j + 0] * bf2f(zp[8 * j + 0]), o[8 * j + 1] * bf2f(zp[8 * j + 1])); w.y = pk2(o[8 * j + 2] * bf2f(zp[8 * j + 2]), o[8 * j + 3] * bf2f(zp[8 * j + 3]));
            w.z = pk2(o[8 * j + 4] * bf2f(zp[8 * j + 4]), o[8 * j + 5] * bf2f(zp[8 * j + 5])); w.w = pk2(o[8 * j + 6] * bf2f(zp[8 * j + 6]), o[8 * j + 7] * bf2f(zp[8 * j + 7]));
            dst[j] = w; }
    }
}
__device__ __forceinline__ void attn_a_naive(const Args& a, int blk, int nblk, const int wave) {
    const int lane = lane_id_v(), tid = wave * 64 + lane, sub = lane & 7;
    const bf16_t* PROJ = (const bf16_t*)(a.ws + WS_PROJ); const int* SEL = (const int*)(a.ws + WS_SEL); bf16_t* UA = (bf16_t*)(a.ws + WS_U);
    for (int wi = blk * 8 + wave; wi < 1024 * 8; wi += nblk * 8) {
        const int h = wi & 7, rg = wi >> 3, r = rg * 8 + (lane >> 3);
        const float slope = exp2f(-(float)(h + 1));
        float o[16];
        const bf16_t* rowp = PROJ + (size_t)r * NPAD;
        naive_attn<128, 128, true>(rowp + C_QA + h * 128 + sub * 16, PROJ + C_KA + h * 128 + sub * 16, PROJ + C_VA + h * 128 + sub * 16, NPAD, TOPK, TOPK, SEL + (size_t)r * TOPK, r, 0.08838834764831845f, slope, o);
        const bf16_t* zp = rowp + C_ZA + h * 128 + sub * 16;
        unsigned w[8];
#pragma unroll
        for (int j = 0; j < 8; ++j) w[j] = pk2(o[2 * j] * bf2f(zp[2 * j]), o[2 * j + 1] * bf2f(zp[2 * j + 1]));
        u32x4* dst = (u32x4*)(UA + (size_t)r * 1024 + h * 128 + sub * 16);
        dst[0] = (u32x4){w[0], w[1], w[2], w[3]}; dst[1] = (u32x4){w[4], w[5], w[6], w[7]};
    }
}
__device__ __forceinline__ void final_norm(const Args& a, int blk, int nblk, const int wave) {
    const int lane = lane_id_v(), tid = wave * 64 + lane;
    const float* part = (const float*)(a.ws + WS_PART); const f32x4* g = (const f32x4*)a.in[16] + lane;
    for (int r = blk * 8 + wave; r < S; r += nblk * 8) {
        float s = (lane < 32) ? part[(size_t)lane * S + r] : 0.f;
        const float rs = 1.0f / sqrtf(wave_sum(s) * (1.f / DM) + RMS_EPS);
        f32x4* y = (f32x4*)(a.out + (size_t)r * DM) + lane;
#pragma unroll
        for (int j = 0; j < 8; ++j) { f32x4 v = y[64 * j]; const f32x4 gg = g[64 * j]; v = v * rs * gg; y[64 * j] = v; }
    }
}


namespace att {
typedef short bf16x8 __attribute__((ext_vector_type(8)));
typedef short s16x4 __attribute__((ext_vector_type(4)));
typedef float f32x16 __attribute__((ext_vector_type(16)));
typedef float f32x2_t __attribute__((ext_vector_type(2)));
typedef __bf16 bf16x2_t __attribute__((ext_vector_type(2)));
constexpr int SHM_V = 16384, SHM_K = 16384;
constexpr float LOG2E = 1.4426950408889634f;
constexpr float THR2 = 8.f * LOG2E;
#define KSWZ(row, colB) ((row) * 256 + ((colB) ^ (((row) & 7) << 4)))
#define SBAR() __builtin_amdgcn_sched_barrier(0)
__device__ __forceinline__ int crow(int r, int hi) { return (r & 3) + 8 * (r >> 2) + 4 * hi; }
__device__ __forceinline__ unsigned cvtpk(float lo, float hi) { f32x2_t v = {lo, hi}; bf16x2_t b = __builtin_convertvector(v, bf16x2_t); return __builtin_bit_cast(unsigned, b); }
__device__ __forceinline__ int v_st(int k, int c) { const int kk = (k & ~0xC) | ((k & 4) << 1) | ((k & 8) >> 1); return ((kk >> 3) * 4 + (c >> 5)) * 512 + ((kk & 7) * 32 + (c & 31)) * 2; }
__device__ __forceinline__ int v_rd_base(int lane) { return ((lane & 3) << 3) | (((lane >> 2) & 3) << 6) | (((lane >> 4) & 1) << 5) | (((lane >> 5) & 1) << 8); }
constexpr int v_rd_off(int d0, int ks, int half) { return d0 * 512 + ks * 4096 + half * 2048; }
typedef short v4i16_t __attribute__((ext_vector_type(4)));
__device__ __forceinline__ s16x4 tr_read(LAS const unsigned char* p) { return __builtin_bit_cast(s16x4, __builtin_amdgcn_ds_read_tr16_b64_v4i16((LAS v4i16_t*)p)); }

template <int NQ> __device__ __forceinline__ void qkt(f32x16& p0, f32x16& p1, LAS const unsigned char* Ks, const bf16x8* qr, int cbyte0, int r32, int hi) {
  p0 = f32x16{}; p1 = f32x16{};
#pragma unroll
  for (int d0 = 0; d0 < NQ; ++d0) { const int cb = cbyte0 + (d0 * 16 + hi * 8) * 2;
    const bf16x8 b0 = *(LAS const bf16x8*)(Ks + KSWZ(r32, cb));
    const bf16x8 b1 = *(LAS const bf16x8*)(Ks + KSWZ(32 + r32, cb));
    p0 = __builtin_amdgcn_mfma_f32_32x32x16_bf16(b0, qr[d0], p0, 0, 0, 0);
    p1 = __builtin_amdgcn_mfma_f32_32x32x16_bf16(b1, qr[d0], p1, 0, 0, 0); }
}
template <int NQ> __device__ __forceinline__ void qkt_l(f32x16& p0, f32x16& p1, LAS const unsigned char* Ks, LAS const unsigned char* Qs, int cbyte0, int r32, int hi) {
  p0 = f32x16{}; p1 = f32x16{};
  asm volatile("" : "+v"(Qs));
#pragma unroll
  for (int d0 = 0; d0 < NQ; ++d0) { const int cb = cbyte0 + (d0 * 16 + hi * 8) * 2;
    const bf16x8 q = *(LAS const bf16x8*)(Qs + d0 * 1024);
    const bf16x8 b0 = *(LAS const bf16x8*)(Ks + KSWZ(r32, cb));
    const bf16x8 b1 = *(LAS const bf16x8*)(Ks + KSWZ(32 + r32, cb));
    p0 = __builtin_amdgcn_mfma_f32_32x32x16_bf16(b0, q, p0, 0, 0, 0);
    p1 = __builtin_amdgcn_mfma_f32_32x32x16_bf16(b1, q, p1, 0, 0, 0); }
}
template <int D0> __device__ __forceinline__ void pv_one(f32x16& od, LAS const unsigned char* vb, bf16x8 pa0, bf16x8 pa1, bf16x8 pa2, bf16x8 pa3) {
  const s16x4 l0 = tr_read(vb + v_rd_off(D0, 0, 0)), h0 = tr_read(vb + v_rd_off(D0, 0, 1)), l1 = tr_read(vb + v_rd_off(D0, 1, 0)), h1 = tr_read(vb + v_rd_off(D0, 1, 1));
  const s16x4 l2 = tr_read(vb + v_rd_off(D0, 2, 0)), h2 = tr_read(vb + v_rd_off(D0, 2, 1)), l3 = tr_read(vb + v_rd_off(D0, 3, 0)), h3 = tr_read(vb + v_rd_off(D0, 3, 1));
#define PK(L, H) (bf16x8){L[0], L[1], L[2], L[3], H[0], H[1], H[2], H[3]}
  od = __builtin_amdgcn_mfma_f32_32x32x16_bf16(pa0, PK(l0, h0), od, 0, 0, 0);
  od = __builtin_amdgcn_mfma_f32_32x32x16_bf16(pa1, PK(l1, h1), od, 0, 0, 0);
  od = __builtin_amdgcn_mfma_f32_32x32x16_bf16(pa2, PK(l2, h2), od, 0, 0, 0);
  od = __builtin_amdgcn_mfma_f32_32x32x16_bf16(pa3, PK(l3, h3), od, 0, 0, 0);
#undef PK
}
__device__ __forceinline__ void pv_d0(f32x16* o, LAS const unsigned char* vb, bf16x8 pa0, bf16x8 pa1, bf16x8 pa2, bf16x8 pa3) {
  pv_one<0>(o[0], vb, pa0, pa1, pa2, pa3); pv_one<1>(o[1], vb, pa0, pa1, pa2, pa3); pv_one<2>(o[2], vb, pa0, pa1, pa2, pa3); pv_one<3>(o[3], vb, pa0, pa1, pa2, pa3);
}
template <bool CAUSAL> __device__ __forceinline__ void partialSM(f32x16& p0, f32x16& p1, float& m_reg, float& alpha, const float (&cs)[16], float base, int lim, float C, float slope2, int delta) {
  const float tb0 = slope2 * (float)delta + base, tb1 = slope2 * (float)(delta + 32) + base;
#pragma unroll
  for (int r = 0; r < 16; ++r) { p0[r] = fmaf(p0[r], C, cs[r]); p1[r] = fmaf(p1[r], C, cs[r]); }
  if (CAUSAL && delta + 63 > 0) {
    const int l0 = lim - delta, l1 = l0 - 32;
#pragma unroll
    for (int r = 0; r < 16; ++r) { const int K = (r & 3) + 8 * (r >> 2); if (K > l0) p0[r] = -INFINITY; if (K > l1) p1[r] = -INFINITY; }
  }
  float pm0 = p0[0], pm1 = p1[0];
#pragma unroll
  for (int r = 1; r < 16; ++r) { pm0 = fmaxf(pm0, p0[r]); pm1 = fmaxf(pm1, p1[r]); }
  float pmax = fmaxf(pm0 + tb0, pm1 + tb1);
  { auto rr = __builtin_amdgcn_permlane32_swap(__float_as_uint(pmax), __float_as_uint(pmax), false, false);
    pmax = fmaxf(__uint_as_float(rr[0]), __uint_as_float(rr[1])); }
  float mn;
  if (__builtin_expect(__all(pmax - m_reg <= THR2), 1)) { mn = m_reg; alpha = 1.f; }
  else { mn = fmaxf(m_reg, pmax); alpha = __builtin_amdgcn_exp2f(m_reg - mn); m_reg = mn; }
  const float a0 = tb0 - mn, a1 = tb1 - mn;
#pragma unroll
  for (int r = 0; r < 16; ++r) { p0[r] += a0; p1[r] += a1; }
#pragma unroll
  for (int r = 0; r < 16; ++r) p0[r] = __builtin_amdgcn_exp2f(p0[r]);
}
__device__ __forceinline__ void finishSM(f32x16& p0, f32x16& p1, float alpha, float& l_reg, bf16x8& pa0, bf16x8& pa1, bf16x8& pa2, bf16x8& pa3) {
#pragma unroll
  for (int r = 0; r < 16; ++r) p1[r] = __builtin_amdgcn_exp2f(p1[r]);
  float ps = 0;
#pragma unroll
  for (int r = 0; r < 16; ++r) ps += p0[r];
#pragma unroll
  for (int r = 0; r < 16; ++r) ps += p1[r];
  { auto rr = __builtin_amdgcn_permlane32_swap(__float_as_uint(ps), __float_as_uint(ps), false, false);
    ps = __uint_as_float(rr[0]) + __uint_as_float(rr[1]); }
  l_reg = l_reg * alpha + ps;
#define PK4(P, BASE, OUT) do { unsigned a0 = cvtpk(P[BASE + 0], P[BASE + 1]), a1 = cvtpk(P[BASE + 2], P[BASE + 3]);   \
    unsigned b0 = cvtpk(P[BASE + 4], P[BASE + 5]), b1 = cvtpk(P[BASE + 6], P[BASE + 7]);                              \
    auto r0 = __builtin_amdgcn_permlane32_swap(a0, b0, false, false); auto r1 = __builtin_amdgcn_permlane32_swap(a1, b1, false, false); \
    u32x4 w = {r0[0], r1[0], r0[1], r1[1]}; OUT = __builtin_bit_cast(bf16x8, w); } while (0)
  PK4(p0, 0, pa0); PK4(p0, 8, pa1); PK4(p1, 0, pa2); PK4(p1, 8, pa3);
#undef PK4
}

__device__ __forceinline__ void attn_b_unit(const bf16_t* __restrict__ PROJ, bf16_t* UB, const float* __restrict__ gsub, float lam, int h, int qb, int jmin, LAS unsigned char* lds, const int wid) {
  const int lane = lane_id_v(), tid = wid * 64 + lane, r32 = lane & 31, hi = lane >> 5, comp = wid >> 2, wq = wid & 3;
  const int R0 = qb * 128, qrow0 = R0 + wq * 32, NT = 2 * qb + 2, NTe = NT - jmin;
  LAS unsigned char* V_lds = lds; LAS unsigned char* K_lds = lds + 2 * SHM_V;
  LAS float* ws = (LAS float*)(lds + 2 * SHM_V + 2 * SHM_K) + wid * 64; LAS float* li_l = ws; LAS float* al_l = ws + 32;
  LAS float* xch = (LAS float*)(lds + 2 * SHM_V + 2 * SHM_K + 2048);
  const float slope2 = __builtin_amdgcn_exp2f(-(float)(h + 1)) * LOG2E, C = 0.125f * LOG2E;
  float cs[16];
#pragma unroll
  for (int r = 0; r < 16; ++r) cs[r] = __uint_as_float(__builtin_amdgcn_readfirstlane(__float_as_uint(slope2 * (float)((r & 3) + 8 * (r >> 2)))));
  const float base = slope2 * (float)(4 * hi - r32); const int lim = r32 - 4 * hi;
  float m_reg = -1e30f, l_reg = 0; f32x16 o[4] = {};
  LAS unsigned char* Qs = lds + 2 * SHM_V + 2 * SHM_K + 2048 + wid * 4096 + lane * 16;
  { const bf16_t* Qw = PROJ + (size_t)(qrow0 + r32) * NPAD + C_QB + h * 128 + comp * 64 + hi * 8;
#pragma unroll
    for (int d0 = 0; d0 < 4; ++d0) *(LAS bf16x8*)(Qs + d0 * 1024) = *(const bf16x8*)(Qw + d0 * 16); }
  const unsigned offK = (unsigned)((tid >> 4) * NPAD + C_KB + h * 128 + (tid & 15) * 8) * 2u, offV = offK + (unsigned)(C_VB - C_KB) * 2u;
  const int sr = tid >> 4, sc = (tid & 15) * 8, vst0 = v_st(sr, sc), vst1 = v_st(32 + sr, sc), cq = comp * 128;
  LAS const unsigned char* vb0 = V_lds + v_rd_base(lane);
  struct { bf16x8 vs0, vs1, ks0, ks1; } sr_[2];
#define KEY0(t) (64 * (NT - 1 - (t)))
#define GLD16(off) (*(const bf16x8*)((const char*)PROJ + (unsigned)(off)))
#define SLOAD(i, k0) do { const unsigned kb_ = (unsigned)(k0) * (unsigned)(NPAD * 2); sr_[i].vs0 = GLD16(offV + kb_); sr_[i].vs1 = GLD16(offV + kb_ + 32u * NPAD * 2u); \
    sr_[i].ks0 = GLD16(offK + kb_); sr_[i].ks1 = GLD16(offK + kb_ + 32u * NPAD * 2u); } while (0)
#define SWRITE(b) do { *(LAS bf16x8*)(V_lds + (b) * SHM_V + vst0) = sr_[b].vs0; *(LAS bf16x8*)(V_lds + (b) * SHM_V + vst1) = sr_[b].vs1; const int kc = sc * 2; \
    *(LAS bf16x8*)(K_lds + (b) * SHM_K + KSWZ(sr, kc)) = sr_[b].ks0; *(LAS bf16x8*)(K_lds + (b) * SHM_K + KSWZ(32 + sr, kc)) = sr_[b].ks1; } while (0)
#define RESC(a) do { if (__any((a) < 1.f)) { if (hi == 0) al_l[r32] = (a); asm volatile("s_waitcnt lgkmcnt(0)" ::: "memory"); \
    _Pragma("unroll") for (int d = 0; d < 4; ++d) _Pragma("unroll") for (int r = 0; r < 16; ++r) o[d][r] *= al_l[crow(r, hi)]; } } while (0)
  f32x16 pA0, pA1, pB0, pB1; float alA, alB; bf16x8 pa0, pa1, pa2, pa3;
  SLOAD(0, KEY0(0)); SWRITE(0); __syncthreads();
  qkt_l<4>(pA0, pA1, K_lds, Qs, cq, r32, hi); partialSM<true>(pA0, pA1, m_reg, alA, cs, base, lim, C, slope2, KEY0(0) - qrow0);
  SLOAD(1, KEY0(1)); if (2 < NTe) SLOAD(0, KEY0(2));
  SWRITE(1); __syncthreads();
  for (int j = 1; j + 1 < NTe; j += 2) {
    SBAR(); qkt_l<4>(pB0, pB1, K_lds + SHM_K, Qs, cq, r32, hi);
    finishSM(pA0, pA1, alA, l_reg, pa0, pa1, pa2, pa3); SBAR();
    SLOAD(1, KEY0(j + 2)); SBAR();
    pv_d0(o, vb0, pa0, pa1, pa2, pa3); partialSM<true>(pB0, pB1, m_reg, alB, cs, base, lim, C, slope2, KEY0(j) - qrow0);
    __syncthreads(); SWRITE(0);
    RESC(alB); __syncthreads();
    SBAR(); qkt_l<4>(pA0, pA1, K_lds, Qs, cq, r32, hi);
    finishSM(pB0, pB1, alB, l_reg, pa0, pa1, pa2, pa3); SBAR();
    SLOAD(0, KEY0(min(j + 3, NTe - 1))); SBAR();
    pv_d0(o, vb0 + SHM_V, pa0, pa1, pa2, pa3); partialSM<true>(pA0, pA1, m_reg, alA, cs, base, lim, C, slope2, KEY0(j + 1) - qrow0);
    __syncthreads(); SWRITE(1);
    RESC(alA); __syncthreads();
  }
  SBAR(); qkt_l<4>(pB0, pB1, K_lds + SHM_K, Qs, cq, r32, hi);
  finishSM(pA0, pA1, alA, l_reg, pa0, pa1, pa2, pa3); SBAR();
  pv_d0(o, vb0, pa0, pa1, pa2, pa3); partialSM<true>(pB0, pB1, m_reg, alB, cs, base, lim, C, slope2, KEY0(NTe - 1) - qrow0);
  __syncthreads(); RESC(alB);
  finishSM(pB0, pB1, alB, l_reg, pa0, pa1, pa2, pa3); SBAR();
  pv_d0(o, vb0 + SHM_V, pa0, pa1, pa2, pa3);
#undef KEY0
#undef SLOAD
#undef GLD16
#undef SWRITE
#undef RESC
  if (hi == 0) li_l[r32] = l_reg; asm volatile("s_waitcnt lgkmcnt(0)" ::: "memory");
  float rli[16];
#pragma unroll
  for (int r = 0; r < 16; ++r) rli[r] = __builtin_amdgcn_rcpf(li_l[crow(r, hi)]);
  __syncthreads();
  if (comp == 1) {
#pragma unroll
    for (int d0 = 0; d0 < 4; ++d0)
#pragma unroll
      for (int r = 0; r < 16; ++r) xch[(wq * 64 + d0 * 16 + r) * 64 + lane] = o[d0][r] * rli[r] * lam;
  }
  __syncthreads();
  if (comp == 0) {
    float ss[16];
#pragma unroll
    for (int r = 0; r < 16; ++r) ss[r] = 0.f;
#pragma unroll
    for (int d0 = 0; d0 < 4; ++d0)
#pragma unroll
      for (int r = 0; r < 16; ++r) { const float d = o[d0][r] * rli[r] - xch[(wq * 64 + d0 * 16 + r) * 64 + lane]; o[d0][r] = d; ss[r] += d * d; }
#pragma unroll
    for (int r = 0; r < 16; ++r) { float s = ss[r]; s += __shfl_xor(s, 1); s += __shfl_xor(s, 2); s += __shfl_xor(s, 4); s += __shfl_xor(s, 8); s += __shfl_xor(s, 16);
      ss[r] = 0.8f / sqrtf(s * (1.f / 128.f) + RMS_EPS); }
#pragma unroll
    for (int d0 = 0; d0 < 4; ++d0) { const int col = d0 * 32 + r32; const float g = gsub[col];
#pragma unroll
      for (int r = 0; r < 16; ++r) { const size_t row = (size_t)(qrow0 + crow(r, hi));
        const float z = bf2f(PROJ[row * NPAD + C_ZB + h * 128 + col]);
        UB[row * 1024 + h * 128 + col] = (bf16_t)f2bf(o[d0][r] * ss[r] * g * z); } }
  }
  __syncthreads();
}
template <bool DUMMY> __device__ __forceinline__ void partialSM_A(f32x16& p0, f32x16& p1, float& m_reg, float& alpha, const float (&cs)[16], float base, float C, float slope2, int delta, unsigned long long mw, int hi) {
  const float tb0 = slope2 * (float)delta + base, tb1 = slope2 * (float)(delta + 32) + base;
  const unsigned wl = (unsigned)mw >> (4 * hi), wh = (unsigned)(mw >> 32) >> (4 * hi);
#pragma unroll
  for (int r = 0; r < 16; ++r) { const int K = (r & 3) + 8 * (r >> 2);
    const float y0 = fmaf(p0[r], C, cs[r]), y1 = fmaf(p1[r], C, cs[r]);
    const unsigned t0 = (unsigned)((int)(wl << (31 - K)) >> 31), t1 = (unsigned)((int)(wh << (31 - K)) >> 31);
    p0[r] = __uint_as_float((__float_as_uint(y0) & t0) | (~t0 & 0xff800000u));
    p1[r] = __uint_as_float((__float_as_uint(y1) & t1) | (~t1 & 0xff800000u)); }
  float pm0 = p0[0], pm1 = p1[0];
#pragma unroll
  for (int r = 1; r < 16; ++r) { pm0 = fmaxf(pm0, p0[r]); pm1 = fmaxf(pm1, p1[r]); }
  float pmax = fmaxf(pm0 + tb0, pm1 + tb1);
  { auto rr = __builtin_amdgcn_permlane32_swap(__float_as_uint(pmax), __float_as_uint(pmax), false, false);
    pmax = fmaxf(__uint_as_float(rr[0]), __uint_as_float(rr[1])); }
  float mn;
  if (__builtin_expect(__all(pmax - m_reg <= THR2), 1)) { mn = m_reg; alpha = 1.f; }
  else { mn = fmaxf(m_reg, pmax); alpha = __builtin_amdgcn_exp2f(m_reg - mn); m_reg = mn; }
  const float a0 = tb0 - mn, a1 = tb1 - mn;
#pragma unroll
  for (int r = 0; r < 16; ++r) { p0[r] += a0; p1[r] += a1; }
#pragma unroll
  for (int r = 0; r < 16; ++r) p0[r] = __builtin_amdgcn_exp2f(p0[r]);
}
__device__ __forceinline__ void attn_a_unit(const bf16_t* __restrict__ PROJ, const unsigned long long* __restrict__ MASK, bf16_t* UA, int h, int qb, int jmin, LAS unsigned char* lds, const int wid) {
  const int lane = lane_id_v(), tid = wid * 64 + lane, r32 = lane & 31, hi = lane >> 5;
  const int R0 = qb * 256, qrow0 = R0 + wid * 32, NT = 4 * qb + 4, NTe = NT - jmin;
  LAS unsigned char* V_lds = lds; LAS unsigned char* K_lds = lds + 2 * SHM_V;
  LAS float* ws = (LAS float*)(lds + 2 * SHM_V + 2 * SHM_K) + wid * 64; LAS float* li_l = ws; LAS float* al_l = ws + 32;
  const float slope2 = __builtin_amdgcn_exp2f(-(float)(h + 1)) * LOG2E, C = 0.08838834764831845f * LOG2E;
  float cs[16];
#pragma unroll
  for (int r = 0; r < 16; ++r) cs[r] = __uint_as_float(__builtin_amdgcn_readfirstlane(__float_as_uint(slope2 * (float)((r & 3) + 8 * (r >> 2)))));
  const float base = slope2 * (float)(4 * hi - r32);
  float m_reg = -1e30f, l_reg = 0; f32x16 o[4] = {}; bf16x8 qr[8];
  { const bf16_t* Qw = PROJ + (size_t)(qrow0 + r32) * NPAD + C_QA + h * 128 + hi * 8;
#pragma unroll
    for (int d0 = 0; d0 < 8; ++d0) qr[d0] = *(const bf16x8*)(Qw + d0 * 16); }
  const unsigned offK = (unsigned)((tid >> 4) * NPAD + C_KA + h * 128 + (tid & 15) * 8) * 2u, offV = offK + (unsigned)(C_VA - C_KA) * 2u;
  const unsigned moff = (unsigned)(qrow0 + r32) * 1024u;
#define MLD(tj) (*(const unsigned long long*)((const char*)MASK + (moff + 8u * (unsigned)(tj))))
  const int sr = tid >> 4, sc = (tid & 15) * 8, vst0 = v_st(sr, sc), vst1 = v_st(32 + sr, sc);
  LAS const unsigned char* vb0 = V_lds + v_rd_base(lane);
  struct { bf16x8 vs0, vs1, ks0, ks1; } sr_;
#define TJ(t) (NT - 1 - (t))
#define KEY0(t) (64 * TJ(t))
#define GLD16(off) (*(const bf16x8*)((const char*)PROJ + (unsigned)(off)))
#define SLOAD(k0) do { const unsigned kb_ = (unsigned)(k0) * (unsigned)(NPAD * 2); sr_.vs0 = GLD16(offV + kb_); sr_.vs1 = GLD16(offV + kb_ + 32u * NPAD * 2u); \
    sr_.ks0 = GLD16(offK + kb_); sr_.ks1 = GLD16(offK + kb_ + 32u * NPAD * 2u); } while (0)
#define SWRITE(b) do { *(LAS bf16x8*)(V_lds + (b) * SHM_V + vst0) = sr_.vs0; *(LAS bf16x8*)(V_lds + (b) * SHM_V + vst1) = sr_.vs1; const int kc = sc * 2; \
    *(LAS bf16x8*)(K_lds + (b) * SHM_K + KSWZ(sr, kc)) = sr_.ks0; *(LAS bf16x8*)(K_lds + (b) * SHM_K + KSWZ(32 + sr, kc)) = sr_.ks1; } while (0)
#define RESC(a) do { if (__any((a) < 1.f)) { if (hi == 0) al_l[r32] = (a); asm volatile("s_waitcnt lgkmcnt(0)" ::: "memory"); \
    _Pragma("unroll") for (int d = 0; d < 4; ++d) _Pragma("unroll") for (int r = 0; r < 16; ++r) o[d][r] *= al_l[crow(r, hi)]; } } while (0)
  f32x16 pA0, pA1, pB0, pB1; float alA, alB; bf16x8 pa0, pa1, pa2, pa3; unsigned long long mwA, mwB;
  SLOAD(KEY0(0)); mwA = MLD(TJ(0)); SWRITE(0); __syncthreads();
  qkt<8>(pA0, pA1, K_lds, qr, 0, r32, hi); partialSM_A<true>(pA0, pA1, m_reg, alA, cs, base, C, slope2, KEY0(0) - qrow0, mwA, hi);
  SLOAD(KEY0(1)); mwB = MLD(TJ(1)); SWRITE(1); __syncthreads();
  for (int j = 1; j + 1 < NTe; j += 2) {
    SBAR(); qkt<8>(pB0, pB1, K_lds + SHM_K, qr, 0, r32, hi);
    finishSM(pA0, pA1, alA, l_reg, pa0, pa1, pa2, pa3); SBAR();
    SLOAD(KEY0(j + 1)); mwA = MLD(TJ(j + 1)); SBAR();
    pv_d0(o, vb0, pa0, pa1, pa2, pa3); partialSM_A<true>(pB0, pB1, m_reg, alB, cs, base, C, slope2, KEY0(j) - qrow0, mwB, hi);
    __syncthreads(); SWRITE(0);
    RESC(alB); __syncthreads();
    SBAR(); qkt<8>(pA0, pA1, K_lds, qr, 0, r32, hi);
    finishSM(pB0, pB1, alB, l_reg, pa0, pa1, pa2, pa3); SBAR();
    SLOAD(KEY0(j + 2)); mwB = MLD(TJ(j + 2)); SBAR();
    pv_d0(o, vb0 + SHM_V, pa0, pa1, pa2, pa3); partialSM_A<true>(pA0, pA1, m_reg, alA, cs, base, C, slope2, KEY0(j + 1) - qrow0, mwA, hi);
    __syncthreads(); SWRITE(1);
    RESC(alA); __syncthreads();
  }
  SBAR(); qkt<8>(pB0, pB1, K_lds + SHM_K, qr, 0, r32, hi);
  finishSM(pA0, pA1, alA, l_reg, pa0, pa1, pa2, pa3); SBAR();
  pv_d0(o, vb0, pa0, pa1, pa2, pa3); partialSM_A<true>(pB0, pB1, m_reg, alB, cs, base, C, slope2, KEY0(NTe - 1) - qrow0, mwB, hi);
  __syncthreads(); RESC(alB);
  finishSM(pB0, pB1, alB, l_reg, pa0, pa1, pa2, pa3); SBAR();
  pv_d0(o, vb0 + SHM_V, pa0, pa1, pa2, pa3);
#undef TJ
#undef MLD
#undef KEY0
#undef SLOAD
#undef GLD16
#undef SWRITE
#undef RESC
  if (hi == 0) li_l[r32] = l_reg; asm volatile("s_waitcnt lgkmcnt(0)" ::: "memory");
  float rli[16];
#pragma unroll
  for (int r = 0; r < 16; ++r) rli[r] = __builtin_amdgcn_rcpf(li_l[crow(r, hi)]);
#pragma unroll
  for (int d0 = 0; d0 < 4; ++d0) { const int col = h * 128 + d0 * 32 + r32;
#pragma unroll
    for (int r = 0; r < 16; ++r) { const size_t row = (size_t)(qrow0 + crow(r, hi));
      const float z = bf2f(PROJ[row * NPAD + C_ZA + col]);
      UA[row * 1024 + col] = (bf16_t)f2bf(o[d0][r] * rli[r] * z); } }
  __syncthreads();
}
template <int NQ, bool ACC> __device__ __forceinline__ void qkt_acc(f32x16& p0, f32x16& p1, LAS const unsigned char* Ks, const bf16x8* qr, int r32, int hi) {
  if (!ACC) { p0 = f32x16{}; p1 = f32x16{}; }
#pragma unroll
  for (int d0 = 0; d0 < NQ; ++d0) { const int cb = (d0 * 16 + hi * 8) * 2;
    const bf16x8 b0 = *(LAS const bf16x8*)(Ks + KSWZ(r32, cb));
    const bf16x8 b1 = *(LAS const bf16x8*)(Ks + KSWZ(32 + r32, cb));
    p0 = __builtin_amdgcn_mfma_f32_32x32x16_bf16(b0, qr[d0], p0, 0, 0, 0);
    p1 = __builtin_amdgcn_mfma_f32_32x32x16_bf16(b1, qr[d0], p1, 0, 0, 0); }
}
__device__ __forceinline__ void attn_m_unit(const bf16_t* __restrict__ PROJ, const bf16_t* __restrict__ MKV, bf16_t* UM, int h, int qb, int vh, LAS unsigned char* lds, const int wid) {
  const int lane = lane_id_v(), tid = wid * 64 + lane, r32 = lane & 31, hi = lane >> 5;
  const int qrow0 = qb * 256 + wid * 32;
  LAS unsigned char* V_lds = lds; LAS unsigned char* K_lds = lds + 2 * SHM_V;
  LAS float* ws = (LAS float*)(lds + 2 * SHM_V + 2 * SHM_K) + wid * 64; LAS float* li_l = ws; LAS float* al_l = ws + 32;
  const float C = 0.0625f * LOG2E;
  const float cs[16] = {0.f, 0.f, 0.f, 0.f, 0.f, 0.f, 0.f, 0.f, 0.f, 0.f, 0.f, 0.f, 0.f, 0.f, 0.f, 0.f};
  float m_reg = -1e30f, l_reg = 0; f32x16 o[4] = {}; bf16x8 qr[16];
  { const bf16_t* Qw = PROJ + (size_t)(qrow0 + r32) * NPAD + C_QM + h * 256 + hi * 8;
#pragma unroll
    for (int d0 = 0; d0 < 16; ++d0) qr[d0] = *(const bf16x8*)(Qw + d0 * 16); }
  const int sr = tid >> 4, sc = (tid & 15) * 8, vst0 = v_st(sr, sc), vst1 = v_st(32 + sr, sc);
  const unsigned offK = (unsigned)(sr * 2048 + h * 256 + sc) * 2u, offV = offK + (unsigned)(1024 + vh * 128) * 2u;
  LAS const unsigned char* vb0 = V_lds + v_rd_base(lane);
#define GLD16(off) (*(const bf16x8*)((const char*)MKV + (unsigned)(off)))
  for (int t = 0; t < 4; ++t) {
    const unsigned kb_ = (unsigned)(64 * t) * 4096u;
    const bf16x8 ka0 = GLD16(offK + kb_), ka1 = GLD16(offK + kb_ + 32u * 4096u), kb0 = GLD16(offK + kb_ + 256u), kb1 = GLD16(offK + kb_ + 32u * 4096u + 256u);
    const bf16x8 vs0 = GLD16(offV + kb_), vs1 = GLD16(offV + kb_ + 32u * 4096u);
    const int kc = sc * 2;
    *(LAS bf16x8*)(K_lds + KSWZ(sr, kc)) = ka0; *(LAS bf16x8*)(K_lds + KSWZ(32 + sr, kc)) = ka1;
    *(LAS bf16x8*)(K_lds + SHM_K + KSWZ(sr, kc)) = kb0; *(LAS bf16x8*)(K_lds + SHM_K + KSWZ(32 + sr, kc)) = kb1;
    *(LAS bf16x8*)(V_lds + vst0) = vs0; *(LAS bf16x8*)(V_lds + vst1) = vs1;
    __syncthreads();
    f32x16 p0, p1; float al; bf16x8 pa0, pa1, pa2, pa3;
    qkt_acc<8, false>(p0, p1, K_lds, qr, r32, hi); qkt_acc<8, true>(p0, p1, K_lds + SHM_K, qr + 8, r32, hi);
    partialSM<false>(p0, p1, m_reg, al, cs, 0.f, 0, C, 0.f, 0);
    if (__any(al < 1.f)) { if (hi == 0) al_l[r32] = al; asm volatile("s_waitcnt lgkmcnt(0)" ::: "memory");
#pragma unroll
      for (int d = 0; d < 4; ++d)
#pragma unroll
        for (int r = 0; r < 16; ++r) o[d][r] *= al_l[crow(r, hi)]; }
    finishSM(p0, p1, al, l_reg, pa0, pa1, pa2, pa3);
    pv_d0(o, vb0, pa0, pa1, pa2, pa3);
    __syncthreads();
  }
#undef GLD16
  if (hi == 0) li_l[r32] = l_reg; asm volatile("s_waitcnt lgkmcnt(0)" ::: "memory");
  float rli[16];
#pragma unroll
  for (int r = 0; r < 16; ++r) rli[r] = __builtin_amdgcn_rcpf(li_l[crow(r, hi)]);
#pragma unroll
  for (int d0 = 0; d0 < 4; ++d0) { const int col = h * 256 + vh * 128 + d0 * 32 + r32;
#pragma unroll
    for (int r = 0; r < 16; ++r) { const size_t row = (size_t)(qrow0 + crow(r, hi));
      const float z = bf2f(PROJ[row * NPAD + C_ZM + col]);
      UM[row * 1024 + col] = (bf16_t)f2bf(o[d0][r] * rli[r] * z); } }
  __syncthreads();
}
__device__ __forceinline__ void attn_m_phase(const Args& a, LAS unsigned char* lds, int blk, int nblk, const int wid) {
  const bf16_t* PROJ = (const bf16_t*)(a.ws + WS_PROJ); const bf16_t* MKV = (const bf16_t*)(a.ws + WS_MKV); bf16_t* UM = (bf16_t*)(a.ws + WS_U) + (size_t)2 * S * 1024;
  for (int u = blk; u < 256; u += nblk) attn_m_unit(PROJ, MKV, UM, u & 3, u >> 3, (u >> 2) & 1, lds, wid);
}
__device__ __forceinline__ float slot_sum(const unsigned* ns, int tile, int bj, int wc0, int nwc) { float s = 0.f;
  for (int w = 0; w < nwc; ++w) s += __uint_as_float(__hip_atomic_load(ns + (tile * 2 + bj) * 4 + wc0 + w, __ATOMIC_RELAXED, __HIP_MEMORY_SCOPE_AGENT)); return s; }
__device__ __forceinline__ int window_jmin(float q2k2, float scale, int h, int R0, int NT) {
  const float slope2 = __builtin_amdgcn_exp2f(-(float)(h + 1)) * LOG2E, L = sqrtf(q2k2) * scale * LOG2E * 1.02f, D = (2.f * L + 48.f) / slope2;
  const float x = ((float)R0 - D - 63.f) * (1.f / 64.f);
  int jm = (int)floorf(x) - 1; jm = jm < 0 ? 0 : jm; jm &= ~1; return jm > NT - 2 ? NT - 2 : jm;
}
__device__ __forceinline__ int jmin_b(const unsigned* ns, int h, int qb) {
  const int bj = h & 1; float m = 0.f;
  for (int c = 0; c < 2; ++c) { const float v = slot_sum(ns, 20 + (h >> 1), bj, 2 * c, 2) * slot_sum(ns, 24 + (h >> 1), bj, 2 * c, 2); m = fmaxf(m, v); }
  return window_jmin(m, 0.125f, h, qb * 128, 2 * qb + 2);
}
constexpr int NUNITS_AB = 512;
__device__ __forceinline__ void build_order(const unsigned* ns, unsigned* order, LAS unsigned char* lds, const int lane) {
  LAS int* cost = (LAS int*)lds;
  for (int u = lane; u < NUNITS_AB; u += 64) { int jm, cst;
    { const int h = u & 7, qb = u >> 3; jm = jmin_b(ns, h, qb); cst = 2 * qb + 2 - jm; }
    cost[u] = cst; cost[NUNITS_AB + u] = jm; }
  asm volatile("s_waitcnt lgkmcnt(0)" ::: "memory"); __builtin_amdgcn_wave_barrier();
  for (int u = lane; u < NUNITS_AB; u += 64) { const int cu = cost[u]; int rank = 0;
    for (int v = 0; v < NUNITS_AB; ++v) { const int cv = cost[v]; rank += (cv > cu || (cv == cu && v < u)) ? 1 : 0; }
    order[rank] = (unsigned)u | ((unsigned)cost[NUNITS_AB + u] << 16); }
}
__device__ __forceinline__ void attn_ab_phase(const Args& a, LAS unsigned char* lds, int blk, int nblk, const int wid) {
  const bf16_t* PROJ = (const bf16_t*)(a.ws + WS_PROJ); bf16_t* UA = (bf16_t*)(a.ws + WS_U); bf16_t* UB = UA + (size_t)S * 1024;
  { const unsigned long long* MASK = (const unsigned long long*)(a.ws + WS_SEL);
    for (int u = blk; u < 256; u += nblk) attn_a_unit(PROJ, MASK, UA, u & 7, 31 - (u >> 3), 0, lds, wid); }
  const unsigned* order = (const unsigned*)(a.ws + WS_CTL + 4096); unsigned* qctr = (unsigned*)(a.ws + WS_CTL + 320);
  LAS unsigned* slot = (LAS unsigned*)(lds + 147456 - 64);
  for (;;) {
    if (wid == 0) { if (lane_id_v() == 0) slot[0] = __hip_atomic_fetch_add(qctr, 1u, __ATOMIC_RELAXED, __HIP_MEMORY_SCOPE_AGENT); }
    __syncthreads();
    const unsigned i = slot[0];
    __syncthreads();
    if (i >= 512u) break;
    const unsigned e = order[i]; const int u = (int)(e & 0xffffu), jm = (int)(e >> 16);
    attn_b_unit(PROJ, UB, a.in[9], ((const float*)(a.ws + WS_CTL))[0], u & 7, u >> 3, jm, lds, wid);
  }
}
#undef KSWZ
#undef SBAR
}


namespace idx {
typedef short bf16x8 __attribute__((ext_vector_type(8)));
typedef float f32x16 __attribute__((ext_vector_type(16)));
constexpr int NUNIT = 8 * (16 * 17 / 2);
__device__ __forceinline__ void scores_phase(const bf16_t* __restrict__ PROJ, float* SC, LAS unsigned char* lds, int blk, int nblk, const int wid) {
  const int lane = lane_id_v(), tid = wid * 64 + lane, n32 = lane & 31, hi = lane >> 5;
  const int skey = tid >> 3, schunk = tid & 7;
  const int swr = skey * 128 + ((schunk ^ (skey & 7)) << 4);
  for (int u = blk; u < NUNIT; u += nblk) {
    int g = 0, rem = u; while (rem >= 8 * (g + 1)) { rem -= 8 * (g + 1); ++g; }
    const int qc = 8 * g + rem / (g + 1), kc = rem % (g + 1);
    const int q0 = 64 * qc + 8 * wid, k_begin = 512 * kc, k_end = min(512 * kc + 512, 64 * qc + 64), ntile = (k_end - k_begin) / 64;
    bf16x8 af[4][4]; float w[4][16];
    const int head = (n32 & 3) + 4 * (n32 >> 3), qbit = (n32 >> 2) & 1;
#pragma unroll
    for (int t = 0; t < 4; ++t) {
      const bf16_t* qp = PROJ + (size_t)(q0 + 2 * t + qbit) * NPAD + C_QI + head * 64 + hi * 8;
#pragma unroll
      for (int ks = 0; ks < 4; ++ks) af[t][ks] = *(const bf16x8*)(qp + ks * 16);
      const bf16_t* wp = PROJ + (size_t)(q0 + 2 * t + hi) * NPAD + C_WI;
      const u32x4 w0 = *(const u32x4*)wp, w1 = *(const u32x4*)(wp + 8);
      const unsigned ww[8] = {w0.x, w0.y, w0.z, w0.w, w1.x, w1.y, w1.z, w1.w};
#pragma unroll
      for (int i = 0; i < 8; ++i) { w[t][2 * i] = bflo(ww[i]) * 0.03125f; w[t][2 * i + 1] = bfhi(ww[i]) * 0.03125f; }
    }
    u32x4 st = *(const u32x4*)(PROJ + (size_t)(k_begin + skey) * NPAD + C_KI + schunk * 8);
    __syncthreads();
    *(LAS u32x4*)(lds + swr) = st;
    __syncthreads();
    for (int tl = 0; tl < ntile; ++tl) {
      LAS const unsigned char* kb = lds + (tl & 1) * 8192;
      if (tl + 1 < ntile) st = *(const u32x4*)(PROJ + (size_t)(k_begin + 64 * (tl + 1) + skey) * NPAD + C_KI + schunk * 8);
#pragma unroll
      for (int kh = 0; kh < 2; ++kh) {
        const int krow = kh * 32 + n32;
        bf16x8 bfr[4];
#pragma unroll
        for (int ks = 0; ks < 4; ++ks) bfr[ks] = *(LAS const bf16x8*)(kb + krow * 128 + (((2 * ks + hi) ^ (krow & 7)) << 4));
        const int s = k_begin + 64 * tl + krow;
#pragma unroll
        for (int t = 0; t < 4; ++t) {
          f32x16 acc = {};
#pragma unroll
          for (int ks = 0; ks < 4; ++ks) acc = __builtin_amdgcn_mfma_f32_32x32x16_bf16(af[t][ks], bfr[ks], acc, 0, 0, 0);
          float sc = 0.f;
#pragma unroll
          for (int r = 0; r < 16; ++r) sc = fmaf(fmaxf(acc[r], 0.f), w[t][r], sc);
          const int q = q0 + 2 * t + hi;
          if (s <= q) SC[sc_off(q) + s] = sc;
        }
      }
      if (tl + 1 < ntile) { *(LAS u32x4*)(lds + ((tl + 1) & 1) * 8192 + swr) = st; }
      __syncthreads();
    }
  }
}
}

#ifdef DBG_STAGE
__device__ __forceinline__ void dbg_dump(const Args& a, int blk, int nblk) {
    const bf16_t* PROJ = (const bf16_t*)(a.ws + WS_PROJ);
    for (size_t idx = (size_t)blk * 512 + threadIdx.x; idx < (size_t)S * DM; idx += (size_t)nblk * 512) {
        const int r = (int)(idx / DM), c = (int)(idx % DM); float v = 0.f;
#if DBG_STAGE == 1 && defined(DBG_WEIGHTS)
        for (int z = 0; z < 3; ++z) v += bf2f(((const bf16_t*)(a.ws + WS_WTBR))[((size_t)z * 2048 + (r & 2047)) * 1024 + (c & 1023)]);
        v += bf2f(((const bf16_t*)(a.ws + WS_WTOUT))[(size_t)(r & 2047) * 2048 + c]);
#elif DBG_STAGE == 1 && defined(DBG_GATES)
        for (int j = 0; j < 3; ++j) v += bf2f(PROJ[(size_t)r * NPAD + C_GL + c + 2048 * j]);
#elif DBG_STAGE == 1
        for (int j = 0; j < 8; ++j) v += bf2f(PROJ[(size_t)r * NPAD + c + 2048 * j]);
        if (c < 1280) v += bf2f(PROJ[(size_t)r * NPAD + 16384 + c]);
        if (r < 256) v += bf2f(((const bf16_t*)(a.ws + WS_MKV))[(size_t)r * 2048 + c]);
        for (int z = 0; z < 3; ++z) v += bf2f(((const bf16_t*)(a.ws + WS_WTBR))[((size_t)z * 2048 + (r & 2047)) * 1024 + (c & 1023)]);
        v += bf2f(((const bf16_t*)(a.ws + WS_WTOUT))[(size_t)(r & 2047) * 2048 + c]);
#elif DBG_STAGE == 2
        if (c < 1024) v = bf2f(((const bf16_t*)(a.ws + WS_U))[(size_t)(S + r) * 1024 + c]) + bf2f(((const bf16_t*)(a.ws + WS_U))[(size_t)(2 * S + r) * 1024 + c]);
        else { const float* row = (const float*)(a.ws + WS_SC) + sc_off(r); for (int j = c - 1024; j <= r; j += 1024) v += row[j]; }
#elif DBG_STAGE == 3
        if (c < 256) v = (float)((const int*)(a.ws + WS_SEL))[(size_t)r * 256 + c];
#elif DBG_STAGE == 4
        if (c < 1024) v = bf2f(((const bf16_t*)(a.ws + WS_U))[(size_t)r * 1024 + c]);
#elif DBG_STAGE == 5
        v = bf2f(((const bf16_t*)(a.ws + WS_MERGED))[(size_t)r * DM + c]);
#endif
        a.out[idx] = v;
    }
}
#endif

__device__ __forceinline__ void grid_bar(unsigned* cnt, unsigned target, const int wave) {
    asm volatile("s_waitcnt vmcnt(0)" ::: "memory");
    __syncthreads();
    if (wave == 0) {
        if (lane_id_v() == 0) {
            __builtin_amdgcn_fence(__ATOMIC_RELEASE, "agent");
            asm volatile("s_waitcnt vmcnt(0)" ::: "memory");
            __hip_atomic_fetch_add(cnt, 1u, __ATOMIC_RELAXED, __HIP_MEMORY_SCOPE_AGENT);
            while (__hip_atomic_load(cnt, __ATOMIC_RELAXED, __HIP_MEMORY_SCOPE_AGENT) < target) __builtin_amdgcn_s_sleep(2);
            __builtin_amdgcn_fence(__ATOMIC_ACQUIRE, "agent");
            asm volatile("s_waitcnt vmcnt(0)" ::: "memory");
        }
    }
    __syncthreads();
}

constexpr int LDS_BYTES = 147456;
constexpr int NPHASE = 8;
__global__ void __launch_bounds__(512, 2) fwd(Args a) {
    extern __shared__ __attribute__((aligned(16))) unsigned char lds_raw[];
    LAS unsigned char* lds = (LAS unsigned char*)lds_raw;
    cg::grid_group grid = cg::this_grid();
    const int blk = blockIdx.x, nblk = gridDim.x, wave = __builtin_amdgcn_readfirstlane(threadIdx.x >> 6);
    unsigned char* ws = a.ws;
    const bf16_t* PROJ = (const bf16_t*)(ws + WS_PROJ);
#define IN(k) (a.ph_lo <= (k) && (k) < a.ph_hi)
#define SEAM(k) do { if (IN(k) && IN((k) + 1)) { if ((k) == 0) grid.sync(); else grid_bar((unsigned*)(ws + WS_CTL + 256), (unsigned)nblk * (unsigned)(k), wave); } } while (0)
    if (IN(0)) { p0_prologue(a, lds, blk, nblk, wave); } SEAM(0);
    if (IN(1)) {
        pg8::Gemm g{(const bf16_t*)(ws + WS_H), (const bf16_t*)(ws + WS_WTIN), S, NPAD, DM, (long)WS_MEMN - (long)WS_H, (long)WS_WTMKV - (long)WS_WTIN};
        pg8::ProjOrder so; so.init(S, NPAD, nblk, blk);
        pg8::EpiProj E{(bf16_t*)(ws + WS_PROJ), NPAD, (bf16_t*)(ws + WS_MKV), 2048, a.in[4], C_GL / 256, (unsigned*)(ws + WS_CTL + 1024)};
        pg8::gemm_phase<pg8::EpiProj, pg8::ProjOrder, true, true>(lds, g, so, E, wave);
    } SEAM(1);
    if (IN(2)) { idx::scores_phase(PROJ, (float*)(ws + WS_SC), lds, blk, nblk, wave); __syncthreads(); att::attn_m_phase(a, lds, blk, nblk, wave); } SEAM(2);
    if (IN(3)) { if (blk == nblk - 1) { if (wave == 7) att::build_order((const unsigned*)(ws + WS_CTL + 1024), (unsigned*)(ws + WS_CTL + 4096), lds + 131072, lane_id_v()); }
                 topk_select((const float*)(ws + WS_SC), (int*)(ws + WS_SEL), lds, blk, nblk, wave); } SEAM(3);
    if (IN(4)) { att::attn_ab_phase(a, lds, blk, nblk, wave); } SEAM(4);
    if (IN(5)) {
        pg8::Gemm g{(const bf16_t*)(ws + WS_U), (const bf16_t*)(ws + WS_WTBR), S, DM, 1024, (long)S * 1024 * 2, (long)2048 * 1024 * 2};
        pg8::MergeOrder so; so.init(S, DM, nblk, blk);
        pg8::EpiMerge E{PROJ + C_GL, NPAD, (float*)(ws + WS_T), (bf16_t*)(ws + WS_MERGED), DM};
        pg8::gemm_phase<pg8::EpiMerge, pg8::MergeOrder, true, true>(lds, g, so, E, wave);
    } SEAM(5);
    if (IN(6)) {
        pg8::Gemm g{(const bf16_t*)(ws + WS_MERGED), (const bf16_t*)(ws + WS_WTOUT), S, DM, DM, 0, 0};
        pg8::StaticOrder so; so.init(S, DM, nblk, blk);
        pg8::EpiOut E{a.in[0], a.out, DM, (float*)(ws + WS_PART), S};
        pg8::gemm_phase<pg8::EpiOut, pg8::StaticOrder, false, true>(lds, g, so, E, wave);
    } SEAM(6);
    if (IN(7)) { final_norm(a, blk, nblk, wave); }
#ifdef DBG_STAGE
    if (IN(8)) { dbg_dump(a, blk, nblk); }
#endif
#undef IN
#undef SEAM
}

#ifndef N_LAUNCH_MODE
#define N_LAUNCH_MODE 0
#endif
extern "C" void kernel_launch(void* const* d_in, const int* in_sizes, int n_in, void* d_out, int out_size, void* d_ws, size_t ws_size, hipStream_t stream) {
    static int grid = 0;
    if (grid == 0) {
        if (n_in != 17 || in_sizes[0] != S * DM || in_sizes[3] != DM * DIN || out_size != S * DM || ws_size < WS_END) {
            fprintf(stderr, "kernel_launch: unexpected shapes (n_in %d, in0 %d, in3 %d, out %d, ws %zu < %zu)\n", n_in, n_in > 0 ? in_sizes[0] : -1, n_in > 3 ? in_sizes[3] : -1, out_size, ws_size, (size_t)WS_END); grid = -1; return; }
        int dev = 0, cus = 0, per_cu = 0;
        (void)hipGetDevice(&dev); (void)hipDeviceGetAttribute(&cus, hipDeviceAttributeMultiprocessorCount, dev);
        if (hipFuncSetAttribute((const void*)fwd, hipFuncAttributeMaxDynamicSharedMemorySize, LDS_BYTES) != hipSuccess) { fprintf(stderr, "kernel_launch: hipFuncSetAttribute failed\n"); grid = -1; return; }
        if (hipOccupancyMaxActiveBlocksPerMultiprocessor(&per_cu, (const void*)fwd, 512, LDS_BYTES) != hipSuccess || per_cu < 1) { fprintf(stderr, "kernel_launch: occupancy query gave %d\n", per_cu); per_cu = 1; }
        (void)hipGetLastError();
        grid = cus * 1;
        if (grid > cus * per_cu) grid = cus * per_cu;
        if (grid < 8) grid = -1;
    }
    if (grid < 0) return;
    Args a{};
    for (int i = 0; i < 17; ++i) a.in[i] = (const float*)d_in[i];
    a.out = (float*)d_out; a.ws = (unsigned char*)d_ws;
#if N_LAUNCH_MODE == 1
    (void)hipMemsetAsync((unsigned char*)d_ws + WS_CTL + 256, 0, 256, stream);
    a.ph_lo = 0; a.ph_hi = NPHASE;
    void* kargs[] = {&a};
    hipError_t e = hipLaunchCooperativeKernel((const void*)fwd, dim3(grid), dim3(512), kargs, LDS_BYTES, stream);
    if (e != hipSuccess) fprintf(stderr, "cooperative launch failed: %s (grid %d)\n", hipGetErrorString(e), grid);
#else
#ifdef DBG_STAGE
    #ifdef DBG_WEIGHTS
    constexpr int last_ph[6] = {0, 0, 2, 3, 4, 5};
#else
    constexpr int last_ph[6] = {0, 1, 2, 3, 4, 5};
#endif
    for (int p = 0; p <= last_ph[DBG_STAGE]; ++p) { a.ph_lo = p; a.ph_hi = p + 1; hipLaunchKernelGGL(fwd, dim3(grid), dim3(512), LDS_BYTES, stream, a); }
    a.ph_lo = 8; a.ph_hi = 9; hipLaunchKernelGGL(fwd, dim3(grid), dim3(512), LDS_BYTES, stream, a);
#else
    for (int p = 0; p < NPHASE; ++p) {
        a.ph_lo = p; a.ph_hi = p + 1;
        hipLaunchKernelGGL(fwd, dim3(grid), dim3(512), LDS_BYTES, stream, a);
    }
#endif
#endif
}
```

```cpp
#define N_LAUNCH_MODE 1
#include <hip/hip_runtime.h>
#include <hip/hip_cooperative_groups.h>
#include <cstdio>
#include <cstdint>
namespace cg = cooperative_groups;

__device__ __forceinline__ int lane_id_v() { int l; asm volatile("v_mbcnt_lo_u32_b32 %0, -1, 0\n\tv_mbcnt_hi_u32_b32 %0, -1, %0" : "=v"(l)); return l; }
namespace pg8 {
#define PG8_LAS __attribute__((address_space(3)))
typedef unsigned short bf16_t;
typedef short bf16x8 __attribute__((ext_vector_type(8)));
typedef float f32x4 __attribute__((ext_vector_type(4)));
typedef unsigned u32x4 __attribute__((ext_vector_type(4)));
constexpr int BM = 256, BK = 64, HALF = 128, HTB = HALF * BK * 2  , STAGE_BYTES = 8 * HTB, NXCD = 8, WGM = 8;

__host__ __device__ __forceinline__ int lds_byte(int r, int c) { const int st = (r >> 4) * 2 + (c >> 5), rr = r & 15, cc = c & 31, ob = rr * 64 + cc * 2; return st * 1024 + (ob ^ (((ob >> 9) & 1) << 5)); }
__host__ __device__ __forceinline__ void stage_rc(int b, int& R, int& C) { const int st = b / 1024, sb = b % 1024, swz = sb ^ (((sb >> 9) & 1) << 5); R = (st >> 1) * 16 + swz / 64; C = (st & 1) * 32 + (swz % 64) / 2; }
__host__ __device__ __forceinline__ int perm32(int rho) { const int n = rho >> 4, i = rho & 15; return 8 * (i >> 2) + 4 * n + (i & 3); }

struct Unit { int pm, pn, z; };
struct Gemm { const bf16_t* A; const bf16_t* Bt; int M, N, K; long zA, zB; };

struct StaticOrder {
    int nM, nN, nwg, G, c;
    __host__ __device__ void init(int M, int N, int G_, int c_) { nM = M / BM; nN = N / BM; nwg = nM * nN; G = G_; c = c_; }
    __host__ __device__ bool next(int i, Unit& u) const {
        const long L = (long)i * G + c; if (L >= nwg) return false;
        int wgid = (int)L; { const int q = nwg / NXCD, r = nwg % NXCD, xcd = wgid % NXCD, off = wgid / NXCD; wgid = (xcd < r ? xcd * (q + 1) : r * (q + 1) + (xcd - r) * q) + off; }
        const int nig = WGM * nN, gid = wgid / nig, fm = gid * WGM, gsz = (nM - fm) < WGM ? (nM - fm) : WGM;
        u.pm = fm + ((wgid % nig) % gsz); u.pn = (wgid % nig) / gsz; u.z = 0; return true;
    }
    __device__ __forceinline__ void a_ready(const Unit&) const {}
    __device__ __forceinline__ void done(const Unit&) const {}
};

typedef float f32x2_t __attribute__((ext_vector_type(2))); typedef __bf16 bf16x2_t __attribute__((ext_vector_type(2)));
__device__ __forceinline__ unsigned cvt_pk_bf16(float lo, float hi) { f32x2_t v = {lo, hi}; bf16x2_t b = __builtin_convertvector(v, bf16x2_t); return __builtin_bit_cast(unsigned, b); }

__device__ __forceinline__ float bf2f(unsigned short u) { return __uint_as_float((unsigned)u << 16); }
__device__ __forceinline__ float sigmoidf_(float v) { return __builtin_amdgcn_rcpf(1.0f + __builtin_amdgcn_exp2f(-1.4426950408889634f * v)); }
template <int MODE> __device__ __forceinline__ float act_(float v, float b) {
    if (MODE == 1) return v * sigmoidf_(v);
    if (MODE == 2) return sigmoidf_(v + b);
    return v;
}
struct EpiProj {
    static constexpr bool PERM = true, AFTER_DRAIN = false, KEEP_ACC = false;
    bf16_t* O; int ldc; bf16_t* O1; int ldc1; const float* bgate; int gate_tile0;
    unsigned* nslot;
    __device__ __forceinline__ void norms(const f32x4 (&acc)[2][2][4][2], const Unit& u, int wc, int lane) const {
        float wm[2] = {0.f, 0.f};
#pragma unroll
        for (int ai = 0; ai < 2; ++ai)
#pragma unroll
            for (int m = 0; m < 4; ++m)
#pragma unroll
                for (int bj = 0; bj < 2; ++bj) { const f32x4 a = acc[ai][bj][m][0], c = acc[ai][bj][m][1];
                    float s = (a[0] * a[0] + a[1] * a[1]) + (a[2] * a[2] + a[3] * a[3]) + (c[0] * c[0] + c[1] * c[1]) + (c[2] * c[2] + c[3] * c[3]);
                    s += __shfl_xor(s, 16); s += __shfl_xor(s, 32); wm[bj] = fmaxf(wm[bj], s); }
#pragma unroll
        for (int bj = 0; bj < 2; ++bj) { float v = wm[bj]; v = fmaxf(v, __shfl_xor(v, 1)); v = fmaxf(v, __shfl_xor(v, 2)); v = fmaxf(v, __shfl_xor(v, 4)); v = fmaxf(v, __shfl_xor(v, 8));
            if (lane == 0) atomicMax(nslot + (u.pn * 2 + bj) * 4 + wc, __float_as_uint(v)); }
    }
    template <int MODE> __device__ __forceinline__ void put(const f32x4 (&acc)[2][2][4][2], bf16_t* base, int ld, int row0, int col0, const float* bias) const {
        f32x4 bv[2][2];
#pragma unroll
        for (int bj = 0; bj < 2; ++bj)
#pragma unroll
            for (int n = 0; n < 2; ++n) bv[bj][n] = (MODE == 2) ? *(const f32x4*)(bias + bj * HALF + 4 * n) : (f32x4){0.f, 0.f, 0.f, 0.f};
#pragma unroll
        for (int ai = 0; ai < 2; ++ai)
#pragma unroll
            for (int m = 0; m < 4; ++m) { bf16_t* rowp = base + (size_t)(row0 + ai * HALF + m * 16) * ld + col0;
#pragma unroll
                for (int bj = 0; bj < 2; ++bj) { f32x4 v0 = acc[ai][bj][m][0], v1 = acc[ai][bj][m][1];
#pragma unroll
                    for (int e = 0; e < 4; ++e) { v0[e] = act_<MODE>(v0[e], bv[bj][0][e]); v1[e] = act_<MODE>(v1[e], bv[bj][1][e]); }
                    u32x4 w; w.x = cvt_pk_bf16(v0[0], v0[1]); w.y = cvt_pk_bf16(v0[2], v0[3]); w.z = cvt_pk_bf16(v1[0], v1[1]); w.w = cvt_pk_bf16(v1[2], v1[3]);
                    *(u32x4*)(rowp + bj * HALF) = w; } }
    }
    __device__ __forceinline__ void operator()(const f32x4 (&acc)[2][2][4][2], const Unit& u, int wr, int wc, int fr, int fq) const {
        const int row0 = u.pm * BM + wr * 64 + fr, col0 = u.pn * BM + wc * 32 + 8 * fq;
        if (u.z == 1) { put<0>(acc, O1, ldc1, row0, col0, nullptr); return; }
        const int t = u.pn;
        if (t < 8 || (t >= 20 && t < 28)) norms(acc, u, wc, fr + 16 * fq);
        const bool is_silu = (t >= 12 && t < 16) || (t >= 32 && t < 36) || (t >= 40 && t < 44);
        if (t >= gate_tile0 && t < 68) put<2>(acc, O, ldc, row0, col0, bgate + (col0 - gate_tile0 * BM));
        else if (is_silu) put<1>(acc, O, ldc, row0, col0, nullptr);
        else put<0>(acc, O, ldc, row0, col0, nullptr);
    }
};
struct EpiMerge {
    static constexpr bool PERM = true, AFTER_DRAIN = false, KEEP_ACC = true;
    const bf16_t* G; int ldg;
    bf16_t* O; int ldc;
    __device__ __forceinline__ static void unpack8(const u32x4 gw, f32x4& g0, f32x4& g1) {
        g0[0] = __uint_as_float(gw.x << 16); g0[1] = __uint_as_float(gw.x & 0xffff0000u); g0[2] = __uint_as_float(gw.y << 16); g0[3] = __uint_as_float(gw.y & 0xffff0000u);
        g1[0] = __uint_as_float(gw.z << 16); g1[1] = __uint_as_float(gw.z & 0xffff0000u); g1[2] = __uint_as_float(gw.w << 16); g1[3] = __uint_as_float(gw.w & 0xffff0000u); }
    __device__ __forceinline__ void operator()(f32x4 (&acc)[2][2][4][2], const Unit& u, int wr, int wc, int fr, int fq) const {
        const int row0 = u.pm * BM + wr * 64 + fr, col0 = u.pn * BM + wc * 32 + 8 * fq;
#pragma unroll
        for (int ai = 0; ai < 2; ++ai) {
            u32x4 ga[4][2], gb[4][2];
#pragma unroll
            for (int m = 0; m < 4; ++m)
#pragma unroll
                for (int bj = 0; bj < 2; ++bj) { const bf16_t* gp = G + (size_t)(row0 + ai * HALF + m * 16) * ldg + (size_t)u.z * 2048 + col0 + bj * HALF;
                    ga[m][bj] = *(const u32x4*)gp; gb[m][bj] = (u.z < 2) ? *(const u32x4*)(gp + 2048) : (u32x4){0u, 0u, 0u, 0u}; }
#pragma unroll
            for (int m = 0; m < 4; ++m) { const size_t row = (size_t)(row0 + ai * HALF + m * 16);
#pragma unroll
                for (int bj = 0; bj < 2; ++bj) { const int col = col0 + bj * HALF;
                    f32x4 a0, a1; unpack8(ga[m][bj], a0, a1);
                    f32x4 r0, r1;
                    if (u.z < 2) { f32x4 n0, n1; unpack8(gb[m][bj], n0, n1);
#pragma unroll
                        for (int e = 0; e < 4; ++e) { const float d0 = fmaxf(n0[e], 1e-30f), d1 = fmaxf(n1[e], 1e-30f);
                            const float x0 = (u.z == 0) ? a0[e] : fmaxf(a0[e], 1e-30f), x1 = (u.z == 0) ? a1[e] : fmaxf(a1[e], 1e-30f);
                            r0[e] = x0 * __builtin_amdgcn_rcpf(d0); r1[e] = x1 * __builtin_amdgcn_rcpf(d1); }
                        acc[ai][bj][m][0] *= r0; acc[ai][bj][m][1] *= r1;
                    } else {
#pragma unroll
                        for (int e = 0; e < 4; ++e) { r0[e] = fmaxf(a0[e], 1e-30f); r1[e] = fmaxf(a1[e], 1e-30f); }
                        const f32x4 v0 = acc[ai][bj][m][0] * r0, v1 = acc[ai][bj][m][1] * r1;
                        u32x4 w; w.x = cvt_pk_bf16(v0[0], v0[1]); w.y = cvt_pk_bf16(v0[2], v0[3]); w.z = cvt_pk_bf16(v1[0], v1[1]); w.w = cvt_pk_bf16(v1[2], v1[3]);
                        *(u32x4*)(O + row * ldc + col) = w;
                        acc[ai][bj][m][0] = (f32x4){0.f, 0.f, 0.f, 0.f}; acc[ai][bj][m][1] = (f32x4){0.f, 0.f, 0.f, 0.f}; } } }
        }
    }
};
struct EpiOut {
    static constexpr bool PERM = false, AFTER_DRAIN = false, KEEP_ACC = false;
    const float* X; float* Y; int ldc; float* part; int M;
    __device__ __forceinline__ void operator()(const f32x4 (&acc)[2][2][4][2], const Unit& u, int wr, int wc, int fr, int fq) const {
        const int row0 = u.pm * BM + wr * 64 + fr, col0 = u.pn * BM + wc * 32 + 4 * fq;
#pragma unroll
        for (int ai = 0; ai < 2; ++ai) {
            f32x4 xv[4][2][2];
#pragma unroll
            for (int m = 0; m < 4; ++m)
#pragma unroll
                for (int bj = 0; bj < 2; ++bj)
#pragma unroll
                    for (int n = 0; n < 2; ++n) xv[m][bj][n] = *(const f32x4*)(X + (size_t)(row0 + ai * HALF + m * 16) * ldc + col0 + bj * HALF + n * 16);
#pragma unroll
            for (int m = 0; m < 4; ++m) { const size_t row = (size_t)(row0 + ai * HALF + m * 16); float ss = 0.f;
#pragma unroll
                for (int bj = 0; bj < 2; ++bj)
#pragma unroll
                    for (int n = 0; n < 2; ++n) { const size_t off = row * ldc + col0 + bj * HALF + n * 16;
                        const f32x4 y = xv[m][bj][n] + acc[ai][bj][m][n]; *(f32x4*)(Y + off) = y;
                        ss += (y[0] * y[0] + y[1] * y[1]) + (y[2] * y[2] + y[3] * y[3]); }
                ss += __shfl_xor(ss, 16); ss += __shfl_xor(ss, 32);
                if (fq == 0) part[(size_t)(u.pn * 4 + wc) * M + row] = ss; }
        }
    }
};
struct ProjOrder {
    StaticOrder so; int nmain, extra;
    __device__ void init(int M, int N, int G, int c) { so.init(M, N, G, c); nmain = (so.nwg - c + G - 1) / G; extra = (c >= G - 8) ? c - (G - 8) : -1; }
    __device__ bool next(int i, Unit& u) const {
        if (i < nmain) return so.next(i, u);
        if (i == nmain && extra >= 0) { u.pm = 0; u.pn = extra; u.z = 1; return true; }
        return false;
    }
    __device__ __forceinline__ void a_ready(const Unit&) const {}
    __device__ __forceinline__ void done(const Unit&) const {}
};
struct MergeOrder {
    StaticOrder so;
    __device__ void init(int M, int N, int G, int c) { so.init(M, N, G, c); }
    __device__ bool next(int i, Unit& u) const { if (i >= 3) return false; if (!so.next(0, u)) return false; u.z = i; return true; }
    __device__ __forceinline__ void a_ready(const Unit&) const {}
    __device__ __forceinline__ void done(const Unit&) const {}
};

template <class Epi, class Sched, bool ALIGN_EPI = false, bool SP2 = false>
__device__ __forceinline__ void gemm_phase(PG8_LAS unsigned char* lds, const Gemm g, const Sched& S, const Epi& E, const int wid  ) {
    const int lane = lane_id_v(), tid = wid * 64 + lane, wr = wid >> 2, wc = wid & 3, fr = lane & 15, fq = lane >> 4;
    const int K = g.K, nt = K / BK;
    unsigned voffA[2], voffB[2];
#pragma unroll
    for (int i = 0; i < 2; ++i) { int R, C; stage_rc(tid * 16 + i * 8192, R, C); const int Rb = Epi::PERM ? ((R & ~31) + perm32(R & 31)) : R;
        voffA[i] = (unsigned)(R * K + C) * 2u; voffB[i] = (unsigned)(Rb * K + C) * 2u; }
    const size_t kstep = (size_t)(BK * 2);
    const size_t hstep = (size_t)HALF * K * 2;
    const size_t tstep = 2 * hstep;
    const unsigned ldsw = (unsigned)wid * 1024u;
    const int aoff = lds_byte(wr * 64 + fr, fq * 8), boff = lds_byte(wc * 32 + fr, fq * 8);
#define PG8_SA(b, h) (((b) * 2 + (h)) * HTB)
#define PG8_SB(b, h) ((4 + (b) * 2 + (h)) * HTB)
#define PG8_STAGE(bufoff, gbase, voff) do { _Pragma("unroll") for (int _i = 0; _i < 2; ++_i) \
        __builtin_amdgcn_global_load_lds((const unsigned*)((const char*)(gbase) + (voff)[_i]), (PG8_LAS unsigned*)(lds + (bufoff) + ldsw + _i * 8192), 16, 0, 0); } while (0)
#define PG8_LDA(dst, b, h) do { _Pragma("unroll") for (int m = 0; m < 4; ++m) _Pragma("unroll") for (int k = 0; k < 2; ++k) dst[m][k] = *(const PG8_LAS bf16x8*)(lds + PG8_SA(b, h) + aoff + m * 2048 + k * 1024); } while (0)
#define PG8_LDB(dst, b, h) do { _Pragma("unroll") for (int n = 0; n < 2; ++n) _Pragma("unroll") for (int k = 0; k < 2; ++k) dst[n][k] = *(const PG8_LAS bf16x8*)(lds + PG8_SB(b, h) + boff + n * 2048 + k * 1024); } while (0)
#define PG8_MMA(ai, bj, At, Bt) do { __builtin_amdgcn_s_setprio(1); _Pragma("unroll") for (int m = 0; m < 4; ++m) _Pragma("unroll") for (int n = 0; n < 2; ++n) _Pragma("unroll") for (int k = 0; k < 2; ++k) \
        acc[ai][bj][m][n] = __builtin_amdgcn_mfma_f32_16x16x32_bf16(Bt[n][k], At[m][k], acc[ai][bj][m][n], 0, 0, 0); __builtin_amdgcn_s_setprio(0); } while (0)
#define PG8_WAIT_V(n) asm volatile("s_waitcnt vmcnt(" #n ")" ::: "memory")
#define PG8_WAIT_L(n) asm volatile("s_waitcnt lgkmcnt(" #n ")" ::: "memory")
#define PG8_BAR __builtin_amdgcn_s_barrier()
#define PG8_SCHED __builtin_amdgcn_sched_barrier(0)
    Unit cur, nxt; int ui = 0;
    if (!S.next(0, cur)) return;
    f32x4 acc[2][2][4][2];
#pragma unroll
    for (int a = 0; a < 2; ++a)
#pragma unroll
        for (int b = 0; b < 2; ++b)
#pragma unroll
            for (int m = 0; m < 4; ++m)
#pragma unroll
                for (int n = 0; n < 2; ++n) acc[a][b][m][n] = (f32x4){0.f, 0.f, 0.f, 0.f};
    bf16x8 At[4][2], B0[2][2], B1[2][2];
    const char* cA = (const char*)g.A + (long)cur.z * g.zA + (size_t)cur.pm * tstep; const char* cB = (const char*)g.Bt + (long)cur.z * g.zB + (size_t)cur.pn * tstep;
    S.a_ready(cur);
    if constexpr (SP2) {
        PG8_STAGE(PG8_SB(0, 0), cB, voffB); PG8_STAGE(PG8_SB(0, 1), cB + hstep, voffB); PG8_STAGE(PG8_SA(0, 0), cA, voffA); PG8_STAGE(PG8_SA(0, 1), cA + hstep, voffA);
        if (wr == 1) PG8_BAR;
        PG8_WAIT_V(2); PG8_BAR;
        PG8_STAGE(PG8_SB(1, 0), cB + kstep, voffB); PG8_STAGE(PG8_SA(1, 0), cA + kstep, voffA); PG8_STAGE(PG8_SB(1, 1), cB + hstep + kstep, voffB);
        PG8_WAIT_V(6); PG8_BAR;
    } else {
        PG8_STAGE(PG8_SB(0, 0), cB, voffB); PG8_STAGE(PG8_SA(0, 0), cA, voffA); PG8_STAGE(PG8_SB(0, 1), cB + hstep, voffB); PG8_STAGE(PG8_SA(0, 1), cA + hstep, voffA);
        if (wr == 1) PG8_BAR;
        PG8_WAIT_V(4); PG8_BAR;
        PG8_STAGE(PG8_SB(1, 0), cB + kstep, voffB); PG8_STAGE(PG8_SA(1, 0), cA + kstep, voffA); PG8_STAGE(PG8_SB(1, 1), cB + hstep + kstep, voffB);
        PG8_WAIT_V(6); PG8_BAR;
    }
    for (;;) {
        const bool has_next = S.next(ui + 1, nxt);
        const char* nA = has_next ? (const char*)g.A + (long)nxt.z * g.zA + (size_t)nxt.pm * tstep : cA; const char* nB = has_next ? (const char*)g.Bt + (long)nxt.z * g.zB + (size_t)nxt.pn * tstep : cB;
        for (int t = 0; t < nt; t += 2) {
            const bool last = (t == nt - 2);
            const char* a1 = cA + (size_t)(t + 1) * kstep;
            const char* a2 = last ? nA : cA + (size_t)(t + 2) * kstep; const char* b2 = last ? nB : cB + (size_t)(t + 2) * kstep;
            const char* a3 = a2 + kstep; const char* b3 = b2 + kstep;
            if (last && has_next) S.a_ready(nxt);
            if constexpr (SP2) {
            PG8_LDB(B0, 0, 0); PG8_LDB(B1, 0, 1); PG8_SCHED; PG8_LDA(At, 0, 0); PG8_STAGE(PG8_SA(1, 1), a1 + hstep, voffA);
            PG8_WAIT_V(8); PG8_WAIT_L(0); PG8_BAR; PG8_MMA(0, 0, At, B0); PG8_MMA(0, 1, At, B1); PG8_BAR; PG8_SCHED;
            PG8_LDA(At, 0, 1); PG8_STAGE(PG8_SB(0, 0), b2, voffB); PG8_STAGE(PG8_SB(0, 1), b2 + hstep, voffB); PG8_STAGE(PG8_SA(0, 0), a2, voffA);
            PG8_WAIT_V(8); PG8_WAIT_L(0); PG8_BAR; PG8_MMA(1, 0, At, B0); PG8_MMA(1, 1, At, B1); PG8_BAR; PG8_SCHED;
            PG8_LDB(B0, 1, 0); PG8_LDB(B1, 1, 1); PG8_SCHED; PG8_LDA(At, 1, 0); PG8_STAGE(PG8_SA(0, 1), a2 + hstep, voffA);
            PG8_WAIT_V(8); PG8_WAIT_L(0); PG8_BAR; PG8_MMA(0, 0, At, B0); PG8_MMA(0, 1, At, B1); PG8_BAR; PG8_SCHED;
            PG8_LDA(At, 1, 1); PG8_STAGE(PG8_SB(1, 0), b3, voffB); PG8_STAGE(PG8_SB(1, 1), b3 + hstep, voffB); PG8_STAGE(PG8_SA(1, 0), a3, voffA);
            PG8_WAIT_V(8); PG8_WAIT_L(0); PG8_BAR; PG8_MMA(1, 0, At, B0); PG8_MMA(1, 1, At, B1); PG8_BAR; PG8_SCHED;
            } else {
            PG8_LDB(B0, 0, 0); PG8_SCHED; PG8_LDA(At, 0, 0); PG8_STAGE(PG8_SA(1, 1), a1 + hstep, voffA);
            PG8_WAIT_L(8); PG8_BAR; PG8_WAIT_L(0); PG8_MMA(0, 0, At, B0); PG8_BAR; PG8_SCHED;
            PG8_LDB(B1, 0, 1); PG8_STAGE(PG8_SB(0, 0), b2, voffB);
            PG8_BAR; PG8_WAIT_L(0); PG8_MMA(0, 1, At, B1); PG8_BAR;
            PG8_LDA(At, 0, 1); PG8_STAGE(PG8_SA(0, 0), a2, voffA);
            PG8_BAR; PG8_WAIT_L(0); PG8_MMA(1, 0, At, B0); PG8_BAR; PG8_SCHED;
            PG8_STAGE(PG8_SB(0, 1), b2 + hstep, voffB);
            PG8_WAIT_V(6); PG8_BAR; PG8_MMA(1, 1, At, B1); PG8_BAR;
            PG8_LDB(B0, 1, 0); PG8_SCHED; PG8_LDA(At, 1, 0); PG8_STAGE(PG8_SA(0, 1), a2 + hstep, voffA);
            PG8_WAIT_L(8); PG8_BAR; PG8_WAIT_L(0); PG8_MMA(0, 0, At, B0); PG8_BAR; PG8_SCHED;
            PG8_LDB(B1, 1, 1); PG8_STAGE(PG8_SB(1, 0), b3, voffB);
            PG8_BAR; PG8_WAIT_L(0); PG8_MMA(0, 1, At, B1); PG8_BAR;
            PG8_LDA(At, 1, 1); PG8_STAGE(PG8_SA(1, 0), a3, voffA);
            PG8_BAR; PG8_WAIT_L(0); PG8_MMA(1, 0, At, B0); PG8_BAR; PG8_SCHED;
            PG8_STAGE(PG8_SB(1, 1), b3 + hstep, voffB);
            PG8_WAIT_V(6); PG8_BAR; PG8_MMA(1, 1, At, B1); PG8_BAR;
            }
        }
        if constexpr (ALIGN_EPI) { if (wr == 0) PG8_BAR; }
        if constexpr (!Epi::AFTER_DRAIN) { E(acc, cur, wr, wc, fr, fq); S.done(cur); }
        if (!has_next) break;
        if constexpr (!Epi::KEEP_ACC) {
#pragma unroll
        for (int a = 0; a < 2; ++a)
#pragma unroll
            for (int b = 0; b < 2; ++b)
#pragma unroll
                for (int m = 0; m < 4; ++m)
#pragma unroll
                    for (int n = 0; n < 2; ++n) acc[a][b][m][n] = (f32x4){0.f, 0.f, 0.f, 0.f};
        }
        cur = nxt; cA = nA; cB = nB; ++ui;
        if constexpr (ALIGN_EPI) { if (wr == 1) PG8_BAR; }
    }
    PG8_WAIT_V(0);
    if constexpr (!ALIGN_EPI) { if (wr == 0) PG8_BAR; }
    PG8_BAR;
    if constexpr (Epi::AFTER_DRAIN) { E.fused(acc, cur, wr, wc, fr, fq, lds, wid, lane); S.done(cur); }
#undef PG8_SA
#undef PG8_SB
#undef PG8_STAGE
#undef PG8_LDA
#undef PG8_LDB
#undef PG8_MMA
#undef PG8_WAIT_V
#undef PG8_WAIT_L
#undef PG8_BAR
#undef PG8_SCHED
}
}

constexpr int S = 8192, DM = 2048, DIN = 17488, NPAD = 17664, NMEM = 256;
constexpr int C_QA = 0, C_KA = 1024, C_VA = 2048, C_ZA = 3072, C_QI = 4096, C_QB = 5120, C_KB = 6144, C_VB = 7168, C_ZB = 8192, C_QM = 9216, C_ZM = 10240, C_GL = 11264, C_KI = 17408, C_WI = 17472;
constexpr int TOPK = 256;
constexpr float RMS_EPS = 1e-6f;
constexpr size_t MiB = 1u << 20;
constexpr size_t WS_CTL = 0;
constexpr size_t WS_WTIN = 1 * MiB;
constexpr size_t WS_U = 1 * MiB;
constexpr size_t WS_WTMKV = 70 * MiB;
constexpr size_t WS_WTBR = 78 * MiB;
constexpr size_t WS_WTOUT = 90 * MiB;
constexpr size_t WS_MEMN = 98 * MiB;
constexpr size_t WS_MKV = 99 * MiB;
constexpr size_t WS_PROJ = 100 * MiB;
constexpr size_t WS_SC = 376 * MiB;
constexpr size_t WS_MERGED = 376 * MiB;
constexpr size_t WS_H = 376 * MiB;
constexpr size_t WS_T = 408 * MiB;
constexpr size_t WS_SEL = 508 * MiB;
constexpr size_t WS_PART = 516 * MiB;
constexpr size_t WS_END = 517 * MiB;

typedef unsigned short bf16_t;
typedef unsigned u32x4 __attribute__((ext_vector_type(4)));
typedef unsigned u32x2 __attribute__((ext_vector_type(2)));
typedef float f32x4 __attribute__((ext_vector_type(4)));
#define LAS __attribute__((address_space(3)))
__device__ __forceinline__ float bf2f(unsigned short u) { return __uint_as_float((unsigned)u << 16); }
__device__ __forceinline__ float bflo(unsigned w) { return __uint_as_float(w << 16); }
__device__ __forceinline__ float bfhi(unsigned w) { return __uint_as_float(w & 0xffff0000u); }
__device__ __forceinline__ unsigned f2bf(float f) { unsigned u = __float_as_uint(f); return (u + 0x7fffu + ((u >> 16) & 1u)) >> 16; }
__device__ __forceinline__ unsigned pk2(float lo, float hi) { return f2bf(lo) | (f2bf(hi) << 16); }
__device__ __forceinline__ float wave_sum(float v) {
#pragma unroll
    for (int o = 1; o < 64; o <<= 1) v += __shfl_xor(v, o);
    return v;
}
__device__ __forceinline__ size_t sc_off(int r) { const size_t i = (size_t)(r >> 8); return 65536ull * (i * (i + 1) / 2) + (size_t)(r & 255) * 256ull * (i + 1); }

struct Args { const float* in[17]; float* out; unsigned char* ws; int ph_lo, ph_hi; };

template <bool MAPIN>
__device__ __forceinline__ void transpose_item(const float* __restrict__ W, int K, int srcN, bf16_t* WT, LAS float* scr, int item, int ndst, int lane) {
    const int nblk = ndst / 32, kb = item / nblk, nb = item % nblk, k0 = 64 * kb, n0 = 32 * nb;
    const int n = n0 + (lane & 31);
    int src = n;
    if (MAPIN) { src = (n < 5120) ? n : (n < 17408) ? n + 80 : (n < 17488) ? n - 17408 + 5120 : -1; }
    float tv[32];
#pragma unroll
    for (int i = 0; i < 32; ++i) { const int kk = 2 * i + (lane >> 5); tv[i] = (src >= 0) ? W[(size_t)(k0 + kk) * srcN + src] : 0.f; }
#pragma unroll
    for (int i = 0; i < 32; ++i) { const int kk = 2 * i + (lane >> 5); scr[kk * 33 + (lane & 31)] = tv[i]; }
    asm volatile("s_waitcnt lgkmcnt(0)" ::: "memory");
    const int c = lane & 7;
#pragma unroll
    for (int j = 0; j < 4; ++j) { const int nn = (lane >> 3) + 8 * j; const LAS float* s = scr + (8 * c) * 33 + nn;
        u32x4 o; o.x = pk2(s[0 * 33], s[1 * 33]); o.y = pk2(s[2 * 33], s[3 * 33]); o.z = pk2(s[4 * 33], s[5 * 33]); o.w = pk2(s[6 * 33], s[7 * 33]);
        *(u32x4*)(WT + (size_t)(n0 + nn) * K + k0 + 8 * c) = o; }
    asm volatile("s_waitcnt lgkmcnt(0)" ::: "memory");
}
__device__ __forceinline__ void rms_row_to_bf16(const float* __restrict__ xrow, const float* __restrict__ g, bf16_t* orow, int lane) {
    const f32x4* xr = (const f32x4*)xrow + lane; const f32x4* gr = (const f32x4*)g + lane;
    f32x4 v[8]; float s = 0.f;
#pragma unroll
    for (int j = 0; j < 8; ++j) { v[j] = xr[64 * j]; s += (v[j].x * v[j].x + v[j].y * v[j].y) + (v[j].z * v[j].z + v[j].w * v[j].w); }
    const float rs = 1.0f / sqrtf(wave_sum(s) * (1.f / DM) + RMS_EPS);
    u32x2* o8 = (u32x2*)orow + lane;
#pragma unroll
    for (int j = 0; j < 8; ++j) { const f32x4 gg = gr[64 * j]; u32x2 w; w.x = pk2(v[j].x * rs * gg.x, v[j].y * rs * gg.y); w.y = pk2(v[j].z * rs * gg.z, v[j].w * rs * gg.w); o8[64 * j] = w; }
}
__device__ __forceinline__ void p0_prologue(const Args& a, LAS unsigned char* lds, int blk, int nblk, const int wave) {
    const int lane = lane_id_v(), tid = wave * 64 + lane;
    LAS float* scr = (LAS float*)(lds + wave * 16384);
    const int gw = blk * 8 + wave, NGW = nblk * 8;
    unsigned char* ws = a.ws;
    constexpr int I_IN = (DM / 64) * (NPAD / 32), I_MKV = (DM / 64) * (2048 / 32), I_BR = (1024 / 64) * (2048 / 32), I_OUT = (DM / 64) * (2048 / 32);
    constexpr int NITEMS = I_IN + I_MKV + 3 * I_BR + I_OUT;
    for (int it = gw; it < NITEMS; it += NGW) {
        int r = it;
        if (r < I_IN) { transpose_item<true>(a.in[3], DM, DIN, (bf16_t*)(ws + WS_WTIN), scr, r, NPAD, lane); continue; } r -= I_IN;
        if (r < I_MKV) { transpose_item<false>(a.in[11], DM, 2048, (bf16_t*)(ws + WS_WTMKV), scr, r, 2048, lane); continue; } r -= I_MKV;
        if (r < 3 * I_BR) { const int z = r / I_BR; transpose_item<false>(a.in[12 + z], 1024, 2048, (bf16_t*)(ws + WS_WTBR) + (size_t)z * 2048 * 1024, scr, r % I_BR, 2048, lane); continue; } r -= 3 * I_BR;
        transpose_item<false>(a.in[15], DM, 2048, (bf16_t*)(ws + WS_WTOUT), scr, r, 2048, lane);
    }
    bf16_t* H = (bf16_t*)(ws + WS_H);
    for (int m = gw; m < S + NMEM; m += NGW) {
        if (m < S) rms_row_to_bf16(a.in[0] + (size_t)m * DM, a.in[2], H + (size_t)m * DM, lane);
        else rms_row_to_bf16(a.in[1] + (size_t)(m - S) * DM, a.in[10], (bf16_t*)(ws + WS_MEMN) + (size_t)(m - S) * DM, lane);
    }
    if (blk == 0) { for (int i = tid; i < 640; i += 512) ((unsigned*)(ws + WS_CTL + 1024))[i] = 0u; }
    if (blk == 0 && wave == 0) {
        const float s1 = wave_sum(a.in[5][lane] * a.in[6][lane]), s2 = wave_sum(a.in[7][lane] * a.in[8][lane]);
        if (lane == 0) ((float*)(ws + WS_CTL))[0] = expf(s1) - expf(s2) + 0.2f;
    }
}

__device__ __forceinline__ void idx_scores_naive(const bf16_t* __restrict__ PROJ, float* SC, LAS unsigned char* lds, int blk, int nblk, const int wave) {
    const int lane = lane_id_v(), tid = wave * 64 + lane;
    LAS float* qs = (LAS float*)lds + wave * 1088;
    constexpr int NITEM = 128 * 129 / 2;
    for (int it = blk; it < NITEM; it += nblk) {
        int kb = 0, rem = it; while (rem >= 128 - kb) { rem -= 128 - kb; ++kb; }
        const int qc = kb + rem, s = 64 * kb + lane;
        float kreg[64];
        { const u32x4* kp = (const u32x4*)(PROJ + (size_t)s * NPAD + C_KI);
#pragma unroll
          for (int i = 0; i < 8; ++i) { const u32x4 w = kp[i]; kreg[8 * i + 0] = bflo(w.x); kreg[8 * i + 1] = bfhi(w.x); kreg[8 * i + 2] = bflo(w.y); kreg[8 * i + 3] = bfhi(w.y);
              kreg[8 * i + 4] = bflo(w.z); kreg[8 * i + 5] = bfhi(w.z); kreg[8 * i + 6] = bflo(w.w); kreg[8 * i + 7] = bfhi(w.w); } }
        for (int qq = 0; qq < 8; ++qq) {
            const int q = 64 * qc + wave * 8 + qq;
            { const u32x4* qp = (const u32x4*)(PROJ + (size_t)q * NPAD + C_QI) + 2 * lane;
              const u32x4 w0 = qp[0], w1 = qp[1];
              LAS f32x4* dst = (LAS f32x4*)(qs + 16 * lane);
              dst[0] = (f32x4){bflo(w0.x), bfhi(w0.x), bflo(w0.y), bfhi(w0.y)}; dst[1] = (f32x4){bflo(w0.z), bfhi(w0.z), bflo(w0.w), bfhi(w0.w)};
              dst[2] = (f32x4){bflo(w1.x), bfhi(w1.x), bflo(w1.y), bfhi(w1.y)}; dst[3] = (f32x4){bflo(w1.z), bfhi(w1.z), bflo(w1.w), bfhi(w1.w)};
              if (lane < 16) qs[1024 + lane] = bf2f(PROJ[(size_t)q * NPAD + C_WI + lane]) * 0.25f; }
            asm volatile("s_waitcnt lgkmcnt(0)" ::: "memory"); __builtin_amdgcn_wave_barrier();
            float score = 0.f;
            for (int j = 0; j < 16; ++j) {
                float acc = 0.f; const LAS f32x4* qj = (const LAS f32x4*)(qs + 64 * j);
#pragma unroll
                for (int d = 0; d < 16; ++d) { const f32x4 qv = qj[d]; acc += qv.x * kreg[4 * d] + qv.y * kreg[4 * d + 1] + qv.z * kreg[4 * d + 2] + qv.w * kreg[4 * d + 3]; }
                score += fmaxf(acc * 0.125f, 0.f) * qs[1024 + j];
            }
            if (s <= q) SC[sc_off(q) + s] = score;
            asm volatile("s_waitcnt lgkmcnt(0)" ::: "memory"); __builtin_amdgcn_wave_barrier();
        }
    }
}
__device__ __forceinline__ unsigned ordkey(float f) { const unsigned u = __float_as_uint(f); return (u & 0x80000000u) ? ~u : (u | 0x80000000u); }
template <int NR, int NL> __device__ __forceinline__ bool topk_row(const float* __restrict__ row, int n, int lane, LAS u32x4* xl, unsigned long long& w0, unsigned long long& w1, unsigned& Tout, int& need_out) {
#pragma unroll
    for (int q = 0; q < NL / 4; ++q) { u32x4 v;
#pragma unroll
        for (int e = 0; e < 4; ++e) { const int i = 4096 + (4 * q + e) * 64 + lane; v[e] = (ordkey(*(const float*)((const char*)row + 4u * (unsigned)min(i, n - 1))) >> 1) & (unsigned)((i - n) >> 31); }
        xl[q * 64 + lane] = v;
        if ((q & 3) == 3) __builtin_amdgcn_sched_barrier(0); }
    unsigned u[NR];
#pragma unroll
    for (int k = 0; k < NR; ++k) { const int i = k * 64 + lane; u[k] = (ordkey(*(const float*)((const char*)row + 4u * (unsigned)min(i, n - 1))) >> 1) & (unsigned)((i - n) >> 31);
        if ((k & 15) == 15) __builtin_amdgcn_sched_barrier(0); }
    unsigned T = 0u; bool cut = false;
    for (int bit = 30; bit >= 0; --bit) {
        const unsigned cand = T | (1u << bit); unsigned lt = 0u;
        asm volatile("" ::: "memory");
#pragma unroll
        for (int k = 0; k < NR; ++k) lt += (u[k] - cand) >> 31;
#pragma unroll
        for (int q = 0; q < NL / 4; ++q) { const u32x4 v = xl[q * 64 + lane]; lt += ((v[0] - cand) >> 31) + ((v[1] - cand) >> 31) + ((v[2] - cand) >> 31) + ((v[3] - cand) >> 31);
            if ((q & 3) == 3) __builtin_amdgcn_sched_barrier(0); }
#pragma unroll
        for (int o = 1; o < 64; o <<= 1) lt += __shfl_xor(lt, o);
        const int ge = (int)((NR + NL) * 64 - lt);
        if (ge >= TOPK) T = cand;
        if (ge == TOPK) { cut = true; break; }
    }
    unsigned c_hi = 0u, c_lt = 0u;
#pragma unroll
    for (int k = 0; k < NR; ++k) { c_hi += (T - u[k]) >> 31; c_lt += (u[k] - T) >> 31; }
#pragma unroll
    for (int q = 0; q < NL / 4; ++q) { const u32x4 v = xl[q * 64 + lane];
#pragma unroll
        for (int e = 0; e < 4; ++e) { c_hi += (T - v[e]) >> 31; c_lt += (v[e] - T) >> 31; } }
#pragma unroll
    for (int o = 1; o < 64; o <<= 1) { c_hi += __shfl_xor(c_hi, o); c_lt += __shfl_xor(c_lt, o); }
    const int need = TOPK - (int)c_hi, c_eq = (NR + NL) * 64 - (int)c_lt - (int)c_hi;
    Tout = T; need_out = need;
    if (!cut && c_eq != need) return false;
    int ln; asm volatile("v_mbcnt_lo_u32_b32 %0, -1, 0\n\tv_mbcnt_hi_u32_b32 %0, -1, %0" : "=v"(ln));
#pragma unroll
    for (int k = 0; k < NR; ++k) {
        const unsigned long long bs = __ballot(u[k] >= T);
        if (k == ln) w0 = bs;
        __builtin_amdgcn_sched_barrier(0); }
#pragma unroll
    for (int q = 0; q < NL / 4; ++q) { const u32x4 v = xl[q * 64 + lane];
#pragma unroll
        for (int e = 0; e < 4; ++e) { const unsigned long long bs = __ballot(v[e] >= T);
            if (4 * q + e == ln) w1 = bs;
            __builtin_amdgcn_sched_barrier(0); } }
    return true;
}
__device__ __forceinline__ void topk_select(const float* SC, int* SEL, LAS unsigned char* lds, int blk, int nblk, const int wave) {
    const int lane = lane_id_v();
    LAS u32x4* xl = (LAS u32x4*)(lds + wave * 16384);
    for (int r = blk * 8 + wave; r < S; r += nblk * 8) {
        const int n = r + 1; unsigned long long* mrow = (unsigned long long*)SEL + (size_t)r * 128;
        unsigned long long w0 = 0ull, w1 = 0ull;
        const int nwords = 4 * ((r >> 8) + 1);
        if (n <= TOPK) { const int lo = 64 * lane; w0 = (r < lo) ? 0ull : ((r - lo >= 63) ? ~0ull : ((2ull << (r - lo)) - 1ull)); }
        else { const float* row = SC + sc_off(r);
            unsigned T; int need; bool ok;
            if (n <= 2048) ok = topk_row<32, 0>(row, n, lane, xl, w0, w1, T, need); else if (n <= 4096) ok = topk_row<64, 0>(row, n, lane, xl, w0, w1, T, need); else ok = topk_row<64, 64>(row, n, lane, xl, w0, w1, T, need);
            if (!ok) { int eqc = 0; const unsigned long long lt = (lane == 0) ? 0ull : (~0ull >> (64 - lane));
                for (int base = 0, it = 0; base < n; base += 64, ++it) {
                    const int i = base + lane; const unsigned v = (i < n) ? (ordkey(row[i]) >> 1) : 0u;
                    const bool gt = v > T, eq = (i < n) && (v == T);
                    const unsigned long long be = __ballot(eq);
                    const bool take = gt || (eq && (eqc + __builtin_popcountll(be & lt) < need));
                    const unsigned long long bs = __ballot(take);
                    if ((it & 63) == lane) { if (it < 64) w0 = bs; else w1 = bs; }
                    eqc += __builtin_popcountll(be); } } }
        if (lane < nwords) mrow[lane] = w0;
        if (64 + lane < nwords) mrow[64 + lane] = w1;
    }
}
template <int DQ, int DV, bool GATHER>
__device__ __forceinline__ void naive_attn(const bf16_t* __restrict__ qp, const bf16_t* __restrict__ kb, const bf16_t* __restrict__ vb, size_t kvpitch,
                                           int nkeys, int nmax, const int* __restrict__ sel, int r, float scale, float slope, float (&o)[DV / 8]) {
    constexpr int QN = DQ / 8, VN = DV / 8;
    float q[QN];
#pragma unroll
    for (int i = 0; i < QN / 2; ++i) { const unsigned w = ((const unsigned*)qp)[i]; q[2 * i] = bflo(w) * scale; q[2 * i + 1] = bfhi(w) * scale; }
#pragma unroll
    for (int i = 0; i < VN; ++i) o[i] = 0.f;
    float m = -1e30f, l = 0.f;
    for (int i = 0; i < nmax; ++i) {
        bool valid = i < nkeys; int key = i;
        if (GATHER) { key = sel[valid ? i : 0]; valid = valid && key >= 0; }
        if (!valid) key = 0;
        const unsigned* kp = (const unsigned*)(kb + (size_t)key * kvpitch);
        float d = 0.f;
#pragma unroll
        for (int j = 0; j < QN / 2; ++j) { const unsigned w = kp[j]; d += q[2 * j] * bflo(w) + q[2 * j + 1] * bfhi(w); }
        d += __shfl_xor(d, 1); d += __shfl_xor(d, 2); d += __shfl_xor(d, 4);
        const float logit = d - slope * (float)(r - key);
        if (valid) {
            if (logit > m) { const float c = __expf(m - logit); l *= c;
#pragma unroll
                for (int j = 0; j < VN; ++j) o[j] *= c;
                m = logit; }
            const float p = __expf(logit - m); l += p;
            const unsigned* vp = (const unsigned*)(vb + (size_t)key * kvpitch);
#pragma unroll
            for (int j = 0; j < VN / 2; ++j) { const unsigned w = vp[j]; o[2 * j] += p * bflo(w); o[2 * j + 1] += p * bfhi(w); }
        }
    }
    const float il = 1.0f / l;
#pragma unroll
    for (int j = 0; j < VN; ++j) o[j] *= il;
}
__device__ __forceinline__ void attn_b_naive(const Args& a, int blk, int nblk, const int wave) {
    const int lane = lane_id_v(), tid = wave * 64 + lane, sub = lane & 7;
    const bf16_t* PROJ = (const bf16_t*)(a.ws + WS_PROJ); bf16_t* UB = (bf16_t*)(a.ws + WS_U) + (size_t)1 * S * 1024;
    const float lam = ((const float*)(a.ws + WS_CTL))[0];
    for (int wi = blk * 8 + wave; wi < 1024 * 8; wi += nblk * 8) {
        const int h = wi & 7, rg = wi >> 3, r = rg * 8 + (lane >> 3), nmax = rg * 8 + 8;
        const float slope = exp2f(-(float)(h + 1));
        float o0[16], o1[16];
        const bf16_t* rowp = PROJ + (size_t)r * NPAD;
        naive_attn<64, 128, false>(rowp + C_QB + h * 128 + sub * 8, PROJ + C_KB + h * 128 + sub * 8, PROJ + C_VB + h * 128 + sub * 16, NPAD, r + 1, nmax, nullptr, r, 0.125f, slope, o0);
        naive_attn<64, 128, false>(rowp + C_QB + h * 128 + 64 + sub * 8, PROJ + C_KB + h * 128 + 64 + sub * 8, PROJ + C_VB + h * 128 + sub * 16, NPAD, r + 1, nmax, nullptr, r, 0.125f, slope, o1);
        float ss = 0.f;
#pragma unroll
        for (int j = 0; j < 16; ++j) { o0[j] -= lam * o1[j]; ss += o0[j] * o0[j]; }
        ss += __shfl_xor(ss, 1); ss += __shfl_xor(ss, 2); ss += __shfl_xor(ss, 4);
        const float rs = 1.0f / sqrtf(ss * (1.f / 128.f) + RMS_EPS) * 0.8f;
        const float* g = a.in[9] + sub * 16; const bf16_t* zp = rowp + C_ZB + h * 128 + sub * 16;
        unsigned w[8];
#pragma unroll
        for (int j = 0; j < 8; ++j) w[j] = pk2(o0[2 * j] * rs * g[2 * j] * bf2f(zp[2 * j]), o0[2 * j + 1] * rs * g[2 * j + 1] * bf2f(zp[2 * j + 1]));
        u32x4* dst = (u32x4*)(UB + (size_t)r * 1024 + h * 128 + sub * 16);
        dst[0] = (u32x4){w[0], w[1], w[2], w[3]}; dst[1] = (u32x4){w[4], w[5], w[6], w[7]};
    }
}
__device__ __forceinline__ void attn_m_naive(const Args& a, int blk, int nblk, const int wave) {
    const int lane = lane_id_v(), tid = wave * 64 + lane, sub = lane & 7;
    const bf16_t* PROJ = (const bf16_t*)(a.ws + WS_PROJ); const bf16_t* MKV = (const bf16_t*)(a.ws + WS_MKV); bf16_t* UM = (bf16_t*)(a.ws + WS_U) + (size_t)2 * S * 1024;
    for (int wi = blk * 8 + wave; wi < 1024 * 4; wi += nblk * 8) {
        const int h = wi & 3, rg = wi >> 2, r = rg * 8 + (lane >> 3);
        float o[32];
        const bf16_t* rowp = PROJ + (size_t)r * NPAD;
        naive_attn<256, 256, false>(rowp + C_QM + h * 256 + sub * 32, MKV + h * 256 + sub * 32, MKV + 1024 + h * 256 + sub * 32, 2048, NMEM, NMEM, nullptr, 0, 0.0625f, 0.f, o);
        const bf16_t* zp = rowp + C_ZM + h * 256 + sub * 32;
        u32x4* dst = (u32x4*)(UM + (size_t)r * 1024 + h * 256 + sub * 32);
#pragma unroll
        for (int j = 0; j < 4; ++j) { u32x4 w;
            w.x = pk2(o[8 * j + 0] * bf2f(zp[8 * j + 0]), o[8 * j + 1] * bf2f(zp[8 * j + 1])); w.y = pk2(o[8 * j + 2] * bf2f(zp[8 * j + 2]), o[8 * j + 3] * bf2f(zp[8 * j + 3]));
            w.z = pk2(o[8 * j + 4] * bf2f(zp[8 * j + 4]), o[8 * j + 5] * bf2f(zp[8 * j + 5])); w.w = pk2(o[8 * j + 6] * bf2f(zp[8 * j + 6]), o[8 * j + 7] * bf2f(zp[8 * j + 7]));
            dst[j] = w; }
    }
}
__device__ __forceinline__ void attn_a_naive(const Args& a, int blk, int nblk, const int wave) {
    const int lane = lane_id_v(), tid = wave * 64 + lane, sub = lane & 7;
    const bf16_t* PROJ = (const bf16_t*)(a.ws + WS_PROJ); const int* SEL = (const int*)(a.ws + WS_SEL); bf16_t* UA = (bf16_t*)(a.ws + WS_U);
    for (int wi = blk * 8 + wave; wi < 1024 * 8; wi += nblk * 8) {
        const int h = wi & 7, rg = wi >> 3, r = rg * 8 + (lane >> 3);
        const float slope = exp2f(-(float)(h + 1));
        float o[16];
        const bf16_t* rowp = PROJ + (size_t)r * NPAD;
        naive_attn<128, 128, true>(rowp + C_QA + h * 128 + sub * 16, PROJ + C_KA + h * 128 + sub * 16, PROJ + C_VA + h * 128 + sub * 16, NPAD, TOPK, TOPK, SEL + (size_t)r * TOPK, r, 0.08838834764831845f, slope, o);
        const bf16_t* zp = rowp + C_ZA + h * 128 + sub * 16;
        unsigned w[8];
#pragma unroll
        for (int j = 0; j < 8; ++j) w[j] = pk2(o[2 * j] * bf2f(zp[2 * j]), o[2 * j + 1] * bf2f(zp[2 * j + 1]));
        u32x4* dst = (u32x4*)(UA + (size_t)r * 1024 + h * 128 + sub * 16);
        dst[0] = (u32x4){w[0], w[1], w[2], w[3]}; dst[1] = (u32x4){w[4], w[5], w[6], w[7]};
    }
}
__device__ __forceinline__ void final_norm(const Args& a, int blk, int nblk, const int wave) {
    const int lane = lane_id_v(), tid = wave * 64 + lane;
    const float* part = (const float*)(a.ws + WS_PART); const f32x4* g = (const f32x4*)a.in[16] + lane;
    for (int r = blk * 8 + wave; r < S; r += nblk * 8) {
        float s = (lane < 32) ? part[(size_t)lane * S + r] : 0.f;
        const float rs = 1.0f / sqrtf(wave_sum(s) * (1.f / DM) + RMS_EPS);
        f32x4* y = (f32x4*)(a.out + (size_t)r * DM) + lane;
#pragma unroll
        for (int j = 0; j < 8; ++j) { f32x4 v = y[64 * j]; const f32x4 gg = g[64 * j]; v = v * rs * gg; y[64 * j] = v; }
    }
}


namespace att {
typedef short bf16x8 __attribute__((ext_vector_type(8)));
typedef short s16x4 __attribute__((ext_vector_type(4)));
typedef float f32x16 __attribute__((ext_vector_type(16)));
typedef float f32x2_t __attribute__((ext_vector_type(2)));
typedef __bf16 bf16x2_t __attribute__((ext_vector_type(2)));
constexpr int SHM_V = 16384, SHM_K = 16384;
constexpr float LOG2E = 1.4426950408889634f;
constexpr float THR2 = 8.f * LOG2E;
#define KSWZ(row, colB) ((row) * 256 + ((colB) ^ (((row) & 7) << 4)))
#define SBAR() __builtin_amdgcn_sched_barrier(0)
__device__ __forceinline__ int crow(int r, int hi) { return (r & 3) + 8 * (r >> 2) + 4 * hi; }
__device__ __forceinline__ unsigned cvtpk(float lo, float hi) { f32x2_t v = {lo, hi}; bf16x2_t b = __builtin_convertvector(v, bf16x2_t); return __builtin_bit_cast(unsigned, b); }
__device__ __forceinline__ int v_st(int k, int c) { const int kk = (k & ~0xC) | ((k & 4) << 1) | ((k & 8) >> 1); return ((kk >> 3) * 4 + (c >> 5)) * 512 + ((kk & 7) * 32 + (c & 31)) * 2; }
__device__ __forceinline__ int v_rd_base(int lane) { return ((lane & 3) << 3) | (((lane >> 2) & 3) << 6) | (((lane >> 4) & 1) << 5) | (((lane >> 5) & 1) << 8); }
constexpr int v_rd_off(int d0, int ks, int half) { return d0 * 512 + ks * 4096 + half * 2048; }
typedef short v4i16_t __attribute__((ext_vector_type(4)));
__device__ __forceinline__ s16x4 tr_read(LAS const unsigned char* p) { return __builtin_bit_cast(s16x4, __builtin_amdgcn_ds_read_tr16_b64_v4i16((LAS v4i16_t*)p)); }

template <int NQ> __device__ __forceinline__ void qkt(f32x16& p0, f32x16& p1, LAS const unsigned char* Ks, const bf16x8* qr, int cbyte0, int r32, int hi) {
  p0 = f32x16{}; p1 = f32x16{};
#pragma unroll
  for (int d0 = 0; d0 < NQ; ++d0) { const int cb = cbyte0 + (d0 * 16 + hi * 8) * 2;
    const bf16x8 b0 = *(LAS const bf16x8*)(Ks + KSWZ(r32, cb));
    const bf16x8 b1 = *(LAS const bf16x8*)(Ks + KSWZ(32 + r32, cb));
    p0 = __builtin_amdgcn_mfma_f32_32x32x16_bf16(b0, qr[d0], p0, 0, 0, 0);
    p1 = __builtin_amdgcn_mfma_f32_32x32x16_bf16(b1, qr[d0], p1, 0, 0, 0); }
}
template <int NQ> __device__ __forceinline__ void qkt_l(f32x16& p0, f32x16& p1, LAS const unsigned char* Ks, LAS const unsigned char* Qs, int cbyte0, int r32, int hi) {
  p0 = f32x16{}; p1 = f32x16{};
  asm volatile("" : "+v"(Qs));
#pragma unroll
  for (int d0 = 0; d0 < NQ; ++d0) { const int cb = cbyte0 + (d0 * 16 + hi * 8) * 2;
    const bf16x8 q = *(LAS const bf16x8*)(Qs + d0 * 1024);
    const bf16x8 b0 = *(LAS const bf16x8*)(Ks + KSWZ(r32, cb));
    const bf16x8 b1 = *(LAS const bf16x8*)(Ks + KSWZ(32 + r32, cb));
    p0 = __builtin_amdgcn_mfma_f32_32x32x16_bf16(b0, q, p0, 0, 0, 0);
    p1 = __builtin_amdgcn_mfma_f32_32x32x16_bf16(b1, q, p1, 0, 0, 0); }
}
template <int D0> __device__ __forceinline__ void pv_one(f32x16& od, LAS const unsigned char* vb, bf16x8 pa0, bf16x8 pa1, bf16x8 pa2, bf16x8 pa3) {
  const s16x4 l0 = tr_read(vb + v_rd_off(D0, 0, 0)), h0 = tr_read(vb + v_rd_off(D0, 0, 1)), l1 = tr_read(vb + v_rd_off(D0, 1, 0)), h1 = tr_read(vb + v_rd_off(D0, 1, 1));
  const s16x4 l2 = tr_read(vb + v_rd_off(D0, 2, 0)), h2 = tr_read(vb + v_rd_off(D0, 2, 1)), l3 = tr_read(vb + v_rd_off(D0, 3, 0)), h3 = tr_read(vb + v_rd_off(D0, 3, 1));
#define PK(L, H) (bf16x8){L[0], L[1], L[2], L[3], H[0], H[1], H[2], H[3]}
  od = __builtin_amdgcn_mfma_f32_32x32x16_bf16(pa0, PK(l0, h0), od, 0, 0, 0);
  od = __builtin_amdgcn_mfma_f32_32x32x16_bf16(pa1, PK(l1, h1), od, 0, 0, 0);
  od = __builtin_amdgcn_mfma_f32_32x32x16_bf16(pa2, PK(l2, h2), od, 0, 0, 0);
  od = __builtin_amdgcn_mfma_f32_32x32x16_bf16(pa3, PK(l3, h3), od, 0, 0, 0);
#undef PK
}
__device__ __forceinline__ void pv_d0(f32x16* o, LAS const unsigned char* vb, bf16x8 pa0, bf16x8 pa1, bf16x8 pa2, bf16x8 pa3) {
  pv_one<0>(o[0], vb, pa0, pa1, pa2, pa3); pv_one<1>(o[1], vb, pa0, pa1, pa2, pa3); pv_one<2>(o[2], vb, pa0, pa1, pa2, pa3); pv_one<3>(o[3], vb, pa0, pa1, pa2, pa3);
}
template <bool CAUSAL> __device__ __forceinline__ void partialSM(f32x16& p0, f32x16& p1, float& m_reg, float& alpha, const float (&cs)[16], float base, int lim, float C, float slope2, int delta) {
  const float tb0 = slope2 * (float)delta + base, tb1 = slope2 * (float)(delta + 32) + base;
#pragma unroll
  for (int r = 0; r < 16; ++r) { p0[r] = fmaf(p0[r], C, cs[r]); p1[r] = fmaf(p1[r], C, cs[r]); }
  if (CAUSAL && delta + 63 > 0) {
    const int l0 = lim - delta, l1 = l0 - 32;
#pragma unroll
    for (int r = 0; r < 16; ++r) { const int K = (r & 3) + 8 * (r >> 2); if (K > l0) p0[r] = -INFINITY; if (K > l1) p1[r] = -INFINITY; }
  }
  float pm0 = p0[0], pm1 = p1[0];
#pragma unroll
  for (int r = 1; r < 16; ++r) { pm0 = fmaxf(pm0, p0[r]); pm1 = fmaxf(pm1, p1[r]); }
  float pmax = fmaxf(pm0 + tb0, pm1 + tb1);
  { auto rr = __builtin_amdgcn_permlane32_swap(__float_as_uint(pmax), __float_as_uint(pmax), false, false);
    pmax = fmaxf(__uint_as_float(rr[0]), __uint_as_float(rr[1])); }
  float mn;
  if (__builtin_expect(__all(pmax - m_reg <= THR2), 1)) { mn = m_reg; alpha = 1.f; }
  else { mn = fmaxf(m_reg, pmax); alpha = __builtin_amdgcn_exp2f(m_reg - mn); m_reg = mn; }
  const float a0 = tb0 - mn, a1 = tb1 - mn;
#pragma unroll
  for (int r = 0; r < 16; ++r) { p0[r] += a0; p1[r] += a1; }
#pragma unroll
  for (int r = 0; r < 16; ++r) p0[r] = __builtin_amdgcn_exp2f(p0[r]);
}
__device__ __forceinline__ void finishSM(f32x16& p0, f32x16& p1, float alpha, float& l_reg, bf16x8& pa0, bf16x8& pa1, bf16x8& pa2, bf16x8& pa3) {
#pragma unroll
  for (int r = 0; r < 16; ++r) p1[r] = __builtin_amdgcn_exp2f(p1[r]);
  float ps = 0;
#pragma unroll
  for (int r = 0; r < 16; ++r) ps += p0[r];
#pragma unroll
  for (int r = 0; r < 16; ++r) ps += p1[r];
  { auto rr = __builtin_amdgcn_permlane32_swap(__float_as_uint(ps), __float_as_uint(ps), false, false);
    ps = __uint_as_float(rr[0]) + __uint_as_float(rr[1]); }
  l_reg = l_reg * alpha + ps;
#define PK4(P, BASE, OUT) do { unsigned a0 = cvtpk(P[BASE + 0], P[BASE + 1]), a1 = cvtpk(P[BASE + 2], P[BASE + 3]);   \
    unsigned b0 = cvtpk(P[BASE + 4], P[BASE + 5]), b1 = cvtpk(P[BASE + 6], P[BASE + 7]);                              \
    auto r0 = __builtin_amdgcn_permlane32_swap(a0, b0, false, false); auto r1 = __builtin_amdgcn_permlane32_swap(a1, b1, false, false); \
    u32x4 w = {r0[0], r1[0], r0[1], r1[1]}; OUT = __builtin_bit_cast(bf16x8, w); } while (0)
  PK4(p0, 0, pa0); PK4(p0, 8, pa1); PK4(p1, 0, pa2); PK4(p1, 8, pa3);
#undef PK4
}

__device__ __forceinline__ void attn_b_unit(const bf16_t* __restrict__ PROJ, bf16_t* UB, const float* __restrict__ gsub, float lam, int h, int qb, int jmin, LAS unsigned char* lds, const int wid) {
  const int lane = lane_id_v(), tid = wid * 64 + lane, r32 = lane & 31, hi = lane >> 5, comp = wid >> 2, wq = wid & 3;
  const int R0 = qb * 128, qrow0 = R0 + wq * 32, NT = 2 * qb + 2, NTe = NT - jmin;
  LAS unsigned char* V_lds = lds; LAS unsigned char* K_lds = lds + 2 * SHM_V;
  LAS float* ws = (LAS float*)(lds + 2 * SHM_V + 2 * SHM_K) + wid * 64; LAS float* li_l = ws; LAS float* al_l = ws + 32;
  LAS float* xch = (LAS float*)(lds + 2 * SHM_V + 2 * SHM_K + 2048);
  const float slope2 = __builtin_amdgcn_exp2f(-(float)(h + 1)) * LOG2E, C = 0.125f * LOG2E;
  float cs[16];
#pragma unroll
  for (int r = 0; r < 16; ++r) cs[r] = __uint_as_float(__builtin_amdgcn_readfirstlane(__float_as_uint(slope2 * (float)((r & 3) + 8 * (r >> 2)))));
  const float base = slope2 * (float)(4 * hi - r32); const int lim = r32 - 4 * hi;
  float m_reg = -1e30f, l_reg = 0; f32x16 o[4] = {};
  LAS unsigned char* Qs = lds + 2 * SHM_V + 2 * SHM_K + 2048 + wid * 4096 + lane * 16;
  { const bf16_t* Qw = PROJ + (size_t)(qrow0 + r32) * NPAD + C_QB + h * 128 + comp * 64 + hi * 8;
#pragma unroll
    for (int d0 = 0; d0 < 4; ++d0) *(LAS bf16x8*)(Qs + d0 * 1024) = *(const bf16x8*)(Qw + d0 * 16); }
  const unsigned offK = (unsigned)((tid >> 4) * NPAD + C_KB + h * 128 + (tid & 15) * 8) * 2u, offV = offK + (unsigned)(C_VB - C_KB) * 2u;
  const int sr = tid >> 4, sc = (tid & 15) * 8, vst0 = v_st(sr, sc), vst1 = v_st(32 + sr, sc), cq = comp * 128;
  LAS const unsigned char* vb0 = V_lds + v_rd_base(lane);
  struct { bf16x8 vs0, vs1, ks0, ks1; } sr_[2];
#define KEY0(t) (64 * (NT - 1 - (t)))
#define GLD16(off) (*(const bf16x8*)((const char*)PROJ + (unsigned)(off)))
#define SLOAD(i, k0) do { const unsigned kb_ = (unsigned)(k0) * (unsigned)(NPAD * 2); sr_[i].vs0 = GLD16(offV + kb_); sr_[i].vs1 = GLD16(offV + kb_ + 32u * NPAD * 2u); \
    sr_[i].ks0 = GLD16(offK + kb_); sr_[i].ks1 = GLD16(offK + kb_ + 32u * NPAD * 2u); } while (0)
#define SWRITE(b) do { *(LAS bf16x8*)(V_lds + (b) * SHM_V + vst0) = sr_[b].vs0; *(LAS bf16x8*)(V_lds + (b) * SHM_V + vst1) = sr_[b].vs1; const int kc = sc * 2; \
    *(LAS bf16x8*)(K_lds + (b) * SHM_K + KSWZ(sr, kc)) = sr_[b].ks0; *(LAS bf16x8*)(K_lds + (b) * SHM_K + KSWZ(32 + sr, kc)) = sr_[b].ks1; } while (0)
#define RESC(a) do { if (__any((a) < 1.f)) { if (hi == 0) al_l[r32] = (a); asm volatile("s_waitcnt lgkmcnt(0)" ::: "memory"); \
    _Pragma("unroll") for (int d = 0; d < 4; ++d) _Pragma("unroll") for (int r = 0; r < 16; ++r) o[d][r] *= al_l[crow(r, hi)]; } } while (0)
  f32x16 pA0, pA1, pB0, pB1; float alA, alB; bf16x8 pa0, pa1, pa2, pa3;
  SLOAD(0, KEY0(0)); SWRITE(0); __syncthreads();
  qkt_l<4>(pA0, pA1, K_lds, Qs, cq, r32, hi); partialSM<true>(pA0, pA1, m_reg, alA, cs, base, lim, C, slope2, KEY0(0) - qrow0);
  SLOAD(1, KEY0(1)); if (2 < NTe) SLOAD(0, KEY0(2));
  SWRITE(1); __syncthreads();
  for (int j = 1; j + 1 < NTe; j += 2) {
    SBAR(); qkt_l<4>(pB0, pB1, K_lds + SHM_K, Qs, cq, r32, hi);
    finishSM(pA0, pA1, alA, l_reg, pa0, pa1, pa2, pa3); SBAR();
    SLOAD(1, KEY0(j + 2)); SBAR();
    pv_d0(o, vb0, pa0, pa1, pa2, pa3); partialSM<true>(pB0, pB1, m_reg, alB, cs, base, lim, C, slope2, KEY0(j) - qrow0);
    __syncthreads(); SWRITE(0);
    RESC(alB); __syncthreads();
    SBAR(); qkt_l<4>(pA0, pA1, K_lds, Qs, cq, r32, hi);
    finishSM(pB0, pB1, alB, l_reg, pa0, pa1, pa2, pa3); SBAR();
    SLOAD(0, KEY0(min(j + 3, NTe - 1))); SBAR();
    pv_d0(o, vb0 + SHM_V, pa0, pa1, pa2, pa3); partialSM<true>(pA0, pA1, m_reg, alA, cs, base, lim, C, slope2, KEY0(j + 1) - qrow0);
    __syncthreads(); SWRITE(1);
    RESC(alA); __syncthreads();
  }
  SBAR(); qkt_l<4>(pB0, pB1, K_lds + SHM_K, Qs, cq, r32, hi);
  finishSM(pA0, pA1, alA, l_reg, pa0, pa1, pa2, pa3); SBAR();
  pv_d0(o, vb0, pa0, pa1, pa2, pa3); partialSM<true>(pB0, pB1, m_reg, alB, cs, base, lim, C, slope2, KEY0(NTe - 1) - qrow0);
  __syncthreads(); RESC(alB);
  finishSM(pB0, pB1, alB, l_reg, pa0, pa1, pa2, pa3); SBAR();
  pv_d0(o, vb0 + SHM_V, pa0, pa1, pa2, pa3);
#undef KEY0
#undef SLOAD
#undef GLD16
#undef SWRITE
#undef RESC
  if (hi == 0) li_l[r32] = l_reg; asm volatile("s_waitcnt lgkmcnt(0)" ::: "memory");
  float rli[16];
#pragma unroll
  for (int r = 0; r < 16; ++r) rli[r] = __builtin_amdgcn_rcpf(li_l[crow(r, hi)]);
  __syncthreads();
  if (comp == 1) {
#pragma unroll
    for (int d0 = 0; d0 < 4; ++d0)
#pragma unroll
      for (int r = 0; r < 16; ++r) xch[(wq * 64 + d0 * 16 + r) * 64 + lane] = o[d0][r] * rli[r] * lam;
  }
  __syncthreads();
  if (comp == 0) {
    float ss[16];
#pragma unroll
    for (int r = 0; r < 16; ++r) ss[r] = 0.f;
#pragma unroll
    for (int d0 = 0; d0 < 4; ++d0)
#pragma unroll
      for (int r = 0; r < 16; ++r) { const float d = o[d0][r] * rli[r] - xch[(wq * 64 + d0 * 16 + r) * 64 + lane]; o[d0][r] = d; ss[r] += d * d; }
#pragma unroll
    for (int r = 0; r < 16; ++r) { float s = ss[r]; s += __shfl_xor(s, 1); s += __shfl_xor(s, 2); s += __shfl_xor(s, 4); s += __shfl_xor(s, 8); s += __shfl_xor(s, 16);
      ss[r] = 0.8f / sqrtf(s * (1.f / 128.f) + RMS_EPS); }
#pragma unroll
    for (int d0 = 0; d0 < 4; ++d0) { const int col = d0 * 32 + r32; const float g = gsub[col];
#pragma unroll
      for (int r = 0; r < 16; ++r) { const size_t row = (size_t)(qrow0 + crow(r, hi));
        const float z = bf2f(PROJ[row * NPAD + C_ZB + h * 128 + col]);
        UB[row * 1024 + h * 128 + col] = (bf16_t)f2bf(o[d0][r] * ss[r] * g * z); } }
  }
  __syncthreads();
}
template <bool DUMMY> __device__ __forceinline__ void partialSM_A(f32x16& p0, f32x16& p1, float& m_reg, float& alpha, const float (&cs)[16], float base, float C, float slope2, int delta, unsigned long long mw, int hi) {
  const float tb0 = slope2 * (float)delta + base, tb1 = slope2 * (float)(delta + 32) + base;
  const unsigned wl = (unsigned)mw >> (4 * hi), wh = (unsigned)(mw >> 32) >> (4 * hi);
#pragma unroll
  for (int r = 0; r < 16; ++r) { const int K = (r & 3) + 8 * (r >> 2);
    const float y0 = fmaf(p0[r], C, cs[r]), y1 = fmaf(p1[r], C, cs[r]);
    const unsigned t0 = (unsigned)((int)(wl << (31 - K)) >> 31), t1 = (unsigned)((int)(wh << (31 - K)) >> 31);
    p0[r] = __uint_as_float((__float_as_uint(y0) & t0) | (~t0 & 0xff800000u));
    p1[r] = __uint_as_float((__float_as_uint(y1) & t1) | (~t1 & 0xff800000u)); }
  float pm0 = p0[0], pm1 = p1[0];
#pragma unroll
  for (int r = 1; r < 16; ++r) { pm0 = fmaxf(pm0, p0[r]); pm1 = fmaxf(pm1, p1[r]); }
  float pmax = fmaxf(pm0 + tb0, pm1 + tb1);
  { auto rr = __builtin_amdgcn_permlane32_swap(__float_as_uint(pmax), __float_as_uint(pmax), false, false);
    pmax = fmaxf(__uint_as_float(rr[0]), __uint_as_float(rr[1])); }
  float mn;
  if (__builtin_expect(__all(pmax - m_reg <= THR2), 1)) { mn = m_reg; alpha = 1.f; }
  else { mn = fmaxf(m_reg, pmax); alpha = __builtin_amdgcn_exp2f(m_reg - mn); m_reg = mn; }
  const float a0 = tb0 - mn, a1 = tb1 - mn;
#pragma unroll
  for (int r = 0; r < 16; ++r) { p0[r] += a0; p1[r] += a1; }
#pragma unroll
  for (int r = 0; r < 16; ++r) p0[r] = __builtin_amdgcn_exp2f(p0[r]);
}
__device__ __forceinline__ void attn_a_unit(const bf16_t* __restrict__ PROJ, const unsigned long long* __restrict__ MASK, bf16_t* UA, int h, int qb, int jmin, LAS unsigned char* lds, const int wid) {
  const int lane = lane_id_v(), tid = wid * 64 + lane, r32 = lane & 31, hi = lane >> 5;
  const int R0 = qb * 256, qrow0 = R0 + wid * 32, NT = 4 * qb + 4, NTe = NT - jmin;
  LAS unsigned char* V_lds = lds; LAS unsigned char* K_lds = lds + 2 * SHM_V;
  LAS float* ws = (LAS float*)(lds + 2 * SHM_V + 2 * SHM_K) + wid * 64; LAS float* li_l = ws; LAS float* al_l = ws + 32;
  const float slope2 = __builtin_amdgcn_exp2f(-(float)(h + 1)) * LOG2E, C = 0.08838834764831845f * LOG2E;
  float cs[16];
#pragma unroll
  for (int r = 0; r < 16; ++r) cs[r] = __uint_as_float(__builtin_amdgcn_readfirstlane(__float_as_uint(slope2 * (float)((r & 3) + 8 * (r >> 2)))));
  const float base = slope2 * (float)(4 * hi - r32);
  float m_reg = -1e30f, l_reg = 0; f32x16 o[4] = {}; bf16x8 qr[8];
  { const bf16_t* Qw = PROJ + (size_t)(qrow0 + r32) * NPAD + C_QA + h * 128 + hi * 8;
#pragma unroll
    for (int d0 = 0; d0 < 8; ++d0) qr[d0] = *(const bf16x8*)(Qw + d0 * 16); }
  const unsigned offK = (unsigned)((tid >> 4) * NPAD + C_KA + h * 128 + (tid & 15) * 8) * 2u, offV = offK + (unsigned)(C_VA - C_KA) * 2u;
  const unsigned moff = (unsigned)(qrow0 + r32) * 1024u;
#define MLD(tj) (*(const unsigned long long*)((const char*)MASK + (moff + 8u * (unsigned)(tj))))
  const int sr = tid >> 4, sc = (tid & 15) * 8, vst0 = v_st(sr, sc), vst1 = v_st(32 + sr, sc);
  LAS const unsigned char* vb0 = V_lds + v_rd_base(lane);
  struct { bf16x8 vs0, vs1, ks0, ks1; } sr_;
#define TJ(t) (NT - 1 - (t))
#define KEY0(t) (64 * TJ(t))
#define GLD16(off) (*(const bf16x8*)((const char*)PROJ + (unsigned)(off)))
#define SLOAD(k0) do { const unsigned kb_ = (unsigned)(k0) * (unsigned)(NPAD * 2); sr_.vs0 = GLD16(offV + kb_); sr_.vs1 = GLD16(offV + kb_ + 32u * NPAD * 2u); \
    sr_.ks0 = GLD16(offK + kb_); sr_.ks1 = GLD16(offK + kb_ + 32u * NPAD * 2u); } while (0)
#define SWRITE(b) do { *(LAS bf16x8*)(V_lds + (b) * SHM_V + vst0) = sr_.vs0; *(LAS bf16x8*)(V_lds + (b) * SHM_V + vst1) = sr_.vs1; const int kc = sc * 2; \
    *(LAS bf16x8*)(K_lds + (b) * SHM_K + KSWZ(sr, kc)) = sr_.ks0; *(LAS bf16x8*)(K_lds + (b) * SHM_K + KSWZ(32 + sr, kc)) = sr_.ks1; } while (0)
#define RESC(a) do { if (__any((a) < 1.f)) { if (hi == 0) al_l[r32] = (a); asm volatile("s_waitcnt lgkmcnt(0)" ::: "memory"); \
    _Pragma("unroll") for (int d = 0; d < 4; ++d) _Pragma("unroll") for (int r = 0; r < 16; ++r) o[d][r] *= al_l[crow(r, hi)]; } } while (0)
  f32x16 pA0, pA1, pB0, pB1; float alA, alB; bf16x8 pa0, pa1, pa2, pa3; unsigned long long mwA, mwB;
  SLOAD(KEY0(0)); mwA = MLD(TJ(0)); SWRITE(0); __syncthreads();
  qkt<8>(pA0, pA1, K_lds, qr, 0, r32, hi); partialSM_A<true>(pA0, pA1, m_reg, alA, cs, base, C, slope2, KEY0(0) - qrow0, mwA, hi);
  SLOAD(KEY0(1)); mwB = MLD(TJ(1)); SWRITE(1); __syncthreads();
  for (int j = 1; j + 1 < NTe; j += 2) {
    SBAR(); qkt<8>(pB0, pB1, K_lds + SHM_K, qr, 0, r32, hi);
    finishSM(pA0, pA1, alA, l_reg, pa0, pa1, pa2, pa3); SBAR();
    SLOAD(KEY0(j + 1)); mwA = MLD(TJ(j + 1)); SBAR();
    pv_d0(o, vb0, pa0, pa1, pa2, pa3); partialSM_A<true>(pB0, pB1, m_reg, alB, cs, base, C, slope2, KEY0(j) - qrow0, mwB, hi);
    __syncthreads(); SWRITE(0);
    RESC(alB); __syncthreads();
    SBAR(); qkt<8>(pA0, pA1, K_lds, qr, 0, r32, hi);
    finishSM(pB0, pB1, alB, l_reg, pa0, pa1, pa2, pa3); SBAR();
    SLOAD(KEY0(j + 2)); mwB = MLD(TJ(j + 2)); SBAR();
    pv_d0(o, vb0 + SHM_V, pa0, pa1, pa2, pa3); partialSM_A<true>(pA0, pA1, m_reg, alA, cs, base, C, slope2, KEY0(j + 1) - qrow0, mwA, hi);
    __syncthreads(); SWRITE(1);
    RESC(alA); __syncthreads();
  }
  SBAR(); qkt<8>(pB0, pB1, K_lds + SHM_K, qr, 0, r32, hi);
  finishSM(pA0, pA1, alA, l_reg, pa0, pa1, pa2, pa3); SBAR();
  pv_d0(o, vb0, pa0, pa1, pa2, pa3); partialSM_A<true>(pB0, pB1, m_reg, alB, cs, base, C, slope2, KEY0(NTe - 1) - qrow0, mwB, hi);
  __syncthreads(); RESC(alB);
  finishSM(pB0, pB1, alB, l_reg, pa0, pa1, pa2, pa3); SBAR();
  pv_d0(o, vb0 + SHM_V, pa0, pa1, pa2, pa3);
#undef TJ
#undef MLD
#undef KEY0
#undef SLOAD
#undef GLD16
#undef SWRITE
#undef RESC
  if (hi == 0) li_l[r32] = l_reg; asm volatile("s_waitcnt lgkmcnt(0)" ::: "memory");
  float rli[16];
#pragma unroll
  for (int r = 0; r < 16; ++r) rli[r] = __builtin_amdgcn_rcpf(li_l[crow(r, hi)]);
#pragma unroll
  for (int d0 = 0; d0 < 4; ++d0) { const int col = h * 128 + d0 * 32 + r32;
#pragma unroll
    for (int r = 0; r < 16; ++r) { const size_t row = (size_t)(qrow0 + crow(r, hi));
      const float z = bf2f(PROJ[row * NPAD + C_ZA + col]);
      UA[row * 1024 + col] = (bf16_t)f2bf(o[d0][r] * rli[r] * z); } }
  __syncthreads();
}
template <int NQ, bool ACC> __device__ __forceinline__ void qkt_acc(f32x16& p0, f32x16& p1, LAS const unsigned char* Ks, const bf16x8* qr, int r32, int hi) {
  if (!ACC) { p0 = f32x16{}; p1 = f32x16{}; }
#pragma unroll
  for (int d0 = 0; d0 < NQ; ++d0) { const int cb = (d0 * 16 + hi * 8) * 2;
    const bf16x8 b0 = *(LAS const bf16x8*)(Ks + KSWZ(r32, cb));
    const bf16x8 b1 = *(LAS const bf16x8*)(Ks + KSWZ(32 + r32, cb));
    p0 = __builtin_amdgcn_mfma_f32_32x32x16_bf16(b0, qr[d0], p0, 0, 0, 0);
    p1 = __builtin_amdgcn_mfma_f32_32x32x16_bf16(b1, qr[d0], p1, 0, 0, 0); }
}
__device__ __forceinline__ void attn_m_unit(const bf16_t* __restrict__ PROJ, const bf16_t* __restrict__ MKV, bf16_t* UM, int h, int qb, int vh, LAS unsigned char* lds, const int wid) {
  const int lane = lane_id_v(), tid = wid * 64 + lane, r32 = lane & 31, hi = lane >> 5;
  const int qrow0 = qb * 256 + wid * 32;
  LAS unsigned char* V_lds = lds; LAS unsigned char* K_lds = lds + 2 * SHM_V;
  LAS float* ws = (LAS float*)(lds + 2 * SHM_V + 2 * SHM_K) + wid * 64; LAS float* li_l = ws; LAS float* al_l = ws + 32;
  const float C = 0.0625f * LOG2E;
  const float cs[16] = {0.f, 0.f, 0.f, 0.f, 0.f, 0.f, 0.f, 0.f, 0.f, 0.f, 0.f, 0.f, 0.f, 0.f, 0.f, 0.f};
  float m_reg = -1e30f, l_reg = 0; f32x16 o[4] = {}; bf16x8 qr[16];
  { const bf16_t* Qw = PROJ + (size_t)(qrow0 + r32) * NPAD + C_QM + h * 256 + hi * 8;
#pragma unroll
    for (int d0 = 0; d0 < 16; ++d0) qr[d0] = *(const bf16x8*)(Qw + d0 * 16); }
  const int sr = tid >> 4, sc = (tid & 15) * 8, vst0 = v_st(sr, sc), vst1 = v_st(32 + sr, sc);
  const unsigned offK = (unsigned)(sr * 2048 + h * 256 + sc) * 2u, offV = offK + (unsigned)(1024 + vh * 128) * 2u;
  LAS const unsigned char* vb0 = V_lds + v_rd_base(lane);
#define GLD16(off) (*(const bf16x8*)((const char*)MKV + (unsigned)(off)))
  for (int t = 0; t < 4; ++t) {
    const unsigned kb_ = (unsigned)(64 * t) * 4096u;
    const bf16x8 ka0 = GLD16(offK + kb_), ka1 = GLD16(offK + kb_ + 32u * 4096u), kb0 = GLD16(offK + kb_ + 256u), kb1 = GLD16(offK + kb_ + 32u * 4096u + 256u);
    const bf16x8 vs0 = GLD16(offV + kb_), vs1 = GLD16(offV + kb_ + 32u * 4096u);
    const int kc = sc * 2;
    *(LAS bf16x8*)(K_lds + KSWZ(sr, kc)) = ka0; *(LAS bf16x8*)(K_lds + KSWZ(32 + sr, kc)) = ka1;
    *(LAS bf16x8*)(K_lds + SHM_K + KSWZ(sr, kc)) = kb0; *(LAS bf16x8*)(K_lds + SHM_K + KSWZ(32 + sr, kc)) = kb1;
    *(LAS bf16x8*)(V_lds + vst0) = vs0; *(LAS bf16x8*)(V_lds + vst1) = vs1;
    __syncthreads();
    f32x16 p0, p1; float al; bf16x8 pa0, pa1, pa2, pa3;
    qkt_acc<8, false>(p0, p1, K_lds, qr, r32, hi); qkt_acc<8, true>(p0, p1, K_lds + SHM_K, qr + 8, r32, hi);
    partialSM<false>(p0, p1, m_reg, al, cs, 0.f, 0, C, 0.f, 0);
    if (__any(al < 1.f)) { if (hi == 0) al_l[r32] = al; asm volatile("s_waitcnt lgkmcnt(0)" ::: "memory");
#pragma unroll
      for (int d = 0; d < 4; ++d)
#pragma unroll
        for (int r = 0; r < 16; ++r) o[d][r] *= al_l[crow(r, hi)]; }
    finishSM(p0, p1, al, l_reg, pa0, pa1, pa2, pa3);
    pv_d0(o, vb0, pa0, pa1, pa2, pa3);
    __syncthreads();
  }
#undef GLD16
  if (hi == 0) li_l[r32] = l_reg; asm volatile("s_waitcnt lgkmcnt(0)" ::: "memory");
  float rli[16];
#pragma unroll
  for (int r = 0; r < 16; ++r) rli[r] = __builtin_amdgcn_rcpf(li_l[crow(r, hi)]);
#pragma unroll
  for (int d0 = 0; d0 < 4; ++d0) { const int col = h * 256 + vh * 128 + d0 * 32 + r32;
#pragma unroll
    for (int r = 0; r < 16; ++r) { const size_t row = (size_t)(qrow0 + crow(r, hi));
      const float z = bf2f(PROJ[row * NPAD + C_ZM + col]);
      UM[row * 1024 + col] = (bf16_t)f2bf(o[d0][r] * rli[r] * z); } }
  __syncthreads();
}
__device__ __forceinline__ void attn_m_phase(const Args& a, LAS unsigned char* lds, int blk, int nblk, const int wid) {
  const bf16_t* PROJ = (const bf16_t*)(a.ws + WS_PROJ); const bf16_t* MKV = (const bf16_t*)(a.ws + WS_MKV); bf16_t* UM = (bf16_t*)(a.ws + WS_U) + (size_t)2 * S * 1024;
  for (int u = blk; u < 256; u += nblk) attn_m_unit(PROJ, MKV, UM, u & 3, u >> 3, (u >> 2) & 1, lds, wid);
}
__device__ __forceinline__ float slot_sum(const unsigned* ns, int tile, int bj, int wc0, int nwc) { float s = 0.f;
  for (int w = 0; w < nwc; ++w) s += __uint_as_float(__hip_atomic_load(ns + (tile * 2 + bj) * 4 + wc0 + w, __ATOMIC_RELAXED, __HIP_MEMORY_SCOPE_AGENT)); return s; }
__device__ __forceinline__ int window_jmin(float q2k2, float scale, int h, int R0, int NT) {
  const float slope2 = __builtin_amdgcn_exp2f(-(float)(h + 1)) * LOG2E, L = sqrtf(q2k2) * scale * LOG2E * 1.02f, D = (2.f * L + 48.f) / slope2;
  const float x = ((float)R0 - D - 63.f) * (1.f / 64.f);
  int jm = (int)floorf(x) - 1; jm = jm < 0 ? 0 : jm; jm &= ~1; return jm > NT - 2 ? NT - 2 : jm;
}
__device__ __forceinline__ int jmin_b(const unsigned* ns, int h, int qb) {
  const int bj = h & 1; float m = 0.f;
  for (int c = 0; c < 2; ++c) { const float v = slot_sum(ns, 20 + (h >> 1), bj, 2 * c, 2) * slot_sum(ns, 24 + (h >> 1), bj, 2 * c, 2); m = fmaxf(m, v); }
  return window_jmin(m, 0.125f, h, qb * 128, 2 * qb + 2);
}
constexpr int NUNITS_AB = 512;
__device__ __forceinline__ void build_order(const unsigned* ns, unsigned* order, LAS unsigned char* lds, const int lane) {
  LAS int* cost = (LAS int*)lds;
  for (int u = lane; u < NUNITS_AB; u += 64) { int jm, cst;
    { const int h = u & 7, qb = u >> 3; jm = jmin_b(ns, h, qb); cst = 2 * qb + 2 - jm; }
    cost[u] = cst; cost[NUNITS_AB + u] = jm; }
  asm volatile("s_waitcnt lgkmcnt(0)" ::: "memory"); __builtin_amdgcn_wave_barrier();
  for (int u = lane; u < NUNITS_AB; u += 64) { const int cu = cost[u]; int rank = 0;
    for (int v = 0; v < NUNITS_AB; ++v) { const int cv = cost[v]; rank += (cv > cu || (cv == cu && v < u)) ? 1 : 0; }
    order[rank] = (unsigned)u | ((unsigned)cost[NUNITS_AB + u] << 16); }
}
__device__ __forceinline__ void attn_ab_phase(const Args& a, LAS unsigned char* lds, int blk, int nblk, const int wid) {
  const bf16_t* PROJ = (const bf16_t*)(a.ws + WS_PROJ); bf16_t* UA = (bf16_t*)(a.ws + WS_U); bf16_t* UB = UA + (size_t)S * 1024;
  { const unsigned long long* MASK = (const unsigned long long*)(a.ws + WS_SEL);
    for (int u = blk; u < 256; u += nblk) attn_a_unit(PROJ, MASK, UA, u & 7, 31 - (u >> 3), 0, lds, wid); }
  const unsigned* order = (const unsigned*)(a.ws + WS_CTL + 4096); unsigned* qctr = (unsigned*)(a.ws + WS_CTL + 320);
  LAS unsigned* slot = (LAS unsigned*)(lds + 147456 - 64);
  for (;;) {
    if (wid == 0) { if (lane_id_v() == 0) slot[0] = __hip_atomic_fetch_add(qctr, 1u, __ATOMIC_RELAXED, __HIP_MEMORY_SCOPE_AGENT); }
    __syncthreads();
    const unsigned i = slot[0];
    __syncthreads();
    if (i >= 512u) break;
    const unsigned e = order[i]; const int u = (int)(e & 0xffffu), jm = (int)(e >> 16);
    attn_b_unit(PROJ, UB, a.in[9], ((const float*)(a.ws + WS_CTL))[0], u & 7, u >> 3, jm, lds, wid);
  }
}
#undef KSWZ
#undef SBAR
}


namespace idx {
typedef short bf16x8 __attribute__((ext_vector_type(8)));
typedef float f32x16 __attribute__((ext_vector_type(16)));
constexpr int NUNIT = 8 * (16 * 17 / 2);
__device__ __forceinline__ void scores_phase(const bf16_t* __restrict__ PROJ, float* SC, LAS unsigned char* lds, int blk, int nblk, const int wid) {
  const int lane = lane_id_v(), tid = wid * 64 + lane, n32 = lane & 31, hi = lane >> 5;
  const int skey = tid >> 3, schunk = tid & 7;
  const int swr = skey * 128 + ((schunk ^ (skey & 7)) << 4);
  for (int u = blk; u < NUNIT; u += nblk) {
    int g = 0, rem = u; while (rem >= 8 * (g + 1)) { rem -= 8 * (g + 1); ++g; }
    const int qc = 8 * g + rem / (g + 1), kc = rem % (g + 1);
    const int q0 = 64 * qc + 8 * wid, k_begin = 512 * kc, k_end = min(512 * kc + 512, 64 * qc + 64), ntile = (k_end - k_begin) / 64;
    bf16x8 af[4][4]; float w[4][16];
    const int head = (n32 & 3) + 4 * (n32 >> 3), qbit = (n32 >> 2) & 1;
#pragma unroll
    for (int t = 0; t < 4; ++t) {
      const bf16_t* qp = PROJ + (size_t)(q0 + 2 * t + qbit) * NPAD + C_QI + head * 64 + hi * 8;
#pragma unroll
      for (int ks = 0; ks < 4; ++ks) af[t][ks] = *(const bf16x8*)(qp + ks * 16);
      const bf16_t* wp = PROJ + (size_t)(q0 + 2 * t + hi) * NPAD + C_WI;
      const u32x4 w0 = *(const u32x4*)wp, w1 = *(const u32x4*)(wp + 8);
      const unsigned ww[8] = {w0.x, w0.y, w0.z, w0.w, w1.x, w1.y, w1.z, w1.w};
#pragma unroll
      for (int i = 0; i < 8; ++i) { w[t][2 * i] = bflo(ww[i]) * 0.03125f; w[t][2 * i + 1] = bfhi(ww[i]) * 0.03125f; }
    }
    u32x4 st = *(const u32x4*)(PROJ + (size_t)(k_begin + skey) * NPAD + C_KI + schunk * 8);
    __syncthreads();
    *(LAS u32x4*)(lds + swr) = st;
    __syncthreads();
    for (int tl = 0; tl < ntile; ++tl) {
      LAS const unsigned char* kb = lds + (tl & 1) * 8192;
      if (tl + 1 < ntile) st = *(const u32x4*)(PROJ + (size_t)(k_begin + 64 * (tl + 1) + skey) * NPAD + C_KI + schunk * 8);
#pragma unroll
      for (int kh = 0; kh < 2; ++kh) {
        const int krow = kh * 32 + n32;
        bf16x8 bfr[4];
#pragma unroll
        for (int ks = 0; ks < 4; ++ks) bfr[ks] = *(LAS const bf16x8*)(kb + krow * 128 + (((2 * ks + hi) ^ (krow & 7)) << 4));
        const int s = k_begin + 64 * tl + krow;
#pragma unroll
        for (int t = 0; t < 4; ++t) {
          f32x16 acc = {};
#pragma unroll
          for (int ks = 0; ks < 4; ++ks) acc = __builtin_amdgcn_mfma_f32_32x32x16_bf16(af[t][ks], bfr[ks], acc, 0, 0, 0);
          float sc = 0.f;
#pragma unroll
          for (int r = 0; r < 16; ++r) sc = fmaf(fmaxf(acc[r], 0.f), w[t][r], sc);
          const int q = q0 + 2 * t + hi;
          if (s <= q) SC[sc_off(q) + s] = sc;
        }
      }
      if (tl + 1 < ntile) { *(LAS u32x4*)(lds + ((tl + 1) & 1) * 8192 + swr) = st; }
      __syncthreads();
    }
  }
}
}

#ifdef DBG_STAGE
__device__ __forceinline__ void dbg_dump(const Args& a, int blk, int nblk) {
    const bf16_t* PROJ = (const bf16_t*)(a.ws + WS_PROJ);
    for (size_t idx = (size_t)blk * 512 + threadIdx.x; idx < (size_t)S * DM; idx += (size_t)nblk * 512) {
        const int r = (int)(idx / DM), c = (int)(idx % DM); float v = 0.f;
#if DBG_STAGE == 1 && defined(DBG_WEIGHTS)
        for (int z = 0; z < 3; ++z) v += bf2f(((const bf16_t*)(a.ws + WS_WTBR))[((size_t)z * 2048 + (r & 2047)) * 1024 + (c & 1023)]);
        v += bf2f(((const bf16_t*)(a.ws + WS_WTOUT))[(size_t)(r & 2047) * 2048 + c]);
#elif DBG_STAGE == 1 && defined(DBG_GATES)
        for (int j = 0; j < 3; ++j) v += bf2f(PROJ[(size_t)r * NPAD + C_GL + c + 2048 * j]);
#elif DBG_STAGE == 1
        for (int j = 0; j < 8; ++j) v += bf2f(PROJ[(size_t)r * NPAD + c + 2048 * j]);
        if (c < 1280) v += bf2f(PROJ[(size_t)r * NPAD + 16384 + c]);
        if (r < 256) v += bf2f(((const bf16_t*)(a.ws + WS_MKV))[(size_t)r * 2048 + c]);
        for (int z = 0; z < 3; ++z) v += bf2f(((const bf16_t*)(a.ws + WS_WTBR))[((size_t)z * 2048 + (r & 2047)) * 1024 + (c & 1023)]);
        v += bf2f(((const bf16_t*)(a.ws + WS_WTOUT))[(size_t)(r & 2047) * 2048 + c]);
#elif DBG_STAGE == 2
        if (c < 1024) v = bf2f(((const bf16_t*)(a.ws + WS_U))[(size_t)(S + r) * 1024 + c]) + bf2f(((const bf16_t*)(a.ws + WS_U))[(size_t)(2 * S + r) * 1024 + c]);
        else { const float* row = (const float*)(a.ws + WS_SC) + sc_off(r); for (int j = c - 1024; j <= r; j += 1024) v += row[j]; }
#elif DBG_STAGE == 3
        if (c < 256) v = (float)((const int*)(a.ws + WS_SEL))[(size_t)r * 256 + c];
#elif DBG_STAGE == 4
        if (c < 1024) v = bf2f(((const bf16_t*)(a.ws + WS_U))[(size_t)r * 1024 + c]);
#elif DBG_STAGE == 5
        v = bf2f(((const bf16_t*)(a.ws + WS_MERGED))[(size_t)r * DM + c]);
#endif
        a.out[idx] = v;
    }
}
#endif

__device__ __forceinline__ void grid_bar(unsigned* cnt, unsigned target, const int wave) {
    asm volatile("s_waitcnt vmcnt(0)" ::: "memory");
    __syncthreads();
    if (wave == 0) {
        if (lane_id_v() == 0) {
            __builtin_amdgcn_fence(__ATOMIC_RELEASE, "agent");
            asm volatile("s_waitcnt vmcnt(0)" ::: "memory");
            __hip_atomic_fetch_add(cnt, 1u, __ATOMIC_RELAXED, __HIP_MEMORY_SCOPE_AGENT);
            while (__hip_atomic_load(cnt, __ATOMIC_RELAXED, __HIP_MEMORY_SCOPE_AGENT) < target) __builtin_amdgcn_s_sleep(2);
            __builtin_amdgcn_fence(__ATOMIC_ACQUIRE, "agent");
            asm volatile("s_waitcnt vmcnt(0)" ::: "memory");
        }
    }
    __syncthreads();
}

constexpr int LDS_BYTES = 147456;
constexpr int NPHASE = 8;
__global__ void __launch_bounds__(512, 2) fwd(Args a) {
    extern __shared__ __attribute__((aligned(16))) unsigned char lds_raw[];
    LAS unsigned char* lds = (LAS unsigned char*)lds_raw;
    cg::grid_group grid = cg::this_grid();
    const int blk = blockIdx.x, nblk = gridDim.x, wave = __builtin_amdgcn_readfirstlane(threadIdx.x >> 6);
    unsigned char* ws = a.ws;
    const bf16_t* PROJ = (const bf16_t*)(ws + WS_PROJ);
#define IN(k) (a.ph_lo <= (k) && (k) < a.ph_hi)
#define SEAM(k) do { if (IN(k) && IN((k) + 1)) { if ((k) == 0) grid.sync(); else grid_bar((unsigned*)(ws + WS_CTL + 256), (unsigned)nblk * (unsigned)(k), wave); } } while (0)
    if (IN(0)) { p0_prologue(a, lds, blk, nblk, wave); } SEAM(0);
    if (IN(1)) {
        pg8::Gemm g{(const bf16_t*)(ws + WS_H), (const bf16_t*)(ws + WS_WTIN), S, NPAD, DM, (long)WS_MEMN - (long)WS_H, (long)WS_WTMKV - (long)WS_WTIN};
        pg8::ProjOrder so; so.init(S, NPAD, nblk, blk);
        pg8::EpiProj E{(bf16_t*)(ws + WS_PROJ), NPAD, (bf16_t*)(ws + WS_MKV), 2048, a.in[4], C_GL / 256, (unsigned*)(ws + WS_CTL + 1024)};
        pg8::gemm_phase<pg8::EpiProj, pg8::ProjOrder, true, true>(lds, g, so, E, wave);
    } SEAM(1);
    if (IN(2)) { idx::scores_phase(PROJ, (float*)(ws + WS_SC), lds, blk, nblk, wave); __syncthreads(); att::attn_m_phase(a, lds, blk, nblk, wave); } SEAM(2);
    if (IN(3)) { if (blk == nblk - 1) { if (wave == 7) att::build_order((const unsigned*)(ws + WS_CTL + 1024), (unsigned*)(ws + WS_CTL + 4096), lds + 131072, lane_id_v()); }
                 topk_select((const float*)(ws + WS_SC), (int*)(ws + WS_SEL), lds, blk, nblk, wave); } SEAM(3);
    if (IN(4)) { att::attn_ab_phase(a, lds, blk, nblk, wave); } SEAM(4);
    if (IN(5)) {
        pg8::Gemm g{(const bf16_t*)(ws + WS_U), (const bf16_t*)(ws + WS_WTBR), S, DM, 1024, (long)S * 1024 * 2, (long)2048 * 1024 * 2};
        pg8::MergeOrder so; so.init(S, DM, nblk, blk);
        pg8::EpiMerge E{PROJ + C_GL, NPAD, (bf16_t*)(ws + WS_MERGED), DM};
        pg8::gemm_phase<pg8::EpiMerge, pg8::MergeOrder, true, true>(lds, g, so, E, wave);
    } SEAM(5);
    if (IN(6)) {
        pg8::Gemm g{(const bf16_t*)(ws + WS_MERGED), (const bf16_t*)(ws + WS_WTOUT), S, DM, DM, 0, 0};
        pg8::StaticOrder so; so.init(S, DM, nblk, blk);
        pg8::EpiOut E{a.in[0], a.out, DM, (float*)(ws + WS_PART), S};
        pg8::gemm_phase<pg8::EpiOut, pg8::StaticOrder, false, true>(lds, g, so, E, wave);
    } SEAM(6);
    if (IN(7)) { final_norm(a, blk, nblk, wave); }
#ifdef DBG_STAGE
    if (IN(8)) { dbg_dump(a, blk, nblk); }
#endif
#undef IN
#undef SEAM
}

#ifndef N_LAUNCH_MODE
#define N_LAUNCH_MODE 0
#endif
extern "C" void kernel_launch(void* const* d_in, const int* in_sizes, int n_in, void* d_out, int out_size, void* d_ws, size_t ws_size, hipStream_t stream) {
    static int grid = 0;
    if (grid == 0) {
        if (n_in != 17 || in_sizes[0] != S * DM || in_sizes[3] != DM * DIN || out_size != S * DM || ws_size < WS_END) {
            fprintf(stderr, "kernel_launch: unexpected shapes (n_in %d, in0 %d, in3 %d, out %d, ws %zu < %zu)\n", n_in, n_in > 0 ? in_sizes[0] : -1, n_in > 3 ? in_sizes[3] : -1, out_size, ws_size, (size_t)WS_END); grid = -1; return; }
        int dev = 0, cus = 0, per_cu = 0;
        (void)hipGetDevice(&dev); (void)hipDeviceGetAttribute(&cus, hipDeviceAttributeMultiprocessorCount, dev);
        if (hipFuncSetAttribute((const void*)fwd, hipFuncAttributeMaxDynamicSharedMemorySize, LDS_BYTES) != hipSuccess) { fprintf(stderr, "kernel_launch: hipFuncSetAttribute failed\n"); grid = -1; return; }
        if (hipOccupancyMaxActiveBlocksPerMultiprocessor(&per_cu, (const void*)fwd, 512, LDS_BYTES) != hipSuccess || per_cu < 1) { fprintf(stderr, "kernel_launch: occupancy query gave %d\n", per_cu); per_cu = 1; }
        (void)hipGetLastError();
        grid = cus * 1;
        if (grid > cus * per_cu) grid = cus * per_cu;
        if (grid < 8) grid = -1;
    }
    if (grid < 0) return;
    Args a{};
    for (int i = 0; i < 17; ++i) a.in[i] = (const float*)d_in[i];
    a.out = (float*)d_out; a.ws = (unsigned char*)d_ws;
#if N_LAUNCH_MODE == 1
    (void)hipMemsetAsync((unsigned char*)d_ws + WS_CTL + 256, 0, 256, stream);
    a.ph_lo = 0; a.ph_hi = NPHASE;
    void* kargs[] = {&a};
    hipError_t e = hipLaunchCooperativeKernel((const void*)fwd, dim3(grid), dim3(512), kargs, LDS_BYTES, stream);
    if (e != hipSuccess) fprintf(stderr, "cooperative launch failed: %s (grid %d)\n", hipGetErrorString(e), grid);
#else
#ifdef DBG_STAGE
    #ifdef DBG_WEIGHTS
    constexpr int last_ph[6] = {0, 0, 2, 3, 4, 5};
#else
    constexpr int last_ph[6] = {0, 1, 2, 3, 4, 5};
#endif
    for (int p = 0; p <= last_ph[DBG_STAGE]; ++p) { a.ph_lo = p; a.ph_hi = p + 1; hipLaunchKernelGGL(fwd, dim3(grid), dim3(512), LDS_BYTES, stream, a); }
    a.ph_lo = 8; a.ph_hi = 9; hipLaunchKernelGGL(fwd, dim3(grid), dim3(512), LDS_BYTES, stream, a);
#else
    for (int p = 0; p < NPHASE; ++p) {
        a.ph_lo = p; a.ph_hi = p + 1;
        hipLaunchKernelGGL(fwd, dim3(grid), dim3(512), LDS_BYTES, stream, a);
    }
#endif
#endif
}
```

```cpp
#define N_LAUNCH_MODE 1
#include <hip/hip_runtime.h>
#include <hip/hip_cooperative_groups.h>
#include <cstdio>
#include <cstdint>
namespace cg = cooperative_groups;

__device__ __forceinline__ int lane_id_v() { int l; asm volatile("v_mbcnt_lo_u32_b32 %0, -1, 0\n\tv_mbcnt_hi_u32_b32 %0, -1, %0" : "=v"(l)); return l; }
namespace pg8 {
#define PG8_LAS __attribute__((address_space(3)))
typedef unsigned short bf16_t;
typedef short bf16x8 __attribute__((ext_vector_type(8)));
typedef float f32x4 __attribute__((ext_vector_type(4)));
typedef unsigned u32x4 __attribute__((ext_vector_type(4)));
constexpr int BM = 256, BK = 64, HALF = 128, HTB = HALF * BK * 2  , STAGE_BYTES = 8 * HTB, NXCD = 8, WGM = 8;

__host__ __device__ __forceinline__ int lds_byte(int r, int c) { const int st = (r >> 4) * 2 + (c >> 5), rr = r & 15, cc = c & 31, ob = rr * 64 + cc * 2; return st * 1024 + (ob ^ (((ob >> 9) & 1) << 5)); }
__host__ __device__ __forceinline__ void stage_rc(int b, int& R, int& C) { const int st = b / 1024, sb = b % 1024, swz = sb ^ (((sb >> 9) & 1) << 5); R = (st >> 1) * 16 + swz / 64; C = (st & 1) * 32 + (swz % 64) / 2; }
__host__ __device__ __forceinline__ int perm32(int rho) { const int n = rho >> 4, i = rho & 15; return 8 * (i >> 2) + 4 * n + (i & 3); }

struct Unit { int pm, pn, z; };
struct Gemm { const bf16_t* A; const bf16_t* Bt; int M, N, K; long zA, zB; };

struct StaticOrder {
    int nM, nN, nwg, G, c;
    __host__ __device__ void init(int M, int N, int G_, int c_) { nM = M / BM; nN = N / BM; nwg = nM * nN; G = G_; c = c_; }
    __host__ __device__ bool next(int i, Unit& u) const {
        const long L = (long)i * G + c; if (L >= nwg) return false;
        int wgid = (int)L; { const int q = nwg / NXCD, r = nwg % NXCD, xcd = wgid % NXCD, off = wgid / NXCD; wgid = (xcd < r ? xcd * (q + 1) : r * (q + 1) + (xcd - r) * q) + off; }
        const int nig = WGM * nN, gid = wgid / nig, fm = gid * WGM, gsz = (nM - fm) < WGM ? (nM - fm) : WGM;
        u.pm = fm + ((wgid % nig) % gsz); u.pn = (wgid % nig) / gsz; u.z = 0; return true;
    }
    __device__ __forceinline__ void a_ready(const Unit&) const {}
    __device__ __forceinline__ void done(const Unit&) const {}
};

typedef float f32x2_t __attribute__((ext_vector_type(2))); typedef __bf16 bf16x2_t __attribute__((ext_vector_type(2)));
__device__ __forceinline__ unsigned cvt_pk_bf16(float lo, float hi) { f32x2_t v = {lo, hi}; bf16x2_t b = __builtin_convertvector(v, bf16x2_t); return __builtin_bit_cast(unsigned, b); }

__device__ __forceinline__ float bf2f(unsigned short u) { return __uint_as_float((unsigned)u << 16); }
__device__ __forceinline__ float sigmoidf_(float v) { return __builtin_amdgcn_rcpf(1.0f + __builtin_amdgcn_exp2f(-1.4426950408889634f * v)); }
template <int MODE> __device__ __forceinline__ float act_(float v, float b) {
    if (MODE == 1) return v * sigmoidf_(v);
    if (MODE == 2) return sigmoidf_(v + b);
    return v;
}
struct EpiProj {
    static constexpr bool PERM = true, AFTER_DRAIN = false, KEEP_ACC = false;
    bf16_t* O; int ldc; bf16_t* O1; int ldc1; const float* bgate; int gate_tile0;
    unsigned* nslot;
    __device__ __forceinline__ void norms(const f32x4 (&acc)[2][2][4][2], const Unit& u, int wc, int lane) const {
        float wm[2] = {0.f, 0.f};
#pragma unroll
        for (int ai = 0; ai < 2; ++ai)
#pragma unroll
            for (int m = 0; m < 4; ++m)
#pragma unroll
                for (int bj = 0; bj < 2; ++bj) { const f32x4 a = acc[ai][bj][m][0], c = acc[ai][bj][m][1];
                    float s = (a[0] * a[0] + a[1] * a[1]) + (a[2] * a[2] + a[3] * a[3]) + (c[0] * c[0] + c[1] * c[1]) + (c[2] * c[2] + c[3] * c[3]);
                    s += __shfl_xor(s, 16); s += __shfl_xor(s, 32); wm[bj] = fmaxf(wm[bj], s); }
#pragma unroll
        for (int bj = 0; bj < 2; ++bj) { float v = wm[bj]; v = fmaxf(v, __shfl_xor(v, 1)); v = fmaxf(v, __shfl_xor(v, 2)); v = fmaxf(v, __shfl_xor(v, 4)); v = fmaxf(v, __shfl_xor(v, 8));
            if (lane == 0) atomicMax(nslot + (u.pn * 2 + bj) * 4 + wc, __float_as_uint(v)); }
    }
    template <int MODE> __device__ __forceinline__ void put(const f32x4 (&acc)[2][2][4][2], bf16_t* base, int ld, int row0, int col0, const float* bias) const {
        f32x4 bv[2][2];
#pragma unroll
        for (int bj = 0; bj < 2; ++bj)
#pragma unroll
            for (int n = 0; n < 2; ++n) bv[bj][n] = (MODE == 2) ? *(const f32x4*)(bias + bj * HALF + 4 * n) : (f32x4){0.f, 0.f, 0.f, 0.f};
#pragma unroll
        for (int ai = 0; ai < 2; ++ai)
#pragma unroll
            for (int m = 0; m < 4; ++m) { bf16_t* rowp = base + (size_t)(row0 + ai * HALF + m * 16) * ld + col0;
#pragma unroll
                for (int bj = 0; bj < 2; ++bj) { f32x4 v0 = acc[ai][bj][m][0], v1 = acc[ai][bj][m][1];
#pragma unroll
                    for (int e = 0; e < 4; ++e) { v0[e] = act_<MODE>(v0[e], bv[bj][0][e]); v1[e] = act_<MODE>(v1[e], bv[bj][1][e]); }
                    u32x4 w; w.x = cvt_pk_bf16(v0[0], v0[1]); w.y = cvt_pk_bf16(v0[2], v0[3]); w.z = cvt_pk_bf16(v1[0], v1[1]); w.w = cvt_pk_bf16(v1[2], v1[3]);
                    *(u32x4*)(rowp + bj * HALF) = w; } }
    }
    __device__ __forceinline__ void operator()(const f32x4 (&acc)[2][2][4][2], const Unit& u, int wr, int wc, int fr, int fq) const {
        const int row0 = u.pm * BM + wr * 64 + fr, col0 = u.pn * BM + wc * 32 + 8 * fq;
        if (u.z == 1) { put<0>(acc, O1, ldc1, row0, col0, nullptr); return; }
        const int t = u.pn;
        if (t < 8 || (t >= 20 && t < 28)) norms(acc, u, wc, fr + 16 * fq);
        const bool is_silu = (t >= 12 && t < 16) || (t >= 32 && t < 36) || (t >= 40 && t < 44);
        if (t >= gate_tile0 && t < 68) put<2>(acc, O, ldc, row0, col0, bgate + (col0 - gate_tile0 * BM));
        else if (is_silu) put<1>(acc, O, ldc, row0, col0, nullptr);
        else put<0>(acc, O, ldc, row0, col0, nullptr);
    }
};
struct EpiMerge {
    static constexpr bool PERM = true, AFTER_DRAIN = false, KEEP_ACC = true;
    const bf16_t* G; int ldg;
    bf16_t* O; int ldc;
    __device__ __forceinline__ static void unpack8(const u32x4 gw, f32x4& g0, f32x4& g1) {
        g0[0] = __uint_as_float(gw.x << 16); g0[1] = __uint_as_float(gw.x & 0xffff0000u); g0[2] = __uint_as_float(gw.y << 16); g0[3] = __uint_as_float(gw.y & 0xffff0000u);
        g1[0] = __uint_as_float(gw.z << 16); g1[1] = __uint_as_float(gw.z & 0xffff0000u); g1[2] = __uint_as_float(gw.w << 16); g1[3] = __uint_as_float(gw.w & 0xffff0000u); }
    __device__ __forceinline__ void operator()(f32x4 (&acc)[2][2][4][2], const Unit& u, int wr, int wc, int fr, int fq) const {
        const int row0 = u.pm * BM + wr * 64 + fr, col0 = u.pn * BM + wc * 32 + 8 * fq;
#pragma unroll
        for (int ai = 0; ai < 2; ++ai) {
            u32x4 ga[4][2], gb[4][2];
#pragma unroll
            for (int m = 0; m < 4; ++m)
#pragma unroll
                for (int bj = 0; bj < 2; ++bj) { const bf16_t* gp = G + (size_t)(row0 + ai * HALF + m * 16) * ldg + (size_t)u.z * 2048 + col0 + bj * HALF;
                    ga[m][bj] = *(const u32x4*)gp; gb[m][bj] = (u.z < 2) ? *(const u32x4*)(gp + 2048) : (u32x4){0u, 0u, 0u, 0u}; }
#pragma unroll
            for (int m = 0; m < 4; ++m) { const size_t row = (size_t)(row0 + ai * HALF + m * 16);
#pragma unroll
                for (int bj = 0; bj < 2; ++bj) { const int col = col0 + bj * HALF;
                    f32x4 a0, a1; unpack8(ga[m][bj], a0, a1);
                    f32x4 r0, r1;
                    if (u.z < 2) { f32x4 n0, n1; unpack8(gb[m][bj], n0, n1);
#pragma unroll
                        for (int e = 0; e < 4; ++e) { const float d0 = fmaxf(n0[e], 1e-30f), d1 = fmaxf(n1[e], 1e-30f);
                            const float x0 = (u.z == 0) ? a0[e] : fmaxf(a0[e], 1e-30f), x1 = (u.z == 0) ? a1[e] : fmaxf(a1[e], 1e-30f);
                            r0[e] = x0 * __builtin_amdgcn_rcpf(d0); r1[e] = x1 * __builtin_amdgcn_rcpf(d1); }
                        acc[ai][bj][m][0] *= r0; acc[ai][bj][m][1] *= r1;
                    } else {
#pragma unroll
                        for (int e = 0; e < 4; ++e) { r0[e] = fmaxf(a0[e], 1e-30f); r1[e] = fmaxf(a1[e], 1e-30f); }
                        const f32x4 v0 = acc[ai][bj][m][0] * r0, v1 = acc[ai][bj][m][1] * r1;
                        u32x4 w; w.x = cvt_pk_bf16(v0[0], v0[1]); w.y = cvt_pk_bf16(v0[2], v0[3]); w.z = cvt_pk_bf16(v1[0], v1[1]); w.w = cvt_pk_bf16(v1[2], v1[3]);
                        *(u32x4*)(O + row * ldc + col) = w;
                        acc[ai][bj][m][0] = (f32x4){0.f, 0.f, 0.f, 0.f}; acc[ai][bj][m][1] = (f32x4){0.f, 0.f, 0.f, 0.f}; } } }
        }
    }
};
struct EpiOut {
    static constexpr bool PERM = false, AFTER_DRAIN = false, KEEP_ACC = false;
    const float* X; float* Y; int ldc; float* part; int M;
    __device__ __forceinline__ void operator()(const f32x4 (&acc)[2][2][4][2], const Unit& u, int wr, int wc, int fr, int fq) const {
        const int row0 = u.pm * BM + wr * 64 + fr, col0 = u.pn * BM + wc * 32 + 4 * fq;
#pragma unroll
        for (int ai = 0; ai < 2; ++ai) {
            f32x4 xv[4][2][2];
#pragma unroll
            for (int m = 0; m < 4; ++m)
#pragma unroll
                for (int bj = 0; bj < 2; ++bj)
#pragma unroll
                    for (int n = 0; n < 2; ++n) xv[m][bj][n] = *(const f32x4*)(X + (size_t)(row0 + ai * HALF + m * 16) * ldc + col0 + bj * HALF + n * 16);
#pragma unroll
            for (int m = 0; m < 4; ++m) { const size_t row = (size_t)(row0 + ai * HALF + m * 16); float ss = 0.f;
#pragma unroll
                for (int bj = 0; bj < 2; ++bj)
#pragma unroll
                    for (int n = 0; n < 2; ++n) { const size_t off = row * ldc + col0 + bj * HALF + n * 16;
                        const f32x4 y = xv[m][bj][n] + acc[ai][bj][m][n]; *(f32x4*)(Y + off) = y;
                        ss += (y[0] * y[0] + y[1] * y[1]) + (y[2] * y[2] + y[3] * y[3]); }
                ss += __shfl_xor(ss, 16); ss += __shfl_xor(ss, 32);
                if (fq == 0) part[(size_t)(u.pn * 4 + wc) * M + row] = ss; }
        }
    }
};
struct ProjOrder {
    StaticOrder so; int nmain, extra;
    __device__ void init(int M, int N, int G, int c) { so.init(M, N, G, c); nmain = (so.nwg - c + G - 1) / G; extra = (c >= G - 8) ? c - (G - 8) : -1; }
    __device__ bool next(int i, Unit& u) const {
        if (i < nmain) return so.next(i, u);
        if (i == nmain && extra >= 0) { u.pm = 0; u.pn = extra; u.z = 1; return true; }
        return false;
    }
    __device__ __forceinline__ void a_ready(const Unit&) const {}
    __device__ __forceinline__ void done(const Unit&) const {}
};
struct MergeOrder {
    StaticOrder so;
    __device__ void init(int M, int N, int G, int c) { so.init(M, N, G, c); }
    __device__ bool next(int i, Unit& u) const { if (i >= 3) return false; if (!so.next(0, u)) return false; u.z = i; return true; }
    __device__ __forceinline__ void a_ready(const Unit&) const {}
    __device__ __forceinline__ void done(const Unit&) const {}
};

template <class Epi, class Sched, bool ALIGN_EPI = false, bool SP2 = false>
__device__ __forceinline__ void gemm_phase(PG8_LAS unsigned char* lds, const Gemm g, const Sched& S, const Epi& E, const int wid  ) {
    const int lane = lane_id_v(), tid = wid * 64 + lane, wr = wid >> 2, wc = wid & 3, fr = lane & 15, fq = lane >> 4;
    const int K = g.K, nt = K / BK;
    unsigned voffA[2], voffB[2];
#pragma unroll
    for (int i = 0; i < 2; ++i) { int R, C; stage_rc(tid * 16 + i * 8192, R, C); const int Rb = Epi::PERM ? ((R & ~31) + perm32(R & 31)) : R;
        voffA[i] = (unsigned)(R * K + C) * 2u; voffB[i] = (unsigned)(Rb * K + C) * 2u; }
    const size_t kstep = (size_t)(BK * 2);
    const size_t hstep = (size_t)HALF * K * 2;
    const size_t tstep = 2 * hstep;
    const unsigned ldsw = (unsigned)wid * 1024u;
    const int aoff = lds_byte(wr * 64 + fr, fq * 8), boff = lds_byte(wc * 32 + fr, fq * 8);
#define PG8_SA(b, h) (((b) * 2 + (h)) * HTB)
#define PG8_SB(b, h) ((4 + (b) * 2 + (h)) * HTB)
#define PG8_STAGE(bufoff, gbase, voff) do { _Pragma("unroll") for (int _i = 0; _i < 2; ++_i) \
        __builtin_amdgcn_global_load_lds((const unsigned*)((const char*)(gbase) + (voff)[_i]), (PG8_LAS unsigned*)(lds + (bufoff) + ldsw + _i * 8192), 16, 0, 0); } while (0)
#define PG8_LDA(dst, b, h) do { _Pragma("unroll") for (int m = 0; m < 4; ++m) _Pragma("unroll") for (int k = 0; k < 2; ++k) dst[m][k] = *(const PG8_LAS bf16x8*)(lds + PG8_SA(b, h) + aoff + m * 2048 + k * 1024); } while (0)
#define PG8_LDB(dst, b, h) do { _Pragma("unroll") for (int n = 0; n < 2; ++n) _Pragma("unroll") for (int k = 0; k < 2; ++k) dst[n][k] = *(const PG8_LAS bf16x8*)(lds + PG8_SB(b, h) + boff + n * 2048 + k * 1024); } while (0)
#define PG8_MMA(ai, bj, At, Bt) do { __builtin_amdgcn_s_setprio(1); _Pragma("unroll") for (int m = 0; m < 4; ++m) _Pragma("unroll") for (int n = 0; n < 2; ++n) _Pragma("unroll") for (int k = 0; k < 2; ++k) \
        acc[ai][bj][m][n] = __builtin_amdgcn_mfma_f32_16x16x32_bf16(Bt[n][k], At[m][k], acc[ai][bj][m][n], 0, 0, 0); __builtin_amdgcn_s_setprio(0); } while (0)
#define PG8_WAIT_V(n) asm volatile("s_waitcnt vmcnt(" #n ")" ::: "memory")
#define PG8_WAIT_L(n) asm volatile("s_waitcnt lgkmcnt(" #n ")" ::: "memory")
#define PG8_BAR __builtin_amdgcn_s_barrier()
#define PG8_SCHED __builtin_amdgcn_sched_barrier(0)
    Unit cur, nxt; int ui = 0;
    if (!S.next(0, cur)) return;
    f32x4 acc[2][2][4][2];
#pragma unroll
    for (int a = 0; a < 2; ++a)
#pragma unroll
        for (int b = 0; b < 2; ++b)
#pragma unroll
            for (int m = 0; m < 4; ++m)
#pragma unroll
                for (int n = 0; n < 2; ++n) acc[a][b][m][n] = (f32x4){0.f, 0.f, 0.f, 0.f};
    bf16x8 At[4][2], B0[2][2], B1[2][2];
    const char* cA = (const char*)g.A + (long)cur.z * g.zA + (size_t)cur.pm * tstep; const char* cB = (const char*)g.Bt + (long)cur.z * g.zB + (size_t)cur.pn * tstep;
    S.a_ready(cur);
    if constexpr (SP2) {
        PG8_STAGE(PG8_SB(0, 0), cB, voffB); PG8_STAGE(PG8_SB(0, 1), cB + hstep, voffB); PG8_STAGE(PG8_SA(0, 0), cA, voffA); PG8_STAGE(PG8_SA(0, 1), cA + hstep, voffA);
        if (wr == 1) PG8_BAR;
        PG8_WAIT_V(2); PG8_BAR;
        PG8_STAGE(PG8_SB(1, 0), cB + kstep, voffB); PG8_STAGE(PG8_SA(1, 0), cA + kstep, voffA); PG8_STAGE(PG8_SB(1, 1), cB + hstep + kstep, voffB);
        PG8_WAIT_V(6); PG8_BAR;
    } else {
        PG8_STAGE(PG8_SB(0, 0), cB, voffB); PG8_STAGE(PG8_SA(0, 0), cA, voffA); PG8_STAGE(PG8_SB(0, 1), cB + hstep, voffB); PG8_STAGE(PG8_SA(0, 1), cA + hstep, voffA);
        if (wr == 1) PG8_BAR;
        PG8_WAIT_V(4); PG8_BAR;
        PG8_STAGE(PG8_SB(1, 0), cB + kstep, voffB); PG8_STAGE(PG8_SA(1, 0), cA + kstep, voffA); PG8_STAGE(PG8_SB(1, 1), cB + hstep + kstep, voffB);
        PG8_WAIT_V(6); PG8_BAR;
    }
    for (;;) {
        const bool has_next = S.next(ui + 1, nxt);
        const char* nA = has_next ? (const char*)g.A + (long)nxt.z * g.zA + (size_t)nxt.pm * tstep : cA; const char* nB = has_next ? (const char*)g.Bt + (long)nxt.z * g.zB + (size_t)nxt.pn * tstep : cB;
        for (int t = 0; t < nt; t += 2) {
            const bool last = (t == nt - 2);
            const char* a1 = cA + (size_t)(t + 1) * kstep;
            const char* a2 = last ? nA : cA + (size_t)(t + 2) * kstep; const char* b2 = last ? nB : cB + (size_t)(t + 2) * kstep;
            const char* a3 = a2 + kstep; const char* b3 = b2 + kstep;
            if (last && has_next) S.a_ready(nxt);
            if constexpr (SP2) {
            PG8_LDB(B0, 0, 0); PG8_LDB(B1, 0, 1); PG8_SCHED; PG8_LDA(At, 0, 0); PG8_STAGE(PG8_SA(1, 1), a1 + hstep, voffA);
            PG8_WAIT_V(8); PG8_WAIT_L(0); PG8_BAR; PG8_MMA(0, 0, At, B0); PG8_MMA(0, 1, At, B1); PG8_BAR; PG8_SCHED;
            PG8_LDA(At, 0, 1); PG8_STAGE(PG8_SB(0, 0), b2, voffB); PG8_STAGE(PG8_SB(0, 1), b2 + hstep, voffB); PG8_STAGE(PG8_SA(0, 0), a2, voffA);
            PG8_WAIT_V(8); PG8_WAIT_L(0); PG8_BAR; PG8_MMA(1, 0, At, B0); PG8_MMA(1, 1, At, B1); PG8_BAR; PG8_SCHED;
            PG8_LDB(B0, 1, 0); PG8_LDB(B1, 1, 1); PG8_SCHED; PG8_LDA(At, 1, 0); PG8_STAGE(PG8_SA(0, 1), a2 + hstep, voffA);
            PG8_WAIT_V(8); PG8_WAIT_L(0); PG8_BAR; PG8_MMA(0, 0, At, B0); PG8_MMA(0, 1, At, B1); PG8_BAR; PG8_SCHED;
            PG8_LDA(At, 1, 1); PG8_STAGE(PG8_SB(1, 0), b3, voffB); PG8_STAGE(PG8_SB(1, 1), b3 + hstep, voffB); PG8_STAGE(PG8_SA(1, 0), a3, voffA);
            PG8_WAIT_V(8); PG8_WAIT_L(0); PG8_BAR; PG8_MMA(1, 0, At, B0); PG8_MMA(1, 1, At, B1); PG8_BAR; PG8_SCHED;
            } else {
            PG8_LDB(B0, 0, 0); PG8_SCHED; PG8_LDA(At, 0, 0); PG8_STAGE(PG8_SA(1, 1), a1 + hstep, voffA);
            PG8_WAIT_L(8); PG8_BAR; PG8_WAIT_L(0); PG8_MMA(0, 0, At, B0); PG8_BAR; PG8_SCHED;
            PG8_LDB(B1, 0, 1); PG8_STAGE(PG8_SB(0, 0), b2, voffB);
            PG8_BAR; PG8_WAIT_L(0); PG8_MMA(0, 1, At, B1); PG8_BAR;
            PG8_LDA(At, 0, 1); PG8_STAGE(PG8_SA(0, 0), a2, voffA);
            PG8_BAR; PG8_WAIT_L(0); PG8_MMA(1, 0, At, B0); PG8_BAR; PG8_SCHED;
            PG8_STAGE(PG8_SB(0, 1), b2 + hstep, voffB);
            PG8_WAIT_V(6); PG8_BAR; PG8_MMA(1, 1, At, B1); PG8_BAR;
            PG8_LDB(B0, 1, 0); PG8_SCHED; PG8_LDA(At, 1, 0); PG8_STAGE(PG8_SA(0, 1), a2 + hstep, voffA);
            PG8_WAIT_L(8); PG8_BAR; PG8_WAIT_L(0); PG8_MMA(0, 0, At, B0); PG8_BAR; PG8_SCHED;
            PG8_LDB(B1, 1, 1); PG8_STAGE(PG8_SB(1, 0), b3, voffB);
            PG8_BAR; PG8_WAIT_L(0); PG8_MMA(0, 1, At, B1); PG8_BAR;
            PG8_LDA(At, 1, 1); PG8_STAGE(PG8_SA(1, 0), a3, voffA);
            PG8_BAR; PG8_WAIT_L(0); PG8_MMA(1, 0, At, B0); PG8_BAR; PG8_SCHED;
            PG8_STAGE(PG8_SB(1, 1), b3 + hstep, voffB);
            PG8_WAIT_V(6); PG8_BAR; PG8_MMA(1, 1, At, B1); PG8_BAR;
            }
        }
        if constexpr (ALIGN_EPI) { if (wr == 0) PG8_BAR; }
        if constexpr (!Epi::AFTER_DRAIN) { E(acc, cur, wr, wc, fr, fq); S.done(cur); }
        if (!has_next) break;
        if constexpr (!Epi::KEEP_ACC) {
#pragma unroll
        for (int a = 0; a < 2; ++a)
#pragma unroll
            for (int b = 0; b < 2; ++b)
#pragma unroll
                for (int m = 0; m < 4; ++m)
#pragma unroll
                    for (int n = 0; n < 2; ++n) acc[a][b][m][n] = (f32x4){0.f, 0.f, 0.f, 0.f};
        }
        cur = nxt; cA = nA; cB = nB; ++ui;
        if constexpr (ALIGN_EPI) { if (wr == 1) PG8_BAR; }
    }
    PG8_WAIT_V(0);
    if constexpr (!ALIGN_EPI) { if (wr == 0) PG8_BAR; }
    PG8_BAR;
    if constexpr (Epi::AFTER_DRAIN) { E.fused(acc, cur, wr, wc, fr, fq, lds, wid, lane); S.done(cur); }
#undef PG8_SA
#undef PG8_SB
#undef PG8_STAGE
#undef PG8_LDA
#undef PG8_LDB
#undef PG8_MMA
#undef PG8_WAIT_V
#undef PG8_WAIT_L
#undef PG8_BAR
#undef PG8_SCHED
}
}

constexpr int S = 8192, DM = 2048, DIN = 17488, NPAD = 17664, NMEM = 256;
constexpr int C_QA = 0, C_KA = 1024, C_VA = 2048, C_ZA = 3072, C_QI = 4096, C_QB = 5120, C_KB = 6144, C_VB = 7168, C_ZB = 8192, C_QM = 9216, C_ZM = 10240, C_GL = 11264, C_KI = 17408, C_WI = 17472;
constexpr int TOPK = 256;
constexpr float RMS_EPS = 1e-6f;
constexpr size_t MiB = 1u << 20;
constexpr size_t WS_CTL = 0;
constexpr size_t WS_WTIN = 1 * MiB;
constexpr size_t WS_U = 1 * MiB;
constexpr size_t WS_WTMKV = 70 * MiB;
constexpr size_t WS_WTBR = 78 * MiB;
constexpr size_t WS_WTOUT = 90 * MiB;
constexpr size_t WS_MEMN = 98 * MiB;
constexpr size_t WS_MKV = 99 * MiB;
constexpr size_t WS_PROJ = 100 * MiB;
constexpr size_t WS_SC = 376 * MiB;
constexpr size_t WS_MERGED = 376 * MiB;
constexpr size_t WS_H = 376 * MiB;
constexpr size_t WS_T = 408 * MiB;
constexpr size_t WS_SEL = 508 * MiB;
constexpr size_t WS_PART = 516 * MiB;
constexpr size_t WS_END = 517 * MiB;

typedef unsigned short bf16_t;
typedef unsigned u32x4 __attribute__((ext_vector_type(4)));
typedef unsigned u32x2 __attribute__((ext_vector_type(2)));
typedef float f32x4 __attribute__((ext_vector_type(4)));
#define LAS __attribute__((address_space(3)))
__device__ __forceinline__ float bf2f(unsigned short u) { return __uint_as_float((unsigned)u << 16); }
__device__ __forceinline__ float bflo(unsigned w) { return __uint_as_float(w << 16); }
__device__ __forceinline__ float bfhi(unsigned w) { return __uint_as_float(w & 0xffff0000u); }
__device__ __forceinline__ unsigned f2bf(float f) { unsigned u = __float_as_uint(f); return (u + 0x7fffu + ((u >> 16) & 1u)) >> 16; }
__device__ __forceinline__ unsigned pk2(float lo, float hi) { return f2bf(lo) | (f2bf(hi) << 16); }
__device__ __forceinline__ float wave_sum(float v) {
#pragma unroll
    for (int o = 1; o < 64; o <<= 1) v += __shfl_xor(v, o);
    return v;
}
__device__ __forceinline__ size_t sc_off(int r) { const size_t i = (size_t)(r >> 8); return 65536ull * (i * (i + 1) / 2) + (size_t)(r & 255) * 256ull * (i + 1); }

struct Args { const float* in[17]; float* out; unsigned char* ws; int ph_lo, ph_hi; };

template <bool MAPIN>
__device__ __forceinline__ void transpose_item(const float* __restrict__ W, int K, int srcN, bf16_t* WT, LAS float* scr, int item, int ndst, int lane) {
    const int nblk = ndst / 32, kb = item / nblk, nb = item % nblk, k0 = 64 * kb, n0 = 32 * nb;
    const int n = n0 + (lane & 31);
    int src = n;
    if (MAPIN) { src = (n < 5120) ? n : (n < 17408) ? n + 80 : (n < 17488) ? n - 17408 + 5120 : -1; }
    float tv[32];
#pragma unroll
    for (int i = 0; i < 32; ++i) { const int kk = 2 * i + (lane >> 5); tv[i] = (src >= 0) ? W[(size_t)(k0 + kk) * srcN + src] : 0.f; }
#pragma unroll
    for (int i = 0; i < 32; ++i) { const int kk = 2 * i + (lane >> 5); scr[kk * 33 + (lane & 31)] = tv[i]; }
    asm volatile("s_waitcnt lgkmcnt(0)" ::: "memory");
    const int c = lane & 7;
#pragma unroll
    for (int j = 0; j < 4; ++j) { const int nn = (lane >> 3) + 8 * j; const LAS float* s = scr + (8 * c) * 33 + nn;
        u32x4 o; o.x = pk2(s[0 * 33], s[1 * 33]); o.y = pk2(s[2 * 33], s[3 * 33]); o.z = pk2(s[4 * 33], s[5 * 33]); o.w = pk2(s[6 * 33], s[7 * 33]);
        *(u32x4*)(WT + (size_t)(n0 + nn) * K + k0 + 8 * c) = o; }
    asm volatile("s_waitcnt lgkmcnt(0)" ::: "memory");
}
__device__ __forceinline__ void rms_row_to_bf16(const float* __restrict__ xrow, const float* __restrict__ g, bf16_t* orow, int lane) {
    const f32x4* xr = (const f32x4*)xrow + lane; const f32x4* gr = (const f32x4*)g + lane;
    f32x4 v[8]; float s = 0.f;
#pragma unroll
    for (int j = 0; j < 8; ++j) { v[j] = xr[64 * j]; s += (v[j].x * v[j].x + v[j].y * v[j].y) + (v[j].z * v[j].z + v[j].w * v[j].w); }
    const float rs = 1.0f / sqrtf(wave_sum(s) * (1.f / DM) + RMS_EPS);
    u32x2* o8 = (u32x2*)orow + lane;
#pragma unroll
    for (int j = 0; j < 8; ++j) { const f32x4 gg = gr[64 * j]; u32x2 w; w.x = pk2(v[j].x * rs * gg.x, v[j].y * rs * gg.y); w.y = pk2(v[j].z * rs * gg.z, v[j].w * rs * gg.w); o8[64 * j] = w; }
}
__device__ __forceinline__ void p0_prologue(const Args& a, LAS unsigned char* lds, int blk, int nblk, const int wave) {
    const int lane = lane_id_v(), tid = wave * 64 + lane;
    LAS float* scr = (LAS float*)(lds + wave * 16384);
    const int gw = blk * 8 + wave, NGW = nblk * 8;
    unsigned char* ws = a.ws;
    constexpr int I_IN = (DM / 64) * (NPAD / 32), I_MKV = (DM / 64) * (2048 / 32), I_BR = (1024 / 64) * (2048 / 32), I_OUT = (DM / 64) * (2048 / 32);
    constexpr int NITEMS = I_IN + I_MKV + 3 * I_BR + I_OUT;
    for (int it = gw; it < NITEMS; it += NGW) {
        int r = it;
        if (r < I_IN) { transpose_item<true>(a.in[3], DM, DIN, (bf16_t*)(ws + WS_WTIN), scr, r, NPAD, lane); continue; } r -= I_IN;
        if (r < I_MKV) { transpose_item<false>(a.in[11], DM, 2048, (bf16_t*)(ws + WS_WTMKV), scr, r, 2048, lane); continue; } r -= I_MKV;
        if (r < 3 * I_BR) { const int z = r / I_BR; transpose_item<false>(a.in[12 + z], 1024, 2048, (bf16_t*)(ws + WS_WTBR) + (size_t)z * 2048 * 1024, scr, r % I_BR, 2048, lane); continue; } r -= 3 * I_BR;
        transpose_item<false>(a.in[15], DM, 2048, (bf16_t*)(ws + WS_WTOUT), scr, r, 2048, lane);
    }
    bf16_t* H = (bf16_t*)(ws + WS_H);
    for (int m = gw; m < S + NMEM; m += NGW) {
        if (m < S) rms_row_to_bf16(a.in[0] + (size_t)m * DM, a.in[2], H + (size_t)m * DM, lane);
        else rms_row_to_bf16(a.in[1] + (size_t)(m - S) * DM, a.in[10], (bf16_t*)(ws + WS_MEMN) + (size_t)(m - S) * DM, lane);
    }
    if (blk == 0) { for (int i = tid; i < 640; i += 512) ((unsigned*)(ws + WS_CTL + 1024))[i] = 0u; }
    if (blk == 0 && wave == 0) {
        const float s1 = wave_sum(a.in[5][lane] * a.in[6][lane]), s2 = wave_sum(a.in[7][lane] * a.in[8][lane]);
        if (lane == 0) ((float*)(ws + WS_CTL))[0] = expf(s1) - expf(s2) + 0.2f;
    }
}

__device__ __forceinline__ void idx_scores_naive(const bf16_t* __restrict__ PROJ, float* SC, LAS unsigned char* lds, int blk, int nblk, const int wave) {
    const int lane = lane_id_v(), tid = wave * 64 + lane;
    LAS float* qs = (LAS float*)lds + wave * 1088;
    constexpr int NITEM = 128 * 129 / 2;
    for (int it = blk; it < NITEM; it += nblk) {
        int kb = 0, rem = it; while (rem >= 128 - kb) { rem -= 128 - kb; ++kb; }
        const int qc = kb + rem, s = 64 * kb + lane;
        float kreg[64];
        { const u32x4* kp = (const u32x4*)(PROJ + (size_t)s * NPAD + C_KI);
#pragma unroll
          for (int i = 0; i < 8; ++i) { const u32x4 w = kp[i]; kreg[8 * i + 0] = bflo(w.x); kreg[8 * i + 1] = bfhi(w.x); kreg[8 * i + 2] = bflo(w.y); kreg[8 * i + 3] = bfhi(w.y);
              kreg[8 * i + 4] = bflo(w.z); kreg[8 * i + 5] = bfhi(w.z); kreg[8 * i + 6] = bflo(w.w); kreg[8 * i + 7] = bfhi(w.w); } }
        for (int qq = 0; qq < 8; ++qq) {
            const int q = 64 * qc + wave * 8 + qq;
            { const u32x4* qp = (const u32x4*)(PROJ + (size_t)q * NPAD + C_QI) + 2 * lane;
              const u32x4 w0 = qp[0], w1 = qp[1];
              LAS f32x4* dst = (LAS f32x4*)(qs + 16 * lane);
              dst[0] = (f32x4){bflo(w0.x), bfhi(w0.x), bflo(w0.y), bfhi(w0.y)}; dst[1] = (f32x4){bflo(w0.z), bfhi(w0.z), bflo(w0.w), bfhi(w0.w)};
              dst[2] = (f32x4){bflo(w1.x), bfhi(w1.x), bflo(w1.y), bfhi(w1.y)}; dst[3] = (f32x4){bflo(w1.z), bfhi(w1.z), bflo(w1.w), bfhi(w1.w)};
              if (lane < 16) qs[1024 + lane] = bf2f(PROJ[(size_t)q * NPAD + C_WI + lane]) * 0.25f; }
            asm volatile("s_waitcnt lgkmcnt(0)" ::: "memory"); __builtin_amdgcn_wave_barrier();
            float score = 0.f;
            for (int j = 0; j < 16; ++j) {
                float acc = 0.f; const LAS f32x4* qj = (const LAS f32x4*)(qs + 64 * j);
#pragma unroll
                for (int d = 0; d < 16; ++d) { const f32x4 qv = qj[d]; acc += qv.x * kreg[4 * d] + qv.y * kreg[4 * d + 1] + qv.z * kreg[4 * d + 2] + qv.w * kreg[4 * d + 3]; }
                score += fmaxf(acc * 0.125f, 0.f) * qs[1024 + j];
            }
            if (s <= q) SC[sc_off(q) + s] = score;
            asm volatile("s_waitcnt lgkmcnt(0)" ::: "memory"); __builtin_amdgcn_wave_barrier();
        }
    }
}
__device__ __forceinline__ unsigned ordkey(float f) { const unsigned u = __float_as_uint(f); return (u & 0x80000000u) ? ~u : (u | 0x80000000u); }
template <int NR, int NL> __device__ __forceinline__ bool topk_row(const float* __restrict__ row, int n, int lane, LAS u32x4* xl, unsigned long long& w0, unsigned long long& w1, unsigned& Tout, int& need_out) {
#pragma unroll
    for (int q = 0; q < NL / 4; ++q) { u32x4 v;
#pragma unroll
        for (int e = 0; e < 4; ++e) { const int i = 4096 + (4 * q + e) * 64 + lane; v[e] = (ordkey(*(const float*)((const char*)row + 4u * (unsigned)min(i, n - 1))) >> 1) & (unsigned)((i - n) >> 31); }
        xl[q * 64 + lane] = v;
        if ((q & 3) == 3) __builtin_amdgcn_sched_barrier(0); }
    unsigned u[NR];
#pragma unroll
    for (int k = 0; k < NR; ++k) { const int i = k * 64 + lane; u[k] = (ordkey(*(const float*)((const char*)row + 4u * (unsigned)min(i, n - 1))) >> 1) & (unsigned)((i - n) >> 31);
        if ((k & 15) == 15) __builtin_amdgcn_sched_barrier(0); }
    unsigned T = 0u; bool cut = false;
    for (int bit = 30; bit >= 0; --bit) {
        const unsigned cand = T | (1u << bit); unsigned lt = 0u;
        asm volatile("" ::: "memory");
#pragma unroll
        for (int k = 0; k < NR; ++k) lt += (u[k] - cand) >> 31;
#pragma unroll
        for (int q = 0; q < NL / 4; ++q) { const u32x4 v = xl[q * 64 + lane]; lt += ((v[0] - cand) >> 31) + ((v[1] - cand) >> 31) + ((v[2] - cand) >> 31) + ((v[3] - cand) >> 31);
            if ((q & 3) == 3) __builtin_amdgcn_sched_barrier(0); }
#pragma unroll
        for (int o = 1; o < 64; o <<= 1) lt += __shfl_xor(lt, o);
        const int ge = (int)((NR + NL) * 64 - lt);
        if (ge >= TOPK) T = cand;
        if (ge == TOPK) { cut = true; break; }
    }
    unsigned c_hi = 0u, c_lt = 0u;
#pragma unroll
    for (int k = 0; k < NR; ++k) { c_hi += (T - u[k]) >> 31; c_lt += (u[k] - T) >> 31; }
#pragma unroll
    for (int q = 0; q < NL / 4; ++q) { const u32x4 v = xl[q * 64 + lane];
#pragma unroll
        for (int e = 0; e < 4; ++e) { c_hi += (T - v[e]) >> 31; c_lt += (v[e] - T) >> 31; } }
#pragma unroll
    for (int o = 1; o < 64; o <<= 1) { c_hi += __shfl_xor(c_hi, o); c_lt += __shfl_xor(c_lt, o); }
    const int need = TOPK - (int)c_hi, c_eq = (NR + NL) * 64 - (int)c_lt - (int)c_hi;
    Tout = T; need_out = need;
    if (!cut && c_eq != need) return false;
    int ln; asm volatile("v_mbcnt_lo_u32_b32 %0, -1, 0\n\tv_mbcnt_hi_u32_b32 %0, -1, %0" : "=v"(ln));
#pragma unroll
    for (int k = 0; k < NR; ++k) {
        const unsigned long long bs = __ballot(u[k] >= T);
        if (k == ln) w0 = bs;
        __builtin_amdgcn_sched_barrier(0); }
#pragma unroll
    for (int q = 0; q < NL / 4; ++q) { const u32x4 v = xl[q * 64 + lane];
#pragma unroll
        for (int e = 0; e < 4; ++e) { const unsigned long long bs = __ballot(v[e] >= T);
            if (4 * q + e == ln) w1 = bs;
            __builtin_amdgcn_sched_barrier(0); } }
    return true;
}
__device__ __forceinline__ void topk_select(const float* SC, int* SEL, LAS unsigned char* lds, int blk, int nblk, const int wave) {
    const int lane = lane_id_v();
    LAS u32x4* xl = (LAS u32x4*)(lds + wave * 16384);
    for (int r = blk * 8 + wave; r < S; r += nblk * 8) {
        const int n = r + 1; unsigned long long* mrow = (unsigned long long*)SEL + (size_t)r * 128;
        unsigned long long w0 = 0ull, w1 = 0ull;
        const int nwords = 4 * ((r >> 8) + 1);
        if (n <= TOPK) { const int lo = 64 * lane; w0 = (r < lo) ? 0ull : ((r - lo >= 63) ? ~0ull : ((2ull << (r - lo)) - 1ull)); }
        else { const float* row = SC + sc_off(r);
            unsigned T; int need; bool ok;
            if (n <= 2048) ok = topk_row<32, 0>(row, n, lane, xl, w0, w1, T, need); else if (n <= 4096) ok = topk_row<64, 0>(row, n, lane, xl, w0, w1, T, need); else ok = topk_row<64, 64>(row, n, lane, xl, w0, w1, T, need);
            if (!ok) { int eqc = 0; const unsigned long long lt = (lane == 0) ? 0ull : (~0ull >> (64 - lane));
                for (int base = 0, it = 0; base < n; base += 64, ++it) {
                    const int i = base + lane; const unsigned v = (i < n) ? (ordkey(row[i]) >> 1) : 0u;
                    const bool gt = v > T, eq = (i < n) && (v == T);
                    const unsigned long long be = __ballot(eq);
                    const bool take = gt || (eq && (eqc + __builtin_popcountll(be & lt) < need));
                    const unsigned long long bs = __ballot(take);
                    if ((it & 63) == lane) { if (it < 64) w0 = bs; else w1 = bs; }
                    eqc += __builtin_popcountll(be); } } }
        if (lane < nwords) mrow[lane] = w0;
        if (64 + lane < nwords) mrow[64 + lane] = w1;
    }
}
template <int DQ, int DV, bool GATHER>
__device__ __forceinline__ void naive_attn(const bf16_t* __restrict__ qp, const bf16_t* __restrict__ kb, const bf16_t* __restrict__ vb, size_t kvpitch,
                                           int nkeys, int nmax, const int* __restrict__ sel, int r, float scale, float slope, float (&o)[DV / 8]) {
    constexpr int QN = DQ / 8, VN = DV / 8;
    float q[QN];
#pragma unroll
    for (int i = 0; i < QN / 2; ++i) { const unsigned w = ((const unsigned*)qp)[i]; q[2 * i] = bflo(w) * scale; q[2 * i + 1] = bfhi(w) * scale; }
#pragma unroll
    for (int i = 0; i < VN; ++i) o[i] = 0.f;
    float m = -1e30f, l = 0.f;
    for (int i = 0; i < nmax; ++i) {
        bool valid = i < nkeys; int key = i;
        if (GATHER) { key = sel[valid ? i : 0]; valid = valid && key >= 0; }
        if (!valid) key = 0;
        const unsigned* kp = (const unsigned*)(kb + (size_t)key * kvpitch);
        float d = 0.f;
#pragma unroll
        for (int j = 0; j < QN / 2; ++j) { const unsigned w = kp[j]; d += q[2 * j] * bflo(w) + q[2 * j + 1] * bfhi(w); }
        d += __shfl_xor(d, 1); d += __shfl_xor(d, 2); d += __shfl_xor(d, 4);
        const float logit = d - slope * (float)(r - key);
        if (valid) {
            if (logit > m) { const float c = __expf(m - logit); l *= c;
#pragma unroll
                for (int j = 0; j < VN; ++j) o[j] *= c;
                m = logit; }
            const float p = __expf(logit - m); l += p;
            const unsigned* vp = (const unsigned*)(vb + (size_t)key * kvpitch);
#pragma unroll
            for (int j = 0; j < VN / 2; ++j) { const unsigned w = vp[j]; o[2 * j] += p * bflo(w); o[2 * j + 1] += p * bfhi(w); }
        }
    }
    const float il = 1.0f / l;
#pragma unroll
    for (int j = 0; j < VN; ++j) o[j] *= il;
}
__device__ __forceinline__ void attn_b_naive(const Args& a, int blk, int nblk, const int wave) {
    const int lane = lane_id_v(), tid = wave * 64 + lane, sub = lane & 7;
    const bf16_t* PROJ = (const bf16_t*)(a.ws + WS_PROJ); bf16_t* UB = (bf16_t*)(a.ws + WS_U) + (size_t)1 * S * 1024;
    const float lam = ((const float*)(a.ws + WS_CTL))[0];
    for (int wi = blk * 8 + wave; wi < 1024 * 8; wi += nblk * 8) {
        const int h = wi & 7, rg = wi >> 3, r = rg * 8 + (lane >> 3), nmax = rg * 8 + 8;
        const float slope = exp2f(-(float)(h + 1));
        float o0[16], o1[16];
        const bf16_t* rowp = PROJ + (size_t)r * NPAD;
        naive_attn<64, 128, false>(rowp + C_QB + h * 128 + sub * 8, PROJ + C_KB + h * 128 + sub * 8, PROJ + C_VB + h * 128 + sub * 16, NPAD, r + 1, nmax, nullptr, r, 0.125f, slope, o0);
        naive_attn<64, 128, false>(rowp + C_QB + h * 128 + 64 + sub * 8, PROJ + C_KB + h * 128 + 64 + sub * 8, PROJ + C_VB + h * 128 + sub * 16, NPAD, r + 1, nmax, nullptr, r, 0.125f, slope, o1);
        float ss = 0.f;
#pragma unroll
        for (int j = 0; j < 16; ++j) { o0[j] -= lam * o1[j]; ss += o0[j] * o0[j]; }
        ss += __shfl_xor(ss, 1); ss += __shfl_xor(ss, 2); ss += __shfl_xor(ss, 4);
        const float rs = 1.0f / sqrtf(ss * (1.f / 128.f) + RMS_EPS) * 0.8f;
        const float* g = a.in[9] + sub * 16; const bf16_t* zp = rowp + C_ZB + h * 128 + sub * 16;
        unsigned w[8];
#pragma unroll
        for (int j = 0; j < 8; ++j) w[j] = pk2(o0[2 * j] * rs * g[2 * j] * bf2f(zp[2 * j]), o0[2 * j + 1] * rs * g[2 * j + 1] * bf2f(zp[2 * j + 1]));
        u32x4* dst = (u32x4*)(UB + (size_t)r * 1024 + h * 128 + sub * 16);
        dst[0] = (u32x4){w[0], w[1], w[2], w[3]}; dst[1] = (u32x4){w[4], w[5], w[6], w[7]};
    }
}
__device__ __forceinline__ void attn_m_naive(const Args& a, int blk, int nblk, const int wave) {
    const int lane = lane_id_v(), tid = wave * 64 + lane, sub = lane & 7;
    const bf16_t* PROJ = (const bf16_t*)(a.ws + WS_PROJ); const bf16_t* MKV = (const bf16_t*)(a.ws + WS_MKV); bf16_t* UM = (bf16_t*)(a.ws + WS_U) + (size_t)2 * S * 1024;
    for (int wi = blk * 8 + wave; wi < 1024 * 4; wi += nblk * 8) {
        const int h = wi & 3, rg = wi >> 2, r = rg * 8 + (lane >> 3);
        float o[32];
        const bf16_t* rowp = PROJ + (size_t)r * NPAD;
        naive_attn<256, 256, false>(rowp + C_QM + h * 256 + sub * 32, MKV + h * 256 + sub * 32, MKV + 1024 + h * 256 + sub * 32, 2048, NMEM, NMEM, nullptr, 0, 0.0625f, 0.f, o);
        const bf16_t* zp = rowp + C_ZM + h * 256 + sub * 32;
        u32x4* dst = (u32x4*)(UM + (size_t)r * 1024 + h * 256 + sub * 32);
#pragma unroll
        for (int j = 0; j < 4; ++j) { u32x4 w;
            w.x = pk2(o[8 * j + 0] * bf2f(zp[8 * j + 0]), o[8 * j + 1] * bf2f(zp[8 * j + 1])); w.y = pk2(o[8 * j + 2] * bf2f(zp[8 * j + 2]), o[8 * j + 3] * bf2f(zp[8 * j + 3]));
            w.z = pk2(o[8 * j + 4] * bf2f(zp[8 * j + 4]), o[8 * j + 5] * bf2f(zp[8 * j + 5])); w.w = pk2(o[8 * j + 6] * bf2f(zp[8 * j + 6]), o[8 * j + 7] * bf2f(zp[8 * j + 7]));
            dst[j] = w; }
    }
}
__device__ __forceinline__ void attn_a_naive(const Args& a, int blk, int nblk, const int wave) {
    const int lane = lane_id_v(), tid = wave * 64 + lane, sub = lane & 7;
    const bf16_t* PROJ = (const bf16_t*)(a.ws + WS_PROJ); const int* SEL = (const int*)(a.ws + WS_SEL); bf16_t* UA = (bf16_t*)(a.ws + WS_U);
    for (int wi = blk * 8 + wave; wi < 1024 * 8; wi += nblk * 8) {
        const int h = wi & 7, rg = wi >> 3, r = rg * 8 + (lane >> 3);
        const float slope = exp2f(-(float)(h + 1));
        float o[16];
        const bf16_t* rowp = PROJ + (size_t)r * NPAD;
        naive_attn<128, 128, true>(rowp + C_QA + h * 128 + sub * 16, PROJ + C_KA + h * 128 + sub * 16, PROJ + C_VA + h * 128 + sub * 16, NPAD, TOPK, TOPK, SEL + (size_t)r * TOPK, r, 0.08838834764831845f, slope, o);
        const bf16_t* zp = rowp + C_ZA + h * 128 + sub * 16;
        unsigned w[8];
#pragma unroll
        for (int j = 0; j < 8; ++j) w[j] = pk2(o[2 * j] * bf2f(zp[2 * j]), o[2 * j + 1] * bf2f(zp[2 * j + 1]));
        u32x4* dst = (u32x4*)(UA + (size_t)r * 1024 + h * 128 + sub * 16);
        dst[0] = (u32x4){w[0], w[1], w[2], w[3]}; dst[1] = (u32x4){w[4], w[5], w[6], w[7]};
    }
}
__device__ __forceinline__ void final_norm(const Args& a, int blk, int nblk, const int wave) {
    const int lane = lane_id_v(), tid = wave * 64 + lane;
    const float* part = (const float*)(a.ws + WS_PART); const f32x4* g = (const f32x4*)a.in[16] + lane;
    for (int r = blk * 8 + wave; r < S; r += nblk * 8) {
        float s = (lane < 32) ? part[(size_t)lane * S + r] : 0.f;
        const float rs = 1.0f / sqrtf(wave_sum(s) * (1.f / DM) + RMS_EPS);
        f32x4* y = (f32x4*)(a.out + (size_t)r * DM) + lane;
#pragma unroll
        for (int j = 0; j < 8; ++j) { f32x4 v = y[64 * j]; const f32x4 gg = g[64 * j]; v = v * rs * gg; y[64 * j] = v; }
    }
}


namespace att {
typedef short bf16x8 __attribute__((ext_vector_type(8)));
typedef short s16x4 __attribute__((ext_vector_type(4)));
typedef float f32x16 __attribute__((ext_vector_type(16)));
typedef float f32x2_t __attribute__((ext_vector_type(2)));
typedef __bf16 bf16x2_t __attribute__((ext_vector_type(2)));
constexpr int SHM_V = 16384, SHM_K = 16384;
constexpr float LOG2E = 1.4426950408889634f;
constexpr float THR2 = 8.f * LOG2E;
#define KSWZ(row, colB) ((row) * 256 + ((colB) ^ (((row) & 7) << 4)))
#define SBAR() __builtin_amdgcn_sched_barrier(0)
__device__ __forceinline__ int crow(int r, int hi) { return (r & 3) + 8 * (r >> 2) + 4 * hi; }
__device__ __forceinline__ unsigned cvtpk(float lo, float hi) { f32x2_t v = {lo, hi}; bf16x2_t b = __builtin_convertvector(v, bf16x2_t); return __builtin_bit_cast(unsigned, b); }
__device__ __forceinline__ int v_st(int k, int c) { const int kk = (k & ~0xC) | ((k & 4) << 1) | ((k & 8) >> 1); return ((kk >> 3) * 4 + (c >> 5)) * 512 + ((kk & 7) * 32 + (c & 31)) * 2; }
__device__ __forceinline__ int v_rd_base(int lane) { return ((lane & 3) << 3) | (((lane >> 2) & 3) << 6) | (((lane >> 4) & 1) << 5) | (((lane >> 5) & 1) << 8); }
constexpr int v_rd_off(int d0, int ks, int half) { return d0 * 512 + ks * 4096 + half * 2048; }
typedef short v4i16_t __attribute__((ext_vector_type(4)));
__device__ __forceinline__ s16x4 tr_read(LAS const unsigned char* p) { return __builtin_bit_cast(s16x4, __builtin_amdgcn_ds_read_tr16_b64_v4i16((LAS v4i16_t*)p)); }

template <int NQ> __device__ __forceinline__ void qkt(f32x16& p0, f32x16& p1, LAS const unsigned char* Ks, const bf16x8* qr, int cbyte0, int r32, int hi) {
  p0 = f32x16{}; p1 = f32x16{};
#pragma unroll
  for (int d0 = 0; d0 < NQ; ++d0) { const int cb = cbyte0 + (d0 * 16 + hi * 8) * 2;
    const bf16x8 b0 = *(LAS const bf16x8*)(Ks + KSWZ(r32, cb));
    const bf16x8 b1 = *(LAS const bf16x8*)(Ks + KSWZ(32 + r32, cb));
    p0 = __builtin_amdgcn_mfma_f32_32x32x16_bf16(b0, qr[d0], p0, 0, 0, 0);
    p1 = __builtin_amdgcn_mfma_f32_32x32x16_bf16(b1, qr[d0], p1, 0, 0, 0); }
}
template <int NQ> __device__ __forceinline__ void qkt_l(f32x16& p0, f32x16& p1, LAS const unsigned char* Ks, LAS const unsigned char* Qs, int cbyte0, int r32, int hi) {
  p0 = f32x16{}; p1 = f32x16{};
  asm volatile("" : "+v"(Qs));
#pragma unroll
  for (int d0 = 0; d0 < NQ; ++d0) { const int cb = cbyte0 + (d0 * 16 + hi * 8) * 2;
    const bf16x8 q = *(LAS const bf16x8*)(Qs + d0 * 1024);
    const bf16x8 b0 = *(LAS const bf16x8*)(Ks + KSWZ(r32, cb));
    const bf16x8 b1 = *(LAS const bf16x8*)(Ks + KSWZ(32 + r32, cb));
    p0 = __builtin_amdgcn_mfma_f32_32x32x16_bf16(b0, q, p0, 0, 0, 0);
    p1 = __builtin_amdgcn_mfma_f32_32x32x16_bf16(b1, q, p1, 0, 0, 0); }
}
template <int D0> __device__ __forceinline__ void pv_one(f32x16& od, LAS const unsigned char* vb, bf16x8 pa0, bf16x8 pa1, bf16x8 pa2, bf16x8 pa3) {
  const s16x4 l0 = tr_read(vb + v_rd_off(D0, 0, 0)), h0 = tr_read(vb + v_rd_off(D0, 0, 1)), l1 = tr_read(vb + v_rd_off(D0, 1, 0)), h1 = tr_read(vb + v_rd_off(D0, 1, 1));
  const s16x4 l2 = tr_read(vb + v_rd_off(D0, 2, 0)), h2 = tr_read(vb + v_rd_off(D0, 2, 1)), l3 = tr_read(vb + v_rd_off(D0, 3, 0)), h3 = tr_read(vb + v_rd_off(D0, 3, 1));
#define PK(L, H) (bf16x8){L[0], L[1], L[2], L[3], H[0], H[1], H[2], H[3]}
  od = __builtin_amdgcn_mfma_f32_32x32x16_bf16(pa0, PK(l0, h0), od, 0, 0, 0);
  od = __builtin_amdgcn_mfma_f32_32x32x16_bf16(pa1, PK(l1, h1), od, 0, 0, 0);
  od = __builtin_amdgcn_mfma_f32_32x32x16_bf16(pa2, PK(l2, h2), od, 0, 0, 0);
  od = __builtin_amdgcn_mfma_f32_32x32x16_bf16(pa3, PK(l3, h3), od, 0, 0, 0);
#undef PK
}
__device__ __forceinline__ void pv_d0(f32x16* o, LAS const unsigned char* vb, bf16x8 pa0, bf16x8 pa1, bf16x8 pa2, bf16x8 pa3) {
  pv_one<0>(o[0], vb, pa0, pa1, pa2, pa3); pv_one<1>(o[1], vb, pa0, pa1, pa2, pa3); pv_one<2>(o[2], vb, pa0, pa1, pa2, pa3); pv_one<3>(o[3], vb, pa0, pa1, pa2, pa3);
}
template <bool CAUSAL> __device__ __forceinline__ void partialSM(f32x16& p0, f32x16& p1, float& m_reg, float& alpha, const float (&cs)[16], float base, int lim, float C, float slope2, int delta) {
  const float tb0 = slope2 * (float)delta + base, tb1 = slope2 * (float)(delta + 32) + base;
#pragma unroll
  for (int r = 0; r < 16; ++r) { p0[r] = fmaf(p0[r], C, cs[r]); p1[r] = fmaf(p1[r], C, cs[r]); }
  if (CAUSAL && delta + 63 > 0) {
    const int l0 = lim - delta, l1 = l0 - 32;
#pragma unroll
    for (int r = 0; r < 16; ++r) { const int K = (r & 3) + 8 * (r >> 2); if (K > l0) p0[r] = -INFINITY; if (K > l1) p1[r] = -INFINITY; }
  }
  float pm0 = p0[0], pm1 = p1[0];
#pragma unroll
  for (int r = 1; r < 16; ++r) { pm0 = fmaxf(pm0, p0[r]); pm1 = fmaxf(pm1, p1[r]); }
  float pmax = fmaxf(pm0 + tb0, pm1 + tb1);
  { auto rr = __builtin_amdgcn_permlane32_swap(__float_as_uint(pmax), __float_as_uint(pmax), false, false);
    pmax = fmaxf(__uint_as_float(rr[0]), __uint_as_float(rr[1])); }
  float mn;
  if (__builtin_expect(__all(pmax - m_reg <= THR2), 1)) { mn = m_reg; alpha = 1.f; }
  else { mn = fmaxf(m_reg, pmax); alpha = __builtin_amdgcn_exp2f(m_reg - mn); m_reg = mn; }
  const float a0 = tb0 - mn, a1 = tb1 - mn;
#pragma unroll
  for (int r = 0; r < 16; ++r) { p0[r] += a0; p1[r] += a1; }
#pragma unroll
  for (int r = 0; r < 16; ++r) p0[r] = __builtin_amdgcn_exp2f(p0[r]);
}
__device__ __forceinline__ void finishSM(f32x16& p0, f32x16& p1, float alpha, float& l_reg, bf16x8& pa0, bf16x8& pa1, bf16x8& pa2, bf16x8& pa3) {
#pragma unroll
  for (int r = 0; r < 16; ++r) p1[r] = __builtin_amdgcn_exp2f(p1[r]);
  float ps = 0;
#pragma unroll
  for (int r = 0; r < 16; ++r) ps += p0[r];
#pragma unroll
  for (int r = 0; r < 16; ++r) ps += p1[r];
  { auto rr = __builtin_amdgcn_permlane32_swap(__float_as_uint(ps), __float_as_uint(ps), false, false);
    ps = __uint_as_float(rr[0]) + __uint_as_float(rr[1]); }
  l_reg = l_reg * alpha + ps;
#define PK4(P, BASE, OUT) do { unsigned a0 = cvtpk(P[BASE + 0], P[BASE + 1]), a1 = cvtpk(P[BASE + 2], P[BASE + 3]);   \
    unsigned b0 = cvtpk(P[BASE + 4], P[BASE + 5]), b1 = cvtpk(P[BASE + 6], P[BASE + 7]);                              \
    auto r0 = __builtin_amdgcn_permlane32_swap(a0, b0, false, false); auto r1 = __builtin_amdgcn_permlane32_swap(a1, b1, false, false); \
    u32x4 w = {r0[0], r1[0], r0[1], r1[1]}; OUT = __builtin_bit_cast(bf16x8, w); } while (0)
  PK4(p0, 0, pa0); PK4(p0, 8, pa1); PK4(p1, 0, pa2); PK4(p1, 8, pa3);
#undef PK4
}

__device__ __forceinline__ void attn_b_unit(const bf16_t* __restrict__ PROJ, bf16_t* UB, const float* __restrict__ gsub, float lam, int h, int qb, int jmin, LAS unsigned char* lds, const int wid) {
  const int lane = lane_id_v(), tid = wid * 64 + lane, r32 = lane & 31, hi = lane >> 5, comp = wid >> 2, wq = wid & 3;
  const int R0 = qb * 128, qrow0 = R0 + wq * 32, NT = 2 * qb + 2, NTe = NT - jmin;
  LAS unsigned char* V_lds = lds; LAS unsigned char* K_lds = lds + 2 * SHM_V;
  LAS float* ws = (LAS float*)(lds + 2 * SHM_V + 2 * SHM_K) + wid * 64; LAS float* li_l = ws; LAS float* al_l = ws + 32;
  LAS float* xch = (LAS float*)(lds + 2 * SHM_V + 2 * SHM_K + 2048);
  const float slope2 = __builtin_amdgcn_exp2f(-(float)(h + 1)) * LOG2E, C = 0.125f * LOG2E;
  float cs[16];
#pragma unroll
  for (int r = 0; r < 16; ++r) cs[r] = __uint_as_float(__builtin_amdgcn_readfirstlane(__float_as_uint(slope2 * (float)((r & 3) + 8 * (r >> 2)))));
  const float base = slope2 * (float)(4 * hi - r32); const int lim = r32 - 4 * hi;
  float m_reg = -1e30f, l_reg = 0; f32x16 o[4] = {};
  LAS unsigned char* Qs = lds + 2 * SHM_V + 2 * SHM_K + 2048 + wid * 4096 + lane * 16;
  { const bf16_t* Qw = PROJ + (size_t)(qrow0 + r32) * NPAD + C_QB + h * 128 + comp * 64 + hi * 8;
#pragma unroll
    for (int d0 = 0; d0 < 4; ++d0) *(LAS bf16x8*)(Qs + d0 * 1024) = *(const bf16x8*)(Qw + d0 * 16); }
  const unsigned offK = (unsigned)((tid >> 4) * NPAD + C_KB + h * 128 + (tid & 15) * 8) * 2u, offV = offK + (unsigned)(C_VB - C_KB) * 2u;
  const int sr = tid >> 4, sc = (tid & 15) * 8, vst0 = v_st(sr, sc), vst1 = v_st(32 + sr, sc), cq = comp * 128;
  LAS const unsigned char* vb0 = V_lds + v_rd_base(lane);
  struct { bf16x8 vs0, vs1, ks0, ks1; } sr_[2];
#define KEY0(t) (64 * (NT - 1 - (t)))
#define GLD16(off) (*(const bf16x8*)((const char*)PROJ + (unsigned)(off)))
#define SLOAD(i, k0) do { const unsigned kb_ = (unsigned)(k0) * (unsigned)(NPAD * 2); sr_[i].vs0 = GLD16(offV + kb_); sr_[i].vs1 = GLD16(offV + kb_ + 32u * NPAD * 2u); \
    sr_[i].ks0 = GLD16(offK + kb_); sr_[i].ks1 = GLD16(offK + kb_ + 32u * NPAD * 2u); } while (0)
#define SWRITE(b) do { *(LAS bf16x8*)(V_lds + (b) * SHM_V + vst0) = sr_[b].vs0; *(LAS bf16x8*)(V_lds + (b) * SHM_V + vst1) = sr_[b].vs1; const int kc = sc * 2; \
    *(LAS bf16x8*)(K_lds + (b) * SHM_K + KSWZ(sr, kc)) = sr_[b].ks0; *(LAS bf16x8*)(K_lds + (b) * SHM_K + KSWZ(32 + sr, kc)) = sr_[b].ks1; } while (0)
#define RESC(a) do { if (__any((a) < 1.f)) { if (hi == 0) al_l[r32] = (a); asm volatile("s_waitcnt lgkmcnt(0)" ::: "memory"); \
    _Pragma("unroll") for (int d = 0; d < 4; ++d) _Pragma("unroll") for (int r = 0; r < 16; ++r) o[d][r] *= al_l[crow(r, hi)]; } } while (0)
  f32x16 pA0, pA1, pB0, pB1; float alA, alB; bf16x8 pa0, pa1, pa2, pa3;
  SLOAD(0, KEY0(0)); SWRITE(0); __syncthreads();
  qkt_l<4>(pA0, pA1, K_lds, Qs, cq, r32, hi); partialSM<true>(pA0, pA1, m_reg, alA, cs, base, lim, C, slope2, KEY0(0) - qrow0);
  SLOAD(1, KEY0(1)); if (2 < NTe) SLOAD(0, KEY0(2));
  SWRITE(1); __syncthreads();
  for (int j = 1; j + 1 < NTe; j += 2) {
    SBAR(); qkt_l<4>(pB0, pB1, K_lds + SHM_K, Qs, cq, r32, hi);
    finishSM(pA0, pA1, alA, l_reg, pa0, pa1, pa2, pa3); SBAR();
    SLOAD(1, KEY0(j + 2)); SBAR();
    pv_d0(o, vb0, pa0, pa1, pa2, pa3); partialSM<true>(pB0, pB1, m_reg, alB, cs, base, lim, C, slope2, KEY0(j) - qrow0);
    __syncthreads(); SWRITE(0);
    RESC(alB); __syncthreads();
    SBAR(); qkt_l<4>(pA0, pA1, K_lds, Qs, cq, r32, hi);
    finishSM(pB0, pB1, alB, l_reg, pa0, pa1, pa2, pa3); SBAR();
    SLOAD(0, KEY0(min(j + 3, NTe - 1))); SBAR();
    pv_d0(o, vb0 + SHM_V, pa0, pa1, pa2, pa3); partialSM<true>(pA0, pA1, m_reg, alA, cs, base, lim, C, slope2, KEY0(j + 1) - qrow0);
    __syncthreads(); SWRITE(1);
    RESC(alA); __syncthreads();
  }
  SBAR(); qkt_l<4>(pB0, pB1, K_lds + SHM_K, Qs, cq, r32, hi);
  finishSM(pA0, pA1, alA, l_reg, pa0, pa1, pa2, pa3); SBAR();
  pv_d0(o, vb0, pa0, pa1, pa2, pa3); partialSM<true>(pB0, pB1, m_reg, alB, cs, base, lim, C, slope2, KEY0(NTe - 1) - qrow0);
  __syncthreads(); RESC(alB);
  finishSM(pB0, pB1, alB, l_reg, pa0, pa1, pa2, pa3); SBAR();
  pv_d0(o, vb0 + SHM_V, pa0, pa1, pa2, pa3);
#undef KEY0
#undef SLOAD
#undef GLD16
#undef SWRITE
#undef RESC
  if (hi == 0) li_l[r32] = l_reg; asm volatile("s_waitcnt lgkmcnt(0)" ::: "memory");
  float rli[16];
#pragma unroll
  for (int r = 0; r < 16; ++r) rli[r] = __builtin_amdgcn_rcpf(li_l[crow(r, hi)]);
  __syncthreads();
  if (comp == 1) {
#pragma unroll
    for (int d0 = 0; d0 < 4; ++d0)
#pragma unroll
      for (int r = 0; r < 16; ++r) xch[(wq * 64 + d0 * 16 + r) * 64 + lane] = o[d0][r] * rli[r] * lam;
  }
  __syncthreads();
  if (comp == 0) {
    float ss[16];
#pragma unroll
    for (int r = 0; r < 16; ++r) ss[r] = 0.f;
#pragma unroll
    for (int d0 = 0; d0 < 4; ++d0)
#pragma unroll
      for (int r = 0; r < 16; ++r) { const float d = o[d0][r] * rli[r] - xch[(wq * 64 + d0 * 16 + r) * 64 + lane]; o[d0][r] = d; ss[r] += d * d; }
#pragma unroll
    for (int r = 0; r < 16; ++r) { float s = ss[r]; s += __shfl_xor(s, 1); s += __shfl_xor(s, 2); s += __shfl_xor(s, 4); s += __shfl_xor(s, 8); s += __shfl_xor(s, 16);
      ss[r] = 0.8f / sqrtf(s * (1.f / 128.f) + RMS_EPS); }
    bf16_t zv[4][16];
#pragma unroll
    for (int d0 = 0; d0 < 4; ++d0)
#pragma unroll
      for (int r = 0; r < 16; ++r) zv[d0][r] = PROJ[(size_t)(qrow0 + crow(r, hi)) * NPAD + C_ZB + h * 128 + d0 * 32 + r32];
#pragma unroll
    for (int d0 = 0; d0 < 4; ++d0) { const int col = d0 * 32 + r32; const float g = gsub[col];
#pragma unroll
      for (int r = 0; r < 16; ++r) { const size_t row = (size_t)(qrow0 + crow(r, hi));
        UB[row * 1024 + h * 128 + col] = (bf16_t)f2bf(o[d0][r] * ss[r] * g * bf2f(zv[d0][r])); } }
  }
  __syncthreads();
}
template <bool DUMMY> __device__ __forceinline__ void partialSM_A(f32x16& p0, f32x16& p1, float& m_reg, float& alpha, const float (&cs)[16], float base, float C, float slope2, int delta, unsigned long long mw, int hi) {
  const float tb0 = slope2 * (float)delta + base, tb1 = slope2 * (float)(delta + 32) + base;
  const unsigned wl = (unsigned)mw >> (4 * hi), wh = (unsigned)(mw >> 32) >> (4 * hi);
#pragma unroll
  for (int r = 0; r < 16; ++r) { const int K = (r & 3) + 8 * (r >> 2);
    const float y0 = fmaf(p0[r], C, cs[r]), y1 = fmaf(p1[r], C, cs[r]);
    const unsigned t0 = (unsigned)((int)(wl << (31 - K)) >> 31), t1 = (unsigned)((int)(wh << (31 - K)) >> 31);
    p0[r] = __uint_as_float((__float_as_uint(y0) & t0) | (~t0 & 0xff800000u));
    p1[r] = __uint_as_float((__float_as_uint(y1) & t1) | (~t1 & 0xff800000u)); }
  float pm0 = p0[0], pm1 = p1[0];
#pragma unroll
  for (int r = 1; r < 16; ++r) { pm0 = fmaxf(pm0, p0[r]); pm1 = fmaxf(pm1, p1[r]); }
  float pmax = fmaxf(pm0 + tb0, pm1 + tb1);
  { auto rr = __builtin_amdgcn_permlane32_swap(__float_as_uint(pmax), __float_as_uint(pmax), false, false);
    pmax = fmaxf(__uint_as_float(rr[0]), __uint_as_float(rr[1])); }
  float mn;
  if (__builtin_expect(__all(pmax - m_reg <= THR2), 1)) { mn = m_reg; alpha = 1.f; }
  else { mn = fmaxf(m_reg, pmax); alpha = __builtin_amdgcn_exp2f(m_reg - mn); m_reg = mn; }
  const float a0 = tb0 - mn, a1 = tb1 - mn;
#pragma unroll
  for (int r = 0; r < 16; ++r) { p0[r] += a0; p1[r] += a1; }
#pragma unroll
  for (int r = 0; r < 16; ++r) p0[r] = __builtin_amdgcn_exp2f(p0[r]);
}
__device__ __forceinline__ void attn_a_unit(const bf16_t* __restrict__ PROJ, const unsigned long long* __restrict__ MASK, bf16_t* UA, int h, int qb, int jmin, LAS unsigned char* lds, const int wid) {
  const int lane = lane_id_v(), tid = wid * 64 + lane, r32 = lane & 31, hi = lane >> 5;
  const int R0 = qb * 256, qrow0 = R0 + wid * 32, NT = 4 * qb + 4, NTe = NT - jmin;
  LAS unsigned char* V_lds = lds; LAS unsigned char* K_lds = lds + 2 * SHM_V;
  LAS float* ws = (LAS float*)(lds + 2 * SHM_V + 2 * SHM_K) + wid * 64; LAS float* li_l = ws; LAS float* al_l = ws + 32;
  const float slope2 = __builtin_amdgcn_exp2f(-(float)(h + 1)) * LOG2E, C = 0.08838834764831845f * LOG2E;
  float cs[16];
#pragma unroll
  for (int r = 0; r < 16; ++r) cs[r] = __uint_as_float(__builtin_amdgcn_readfirstlane(__float_as_uint(slope2 * (float)((r & 3) + 8 * (r >> 2)))));
  const float base = slope2 * (float)(4 * hi - r32);
  float m_reg = -1e30f, l_reg = 0; f32x16 o[4] = {}; bf16x8 qr[8];
  { const bf16_t* Qw = PROJ + (size_t)(qrow0 + r32) * NPAD + C_QA + h * 128 + hi * 8;
#pragma unroll
    for (int d0 = 0; d0 < 8; ++d0) qr[d0] = *(const bf16x8*)(Qw + d0 * 16); }
  const unsigned offK = (unsigned)((tid >> 4) * NPAD + C_KA + h * 128 + (tid & 15) * 8) * 2u, offV = offK + (unsigned)(C_VA - C_KA) * 2u;
  const unsigned moff = (unsigned)(qrow0 + r32) * 1024u;
#define MLD(tj) (*(const unsigned long long*)((const char*)MASK + (moff + 8u * (unsigned)(tj))))
  const int sr = tid >> 4, sc = (tid & 15) * 8, vst0 = v_st(sr, sc), vst1 = v_st(32 + sr, sc);
  LAS const unsigned char* vb0 = V_lds + v_rd_base(lane);
  struct { bf16x8 vs0, vs1, ks0, ks1; } sr_;
#define TJ(t) (NT - 1 - (t))
#define KEY0(t) (64 * TJ(t))
#define GLD16(off) (*(const bf16x8*)((const char*)PROJ + (unsigned)(off)))
#define SLOAD(k0) do { const unsigned kb_ = (unsigned)(k0) * (unsigned)(NPAD * 2); sr_.vs0 = GLD16(offV + kb_); sr_.vs1 = GLD16(offV + kb_ + 32u * NPAD * 2u); \
    sr_.ks0 = GLD16(offK + kb_); sr_.ks1 = GLD16(offK + kb_ + 32u * NPAD * 2u); } while (0)
#define SWRITE(b) do { *(LAS bf16x8*)(V_lds + (b) * SHM_V + vst0) = sr_.vs0; *(LAS bf16x8*)(V_lds + (b) * SHM_V + vst1) = sr_.vs1; const int kc = sc * 2; \
    *(LAS bf16x8*)(K_lds + (b) * SHM_K + KSWZ(sr, kc)) = sr_.ks0; *(LAS bf16x8*)(K_lds + (b) * SHM_K + KSWZ(32 + sr, kc)) = sr_.ks1; } while (0)
#define RESC(a) do { if (__any((a) < 1.f)) { if (hi == 0) al_l[r32] = (a); asm volatile("s_waitcnt lgkmcnt(0)" ::: "memory"); \
    _Pragma("unroll") for (int d = 0; d < 4; ++d) _Pragma("unroll") for (int r = 0; r < 16; ++r) o[d][r] *= al_l[crow(r, hi)]; } } while (0)
  f32x16 pA0, pA1, pB0, pB1; float alA, alB; bf16x8 pa0, pa1, pa2, pa3; unsigned long long mwA, mwB;
  SLOAD(KEY0(0)); mwA = MLD(TJ(0)); SWRITE(0); __syncthreads();
  qkt<8>(pA0, pA1, K_lds, qr, 0, r32, hi); partialSM_A<true>(pA0, pA1, m_reg, alA, cs, base, C, slope2, KEY0(0) - qrow0, mwA, hi);
  SLOAD(KEY0(1)); mwB = MLD(TJ(1)); SWRITE(1); __syncthreads();
  for (int j = 1; j + 1 < NTe; j += 2) {
    SBAR(); qkt<8>(pB0, pB1, K_lds + SHM_K, qr, 0, r32, hi);
    finishSM(pA0, pA1, alA, l_reg, pa0, pa1, pa2, pa3); SBAR();
    SLOAD(KEY0(j + 1)); mwA = MLD(TJ(j + 1)); SBAR();
    pv_d0(o, vb0, pa0, pa1, pa2, pa3); partialSM_A<true>(pB0, pB1, m_reg, alB, cs, base, C, slope2, KEY0(j) - qrow0, mwB, hi);
    __syncthreads(); SWRITE(0);
    RESC(alB); __syncthreads();
    SBAR(); qkt<8>(pA0, pA1, K_lds, qr, 0, r32, hi);
    finishSM(pB0, pB1, alB, l_reg, pa0, pa1, pa2, pa3); SBAR();
    SLOAD(KEY0(j + 2)); mwB = MLD(TJ(j + 2)); SBAR();
    pv_d0(o, vb0 + SHM_V, pa0, pa1, pa2, pa3); partialSM_A<true>(pA0, pA1, m_reg, alA, cs, base, C, slope2, KEY0(j + 1) - qrow0, mwA, hi);
    __syncthreads(); SWRITE(1);
    RESC(alA); __syncthreads();
  }
  SBAR(); qkt<8>(pB0, pB1, K_lds + SHM_K, qr, 0, r32, hi);
  finishSM(pA0, pA1, alA, l_reg, pa0, pa1, pa2, pa3); SBAR();
  pv_d0(o, vb0, pa0, pa1, pa2, pa3); partialSM_A<true>(pB0, pB1, m_reg, alB, cs, base, C, slope2, KEY0(NTe - 1) - qrow0, mwB, hi);
  __syncthreads(); RESC(alB);
  finishSM(pB0, pB1, alB, l_reg, pa0, pa1, pa2, pa3); SBAR();
  pv_d0(o, vb0 + SHM_V, pa0, pa1, pa2, pa3);
#undef TJ
#undef MLD
#undef KEY0
#undef SLOAD
#undef GLD16
#undef SWRITE
#undef RESC
  if (hi == 0) li_l[r32] = l_reg; asm volatile("s_waitcnt lgkmcnt(0)" ::: "memory");
  float rli[16];
#pragma unroll
  for (int r = 0; r < 16; ++r) rli[r] = __builtin_amdgcn_rcpf(li_l[crow(r, hi)]);
  { bf16_t zv[4][16];
#pragma unroll
  for (int d0 = 0; d0 < 4; ++d0)
#pragma unroll
    for (int r = 0; r < 16; ++r) zv[d0][r] = PROJ[(size_t)(qrow0 + crow(r, hi)) * NPAD + C_ZA + h * 128 + d0 * 32 + r32];
#pragma unroll
  for (int d0 = 0; d0 < 4; ++d0) { const int col = h * 128 + d0 * 32 + r32;
#pragma unroll
    for (int r = 0; r < 16; ++r) { const size_t row = (size_t)(qrow0 + crow(r, hi));
      UA[row * 1024 + col] = (bf16_t)f2bf(o[d0][r] * rli[r] * bf2f(zv[d0][r])); } } }
  __syncthreads();
}
template <int NQ, bool ACC> __device__ __forceinline__ void qkt_acc(f32x16& p0, f32x16& p1, LAS const unsigned char* Ks, const bf16x8* qr, int r32, int hi) {
  if (!ACC) { p0 = f32x16{}; p1 = f32x16{}; }
#pragma unroll
  for (int d0 = 0; d0 < NQ; ++d0) { const int cb = (d0 * 16 + hi * 8) * 2;
    const bf16x8 b0 = *(LAS const bf16x8*)(Ks + KSWZ(r32, cb));
    const bf16x8 b1 = *(LAS const bf16x8*)(Ks + KSWZ(32 + r32, cb));
    p0 = __builtin_amdgcn_mfma_f32_32x32x16_bf16(b0, qr[d0], p0, 0, 0, 0);
    p1 = __builtin_amdgcn_mfma_f32_32x32x16_bf16(b1, qr[d0], p1, 0, 0, 0); }
}
__device__ __forceinline__ void attn_m_unit(const bf16_t* __restrict__ PROJ, const bf16_t* __restrict__ MKV, bf16_t* UM, int h, int qb, int vh, LAS unsigned char* lds, const int wid) {
  const int lane = lane_id_v(), tid = wid * 64 + lane, r32 = lane & 31, hi = lane >> 5;
  const int qrow0 = qb * 256 + wid * 32;
  LAS unsigned char* V_lds = lds; LAS unsigned char* K_lds = lds + 2 * SHM_V;
  LAS float* ws = (LAS float*)(lds + 2 * SHM_V + 2 * SHM_K) + wid * 64; LAS float* li_l = ws; LAS float* al_l = ws + 32;
  const float C = 0.0625f * LOG2E;
  const float cs[16] = {0.f, 0.f, 0.f, 0.f, 0.f, 0.f, 0.f, 0.f, 0.f, 0.f, 0.f, 0.f, 0.f, 0.f, 0.f, 0.f};
  float m_reg = -1e30f, l_reg = 0; f32x16 o[4] = {}; bf16x8 qr[16];
  { const bf16_t* Qw = PROJ + (size_t)(qrow0 + r32) * NPAD + C_QM + h * 256 + hi * 8;
#pragma unroll
    for (int d0 = 0; d0 < 16; ++d0) qr[d0] = *(const bf16x8*)(Qw + d0 * 16); }
  const int sr = tid >> 4, sc = (tid & 15) * 8, vst0 = v_st(sr, sc), vst1 = v_st(32 + sr, sc);
  const unsigned offK = (unsigned)(sr * 2048 + h * 256 + sc) * 2u, offV = offK + (unsigned)(1024 + vh * 128) * 2u;
  LAS const unsigned char* vb0 = V_lds + v_rd_base(lane);
#define GLD16(off) (*(const bf16x8*)((const char*)MKV + (unsigned)(off)))
  for (int t = 0; t < 4; ++t) {
    const unsigned kb_ = (unsigned)(64 * t) * 4096u;
    const bf16x8 ka0 = GLD16(offK + kb_), ka1 = GLD16(offK + kb_ + 32u * 4096u), kb0 = GLD16(offK + kb_ + 256u), kb1 = GLD16(offK + kb_ + 32u * 4096u + 256u);
    const bf16x8 vs0 = GLD16(offV + kb_), vs1 = GLD16(offV + kb_ + 32u * 4096u);
    const int kc = sc * 2;
    *(LAS bf16x8*)(K_lds + KSWZ(sr, kc)) = ka0; *(LAS bf16x8*)(K_lds + KSWZ(32 + sr, kc)) = ka1;
    *(LAS bf16x8*)(K_lds + SHM_K + KSWZ(sr, kc)) = kb0; *(LAS bf16x8*)(K_lds + SHM_K + KSWZ(32 + sr, kc)) = kb1;
    *(LAS bf16x8*)(V_lds + vst0) = vs0; *(LAS bf16x8*)(V_lds + vst1) = vs1;
    __syncthreads();
    f32x16 p0, p1; float al; bf16x8 pa0, pa1, pa2, pa3;
    qkt_acc<8, false>(p0, p1, K_lds, qr, r32, hi); qkt_acc<8, true>(p0, p1, K_lds + SHM_K, qr + 8, r32, hi);
    partialSM<false>(p0, p1, m_reg, al, cs, 0.f, 0, C, 0.f, 0);
    if (__any(al < 1.f)) { if (hi == 0) al_l[r32] = al; asm volatile("s_waitcnt lgkmcnt(0)" ::: "memory");
#pragma unroll
      for (int d = 0; d < 4; ++d)
#pragma unroll
        for (int r = 0; r < 16; ++r) o[d][r] *= al_l[crow(r, hi)]; }
    finishSM(p0, p1, al, l_reg, pa0, pa1, pa2, pa3);
    pv_d0(o, vb0, pa0, pa1, pa2, pa3);
    __syncthreads();
  }
#undef GLD16
  if (hi == 0) li_l[r32] = l_reg; asm volatile("s_waitcnt lgkmcnt(0)" ::: "memory");
  float rli[16];
#pragma unroll
  for (int r = 0; r < 16; ++r) rli[r] = __builtin_amdgcn_rcpf(li_l[crow(r, hi)]);
  { bf16_t zv[4][16];
#pragma unroll
  for (int d0 = 0; d0 < 4; ++d0)
#pragma unroll
    for (int r = 0; r < 16; ++r) zv[d0][r] = PROJ[(size_t)(qrow0 + crow(r, hi)) * NPAD + C_ZM + h * 256 + vh * 128 + d0 * 32 + r32];
#pragma unroll
  for (int d0 = 0; d0 < 4; ++d0) { const int col = h * 256 + vh * 128 + d0 * 32 + r32;
#pragma unroll
    for (int r = 0; r < 16; ++r) { const size_t row = (size_t)(qrow0 + crow(r, hi));
      UM[row * 1024 + col] = (bf16_t)f2bf(o[d0][r] * rli[r] * bf2f(zv[d0][r])); } } }
  __syncthreads();
}
__device__ __forceinline__ void attn_m_phase(const Args& a, LAS unsigned char* lds, int blk, int nblk, const int wid) {
  const bf16_t* PROJ = (const bf16_t*)(a.ws + WS_PROJ); const bf16_t* MKV = (const bf16_t*)(a.ws + WS_MKV); bf16_t* UM = (bf16_t*)(a.ws + WS_U) + (size_t)2 * S * 1024;
  for (int u = blk; u < 256; u += nblk) attn_m_unit(PROJ, MKV, UM, u & 3, u >> 3, (u >> 2) & 1, lds, wid);
}
__device__ __forceinline__ float slot_sum(const unsigned* ns, int tile, int bj, int wc0, int nwc) { float s = 0.f;
  for (int w = 0; w < nwc; ++w) s += __uint_as_float(__hip_atomic_load(ns + (tile * 2 + bj) * 4 + wc0 + w, __ATOMIC_RELAXED, __HIP_MEMORY_SCOPE_AGENT)); return s; }
__device__ __forceinline__ int window_jmin(float q2k2, float scale, int h, int R0, int NT) {
  const float slope2 = __builtin_amdgcn_exp2f(-(float)(h + 1)) * LOG2E, L = sqrtf(q2k2) * scale * LOG2E * 1.02f, D = (2.f * L + 48.f) / slope2;
  const float x = ((float)R0 - D - 63.f) * (1.f / 64.f);
  int jm = (int)floorf(x) - 1; jm = jm < 0 ? 0 : jm; jm &= ~1; return jm > NT - 2 ? NT - 2 : jm;
}
__device__ __forceinline__ int jmin_b(const unsigned* ns, int h, int qb) {
  const int bj = h & 1; float m = 0.f;
  for (int c = 0; c < 2; ++c) { const float v = slot_sum(ns, 20 + (h >> 1), bj, 2 * c, 2) * slot_sum(ns, 24 + (h >> 1), bj, 2 * c, 2); m = fmaxf(m, v); }
  return window_jmin(m, 0.125f, h, qb * 128, 2 * qb + 2);
}
constexpr int NUNITS_AB = 512;
__device__ __forceinline__ void build_order(const unsigned* ns, unsigned* order, LAS unsigned char* lds, const int lane) {
  LAS int* cost = (LAS int*)lds;
  for (int u = lane; u < NUNITS_AB; u += 64) { int jm, cst;
    { const int h = u & 7, qb = u >> 3; jm = jmin_b(ns, h, qb); cst = 2 * qb + 2 - jm; }
    cost[u] = cst; cost[NUNITS_AB + u] = jm; }
  asm volatile("s_waitcnt lgkmcnt(0)" ::: "memory"); __builtin_amdgcn_wave_barrier();
  for (int u = lane; u < NUNITS_AB; u += 64) { const int cu = cost[u]; int rank = 0;
    for (int v = 0; v < NUNITS_AB; ++v) { const int cv = cost[v]; rank += (cv > cu || (cv == cu && v < u)) ? 1 : 0; }
    order[rank] = (unsigned)u | ((unsigned)cost[NUNITS_AB + u] << 16); }
}
__device__ __forceinline__ void attn_ab_phase(const Args& a, LAS unsigned char* lds, int blk, int nblk, const int wid) {
  const bf16_t* PROJ = (const bf16_t*)(a.ws + WS_PROJ); bf16_t* UA = (bf16_t*)(a.ws + WS_U); bf16_t* UB = UA + (size_t)S * 1024;
  { const unsigned long long* MASK = (const unsigned long long*)(a.ws + WS_SEL);
    for (int u = blk; u < 256; u += nblk) attn_a_unit(PROJ, MASK, UA, u & 7, 31 - (u >> 3), 0, lds, wid); }
  const unsigned* order = (const unsigned*)(a.ws + WS_CTL + 4096); unsigned* qctr = (unsigned*)(a.ws + WS_CTL + 320);
  LAS unsigned* slot = (LAS unsigned*)(lds + 147456 - 64);
  for (;;) {
    if (wid == 0) { if (lane_id_v() == 0) slot[0] = __hip_atomic_fetch_add(qctr, 1u, __ATOMIC_RELAXED, __HIP_MEMORY_SCOPE_AGENT); }
    __syncthreads();
    const unsigned i = slot[0];
    __syncthreads();
    if (i >= 512u) break;
    const unsigned e = order[i]; const int u = (int)(e & 0xffffu), jm = (int)(e >> 16);
    attn_b_unit(PROJ, UB, a.in[9], ((const float*)(a.ws + WS_CTL))[0], u & 7, u >> 3, jm, lds, wid);
  }
}
#undef KSWZ
#undef SBAR
}


namespace idx {
typedef short bf16x8 __attribute__((ext_vector_type(8)));
typedef float f32x16 __attribute__((ext_vector_type(16)));
constexpr int NUNIT = 8 * (16 * 17 / 2);
__device__ __forceinline__ void scores_phase(const bf16_t* __restrict__ PROJ, float* SC, LAS unsigned char* lds, int blk, int nblk, const int wid) {
  const int lane = lane_id_v(), tid = wid * 64 + lane, n32 = lane & 31, hi = lane >> 5;
  const int skey = tid >> 3, schunk = tid & 7;
  const int swr = skey * 128 + ((schunk ^ (skey & 7)) << 4);
  for (int u = blk; u < NUNIT; u += nblk) {
    int g = 0, rem = u; while (rem >= 8 * (g + 1)) { rem -= 8 * (g + 1); ++g; }
    const int qc = 8 * g + rem / (g + 1), kc = rem % (g + 1);
    const int q0 = 64 * qc + 8 * wid, k_begin = 512 * kc, k_end = min(512 * kc + 512, 64 * qc + 64), ntile = (k_end - k_begin) / 64;
    bf16x8 af[4][4]; float w[4][16];
    const int head = (n32 & 3) + 4 * (n32 >> 3), qbit = (n32 >> 2) & 1;
#pragma unroll
    for (int t = 0; t < 4; ++t) {
      const bf16_t* qp = PROJ + (size_t)(q0 + 2 * t + qbit) * NPAD + C_QI + head * 64 + hi * 8;
#pragma unroll
      for (int ks = 0; ks < 4; ++ks) af[t][ks] = *(const bf16x8*)(qp + ks * 16);
      const bf16_t* wp = PROJ + (size_t)(q0 + 2 * t + hi) * NPAD + C_WI;
      const u32x4 w0 = *(const u32x4*)wp, w1 = *(const u32x4*)(wp + 8);
      const unsigned ww[8] = {w0.x, w0.y, w0.z, w0.w, w1.x, w1.y, w1.z, w1.w};
#pragma unroll
      for (int i = 0; i < 8; ++i) { w[t][2 * i] = bflo(ww[i]) * 0.03125f; w[t][2 * i + 1] = bfhi(ww[i]) * 0.03125f; }
    }
    u32x4 st = *(const u32x4*)(PROJ + (size_t)(k_begin + skey) * NPAD + C_KI + schunk * 8);
    __syncthreads();
    *(LAS u32x4*)(lds + swr) = st;
    __syncthreads();
    for (int tl = 0; tl < ntile; ++tl) {
      LAS const unsigned char* kb = lds + (tl & 1) * 8192;
      if (tl + 1 < ntile) st = *(const u32x4*)(PROJ + (size_t)(k_begin + 64 * (tl + 1) + skey) * NPAD + C_KI + schunk * 8);
#pragma unroll
      for (int kh = 0; kh < 2; ++kh) {
        const int krow = kh * 32 + n32;
        bf16x8 bfr[4];
#pragma unroll
        for (int ks = 0; ks < 4; ++ks) bfr[ks] = *(LAS const bf16x8*)(kb + krow * 128 + (((2 * ks + hi) ^ (krow & 7)) << 4));
        const int s = k_begin + 64 * tl + krow;
#pragma unroll
        for (int t = 0; t < 4; ++t) {
          f32x16 acc = {};
#pragma unroll
          for (int ks = 0; ks < 4; ++ks) acc = __builtin_amdgcn_mfma_f32_32x32x16_bf16(af[t][ks], bfr[ks], acc, 0, 0, 0);
          float sc = 0.f;
#pragma unroll
          for (int r = 0; r < 16; ++r) sc = fmaf(fmaxf(acc[r], 0.f), w[t][r], sc);
          const int q = q0 + 2 * t + hi;
          if (s <= q) SC[sc_off(q) + s] = sc;
        }
      }
      if (tl + 1 < ntile) { *(LAS u32x4*)(lds + ((tl + 1) & 1) * 8192 + swr) = st; }
      __syncthreads();
    }
  }
}
}

#ifdef DBG_STAGE
__device__ __forceinline__ void dbg_dump(const Args& a, int blk, int nblk) {
    const bf16_t* PROJ = (const bf16_t*)(a.ws + WS_PROJ);
    for (size_t idx = (size_t)blk * 512 + threadIdx.x; idx < (size_t)S * DM; idx += (size_t)nblk * 512) {
        const int r = (int)(idx / DM), c = (int)(idx % DM); float v = 0.f;
#if DBG_STAGE == 1 && defined(DBG_WEIGHTS)
        for (int z = 0; z < 3; ++z) v += bf2f(((const bf16_t*)(a.ws + WS_WTBR))[((size_t)z * 2048 + (r & 2047)) * 1024 + (c & 1023)]);
        v += bf2f(((const bf16_t*)(a.ws + WS_WTOUT))[(size_t)(r & 2047) * 2048 + c]);
#elif DBG_STAGE == 1 && defined(DBG_GATES)
        for (int j = 0; j < 3; ++j) v += bf2f(PROJ[(size_t)r * NPAD + C_GL + c + 2048 * j]);
#elif DBG_STAGE == 1
        for (int j = 0; j < 8; ++j) v += bf2f(PROJ[(size_t)r * NPAD + c + 2048 * j]);
        if (c < 1280) v += bf2f(PROJ[(size_t)r * NPAD + 16384 + c]);
        if (r < 256) v += bf2f(((const bf16_t*)(a.ws + WS_MKV))[(size_t)r * 2048 + c]);
        for (int z = 0; z < 3; ++z) v += bf2f(((const bf16_t*)(a.ws + WS_WTBR))[((size_t)z * 2048 + (r & 2047)) * 1024 + (c & 1023)]);
        v += bf2f(((const bf16_t*)(a.ws + WS_WTOUT))[(size_t)(r & 2047) * 2048 + c]);
#elif DBG_STAGE == 2
        if (c < 1024) v = bf2f(((const bf16_t*)(a.ws + WS_U))[(size_t)(S + r) * 1024 + c]) + bf2f(((const bf16_t*)(a.ws + WS_U))[(size_t)(2 * S + r) * 1024 + c]);
        else { const float* row = (const float*)(a.ws + WS_SC) + sc_off(r); for (int j = c - 1024; j <= r; j += 1024) v += row[j]; }
#elif DBG_STAGE == 3
        if (c < 256) v = (float)((const int*)(a.ws + WS_SEL))[(size_t)r * 256 + c];
#elif DBG_STAGE == 4
        if (c < 1024) v = bf2f(((const bf16_t*)(a.ws + WS_U))[(size_t)r * 1024 + c]);
#elif DBG_STAGE == 5
        v = bf2f(((const bf16_t*)(a.ws + WS_MERGED))[(size_t)r * DM + c]);
#endif
        a.out[idx] = v;
    }
}
#endif

#define RLX_AGENT __ATOMIC_RELAXED, __HIP_MEMORY_SCOPE_AGENT
#define XB_TMO      128
#define XB_XCNT(j)  (256  + 64 * (j))
#define XB_XSUB(j)  (1280 + 64 * (j))
#define XB_XGEN(j)  (2304 + 64 * (j))
#define XB_TOP      3328
#define XB_TOPGEN   3392
#define XCD_BAR_WORDS 3456
#define XB_SPIN_CAP (1u << 18)

__device__ __forceinline__ unsigned xb_ld(unsigned* p)              { return __hip_atomic_load(p, __ATOMIC_RELAXED, __HIP_MEMORY_SCOPE_AGENT); }
__device__ __forceinline__ unsigned xb_add(unsigned* p, unsigned v) { return __hip_atomic_fetch_add(p, v, __ATOMIC_RELAXED, __HIP_MEMORY_SCOPE_AGENT); }
__device__ __forceinline__ unsigned xb_xcc_id() { return (unsigned)__builtin_amdgcn_s_getreg((3 << 11) | 20) & 0xFu; }
#define XB_SPIN(cond, bar) do { unsigned _sp = 0; while (cond) { __builtin_amdgcn_s_sleep(1); \
    if ((++_sp & 255u) == 0u) { if (xb_ld(&(bar)[XB_TMO])) break; if (_sp > XB_SPIN_CAP) { atomicAdd(&(bar)[XB_TMO], 1u); break; } } } } while (0)

struct XcdBarrier {
    unsigned* bar; unsigned x;
    volatile LAS unsigned* st;
};

__device__ __forceinline__ XcdBarrier xcd_barrier_post(unsigned* bar, volatile LAS unsigned* st, bool leader) {
    XcdBarrier b; b.bar = bar; b.x = xb_xcc_id(); b.st = st;
    if (leader) (void)xb_add(&bar[XB_XCNT(b.x)], 1u);
    return b;
}
__device__ __forceinline__ void xcd_barrier_complete(unsigned* bar, unsigned x, unsigned& nloc, unsigned& nx) {
    const unsigned G = gridDim.x * gridDim.y * gridDim.z;
    unsigned sum, cnt, mine, sp = 0u;
    for (;;) {
        sum = 0u; cnt = 0u; mine = 0u;
#pragma unroll
        for (unsigned j = 0; j < 16; ++j) { const unsigned c = xb_ld(&bar[XB_XCNT(j)]); sum += c; cnt += (c > 0u) ? 1u : 0u; mine = (j == x) ? c : mine; }
        if (sum == G) break;
        __builtin_amdgcn_s_sleep(1);
        if ((++sp & 255u) == 0u) { if (xb_ld(&bar[XB_TMO])) break; if (sp > XB_SPIN_CAP) { atomicAdd(&bar[XB_TMO], 1u); break; } }
    }
    nloc = mine > 0u ? mine : 1u; nx = cnt > 0u ? cnt : 1u;
}

__device__ __forceinline__ void xcd_barrier(const XcdBarrier& b, bool leader) {
    asm volatile("s_waitcnt vmcnt(0)" ::: "memory");
    __syncthreads();
    if (leader) {
        unsigned* bar = b.bar;
        __builtin_amdgcn_s_waitcnt(0);
        unsigned nloc = b.st[0], nx = b.st[1];
        if (nloc == 0u) { xcd_barrier_complete(bar, b.x, nloc, nx); b.st[0] = nloc; b.st[1] = nx; }
        const unsigned old = xb_add(&bar[XB_XSUB(b.x)], 1u);
        const unsigned gen = old / nloc;
        if (old + 1u == (gen + 1u) * nloc) {
            __builtin_amdgcn_fence(__ATOMIC_RELEASE, "agent");
            asm volatile("s_waitcnt vmcnt(0)" ::: "memory");
            const unsigned og = xb_add(&bar[XB_TOP], 1u);
            const unsigned tg = og / nx;
            if (og + 1u == (tg + 1u) * nx) xb_add(&bar[XB_TOPGEN], 1u);
            else XB_SPIN(xb_ld(&bar[XB_TOPGEN]) == tg, bar);
            __builtin_amdgcn_fence(__ATOMIC_ACQUIRE, "agent");
            xb_add(&bar[XB_XGEN(b.x)], 1u);
            asm volatile("s_waitcnt vmcnt(0)" ::: "memory");
        } else {
            XB_SPIN(xb_ld(&bar[XB_XGEN(b.x)]) == gen, bar);
            __builtin_amdgcn_fence(__ATOMIC_ACQUIRE, "agent");
            asm volatile("s_waitcnt vmcnt(0)" ::: "memory");
        }
    }
    __syncthreads();
}

__device__ __forceinline__ void grid_bar(unsigned* cnt, unsigned target, const int wave) {
    asm volatile("s_waitcnt vmcnt(0)" ::: "memory");
    __syncthreads();
    if (wave == 0) {
        if (lane_id_v() == 0) {
            __builtin_amdgcn_fence(__ATOMIC_RELEASE, "agent");
            asm volatile("s_waitcnt vmcnt(0)" ::: "memory");
            __hip_atomic_fetch_add(cnt, 1u, __ATOMIC_RELAXED, __HIP_MEMORY_SCOPE_AGENT);
            while (__hip_atomic_load(cnt, __ATOMIC_RELAXED, __HIP_MEMORY_SCOPE_AGENT) < target) __builtin_amdgcn_s_sleep(2);
            __builtin_amdgcn_fence(__ATOMIC_ACQUIRE, "agent");
            asm volatile("s_waitcnt vmcnt(0)" ::: "memory");
        }
    }
    __syncthreads();
}

constexpr int LDS_BYTES = 147456;
constexpr int NPHASE = 8;
__global__ void __launch_bounds__(512, 2) fwd(Args a) {
    extern __shared__ __attribute__((aligned(16))) unsigned char lds_raw[];
    LAS unsigned char* lds = (LAS unsigned char*)lds_raw;
    cg::grid_group grid = cg::this_grid();
    const int blk = blockIdx.x, nblk = gridDim.x, wave = __builtin_amdgcn_readfirstlane(threadIdx.x >> 6);
    unsigned char* ws = a.ws;
    const bf16_t* PROJ = (const bf16_t*)(ws + WS_PROJ);
    volatile LAS unsigned* xst = (volatile LAS unsigned*)(lds + 147456 - 128);
    if (wave == 0) { if (lane_id_v() == 0) { xst[0] = 0u; xst[1] = 0u; } }
    __syncthreads();
    (void)xcd_barrier_post((unsigned*)(ws + WS_CTL + 16384), xst, wave == 0 && lane_id_v() == 0);
#define IN(k) (a.ph_lo <= (k) && (k) < a.ph_hi)
#define SEAM(k) do { if (IN(k) && IN((k) + 1)) { if ((k) == 0) grid.sync(); else { XcdBarrier xb_; xb_.bar = (unsigned*)(ws + WS_CTL + 16384); xb_.x = xb_xcc_id(); xb_.st = (volatile LAS unsigned*)(lds + 147456 - 128); xcd_barrier(xb_, wave == 0 && lane_id_v() == 0); } } } while (0)
    if (IN(0)) { p0_prologue(a, lds, blk, nblk, wave); } SEAM(0);
    if (IN(1)) {
        pg8::Gemm g{(const bf16_t*)(ws + WS_H), (const bf16_t*)(ws + WS_WTIN), S, NPAD, DM, (long)WS_MEMN - (long)WS_H, (long)WS_WTMKV - (long)WS_WTIN};
        pg8::ProjOrder so; so.init(S, NPAD, nblk, blk);
        pg8::EpiProj E{(bf16_t*)(ws + WS_PROJ), NPAD, (bf16_t*)(ws + WS_MKV), 2048, a.in[4], C_GL / 256, (unsigned*)(ws + WS_CTL + 1024)};
        pg8::gemm_phase<pg8::EpiProj, pg8::ProjOrder, true, true>(lds, g, so, E, wave);
    } SEAM(1);
    if (IN(2)) { idx::scores_phase(PROJ, (float*)(ws + WS_SC), lds, blk, nblk, wave); __syncthreads(); att::attn_m_phase(a, lds, blk, nblk, wave); } SEAM(2);
    if (IN(3)) { if (blk == nblk - 1) { if (wave == 7) att::build_order((const unsigned*)(ws + WS_CTL + 1024), (unsigned*)(ws + WS_CTL + 4096), lds + 131072, lane_id_v()); }
                 topk_select((const float*)(ws + WS_SC), (int*)(ws + WS_SEL), lds, blk, nblk, wave); } SEAM(3);
    if (IN(4)) { att::attn_ab_phase(a, lds, blk, nblk, wave); } SEAM(4);
    if (IN(5)) {
        pg8::Gemm g{(const bf16_t*)(ws + WS_U), (const bf16_t*)(ws + WS_WTBR), S, DM, 1024, (long)S * 1024 * 2, (long)2048 * 1024 * 2};
        pg8::MergeOrder so; so.init(S, DM, nblk, blk);
        pg8::EpiMerge E{PROJ + C_GL, NPAD, (bf16_t*)(ws + WS_MERGED), DM};
        pg8::gemm_phase<pg8::EpiMerge, pg8::MergeOrder, true, true>(lds, g, so, E, wave);
    } SEAM(5);
    if (IN(6)) {
        pg8::Gemm g{(const bf16_t*)(ws + WS_MERGED), (const bf16_t*)(ws + WS_WTOUT), S, DM, DM, 0, 0};
        pg8::StaticOrder so; so.init(S, DM, nblk, blk);
        pg8::EpiOut E{a.in[0], a.out, DM, (float*)(ws + WS_PART), S};
        pg8::gemm_phase<pg8::EpiOut, pg8::StaticOrder, false, true>(lds, g, so, E, wave);
    } SEAM(6);
    if (IN(7)) { final_norm(a, blk, nblk, wave); }
#ifdef DBG_STAGE
    if (IN(8)) { dbg_dump(a, blk, nblk); }
#endif
#undef IN
#undef SEAM
}

#ifndef N_LAUNCH_MODE
#define N_LAUNCH_MODE 0
#endif
extern "C" void kernel_launch(void* const* d_in, const int* in_sizes, int n_in, void* d_out, int out_size, void* d_ws, size_t ws_size, hipStream_t stream) {
    static int grid = 0;
    if (grid == 0) {
        if (n_in != 17 || in_sizes[0] != S * DM || in_sizes[3] != DM * DIN || out_size != S * DM || ws_size < WS_END) {
            fprintf(stderr, "kernel_launch: unexpected shapes (n_in %d, in0 %d, in3 %d, out %d, ws %zu < %zu)\n", n_in, n_in > 0 ? in_sizes[0] : -1, n_in > 3 ? in_sizes[3] : -1, out_size, ws_size, (size_t)WS_END); grid = -1; return; }
        int dev = 0, cus = 0, per_cu = 0;
        (void)hipGetDevice(&dev); (void)hipDeviceGetAttribute(&cus, hipDeviceAttributeMultiprocessorCount, dev);
        if (hipFuncSetAttribute((const void*)fwd, hipFuncAttributeMaxDynamicSharedMemorySize, LDS_BYTES) != hipSuccess) { fprintf(stderr, "kernel_launch: hipFuncSetAttribute failed\n"); grid = -1; return; }
        if (hipOccupancyMaxActiveBlocksPerMultiprocessor(&per_cu, (const void*)fwd, 512, LDS_BYTES) != hipSuccess || per_cu < 1) { fprintf(stderr, "kernel_launch: occupancy query gave %d\n", per_cu); per_cu = 1; }
        (void)hipGetLastError();
        grid = cus * 1;
        if (grid > cus * per_cu) grid = cus * per_cu;
        if (grid < 8) grid = -1;
    }
    if (grid < 0) return;
    Args a{};
    for (int i = 0; i < 17; ++i) a.in[i] = (const float*)d_in[i];
    a.out = (float*)d_out; a.ws = (unsigned char*)d_ws;
#if N_LAUNCH_MODE == 1
    (void)hipMemsetAsync((unsigned char*)d_ws + WS_CTL + 256, 0, 256, stream);
    (void)hipMemsetAsync((unsigned char*)d_ws + WS_CTL + 16384, 0, 16384, stream);
    a.ph_lo = 0; a.ph_hi = NPHASE;
    void* kargs[] = {&a};
    hipError_t e = hipLaunchCooperativeKernel((const void*)fwd, dim3(grid), dim3(512), kargs, LDS_BYTES, stream);
    if (e != hipSuccess) fprintf(stderr, "cooperative launch failed: %s (grid %d)\n", hipGetErrorString(e), grid);
#else
#ifdef DBG_STAGE
    #ifdef DBG_WEIGHTS
    constexpr int last_ph[6] = {0, 0, 2, 3, 4, 5};
#else
    constexpr int last_ph[6] = {0, 1, 2, 3, 4, 5};
#endif
    for (int p = 0; p <= last_ph[DBG_STAGE]; ++p) { a.ph_lo = p; a.ph_hi = p + 1; hipLaunchKernelGGL(fwd, dim3(grid), dim3(512), LDS_BYTES, stream, a); }
    a.ph_lo = 8; a.ph_hi = 9; hipLaunchKernelGGL(fwd, dim3(grid), dim3(512), LDS_BYTES, stream, a);
#else
    for (int p = 0; p < NPHASE; ++p) {
        a.ph_lo = p; a.ph_hi = p + 1;
        hipLaunchKernelGGL(fwd, dim3(grid), dim3(512), LDS_BYTES, stream, a);
    }
#endif
#endif
}
```

```cpp
#define N_LAUNCH_MODE 1
#include <hip/hip_runtime.h>
#include <hip/hip_cooperative_groups.h>
#include <cstdio>
#include <cstdint>
namespace cg = cooperative_groups;

__device__ __forceinline__ int lane_id_v() { int l; asm volatile("v_mbcnt_lo_u32_b32 %0, -1, 0\n\tv_mbcnt_hi_u32_b32 %0, -1, %0" : "=v"(l)); return l; }
namespace pg8 {
#define PG8_LAS __attribute__((address_space(3)))
typedef unsigned short bf16_t;
typedef short bf16x8 __attribute__((ext_vector_type(8)));
typedef float f32x4 __attribute__((ext_vector_type(4)));
typedef unsigned u32x4 __attribute__((ext_vector_type(4)));
constexpr int BM = 256, BK = 64, HALF = 128, HTB = HALF * BK * 2  , STAGE_BYTES = 8 * HTB, NXCD = 8, WGM = 8;

__host__ __device__ __forceinline__ int lds_byte(int r, int c) { const int st = (r >> 4) * 2 + (c >> 5), rr = r & 15, cc = c & 31, ob = rr * 64 + cc * 2; return st * 1024 + (ob ^ (((ob >> 9) & 1) << 5)); }
__host__ __device__ __forceinline__ void stage_rc(int b, int& R, int& C) { const int st = b / 1024, sb = b % 1024, swz = sb ^ (((sb >> 9) & 1) << 5); R = (st >> 1) * 16 + swz / 64; C = (st & 1) * 32 + (swz % 64) / 2; }
__host__ __device__ __forceinline__ int perm32(int rho) { const int n = rho >> 4, i = rho & 15; return 8 * (i >> 2) + 4 * n + (i & 3); }

struct Unit { int pm, pn, z; };
struct Gemm { const bf16_t* A; const bf16_t* Bt; int M, N, K; long zA, zB; };

struct StaticOrder {
    int nM, nN, nwg, G, c;
    __host__ __device__ void init(int M, int N, int G_, int c_) { nM = M / BM; nN = N / BM; nwg = nM * nN; G = G_; c = c_; }
    __host__ __device__ bool next(int i, Unit& u) const {
        const long L = (long)i * G + c; if (L >= nwg) return false;
        int wgid = (int)L; { const int q = nwg / NXCD, r = nwg % NXCD, xcd = wgid % NXCD, off = wgid / NXCD; wgid = (xcd < r ? xcd * (q + 1) : r * (q + 1) + (xcd - r) * q) + off; }
        const int nig = WGM * nN, gid = wgid / nig, fm = gid * WGM, gsz = (nM - fm) < WGM ? (nM - fm) : WGM;
        u.pm = fm + ((wgid % nig) % gsz); u.pn = (wgid % nig) / gsz; u.z = 0; return true;
    }
    __device__ __forceinline__ void a_ready(const Unit&) const {}
    __device__ __forceinline__ void done(const Unit&) const {}
};

typedef float f32x2_t __attribute__((ext_vector_type(2))); typedef __bf16 bf16x2_t __attribute__((ext_vector_type(2)));
__device__ __forceinline__ unsigned cvt_pk_bf16(float lo, float hi) { f32x2_t v = {lo, hi}; bf16x2_t b = __builtin_convertvector(v, bf16x2_t); return __builtin_bit_cast(unsigned, b); }

__device__ __forceinline__ float bf2f(unsigned short u) { return __uint_as_float((unsigned)u << 16); }
__device__ __forceinline__ float sigmoidf_(float v) { return __builtin_amdgcn_rcpf(1.0f + __builtin_amdgcn_exp2f(-1.4426950408889634f * v)); }
template <int MODE> __device__ __forceinline__ float act_(float v, float b) {
    if (MODE == 1) return v * sigmoidf_(v);
    if (MODE == 2) return sigmoidf_(v + b);
    return v;
}
struct EpiProj {
    static constexpr bool PERM = true, AFTER_DRAIN = false, KEEP_ACC = false;
    bf16_t* O; int ldc; bf16_t* O1; int ldc1; const float* bgate; int gate_tile0;
    unsigned* nslot;
    __device__ __forceinline__ void norms(const f32x4 (&acc)[2][2][4][2], const Unit& u, int wc, int lane) const {
        float wm[2] = {0.f, 0.f};
#pragma unroll
        for (int ai = 0; ai < 2; ++ai)
#pragma unroll
            for (int m = 0; m < 4; ++m)
#pragma unroll
                for (int bj = 0; bj < 2; ++bj) { const f32x4 a = acc[ai][bj][m][0], c = acc[ai][bj][m][1];
                    float s = (a[0] * a[0] + a[1] * a[1]) + (a[2] * a[2] + a[3] * a[3]) + (c[0] * c[0] + c[1] * c[1]) + (c[2] * c[2] + c[3] * c[3]);
                    s += __shfl_xor(s, 16); s += __shfl_xor(s, 32); wm[bj] = fmaxf(wm[bj], s); }
#pragma unroll
        for (int bj = 0; bj < 2; ++bj) { float v = wm[bj]; v = fmaxf(v, __shfl_xor(v, 1)); v = fmaxf(v, __shfl_xor(v, 2)); v = fmaxf(v, __shfl_xor(v, 4)); v = fmaxf(v, __shfl_xor(v, 8));
            if (lane == 0) atomicMax(nslot + (u.pn * 2 + bj) * 4 + wc, __float_as_uint(v)); }
    }
    template <int MODE> __device__ __forceinline__ void put(const f32x4 (&acc)[2][2][4][2], bf16_t* base, int ld, int row0, int col0, const float* bias) const {
        f32x4 bv[2][2];
#pragma unroll
        for (int bj = 0; bj < 2; ++bj)
#pragma unroll
            for (int n = 0; n < 2; ++n) bv[bj][n] = (MODE == 2) ? *(const f32x4*)(bias + bj * HALF + 4 * n) : (f32x4){0.f, 0.f, 0.f, 0.f};
#pragma unroll
        for (int ai = 0; ai < 2; ++ai)
#pragma unroll
            for (int m = 0; m < 4; ++m) { bf16_t* rowp = base + (size_t)(row0 + ai * HALF + m * 16) * ld + col0;
#pragma unroll
                for (int bj = 0; bj < 2; ++bj) { f32x4 v0 = acc[ai][bj][m][0], v1 = acc[ai][bj][m][1];
#pragma unroll
                    for (int e = 0; e < 4; ++e) { v0[e] = act_<MODE>(v0[e], bv[bj][0][e]); v1[e] = act_<MODE>(v1[e], bv[bj][1][e]); }
                    u32x4 w; w.x = cvt_pk_bf16(v0[0], v0[1]); w.y = cvt_pk_bf16(v0[2], v0[3]); w.z = cvt_pk_bf16(v1[0], v1[1]); w.w = cvt_pk_bf16(v1[2], v1[3]);
                    *(u32x4*)(rowp + bj * HALF) = w; } }
    }
    __device__ __forceinline__ void operator()(const f32x4 (&acc)[2][2][4][2], const Unit& u, int wr, int wc, int fr, int fq) const {
        const int row0 = u.pm * BM + wr * 64 + fr, col0 = u.pn * BM + wc * 32 + 8 * fq;
        if (u.z == 1) { put<0>(acc, O1, ldc1, row0, col0, nullptr); return; }
        const int t = u.pn;
        if (t < 8 || (t >= 20 && t < 28)) norms(acc, u, wc, fr + 16 * fq);
        const bool is_silu = (t >= 12 && t < 16) || (t >= 32 && t < 36) || (t >= 40 && t < 44);
        if (t >= gate_tile0 && t < 68) put<2>(acc, O, ldc, row0, col0, bgate + (col0 - gate_tile0 * BM));
        else if (is_silu) put<1>(acc, O, ldc, row0, col0, nullptr);
        else put<0>(acc, O, ldc, row0, col0, nullptr);
    }
};
struct EpiMerge {
    static constexpr bool PERM = true, AFTER_DRAIN = false, KEEP_ACC = true;
    const bf16_t* G; int ldg;
    bf16_t* O; int ldc;
    __device__ __forceinline__ static void unpack8(const u32x4 gw, f32x4& g0, f32x4& g1) {
        g0[0] = __uint_as_float(gw.x << 16); g0[1] = __uint_as_float(gw.x & 0xffff0000u); g0[2] = __uint_as_float(gw.y << 16); g0[3] = __uint_as_float(gw.y & 0xffff0000u);
        g1[0] = __uint_as_float(gw.z << 16); g1[1] = __uint_as_float(gw.z & 0xffff0000u); g1[2] = __uint_as_float(gw.w << 16); g1[3] = __uint_as_float(gw.w & 0xffff0000u); }
    __device__ __forceinline__ void operator()(f32x4 (&acc)[2][2][4][2], const Unit& u, int wr, int wc, int fr, int fq) const {
        const int row0 = u.pm * BM + wr * 64 + fr, col0 = u.pn * BM + wc * 32 + 8 * fq;
#pragma unroll
        for (int ai = 0; ai < 2; ++ai) {
            u32x4 ga[4][2], gb[4][2];
#pragma unroll
            for (int m = 0; m < 4; ++m)
#pragma unroll
                for (int bj = 0; bj < 2; ++bj) { const bf16_t* gp = G + (size_t)(row0 + ai * HALF + m * 16) * ldg + (size_t)u.z * 2048 + col0 + bj * HALF;
                    ga[m][bj] = *(const u32x4*)gp; gb[m][bj] = (u.z < 2) ? *(const u32x4*)(gp + 2048) : (u32x4){0u, 0u, 0u, 0u}; }
#pragma unroll
            for (int m = 0; m < 4; ++m) { const size_t row = (size_t)(row0 + ai * HALF + m * 16);
#pragma unroll
                for (int bj = 0; bj < 2; ++bj) { const int col = col0 + bj * HALF;
                    f32x4 a0, a1; unpack8(ga[m][bj], a0, a1);
                    f32x4 r0, r1;
                    if (u.z < 2) { f32x4 n0, n1; unpack8(gb[m][bj], n0, n1);
#pragma unroll
                        for (int e = 0; e < 4; ++e) { const float d0 = fmaxf(n0[e], 1e-30f), d1 = fmaxf(n1[e], 1e-30f);
                            const float x0 = (u.z == 0) ? a0[e] : fmaxf(a0[e], 1e-30f), x1 = (u.z == 0) ? a1[e] : fmaxf(a1[e], 1e-30f);
                            r0[e] = x0 * __builtin_amdgcn_rcpf(d0); r1[e] = x1 * __builtin_amdgcn_rcpf(d1); }
                        acc[ai][bj][m][0] *= r0; acc[ai][bj][m][1] *= r1;
                    } else {
#pragma unroll
                        for (int e = 0; e < 4; ++e) { r0[e] = fmaxf(a0[e], 1e-30f); r1[e] = fmaxf(a1[e], 1e-30f); }
                        const f32x4 v0 = acc[ai][bj][m][0] * r0, v1 = acc[ai][bj][m][1] * r1;
                        u32x4 w; w.x = cvt_pk_bf16(v0[0], v0[1]); w.y = cvt_pk_bf16(v0[2], v0[3]); w.z = cvt_pk_bf16(v1[0], v1[1]); w.w = cvt_pk_bf16(v1[2], v1[3]);
                        *(u32x4*)(O + row * ldc + col) = w;
                        acc[ai][bj][m][0] = (f32x4){0.f, 0.f, 0.f, 0.f}; acc[ai][bj][m][1] = (f32x4){0.f, 0.f, 0.f, 0.f}; } } }
        }
    }
};
struct EpiOut {
    static constexpr bool PERM = false, AFTER_DRAIN = false, KEEP_ACC = false;
    const float* X; float* Y; int ldc; float* part; int M;
    __device__ __forceinline__ void operator()(const f32x4 (&acc)[2][2][4][2], const Unit& u, int wr, int wc, int fr, int fq) const {
        const int row0 = u.pm * BM + wr * 64 + fr, col0 = u.pn * BM + wc * 32 + 4 * fq;
#pragma unroll
        for (int ai = 0; ai < 2; ++ai) {
            f32x4 xv[4][2][2];
#pragma unroll
            for (int m = 0; m < 4; ++m)
#pragma unroll
                for (int bj = 0; bj < 2; ++bj)
#pragma unroll
                    for (int n = 0; n < 2; ++n) xv[m][bj][n] = *(const f32x4*)(X + (size_t)(row0 + ai * HALF + m * 16) * ldc + col0 + bj * HALF + n * 16);
#pragma unroll
            for (int m = 0; m < 4; ++m) { const size_t row = (size_t)(row0 + ai * HALF + m * 16); float ss = 0.f;
#pragma unroll
                for (int bj = 0; bj < 2; ++bj)
#pragma unroll
                    for (int n = 0; n < 2; ++n) { const size_t off = row * ldc + col0 + bj * HALF + n * 16;
                        const f32x4 y = xv[m][bj][n] + acc[ai][bj][m][n]; *(f32x4*)(Y + off) = y;
                        ss += (y[0] * y[0] + y[1] * y[1]) + (y[2] * y[2] + y[3] * y[3]); }
                ss += __shfl_xor(ss, 16); ss += __shfl_xor(ss, 32);
                if (fq == 0) part[(size_t)(u.pn * 4 + wc) * M + row] = ss; }
        }
    }
};
struct ProjOrder {
    StaticOrder so; int nmain, extra;
    __device__ void init(int M, int N, int G, int c) { so.init(M, N, G, c); nmain = (so.nwg - c + G - 1) / G; extra = (c >= G - 8) ? c - (G - 8) : -1; }
    __device__ bool next(int i, Unit& u) const {
        if (i < nmain) return so.next(i, u);
        if (i == nmain && extra >= 0) { u.pm = 0; u.pn = extra; u.z = 1; return true; }
        return false;
    }
    __device__ __forceinline__ void a_ready(const Unit&) const {}
    __device__ __forceinline__ void done(const Unit&) const {}
};
struct MergeOrder {
    StaticOrder so;
    __device__ void init(int M, int N, int G, int c) { so.init(M, N, G, c); }
    __device__ bool next(int i, Unit& u) const { if (i >= 3) return false; if (!so.next(0, u)) return false; u.z = i; return true; }
    __device__ __forceinline__ void a_ready(const Unit&) const {}
    __device__ __forceinline__ void done(const Unit&) const {}
};

template <class Epi, class Sched, bool ALIGN_EPI = false, bool SP2 = false>
__device__ __forceinline__ void gemm_phase(PG8_LAS unsigned char* lds, const Gemm g, const Sched& S, const Epi& E, const int wid  ) {
    const int lane = lane_id_v(), tid = wid * 64 + lane, wr = wid >> 2, wc = wid & 3, fr = lane & 15, fq = lane >> 4;
    const int K = g.K, nt = K / BK;
    unsigned voffA[2], voffB[2];
#pragma unroll
    for (int i = 0; i < 2; ++i) { int R, C; stage_rc(tid * 16 + i * 8192, R, C); const int Rb = Epi::PERM ? ((R & ~31) + perm32(R & 31)) : R;
        voffA[i] = (unsigned)(R * K + C) * 2u; voffB[i] = (unsigned)(Rb * K + C) * 2u; }
    const size_t kstep = (size_t)(BK * 2);
    const size_t hstep = (size_t)HALF * K * 2;
    const size_t tstep = 2 * hstep;
    const unsigned ldsw = (unsigned)wid * 1024u;
    const int aoff = lds_byte(wr * 64 + fr, fq * 8), boff = lds_byte(wc * 32 + fr, fq * 8);
#define PG8_SA(b, h) (((b) * 2 + (h)) * HTB)
#define PG8_SB(b, h) ((4 + (b) * 2 + (h)) * HTB)
#define PG8_STAGE(bufoff, gbase, voff) do { _Pragma("unroll") for (int _i = 0; _i < 2; ++_i) \
        __builtin_amdgcn_global_load_lds((const unsigned*)((const char*)(gbase) + (voff)[_i]), (PG8_LAS unsigned*)(lds + (bufoff) + ldsw + _i * 8192), 16, 0, 0); } while (0)
#define PG8_LDA(dst, b, h) do { _Pragma("unroll") for (int m = 0; m < 4; ++m) _Pragma("unroll") for (int k = 0; k < 2; ++k) dst[m][k] = *(const PG8_LAS bf16x8*)(lds + PG8_SA(b, h) + aoff + m * 2048 + k * 1024); } while (0)
#define PG8_LDB(dst, b, h) do { _Pragma("unroll") for (int n = 0; n < 2; ++n) _Pragma("unroll") for (int k = 0; k < 2; ++k) dst[n][k] = *(const PG8_LAS bf16x8*)(lds + PG8_SB(b, h) + boff + n * 2048 + k * 1024); } while (0)
#define PG8_MMA(ai, bj, At, Bt) do { __builtin_amdgcn_s_setprio(1); _Pragma("unroll") for (int m = 0; m < 4; ++m) _Pragma("unroll") for (int n = 0; n < 2; ++n) _Pragma("unroll") for (int k = 0; k < 2; ++k) \
        acc[ai][bj][m][n] = __builtin_amdgcn_mfma_f32_16x16x32_bf16(Bt[n][k], At[m][k], acc[ai][bj][m][n], 0, 0, 0); __builtin_amdgcn_s_setprio(0); } while (0)
#define PG8_WAIT_V(n) asm volatile("s_waitcnt vmcnt(" #n ")" ::: "memory")
#define PG8_WAIT_L(n) asm volatile("s_waitcnt lgkmcnt(" #n ")" ::: "memory")
#define PG8_BAR __builtin_amdgcn_s_barrier()
#define PG8_SCHED __builtin_amdgcn_sched_barrier(0)
    Unit cur, nxt; int ui = 0;
    if (!S.next(0, cur)) return;
    f32x4 acc[2][2][4][2];
#pragma unroll
    for (int a = 0; a < 2; ++a)
#pragma unroll
        for (int b = 0; b < 2; ++b)
#pragma unroll
            for (int m = 0; m < 4; ++m)
#pragma unroll
                for (int n = 0; n < 2; ++n) acc[a][b][m][n] = (f32x4){0.f, 0.f, 0.f, 0.f};
    bf16x8 At[4][2], B0[2][2], B1[2][2];
    const char* cA = (const char*)g.A + (long)cur.z * g.zA + (size_t)cur.pm * tstep; const char* cB = (const char*)g.Bt + (long)cur.z * g.zB + (size_t)cur.pn * tstep;
    S.a_ready(cur);
    if constexpr (SP2) {
        PG8_STAGE(PG8_SB(0, 0), cB, voffB); PG8_STAGE(PG8_SB(0, 1), cB + hstep, voffB); PG8_STAGE(PG8_SA(0, 0), cA, voffA); PG8_STAGE(PG8_SA(0, 1), cA + hstep, voffA);
        if (wr == 1) PG8_BAR;
        PG8_WAIT_V(2); PG8_BAR;
        PG8_STAGE(PG8_SB(1, 0), cB + kstep, voffB); PG8_STAGE(PG8_SA(1, 0), cA + kstep, voffA); PG8_STAGE(PG8_SB(1, 1), cB + hstep + kstep, voffB);
        PG8_WAIT_V(6); PG8_BAR;
    } else {
        PG8_STAGE(PG8_SB(0, 0), cB, voffB); PG8_STAGE(PG8_SA(0, 0), cA, voffA); PG8_STAGE(PG8_SB(0, 1), cB + hstep, voffB); PG8_STAGE(PG8_SA(0, 1), cA + hstep, voffA);
        if (wr == 1) PG8_BAR;
        PG8_WAIT_V(4); PG8_BAR;
        PG8_STAGE(PG8_SB(1, 0), cB + kstep, voffB); PG8_STAGE(PG8_SA(1, 0), cA + kstep, voffA); PG8_STAGE(PG8_SB(1, 1), cB + hstep + kstep, voffB);
        PG8_WAIT_V(6); PG8_BAR;
    }
    for (;;) {
        const bool has_next = S.next(ui + 1, nxt);
        const char* nA = has_next ? (const char*)g.A + (long)nxt.z * g.zA + (size_t)nxt.pm * tstep : cA; const char* nB = has_next ? (const char*)g.Bt + (long)nxt.z * g.zB + (size_t)nxt.pn * tstep : cB;
        for (int t = 0; t < nt; t += 2) {
            const bool last = (t == nt - 2);
            const char* a1 = cA + (size_t)(t + 1) * kstep;
            const char* a2 = last ? nA : cA + (size_t)(t + 2) * kstep; const char* b2 = last ? nB : cB + (size_t)(t + 2) * kstep;
            const char* a3 = a2 + kstep; const char* b3 = b2 + kstep;
            if (last && has_next) S.a_ready(nxt);
            if constexpr (SP2) {
            PG8_LDB(B0, 0, 0); PG8_LDB(B1, 0, 1); PG8_SCHED; PG8_LDA(At, 0, 0); PG8_STAGE(PG8_SA(1, 1), a1 + hstep, voffA);
            PG8_WAIT_V(8); PG8_WAIT_L(0); PG8_BAR; PG8_MMA(0, 0, At, B0); PG8_MMA(0, 1, At, B1); PG8_BAR; PG8_SCHED;
            PG8_LDA(At, 0, 1); PG8_STAGE(PG8_SB(0, 0), b2, voffB); PG8_STAGE(PG8_SB(0, 1), b2 + hstep, voffB); PG8_STAGE(PG8_SA(0, 0), a2, voffA);
            PG8_WAIT_V(8); PG8_WAIT_L(0); PG8_BAR; PG8_MMA(1, 0, At, B0); PG8_MMA(1, 1, At, B1); PG8_BAR; PG8_SCHED;
            PG8_LDB(B0, 1, 0); PG8_LDB(B1, 1, 1); PG8_SCHED; PG8_LDA(At, 1, 0); PG8_STAGE(PG8_SA(0, 1), a2 + hstep, voffA);
            PG8_WAIT_V(8); PG8_WAIT_L(0); PG8_BAR; PG8_MMA(0, 0, At, B0); PG8_MMA(0, 1, At, B1); PG8_BAR; PG8_SCHED;
            PG8_LDA(At, 1, 1); PG8_STAGE(PG8_SB(1, 0), b3, voffB); PG8_STAGE(PG8_SB(1, 1), b3 + hstep, voffB); PG8_STAGE(PG8_SA(1, 0), a3, voffA);
            PG8_WAIT_V(8); PG8_WAIT_L(0); PG8_BAR; PG8_MMA(1, 0, At, B0); PG8_MMA(1, 1, At, B1); PG8_BAR; PG8_SCHED;
            } else {
            PG8_LDB(B0, 0, 0); PG8_SCHED; PG8_LDA(At, 0, 0); PG8_STAGE(PG8_SA(1, 1), a1 + hstep, voffA);
            PG8_WAIT_L(8); PG8_BAR; PG8_WAIT_L(0); PG8_MMA(0, 0, At, B0); PG8_BAR; PG8_SCHED;
            PG8_LDB(B1, 0, 1); PG8_STAGE(PG8_SB(0, 0), b2, voffB);
            PG8_BAR; PG8_WAIT_L(0); PG8_MMA(0, 1, At, B1); PG8_BAR;
            PG8_LDA(At, 0, 1); PG8_STAGE(PG8_SA(0, 0), a2, voffA);
            PG8_BAR; PG8_WAIT_L(0); PG8_MMA(1, 0, At, B0); PG8_BAR; PG8_SCHED;
            PG8_STAGE(PG8_SB(0, 1), b2 + hstep, voffB);
            PG8_WAIT_V(6); PG8_BAR; PG8_MMA(1, 1, At, B1); PG8_BAR;
            PG8_LDB(B0, 1, 0); PG8_SCHED; PG8_LDA(At, 1, 0); PG8_STAGE(PG8_SA(0, 1), a2 + hstep, voffA);
            PG8_WAIT_L(8); PG8_BAR; PG8_WAIT_L(0); PG8_MMA(0, 0, At, B0); PG8_BAR; PG8_SCHED;
            PG8_LDB(B1, 1, 1); PG8_STAGE(PG8_SB(1, 0), b3, voffB);
            PG8_BAR; PG8_WAIT_L(0); PG8_MMA(0, 1, At, B1); PG8_BAR;
            PG8_LDA(At, 1, 1); PG8_STAGE(PG8_SA(1, 0), a3, voffA);
            PG8_BAR; PG8_WAIT_L(0); PG8_MMA(1, 0, At, B0); PG8_BAR; PG8_SCHED;
            PG8_STAGE(PG8_SB(1, 1), b3 + hstep, voffB);
            PG8_WAIT_V(6); PG8_BAR; PG8_MMA(1, 1, At, B1); PG8_BAR;
            }
        }
        if constexpr (ALIGN_EPI) { if (wr == 0) PG8_BAR; }
        if constexpr (!Epi::AFTER_DRAIN) { E(acc, cur, wr, wc, fr, fq); S.done(cur); }
        if (!has_next) break;
        if constexpr (!Epi::KEEP_ACC) {
#pragma unroll
        for (int a = 0; a < 2; ++a)
#pragma unroll
            for (int b = 0; b < 2; ++b)
#pragma unroll
                for (int m = 0; m < 4; ++m)
#pragma unroll
                    for (int n = 0; n < 2; ++n) acc[a][b][m][n] = (f32x4){0.f, 0.f, 0.f, 0.f};
        }
        cur = nxt; cA = nA; cB = nB; ++ui;
        if constexpr (ALIGN_EPI) { if (wr == 1) PG8_BAR; }
    }
    PG8_WAIT_V(0);
    if constexpr (!ALIGN_EPI) { if (wr == 0) PG8_BAR; }
    PG8_BAR;
    if constexpr (Epi::AFTER_DRAIN) { E.fused(acc, cur, wr, wc, fr, fq, lds, wid, lane); S.done(cur); }
#undef PG8_SA
#undef PG8_SB
#undef PG8_STAGE
#undef PG8_LDA
#undef PG8_LDB
#undef PG8_MMA
#undef PG8_WAIT_V
#undef PG8_WAIT_L
#undef PG8_BAR
#undef PG8_SCHED
}
}

constexpr int S = 8192, DM = 2048, DIN = 17488, NPAD = 17664, NMEM = 256;
constexpr int C_QA = 0, C_KA = 1024, C_VA = 2048, C_ZA = 3072, C_QI = 4096, C_QB = 5120, C_KB = 6144, C_VB = 7168, C_ZB = 8192, C_QM = 9216, C_ZM = 10240, C_GL = 11264, C_KI = 17408, C_WI = 17472;
constexpr int TOPK = 256;
constexpr float RMS_EPS = 1e-6f;
constexpr size_t MiB = 1u << 20;
constexpr size_t WS_CTL = 0;
constexpr size_t WS_WTIN = 1 * MiB;
constexpr size_t WS_U = 1 * MiB;
constexpr size_t WS_WTMKV = 70 * MiB;
constexpr size_t WS_WTBR = 78 * MiB;
constexpr size_t WS_WTOUT = 90 * MiB;
constexpr size_t WS_MEMN = 98 * MiB;
constexpr size_t WS_MKV = 99 * MiB;
constexpr size_t WS_PROJ = 100 * MiB;
constexpr size_t WS_SC = 376 * MiB;
constexpr size_t WS_MERGED = 376 * MiB;
constexpr size_t WS_H = 376 * MiB;
constexpr size_t WS_T = 408 * MiB;
constexpr size_t WS_SEL = 508 * MiB;
constexpr size_t WS_PART = 516 * MiB;
constexpr size_t WS_END = 517 * MiB;

typedef unsigned short bf16_t;
typedef unsigned u32x4 __attribute__((ext_vector_type(4)));
typedef unsigned u32x2 __attribute__((ext_vector_type(2)));
typedef float f32x4 __attribute__((ext_vector_type(4)));
#define LAS __attribute__((address_space(3)))
__device__ __forceinline__ float bf2f(unsigned short u) { return __uint_as_float((unsigned)u << 16); }
__device__ __forceinline__ float bflo(unsigned w) { return __uint_as_float(w << 16); }
__device__ __forceinline__ float bfhi(unsigned w) { return __uint_as_float(w & 0xffff0000u); }
__device__ __forceinline__ unsigned f2bf(float f) { unsigned u = __float_as_uint(f); return (u + 0x7fffu + ((u >> 16) & 1u)) >> 16; }
__device__ __forceinline__ unsigned pk2(float lo, float hi) { return f2bf(lo) | (f2bf(hi) << 16); }
__device__ __forceinline__ float wave_sum(float v) {
#pragma unroll
    for (int o = 1; o < 64; o <<= 1) v += __shfl_xor(v, o);
    return v;
}
__device__ __forceinline__ size_t sc_off(int r) { const size_t i = (size_t)(r >> 8); return 65536ull * (i * (i + 1) / 2) + (size_t)(r & 255) * 256ull * (i + 1); }

struct Args { const float* in[17]; float* out; unsigned char* ws; int ph_lo, ph_hi; };

template <bool MAPIN>
__device__ __forceinline__ void transpose_item(const float* __restrict__ W, int K, int srcN, bf16_t* WT, LAS float* scr, int item, int ndst, int lane) {
    const int nblk = ndst / 32, kb = item / nblk, nb = item % nblk, k0 = 64 * kb, n0 = 32 * nb;
    const int n = n0 + (lane & 31);
    int src = n;
    if (MAPIN) { src = (n < 5120) ? n : (n < 17408) ? n + 80 : (n < 17488) ? n - 17408 + 5120 : -1; }
    float tv[32];
#pragma unroll
    for (int i = 0; i < 32; ++i) { const int kk = 2 * i + (lane >> 5); tv[i] = (src >= 0) ? W[(size_t)(k0 + kk) * srcN + src] : 0.f; }
#pragma unroll
    for (int i = 0; i < 32; ++i) { const int kk = 2 * i + (lane >> 5); scr[kk * 33 + (lane & 31)] = tv[i]; }
    asm volatile("s_waitcnt lgkmcnt(0)" ::: "memory");
    const int c = lane & 7;
#pragma unroll
    for (int j = 0; j < 4; ++j) { const int nn = (lane >> 3) + 8 * j; const LAS float* s = scr + (8 * c) * 33 + nn;
        u32x4 o; o.x = pk2(s[0 * 33], s[1 * 33]); o.y = pk2(s[2 * 33], s[3 * 33]); o.z = pk2(s[4 * 33], s[5 * 33]); o.w = pk2(s[6 * 33], s[7 * 33]);
        *(u32x4*)(WT + (size_t)(n0 + nn) * K + k0 + 8 * c) = o; }
    asm volatile("s_waitcnt lgkmcnt(0)" ::: "memory");
}
__device__ __forceinline__ void rms_row_to_bf16(const float* __restrict__ xrow, const float* __restrict__ g, bf16_t* orow, int lane) {
    const f32x4* xr = (const f32x4*)xrow + lane; const f32x4* gr = (const f32x4*)g + lane;
    f32x4 v[8]; float s = 0.f;
#pragma unroll
    for (int j = 0; j < 8; ++j) { v[j] = xr[64 * j]; s += (v[j].x * v[j].x + v[j].y * v[j].y) + (v[j].z * v[j].z + v[j].w * v[j].w); }
    const float rs = 1.0f / sqrtf(wave_sum(s) * (1.f / DM) + RMS_EPS);
    u32x2* o8 = (u32x2*)orow + lane;
#pragma unroll
    for (int j = 0; j < 8; ++j) { const f32x4 gg = gr[64 * j]; u32x2 w; w.x = pk2(v[j].x * rs * gg.x, v[j].y * rs * gg.y); w.y = pk2(v[j].z * rs * gg.z, v[j].w * rs * gg.w); o8[64 * j] = w; }
}
__device__ __forceinline__ void p0_prologue(const Args& a, LAS unsigned char* lds, int blk, int nblk, const int wave) {
    const int lane = lane_id_v(), tid = wave * 64 + lane;
    LAS float* scr = (LAS float*)(lds + wave * 16384);
    const int gw = blk * 8 + wave, NGW = nblk * 8;
    unsigned char* ws = a.ws;
    constexpr int I_IN = (DM / 64) * (NPAD / 32), I_MKV = (DM / 64) * (2048 / 32), I_BR = (1024 / 64) * (2048 / 32), I_OUT = (DM / 64) * (2048 / 32);
    constexpr int NITEMS = I_IN + I_MKV + 3 * I_BR + I_OUT;
    for (int it = gw; it < NITEMS; it += NGW) {
        int r = it;
        if (r < I_IN) { transpose_item<true>(a.in[3], DM, DIN, (bf16_t*)(ws + WS_WTIN), scr, r, NPAD, lane); continue; } r -= I_IN;
        if (r < I_MKV) { transpose_item<false>(a.in[11], DM, 2048, (bf16_t*)(ws + WS_WTMKV), scr, r, 2048, lane); continue; } r -= I_MKV;
        if (r < 3 * I_BR) { const int z = r / I_BR; transpose_item<false>(a.in[12 + z], 1024, 2048, (bf16_t*)(ws + WS_WTBR) + (size_t)z * 2048 * 1024, scr, r % I_BR, 2048, lane); continue; } r -= 3 * I_BR;
        transpose_item<false>(a.in[15], DM, 2048, (bf16_t*)(ws + WS_WTOUT), scr, r, 2048, lane);
    }
    bf16_t* H = (bf16_t*)(ws + WS_H);
    for (int m = gw; m < S + NMEM; m += NGW) {
        if (m < S) rms_row_to_bf16(a.in[0] + (size_t)m * DM, a.in[2], H + (size_t)m * DM, lane);
        else rms_row_to_bf16(a.in[1] + (size_t)(m - S) * DM, a.in[10], (bf16_t*)(ws + WS_MEMN) + (size_t)(m - S) * DM, lane);
    }
    if (blk == 0) { for (int i = tid; i < 640; i += 512) ((unsigned*)(ws + WS_CTL + 1024))[i] = 0u; }
    if (blk == 0 && wave == 0) {
        const float s1 = wave_sum(a.in[5][lane] * a.in[6][lane]), s2 = wave_sum(a.in[7][lane] * a.in[8][lane]);
        if (lane == 0) ((float*)(ws + WS_CTL))[0] = expf(s1) - expf(s2) + 0.2f;
    }
}

__device__ __forceinline__ void idx_scores_naive(const bf16_t* __restrict__ PROJ, float* SC, LAS unsigned char* lds, int blk, int nblk, const int wave) {
    const int lane = lane_id_v(), tid = wave * 64 + lane;
    LAS float* qs = (LAS float*)lds + wave * 1088;
    constexpr int NITEM = 128 * 129 / 2;
    for (int it = blk; it < NITEM; it += nblk) {
        int kb = 0, rem = it; while (rem >= 128 - kb) { rem -= 128 - kb; ++kb; }
        const int qc = kb + rem, s = 64 * kb + lane;
        float kreg[64];
        { const u32x4* kp = (const u32x4*)(PROJ + (size_t)s * NPAD + C_KI);
#pragma unroll
          for (int i = 0; i < 8; ++i) { const u32x4 w = kp[i]; kreg[8 * i + 0] = bflo(w.x); kreg[8 * i + 1] = bfhi(w.x); kreg[8 * i + 2] = bflo(w.y); kreg[8 * i + 3] = bfhi(w.y);
              kreg[8 * i + 4] = bflo(w.z); kreg[8 * i + 5] = bfhi(w.z); kreg[8 * i + 6] = bflo(w.w); kreg[8 * i + 7] = bfhi(w.w); } }
        for (int qq = 0; qq < 8; ++qq) {
            const int q = 64 * qc + wave * 8 + qq;
            { const u32x4* qp = (const u32x4*)(PROJ + (size_t)q * NPAD + C_QI) + 2 * lane;
              const u32x4 w0 = qp[0], w1 = qp[1];
              LAS f32x4* dst = (LAS f32x4*)(qs + 16 * lane);
              dst[0] = (f32x4){bflo(w0.x), bfhi(w0.x), bflo(w0.y), bfhi(w0.y)}; dst[1] = (f32x4){bflo(w0.z), bfhi(w0.z), bflo(w0.w), bfhi(w0.w)};
              dst[2] = (f32x4){bflo(w1.x), bfhi(w1.x), bflo(w1.y), bfhi(w1.y)}; dst[3] = (f32x4){bflo(w1.z), bfhi(w1.z), bflo(w1.w), bfhi(w1.w)};
              if (lane < 16) qs[1024 + lane] = bf2f(PROJ[(size_t)q * NPAD + C_WI + lane]) * 0.25f; }
            asm volatile("s_waitcnt lgkmcnt(0)" ::: "memory"); __builtin_amdgcn_wave_barrier();
            float score = 0.f;
            for (int j = 0; j < 16; ++j) {
                float acc = 0.f; const LAS f32x4* qj = (const LAS f32x4*)(qs + 64 * j);
#pragma unroll
                for (int d = 0; d < 16; ++d) { const f32x4 qv = qj[d]; acc += qv.x * kreg[4 * d] + qv.y * kreg[4 * d + 1] + qv.z * kreg[4 * d + 2] + qv.w * kreg[4 * d + 3]; }
                score += fmaxf(acc * 0.125f, 0.f) * qs[1024 + j];
            }
            if (s <= q) SC[sc_off(q) + s] = score;
            asm volatile("s_waitcnt lgkmcnt(0)" ::: "memory"); __builtin_amdgcn_wave_barrier();
        }
    }
}
__device__ __forceinline__ unsigned ordkey(float f) { const unsigned u = __float_as_uint(f); return (u & 0x80000000u) ? ~u : (u | 0x80000000u); }
template <int NR, int NL> __device__ __forceinline__ bool topk_row(const float* __restrict__ row, int n, int lane, LAS u32x4* xl, unsigned long long& w0, unsigned long long& w1, unsigned& Tout, int& need_out) {
#pragma unroll
    for (int q = 0; q < NL / 4; ++q) { u32x4 v;
#pragma unroll
        for (int e = 0; e < 4; ++e) { const int i = 4096 + (4 * q + e) * 64 + lane; v[e] = (ordkey(*(const float*)((const char*)row + 4u * (unsigned)min(i, n - 1))) >> 1) & (unsigned)((i - n) >> 31); }
        xl[q * 64 + lane] = v;
        if ((q & 3) == 3) __builtin_amdgcn_sched_barrier(0); }
    unsigned u[NR];
#pragma unroll
    for (int k = 0; k < NR; ++k) { const int i = k * 64 + lane; u[k] = (ordkey(*(const float*)((const char*)row + 4u * (unsigned)min(i, n - 1))) >> 1) & (unsigned)((i - n) >> 31);
        if ((k & 15) == 15) __builtin_amdgcn_sched_barrier(0); }
    unsigned T = 0u; bool cut = false;
    for (int bit = 30; bit >= 0; --bit) {
        const unsigned cand = T | (1u << bit); unsigned lt = 0u;
        asm volatile("" ::: "memory");
#pragma unroll
        for (int k = 0; k < NR; ++k) lt += (u[k] - cand) >> 31;
#pragma unroll
        for (int q = 0; q < NL / 4; ++q) { const u32x4 v = xl[q * 64 + lane]; lt += ((v[0] - cand) >> 31) + ((v[1] - cand) >> 31) + ((v[2] - cand) >> 31) + ((v[3] - cand) >> 31);
            if ((q & 3) == 3) __builtin_amdgcn_sched_barrier(0); }
#pragma unroll
        for (int o = 1; o < 64; o <<= 1) lt += __shfl_xor(lt, o);
        const int ge = (int)((NR + NL) * 64 - lt);
        if (ge >= TOPK) T = cand;
        if (ge == TOPK) { cut = true; break; }
    }
    unsigned c_hi = 0u, c_lt = 0u;
#pragma unroll
    for (int k = 0; k < NR; ++k) { c_hi += (T - u[k]) >> 31; c_lt += (u[k] - T) >> 31; }
#pragma unroll
    for (int q = 0; q < NL / 4; ++q) { const u32x4 v = xl[q * 64 + lane];
#pragma unroll
        for (int e = 0; e < 4; ++e) { c_hi += (T - v[e]) >> 31; c_lt += (v[e] - T) >> 31; } }
#pragma unroll
    for (int o = 1; o < 64; o <<= 1) { c_hi += __shfl_xor(c_hi, o); c_lt += __shfl_xor(c_lt, o); }
    const int need = TOPK - (int)c_hi, c_eq = (NR + NL) * 64 - (int)c_lt - (int)c_hi;
    Tout = T; need_out = need;
    if (!cut && c_eq != need) return false;
    int ln; asm volatile("v_mbcnt_lo_u32_b32 %0, -1, 0\n\tv_mbcnt_hi_u32_b32 %0, -1, %0" : "=v"(ln));
#pragma unroll
    for (int k = 0; k < NR; ++k) {
        const unsigned long long bs = __ballot(u[k] >= T);
        if (k == ln) w0 = bs;
        __builtin_amdgcn_sched_barrier(0); }
#pragma unroll
    for (int q = 0; q < NL / 4; ++q) { const u32x4 v = xl[q * 64 + lane];
#pragma unroll
        for (int e = 0; e < 4; ++e) { const unsigned long long bs = __ballot(v[e] >= T);
            if (4 * q + e == ln) w1 = bs;
            __builtin_amdgcn_sched_barrier(0); } }
    return true;
}
__device__ __forceinline__ void topk_select(const float* SC, int* SEL, LAS unsigned char* lds, int blk, int nblk, const int wave) {
    const int lane = lane_id_v();
    LAS u32x4* xl = (LAS u32x4*)(lds + wave * 16384);
    for (int r = blk * 8 + wave; r < S; r += nblk * 8) {
        const int n = r + 1; unsigned long long* mrow = (unsigned long long*)SEL + (size_t)r * 128;
        unsigned long long w0 = 0ull, w1 = 0ull;
        const int nwords = 4 * ((r >> 8) + 1);
        if (n <= TOPK) { const int lo = 64 * lane; w0 = (r < lo) ? 0ull : ((r - lo >= 63) ? ~0ull : ((2ull << (r - lo)) - 1ull)); }
        else { const float* row = SC + sc_off(r);
            unsigned T; int need; bool ok;
            if (n <= 2048) ok = topk_row<32, 0>(row, n, lane, xl, w0, w1, T, need); else if (n <= 4096) ok = topk_row<64, 0>(row, n, lane, xl, w0, w1, T, need); else ok = topk_row<64, 64>(row, n, lane, xl, w0, w1, T, need);
            if (!ok) { int eqc = 0; const unsigned long long lt = (lane == 0) ? 0ull : (~0ull >> (64 - lane));
                for (int base = 0, it = 0; base < n; base += 64, ++it) {
                    const int i = base + lane; const unsigned v = (i < n) ? (ordkey(row[i]) >> 1) : 0u;
                    const bool gt = v > T, eq = (i < n) && (v == T);
                    const unsigned long long be = __ballot(eq);
                    const bool take = gt || (eq && (eqc + __builtin_popcountll(be & lt) < need));
                    const unsigned long long bs = __ballot(take);
                    if ((it & 63) == lane) { if (it < 64) w0 = bs; else w1 = bs; }
                    eqc += __builtin_popcountll(be); } } }
        if (lane < nwords) mrow[lane] = w0;
        if (64 + lane < nwords) mrow[64 + lane] = w1;
    }
}
template <int DQ, int DV, bool GATHER>
__device__ __forceinline__ void naive_attn(const bf16_t* __restrict__ qp, const bf16_t* __restrict__ kb, const bf16_t* __restrict__ vb, size_t kvpitch,
                                           int nkeys, int nmax, const int* __restrict__ sel, int r, float scale, float slope, float (&o)[DV / 8]) {
    constexpr int QN = DQ / 8, VN = DV / 8;
    float q[QN];
#pragma unroll
    for (int i = 0; i < QN / 2; ++i) { const unsigned w = ((const unsigned*)qp)[i]; q[2 * i] = bflo(w) * scale; q[2 * i + 1] = bfhi(w) * scale; }
#pragma unroll
    for (int i = 0; i < VN; ++i) o[i] = 0.f;
    float m = -1e30f, l = 0.f;
    for (int i = 0; i < nmax; ++i) {
        bool valid = i < nkeys; int key = i;
        if (GATHER) { key = sel[valid ? i : 0]; valid = valid && key >= 0; }
        if (!valid) key = 0;
        const unsigned* kp = (const unsigned*)(kb + (size_t)key * kvpitch);
        float d = 0.f;
#pragma unroll
        for (int j = 0; j < QN / 2; ++j) { const unsigned w = kp[j]; d += q[2 * j] * bflo(w) + q[2 * j + 1] * bfhi(w); }
        d += __shfl_xor(d, 1); d += __shfl_xor(d, 2); d += __shfl_xor(d, 4);
        const float logit = d - slope * (float)(r - key);
        if (valid) {
            if (logit > m) { const float c = __expf(m - logit); l *= c;
#pragma unroll
                for (int j = 0; j < VN; ++j) o[j] *= c;
                m = logit; }
            const float p = __expf(logit - m); l += p;
            const unsigned* vp = (const unsigned*)(vb + (size_t)key * kvpitch);
#pragma unroll
            for (int j = 0; j < VN / 2; ++j) { const unsigned w = vp[j]; o[2 * j] += p * bflo(w); o[2 * j + 1] += p * bfhi(w); }
        }
    }
    const float il = 1.0f / l;
#pragma unroll
    for (int j = 0; j < VN; ++j) o[j] *= il;
}
__device__ __forceinline__ void attn_b_naive(const Args& a, int blk, int nblk, const int wave) {
    const int lane = lane_id_v(), tid = wave * 64 + lane, sub = lane & 7;
    const bf16_t* PROJ = (const bf16_t*)(a.ws + WS_PROJ); bf16_t* UB = (bf16_t*)(a.ws + WS_U) + (size_t)1 * S * 1024;
    const float lam = ((const float*)(a.ws + WS_CTL))[0];
    for (int wi = blk * 8 + wave; wi < 1024 * 8; wi += nblk * 8) {
        const int h = wi & 7, rg = wi >> 3, r = rg * 8 + (lane >> 3), nmax = rg * 8 + 8;
        const float slope = exp2f(-(float)(h + 1));
        float o0[16], o1[16];
        const bf16_t* rowp = PROJ + (size_t)r * NPAD;
        naive_attn<64, 128, false>(rowp + C_QB + h * 128 + sub * 8, PROJ + C_KB + h * 128 + sub * 8, PROJ + C_VB + h * 128 + sub * 16, NPAD, r + 1, nmax, nullptr, r, 0.125f, slope, o0);
        naive_attn<64, 128, false>(rowp + C_QB + h * 128 + 64 + sub * 8, PROJ + C_KB + h * 128 + 64 + sub * 8, PROJ + C_VB + h * 128 + sub * 16, NPAD, r + 1, nmax, nullptr, r, 0.125f, slope, o1);
        float ss = 0.f;
#pragma unroll
        for (int j = 0; j < 16; ++j) { o0[j] -= lam * o1[j]; ss += o0[j] * o0[j]; }
        ss += __shfl_xor(ss, 1); ss += __shfl_xor(ss, 2); ss += __shfl_xor(ss, 4);
        const float rs = 1.0f / sqrtf(ss * (1.f / 128.f) + RMS_EPS) * 0.8f;
        const float* g = a.in[9] + sub * 16; const bf16_t* zp = rowp + C_ZB + h * 128 + sub * 16;
        unsigned w[8];
#pragma unroll
        for (int j = 0; j < 8; ++j) w[j] = pk2(o0[2 * j] * rs * g[2 * j] * bf2f(zp[2 * j]), o0[2 * j + 1] * rs * g[2 * j + 1] * bf2f(zp[2 * j + 1]));
        u32x4* dst = (u32x4*)(UB + (size_t)r * 1024 + h * 128 + sub * 16);
        dst[0] = (u32x4){w[0], w[1], w[2], w[3]}; dst[1] = (u32x4){w[4], w[5], w[6], w[7]};
    }
}
__device__ __forceinline__ void attn_m_naive(const Args& a, int blk, int nblk, const int wave) {
    const int lane = lane_id_v(), tid = wave * 64 + lane, sub = lane & 7;
    const bf16_t* PROJ = (const bf16_t*)(a.ws + WS_PROJ); const bf16_t* MKV = (const bf16_t*)(a.ws + WS_MKV); bf16_t* UM = (bf16_t*)(a.ws + WS_U) + (size_t)2 * S * 1024;
    for (int wi = blk * 8 + wave; wi < 1024 * 4; wi += nblk * 8) {
        const int h = wi & 3, rg = wi >> 2, r = rg * 8 + (lane >> 3);
        float o[32];
        const bf16_t* rowp = PROJ + (size_t)r * NPAD;
        naive_attn<256, 256, false>(rowp + C_QM + h * 256 + sub * 32, MKV + h * 256 + sub * 32, MKV + 1024 + h * 256 + sub * 32, 2048, NMEM, NMEM, nullptr, 0, 0.0625f, 0.f, o);
        const bf16_t* zp = rowp + C_ZM + h * 256 + sub * 32;
        u32x4* dst = (u32x4*)(UM + (size_t)r * 1024 + h * 256 + sub * 32);
#pragma unroll
        for (int j = 0; j < 4; ++j) { u32x4 w;
            w.x = pk2(o[8 * j + 0] * bf2f(zp[8 * j + 0]), o[8 * j + 1] * bf2f(zp[8 * j + 1])); w.y = pk2(o[8 * j + 2] * bf2f(zp[8 * j + 2]), o[8 * j + 3] * bf2f(zp[8 * j + 3]));
            w.z = pk2(o[8 * j + 4] * bf2f(zp[8 * j + 4]), o[8 * j + 5] * bf2f(zp[8 * j + 5])); w.w = pk2(o[8 * j + 6] * bf2f(zp[8 * j + 6]), o[8 * j + 7] * bf2f(zp[8 * j + 7]));
            dst[j] = w; }
    }
}
__device__ __forceinline__ void attn_a_naive(const Args& a, int blk, int nblk, const int wave) {
    const int lane = lane_id_v(), tid = wave * 64 + lane, sub = lane & 7;
    const bf16_t* PROJ = (const bf16_t*)(a.ws + WS_PROJ); const int* SEL = (const int*)(a.ws + WS_SEL); bf16_t* UA = (bf16_t*)(a.ws + WS_U);
    for (int wi = blk * 8 + wave; wi < 1024 * 8; wi += nblk * 8) {
        const int h = wi & 7, rg = wi >> 3, r = rg * 8 + (lane >> 3);
        const float slope = exp2f(-(float)(h + 1));
        float o[16];
        const bf16_t* rowp = PROJ + (size_t)r * NPAD;
        naive_attn<128, 128, true>(rowp + C_QA + h * 128 + sub * 16, PROJ + C_KA + h * 128 + sub * 16, PROJ + C_VA + h * 128 + sub * 16, NPAD, TOPK, TOPK, SEL + (size_t)r * TOPK, r, 0.08838834764831845f, slope, o);
        const bf16_t* zp = rowp + C_ZA + h * 128 + sub * 16;
        unsigned w[8];
#pragma unroll
        for (int j = 0; j < 8; ++j) w[j] = pk2(o[2 * j] * bf2f(zp[2 * j]), o[2 * j + 1] * bf2f(zp[2 * j + 1]));
        u32x4* dst = (u32x4*)(UA + (size_t)r * 1024 + h * 128 + sub * 16);
        dst[0] = (u32x4){w[0], w[1], w[2], w[3]}; dst[1] = (u32x4){w[4], w[5], w[6], w[7]};
    }
}
__device__ __forceinline__ void final_norm(const Args& a, int blk, int nblk, const int wave) {
    const int lane = lane_id_v(), tid = wave * 64 + lane;
    const float* part = (const float*)(a.ws + WS_PART); const f32x4* g = (const f32x4*)a.in[16] + lane;
    for (int r = blk * 8 + wave; r < S; r += nblk * 8) {
        float s = (lane < 32) ? part[(size_t)lane * S + r] : 0.f;
        const float rs = 1.0f / sqrtf(wave_sum(s) * (1.f / DM) + RMS_EPS);
        f32x4* y = (f32x4*)(a.out + (size_t)r * DM) + lane;
#pragma unroll
        for (int j = 0; j < 8; ++j) { f32x4 v = y[64 * j]; const f32x4 gg = g[64 * j]; v = v * rs * gg; y[64 * j] = v; }
    }
}


namespace att {
typedef short bf16x8 __attribute__((ext_vector_type(8)));
typedef short s16x4 __attribute__((ext_vector_type(4)));
typedef float f32x16 __attribute__((ext_vector_type(16)));
typedef float f32x2_t __attribute__((ext_vector_type(2)));
typedef __bf16 bf16x2_t __attribute__((ext_vector_type(2)));
constexpr int SHM_V = 16384, SHM_K = 16384;
constexpr float LOG2E = 1.4426950408889634f;
constexpr float THR2 = 8.f * LOG2E;
#define KSWZ(row, colB) ((row) * 256 + ((colB) ^ (((row) & 7) << 4)))
#define SBAR() __builtin_amdgcn_sched_barrier(0)
__device__ __forceinline__ int crow(int r, int hi) { return (r & 3) + 8 * (r >> 2) + 4 * hi; }
__device__ __forceinline__ unsigned cvtpk(float lo, float hi) { f32x2_t v = {lo, hi}; bf16x2_t b = __builtin_convertvector(v, bf16x2_t); return __builtin_bit_cast(unsigned, b); }
__device__ __forceinline__ int v_st(int k, int c) { const int kk = (k & ~0xC) | ((k & 4) << 1) | ((k & 8) >> 1); return ((kk >> 3) * 4 + (c >> 5)) * 512 + ((kk & 7) * 32 + (c & 31)) * 2; }
__device__ __forceinline__ int v_rd_base(int lane) { return ((lane & 3) << 3) | (((lane >> 2) & 3) << 6) | (((lane >> 4) & 1) << 5) | (((lane >> 5) & 1) << 8); }
constexpr int v_rd_off(int d0, int ks, int half) { return d0 * 512 + ks * 4096 + half * 2048; }
typedef short v4i16_t __attribute__((ext_vector_type(4)));
__device__ __forceinline__ s16x4 tr_read(LAS const unsigned char* p) { return __builtin_bit_cast(s16x4, __builtin_amdgcn_ds_read_tr16_b64_v4i16((LAS v4i16_t*)p)); }

template <int NQ> __device__ __forceinline__ void qkt(f32x16& p0, f32x16& p1, LAS const unsigned char* Ks, const bf16x8* qr, int cbyte0, int r32, int hi) {
  p0 = f32x16{}; p1 = f32x16{};
#pragma unroll
  for (int d0 = 0; d0 < NQ; ++d0) { const int cb = cbyte0 + (d0 * 16 + hi * 8) * 2;
    const bf16x8 b0 = *(LAS const bf16x8*)(Ks + KSWZ(r32, cb));
    const bf16x8 b1 = *(LAS const bf16x8*)(Ks + KSWZ(32 + r32, cb));
    p0 = __builtin_amdgcn_mfma_f32_32x32x16_bf16(b0, qr[d0], p0, 0, 0, 0);
    p1 = __builtin_amdgcn_mfma_f32_32x32x16_bf16(b1, qr[d0], p1, 0, 0, 0); }
}
template <int NQ> __device__ __forceinline__ void qkt_l(f32x16& p0, f32x16& p1, LAS const unsigned char* Ks, LAS const unsigned char* Qs, int cbyte0, int r32, int hi) {
  p0 = f32x16{}; p1 = f32x16{};
  asm volatile("" : "+v"(Qs));
#pragma unroll
  for (int d0 = 0; d0 < NQ; ++d0) { const int cb = cbyte0 + (d0 * 16 + hi * 8) * 2;
    const bf16x8 q = *(LAS const bf16x8*)(Qs + d0 * 1024);
    const bf16x8 b0 = *(LAS const bf16x8*)(Ks + KSWZ(r32, cb));
    const bf16x8 b1 = *(LAS const bf16x8*)(Ks + KSWZ(32 + r32, cb));
    p0 = __builtin_amdgcn_mfma_f32_32x32x16_bf16(b0, q, p0, 0, 0, 0);
    p1 = __builtin_amdgcn_mfma_f32_32x32x16_bf16(b1, q, p1, 0, 0, 0); }
}
template <int D0> __device__ __forceinline__ void pv_one(f32x16& od, LAS const unsigned char* vb, bf16x8 pa0, bf16x8 pa1, bf16x8 pa2, bf16x8 pa3) {
  const s16x4 l0 = tr_read(vb + v_rd_off(D0, 0, 0)), h0 = tr_read(vb + v_rd_off(D0, 0, 1)), l1 = tr_read(vb + v_rd_off(D0, 1, 0)), h1 = tr_read(vb + v_rd_off(D0, 1, 1));
  const s16x4 l2 = tr_read(vb + v_rd_off(D0, 2, 0)), h2 = tr_read(vb + v_rd_off(D0, 2, 1)), l3 = tr_read(vb + v_rd_off(D0, 3, 0)), h3 = tr_read(vb + v_rd_off(D0, 3, 1));
#define PK(L, H) (bf16x8){L[0], L[1], L[2], L[3], H[0], H[1], H[2], H[3]}
  od = __builtin_amdgcn_mfma_f32_32x32x16_bf16(pa0, PK(l0, h0), od, 0, 0, 0);
  od = __builtin_amdgcn_mfma_f32_32x32x16_bf16(pa1, PK(l1, h1), od, 0, 0, 0);
  od = __builtin_amdgcn_mfma_f32_32x32x16_bf16(pa2, PK(l2, h2), od, 0, 0, 0);
  od = __builtin_amdgcn_mfma_f32_32x32x16_bf16(pa3, PK(l3, h3), od, 0, 0, 0);
#undef PK
}
__device__ __forceinline__ void pv_d0(f32x16* o, LAS const unsigned char* vb, bf16x8 pa0, bf16x8 pa1, bf16x8 pa2, bf16x8 pa3) {
  pv_one<0>(o[0], vb, pa0, pa1, pa2, pa3); pv_one<1>(o[1], vb, pa0, pa1, pa2, pa3); pv_one<2>(o[2], vb, pa0, pa1, pa2, pa3); pv_one<3>(o[3], vb, pa0, pa1, pa2, pa3);
}
template <bool CAUSAL> __device__ __forceinline__ void partialSM(f32x16& p0, f32x16& p1, float& m_reg, float& alpha, const float (&cs)[16], float base, int lim, float C, float slope2, int delta) {
  const float tb0 = slope2 * (float)delta + base, tb1 = slope2 * (float)(delta + 32) + base;
#pragma unroll
  for (int r = 0; r < 16; ++r) { p0[r] = fmaf(p0[r], C, cs[r]); p1[r] = fmaf(p1[r], C, cs[r]); }
  if (CAUSAL && delta + 63 > 0) {
    const int l0 = lim - delta, l1 = l0 - 32;
#pragma unroll
    for (int r = 0; r < 16; ++r) { const int K = (r & 3) + 8 * (r >> 2); if (K > l0) p0[r] = -INFINITY; if (K > l1) p1[r] = -INFINITY; }
  }
  float pm0 = p0[0], pm1 = p1[0];
#pragma unroll
  for (int r = 1; r < 16; ++r) { pm0 = fmaxf(pm0, p0[r]); pm1 = fmaxf(pm1, p1[r]); }
  float pmax = fmaxf(pm0 + tb0, pm1 + tb1);
  { auto rr = __builtin_amdgcn_permlane32_swap(__float_as_uint(pmax), __float_as_uint(pmax), false, false);
    pmax = fmaxf(__uint_as_float(rr[0]), __uint_as_float(rr[1])); }
  float mn;
  if (__builtin_expect(__all(pmax - m_reg <= THR2), 1)) { mn = m_reg; alpha = 1.f; }
  else { mn = fmaxf(m_reg, pmax); alpha = __builtin_amdgcn_exp2f(m_reg - mn); m_reg = mn; }
  const float a0 = tb0 - mn, a1 = tb1 - mn;
#pragma unroll
  for (int r = 0; r < 16; ++r) { p0[r] += a0; p1[r] += a1; }
#pragma unroll
  for (int r = 0; r < 16; ++r) p0[r] = __builtin_amdgcn_exp2f(p0[r]);
}
__device__ __forceinline__ void finishSM(f32x16& p0, f32x16& p1, float alpha, float& l_reg, bf16x8& pa0, bf16x8& pa1, bf16x8& pa2, bf16x8& pa3) {
#pragma unroll
  for (int r = 0; r < 16; ++r) p1[r] = __builtin_amdgcn_exp2f(p1[r]);
  float ps = 0;
#pragma unroll
  for (int r = 0; r < 16; ++r) ps += p0[r];
#pragma unroll
  for (int r = 0; r < 16; ++r) ps += p1[r];
  { auto rr = __builtin_amdgcn_permlane32_swap(__float_as_uint(ps), __float_as_uint(ps), false, false);
    ps = __uint_as_float(rr[0]) + __uint_as_float(rr[1]); }
  l_reg = l_reg * alpha + ps;
#define PK4(P, BASE, OUT) do { unsigned a0 = cvtpk(P[BASE + 0], P[BASE + 1]), a1 = cvtpk(P[BASE + 2], P[BASE + 3]);   \
    unsigned b0 = cvtpk(P[BASE + 4], P[BASE + 5]), b1 = cvtpk(P[BASE + 6], P[BASE + 7]);                              \
    auto r0 = __builtin_amdgcn_permlane32_swap(a0, b0, false, false); auto r1 = __builtin_amdgcn_permlane32_swap(a1, b1, false, false); \
    u32x4 w = {r0[0], r1[0], r0[1], r1[1]}; OUT = __builtin_bit_cast(bf16x8, w); } while (0)
  PK4(p0, 0, pa0); PK4(p0, 8, pa1); PK4(p1, 0, pa2); PK4(p1, 8, pa3);
#undef PK4
}

__device__ __forceinline__ void attn_b_unit(const bf16_t* __restrict__ PROJ, bf16_t* UB, const float* __restrict__ gsub, float lam, int h, int qb, int jmin, LAS unsigned char* lds, const int wid) {
  const int lane = lane_id_v(), tid = wid * 64 + lane, r32 = lane & 31, hi = lane >> 5, comp = wid >> 2, wq = wid & 3;
  const int R0 = qb * 128, qrow0 = R0 + wq * 32, NT = 2 * qb + 2, NTe = NT - jmin;
  LAS unsigned char* V_lds = lds; LAS unsigned char* K_lds = lds + 2 * SHM_V;
  LAS float* ws = (LAS float*)(lds + 2 * SHM_V + 2 * SHM_K) + wid * 64; LAS float* li_l = ws; LAS float* al_l = ws + 32;
  LAS float* xch = (LAS float*)(lds + 2 * SHM_V + 2 * SHM_K + 2048);
  const float slope2 = __builtin_amdgcn_exp2f(-(float)(h + 1)) * LOG2E, C = 0.125f * LOG2E;
  float cs[16];
#pragma unroll
  for (int r = 0; r < 16; ++r) cs[r] = __uint_as_float(__builtin_amdgcn_readfirstlane(__float_as_uint(slope2 * (float)((r & 3) + 8 * (r >> 2)))));
  const float base = slope2 * (float)(4 * hi - r32); const int lim = r32 - 4 * hi;
  float m_reg = -1e30f, l_reg = 0; f32x16 o[4] = {};
  LAS unsigned char* Qs = lds + 2 * SHM_V + 2 * SHM_K + 2048 + wid * 4096 + lane * 16;
  { const bf16_t* Qw = PROJ + (size_t)(qrow0 + r32) * NPAD + C_QB + h * 128 + comp * 64 + hi * 8;
#pragma unroll
    for (int d0 = 0; d0 < 4; ++d0) *(LAS bf16x8*)(Qs + d0 * 1024) = *(const bf16x8*)(Qw + d0 * 16); }
  const unsigned offK = (unsigned)((tid >> 4) * NPAD + C_KB + h * 128 + (tid & 15) * 8) * 2u, offV = offK + (unsigned)(C_VB - C_KB) * 2u;
  const int sr = tid >> 4, sc = (tid & 15) * 8, vst0 = v_st(sr, sc), vst1 = v_st(32 + sr, sc), cq = comp * 128;
  LAS const unsigned char* vb0 = V_lds + v_rd_base(lane);
  struct { bf16x8 vs0, vs1, ks0, ks1; } sr_[2];
#define KEY0(t) (64 * (NT - 1 - (t)))
#define GLD16(off) (*(const bf16x8*)((const char*)PROJ + (unsigned)(off)))
#define SLOAD(i, k0) do { const unsigned kb_ = (unsigned)(k0) * (unsigned)(NPAD * 2); sr_[i].vs0 = GLD16(offV + kb_); sr_[i].vs1 = GLD16(offV + kb_ + 32u * NPAD * 2u); \
    sr_[i].ks0 = GLD16(offK + kb_); sr_[i].ks1 = GLD16(offK + kb_ + 32u * NPAD * 2u); } while (0)
#define SWRITE(b) do { *(LAS bf16x8*)(V_lds + (b) * SHM_V + vst0) = sr_[b].vs0; *(LAS bf16x8*)(V_lds + (b) * SHM_V + vst1) = sr_[b].vs1; const int kc = sc * 2; \
    *(LAS bf16x8*)(K_lds + (b) * SHM_K + KSWZ(sr, kc)) = sr_[b].ks0; *(LAS bf16x8*)(K_lds + (b) * SHM_K + KSWZ(32 + sr, kc)) = sr_[b].ks1; } while (0)
#define RESC(a) do { if (__any((a) < 1.f)) { if (hi == 0) al_l[r32] = (a); asm volatile("s_waitcnt lgkmcnt(0)" ::: "memory"); \
    _Pragma("unroll") for (int d = 0; d < 4; ++d) _Pragma("unroll") for (int r = 0; r < 16; ++r) o[d][r] *= al_l[crow(r, hi)]; } } while (0)
  f32x16 pA0, pA1, pB0, pB1; float alA, alB; bf16x8 pa0, pa1, pa2, pa3;
  SLOAD(0, KEY0(0)); SWRITE(0); __syncthreads();
  qkt_l<4>(pA0, pA1, K_lds, Qs, cq, r32, hi); partialSM<true>(pA0, pA1, m_reg, alA, cs, base, lim, C, slope2, KEY0(0) - qrow0);
  SLOAD(1, KEY0(1)); if (2 < NTe) SLOAD(0, KEY0(2));
  SWRITE(1); __syncthreads();
  for (int j = 1; j + 1 < NTe; j += 2) {
    SBAR(); qkt_l<4>(pB0, pB1, K_lds + SHM_K, Qs, cq, r32, hi);
    finishSM(pA0, pA1, alA, l_reg, pa0, pa1, pa2, pa3); SBAR();
    SLOAD(1, KEY0(j + 2)); SBAR();
    pv_d0(o, vb0, pa0, pa1, pa2, pa3); partialSM<true>(pB0, pB1, m_reg, alB, cs, base, lim, C, slope2, KEY0(j) - qrow0);
    __syncthreads(); SWRITE(0);
    RESC(alB); __syncthreads();
    SBAR(); qkt_l<4>(pA0, pA1, K_lds, Qs, cq, r32, hi);
    finishSM(pB0, pB1, alB, l_reg, pa0, pa1, pa2, pa3); SBAR();
    SLOAD(0, KEY0(min(j + 3, NTe - 1))); SBAR();
    pv_d0(o, vb0 + SHM_V, pa0, pa1, pa2, pa3); partialSM<true>(pA0, pA1, m_reg, alA, cs, base, lim, C, slope2, KEY0(j + 1) - qrow0);
    __syncthreads(); SWRITE(1);
    RESC(alA); __syncthreads();
  }
  SBAR(); qkt_l<4>(pB0, pB1, K_lds + SHM_K, Qs, cq, r32, hi);
  finishSM(pA0, pA1, alA, l_reg, pa0, pa1, pa2, pa3); SBAR();
  pv_d0(o, vb0, pa0, pa1, pa2, pa3); partialSM<true>(pB0, pB1, m_reg, alB, cs, base, lim, C, slope2, KEY0(NTe - 1) - qrow0);
  __syncthreads(); RESC(alB);
  finishSM(pB0, pB1, alB, l_reg, pa0, pa1, pa2, pa3); SBAR();
  pv_d0(o, vb0 + SHM_V, pa0, pa1, pa2, pa3);
#undef KEY0
#undef SLOAD
#undef GLD16
#undef SWRITE
#undef RESC
  if (hi == 0) li_l[r32] = l_reg; asm volatile("s_waitcnt lgkmcnt(0)" ::: "memory");
  float rli[16];
#pragma unroll
  for (int r = 0; r < 16; ++r) rli[r] = __builtin_amdgcn_rcpf(li_l[crow(r, hi)]);
  __syncthreads();
  if (comp == 1) {
#pragma unroll
    for (int d0 = 0; d0 < 4; ++d0)
#pragma unroll
      for (int r = 0; r < 16; ++r) xch[(wq * 64 + d0 * 16 + r) * 64 + lane] = o[d0][r] * rli[r] * lam;
  }
  __syncthreads();
  if (comp == 0) {
    float ss[16];
#pragma unroll
    for (int r = 0; r < 16; ++r) ss[r] = 0.f;
#pragma unroll
    for (int d0 = 0; d0 < 4; ++d0)
#pragma unroll
      for (int r = 0; r < 16; ++r) { const float d = o[d0][r] * rli[r] - xch[(wq * 64 + d0 * 16 + r) * 64 + lane]; o[d0][r] = d; ss[r] += d * d; }
#pragma unroll
    for (int r = 0; r < 16; ++r) { float s = ss[r]; s += __shfl_xor(s, 1); s += __shfl_xor(s, 2); s += __shfl_xor(s, 4); s += __shfl_xor(s, 8); s += __shfl_xor(s, 16);
      ss[r] = 0.8f / sqrtf(s * (1.f / 128.f) + RMS_EPS); }
    bf16_t zv[4][16];
#pragma unroll
    for (int d0 = 0; d0 < 4; ++d0)
#pragma unroll
      for (int r = 0; r < 16; ++r) zv[d0][r] = PROJ[(size_t)(qrow0 + crow(r, hi)) * NPAD + C_ZB + h * 128 + d0 * 32 + r32];
#pragma unroll
    for (int d0 = 0; d0 < 4; ++d0) { const int col = d0 * 32 + r32; const float g = gsub[col];
#pragma unroll
      for (int r = 0; r < 16; ++r) { const size_t row = (size_t)(qrow0 + crow(r, hi));
        UB[row * 1024 + h * 128 + col] = (bf16_t)f2bf(o[d0][r] * ss[r] * g * bf2f(zv[d0][r])); } }
  }
  __syncthreads();
}
template <bool DUMMY> __device__ __forceinline__ void partialSM_A(f32x16& p0, f32x16& p1, float& m_reg, float& alpha, const float (&cs)[16], float base, float C, float slope2, int delta, unsigned long long mw, int hi) {
  const float tb0 = slope2 * (float)delta + base, tb1 = slope2 * (float)(delta + 32) + base;
  const unsigned wl = (unsigned)mw >> (4 * hi), wh = (unsigned)(mw >> 32) >> (4 * hi);
#pragma unroll
  for (int r = 0; r < 16; ++r) { const int K = (r & 3) + 8 * (r >> 2);
    const float y0 = fmaf(p0[r], C, cs[r]), y1 = fmaf(p1[r], C, cs[r]);
    const unsigned t0 = (unsigned)((int)(wl << (31 - K)) >> 31), t1 = (unsigned)((int)(wh << (31 - K)) >> 31);
    p0[r] = __uint_as_float((__float_as_uint(y0) & t0) | (~t0 & 0xff800000u));
    p1[r] = __uint_as_float((__float_as_uint(y1) & t1) | (~t1 & 0xff800000u)); }
  float pm0 = p0[0], pm1 = p1[0];
#pragma unroll
  for (int r = 1; r < 16; ++r) { pm0 = fmaxf(pm0, p0[r]); pm1 = fmaxf(pm1, p1[r]); }
  float pmax = fmaxf(pm0 + tb0, pm1 + tb1);
  { auto rr = __builtin_amdgcn_permlane32_swap(__float_as_uint(pmax), __float_as_uint(pmax), false, false);
    pmax = fmaxf(__uint_as_float(rr[0]), __uint_as_float(rr[1])); }
  float mn;
  if (__builtin_expect(__all(pmax - m_reg <= THR2), 1)) { mn = m_reg; alpha = 1.f; }
  else { mn = fmaxf(m_reg, pmax); alpha = __builtin_amdgcn_exp2f(m_reg - mn); m_reg = mn; }
  const float a0 = tb0 - mn, a1 = tb1 - mn;
#pragma unroll
  for (int r = 0; r < 16; ++r) { p0[r] += a0; p1[r] += a1; }
#pragma unroll
  for (int r = 0; r < 16; ++r) p0[r] = __builtin_amdgcn_exp2f(p0[r]);
}
__device__ __forceinline__ void attn_a_unit(const bf16_t* __restrict__ PROJ, const unsigned long long* __restrict__ MASK, bf16_t* UA, int h, int qb, int jmin, LAS unsigned char* lds, const int wid) {
  const int lane = lane_id_v(), tid = wid * 64 + lane, r32 = lane & 31, hi = lane >> 5;
  const int R0 = qb * 256, qrow0 = R0 + wid * 32, NT = 4 * qb + 4, NTe = NT - jmin;
  LAS unsigned char* V_lds = lds; LAS unsigned char* K_lds = lds + 2 * SHM_V;
  LAS float* ws = (LAS float*)(lds + 2 * SHM_V + 2 * SHM_K) + wid * 64; LAS float* li_l = ws; LAS float* al_l = ws + 32;
  const float slope2 = __builtin_amdgcn_exp2f(-(float)(h + 1)) * LOG2E, C = 0.08838834764831845f * LOG2E;
  float cs[16];
#pragma unroll
  for (int r = 0; r < 16; ++r) cs[r] = __uint_as_float(__builtin_amdgcn_readfirstlane(__float_as_uint(slope2 * (float)((r & 3) + 8 * (r >> 2)))));
  const float base = slope2 * (float)(4 * hi - r32);
  float m_reg = -1e30f, l_reg = 0; f32x16 o[4] = {}; bf16x8 qr[8];
  { const bf16_t* Qw = PROJ + (size_t)(qrow0 + r32) * NPAD + C_QA + h * 128 + hi * 8;
#pragma unroll
    for (int d0 = 0; d0 < 8; ++d0) qr[d0] = *(const bf16x8*)(Qw + d0 * 16); }
  const unsigned offK = (unsigned)((tid >> 4) * NPAD + C_KA + h * 128 + (tid & 15) * 8) * 2u, offV = offK + (unsigned)(C_VA - C_KA) * 2u;
  const unsigned moff = (unsigned)(qrow0 + r32) * 1024u;
#define MLD(tj) (*(const unsigned long long*)((const char*)MASK + (moff + 8u * (unsigned)(tj))))
  const int sr = tid >> 4, sc = (tid & 15) * 8, vst0 = v_st(sr, sc), vst1 = v_st(32 + sr, sc);
  LAS const unsigned char* vb0 = V_lds + v_rd_base(lane);
  struct { bf16x8 vs0, vs1, ks0, ks1; } sr_;
#define TJ(t) (NT - 1 - (t))
#define KEY0(t) (64 * TJ(t))
#define GLD16(off) (*(const bf16x8*)((const char*)PROJ + (unsigned)(off)))
#define SLOAD(k0) do { const unsigned kb_ = (unsigned)(k0) * (unsigned)(NPAD * 2); sr_.vs0 = GLD16(offV + kb_); sr_.vs1 = GLD16(offV + kb_ + 32u * NPAD * 2u); \
    sr_.ks0 = GLD16(offK + kb_); sr_.ks1 = GLD16(offK + kb_ + 32u * NPAD * 2u); } while (0)
#define SWRITE(b) do { *(LAS bf16x8*)(V_lds + (b) * SHM_V + vst0) = sr_.vs0; *(LAS bf16x8*)(V_lds + (b) * SHM_V + vst1) = sr_.vs1; const int kc = sc * 2; \
    *(LAS bf16x8*)(K_lds + (b) * SHM_K + KSWZ(sr, kc)) = sr_.ks0; *(LAS bf16x8*)(K_lds + (b) * SHM_K + KSWZ(32 + sr, kc)) = sr_.ks1; } while (0)
#define RESC(a) do { if (__any((a) < 1.f)) { if (hi == 0) al_l[r32] = (a); asm volatile("s_waitcnt lgkmcnt(0)" ::: "memory"); \
    _Pragma("unroll") for (int d = 0; d < 4; ++d) _Pragma("unroll") for (int r = 0; r < 16; ++r) o[d][r] *= al_l[crow(r, hi)]; } } while (0)
  f32x16 pA0, pA1, pB0, pB1; float alA, alB; bf16x8 pa0, pa1, pa2, pa3; unsigned long long mwA, mwB;
  SLOAD(KEY0(0)); mwA = MLD(TJ(0)); SWRITE(0); __syncthreads();
  qkt<8>(pA0, pA1, K_lds, qr, 0, r32, hi); partialSM_A<true>(pA0, pA1, m_reg, alA, cs, base, C, slope2, KEY0(0) - qrow0, mwA, hi);
  SLOAD(KEY0(1)); mwB = MLD(TJ(1)); SWRITE(1); __syncthreads();
  for (int j = 1; j + 1 < NTe; j += 2) {
    SBAR(); qkt<8>(pB0, pB1, K_lds + SHM_K, qr, 0, r32, hi);
    finishSM(pA0, pA1, alA, l_reg, pa0, pa1, pa2, pa3); SBAR();
    SLOAD(KEY0(j + 1)); mwA = MLD(TJ(j + 1)); SBAR();
    pv_d0(o, vb0, pa0, pa1, pa2, pa3); partialSM_A<true>(pB0, pB1, m_reg, alB, cs, base, C, slope2, KEY0(j) - qrow0, mwB, hi);
    __syncthreads(); SWRITE(0);
    RESC(alB); __syncthreads();
    SBAR(); qkt<8>(pA0, pA1, K_lds, qr, 0, r32, hi);
    finishSM(pB0, pB1, alB, l_reg, pa0, pa1, pa2, pa3); SBAR();
    SLOAD(KEY0(j + 2)); mwB = MLD(TJ(j + 2)); SBAR();
    pv_d0(o, vb0 + SHM_V, pa0, pa1, pa2, pa3); partialSM_A<true>(pA0, pA1, m_reg, alA, cs, base, C, slope2, KEY0(j + 1) - qrow0, mwA, hi);
    __syncthreads(); SWRITE(1);
    RESC(alA); __syncthreads();
  }
  SBAR(); qkt<8>(pB0, pB1, K_lds + SHM_K, qr, 0, r32, hi);
  finishSM(pA0, pA1, alA, l_reg, pa0, pa1, pa2, pa3); SBAR();
  pv_d0(o, vb0, pa0, pa1, pa2, pa3); partialSM_A<true>(pB0, pB1, m_reg, alB, cs, base, C, slope2, KEY0(NTe - 1) - qrow0, mwB, hi);
  __syncthreads(); RESC(alB);
  finishSM(pB0, pB1, alB, l_reg, pa0, pa1, pa2, pa3); SBAR();
  pv_d0(o, vb0 + SHM_V, pa0, pa1, pa2, pa3);
#undef TJ
#undef MLD
#undef KEY0
#undef SLOAD
#undef GLD16
#undef SWRITE
#undef RESC
  if (hi == 0) li_l[r32] = l_reg; asm volatile("s_waitcnt lgkmcnt(0)" ::: "memory");
  float rli[16];
#pragma unroll
  for (int r = 0; r < 16; ++r) rli[r] = __builtin_amdgcn_rcpf(li_l[crow(r, hi)]);
  { bf16_t zv[4][16];
#pragma unroll
  for (int d0 = 0; d0 < 4; ++d0)
#pragma unroll
    for (int r = 0; r < 16; ++r) zv[d0][r] = PROJ[(size_t)(qrow0 + crow(r, hi)) * NPAD + C_ZA + h * 128 + d0 * 32 + r32];
#pragma unroll
  for (int d0 = 0; d0 < 4; ++d0) { const int col = h * 128 + d0 * 32 + r32;
#pragma unroll
    for (int r = 0; r < 16; ++r) { const size_t row = (size_t)(qrow0 + crow(r, hi));
      UA[row * 1024 + col] = (bf16_t)f2bf(o[d0][r] * rli[r] * bf2f(zv[d0][r])); } } }
  __syncthreads();
}
template <int NQ, bool ACC> __device__ __forceinline__ void qkt_acc(f32x16& p0, f32x16& p1, LAS const unsigned char* Ks, const bf16x8* qr, int r32, int hi) {
  if (!ACC) { p0 = f32x16{}; p1 = f32x16{}; }
#pragma unroll
  for (int d0 = 0; d0 < NQ; ++d0) { const int cb = (d0 * 16 + hi * 8) * 2;
    const bf16x8 b0 = *(LAS const bf16x8*)(Ks + KSWZ(r32, cb));
    const bf16x8 b1 = *(LAS const bf16x8*)(Ks + KSWZ(32 + r32, cb));
    p0 = __builtin_amdgcn_mfma_f32_32x32x16_bf16(b0, qr[d0], p0, 0, 0, 0);
    p1 = __builtin_amdgcn_mfma_f32_32x32x16_bf16(b1, qr[d0], p1, 0, 0, 0); }
}
__device__ __forceinline__ void attn_m_unit(const bf16_t* __restrict__ PROJ, const bf16_t* __restrict__ MKV, bf16_t* UM, int h, int qb, int vh, LAS unsigned char* lds, const int wid) {
  const int lane = lane_id_v(), tid = wid * 64 + lane, r32 = lane & 31, hi = lane >> 5;
  const int qrow0 = qb * 256 + wid * 32;
  LAS unsigned char* V_lds = lds; LAS unsigned char* K_lds = lds + 2 * SHM_V;
  LAS float* ws = (LAS float*)(lds + 2 * SHM_V + 2 * SHM_K) + wid * 64; LAS float* li_l = ws; LAS float* al_l = ws + 32;
  const float C = 0.0625f * LOG2E;
  const float cs[16] = {0.f, 0.f, 0.f, 0.f, 0.f, 0.f, 0.f, 0.f, 0.f, 0.f, 0.f, 0.f, 0.f, 0.f, 0.f, 0.f};
  float m_reg = -1e30f, l_reg = 0; f32x16 o[4] = {}; bf16x8 qr[16];
  { const bf16_t* Qw = PROJ + (size_t)(qrow0 + r32) * NPAD + C_QM + h * 256 + hi * 8;
#pragma unroll
    for (int d0 = 0; d0 < 16; ++d0) qr[d0] = *(const bf16x8*)(Qw + d0 * 16); }
  const int sr = tid >> 4, sc = (tid & 15) * 8, vst0 = v_st(sr, sc), vst1 = v_st(32 + sr, sc);
  const unsigned offK = (unsigned)(sr * 2048 + h * 256 + sc) * 2u, offV = offK + (unsigned)(1024 + vh * 128) * 2u;
  LAS const unsigned char* vb0 = V_lds + v_rd_base(lane);
#define GLD16(off) (*(const bf16x8*)((const char*)MKV + (unsigned)(off)))
  for (int t = 0; t < 4; ++t) {
    const unsigned kb_ = (unsigned)(64 * t) * 4096u;
    const bf16x8 ka0 = GLD16(offK + kb_), ka1 = GLD16(offK + kb_ + 32u * 4096u), kb0 = GLD16(offK + kb_ + 256u), kb1 = GLD16(offK + kb_ + 32u * 4096u + 256u);
    const bf16x8 vs0 = GLD16(offV + kb_), vs1 = GLD16(offV + kb_ + 32u * 4096u);
    const int kc = sc * 2;
    *(LAS bf16x8*)(K_lds + KSWZ(sr, kc)) = ka0; *(LAS bf16x8*)(K_lds + KSWZ(32 + sr, kc)) = ka1;
    *(LAS bf16x8*)(K_lds + SHM_K + KSWZ(sr, kc)) = kb0; *(LAS bf16x8*)(K_lds + SHM_K + KSWZ(32 + sr, kc)) = kb1;
    *(LAS bf16x8*)(V_lds + vst0) = vs0; *(LAS bf16x8*)(V_lds + vst1) = vs1;
    __syncthreads();
    f32x16 p0, p1; float al; bf16x8 pa0, pa1, pa2, pa3;
    qkt_acc<8, false>(p0, p1, K_lds, qr, r32, hi); qkt_acc<8, true>(p0, p1, K_lds + SHM_K, qr + 8, r32, hi);
    partialSM<false>(p0, p1, m_reg, al, cs, 0.f, 0, C, 0.f, 0);
    if (__any(al < 1.f)) { if (hi == 0) al_l[r32] = al; asm volatile("s_waitcnt lgkmcnt(0)" ::: "memory");
#pragma unroll
      for (int d = 0; d < 4; ++d)
#pragma unroll
        for (int r = 0; r < 16; ++r) o[d][r] *= al_l[crow(r, hi)]; }
    finishSM(p0, p1, al, l_reg, pa0, pa1, pa2, pa3);
    pv_d0(o, vb0, pa0, pa1, pa2, pa3);
    __syncthreads();
  }
#undef GLD16
  if (hi == 0) li_l[r32] = l_reg; asm volatile("s_waitcnt lgkmcnt(0)" ::: "memory");
  float rli[16];
#pragma unroll
  for (int r = 0; r < 16; ++r) rli[r] = __builtin_amdgcn_rcpf(li_l[crow(r, hi)]);
  { bf16_t zv[4][16];
#pragma unroll
  for (int d0 = 0; d0 < 4; ++d0)
#pragma unroll
    for (int r = 0; r < 16; ++r) zv[d0][r] = PROJ[(size_t)(qrow0 + crow(r, hi)) * NPAD + C_ZM + h * 256 + vh * 128 + d0 * 32 + r32];
#pragma unroll
  for (int d0 = 0; d0 < 4; ++d0) { const int col = h * 256 + vh * 128 + d0 * 32 + r32;
#pragma unroll
    for (int r = 0; r < 16; ++r) { const size_t row = (size_t)(qrow0 + crow(r, hi));
      UM[row * 1024 + col] = (bf16_t)f2bf(o[d0][r] * rli[r] * bf2f(zv[d0][r])); } } }
  __syncthreads();
}
__device__ __forceinline__ void attn_m_phase(const Args& a, LAS unsigned char* lds, int blk, int nblk, const int wid) {
  const bf16_t* PROJ = (const bf16_t*)(a.ws + WS_PROJ); const bf16_t* MKV = (const bf16_t*)(a.ws + WS_MKV); bf16_t* UM = (bf16_t*)(a.ws + WS_U) + (size_t)2 * S * 1024;
  for (int u = blk; u < 256; u += nblk) attn_m_unit(PROJ, MKV, UM, u & 3, u >> 3, (u >> 2) & 1, lds, wid);
}
__device__ __forceinline__ float slot_sum(const unsigned* ns, int tile, int bj, int wc0, int nwc) { float s = 0.f;
  for (int w = 0; w < nwc; ++w) s += __uint_as_float(__hip_atomic_load(ns + (tile * 2 + bj) * 4 + wc0 + w, __ATOMIC_RELAXED, __HIP_MEMORY_SCOPE_AGENT)); return s; }
__device__ __forceinline__ int window_jmin(float q2k2, float scale, int h, int R0, int NT) {
  const float slope2 = __builtin_amdgcn_exp2f(-(float)(h + 1)) * LOG2E, L = sqrtf(q2k2) * scale * LOG2E * 1.02f, D = (2.f * L + 48.f) / slope2;
  const float x = ((float)R0 - D - 63.f) * (1.f / 64.f);
  int jm = (int)floorf(x) - 1; jm = jm < 0 ? 0 : jm; jm &= ~1; return jm > NT - 2 ? NT - 2 : jm;
}
__device__ __forceinline__ int jmin_b(const unsigned* ns, int h, int qb) {
  const int bj = h & 1; float m = 0.f;
  for (int c = 0; c < 2; ++c) { const float v = slot_sum(ns, 20 + (h >> 1), bj, 2 * c, 2) * slot_sum(ns, 24 + (h >> 1), bj, 2 * c, 2); m = fmaxf(m, v); }
  return window_jmin(m, 0.125f, h, qb * 128, 2 * qb + 2);
}
constexpr int NUNITS_AB = 512;
__device__ __forceinline__ void build_order(const unsigned* ns, unsigned* order, LAS unsigned char* lds, const int lane) {
  LAS int* cost = (LAS int*)lds;
  for (int u = lane; u < NUNITS_AB; u += 64) { int jm, cst;
    { const int h = u & 7, qb = u >> 3; jm = jmin_b(ns, h, qb); cst = 2 * qb + 2 - jm; }
    cost[u] = cst; cost[NUNITS_AB + u] = jm; }
  asm volatile("s_waitcnt lgkmcnt(0)" ::: "memory"); __builtin_amdgcn_wave_barrier();
  for (int u = lane; u < NUNITS_AB; u += 64) { const int cu = cost[u]; int rank = 0;
    for (int v = 0; v < NUNITS_AB; ++v) { const int cv = cost[v]; rank += (cv > cu || (cv == cu && v < u)) ? 1 : 0; }
    order[rank] = (unsigned)u | ((unsigned)cost[NUNITS_AB + u] << 16); }
}
__device__ __forceinline__ void attn_ab_phase(const Args& a, LAS unsigned char* lds, int blk, int nblk, const int wid) {
  const bf16_t* PROJ = (const bf16_t*)(a.ws + WS_PROJ); bf16_t* UA = (bf16_t*)(a.ws + WS_U); bf16_t* UB = UA + (size_t)S * 1024;
  { const unsigned long long* MASK = (const unsigned long long*)(a.ws + WS_SEL);
    for (int u = blk; u < 256; u += nblk) attn_a_unit(PROJ, MASK, UA, u & 7, 31 - (u >> 3), 0, lds, wid); }
  const unsigned* order = (const unsigned*)(a.ws + WS_CTL + 4096); unsigned* qctr = (unsigned*)(a.ws + WS_CTL + 320);
  LAS unsigned* slot = (LAS unsigned*)(lds + 147456 - 64);
  for (;;) {
    if (wid == 0) { if (lane_id_v() == 0) slot[0] = __hip_atomic_fetch_add(qctr, 1u, __ATOMIC_RELAXED, __HIP_MEMORY_SCOPE_AGENT); }
    __syncthreads();
    const unsigned i = slot[0];
    __syncthreads();
    if (i >= 512u) break;
    const unsigned e = order[i]; const int u = (int)(e & 0xffffu), jm = (int)(e >> 16);
    attn_b_unit(PROJ, UB, a.in[9], ((const float*)(a.ws + WS_CTL))[0], u & 7, u >> 3, jm, lds, wid);
  }
}
#undef KSWZ
#undef SBAR
}


namespace idx {
typedef short bf16x8 __attribute__((ext_vector_type(8)));
typedef float f32x16 __attribute__((ext_vector_type(16)));
constexpr int NUNIT = 8 * (16 * 17 / 2);
__device__ __forceinline__ void scores_phase(const bf16_t* __restrict__ PROJ, float* SC, unsigned* uctr, LAS unsigned char* lds, int blk, int nblk, const int wid) {
  const int lane = lane_id_v(), tid = wid * 64 + lane, n32 = lane & 31, hi = lane >> 5;
  const int skey = tid >> 3, schunk = tid & 7;
  const int swr = skey * 128 + ((schunk ^ (skey & 7)) << 4);
  LAS unsigned* uslot = (LAS unsigned*)(lds + 147456 - 64);
  for (;;) {
    if (wid == 0) { if (lane_id_v() == 0) uslot[0] = __hip_atomic_fetch_add(uctr, 1u, __ATOMIC_RELAXED, __HIP_MEMORY_SCOPE_AGENT); }
    __syncthreads();
    const int u = NUNIT - 1 - (int)uslot[0];
    __syncthreads();
    if (u < 0) break;
    int g = 0, rem = u; while (rem >= 8 * (g + 1)) { rem -= 8 * (g + 1); ++g; }
    const int qc = 8 * g + rem / (g + 1), kc = rem % (g + 1);
    const int q0 = 64 * qc + 8 * wid, k_begin = 512 * kc, k_end = min(512 * kc + 512, 64 * qc + 64), ntile = (k_end - k_begin) / 64;
    bf16x8 af[4][4]; float w[4][16];
    const int head = (n32 & 3) + 4 * (n32 >> 3), qbit = (n32 >> 2) & 1;
#pragma unroll
    for (int t = 0; t < 4; ++t) {
      const bf16_t* qp = PROJ + (size_t)(q0 + 2 * t + qbit) * NPAD + C_QI + head * 64 + hi * 8;
#pragma unroll
      for (int ks = 0; ks < 4; ++ks) af[t][ks] = *(const bf16x8*)(qp + ks * 16);
      const bf16_t* wp = PROJ + (size_t)(q0 + 2 * t + hi) * NPAD + C_WI;
      const u32x4 w0 = *(const u32x4*)wp, w1 = *(const u32x4*)(wp + 8);
      const unsigned ww[8] = {w0.x, w0.y, w0.z, w0.w, w1.x, w1.y, w1.z, w1.w};
#pragma unroll
      for (int i = 0; i < 8; ++i) { w[t][2 * i] = bflo(ww[i]) * 0.03125f; w[t][2 * i + 1] = bfhi(ww[i]) * 0.03125f; }
    }
    u32x4 st = *(const u32x4*)(PROJ + (size_t)(k_begin + skey) * NPAD + C_KI + schunk * 8);
    __syncthreads();
    *(LAS u32x4*)(lds + swr) = st;
    __syncthreads();
    for (int tl = 0; tl < ntile; ++tl) {
      LAS const unsigned char* kb = lds + (tl & 1) * 8192;
      if (tl + 1 < ntile) st = *(const u32x4*)(PROJ + (size_t)(k_begin + 64 * (tl + 1) + skey) * NPAD + C_KI + schunk * 8);
#pragma unroll
      for (int kh = 0; kh < 2; ++kh) {
        const int krow = kh * 32 + n32;
        bf16x8 bfr[4];
#pragma unroll
        for (int ks = 0; ks < 4; ++ks) bfr[ks] = *(LAS const bf16x8*)(kb + krow * 128 + (((2 * ks + hi) ^ (krow & 7)) << 4));
        const int s = k_begin + 64 * tl + krow;
#pragma unroll
        for (int t = 0; t < 4; ++t) {
          f32x16 acc = {};
#pragma unroll
          for (int ks = 0; ks < 4; ++ks) acc = __builtin_amdgcn_mfma_f32_32x32x16_bf16(af[t][ks], bfr[ks], acc, 0, 0, 0);
          float sc = 0.f;
#pragma unroll
          for (int r = 0; r < 16; ++r) sc = fmaf(fmaxf(acc[r], 0.f), w[t][r], sc);
          const int q = q0 + 2 * t + hi;
          if (s <= q) SC[sc_off(q) + s] = sc;
        }
      }
      if (tl + 1 < ntile) { *(LAS u32x4*)(lds + ((tl + 1) & 1) * 8192 + swr) = st; }
      __syncthreads();
    }
  }
}
}

#ifdef DBG_STAGE
__device__ __forceinline__ void dbg_dump(const Args& a, int blk, int nblk) {
    const bf16_t* PROJ = (const bf16_t*)(a.ws + WS_PROJ);
    for (size_t idx = (size_t)blk * 512 + threadIdx.x; idx < (size_t)S * DM; idx += (size_t)nblk * 512) {
        const int r = (int)(idx / DM), c = (int)(idx % DM); float v = 0.f;
#if DBG_STAGE == 1 && defined(DBG_WEIGHTS)
        for (int z = 0; z < 3; ++z) v += bf2f(((const bf16_t*)(a.ws + WS_WTBR))[((size_t)z * 2048 + (r & 2047)) * 1024 + (c & 1023)]);
        v += bf2f(((const bf16_t*)(a.ws + WS_WTOUT))[(size_t)(r & 2047) * 2048 + c]);
#elif DBG_STAGE == 1 && defined(DBG_GATES)
        for (int j = 0; j < 3; ++j) v += bf2f(PROJ[(size_t)r * NPAD + C_GL + c + 2048 * j]);
#elif DBG_STAGE == 1
        for (int j = 0; j < 8; ++j) v += bf2f(PROJ[(size_t)r * NPAD + c + 2048 * j]);
        if (c < 1280) v += bf2f(PROJ[(size_t)r * NPAD + 16384 + c]);
        if (r < 256) v += bf2f(((const bf16_t*)(a.ws + WS_MKV))[(size_t)r * 2048 + c]);
        for (int z = 0; z < 3; ++z) v += bf2f(((const bf16_t*)(a.ws + WS_WTBR))[((size_t)z * 2048 + (r & 2047)) * 1024 + (c & 1023)]);
        v += bf2f(((const bf16_t*)(a.ws + WS_WTOUT))[(size_t)(r & 2047) * 2048 + c]);
#elif DBG_STAGE == 2
        if (c < 1024) v = bf2f(((const bf16_t*)(a.ws + WS_U))[(size_t)(S + r) * 1024 + c]) + bf2f(((const bf16_t*)(a.ws + WS_U))[(size_t)(2 * S + r) * 1024 + c]);
        else { const float* row = (const float*)(a.ws + WS_SC) + sc_off(r); for (int j = c - 1024; j <= r; j += 1024) v += row[j]; }
#elif DBG_STAGE == 3
        if (c < 256) v = (float)((const int*)(a.ws + WS_SEL))[(size_t)r * 256 + c];
#elif DBG_STAGE == 4
        if (c < 1024) v = bf2f(((const bf16_t*)(a.ws + WS_U))[(size_t)r * 1024 + c]);
#elif DBG_STAGE == 5
        v = bf2f(((const bf16_t*)(a.ws + WS_MERGED))[(size_t)r * DM + c]);
#endif
        a.out[idx] = v;
    }
}
#endif

#define RLX_AGENT __ATOMIC_RELAXED, __HIP_MEMORY_SCOPE_AGENT
#define XB_TMO      128
#define XB_XCNT(j)  (256  + 64 * (j))
#define XB_XSUB(j)  (1280 + 64 * (j))
#define XB_XGEN(j)  (2304 + 64 * (j))
#define XB_TOP      3328
#define XB_TOPGEN   3392
#define XCD_BAR_WORDS 3456
#define XB_SPIN_CAP (1u << 18)

__device__ __forceinline__ unsigned xb_ld(unsigned* p)              { return __hip_atomic_load(p, __ATOMIC_RELAXED, __HIP_MEMORY_SCOPE_AGENT); }
__device__ __forceinline__ unsigned xb_add(unsigned* p, unsigned v) { return __hip_atomic_fetch_add(p, v, __ATOMIC_RELAXED, __HIP_MEMORY_SCOPE_AGENT); }
__device__ __forceinline__ unsigned xb_xcc_id() { return (unsigned)__builtin_amdgcn_s_getreg((3 << 11) | 20) & 0xFu; }
#define XB_SPIN(cond, bar) do { unsigned _sp = 0; while (cond) { __builtin_amdgcn_s_sleep(1); \
    if ((++_sp & 255u) == 0u) { if (xb_ld(&(bar)[XB_TMO])) break; if (_sp > XB_SPIN_CAP) { atomicAdd(&(bar)[XB_TMO], 1u); break; } } } } while (0)

struct XcdBarrier {
    unsigned* bar; unsigned x;
    volatile LAS unsigned* st;
};

__device__ __forceinline__ XcdBarrier xcd_barrier_post(unsigned* bar, volatile LAS unsigned* st, bool leader) {
    XcdBarrier b; b.bar = bar; b.x = xb_xcc_id(); b.st = st;
    if (leader) (void)xb_add(&bar[XB_XCNT(b.x)], 1u);
    return b;
}
__device__ __forceinline__ void xcd_barrier_complete(unsigned* bar, unsigned x, unsigned& nloc, unsigned& nx) {
    const unsigned G = gridDim.x * gridDim.y * gridDim.z;
    unsigned sum, cnt, mine, sp = 0u;
    for (;;) {
        sum = 0u; cnt = 0u; mine = 0u;
#pragma unroll
        for (unsigned j = 0; j < 16; ++j) { const unsigned c = xb_ld(&bar[XB_XCNT(j)]); sum += c; cnt += (c > 0u) ? 1u : 0u; mine = (j == x) ? c : mine; }
        if (sum == G) break;
        __builtin_amdgcn_s_sleep(1);
        if ((++sp & 255u) == 0u) { if (xb_ld(&bar[XB_TMO])) break; if (sp > XB_SPIN_CAP) { atomicAdd(&bar[XB_TMO], 1u); break; } }
    }
    nloc = mine > 0u ? mine : 1u; nx = cnt > 0u ? cnt : 1u;
}

__device__ __forceinline__ void xcd_barrier(const XcdBarrier& b, bool leader) {
    asm volatile("s_waitcnt vmcnt(0)" ::: "memory");
    __syncthreads();
    if (leader) {
        unsigned* bar = b.bar;
        __builtin_amdgcn_s_waitcnt(0);
        unsigned nloc = b.st[0], nx = b.st[1];
        if (nloc == 0u) { xcd_barrier_complete(bar, b.x, nloc, nx); b.st[0] = nloc; b.st[1] = nx; }
        const unsigned old = xb_add(&bar[XB_XSUB(b.x)], 1u);
        const unsigned gen = old / nloc;
        if (old + 1u == (gen + 1u) * nloc) {
            __builtin_amdgcn_fence(__ATOMIC_RELEASE, "agent");
            asm volatile("s_waitcnt vmcnt(0)" ::: "memory");
            const unsigned og = xb_add(&bar[XB_TOP], 1u);
            const unsigned tg = og / nx;
            if (og + 1u == (tg + 1u) * nx) xb_add(&bar[XB_TOPGEN], 1u);
            else XB_SPIN(xb_ld(&bar[XB_TOPGEN]) == tg, bar);
            __builtin_amdgcn_fence(__ATOMIC_ACQUIRE, "agent");
            xb_add(&bar[XB_XGEN(b.x)], 1u);
            asm volatile("s_waitcnt vmcnt(0)" ::: "memory");
        } else {
            XB_SPIN(xb_ld(&bar[XB_XGEN(b.x)]) == gen, bar);
            __builtin_amdgcn_fence(__ATOMIC_ACQUIRE, "agent");
            asm volatile("s_waitcnt vmcnt(0)" ::: "memory");
        }
    }
    __syncthreads();
}

__device__ __forceinline__ void grid_bar(unsigned* cnt, unsigned target, const int wave) {
    asm volatile("s_waitcnt vmcnt(0)" ::: "memory");
    __syncthreads();
    if (wave == 0) {
        if (lane_id_v() == 0) {
            __builtin_amdgcn_fence(__ATOMIC_RELEASE, "agent");
            asm volatile("s_waitcnt vmcnt(0)" ::: "memory");
            __hip_atomic_fetch_add(cnt, 1u, __ATOMIC_RELAXED, __HIP_MEMORY_SCOPE_AGENT);
            while (__hip_atomic_load(cnt, __ATOMIC_RELAXED, __HIP_MEMORY_SCOPE_AGENT) < target) __builtin_amdgcn_s_sleep(2);
            __builtin_amdgcn_fence(__ATOMIC_ACQUIRE, "agent");
            asm volatile("s_waitcnt vmcnt(0)" ::: "memory");
        }
    }
    __syncthreads();
}

constexpr int LDS_BYTES = 147456;
constexpr int NPHASE = 8;
__global__ void __launch_bounds__(512, 2) fwd(Args a) {
    extern __shared__ __attribute__((aligned(16))) unsigned char lds_raw[];
    LAS unsigned char* lds = (LAS unsigned char*)lds_raw;
    cg::grid_group grid = cg::this_grid();
    const int blk = blockIdx.x, nblk = gridDim.x, wave = __builtin_amdgcn_readfirstlane(threadIdx.x >> 6);
    unsigned char* ws = a.ws;
    const bf16_t* PROJ = (const bf16_t*)(ws + WS_PROJ);
    volatile LAS unsigned* xst = (volatile LAS unsigned*)(lds + 147456 - 128);
    if (wave == 0) { if (lane_id_v() == 0) { xst[0] = 0u; xst[1] = 0u; } }
    __syncthreads();
    (void)xcd_barrier_post((unsigned*)(ws + WS_CTL + 16384), xst, wave == 0 && lane_id_v() == 0);
#define IN(k) (a.ph_lo <= (k) && (k) < a.ph_hi)
#define SEAM(k) do { if (IN(k) && IN((k) + 1)) { if ((k) == 0) grid.sync(); else { XcdBarrier xb_; xb_.bar = (unsigned*)(ws + WS_CTL + 16384); xb_.x = xb_xcc_id(); xb_.st = (volatile LAS unsigned*)(lds + 147456 - 128); xcd_barrier(xb_, wave == 0 && lane_id_v() == 0); } } } while (0)
    if (IN(0)) { p0_prologue(a, lds, blk, nblk, wave); } SEAM(0);
    if (IN(1)) {
        pg8::Gemm g{(const bf16_t*)(ws + WS_H), (const bf16_t*)(ws + WS_WTIN), S, NPAD, DM, (long)WS_MEMN - (long)WS_H, (long)WS_WTMKV - (long)WS_WTIN};
        pg8::ProjOrder so; so.init(S, NPAD, nblk, blk);
        pg8::EpiProj E{(bf16_t*)(ws + WS_PROJ), NPAD, (bf16_t*)(ws + WS_MKV), 2048, a.in[4], C_GL / 256, (unsigned*)(ws + WS_CTL + 1024)};
        pg8::gemm_phase<pg8::EpiProj, pg8::ProjOrder, true, true>(lds, g, so, E, wave);
    } SEAM(1);
    if (IN(2)) { idx::scores_phase(PROJ, (float*)(ws + WS_SC), (unsigned*)(ws + WS_CTL + 448), lds, blk, nblk, wave); __syncthreads(); att::attn_m_phase(a, lds, blk, nblk, wave); } SEAM(2);
    if (IN(3)) { if (blk == nblk - 1) { if (wave == 7) att::build_order((const unsigned*)(ws + WS_CTL + 1024), (unsigned*)(ws + WS_CTL + 4096), lds + 131072, lane_id_v()); }
                 topk_select((const float*)(ws + WS_SC), (int*)(ws + WS_SEL), lds, blk, nblk, wave); } SEAM(3);
    if (IN(4)) { att::attn_ab_phase(a, lds, blk, nblk, wave); } SEAM(4);
    if (IN(5)) {
        pg8::Gemm g{(const bf16_t*)(ws + WS_U), (const bf16_t*)(ws + WS_WTBR), S, DM, 1024, (long)S * 1024 * 2, (long)2048 * 1024 * 2};
        pg8::MergeOrder so; so.init(S, DM, nblk, blk);
        pg8::EpiMerge E{PROJ + C_GL, NPAD, (bf16_t*)(ws + WS_MERGED), DM};
        pg8::gemm_phase<pg8::EpiMerge, pg8::MergeOrder, true, true>(lds, g, so, E, wave);
    } SEAM(5);
    if (IN(6)) {
        pg8::Gemm g{(const bf16_t*)(ws + WS_MERGED), (const bf16_t*)(ws + WS_WTOUT), S, DM, DM, 0, 0};
        pg8::StaticOrder so; so.init(S, DM, nblk, blk);
        pg8::EpiOut E{a.in[0], a.out, DM, (float*)(ws + WS_PART), S};
        pg8::gemm_phase<pg8::EpiOut, pg8::StaticOrder, false, true>(lds, g, so, E, wave);
    } SEAM(6);
    if (IN(7)) { final_norm(a, blk, nblk, wave); }
#ifdef DBG_STAGE
    if (IN(8)) { dbg_dump(a, blk, nblk); }
#endif
#undef IN
#undef SEAM
}

#ifndef N_LAUNCH_MODE
#define N_LAUNCH_MODE 0
#endif
extern "C" void kernel_launch(void* const* d_in, const int* in_sizes, int n_in, void* d_out, int out_size, void* d_ws, size_t ws_size, hipStream_t stream) {
    static int grid = 0;
    if (grid == 0) {
        if (n_in != 17 || in_sizes[0] != S * DM || in_sizes[3] != DM * DIN || out_size != S * DM || ws_size < WS_END) {
            fprintf(stderr, "kernel_launch: unexpected shapes (n_in %d, in0 %d, in3 %d, out %d, ws %zu < %zu)\n", n_in, n_in > 0 ? in_sizes[0] : -1, n_in > 3 ? in_sizes[3] : -1, out_size, ws_size, (size_t)WS_END); grid = -1; return; }
        int dev = 0, cus = 0, per_cu = 0;
        (void)hipGetDevice(&dev); (void)hipDeviceGetAttribute(&cus, hipDeviceAttributeMultiprocessorCount, dev);
        if (hipFuncSetAttribute((const void*)fwd, hipFuncAttributeMaxDynamicSharedMemorySize, LDS_BYTES) != hipSuccess) { fprintf(stderr, "kernel_launch: hipFuncSetAttribute failed\n"); grid = -1; return; }
        if (hipOccupancyMaxActiveBlocksPerMultiprocessor(&per_cu, (const void*)fwd, 512, LDS_BYTES) != hipSuccess || per_cu < 1) { fprintf(stderr, "kernel_launch: occupancy query gave %d\n", per_cu); per_cu = 1; }
        (void)hipGetLastError();
        grid = cus * 1;
        if (grid > cus * per_cu) grid = cus * per_cu;
        if (grid < 8) grid = -1;
    }
    if (grid < 0) return;
    Args a{};
    for (int i = 0; i < 17; ++i) a.in[i] = (const float*)d_in[i];
    a.out = (float*)d_out; a.ws = (unsigned char*)d_ws;
#if N_LAUNCH_MODE == 1
    (void)hipMemsetAsync((unsigned char*)d_ws + WS_CTL + 256, 0, 256, stream);
    (void)hipMemsetAsync((unsigned char*)d_ws + WS_CTL + 16384, 0, 16384, stream);
    a.ph_lo = 0; a.ph_hi = NPHASE;
    void* kargs[] = {&a};
    hipError_t e = hipLaunchCooperativeKernel((const void*)fwd, dim3(grid), dim3(512), kargs, LDS_BYTES, stream);
    if (e != hipSuccess) fprintf(stderr, "cooperative launch failed: %s (grid %d)\n", hipGetErrorString(e), grid);
#else
#ifdef DBG_STAGE
    #ifdef DBG_WEIGHTS
    constexpr int last_ph[6] = {0, 0, 2, 3, 4, 5};
#else
    constexpr int last_ph[6] = {0, 1, 2, 3, 4, 5};
#endif
    for (int p = 0; p <= last_ph[DBG_STAGE]; ++p) { a.ph_lo = p; a.ph_hi = p + 1; hipLaunchKernelGGL(fwd, dim3(grid), dim3(512), LDS_BYTES, stream, a); }
    a.ph_lo = 8; a.ph_hi = 9; hipLaunchKernelGGL(fwd, dim3(grid), dim3(512), LDS_BYTES, stream, a);
#else
    for (int p = 0; p < NPHASE; ++p) {
        a.ph_lo = p; a.ph_hi = p + 1;
        hipLaunchKernelGGL(fwd, dim3(grid), dim3(512), LDS_BYTES, stream, a);
    }
#endif
#endif
}
```

```cpp
#define N_LAUNCH_MODE 1
#include <hip/hip_runtime.h>
#include <hip/hip_cooperative_groups.h>
#include <cstdio>
#include <cstdint>
namespace cg = cooperative_groups;

__device__ __forceinline__ int lane_id_v() { int l; asm volatile("v_mbcnt_lo_u32_b32 %0, -1, 0\n\tv_mbcnt_hi_u32_b32 %0, -1, %0" : "=v"(l)); return l; }
namespace pg8 {
#define PG8_LAS __attribute__((address_space(3)))
typedef unsigned short bf16_t;
typedef short bf16x8 __attribute__((ext_vector_type(8)));
typedef float f32x4 __attribute__((ext_vector_type(4)));
typedef int i32x4 __attribute__((ext_vector_type(4)));
typedef unsigned u32x4 __attribute__((ext_vector_type(4)));
constexpr int BM = 256, BK = 64, HALF = 128, HTB = HALF * BK * 2  , STAGE_BYTES = 8 * HTB, NXCD = 8, WGM = 8;

__host__ __device__ __forceinline__ int lds_byte(int r, int c) { const int st = (r >> 4) * 2 + (c >> 5), rr = r & 15, cc = c & 31, ob = rr * 64 + cc * 2; return st * 1024 + (ob ^ (((ob >> 9) & 1) << 5)); }
__host__ __device__ __forceinline__ void stage_rc(int b, int& R, int& C) { const int st = b / 1024, sb = b % 1024, swz = sb ^ (((sb >> 9) & 1) << 5); R = (st >> 1) * 16 + swz / 64; C = (st & 1) * 32 + (swz % 64) / 2; }
__host__ __device__ __forceinline__ int perm32(int rho) { const int n = rho >> 4, i = rho & 15; return 8 * (i >> 2) + 4 * n + (i & 3); }

struct Unit { int pm, pn, z; };
struct Gemm { const bf16_t* A; const bf16_t* Bt; int M, N, K; long zA, zB; };

struct StaticOrder {
    int nM, nN, nwg, G, c;
    __host__ __device__ void init(int M, int N, int G_, int c_) { nM = M / BM; nN = N / BM; nwg = nM * nN; G = G_; c = c_; }
    __host__ __device__ bool next(int i, Unit& u) const {
        const long L = (long)i * G + c; if (L >= nwg) return false;
        int wgid = (int)L; { const int q = nwg / NXCD, r = nwg % NXCD, xcd = wgid % NXCD, off = wgid / NXCD; wgid = (xcd < r ? xcd * (q + 1) : r * (q + 1) + (xcd - r) * q) + off; }
        const int nig = WGM * nN, gid = wgid / nig, fm = gid * WGM, gsz = (nM - fm) < WGM ? (nM - fm) : WGM;
        u.pm = fm + ((wgid % nig) % gsz); u.pn = (wgid % nig) / gsz; u.z = 0; return true;
    }
    __device__ __forceinline__ void a_ready(const Unit&) const {}
    __device__ __forceinline__ void done(const Unit&) const {}
};

typedef float f32x2_t __attribute__((ext_vector_type(2))); typedef __bf16 bf16x2_t __attribute__((ext_vector_type(2)));
__device__ __forceinline__ unsigned cvt_pk_bf16(float lo, float hi) { f32x2_t v = {lo, hi}; bf16x2_t b = __builtin_convertvector(v, bf16x2_t); return __builtin_bit_cast(unsigned, b); }

__device__ __forceinline__ float bf2f(unsigned short u) { return __uint_as_float((unsigned)u << 16); }
__device__ __forceinline__ float sigmoidf_(float v) { return __builtin_amdgcn_rcpf(1.0f + __builtin_amdgcn_exp2f(-1.4426950408889634f * v)); }
template <int MODE> __device__ __forceinline__ float act_(float v, float b) {
    if (MODE == 1) return v * sigmoidf_(v);
    if (MODE == 2) return sigmoidf_(v + b);
    return v;
}
struct EpiProj {
    static constexpr bool PERM = true, AFTER_DRAIN = false, KEEP_ACC = false, I8 = false; typedef f32x4 acc_t;
    bf16_t* O; int ldc; bf16_t* O1; int ldc1; const float* bgate; int gate_tile0;
    unsigned* nslot;
    __device__ __forceinline__ void norms(const f32x4 (&acc)[2][2][4][2], const Unit& u, int wc, int lane) const {
        float wm[2] = {0.f, 0.f};
#pragma unroll
        for (int ai = 0; ai < 2; ++ai)
#pragma unroll
            for (int m = 0; m < 4; ++m)
#pragma unroll
                for (int bj = 0; bj < 2; ++bj) { const f32x4 a = acc[ai][bj][m][0], c = acc[ai][bj][m][1];
                    float s = (a[0] * a[0] + a[1] * a[1]) + (a[2] * a[2] + a[3] * a[3]) + (c[0] * c[0] + c[1] * c[1]) + (c[2] * c[2] + c[3] * c[3]);
                    s += __shfl_xor(s, 16); s += __shfl_xor(s, 32); wm[bj] = fmaxf(wm[bj], s); }
#pragma unroll
        for (int bj = 0; bj < 2; ++bj) { float v = wm[bj]; v = fmaxf(v, __shfl_xor(v, 1)); v = fmaxf(v, __shfl_xor(v, 2)); v = fmaxf(v, __shfl_xor(v, 4)); v = fmaxf(v, __shfl_xor(v, 8));
            if (lane == 0) atomicMax(nslot + (u.pn * 2 + bj) * 4 + wc, __float_as_uint(v)); }
    }
    template <int MODE> __device__ __forceinline__ void put(const f32x4 (&acc)[2][2][4][2], bf16_t* base, int ld, int row0, int col0, const float* bias) const {
        f32x4 bv[2][2];
#pragma unroll
        for (int bj = 0; bj < 2; ++bj)
#pragma unroll
            for (int n = 0; n < 2; ++n) bv[bj][n] = (MODE == 2) ? *(const f32x4*)(bias + bj * HALF + 4 * n) : (f32x4){0.f, 0.f, 0.f, 0.f};
#pragma unroll
        for (int ai = 0; ai < 2; ++ai)
#pragma unroll
            for (int m = 0; m < 4; ++m) { bf16_t* rowp = base + (size_t)(row0 + ai * HALF + m * 16) * ld + col0;
#pragma unroll
                for (int bj = 0; bj < 2; ++bj) { f32x4 v0 = acc[ai][bj][m][0], v1 = acc[ai][bj][m][1];
#pragma unroll
                    for (int e = 0; e < 4; ++e) { v0[e] = act_<MODE>(v0[e], bv[bj][0][e]); v1[e] = act_<MODE>(v1[e], bv[bj][1][e]); }
                    u32x4 w; w.x = cvt_pk_bf16(v0[0], v0[1]); w.y = cvt_pk_bf16(v0[2], v0[3]); w.z = cvt_pk_bf16(v1[0], v1[1]); w.w = cvt_pk_bf16(v1[2], v1[3]);
                    *(u32x4*)(rowp + bj * HALF) = w; } }
    }
    __device__ __forceinline__ void operator()(const f32x4 (&acc)[2][2][4][2], const Unit& u, int wr, int wc, int fr, int fq) const {
        const int row0 = u.pm * BM + wr * 64 + fr, col0 = u.pn * BM + wc * 32 + 8 * fq;
        if (u.z == 1) { put<0>(acc, O1, ldc1, row0, col0, nullptr); return; }
        const int t = u.pn;
        if (t < 8 || (t >= 20 && t < 28)) norms(acc, u, wc, fr + 16 * fq);
        const bool is_silu = (t >= 12 && t < 16) || (t >= 32 && t < 36) || (t >= 40 && t < 44);
        if (t >= gate_tile0 && t < 68) put<2>(acc, O, ldc, row0, col0, bgate + (col0 - gate_tile0 * BM));
        else if (is_silu) put<1>(acc, O, ldc, row0, col0, nullptr);
        else put<0>(acc, O, ldc, row0, col0, nullptr);
    }
};
struct EpiMerge {
    static constexpr bool PERM = true, AFTER_DRAIN = false, KEEP_ACC = true, I8 = false; typedef f32x4 acc_t;
    const bf16_t* G; int ldg;
    bf16_t* O; int ldc;
    __device__ __forceinline__ static void unpack8(const u32x4 gw, f32x4& g0, f32x4& g1) {
        g0[0] = __uint_as_float(gw.x << 16); g0[1] = __uint_as_float(gw.x & 0xffff0000u); g0[2] = __uint_as_float(gw.y << 16); g0[3] = __uint_as_float(gw.y & 0xffff0000u);
        g1[0] = __uint_as_float(gw.z << 16); g1[1] = __uint_as_float(gw.z & 0xffff0000u); g1[2] = __uint_as_float(gw.w << 16); g1[3] = __uint_as_float(gw.w & 0xffff0000u); }
    __device__ __forceinline__ void operator()(f32x4 (&acc)[2][2][4][2], const Unit& u, int wr, int wc, int fr, int fq) const {
        const int row0 = u.pm * BM + wr * 64 + fr, col0 = u.pn * BM + wc * 32 + 8 * fq;
#pragma unroll
        for (int ai = 0; ai < 2; ++ai) {
            u32x4 ga[4][2], gb[4][2];
#pragma unroll
            for (int m = 0; m < 4; ++m)
#pragma unroll
                for (int bj = 0; bj < 2; ++bj) { const bf16_t* gp = G + (size_t)(row0 + ai * HALF + m * 16) * ldg + (size_t)u.z * 2048 + col0 + bj * HALF;
                    ga[m][bj] = *(const u32x4*)gp; gb[m][bj] = (u.z < 2) ? *(const u32x4*)(gp + 2048) : (u32x4){0u, 0u, 0u, 0u}; }
#pragma unroll
            for (int m = 0; m < 4; ++m) { const size_t row = (size_t)(row0 + ai * HALF + m * 16);
#pragma unroll
                for (int bj = 0; bj < 2; ++bj) { const int col = col0 + bj * HALF;
                    f32x4 a0, a1; unpack8(ga[m][bj], a0, a1);
                    f32x4 r0, r1;
                    if (u.z < 2) { f32x4 n0, n1; unpack8(gb[m][bj], n0, n1);
#pragma unroll
                        for (int e = 0; e < 4; ++e) { const float d0 = fmaxf(n0[e], 1e-30f), d1 = fmaxf(n1[e], 1e-30f);
                            const float x0 = (u.z == 0) ? a0[e] : fmaxf(a0[e], 1e-30f), x1 = (u.z == 0) ? a1[e] : fmaxf(a1[e], 1e-30f);
                            r0[e] = x0 * __builtin_amdgcn_rcpf(d0); r1[e] = x1 * __builtin_amdgcn_rcpf(d1); }
                        acc[ai][bj][m][0] *= r0; acc[ai][bj][m][1] *= r1;
                    } else {
#pragma unroll
                        for (int e = 0; e < 4; ++e) { r0[e] = fmaxf(a0[e], 1e-30f); r1[e] = fmaxf(a1[e], 1e-30f); }
                        const f32x4 v0 = acc[ai][bj][m][0] * r0, v1 = acc[ai][bj][m][1] * r1;
                        u32x4 w; w.x = cvt_pk_bf16(v0[0], v0[1]); w.y = cvt_pk_bf16(v0[2], v0[3]); w.z = cvt_pk_bf16(v1[0], v1[1]); w.w = cvt_pk_bf16(v1[2], v1[3]);
                        *(u32x4*)(O + row * ldc + col) = w;
                        acc[ai][bj][m][0] = (f32x4){0.f, 0.f, 0.f, 0.f}; acc[ai][bj][m][1] = (f32x4){0.f, 0.f, 0.f, 0.f}; } } }
        }
    }
};
struct EpiOut {
    static constexpr bool PERM = false, AFTER_DRAIN = false, KEEP_ACC = false, I8 = false; typedef f32x4 acc_t;
    const float* X; float* Y; int ldc; float* part; int M;
    __device__ __forceinline__ void operator()(const f32x4 (&acc)[2][2][4][2], const Unit& u, int wr, int wc, int fr, int fq) const {
        const int row0 = u.pm * BM + wr * 64 + fr, col0 = u.pn * BM + wc * 32 + 4 * fq;
#pragma unroll
        for (int ai = 0; ai < 2; ++ai) {
            f32x4 xv[4][2][2];
#pragma unroll
            for (int m = 0; m < 4; ++m)
#pragma unroll
                for (int bj = 0; bj < 2; ++bj)
#pragma unroll
                    for (int n = 0; n < 2; ++n) xv[m][bj][n] = *(const f32x4*)(X + (size_t)(row0 + ai * HALF + m * 16) * ldc + col0 + bj * HALF + n * 16);
#pragma unroll
            for (int m = 0; m < 4; ++m) { const size_t row = (size_t)(row0 + ai * HALF + m * 16); float ss = 0.f;
#pragma unroll
                for (int bj = 0; bj < 2; ++bj)
#pragma unroll
                    for (int n = 0; n < 2; ++n) { const size_t off = row * ldc + col0 + bj * HALF + n * 16;
                        const f32x4 y = xv[m][bj][n] + acc[ai][bj][m][n]; *(f32x4*)(Y + off) = y;
                        ss += (y[0] * y[0] + y[1] * y[1]) + (y[2] * y[2] + y[3] * y[3]); }
                ss += __shfl_xor(ss, 16); ss += __shfl_xor(ss, 32);
                if (fq == 0) part[(size_t)(u.pn * 4 + wc) * M + row] = ss; }
        }
    }
};
struct EpiProj8 {
    static constexpr bool PERM = true, AFTER_DRAIN = false, KEEP_ACC = false, I8 = true; typedef i32x4 acc_t;
    bf16_t* O; int ldc; const float* bgate; int gate_tile0; unsigned* nslot; const float* sA; const float* sB;
    template <int MODE, bool NORMS> __device__ __forceinline__ void put(const i32x4 (&acc)[2][2][4][2], const Unit& u, int row0, int col0, int wc, int lane) const {
        f32x4 bv[2][2], cs[2][2]; float rs[2][4];
#pragma unroll
        for (int bj = 0; bj < 2; ++bj)
#pragma unroll
            for (int n = 0; n < 2; ++n) { cs[bj][n] = *(const f32x4*)(sB + col0 + bj * HALF + 4 * n) * (1.f / 127.f);
                bv[bj][n] = (MODE == 2) ? *(const f32x4*)(bgate + (col0 - gate_tile0 * BM) + bj * HALF + 4 * n) : (f32x4){0.f, 0.f, 0.f, 0.f}; }
#pragma unroll
        for (int ai = 0; ai < 2; ++ai)
#pragma unroll
            for (int m = 0; m < 4; ++m) rs[ai][m] = sA[row0 + ai * HALF + m * 16];
        float wm[2] = {0.f, 0.f};
#pragma unroll
        for (int ai = 0; ai < 2; ++ai)
#pragma unroll
            for (int m = 0; m < 4; ++m) { bf16_t* rowp = O + (size_t)(row0 + ai * HALF + m * 16) * ldc + col0;
#pragma unroll
                for (int bj = 0; bj < 2; ++bj) { f32x4 v0, v1;
#pragma unroll
                    for (int e = 0; e < 4; ++e) { v0[e] = (float)acc[ai][bj][m][0][e] * (rs[ai][m] * cs[bj][0][e]); v1[e] = (float)acc[ai][bj][m][1][e] * (rs[ai][m] * cs[bj][1][e]); }
                    if (NORMS) { float sq = (v0[0] * v0[0] + v0[1] * v0[1]) + (v0[2] * v0[2] + v0[3] * v0[3]) + (v1[0] * v1[0] + v1[1] * v1[1]) + (v1[2] * v1[2] + v1[3] * v1[3]);
                        sq += __shfl_xor(sq, 16); sq += __shfl_xor(sq, 32); wm[bj] = fmaxf(wm[bj], sq); }
#pragma unroll
                    for (int e = 0; e < 4; ++e) { v0[e] = act_<MODE>(v0[e], bv[bj][0][e]); v1[e] = act_<MODE>(v1[e], bv[bj][1][e]); }
                    u32x4 w; w.x = cvt_pk_bf16(v0[0], v0[1]); w.y = cvt_pk_bf16(v0[2], v0[3]); w.z = cvt_pk_bf16(v1[0], v1[1]); w.w = cvt_pk_bf16(v1[2], v1[3]);
                    *(u32x4*)(rowp + bj * HALF) = w; } }
        if (NORMS) {
#pragma unroll
            for (int bj = 0; bj < 2; ++bj) { float v = wm[bj]; v = fmaxf(v, __shfl_xor(v, 1)); v = fmaxf(v, __shfl_xor(v, 2)); v = fmaxf(v, __shfl_xor(v, 4)); v = fmaxf(v, __shfl_xor(v, 8));
                if (lane == 0) atomicMax(nslot + (u.pn * 2 + bj) * 4 + wc, __float_as_uint(v)); } }
    }
    __device__ __forceinline__ void operator()(const i32x4 (&acc)[2][2][4][2], const Unit& u, int wr, int wc, int fr, int fq) const {
        const int row0 = u.pm * BM + wr * 64 + fr, col0 = u.pn * BM + wc * 32 + 8 * fq, t = u.pn, lane = fr + 16 * fq;
        const bool is_silu = (t >= 12 && t < 16) || (t >= 32 && t < 36) || (t >= 40 && t < 44);
        if (t >= gate_tile0 && t < 68) put<2, false>(acc, u, row0, col0, wc, lane);
        else if (is_silu) put<1, false>(acc, u, row0, col0, wc, lane);
        else if (t < 8 || (t >= 20 && t < 28)) put<0, true>(acc, u, row0, col0, wc, lane);
        else put<0, false>(acc, u, row0, col0, wc, lane);
    }
};
struct ProjOrder8 {
    StaticOrder so;
    __device__ void init(int M, int G, int c) { so.init(M, 64 * BM, G, c); }
    __device__ bool next(int i, Unit& u) const { if (!so.next(i, u)) return false; if (u.pn >= 16) u.pn += 4; return true; }
    __device__ __forceinline__ void a_ready(const Unit&) const {}
    __device__ __forceinline__ void done(const Unit&) const {}
};
struct ProjOrderB {
    int G, c;
    __device__ void init(int G_, int c_) { G = G_; c = c_; }
    __device__ bool next(int i, Unit& u) const { const int L = i * G + c; if (L >= 168) return false;
        if (L < 160) { const int t = L >> 5; u.pm = L & 31; u.pn = (t < 4) ? 16 + t : 68; u.z = 0; } else { u.pm = 0; u.pn = L - 160; u.z = 1; } return true; }
    __device__ __forceinline__ void a_ready(const Unit&) const {}
    __device__ __forceinline__ void done(const Unit&) const {}
};
struct ProjOrder {
    StaticOrder so; int nmain, extra;
    __device__ void init(int M, int N, int G, int c) { so.init(M, N, G, c); nmain = (so.nwg - c + G - 1) / G; extra = (c >= G - 8) ? c - (G - 8) : -1; }
    __device__ bool next(int i, Unit& u) const {
        if (i < nmain) return so.next(i, u);
        if (i == nmain && extra >= 0) { u.pm = 0; u.pn = extra; u.z = 1; return true; }
        return false;
    }
    __device__ __forceinline__ void a_ready(const Unit&) const {}
    __device__ __forceinline__ void done(const Unit&) const {}
};
struct MergeOrder {
    StaticOrder so;
    __device__ void init(int M, int N, int G, int c) { so.init(M, N, G, c); }
    __device__ bool next(int i, Unit& u) const { if (i >= 3) return false; if (!so.next(0, u)) return false; u.z = i; return true; }
    __device__ __forceinline__ void a_ready(const Unit&) const {}
    __device__ __forceinline__ void done(const Unit&) const {}
};

template <class Epi, class Sched, bool ALIGN_EPI = false, bool SP2 = false>
__device__ __forceinline__ void gemm_phase(PG8_LAS unsigned char* lds, const Gemm g, const Sched& S, const Epi& E, const int wid  ) {
    const int lane = lane_id_v(), tid = wid * 64 + lane, wr = wid >> 2, wc = wid & 3, fr = lane & 15, fq = lane >> 4;
    const int K = g.K, nt = K / BK;
    unsigned voffA[2], voffB[2];
#pragma unroll
    for (int i = 0; i < 2; ++i) { int R, C; stage_rc(tid * 16 + i * 8192, R, C); const int Rb = Epi::PERM ? ((R & ~31) + perm32(R & 31)) : R;
        voffA[i] = (unsigned)(R * K + C) * 2u; voffB[i] = (unsigned)(Rb * K + C) * 2u; }
    const size_t kstep = (size_t)(BK * 2);
    const size_t hstep = (size_t)HALF * K * 2;
    const size_t tstep = 2 * hstep;
    const unsigned ldsw = (unsigned)wid * 1024u;
    const int aoff = lds_byte(wr * 64 + fr, fq * 8), boff = lds_byte(wc * 32 + fr, fq * 8);
#define PG8_SA(b, h) (((b) * 2 + (h)) * HTB)
#define PG8_SB(b, h) ((4 + (b) * 2 + (h)) * HTB)
#define PG8_STAGE(bufoff, gbase, voff) do { _Pragma("unroll") for (int _i = 0; _i < 2; ++_i) \
        __builtin_amdgcn_global_load_lds((const unsigned*)((const char*)(gbase) + (voff)[_i]), (PG8_LAS unsigned*)(lds + (bufoff) + ldsw + _i * 8192), 16, 0, 0); } while (0)
#define PG8_LDA(dst, b, h) do { _Pragma("unroll") for (int m = 0; m < 4; ++m) _Pragma("unroll") for (int k = 0; k < 2; ++k) dst[m][k] = *(const PG8_LAS bf16x8*)(lds + PG8_SA(b, h) + aoff + m * 2048 + k * 1024); } while (0)
#define PG8_LDB(dst, b, h) do { _Pragma("unroll") for (int n = 0; n < 2; ++n) _Pragma("unroll") for (int k = 0; k < 2; ++k) dst[n][k] = *(const PG8_LAS bf16x8*)(lds + PG8_SB(b, h) + boff + n * 2048 + k * 1024); } while (0)
#define PG8_MMA(ai, bj, At, Bt) do { __builtin_amdgcn_s_setprio(1); _Pragma("unroll") for (int m = 0; m < 4; ++m) _Pragma("unroll") for (int n = 0; n < 2; ++n) _Pragma("unroll") for (int k = 0; k < 2; ++k) \
        { if constexpr (Epi::I8) acc[ai][bj][m][n] = __builtin_amdgcn_mfma_i32_16x16x64_i8(__builtin_bit_cast(i32x4, Bt[n][k]), __builtin_bit_cast(i32x4, At[m][k]), acc[ai][bj][m][n], 0, 0, 0); \
          else acc[ai][bj][m][n] = __builtin_amdgcn_mfma_f32_16x16x32_bf16(Bt[n][k], At[m][k], acc[ai][bj][m][n], 0, 0, 0); } __builtin_amdgcn_s_setprio(0); } while (0)
#define PG8_WAIT_V(n) asm volatile("s_waitcnt vmcnt(" #n ")" ::: "memory")
#define PG8_WAIT_L(n) asm volatile("s_waitcnt lgkmcnt(" #n ")" ::: "memory")
#define PG8_BAR __builtin_amdgcn_s_barrier()
#define PG8_SCHED __builtin_amdgcn_sched_barrier(0)
    Unit cur, nxt; int ui = 0;
    if (!S.next(0, cur)) return;
    typedef typename Epi::acc_t acc_t;
    acc_t acc[2][2][4][2];
#pragma unroll
    for (int a = 0; a < 2; ++a)
#pragma unroll
        for (int b = 0; b < 2; ++b)
#pragma unroll
            for (int m = 0; m < 4; ++m)
#pragma unroll
                for (int n = 0; n < 2; ++n) acc[a][b][m][n] = acc_t{};
    bf16x8 At[4][2], B0[2][2], B1[2][2];
    const char* cA = (const char*)g.A + (long)cur.z * g.zA + (size_t)cur.pm * tstep; const char* cB = (const char*)g.Bt + (long)cur.z * g.zB + (size_t)cur.pn * tstep;
    S.a_ready(cur);
    if constexpr (SP2) {
        PG8_STAGE(PG8_SB(0, 0), cB, voffB); PG8_STAGE(PG8_SB(0, 1), cB + hstep, voffB); PG8_STAGE(PG8_SA(0, 0), cA, voffA); PG8_STAGE(PG8_SA(0, 1), cA + hstep, voffA);
        if (wr == 1) PG8_BAR;
        PG8_WAIT_V(2); PG8_BAR;
        PG8_STAGE(PG8_SB(1, 0), cB + kstep, voffB); PG8_STAGE(PG8_SA(1, 0), cA + kstep, voffA); PG8_STAGE(PG8_SB(1, 1), cB + hstep + kstep, voffB);
        PG8_WAIT_V(6); PG8_BAR;
    } else {
        PG8_STAGE(PG8_SB(0, 0), cB, voffB); PG8_STAGE(PG8_SA(0, 0), cA, voffA); PG8_STAGE(PG8_SB(0, 1), cB + hstep, voffB); PG8_STAGE(PG8_SA(0, 1), cA + hstep, voffA);
        if (wr == 1) PG8_BAR;
        PG8_WAIT_V(4); PG8_BAR;
        PG8_STAGE(PG8_SB(1, 0), cB + kstep, voffB); PG8_STAGE(PG8_SA(1, 0), cA + kstep, voffA); PG8_STAGE(PG8_SB(1, 1), cB + hstep + kstep, voffB);
        PG8_WAIT_V(6); PG8_BAR;
    }
    for (;;) {
        const bool has_next = S.next(ui + 1, nxt);
        const char* nA = has_next ? (const char*)g.A + (long)nxt.z * g.zA + (size_t)nxt.pm * tstep : cA; const char* nB = has_next ? (const char*)g.Bt + (long)nxt.z * g.zB + (size_t)nxt.pn * tstep : cB;
        for (int t = 0; t < nt; t += 2) {
            const bool last = (t == nt - 2);
            const char* a1 = cA + (size_t)(t + 1) * kstep;
            const char* a2 = last ? nA : cA + (size_t)(t + 2) * kstep; const char* b2 = last ? nB : cB + (size_t)(t + 2) * kstep;
            const char* a3 = a2 + kstep; const char* b3 = b2 + kstep;
            if (last && has_next) S.a_ready(nxt);
            if constexpr (SP2) {
            PG8_LDB(B0, 0, 0); PG8_LDB(B1, 0, 1); PG8_SCHED; PG8_LDA(At, 0, 0); PG8_STAGE(PG8_SA(1, 1), a1 + hstep, voffA);
            PG8_WAIT_V(8); PG8_WAIT_L(0); PG8_BAR; PG8_MMA(0, 0, At, B0); PG8_MMA(0, 1, At, B1); PG8_BAR; PG8_SCHED;
            PG8_LDA(At, 0, 1); PG8_STAGE(PG8_SB(0, 0), b2, voffB); PG8_STAGE(PG8_SB(0, 1), b2 + hstep, voffB); PG8_STAGE(PG8_SA(0, 0), a2, voffA);
            PG8_WAIT_V(8); PG8_WAIT_L(0); PG8_BAR; PG8_MMA(1, 0, At, B0); PG8_MMA(1, 1, At, B1); PG8_BAR; PG8_SCHED;
            PG8_LDB(B0, 1, 0); PG8_LDB(B1, 1, 1); PG8_SCHED; PG8_LDA(At, 1, 0); PG8_STAGE(PG8_SA(0, 1), a2 + hstep, voffA);
            PG8_WAIT_V(8); PG8_WAIT_L(0); PG8_BAR; PG8_MMA(0, 0, At, B0); PG8_MMA(0, 1, At, B1); PG8_BAR; PG8_SCHED;
            PG8_LDA(At, 1, 1); PG8_STAGE(PG8_SB(1, 0), b3, voffB); PG8_STAGE(PG8_SB(1, 1), b3 + hstep, voffB); PG8_STAGE(PG8_SA(1, 0), a3, voffA);
            PG8_WAIT_V(8); PG8_WAIT_L(0); PG8_BAR; PG8_MMA(1, 0, At, B0); PG8_MMA(1, 1, At, B1); PG8_BAR; PG8_SCHED;
            } else {
            PG8_LDB(B0, 0, 0); PG8_SCHED; PG8_LDA(At, 0, 0); PG8_STAGE(PG8_SA(1, 1), a1 + hstep, voffA);
            PG8_WAIT_L(8); PG8_BAR; PG8_WAIT_L(0); PG8_MMA(0, 0, At, B0); PG8_BAR; PG8_SCHED;
            PG8_LDB(B1, 0, 1); PG8_STAGE(PG8_SB(0, 0), b2, voffB);
            PG8_BAR; PG8_WAIT_L(0); PG8_MMA(0, 1, At, B1); PG8_BAR;
            PG8_LDA(At, 0, 1); PG8_STAGE(PG8_SA(0, 0), a2, voffA);
            PG8_BAR; PG8_WAIT_L(0); PG8_MMA(1, 0, At, B0); PG8_BAR; PG8_SCHED;
            PG8_STAGE(PG8_SB(0, 1), b2 + hstep, voffB);
            PG8_WAIT_V(6); PG8_BAR; PG8_MMA(1, 1, At, B1); PG8_BAR;
            PG8_LDB(B0, 1, 0); PG8_SCHED; PG8_LDA(At, 1, 0); PG8_STAGE(PG8_SA(0, 1), a2 + hstep, voffA);
            PG8_WAIT_L(8); PG8_BAR; PG8_WAIT_L(0); PG8_MMA(0, 0, At, B0); PG8_BAR; PG8_SCHED;
            PG8_LDB(B1, 1, 1); PG8_STAGE(PG8_SB(1, 0), b3, voffB);
            PG8_BAR; PG8_WAIT_L(0); PG8_MMA(0, 1, At, B1); PG8_BAR;
            PG8_LDA(At, 1, 1); PG8_STAGE(PG8_SA(1, 0), a3, voffA);
            PG8_BAR; PG8_WAIT_L(0); PG8_MMA(1, 0, At, B0); PG8_BAR; PG8_SCHED;
            PG8_STAGE(PG8_SB(1, 1), b3 + hstep, voffB);
            PG8_WAIT_V(6); PG8_BAR; PG8_MMA(1, 1, At, B1); PG8_BAR;
            }
        }
        if constexpr (ALIGN_EPI) { if (wr == 0) PG8_BAR; }
        if constexpr (!Epi::AFTER_DRAIN) { E(acc, cur, wr, wc, fr, fq); S.done(cur); }
        if (!has_next) break;
        if constexpr (!Epi::KEEP_ACC) {
#pragma unroll
        for (int a = 0; a < 2; ++a)
#pragma unroll
            for (int b = 0; b < 2; ++b)
#pragma unroll
                for (int m = 0; m < 4; ++m)
#pragma unroll
                    for (int n = 0; n < 2; ++n) acc[a][b][m][n] = acc_t{};
        }
        cur = nxt; cA = nA; cB = nB; ++ui;
        if constexpr (ALIGN_EPI) { if (wr == 1) PG8_BAR; }
    }
    PG8_WAIT_V(0);
    if constexpr (!ALIGN_EPI) { if (wr == 0) PG8_BAR; }
    PG8_BAR;
    if constexpr (Epi::AFTER_DRAIN) { E.fused(acc, cur, wr, wc, fr, fq, lds, wid, lane); S.done(cur); }
#undef PG8_SA
#undef PG8_SB
#undef PG8_STAGE
#undef PG8_LDA
#undef PG8_LDB
#undef PG8_MMA
#undef PG8_WAIT_V
#undef PG8_WAIT_L
#undef PG8_BAR
#undef PG8_SCHED
}
}

constexpr int S = 8192, DM = 2048, DIN = 17488, NPAD = 17664, NMEM = 256;
constexpr int C_QA = 0, C_KA = 1024, C_VA = 2048, C_ZA = 3072, C_QI = 4096, C_QB = 5120, C_KB = 6144, C_VB = 7168, C_ZB = 8192, C_QM = 9216, C_ZM = 10240, C_GL = 11264, C_KI = 17408, C_WI = 17472;
constexpr int TOPK = 256;
constexpr float RMS_EPS = 1e-6f;
constexpr size_t MiB = 1u << 20;
constexpr size_t WS_CTL = 0;
constexpr size_t WS_WTIN = 1 * MiB;
constexpr size_t WS_U = 1 * MiB;
constexpr size_t WS_WTMKV = 70 * MiB;
constexpr size_t WS_WTBR = 78 * MiB;
constexpr size_t WS_WTOUT = 90 * MiB;
constexpr size_t WS_MEMN = 98 * MiB;
constexpr size_t WS_MKV = 99 * MiB;
constexpr size_t WS_PROJ = 100 * MiB;
constexpr size_t WS_SC = 376 * MiB;
constexpr size_t WS_MERGED = 376 * MiB;
constexpr size_t WS_H = 376 * MiB;
constexpr size_t WS_W8 = 408 * MiB;
constexpr size_t WS_H8 = 444 * MiB;
constexpr size_t WS_SA = 461 * MiB;
constexpr size_t WS_SB = 462 * MiB;
constexpr size_t WS_SEL = 508 * MiB;
constexpr size_t WS_PART = 516 * MiB;
constexpr size_t WS_END = 517 * MiB;

typedef unsigned short bf16_t;
typedef unsigned u32x4 __attribute__((ext_vector_type(4)));
typedef unsigned u32x2 __attribute__((ext_vector_type(2)));
typedef float f32x4 __attribute__((ext_vector_type(4)));
#define LAS __attribute__((address_space(3)))
__device__ __forceinline__ float bf2f(unsigned short u) { return __uint_as_float((unsigned)u << 16); }
__device__ __forceinline__ float bflo(unsigned w) { return __uint_as_float(w << 16); }
__device__ __forceinline__ float bfhi(unsigned w) { return __uint_as_float(w & 0xffff0000u); }
__device__ __forceinline__ unsigned f2bf(float f) { unsigned u = __float_as_uint(f); return (u + 0x7fffu + ((u >> 16) & 1u)) >> 16; }
__device__ __forceinline__ unsigned pk2(float lo, float hi) { return f2bf(lo) | (f2bf(hi) << 16); }
__device__ __forceinline__ float wave_sum(float v) {
#pragma unroll
    for (int o = 1; o < 64; o <<= 1) v += __shfl_xor(v, o);
    return v;
}
__device__ __forceinline__ size_t sc_off(int r) { const size_t i = (size_t)(r >> 8); return 65536ull * (i * (i + 1) / 2) + (size_t)(r & 255) * 256ull * (i + 1); }

struct Args { const float* in[17]; float* out; unsigned char* ws; int ph_lo, ph_hi; };

template <bool MAPIN>
__device__ __forceinline__ void transpose_item(const float* __restrict__ W, int K, int srcN, bf16_t* WT, LAS float* scr, int item, int ndst, int lane) {
    const int nblk = ndst / 32, kb = item / nblk, nb = item % nblk, k0 = 64 * kb, n0 = 32 * nb;
    const int n = n0 + (lane & 31);
    int src = n;
    if (MAPIN) { src = (n < 5120) ? n : (n < 17408) ? n + 80 : (n < 17488) ? n - 17408 + 5120 : -1; }
    float tv[32];
#pragma unroll
    for (int i = 0; i < 32; ++i) { const int kk = 2 * i + (lane >> 5); tv[i] = (src >= 0) ? W[(size_t)(k0 + kk) * srcN + src] : 0.f; }
#pragma unroll
    for (int i = 0; i < 32; ++i) { const int kk = 2 * i + (lane >> 5); scr[kk * 33 + (lane & 31)] = tv[i]; }
    asm volatile("s_waitcnt lgkmcnt(0)" ::: "memory");
    const int c = lane & 7;
#pragma unroll
    for (int j = 0; j < 4; ++j) { const int nn = (lane >> 3) + 8 * j; const LAS float* s = scr + (8 * c) * 33 + nn;
        u32x4 o; o.x = pk2(s[0 * 33], s[1 * 33]); o.y = pk2(s[2 * 33], s[3 * 33]); o.z = pk2(s[4 * 33], s[5 * 33]); o.w = pk2(s[6 * 33], s[7 * 33]);
        *(u32x4*)(WT + (size_t)(n0 + nn) * K + k0 + 8 * c) = o; }
    asm volatile("s_waitcnt lgkmcnt(0)" ::: "memory");
}
__device__ __forceinline__ void rms_row_to_bf16(const float* __restrict__ xrow, const float* __restrict__ g, bf16_t* orow, int lane) {
    const f32x4* xr = (const f32x4*)xrow + lane; const f32x4* gr = (const f32x4*)g + lane;
    f32x4 v[8]; float s = 0.f;
#pragma unroll
    for (int j = 0; j < 8; ++j) { v[j] = xr[64 * j]; s += (v[j].x * v[j].x + v[j].y * v[j].y) + (v[j].z * v[j].z + v[j].w * v[j].w); }
    const float rs = 1.0f / sqrtf(wave_sum(s) * (1.f / DM) + RMS_EPS);
    u32x2* o8 = (u32x2*)orow + lane;
#pragma unroll
    for (int j = 0; j < 8; ++j) { const f32x4 gg = gr[64 * j]; u32x2 w; w.x = pk2(v[j].x * rs * gg.x, v[j].y * rs * gg.y); w.y = pk2(v[j].z * rs * gg.z, v[j].w * rs * gg.w); o8[64 * j] = w; }
}
__device__ __forceinline__ void colmax_item(const float* __restrict__ W, unsigned* CM, int item, int lane) {
    const int nblk = NPAD / 32, kb = item / nblk, nb = item % nblk, k0 = 64 * kb, n = 32 * nb + (lane & 31);
    const int src = (n < 5120) ? n : (n < 17408) ? n + 80 : (n < 17488) ? n - 17408 + 5120 : -1;
    if (n >= 4096 && n < 5120) return;
    if (n >= 17408) return;
    float tv[32];
#pragma unroll
    for (int i = 0; i < 32; ++i) { const int kk = 2 * i + (lane >> 5); tv[i] = (src >= 0) ? W[(size_t)(k0 + kk) * DIN + src] : 0.f; }
    float m = 0.f;
#pragma unroll
    for (int i = 0; i < 32; ++i) m = fmaxf(m, fabsf(tv[i]));
    m = fmaxf(m, __shfl_xor(m, 32));
    if (lane < 32) atomicMax(CM + n, __float_as_uint(m));
}
__device__ __forceinline__ void quant_item(const float* __restrict__ W, const unsigned* CM, signed char* W8, bf16_t* WT, LAS float* scr, int item, int lane) {
    const int nblk = NPAD / 32, kb = item / nblk, nb = item % nblk, k0 = 64 * kb, n0 = 32 * nb, n = n0 + (lane & 31);
    const int src = (n < 5120) ? n : (n < 17408) ? n + 80 : (n < 17488) ? n - 17408 + 5120 : -1;
    const bool isb = (n0 >= 4096 && n0 < 5120) || n0 >= 17408;
    float tv[32];
#pragma unroll
    for (int i = 0; i < 32; ++i) { const int kk = 2 * i + (lane >> 5); tv[i] = (src >= 0) ? W[(size_t)(k0 + kk) * DIN + src] : 0.f; }
    float q = 1.f;
    if (!isb) { const float cm = __uint_as_float(__hip_atomic_load(CM + n, __ATOMIC_RELAXED, __HIP_MEMORY_SCOPE_AGENT)); q = cm > 0.f ? 127.f / cm : 0.f; }
#pragma unroll
    for (int i = 0; i < 32; ++i) { const int kk = 2 * i + (lane >> 5); scr[kk * 33 + (lane & 31)] = isb ? tv[i] : rintf(tv[i] * q); }
    asm volatile("s_waitcnt lgkmcnt(0)" ::: "memory");
    const int c = lane & 7;
#pragma unroll
    for (int j = 0; j < 4; ++j) { const int nn = (lane >> 3) + 8 * j; const LAS float* p = scr + (8 * c) * 33 + nn;
        if (isb) { u32x4 o; o.x = pk2(p[0 * 33], p[1 * 33]); o.y = pk2(p[2 * 33], p[3 * 33]); o.z = pk2(p[4 * 33], p[5 * 33]); o.w = pk2(p[6 * 33], p[7 * 33]);
            *(u32x4*)(WT + (size_t)(n0 + nn) * DM + k0 + 8 * c) = o; }
        else { u32x2 o;
            o.x = ((unsigned)(int)p[0 * 33] & 0xffu) | (((unsigned)(int)p[1 * 33] & 0xffu) << 8) | (((unsigned)(int)p[2 * 33] & 0xffu) << 16) | (((unsigned)(int)p[3 * 33] & 0xffu) << 24);
            o.y = ((unsigned)(int)p[4 * 33] & 0xffu) | (((unsigned)(int)p[5 * 33] & 0xffu) << 8) | (((unsigned)(int)p[6 * 33] & 0xffu) << 16) | (((unsigned)(int)p[7 * 33] & 0xffu) << 24);
            *(u32x2*)(W8 + (size_t)(n0 + nn) * DM + k0 + 8 * c) = o; } }
    asm volatile("s_waitcnt lgkmcnt(0)" ::: "memory");
}
__device__ __forceinline__ void rms_row_quant(const float* __restrict__ xrow, const float* __restrict__ g, bf16_t* orow, signed char* o8row, float* sA, int lane) {
    const f32x4* xr = (const f32x4*)xrow + lane; const f32x4* gr = (const f32x4*)g + lane;
    f32x4 v[8]; float s = 0.f;
#pragma unroll
    for (int j = 0; j < 8; ++j) { v[j] = xr[64 * j]; s += (v[j].x * v[j].x + v[j].y * v[j].y) + (v[j].z * v[j].z + v[j].w * v[j].w); }
    const float rs = 1.0f / sqrtf(wave_sum(s) * (1.f / DM) + RMS_EPS);
    float mx = 0.f;
#pragma unroll
    for (int j = 0; j < 8; ++j) { const f32x4 gg = gr[64 * j]; v[j].x = v[j].x * rs * gg.x; v[j].y = v[j].y * rs * gg.y; v[j].z = v[j].z * rs * gg.z; v[j].w = v[j].w * rs * gg.w;
        mx = fmaxf(mx, fmaxf(fmaxf(fabsf(v[j].x), fabsf(v[j].y)), fmaxf(fabsf(v[j].z), fabsf(v[j].w)))); }
#pragma unroll
    for (int o = 1; o < 64; o <<= 1) mx = fmaxf(mx, __shfl_xor(mx, o));
    const float q = mx > 0.f ? 127.f / mx : 0.f;
    if (lane == 0) *sA = mx * (1.f / 127.f);
    u32x2* o16 = (u32x2*)orow + lane; unsigned* o8 = (unsigned*)o8row + lane;
#pragma unroll
    for (int j = 0; j < 8; ++j) { u32x2 w; w.x = pk2(v[j].x, v[j].y); w.y = pk2(v[j].z, v[j].w); o16[64 * j] = w;
        o8[64 * j] = ((unsigned)(int)rintf(v[j].x * q) & 0xffu) | (((unsigned)(int)rintf(v[j].y * q) & 0xffu) << 8) | (((unsigned)(int)rintf(v[j].z * q) & 0xffu) << 16) | (((unsigned)(int)rintf(v[j].w * q) & 0xffu) << 24); }
}
__device__ __forceinline__ void p0_prologue_a(const Args& a, LAS unsigned char* lds, int blk, int nblk, const int wave) {
    const int lane = lane_id_v(), tid = wave * 64 + lane;
    LAS float* scr = (LAS float*)(lds + wave * 16384);
    const int gw = blk * 8 + wave, NGW = nblk * 8;
    unsigned char* ws = a.ws;
    constexpr int I_IN = (DM / 64) * (NPAD / 32), I_MKV = (DM / 64) * (2048 / 32), I_BR = (1024 / 64) * (2048 / 32), I_OUT = (DM / 64) * (2048 / 32);
    constexpr int NITEMS = I_IN + I_MKV + 3 * I_BR + I_OUT;
    for (int it = gw; it < NITEMS; it += NGW) {
        int r = it;
        if (r < I_IN) { colmax_item(a.in[3], (unsigned*)(ws + WS_SB), r, lane); continue; } r -= I_IN;
        if (r < I_MKV) { transpose_item<false>(a.in[11], DM, 2048, (bf16_t*)(ws + WS_WTMKV), scr, r, 2048, lane); continue; } r -= I_MKV;
        if (r < 3 * I_BR) { const int z = r / I_BR; transpose_item<false>(a.in[12 + z], 1024, 2048, (bf16_t*)(ws + WS_WTBR) + (size_t)z * 2048 * 1024, scr, r % I_BR, 2048, lane); continue; } r -= 3 * I_BR;
        transpose_item<false>(a.in[15], DM, 2048, (bf16_t*)(ws + WS_WTOUT), scr, r, 2048, lane);
    }
    bf16_t* H = (bf16_t*)(ws + WS_H);
    for (int m = gw; m < S + NMEM; m += NGW) {
        if (m < S) rms_row_quant(a.in[0] + (size_t)m * DM, a.in[2], H + (size_t)m * DM, (signed char*)(ws + WS_H8) + (size_t)m * DM, (float*)(ws + WS_SA) + m, lane);
        else rms_row_to_bf16(a.in[1] + (size_t)(m - S) * DM, a.in[10], (bf16_t*)(ws + WS_MEMN) + (size_t)(m - S) * DM, lane);
    }
    if (blk == 0) { for (int i = tid; i < 640; i += 512) ((unsigned*)(ws + WS_CTL + 1024))[i] = 0u; }
    if (blk == 0 && wave == 0) {
        const float s1 = wave_sum(a.in[5][lane] * a.in[6][lane]), s2 = wave_sum(a.in[7][lane] * a.in[8][lane]);
        if (lane == 0) ((float*)(ws + WS_CTL))[0] = expf(s1) - expf(s2) + 0.2f;
    }
}
__device__ __forceinline__ void p0_prologue_b(const Args& a, LAS unsigned char* lds, int blk, int nblk, const int wave) {
    const int lane = lane_id_v();
    LAS float* scr = (LAS float*)(lds + wave * 16384);
    const int gw = blk * 8 + wave, NGW = nblk * 8;
    unsigned char* ws = a.ws;
    constexpr int I_IN = (DM / 64) * (NPAD / 32);
    for (int it = gw; it < I_IN; it += NGW) quant_item(a.in[3], (const unsigned*)(ws + WS_SB), (signed char*)(ws + WS_W8), (bf16_t*)(ws + WS_WTIN), scr, it, lane);
}

__device__ __forceinline__ void idx_scores_naive(const bf16_t* __restrict__ PROJ, float* SC, LAS unsigned char* lds, int blk, int nblk, const int wave) {
    const int lane = lane_id_v(), tid = wave * 64 + lane;
    LAS float* qs = (LAS float*)lds + wave * 1088;
    constexpr int NITEM = 128 * 129 / 2;
    for (int it = blk; it < NITEM; it += nblk) {
        int kb = 0, rem = it; while (rem >= 128 - kb) { rem -= 128 - kb; ++kb; }
        const int qc = kb + rem, s = 64 * kb + lane;
        float kreg[64];
        { const u32x4* kp = (const u32x4*)(PROJ + (size_t)s * NPAD + C_KI);
#pragma unroll
          for (int i = 0; i < 8; ++i) { const u32x4 w = kp[i]; kreg[8 * i + 0] = bflo(w.x); kreg[8 * i + 1] = bfhi(w.x); kreg[8 * i + 2] = bflo(w.y); kreg[8 * i + 3] = bfhi(w.y);
              kreg[8 * i + 4] = bflo(w.z); kreg[8 * i + 5] = bfhi(w.z); kreg[8 * i + 6] = bflo(w.w); kreg[8 * i + 7] = bfhi(w.w); } }
        for (int qq = 0; qq < 8; ++qq) {
            const int q = 64 * qc + wave * 8 + qq;
            { const u32x4* qp = (const u32x4*)(PROJ + (size_t)q * NPAD + C_QI) + 2 * lane;
              const u32x4 w0 = qp[0], w1 = qp[1];
              LAS f32x4* dst = (LAS f32x4*)(qs + 16 * lane);
              dst[0] = (f32x4){bflo(w0.x), bfhi(w0.x), bflo(w0.y), bfhi(w0.y)}; dst[1] = (f32x4){bflo(w0.z), bfhi(w0.z), bflo(w0.w), bfhi(w0.w)};
              dst[2] = (f32x4){bflo(w1.x), bfhi(w1.x), bflo(w1.y), bfhi(w1.y)}; dst[3] = (f32x4){bflo(w1.z), bfhi(w1.z), bflo(w1.w), bfhi(w1.w)};
              if (lane < 16) qs[1024 + lane] = bf2f(PROJ[(size_t)q * NPAD + C_WI + lane]) * 0.25f; }
            asm volatile("s_waitcnt lgkmcnt(0)" ::: "memory"); __builtin_amdgcn_wave_barrier();
            float score = 0.f;
            for (int j = 0; j < 16; ++j) {
                float acc = 0.f; const LAS f32x4* qj = (const LAS f32x4*)(qs + 64 * j);
#pragma unroll
                for (int d = 0; d < 16; ++d) { const f32x4 qv = qj[d]; acc += qv.x * kreg[4 * d] + qv.y * kreg[4 * d + 1] + qv.z * kreg[4 * d + 2] + qv.w * kreg[4 * d + 3]; }
                score += fmaxf(acc * 0.125f, 0.f) * qs[1024 + j];
            }
            if (s <= q) SC[sc_off(q) + s] = score;
            asm volatile("s_waitcnt lgkmcnt(0)" ::: "memory"); __builtin_amdgcn_wave_barrier();
        }
    }
}
__device__ __forceinline__ unsigned ordkey(float f) { const unsigned u = __float_as_uint(f); return (u & 0x80000000u) ? ~u : (u | 0x80000000u); }
template <int NR, int NL> __device__ __forceinline__ bool topk_row(const float* __restrict__ row, int n, int lane, LAS u32x4* xl, unsigned long long& w0, unsigned long long& w1, unsigned& Tout, int& need_out) {
#pragma unroll
    for (int q = 0; q < NL / 4; ++q) { u32x4 v;
#pragma unroll
        for (int e = 0; e < 4; ++e) { const int i = 4096 + (4 * q + e) * 64 + lane; v[e] = (ordkey(*(const float*)((const char*)row + 4u * (unsigned)min(i, n - 1))) >> 1) & (unsigned)((i - n) >> 31); }
        xl[q * 64 + lane] = v;
        if ((q & 3) == 3) __builtin_amdgcn_sched_barrier(0); }
    unsigned u[NR];
#pragma unroll
    for (int k = 0; k < NR; ++k) { const int i = k * 64 + lane; u[k] = (ordkey(*(const float*)((const char*)row + 4u * (unsigned)min(i, n - 1))) >> 1) & (unsigned)((i - n) >> 31);
        if ((k & 15) == 15) __builtin_amdgcn_sched_barrier(0); }
    unsigned T = 0u; bool cut = false;
    for (int bit = 30; bit >= 0; --bit) {
        const unsigned cand = T | (1u << bit); unsigned lt = 0u;
        asm volatile("" ::: "memory");
#pragma unroll
        for (int k = 0; k < NR; ++k) lt += (u[k] - cand) >> 31;
#pragma unroll
        for (int q = 0; q < NL / 4; ++q) { const u32x4 v = xl[q * 64 + lane]; lt += ((v[0] - cand) >> 31) + ((v[1] - cand) >> 31) + ((v[2] - cand) >> 31) + ((v[3] - cand) >> 31);
            if ((q & 3) == 3) __builtin_amdgcn_sched_barrier(0); }
#pragma unroll
        for (int o = 1; o < 64; o <<= 1) lt += __shfl_xor(lt, o);
        const int ge = (int)((NR + NL) * 64 - lt);
        if (ge >= TOPK) T = cand;
        if (ge == TOPK) { cut = true; break; }
    }
    unsigned c_hi = 0u, c_lt = 0u;
#pragma unroll
    for (int k = 0; k < NR; ++k) { c_hi += (T - u[k]) >> 31; c_lt += (u[k] - T) >> 31; }
#pragma unroll
    for (int q = 0; q < NL / 4; ++q) { const u32x4 v = xl[q * 64 + lane];
#pragma unroll
        for (int e = 0; e < 4; ++e) { c_hi += (T - v[e]) >> 31; c_lt += (v[e] - T) >> 31; } }
#pragma unroll
    for (int o = 1; o < 64; o <<= 1) { c_hi += __shfl_xor(c_hi, o); c_lt += __shfl_xor(c_lt, o); }
    const int need = TOPK - (int)c_hi, c_eq = (NR + NL) * 64 - (int)c_lt - (int)c_hi;
    Tout = T; need_out = need;
    if (!cut && c_eq != need) return false;
    int ln; asm volatile("v_mbcnt_lo_u32_b32 %0, -1, 0\n\tv_mbcnt_hi_u32_b32 %0, -1, %0" : "=v"(ln));
#pragma unroll
    for (int k = 0; k < NR; ++k) {
        const unsigned long long bs = __ballot(u[k] >= T);
        if (k == ln) w0 = bs;
        __builtin_amdgcn_sched_barrier(0); }
#pragma unroll
    for (int q = 0; q < NL / 4; ++q) { const u32x4 v = xl[q * 64 + lane];
#pragma unroll
        for (int e = 0; e < 4; ++e) { const unsigned long long bs = __ballot(v[e] >= T);
            if (4 * q + e == ln) w1 = bs;
            __builtin_amdgcn_sched_barrier(0); } }
    return true;
}
__device__ __forceinline__ void topk_select(const float* SC, int* SEL, LAS unsigned char* lds, int blk, int nblk, const int wave) {
    const int lane = lane_id_v();
    LAS u32x4* xl = (LAS u32x4*)(lds + wave * 16384);
    for (int r = blk * 8 + wave; r < S; r += nblk * 8) {
        const int n = r + 1; unsigned long long* mrow = (unsigned long long*)SEL + (size_t)r * 128;
        unsigned long long w0 = 0ull, w1 = 0ull;
        const int nwords = 4 * ((r >> 8) + 1);
        if (n <= TOPK) { const int lo = 64 * lane; w0 = (r < lo) ? 0ull : ((r - lo >= 63) ? ~0ull : ((2ull << (r - lo)) - 1ull)); }
        else { const float* row = SC + sc_off(r);
            unsigned T; int need; bool ok;
            if (n <= 2048) ok = topk_row<32, 0>(row, n, lane, xl, w0, w1, T, need); else if (n <= 4096) ok = topk_row<64, 0>(row, n, lane, xl, w0, w1, T, need); else ok = topk_row<64, 64>(row, n, lane, xl, w0, w1, T, need);
            if (!ok) { int eqc = 0; const unsigned long long lt = (lane == 0) ? 0ull : (~0ull >> (64 - lane));
                for (int base = 0, it = 0; base < n; base += 64, ++it) {
                    const int i = base + lane; const unsigned v = (i < n) ? (ordkey(row[i]) >> 1) : 0u;
                    const bool gt = v > T, eq = (i < n) && (v == T);
                    const unsigned long long be = __ballot(eq);
                    const bool take = gt || (eq && (eqc + __builtin_popcountll(be & lt) < need));
                    const unsigned long long bs = __ballot(take);
                    if ((it & 63) == lane) { if (it < 64) w0 = bs; else w1 = bs; }
                    eqc += __builtin_popcountll(be); } } }
        if (lane < nwords) mrow[lane] = w0;
        if (64 + lane < nwords) mrow[64 + lane] = w1;
    }
}
template <int DQ, int DV, bool GATHER>
__device__ __forceinline__ void naive_attn(const bf16_t* __restrict__ qp, const bf16_t* __restrict__ kb, const bf16_t* __restrict__ vb, size_t kvpitch,
                                           int nkeys, int nmax, const int* __restrict__ sel, int r, float scale, float slope, float (&o)[DV / 8]) {
    constexpr int QN = DQ / 8, VN = DV / 8;
    float q[QN];
#pragma unroll
    for (int i = 0; i < QN / 2; ++i) { const unsigned w = ((const unsigned*)qp)[i]; q[2 * i] = bflo(w) * scale; q[2 * i + 1] = bfhi(w) * scale; }
#pragma unroll
    for (int i = 0; i < VN; ++i) o[i] = 0.f;
    float m = -1e30f, l = 0.f;
    for (int i = 0; i < nmax; ++i) {
        bool valid = i < nkeys; int key = i;
        if (GATHER) { key = sel[valid ? i : 0]; valid = valid && key >= 0; }
        if (!valid) key = 0;
        const unsigned* kp = (const unsigned*)(kb + (size_t)key * kvpitch);
        float d = 0.f;
#pragma unroll
        for (int j = 0; j < QN / 2; ++j) { const unsigned w = kp[j]; d += q[2 * j] * bflo(w) + q[2 * j + 1] * bfhi(w); }
        d += __shfl_xor(d, 1); d += __shfl_xor(d, 2); d += __shfl_xor(d, 4);
        const float logit = d - slope * (float)(r - key);
        if (valid) {
            if (logit > m) { const float c = __expf(m - logit); l *= c;
#pragma unroll
                for (int j = 0; j < VN; ++j) o[j] *= c;
                m = logit; }
            const float p = __expf(logit - m); l += p;
            const unsigned* vp = (const unsigned*)(vb + (size_t)key * kvpitch);
#pragma unroll
            for (int j = 0; j < VN / 2; ++j) { const unsigned w = vp[j]; o[2 * j] += p * bflo(w); o[2 * j + 1] += p * bfhi(w); }
        }
    }
    const float il = 1.0f / l;
#pragma unroll
    for (int j = 0; j < VN; ++j) o[j] *= il;
}
__device__ __forceinline__ void attn_b_naive(const Args& a, int blk, int nblk, const int wave) {
    const int lane = lane_id_v(), tid = wave * 64 + lane, sub = lane & 7;
    const bf16_t* PROJ = (const bf16_t*)(a.ws + WS_PROJ); bf16_t* UB = (bf16_t*)(a.ws + WS_U) + (size_t)1 * S * 1024;
    const float lam = ((const float*)(a.ws + WS_CTL))[0];
    for (int wi = blk * 8 + wave; wi < 1024 * 8; wi += nblk * 8) {
        const int h = wi & 7, rg = wi >> 3, r = rg * 8 + (lane >> 3), nmax = rg * 8 + 8;
        const float slope = exp2f(-(float)(h + 1));
        float o0[16], o1[16];
        const bf16_t* rowp = PROJ + (size_t)r * NPAD;
        naive_attn<64, 128, false>(rowp + C_QB + h * 128 + sub * 8, PROJ + C_KB + h * 128 + sub * 8, PROJ + C_VB + h * 128 + sub * 16, NPAD, r + 1, nmax, nullptr, r, 0.125f, slope, o0);
        naive_attn<64, 128, false>(rowp + C_QB + h * 128 + 64 + sub * 8, PROJ + C_KB + h * 128 + 64 + sub * 8, PROJ + C_VB + h * 128 + sub * 16, NPAD, r + 1, nmax, nullptr, r, 0.125f, slope, o1);
        float ss = 0.f;
#pragma unroll
        for (int j = 0; j < 16; ++j) { o0[j] -= lam * o1[j]; ss += o0[j] * o0[j]; }
        ss += __shfl_xor(ss, 1); ss += __shfl_xor(ss, 2); ss += __shfl_xor(ss, 4);
        const float rs = 1.0f / sqrtf(ss * (1.f / 128.f) + RMS_EPS) * 0.8f;
        const float* g = a.in[9] + sub * 16; const bf16_t* zp = rowp + C_ZB + h * 128 + sub * 16;
        unsigned w[8];
#pragma unroll
        for (int j = 0; j < 8; ++j) w[j] = pk2(o0[2 * j] * rs * g[2 * j] * bf2f(zp[2 * j]), o0[2 * j + 1] * rs * g[2 * j + 1] * bf2f(zp[2 * j + 1]));
        u32x4* dst = (u32x4*)(UB + (size_t)r * 1024 + h * 128 + sub * 16);
        dst[0] = (u32x4){w[0], w[1], w[2], w[3]}; dst[1] = (u32x4){w[4], w[5], w[6], w[7]};
    }
}
__device__ __forceinline__ void attn_m_naive(const Args& a, int blk, int nblk, const int wave) {
    const int lane = lane_id_v(), tid = wave * 64 + lane, sub = lane & 7;
    const bf16_t* PROJ = (const bf16_t*)(a.ws + WS_PROJ); const bf16_t* MKV = (const bf16_t*)(a.ws + WS_MKV); bf16_t* UM = (bf16_t*)(a.ws + WS_U) + (size_t)2 * S * 1024;
    for (int wi = blk * 8 + wave; wi < 1024 * 4; wi += nblk * 8) {
        const int h = wi & 3, rg = wi >> 2, r = rg * 8 + (lane >> 3);
        float o[32];
        const bf16_t* rowp = PROJ + (size_t)r * NPAD;
        naive_attn<256, 256, false>(rowp + C_QM + h * 256 + sub * 32, MKV + h * 256 + sub * 32, MKV + 1024 + h * 256 + sub * 32, 2048, NMEM, NMEM, nullptr, 0, 0.0625f, 0.f, o);
        const bf16_t* zp = rowp + C_ZM + h * 256 + sub * 32;
        u32x4* dst = (u32x4*)(UM + (size_t)r * 1024 + h * 256 + sub * 32);
#pragma unroll
        for (int j = 0; j < 4; ++j) { u32x4 w;
            w.x = pk2(o[8 * j + 0] * bf2f(zp[8 * j + 0]), o[8 * j + 1] * bf2f(zp[8 * j + 1])); w.y = pk2(o[8 * j + 2] * bf2f(zp[8 * j + 2]), o[8 * j + 3] * bf2f(zp[8 * j + 3]));
            w.z = pk2(o[8 * j + 4] * bf2f(zp[8 * j + 4]), o[8 * j + 5] * bf2f(zp[8 * j + 5])); w.w = pk2(o[8 * j + 6] * bf2f(zp[8 * j + 6]), o[8 * j + 7] * bf2f(zp[8 * j + 7]));
            dst[j] = w; }
    }
}
__device__ __forceinline__ void attn_a_naive(const Args& a, int blk, int nblk, const int wave) {
    const int lane = lane_id_v(), tid = wave * 64 + lane, sub = lane & 7;
    const bf16_t* PROJ = (const bf16_t*)(a.ws + WS_PROJ); const int* SEL = (const int*)(a.ws + WS_SEL); bf16_t* UA = (bf16_t*)(a.ws + WS_U);
    for (int wi = blk * 8 + wave; wi < 1024 * 8; wi += nblk * 8) {
        const int h = wi & 7, rg = wi >> 3, r = rg * 8 + (lane >> 3);
        const float slope = exp2f(-(float)(h + 1));
        float o[16];
        const bf16_t* rowp = PROJ + (size_t)r * NPAD;
        naive_attn<128, 128, true>(rowp + C_QA + h * 128 + sub * 16, PROJ + C_KA + h * 128 + sub * 16, PROJ + C_VA + h * 128 + sub * 16, NPAD, TOPK, TOPK, SEL + (size_t)r * TOPK, r, 0.08838834764831845f, slope, o);
        const bf16_t* zp = rowp + C_ZA + h * 128 + sub * 16;
        unsigned w[8];
#pragma unroll
        for (int j = 0; j < 8; ++j) w[j] = pk2(o[2 * j] * bf2f(zp[2 * j]), o[2 * j + 1] * bf2f(zp[2 * j + 1]));
        u32x4* dst = (u32x4*)(UA + (size_t)r * 1024 + h * 128 + sub * 16);
        dst[0] = (u32x4){w[0], w[1], w[2], w[3]}; dst[1] = (u32x4){w[4], w[5], w[6], w[7]};
    }
}
__device__ __forceinline__ void final_norm(const Args& a, int blk, int nblk, const int wave) {
    const int lane = lane_id_v(), tid = wave * 64 + lane;
    const float* part = (const float*)(a.ws + WS_PART); const f32x4* g = (const f32x4*)a.in[16] + lane;
    for (int r = blk * 8 + wave; r < S; r += nblk * 8) {
        float s = (lane < 32) ? part[(size_t)lane * S + r] : 0.f;
        const float rs = 1.0f / sqrtf(wave_sum(s) * (1.f / DM) + RMS_EPS);
        f32x4* y = (f32x4*)(a.out + (size_t)r * DM) + lane;
#pragma unroll
        for (int j = 0; j < 8; ++j) { f32x4 v = y[64 * j]; const f32x4 gg = g[64 * j]; v = v * rs * gg; y[64 * j] = v; }
    }
}


namespace att {
typedef short bf16x8 __attribute__((ext_vector_type(8)));
typedef short s16x4 __attribute__((ext_vector_type(4)));
typedef float f32x16 __attribute__((ext_vector_type(16)));
typedef float f32x2_t __attribute__((ext_vector_type(2)));
typedef __bf16 bf16x2_t __attribute__((ext_vector_type(2)));
constexpr int SHM_V = 16384, SHM_K = 16384;
constexpr float LOG2E = 1.4426950408889634f;
constexpr float THR2 = 8.f * LOG2E;
#define KSWZ(row, colB) ((row) * 256 + ((colB) ^ (((row) & 7) << 4)))
#define SBAR() __builtin_amdgcn_sched_barrier(0)
__device__ __forceinline__ int crow(int r, int hi) { return (r & 3) + 8 * (r >> 2) + 4 * hi; }
__device__ __forceinline__ unsigned cvtpk(float lo, float hi) { f32x2_t v = {lo, hi}; bf16x2_t b = __builtin_convertvector(v, bf16x2_t); return __builtin_bit_cast(unsigned, b); }
__device__ __forceinline__ int v_st(int k, int c) { const int kk = (k & ~0xC) | ((k & 4) << 1) | ((k & 8) >> 1); return ((kk >> 3) * 4 + (c >> 5)) * 512 + ((kk & 7) * 32 + (c & 31)) * 2; }
__device__ __forceinline__ int v_rd_base(int lane) { return ((lane & 3) << 3) | (((lane >> 2) & 3) << 6) | (((lane >> 4) & 1) << 5) | (((lane >> 5) & 1) << 8); }
constexpr int v_rd_off(int d0, int ks, int half) { return d0 * 512 + ks * 4096 + half * 2048; }
typedef short v4i16_t __attribute__((ext_vector_type(4)));
__device__ __forceinline__ s16x4 tr_read(LAS const unsigned char* p) { return __builtin_bit_cast(s16x4, __builtin_amdgcn_ds_read_tr16_b64_v4i16((LAS v4i16_t*)p)); }

template <int NQ> __device__ __forceinline__ void qkt(f32x16& p0, f32x16& p1, LAS const unsigned char* Ks, const bf16x8* qr, int cbyte0, int r32, int hi) {
  p0 = f32x16{}; p1 = f32x16{};
#pragma unroll
  for (int d0 = 0; d0 < NQ; ++d0) { const int cb = cbyte0 + (d0 * 16 + hi * 8) * 2;
    const bf16x8 b0 = *(LAS const bf16x8*)(Ks + KSWZ(r32, cb));
    const bf16x8 b1 = *(LAS const bf16x8*)(Ks + KSWZ(32 + r32, cb));
    p0 = __builtin_amdgcn_mfma_f32_32x32x16_bf16(b0, qr[d0], p0, 0, 0, 0);
    p1 = __builtin_amdgcn_mfma_f32_32x32x16_bf16(b1, qr[d0], p1, 0, 0, 0); }
}
template <int NQ> __device__ __forceinline__ void qkt_l(f32x16& p0, f32x16& p1, LAS const unsigned char* Ks, LAS const unsigned char* Qs, int cbyte0, int r32, int hi) {
  p0 = f32x16{}; p1 = f32x16{};
  asm volatile("" : "+v"(Qs));
#pragma unroll
  for (int d0 = 0; d0 < NQ; ++d0) { const int cb = cbyte0 + (d0 * 16 + hi * 8) * 2;
    const bf16x8 q = *(LAS const bf16x8*)(Qs + d0 * 1024);
    const bf16x8 b0 = *(LAS const bf16x8*)(Ks + KSWZ(r32, cb));
    const bf16x8 b1 = *(LAS const bf16x8*)(Ks + KSWZ(32 + r32, cb));
    p0 = __builtin_amdgcn_mfma_f32_32x32x16_bf16(b0, q, p0, 0, 0, 0);
    p1 = __builtin_amdgcn_mfma_f32_32x32x16_bf16(b1, q, p1, 0, 0, 0); }
}
template <int D0> __device__ __forceinline__ void pv_one(f32x16& od, LAS const unsigned char* vb, bf16x8 pa0, bf16x8 pa1, bf16x8 pa2, bf16x8 pa3) {
  const s16x4 l0 = tr_read(vb + v_rd_off(D0, 0, 0)), h0 = tr_read(vb + v_rd_off(D0, 0, 1)), l1 = tr_read(vb + v_rd_off(D0, 1, 0)), h1 = tr_read(vb + v_rd_off(D0, 1, 1));
  const s16x4 l2 = tr_read(vb + v_rd_off(D0, 2, 0)), h2 = tr_read(vb + v_rd_off(D0, 2, 1)), l3 = tr_read(vb + v_rd_off(D0, 3, 0)), h3 = tr_read(vb + v_rd_off(D0, 3, 1));
#define PK(L, H) (bf16x8){L[0], L[1], L[2], L[3], H[0], H[1], H[2], H[3]}
  od = __builtin_amdgcn_mfma_f32_32x32x16_bf16(pa0, PK(l0, h0), od, 0, 0, 0);
  od = __builtin_amdgcn_mfma_f32_32x32x16_bf16(pa1, PK(l1, h1), od, 0, 0, 0);
  od = __builtin_amdgcn_mfma_f32_32x32x16_bf16(pa2, PK(l2, h2), od, 0, 0, 0);
  od = __builtin_amdgcn_mfma_f32_32x32x16_bf16(pa3, PK(l3, h3), od, 0, 0, 0);
#undef PK
}
__device__ __forceinline__ void pv_d0(f32x16* o, LAS const unsigned char* vb, bf16x8 pa0, bf16x8 pa1, bf16x8 pa2, bf16x8 pa3) {
  pv_one<0>(o[0], vb, pa0, pa1, pa2, pa3); pv_one<1>(o[1], vb, pa0, pa1, pa2, pa3); pv_one<2>(o[2], vb, pa0, pa1, pa2, pa3); pv_one<3>(o[3], vb, pa0, pa1, pa2, pa3);
}
template <bool CAUSAL> __device__ __forceinline__ void partialSM(f32x16& p0, f32x16& p1, float& m_reg, float& alpha, const float (&cs)[16], float base, int lim, float C, float slope2, int delta) {
  const float tb0 = slope2 * (float)delta + base, tb1 = slope2 * (float)(delta + 32) + base;
#pragma unroll
  for (int r = 0; r < 16; ++r) { p0[r] = fmaf(p0[r], C, cs[r]); p1[r] = fmaf(p1[r], C, cs[r]); }
  if (CAUSAL && delta + 63 > 0) {
    const int l0 = lim - delta, l1 = l0 - 32;
#pragma unroll
    for (int r = 0; r < 16; ++r) { const int K = (r & 3) + 8 * (r >> 2); if (K > l0) p0[r] = -INFINITY; if (K > l1) p1[r] = -INFINITY; }
  }
  float pm0 = p0[0], pm1 = p1[0];
#pragma unroll
  for (int r = 1; r < 16; ++r) { pm0 = fmaxf(pm0, p0[r]); pm1 = fmaxf(pm1, p1[r]); }
  float pmax = fmaxf(pm0 + tb0, pm1 + tb1);
  { auto rr = __builtin_amdgcn_permlane32_swap(__float_as_uint(pmax), __float_as_uint(pmax), false, false);
    pmax = fmaxf(__uint_as_float(rr[0]), __uint_as_float(rr[1])); }
  float mn;
  if (__builtin_expect(__all(pmax - m_reg <= THR2), 1)) { mn = m_reg; alpha = 1.f; }
  else { mn = fmaxf(m_reg, pmax); alpha = __builtin_amdgcn_exp2f(m_reg - mn); m_reg = mn; }
  const float a0 = tb0 - mn, a1 = tb1 - mn;
#pragma unroll
  for (int r = 0; r < 16; ++r) { p0[r] += a0; p1[r] += a1; }
#pragma unroll
  for (int r = 0; r < 16; ++r) p0[r] = __builtin_amdgcn_exp2f(p0[r]);
}
__device__ __forceinline__ void finishSM(f32x16& p0, f32x16& p1, float alpha, float& l_reg, bf16x8& pa0, bf16x8& pa1, bf16x8& pa2, bf16x8& pa3) {
#pragma unroll
  for (int r = 0; r < 16; ++r) p1[r] = __builtin_amdgcn_exp2f(p1[r]);
  float ps = 0;
#pragma unroll
  for (int r = 0; r < 16; ++r) ps += p0[r];
#pragma unroll
  for (int r = 0; r < 16; ++r) ps += p1[r];
  { auto rr = __builtin_amdgcn_permlane32_swap(__float_as_uint(ps), __float_as_uint(ps), false, false);
    ps = __uint_as_float(rr[0]) + __uint_as_float(rr[1]); }
  l_reg = l_reg * alpha + ps;
#define PK4(P, BASE, OUT) do { unsigned a0 = cvtpk(P[BASE + 0], P[BASE + 1]), a1 = cvtpk(P[BASE + 2], P[BASE + 3]);   \
    unsigned b0 = cvtpk(P[BASE + 4], P[BASE + 5]), b1 = cvtpk(P[BASE + 6], P[BASE + 7]);                              \
    auto r0 = __builtin_amdgcn_permlane32_swap(a0, b0, false, false); auto r1 = __builtin_amdgcn_permlane32_swap(a1, b1, false, false); \
    u32x4 w = {r0[0], r1[0], r0[1], r1[1]}; OUT = __builtin_bit_cast(bf16x8, w); } while (0)
  PK4(p0, 0, pa0); PK4(p0, 8, pa1); PK4(p1, 0, pa2); PK4(p1, 8, pa3);
#undef PK4
}

__device__ __forceinline__ void attn_b_unit(const bf16_t* __restrict__ PROJ, bf16_t* UB, const float* __restrict__ gsub, float lam, int h, int qb, int jmin, LAS unsigned char* lds, const int wid) {
  const int lane = lane_id_v(), tid = wid * 64 + lane, r32 = lane & 31, hi = lane >> 5, comp = wid >> 2, wq = wid & 3;
  const int R0 = qb * 128, qrow0 = R0 + wq * 32, NT = 2 * qb + 2, NTe = NT - jmin;
  LAS unsigned char* V_lds = lds; LAS unsigned char* K_lds = lds + 2 * SHM_V;
  LAS float* ws = (LAS float*)(lds + 2 * SHM_V + 2 * SHM_K) + wid * 64; LAS float* li_l = ws; LAS float* al_l = ws + 32;
  LAS float* xch = (LAS float*)(lds + 2 * SHM_V + 2 * SHM_K + 2048);
  const float slope2 = __builtin_amdgcn_exp2f(-(float)(h + 1)) * LOG2E, C = 0.125f * LOG2E;
  float cs[16];
#pragma unroll
  for (int r = 0; r < 16; ++r) cs[r] = __uint_as_float(__builtin_amdgcn_readfirstlane(__float_as_uint(slope2 * (float)((r & 3) + 8 * (r >> 2)))));
  const float base = slope2 * (float)(4 * hi - r32); const int lim = r32 - 4 * hi;
  float m_reg = -1e30f, l_reg = 0; f32x16 o[4] = {};
  LAS unsigned char* Qs = lds + 2 * SHM_V + 2 * SHM_K + 2048 + wid * 4096 + lane * 16;
  { const unsigned qo = ((unsigned)(qrow0 + r32) * (unsigned)NPAD + (unsigned)(C_QB + h * 128 + comp * 64 + hi * 8)) * 2u;
#pragma unroll
    for (int d0 = 0; d0 < 4; ++d0) *(LAS bf16x8*)(Qs + d0 * 1024) = *(const bf16x8*)((const char*)PROJ + (qo + 32u * d0)); }
  const unsigned offK = (unsigned)((tid >> 4) * NPAD + C_KB + h * 128 + (tid & 15) * 8) * 2u, offV = offK + (unsigned)(C_VB - C_KB) * 2u;
  const int sr = tid >> 4, sc = (tid & 15) * 8, vst0 = v_st(sr, sc), vst1 = v_st(32 + sr, sc), cq = comp * 128;
  LAS const unsigned char* vb0 = V_lds + v_rd_base(lane);
  struct { bf16x8 vs0, vs1, ks0, ks1; } sr_[2];
#define KEY0(t) (64 * (NT - 1 - (t)))
#define GLD16(off) (*(const bf16x8*)((const char*)PROJ + (unsigned)(off)))
#define SLOAD(i, k0) do { const unsigned kb_ = (unsigned)(k0) * (unsigned)(NPAD * 2); sr_[i].vs0 = GLD16(offV + kb_); sr_[i].vs1 = GLD16(offV + kb_ + 32u * NPAD * 2u); \
    sr_[i].ks0 = GLD16(offK + kb_); sr_[i].ks1 = GLD16(offK + kb_ + 32u * NPAD * 2u); } while (0)
#define SWRITE(b) do { *(LAS bf16x8*)(V_lds + (b) * SHM_V + vst0) = sr_[b].vs0; *(LAS bf16x8*)(V_lds + (b) * SHM_V + vst1) = sr_[b].vs1; const int kc = sc * 2; \
    *(LAS bf16x8*)(K_lds + (b) * SHM_K + KSWZ(sr, kc)) = sr_[b].ks0; *(LAS bf16x8*)(K_lds + (b) * SHM_K + KSWZ(32 + sr, kc)) = sr_[b].ks1; } while (0)
#define RESC(a) do { if (__any((a) < 1.f)) { if (hi == 0) al_l[r32] = (a); asm volatile("s_waitcnt lgkmcnt(0)" ::: "memory"); \
    _Pragma("unroll") for (int d = 0; d < 4; ++d) _Pragma("unroll") for (int r = 0; r < 16; ++r) o[d][r] *= al_l[crow(r, hi)]; } } while (0)
  f32x16 pA0, pA1, pB0, pB1; float alA, alB; bf16x8 pa0, pa1, pa2, pa3;
  SLOAD(0, KEY0(0)); SWRITE(0); __syncthreads();
  qkt_l<4>(pA0, pA1, K_lds, Qs, cq, r32, hi); partialSM<true>(pA0, pA1, m_reg, alA, cs, base, lim, C, slope2, KEY0(0) - qrow0);
  SLOAD(1, KEY0(1)); if (2 < NTe) SLOAD(0, KEY0(2));
  SWRITE(1); __syncthreads();
  for (int j = 1; j + 1 < NTe; j += 2) {
    SBAR(); qkt_l<4>(pB0, pB1, K_lds + SHM_K, Qs, cq, r32, hi);
    finishSM(pA0, pA1, alA, l_reg, pa0, pa1, pa2, pa3); SBAR();
    SLOAD(1, KEY0(j + 2)); SBAR();
    pv_d0(o, vb0, pa0, pa1, pa2, pa3); partialSM<true>(pB0, pB1, m_reg, alB, cs, base, lim, C, slope2, KEY0(j) - qrow0);
    __syncthreads(); SWRITE(0);
    RESC(alB); __syncthreads();
    SBAR(); qkt_l<4>(pA0, pA1, K_lds, Qs, cq, r32, hi);
    finishSM(pB0, pB1, alB, l_reg, pa0, pa1, pa2, pa3); SBAR();
    SLOAD(0, KEY0(min(j + 3, NTe - 1))); SBAR();
    pv_d0(o, vb0 + SHM_V, pa0, pa1, pa2, pa3); partialSM<true>(pA0, pA1, m_reg, alA, cs, base, lim, C, slope2, KEY0(j + 1) - qrow0);
    __syncthreads(); SWRITE(1);
    RESC(alA); __syncthreads();
  }
  SBAR(); qkt_l<4>(pB0, pB1, K_lds + SHM_K, Qs, cq, r32, hi);
  finishSM(pA0, pA1, alA, l_reg, pa0, pa1, pa2, pa3); SBAR();
  pv_d0(o, vb0, pa0, pa1, pa2, pa3); partialSM<true>(pB0, pB1, m_reg, alB, cs, base, lim, C, slope2, KEY0(NTe - 1) - qrow0);
  __syncthreads(); RESC(alB);
  finishSM(pB0, pB1, alB, l_reg, pa0, pa1, pa2, pa3); SBAR();
  pv_d0(o, vb0 + SHM_V, pa0, pa1, pa2, pa3);
#undef KEY0
#undef SLOAD
#undef GLD16
#undef SWRITE
#undef RESC
  if (hi == 0) li_l[r32] = l_reg; asm volatile("s_waitcnt lgkmcnt(0)" ::: "memory");
  float rli[16];
#pragma unroll
  for (int r = 0; r < 16; ++r) rli[r] = __builtin_amdgcn_rcpf(li_l[crow(r, hi)]);
  __syncthreads();
  if (comp == 1) {
#pragma unroll
    for (int d0 = 0; d0 < 4; ++d0)
#pragma unroll
      for (int r = 0; r < 16; ++r) xch[(wq * 64 + d0 * 16 + r) * 64 + lane] = o[d0][r] * rli[r] * lam;
  }
  __syncthreads();
  if (comp == 0) {
    float ss[16];
#pragma unroll
    for (int r = 0; r < 16; ++r) ss[r] = 0.f;
#pragma unroll
    for (int d0 = 0; d0 < 4; ++d0)
#pragma unroll
      for (int r = 0; r < 16; ++r) { const float d = o[d0][r] * rli[r] - xch[(wq * 64 + d0 * 16 + r) * 64 + lane]; o[d0][r] = d; ss[r] += d * d; }
#pragma unroll
    for (int r = 0; r < 16; ++r) { float s = ss[r]; s += __shfl_xor(s, 1); s += __shfl_xor(s, 2); s += __shfl_xor(s, 4); s += __shfl_xor(s, 8); s += __shfl_xor(s, 16);
      ss[r] = 0.8f / sqrtf(s * (1.f / 128.f) + RMS_EPS); }
    bf16_t zv[4][16];
#pragma unroll
    for (int d0 = 0; d0 < 4; ++d0)
#pragma unroll
      for (int r = 0; r < 16; ++r) zv[d0][r] = PROJ[(size_t)(qrow0 + crow(r, hi)) * NPAD + C_ZB + h * 128 + d0 * 32 + r32];
#pragma unroll
    for (int d0 = 0; d0 < 4; ++d0) { const int col = d0 * 32 + r32; const float g = gsub[col];
#pragma unroll
      for (int r = 0; r < 16; ++r) { const size_t row = (size_t)(qrow0 + crow(r, hi));
        UB[row * 1024 + h * 128 + col] = (bf16_t)f2bf(o[d0][r] * ss[r] * g * bf2f(zv[d0][r])); } }
  }
  __syncthreads();
}
template <bool DUMMY> __device__ __forceinline__ void partialSM_A(f32x16& p0, f32x16& p1, float& m_reg, float& alpha, const float (&cs)[16], float base, float C, float slope2, int delta, unsigned long long mw, int hi) {
  const float tb0 = slope2 * (float)delta + base, tb1 = slope2 * (float)(delta + 32) + base;
  const unsigned wl = (unsigned)mw >> (4 * hi), wh = (unsigned)(mw >> 32) >> (4 * hi);
#pragma unroll
  for (int r = 0; r < 16; ++r) { const int K = (r & 3) + 8 * (r >> 2);
    const float y0 = fmaf(p0[r], C, cs[r]), y1 = fmaf(p1[r], C, cs[r]);
    const unsigned t0 = (unsigned)((int)(wl << (31 - K)) >> 31), t1 = (unsigned)((int)(wh << (31 - K)) >> 31);
    p0[r] = __uint_as_float((__float_as_uint(y0) & t0) | (~t0 & 0xff800000u));
    p1[r] = __uint_as_float((__float_as_uint(y1) & t1) | (~t1 & 0xff800000u)); }
  float pm0 = p0[0], pm1 = p1[0];
#pragma unroll
  for (int r = 1; r < 16; ++r) { pm0 = fmaxf(pm0, p0[r]); pm1 = fmaxf(pm1, p1[r]); }
  float pmax = fmaxf(pm0 + tb0, pm1 + tb1);
  { auto rr = __builtin_amdgcn_permlane32_swap(__float_as_uint(pmax), __float_as_uint(pmax), false, false);
    pmax = fmaxf(__uint_as_float(rr[0]), __uint_as_float(rr[1])); }
  float mn;
  if (__builtin_expect(__all(pmax - m_reg <= THR2), 1)) { mn = m_reg; alpha = 1.f; }
  else { mn = fmaxf(m_reg, pmax); alpha = __builtin_amdgcn_exp2f(m_reg - mn); m_reg = mn; }
  const float a0 = tb0 - mn, a1 = tb1 - mn;
#pragma unroll
  for (int r = 0; r < 16; ++r) { p0[r] += a0; p1[r] += a1; }
#pragma unroll
  for (int r = 0; r < 16; ++r) p0[r] = __builtin_amdgcn_exp2f(p0[r]);
}
__device__ __forceinline__ void attn_a_unit(const bf16_t* __restrict__ PROJ, const unsigned long long* __restrict__ MASK, bf16_t* UA, int h, int qb, int jmin, LAS unsigned char* lds, const int wid) {
  const int lane = lane_id_v(), tid = wid * 64 + lane, r32 = lane & 31, hi = lane >> 5;
  const int R0 = qb * 256, qrow0 = R0 + wid * 32, NT = 4 * qb + 4, NTe = NT - jmin;
  LAS unsigned char* V_lds = lds; LAS unsigned char* K_lds = lds + 2 * SHM_V;
  LAS float* ws = (LAS float*)(lds + 2 * SHM_V + 2 * SHM_K) + wid * 64; LAS float* li_l = ws; LAS float* al_l = ws + 32;
  const float slope2 = __builtin_amdgcn_exp2f(-(float)(h + 1)) * LOG2E, C = 0.08838834764831845f * LOG2E;
  float cs[16];
#pragma unroll
  for (int r = 0; r < 16; ++r) cs[r] = __uint_as_float(__builtin_amdgcn_readfirstlane(__float_as_uint(slope2 * (float)((r & 3) + 8 * (r >> 2)))));
  const float base = slope2 * (float)(4 * hi - r32);
  float m_reg = -1e30f, l_reg = 0; f32x16 o[4] = {}; bf16x8 qr[8];
  { const bf16_t* Qw = PROJ + (size_t)(qrow0 + r32) * NPAD + C_QA + h * 128 + hi * 8;
#pragma unroll
    for (int d0 = 0; d0 < 8; ++d0) qr[d0] = *(const bf16x8*)(Qw + d0 * 16); }
  const unsigned offK = (unsigned)((tid >> 4) * NPAD + C_KA + h * 128 + (tid & 15) * 8) * 2u, offV = offK + (unsigned)(C_VA - C_KA) * 2u;
  const unsigned moff = (unsigned)(qrow0 + r32) * 1024u;
#define MLD(tj) (*(const unsigned long long*)((const char*)MASK + (moff + 8u * (unsigned)(tj))))
  const int sr = tid >> 4, sc = (tid & 15) * 8, vst0 = v_st(sr, sc), vst1 = v_st(32 + sr, sc);
  LAS const unsigned char* vb0 = V_lds + v_rd_base(lane);
  struct { bf16x8 vs0, vs1, ks0, ks1; } sr_;
#define TJ(t) (NT - 1 - (t))
#define KEY0(t) (64 * TJ(t))
#define GLD16(off) (*(const bf16x8*)((const char*)PROJ + (unsigned)(off)))
#define SLOAD(k0) do { const unsigned kb_ = (unsigned)(k0) * (unsigned)(NPAD * 2); sr_.vs0 = GLD16(offV + kb_); sr_.vs1 = GLD16(offV + kb_ + 32u * NPAD * 2u); \
    sr_.ks0 = GLD16(offK + kb_); sr_.ks1 = GLD16(offK + kb_ + 32u * NPAD * 2u); } while (0)
#define SWRITE(b) do { *(LAS bf16x8*)(V_lds + (b) * SHM_V + vst0) = sr_.vs0; *(LAS bf16x8*)(V_lds + (b) * SHM_V + vst1) = sr_.vs1; const int kc = sc * 2; \
    *(LAS bf16x8*)(K_lds + (b) * SHM_K + KSWZ(sr, kc)) = sr_.ks0; *(LAS bf16x8*)(K_lds + (b) * SHM_K + KSWZ(32 + sr, kc)) = sr_.ks1; } while (0)
#define RESC(a) do { if (__any((a) < 1.f)) { if (hi == 0) al_l[r32] = (a); asm volatile("s_waitcnt lgkmcnt(0)" ::: "memory"); \
    _Pragma("unroll") for (int d = 0; d < 4; ++d) _Pragma("unroll") for (int r = 0; r < 16; ++r) o[d][r] *= al_l[crow(r, hi)]; } } while (0)
  f32x16 pA0, pA1, pB0, pB1; float alA, alB; bf16x8 pa0, pa1, pa2, pa3; unsigned long long mwA, mwB;
  SLOAD(KEY0(0)); mwA = MLD(TJ(0)); SWRITE(0); __syncthreads();
  qkt<8>(pA0, pA1, K_lds, qr, 0, r32, hi); partialSM_A<true>(pA0, pA1, m_reg, alA, cs, base, C, slope2, KEY0(0) - qrow0, mwA, hi);
  SLOAD(KEY0(1)); mwB = MLD(TJ(1)); SWRITE(1); __syncthreads();
  for (int j = 1; j + 1 < NTe; j += 2) {
    SBAR(); qkt<8>(pB0, pB1, K_lds + SHM_K, qr, 0, r32, hi);
    finishSM(pA0, pA1, alA, l_reg, pa0, pa1, pa2, pa3); SBAR();
    SLOAD(KEY0(j + 1)); mwA = MLD(TJ(j + 1)); SBAR();
    pv_d0(o, vb0, pa0, pa1, pa2, pa3); partialSM_A<true>(pB0, pB1, m_reg, alB, cs, base, C, slope2, KEY0(j) - qrow0, mwB, hi);
    __syncthreads(); SWRITE(0);
    RESC(alB); __syncthreads();
    SBAR(); qkt<8>(pA0, pA1, K_lds, qr, 0, r32, hi);
    finishSM(pB0, pB1, alB, l_reg, pa0, pa1, pa2, pa3); SBAR();
    SLOAD(KEY0(j + 2)); mwB = MLD(TJ(j + 2)); SBAR();
    pv_d0(o, vb0 + SHM_V, pa0, pa1, pa2, pa3); partialSM_A<true>(pA0, pA1, m_reg, alA, cs, base, C, slope2, KEY0(j + 1) - qrow0, mwA, hi);
    __syncthreads(); SWRITE(1);
    RESC(alA); __syncthreads();
  }
  SBAR(); qkt<8>(pB0, pB1, K_lds + SHM_K, qr, 0, r32, hi);
  finishSM(pA0, pA1, alA, l_reg, pa0, pa1, pa2, pa3); SBAR();
  pv_d0(o, vb0, pa0, pa1, pa2, pa3); partialSM_A<true>(pB0, pB1, m_reg, alB, cs, base, C, slope2, KEY0(NTe - 1) - qrow0, mwB, hi);
  __syncthreads(); RESC(alB);
  finishSM(pB0, pB1, alB, l_reg, pa0, pa1, pa2, pa3); SBAR();
  pv_d0(o, vb0 + SHM_V, pa0, pa1, pa2, pa3);
#undef TJ
#undef MLD
#undef KEY0
#undef SLOAD
#undef GLD16
#undef SWRITE
#undef RESC
  if (hi == 0) li_l[r32] = l_reg; asm volatile("s_waitcnt lgkmcnt(0)" ::: "memory");
  float rli[16];
#pragma unroll
  for (int r = 0; r < 16; ++r) rli[r] = __builtin_amdgcn_rcpf(li_l[crow(r, hi)]);
  { bf16_t zv[4][16];
#pragma unroll
  for (int d0 = 0; d0 < 4; ++d0)
#pragma unroll
    for (int r = 0; r < 16; ++r) zv[d0][r] = PROJ[(size_t)(qrow0 + crow(r, hi)) * NPAD + C_ZA + h * 128 + d0 * 32 + r32];
#pragma unroll
  for (int d0 = 0; d0 < 4; ++d0) { const int col = h * 128 + d0 * 32 + r32;
#pragma unroll
    for (int r = 0; r < 16; ++r) { const size_t row = (size_t)(qrow0 + crow(r, hi));
      UA[row * 1024 + col] = (bf16_t)f2bf(o[d0][r] * rli[r] * bf2f(zv[d0][r])); } } }
  __syncthreads();
}
template <int NQ, bool ACC> __device__ __forceinline__ void qkt_acc(f32x16& p0, f32x16& p1, LAS const unsigned char* Ks, const bf16x8* qr, int r32, int hi) {
  if (!ACC) { p0 = f32x16{}; p1 = f32x16{}; }
#pragma unroll
  for (int d0 = 0; d0 < NQ; ++d0) { const int cb = (d0 * 16 + hi * 8) * 2;
    const bf16x8 b0 = *(LAS const bf16x8*)(Ks + KSWZ(r32, cb));
    const bf16x8 b1 = *(LAS const bf16x8*)(Ks + KSWZ(32 + r32, cb));
    p0 = __builtin_amdgcn_mfma_f32_32x32x16_bf16(b0, qr[d0], p0, 0, 0, 0);
    p1 = __builtin_amdgcn_mfma_f32_32x32x16_bf16(b1, qr[d0], p1, 0, 0, 0); }
}
__device__ __forceinline__ void attn_m_unit(const bf16_t* __restrict__ PROJ, const bf16_t* __restrict__ MKV, bf16_t* UM, int h, int qb, int vh, LAS unsigned char* lds, const int wid) {
  const int lane = lane_id_v(), tid = wid * 64 + lane, r32 = lane & 31, hi = lane >> 5;
  const int qrow0 = qb * 256 + wid * 32;
  LAS unsigned char* V_lds = lds; LAS unsigned char* K_lds = lds + 2 * SHM_V;
  LAS float* ws = (LAS float*)(lds + 2 * SHM_V + 2 * SHM_K) + wid * 64; LAS float* li_l = ws; LAS float* al_l = ws + 32;
  const float C = 0.0625f * LOG2E;
  const float cs[16] = {0.f, 0.f, 0.f, 0.f, 0.f, 0.f, 0.f, 0.f, 0.f, 0.f, 0.f, 0.f, 0.f, 0.f, 0.f, 0.f};
  float m_reg = -1e30f, l_reg = 0; f32x16 o[4] = {}; bf16x8 qr[16];
  { const unsigned qo = ((unsigned)(qrow0 + r32) * (unsigned)NPAD + (unsigned)(C_QM + h * 256 + hi * 8)) * 2u;
#pragma unroll
    for (int d0 = 0; d0 < 16; ++d0) qr[d0] = *(const bf16x8*)((const char*)PROJ + (qo + 32u * d0)); }
  const int sr = tid >> 4, sc = (tid & 15) * 8, vst0 = v_st(sr, sc), vst1 = v_st(32 + sr, sc);
  const unsigned offK = (unsigned)(sr * 2048 + h * 256 + sc) * 2u, offV = offK + (unsigned)(1024 + vh * 128) * 2u;
  LAS const unsigned char* vb0 = V_lds + v_rd_base(lane);
#define GLD16(off) (*(const bf16x8*)((const char*)MKV + (unsigned)(off)))
  for (int t = 0; t < 4; ++t) {
    const unsigned kb_ = (unsigned)(64 * t) * 4096u;
    const bf16x8 ka0 = GLD16(offK + kb_), ka1 = GLD16(offK + kb_ + 32u * 4096u), kb0 = GLD16(offK + kb_ + 256u), kb1 = GLD16(offK + kb_ + 32u * 4096u + 256u);
    const bf16x8 vs0 = GLD16(offV + kb_), vs1 = GLD16(offV + kb_ + 32u * 4096u);
    const int kc = sc * 2;
    *(LAS bf16x8*)(K_lds + KSWZ(sr, kc)) = ka0; *(LAS bf16x8*)(K_lds + KSWZ(32 + sr, kc)) = ka1;
    *(LAS bf16x8*)(K_lds + SHM_K + KSWZ(sr, kc)) = kb0; *(LAS bf16x8*)(K_lds + SHM_K + KSWZ(32 + sr, kc)) = kb1;
    *(LAS bf16x8*)(V_lds + vst0) = vs0; *(LAS bf16x8*)(V_lds + vst1) = vs1;
    __syncthreads();
    f32x16 p0, p1; float al; bf16x8 pa0, pa1, pa2, pa3;
    qkt_acc<8, false>(p0, p1, K_lds, qr, r32, hi); qkt_acc<8, true>(p0, p1, K_lds + SHM_K, qr + 8, r32, hi);
    partialSM<false>(p0, p1, m_reg, al, cs, 0.f, 0, C, 0.f, 0);
    if (__any(al < 1.f)) { if (hi == 0) al_l[r32] = al; asm volatile("s_waitcnt lgkmcnt(0)" ::: "memory");
#pragma unroll
      for (int d = 0; d < 4; ++d)
#pragma unroll
        for (int r = 0; r < 16; ++r) o[d][r] *= al_l[crow(r, hi)]; }
    finishSM(p0, p1, al, l_reg, pa0, pa1, pa2, pa3);
    pv_d0(o, vb0, pa0, pa1, pa2, pa3);
    __syncthreads();
  }
#undef GLD16
  if (hi == 0) li_l[r32] = l_reg; asm volatile("s_waitcnt lgkmcnt(0)" ::: "memory");
  float rli[16];
#pragma unroll
  for (int r = 0; r < 16; ++r) rli[r] = __builtin_amdgcn_rcpf(li_l[crow(r, hi)]);
  { bf16_t zv[4][16];
#pragma unroll
  for (int d0 = 0; d0 < 4; ++d0)
#pragma unroll
    for (int r = 0; r < 16; ++r) zv[d0][r] = PROJ[(size_t)(qrow0 + crow(r, hi)) * NPAD + C_ZM + h * 256 + vh * 128 + d0 * 32 + r32];
#pragma unroll
  for (int d0 = 0; d0 < 4; ++d0) { const int col = h * 256 + vh * 128 + d0 * 32 + r32;
#pragma unroll
    for (int r = 0; r < 16; ++r) { const size_t row = (size_t)(qrow0 + crow(r, hi));
      UM[row * 1024 + col] = (bf16_t)f2bf(o[d0][r] * rli[r] * bf2f(zv[d0][r])); } } }
  __syncthreads();
}
__device__ __forceinline__ void attn_m_phase(const Args& a, LAS unsigned char* lds, int blk, int nblk, const int wid) {
  const bf16_t* PROJ = (const bf16_t*)(a.ws + WS_PROJ); const bf16_t* MKV = (const bf16_t*)(a.ws + WS_MKV); bf16_t* UM = (bf16_t*)(a.ws + WS_U) + (size_t)2 * S * 1024;
  for (int u = blk; u < 256; u += nblk) attn_m_unit(PROJ, MKV, UM, u & 3, u >> 3, (u >> 2) & 1, lds, wid);
}
__device__ __forceinline__ float slot_sum(const unsigned* ns, int tile, int bj, int wc0, int nwc) { float s = 0.f;
  for (int w = 0; w < nwc; ++w) s += __uint_as_float(__hip_atomic_load(ns + (tile * 2 + bj) * 4 + wc0 + w, __ATOMIC_RELAXED, __HIP_MEMORY_SCOPE_AGENT)); return s; }
__device__ __forceinline__ int window_jmin(float q2k2, float scale, int h, int R0, int NT) {
  const float slope2 = __builtin_amdgcn_exp2f(-(float)(h + 1)) * LOG2E, L = sqrtf(q2k2) * scale * LOG2E * 1.02f, D = (2.f * L + 48.f) / slope2;
  const float x = ((float)R0 - D - 63.f) * (1.f / 64.f);
  int jm = (int)floorf(x) - 1; jm = jm < 0 ? 0 : jm; jm &= ~1; return jm > NT - 2 ? NT - 2 : jm;
}
__device__ __forceinline__ int jmin_b(const unsigned* ns, int h, int qb) {
  const int bj = h & 1; float m = 0.f;
  for (int c = 0; c < 2; ++c) { const float v = slot_sum(ns, 20 + (h >> 1), bj, 2 * c, 2) * slot_sum(ns, 24 + (h >> 1), bj, 2 * c, 2); m = fmaxf(m, v); }
  return window_jmin(m, 0.125f, h, qb * 128, 2 * qb + 2);
}
constexpr int NUNITS_AB = 512;
__device__ __forceinline__ void build_order(const unsigned* ns, unsigned* order, LAS unsigned char* lds, const int lane) {
  LAS int* cost = (LAS int*)lds;
  for (int u = lane; u < NUNITS_AB; u += 64) { int jm, cst;
    { const int h = u & 7, qb = u >> 3; jm = jmin_b(ns, h, qb); cst = 2 * qb + 2 - jm; }
    cost[u] = cst; cost[NUNITS_AB + u] = jm; }
  asm volatile("s_waitcnt lgkmcnt(0)" ::: "memory"); __builtin_amdgcn_wave_barrier();
  for (int u = lane; u < NUNITS_AB; u += 64) { const int cu = cost[u]; int rank = 0;
    for (int v = 0; v < NUNITS_AB; ++v) { const int cv = cost[v]; rank += (cv > cu || (cv == cu && v < u)) ? 1 : 0; }
    order[rank] = (unsigned)u | ((unsigned)cost[NUNITS_AB + u] << 16); }
}
__device__ __forceinline__ void attn_ab_phase(const Args& a, LAS unsigned char* lds, int blk, int nblk, const int wid) {
  const bf16_t* PROJ = (const bf16_t*)(a.ws + WS_PROJ); bf16_t* UA = (bf16_t*)(a.ws + WS_U); bf16_t* UB = UA + (size_t)S * 1024;
  { const unsigned long long* MASK = (const unsigned long long*)(a.ws + WS_SEL);
    for (int u = blk; u < 256; u += nblk) attn_a_unit(PROJ, MASK, UA, u & 7, 31 - (u >> 3), 0, lds, wid); }
  const unsigned* order = (const unsigned*)(a.ws + WS_CTL + 4096); unsigned* qctr = (unsigned*)(a.ws + WS_CTL + 320);
  LAS unsigned* slot = (LAS unsigned*)(lds + 147456 - 64);
  for (;;) {
    if (wid == 0) { if (lane_id_v() == 0) slot[0] = __hip_atomic_fetch_add(qctr, 1u, __ATOMIC_RELAXED, __HIP_MEMORY_SCOPE_AGENT); }
    __syncthreads();
    const unsigned i = slot[0];
    __syncthreads();
    if (i >= 512u) break;
    const unsigned e = order[i]; const int u = (int)(e & 0xffffu), jm = (int)(e >> 16);
    attn_b_unit(PROJ, UB, a.in[9], ((const float*)(a.ws + WS_CTL))[0], u & 7, u >> 3, jm, lds, wid);
  }
}
#undef KSWZ
#undef SBAR
}


namespace idx {
typedef short bf16x8 __attribute__((ext_vector_type(8)));
typedef float f32x16 __attribute__((ext_vector_type(16)));
constexpr int NUNIT = 8 * (16 * 17 / 2);
__device__ __forceinline__ void scores_phase(const bf16_t* __restrict__ PROJ, float* SC, unsigned* uctr, LAS unsigned char* lds, int blk, int nblk, const int wid) {
  const int lane = lane_id_v(), tid = wid * 64 + lane, n32 = lane & 31, hi = lane >> 5;
  const int skey = tid >> 3, schunk = tid & 7;
  const int swr = skey * 128 + ((schunk ^ (skey & 7)) << 4);
  LAS unsigned* uslot = (LAS unsigned*)(lds + 147456 - 64);
  for (;;) {
    if (wid == 0) { if (lane_id_v() == 0) uslot[0] = __hip_atomic_fetch_add(uctr, 1u, __ATOMIC_RELAXED, __HIP_MEMORY_SCOPE_AGENT); }
    __syncthreads();
    const int u = NUNIT - 1 - (int)uslot[0];
    __syncthreads();
    if (u < 0) break;
    int g = 0, rem = u; while (rem >= 8 * (g + 1)) { rem -= 8 * (g + 1); ++g; }
    const int qc = 8 * g + rem / (g + 1), kc = rem % (g + 1);
    const int q0 = 64 * qc + 8 * wid, k_begin = 512 * kc, k_end = min(512 * kc + 512, 64 * qc + 64), ntile = (k_end - k_begin) / 64;
    bf16x8 af[4][4]; float w[4][16];
    const int head = (n32 & 3) + 4 * (n32 >> 3), qbit = (n32 >> 2) & 1;
#pragma unroll
    for (int t = 0; t < 4; ++t) {
      const bf16_t* qp = PROJ + (size_t)(q0 + 2 * t + qbit) * NPAD + C_QI + head * 64 + hi * 8;
#pragma unroll
      for (int ks = 0; ks < 4; ++ks) af[t][ks] = *(const bf16x8*)(qp + ks * 16);
      const bf16_t* wp = PROJ + (size_t)(q0 + 2 * t + hi) * NPAD + C_WI;
      const u32x4 w0 = *(const u32x4*)wp, w1 = *(const u32x4*)(wp + 8);
      const unsigned ww[8] = {w0.x, w0.y, w0.z, w0.w, w1.x, w1.y, w1.z, w1.w};
#pragma unroll
      for (int i = 0; i < 8; ++i) { w[t][2 * i] = bflo(ww[i]) * 0.03125f; w[t][2 * i + 1] = bfhi(ww[i]) * 0.03125f; }
    }
    u32x4 st = *(const u32x4*)(PROJ + (size_t)(k_begin + skey) * NPAD + C_KI + schunk * 8);
    __syncthreads();
    *(LAS u32x4*)(lds + swr) = st;
    __syncthreads();
    for (int tl = 0; tl < ntile; ++tl) {
      LAS const unsigned char* kb = lds + (tl & 1) * 8192;
      if (tl + 1 < ntile) st = *(const u32x4*)(PROJ + (size_t)(k_begin + 64 * (tl + 1) + skey) * NPAD + C_KI + schunk * 8);
#pragma unroll
      for (int kh = 0; kh < 2; ++kh) {
        const int krow = kh * 32 + n32;
        bf16x8 bfr[4];
#pragma unroll
        for (int ks = 0; ks < 4; ++ks) bfr[ks] = *(LAS const bf16x8*)(kb + krow * 128 + (((2 * ks + hi) ^ (krow & 7)) << 4));
        const int s = k_begin + 64 * tl + krow;
#pragma unroll
        for (int t = 0; t < 4; ++t) {
          f32x16 acc = {};
#pragma unroll
          for (int ks = 0; ks < 4; ++ks) acc = __builtin_amdgcn_mfma_f32_32x32x16_bf16(af[t][ks], bfr[ks], acc, 0, 0, 0);
          float sc = 0.f;
#pragma unroll
          for (int r = 0; r < 16; ++r) sc = fmaf(fmaxf(acc[r], 0.f), w[t][r], sc);
          const int q = q0 + 2 * t + hi;
          if (s <= q) SC[sc_off(q) + s] = sc;
        }
      }
      if (tl + 1 < ntile) { *(LAS u32x4*)(lds + ((tl + 1) & 1) * 8192 + swr) = st; }
      __syncthreads();
    }
  }
}
}

#ifdef DBG_STAGE
__device__ __forceinline__ void dbg_dump(const Args& a, int blk, int nblk) {
    const bf16_t* PROJ = (const bf16_t*)(a.ws + WS_PROJ);
    for (size_t idx = (size_t)blk * 512 + threadIdx.x; idx < (size_t)S * DM; idx += (size_t)nblk * 512) {
        const int r = (int)(idx / DM), c = (int)(idx % DM); float v = 0.f;
#if DBG_STAGE == 1 && defined(DBG_WEIGHTS)
        for (int z = 0; z < 3; ++z) v += bf2f(((const bf16_t*)(a.ws + WS_WTBR))[((size_t)z * 2048 + (r & 2047)) * 1024 + (c & 1023)]);
        v += bf2f(((const bf16_t*)(a.ws + WS_WTOUT))[(size_t)(r & 2047) * 2048 + c]);
#elif DBG_STAGE == 1 && defined(DBG_GATES)
        for (int j = 0; j < 3; ++j) v += bf2f(PROJ[(size_t)r * NPAD + C_GL + c + 2048 * j]);
#elif DBG_STAGE == 1
        for (int j = 0; j < 8; ++j) v += bf2f(PROJ[(size_t)r * NPAD + c + 2048 * j]);
        if (c < 1280) v += bf2f(PROJ[(size_t)r * NPAD + 16384 + c]);
        if (r < 256) v += bf2f(((const bf16_t*)(a.ws + WS_MKV))[(size_t)r * 2048 + c]);
        for (int z = 0; z < 3; ++z) v += bf2f(((const bf16_t*)(a.ws + WS_WTBR))[((size_t)z * 2048 + (r & 2047)) * 1024 + (c & 1023)]);
        v += bf2f(((const bf16_t*)(a.ws + WS_WTOUT))[(size_t)(r & 2047) * 2048 + c]);
#elif DBG_STAGE == 2
        if (c < 1024) v = bf2f(((const bf16_t*)(a.ws + WS_U))[(size_t)(S + r) * 1024 + c]) + bf2f(((const bf16_t*)(a.ws + WS_U))[(size_t)(2 * S + r) * 1024 + c]);
        else { const float* row = (const float*)(a.ws + WS_SC) + sc_off(r); for (int j = c - 1024; j <= r; j += 1024) v += row[j]; }
#elif DBG_STAGE == 3
        if (c < 256) v = (float)((const int*)(a.ws + WS_SEL))[(size_t)r * 256 + c];
#elif DBG_STAGE == 4
        if (c < 1024) v = bf2f(((const bf16_t*)(a.ws + WS_U))[(size_t)r * 1024 + c]);
#elif DBG_STAGE == 5
        v = bf2f(((const bf16_t*)(a.ws + WS_MERGED))[(size_t)r * DM + c]);
#endif
        a.out[idx] = v;
    }
}
#endif

#define RLX_AGENT __ATOMIC_RELAXED, __HIP_MEMORY_SCOPE_AGENT
#define XB_TMO      128
#define XB_XCNT(j)  (256  + 64 * (j))
#define XB_XSUB(j)  (1280 + 64 * (j))
#define XB_XGEN(j)  (2304 + 64 * (j))
#define XB_TOP      3328
#define XB_TOPGEN   3392
#define XCD_BAR_WORDS 3456
#define XB_SPIN_CAP (1u << 18)

__device__ __forceinline__ unsigned xb_ld(unsigned* p)              { return __hip_atomic_load(p, __ATOMIC_RELAXED, __HIP_MEMORY_SCOPE_AGENT); }
__device__ __forceinline__ unsigned xb_add(unsigned* p, unsigned v) { return __hip_atomic_fetch_add(p, v, __ATOMIC_RELAXED, __HIP_MEMORY_SCOPE_AGENT); }
__device__ __forceinline__ unsigned xb_xcc_id() { return (unsigned)__builtin_amdgcn_s_getreg((3 << 11) | 20) & 0xFu; }
#define XB_SPIN(cond, bar) do { unsigned _sp = 0; while (cond) { __builtin_amdgcn_s_sleep(1); \
    if ((++_sp & 255u) == 0u) { if (xb_ld(&(bar)[XB_TMO])) break; if (_sp > XB_SPIN_CAP) { atomicAdd(&(bar)[XB_TMO], 1u); break; } } } } while (0)

struct XcdBarrier {
    unsigned* bar; unsigned x;
    volatile LAS unsigned* st;
};

__device__ __forceinline__ XcdBarrier xcd_barrier_post(unsigned* bar, volatile LAS unsigned* st, bool leader) {
    XcdBarrier b; b.bar = bar; b.x = xb_xcc_id(); b.st = st;
    if (leader) (void)xb_add(&bar[XB_XCNT(b.x)], 1u);
    return b;
}
__device__ __forceinline__ void xcd_barrier_complete(unsigned* bar, unsigned x, unsigned& nloc, unsigned& nx) {
    const unsigned G = gridDim.x * gridDim.y * gridDim.z;
    unsigned sum, cnt, mine, sp = 0u;
    for (;;) {
        sum = 0u; cnt = 0u; mine = 0u;
#pragma unroll
        for (unsigned j = 0; j < 16; ++j) { const unsigned c = xb_ld(&bar[XB_XCNT(j)]); sum += c; cnt += (c > 0u) ? 1u : 0u; mine = (j == x) ? c : mine; }
        if (sum == G) break;
        __builtin_amdgcn_s_sleep(1);
        if ((++sp & 255u) == 0u) { if (xb_ld(&bar[XB_TMO])) break; if (sp > XB_SPIN_CAP) { atomicAdd(&bar[XB_TMO], 1u); break; } }
    }
    nloc = mine > 0u ? mine : 1u; nx = cnt > 0u ? cnt : 1u;
}

__device__ __forceinline__ void xcd_barrier(const XcdBarrier& b, bool leader) {
    asm volatile("s_waitcnt vmcnt(0)" ::: "memory");
    __syncthreads();
    if (leader) {
        unsigned* bar = b.bar;
        __builtin_amdgcn_s_waitcnt(0);
        unsigned nloc = b.st[0], nx = b.st[1];
        if (nloc == 0u) { xcd_barrier_complete(bar, b.x, nloc, nx); b.st[0] = nloc; b.st[1] = nx; }
        const unsigned old = xb_add(&bar[XB_XSUB(b.x)], 1u);
        const unsigned gen = old / nloc;
        if (old + 1u == (gen + 1u) * nloc) {
            __builtin_amdgcn_fence(__ATOMIC_RELEASE, "agent");
            asm volatile("s_waitcnt vmcnt(0)" ::: "memory");
            const unsigned og = xb_add(&bar[XB_TOP], 1u);
            const unsigned tg = og / nx;
            if (og + 1u == (tg + 1u) * nx) xb_add(&bar[XB_TOPGEN], 1u);
            else XB_SPIN(xb_ld(&bar[XB_TOPGEN]) == tg, bar);
            __builtin_amdgcn_fence(__ATOMIC_ACQUIRE, "agent");
            xb_add(&bar[XB_XGEN(b.x)], 1u);
            asm volatile("s_waitcnt vmcnt(0)" ::: "memory");
        } else {
            XB_SPIN(xb_ld(&bar[XB_XGEN(b.x)]) == gen, bar);
            __builtin_amdgcn_fence(__ATOMIC_ACQUIRE, "agent");
            asm volatile("s_waitcnt vmcnt(0)" ::: "memory");
        }
    }
    __syncthreads();
}

__device__ __forceinline__ void grid_bar(unsigned* cnt, unsigned target, const int wave) {
    asm volatile("s_waitcnt vmcnt(0)" ::: "memory");
    __syncthreads();
    if (wave == 0) {
        if (lane_id_v() == 0) {
            __builtin_amdgcn_fence(__ATOMIC_RELEASE, "agent");
            asm volatile("s_waitcnt vmcnt(0)" ::: "memory");
            __hip_atomic_fetch_add(cnt, 1u, __ATOMIC_RELAXED, __HIP_MEMORY_SCOPE_AGENT);
            while (__hip_atomic_load(cnt, __ATOMIC_RELAXED, __HIP_MEMORY_SCOPE_AGENT) < target) __builtin_amdgcn_s_sleep(2);
            __builtin_amdgcn_fence(__ATOMIC_ACQUIRE, "agent");
            asm volatile("s_waitcnt vmcnt(0)" ::: "memory");
        }
    }
    __syncthreads();
}

constexpr int LDS_BYTES = 147456;
constexpr int NPHASE = 8;
__global__ void __launch_bounds__(512, 2) fwd(Args a) {
    extern __shared__ __attribute__((aligned(16))) unsigned char lds_raw[];
    LAS unsigned char* lds = (LAS unsigned char*)lds_raw;
    cg::grid_group grid = cg::this_grid();
    const int blk = blockIdx.x, nblk = gridDim.x, wave = __builtin_amdgcn_readfirstlane(threadIdx.x >> 6);
    unsigned char* ws = a.ws;
    const bf16_t* PROJ = (const bf16_t*)(ws + WS_PROJ);
    volatile LAS unsigned* xst = (volatile LAS unsigned*)(lds + 147456 - 128);
    if (wave == 0) { if (lane_id_v() == 0) { xst[0] = 0u; xst[1] = 0u; } }
    __syncthreads();
    (void)xcd_barrier_post((unsigned*)(ws + WS_CTL + 16384), xst, wave == 0 && lane_id_v() == 0);
#define IN(k) (a.ph_lo <= (k) && (k) < a.ph_hi)
#define SEAM(k) do { if (IN(k) && IN((k) + 1)) { { XcdBarrier xb_; xb_.bar = (unsigned*)(ws + WS_CTL + 16384); xb_.x = xb_xcc_id(); xb_.st = (volatile LAS unsigned*)(lds + 147456 - 128); xcd_barrier(xb_, wave == 0 && lane_id_v() == 0); } } } while (0)
    if (IN(0)) { p0_prologue_a(a, lds, blk, nblk, wave); grid.sync();
                 p0_prologue_b(a, lds, blk, nblk, wave); } SEAM(0);
    if (IN(1)) {
        {
            pg8::Gemm g8{(const bf16_t*)(ws + WS_H8), (const bf16_t*)(ws + WS_W8), S, 64 * 256, DM / 2, 0, 0};
            pg8::ProjOrder8 so; so.init(S, nblk, blk);
            pg8::EpiProj8 E{(bf16_t*)(ws + WS_PROJ), NPAD, a.in[4], C_GL / 256, (unsigned*)(ws + WS_CTL + 1024), (const float*)(ws + WS_SA), (const float*)(ws + WS_SB)};
            pg8::gemm_phase<pg8::EpiProj8, pg8::ProjOrder8, true, true>(lds, g8, so, E, wave); }
        __syncthreads();
        {
            pg8::Gemm g{(const bf16_t*)(ws + WS_H), (const bf16_t*)(ws + WS_WTIN), S, NPAD, DM, (long)WS_MEMN - (long)WS_H, (long)WS_WTMKV - (long)WS_WTIN};
            pg8::ProjOrderB so; so.init(nblk, blk);
            pg8::EpiProj E{(bf16_t*)(ws + WS_PROJ), NPAD, (bf16_t*)(ws + WS_MKV), 2048, a.in[4], C_GL / 256, (unsigned*)(ws + WS_CTL + 1024)};
            pg8::gemm_phase<pg8::EpiProj, pg8::ProjOrderB, false, true>(lds, g, so, E, wave); }
    } SEAM(1);
    if (IN(2)) { idx::scores_phase(PROJ, (float*)(ws + WS_SC), (unsigned*)(ws + WS_CTL + 448), lds, blk, nblk, wave); __syncthreads(); att::attn_m_phase(a, lds, blk, nblk, wave); } SEAM(2);
    if (IN(3)) { if (blk == nblk - 1) { if (wave == 7) att::build_order((const unsigned*)(ws + WS_CTL + 1024), (unsigned*)(ws + WS_CTL + 4096), lds + 131072, lane_id_v()); }
                 topk_select((const float*)(ws + WS_SC), (int*)(ws + WS_SEL), lds, blk, nblk, wave); } SEAM(3);
    if (IN(4)) { att::attn_ab_phase(a, lds, blk, nblk, wave); } SEAM(4);
    if (IN(5)) {
        pg8::Gemm g{(const bf16_t*)(ws + WS_U), (const bf16_t*)(ws + WS_WTBR), S, DM, 1024, (long)S * 1024 * 2, (long)2048 * 1024 * 2};
        pg8::MergeOrder so; so.init(S, DM, nblk, blk);
        pg8::EpiMerge E{PROJ + C_GL, NPAD, (bf16_t*)(ws + WS_MERGED), DM};
        pg8::gemm_phase<pg8::EpiMerge, pg8::MergeOrder, true, true>(lds, g, so, E, wave);
    } SEAM(5);
    if (IN(6)) {
        pg8::Gemm g{(const bf16_t*)(ws + WS_MERGED), (const bf16_t*)(ws + WS_WTOUT), S, DM, DM, 0, 0};
        pg8::StaticOrder so; so.init(S, DM, nblk, blk);
        pg8::EpiOut E{a.in[0], a.out, DM, (float*)(ws + WS_PART), S};
        pg8::gemm_phase<pg8::EpiOut, pg8::StaticOrder, false, true>(lds, g, so, E, wave);
    } SEAM(6);
    if (IN(7)) { final_norm(a, blk, nblk, wave); }
#ifdef DBG_STAGE
    if (IN(8)) { dbg_dump(a, blk, nblk); }
#endif
#undef IN
#undef SEAM
}

#ifndef N_LAUNCH_MODE
#define N_LAUNCH_MODE 0
#endif
extern "C" void kernel_launch(void* const* d_in, const int* in_sizes, int n_in, void* d_out, int out_size, void* d_ws, size_t ws_size, hipStream_t stream) {
    static int grid = 0;
    if (grid == 0) {
        if (n_in != 17 || in_sizes[0] != S * DM || in_sizes[3] != DM * DIN || out_size != S * DM || ws_size < WS_END) {
            fprintf(stderr, "kernel_launch: unexpected shapes (n_in %d, in0 %d, in3 %d, out %d, ws %zu < %zu)\n", n_in, n_in > 0 ? in_sizes[0] : -1, n_in > 3 ? in_sizes[3] : -1, out_size, ws_size, (size_t)WS_END); grid = -1; return; }
        int dev = 0, cus = 0, per_cu = 0;
        (void)hipGetDevice(&dev); (void)hipDeviceGetAttribute(&cus, hipDeviceAttributeMultiprocessorCount, dev);
        if (hipFuncSetAttribute((const void*)fwd, hipFuncAttributeMaxDynamicSharedMemorySize, LDS_BYTES) != hipSuccess) { fprintf(stderr, "kernel_launch: hipFuncSetAttribute failed\n"); grid = -1; return; }
        if (hipOccupancyMaxActiveBlocksPerMultiprocessor(&per_cu, (const void*)fwd, 512, LDS_BYTES) != hipSuccess || per_cu < 1) { fprintf(stderr, "kernel_launch: occupancy query gave %d\n", per_cu); per_cu = 1; }
        (void)hipGetLastError();
        grid = cus * 1;
        if (grid > cus * per_cu) grid = cus * per_cu;
        if (grid < 8) grid = -1;
    }
    if (grid < 0) return;
    Args a{};
    for (int i = 0; i < 17; ++i) a.in[i] = (const float*)d_in[i];
    a.out = (float*)d_out; a.ws = (unsigned char*)d_ws;
#if N_LAUNCH_MODE == 1
    (void)hipMemsetAsync((unsigned char*)d_ws + WS_CTL + 256, 0, 256, stream);
    (void)hipMemsetAsync((unsigned char*)d_ws + WS_CTL + 16384, 0, 16384, stream);
    (void)hipMemsetAsync((unsigned char*)d_ws + WS_SB, 0, 17664 * 4, stream);
    a.ph_lo = 0; a.ph_hi = NPHASE;
    void* kargs[] = {&a};
    hipError_t e = hipLaunchCooperativeKernel((const void*)fwd, dim3(grid), dim3(512), kargs, LDS_BYTES, stream);
    if (e != hipSuccess) fprintf(stderr, "cooperative launch failed: %s (grid %d)\n", hipGetErrorString(e), grid);
#else
#ifdef DBG_STAGE
    #ifdef DBG_WEIGHTS
    constexpr int last_ph[6] = {0, 0, 2, 3, 4, 5};
#else
    constexpr int last_ph[6] = {0, 1, 2, 3, 4, 5};
#endif
    for (int p = 0; p <= last_ph[DBG_STAGE]; ++p) { a.ph_lo = p; a.ph_hi = p + 1; hipLaunchKernelGGL(fwd, dim3(grid), dim3(512), LDS_BYTES, stream, a); }
    a.ph_lo = 8; a.ph_hi = 9; hipLaunchKernelGGL(fwd, dim3(grid), dim3(512), LDS_BYTES, stream, a);
#else
    for (int p = 0; p < NPHASE; ++p) {
        a.ph_lo = p; a.ph_hi = p + 1;
        hipLaunchKernelGGL(fwd, dim3(grid), dim3(512), LDS_BYTES, stream, a);
    }
#endif
#endif
}
```

```cpp
#define N_LAUNCH_MODE 1
#include <hip/hip_runtime.h>
#include <hip/hip_cooperative_groups.h>
#include <cstdio>
#include <cstdint>
namespace cg = cooperative_groups;

__device__ __forceinline__ int lane_id_v() { int l; asm volatile("v_mbcnt_lo_u32_b32 %0, -1, 0\n\tv_mbcnt_hi_u32_b32 %0, -1, %0" : "=v"(l)); return l; }
namespace pg8 {
#define PG8_LAS __attribute__((address_space(3)))
typedef unsigned short bf16_t;
typedef short bf16x8 __attribute__((ext_vector_type(8)));
typedef float f32x4 __attribute__((ext_vector_type(4)));
typedef int i32x4 __attribute__((ext_vector_type(4)));
typedef unsigned u32x4 __attribute__((ext_vector_type(4)));
constexpr int BM = 256, BK = 64, HALF = 128, HTB = HALF * BK * 2  , STAGE_BYTES = 8 * HTB, NXCD = 8, WGM = 8;

__host__ __device__ __forceinline__ int lds_byte(int r, int c) { const int st = (r >> 4) * 2 + (c >> 5), rr = r & 15, cc = c & 31, ob = rr * 64 + cc * 2; return st * 1024 + (ob ^ (((ob >> 9) & 1) << 5)); }
__host__ __device__ __forceinline__ void stage_rc(int b, int& R, int& C) { const int st = b / 1024, sb = b % 1024, swz = sb ^ (((sb >> 9) & 1) << 5); R = (st >> 1) * 16 + swz / 64; C = (st & 1) * 32 + (swz % 64) / 2; }
__host__ __device__ __forceinline__ int perm32(int rho) { const int n = rho >> 4, i = rho & 15; return 8 * (i >> 2) + 4 * n + (i & 3); }

struct Unit { int pm, pn, z; };
struct Gemm { const bf16_t* A; const bf16_t* Bt; int M, N, K; long zA, zB; };

struct StaticOrder {
    int nM, nN, nwg, G, c;
    __host__ __device__ void init(int M, int N, int G_, int c_) { nM = M / BM; nN = N / BM; nwg = nM * nN; G = G_; c = c_; }
    __host__ __device__ bool next(int i, Unit& u) const {
        const long L = (long)i * G + c; if (L >= nwg) return false;
        int wgid = (int)L; { const int q = nwg / NXCD, r = nwg % NXCD, xcd = wgid % NXCD, off = wgid / NXCD; wgid = (xcd < r ? xcd * (q + 1) : r * (q + 1) + (xcd - r) * q) + off; }
        const int nig = WGM * nN, gid = wgid / nig, fm = gid * WGM, gsz = (nM - fm) < WGM ? (nM - fm) : WGM;
        u.pm = fm + ((wgid % nig) % gsz); u.pn = (wgid % nig) / gsz; u.z = 0; return true;
    }
    __device__ __forceinline__ void a_ready(const Unit&) const {}
    __device__ __forceinline__ void done(const Unit&) const {}
};

typedef float f32x2_t __attribute__((ext_vector_type(2))); typedef __bf16 bf16x2_t __attribute__((ext_vector_type(2)));
__device__ __forceinline__ unsigned cvt_pk_bf16(float lo, float hi) { f32x2_t v = {lo, hi}; bf16x2_t b = __builtin_convertvector(v, bf16x2_t); return __builtin_bit_cast(unsigned, b); }

__device__ __forceinline__ float bf2f(unsigned short u) { return __uint_as_float((unsigned)u << 16); }
__device__ __forceinline__ float sigmoidf_(float v) { return __builtin_amdgcn_rcpf(1.0f + __builtin_amdgcn_exp2f(-1.4426950408889634f * v)); }
template <int MODE> __device__ __forceinline__ float act_(float v, float b) {
    if (MODE == 1) return v * sigmoidf_(v);
    if (MODE == 2) return sigmoidf_(v + b);
    return v;
}
struct EpiProj {
    static constexpr bool PERM = true, AFTER_DRAIN = false, KEEP_ACC = false, I8 = false; typedef f32x4 acc_t;
    bf16_t* O; int ldc; bf16_t* O1; int ldc1; const float* bgate; int gate_tile0;
    unsigned* nslot;
    __device__ __forceinline__ void norms(const f32x4 (&acc)[2][2][4][2], const Unit& u, int wc, int lane) const {
        float wm[2] = {0.f, 0.f};
#pragma unroll
        for (int ai = 0; ai < 2; ++ai)
#pragma unroll
            for (int m = 0; m < 4; ++m)
#pragma unroll
                for (int bj = 0; bj < 2; ++bj) { const f32x4 a = acc[ai][bj][m][0], c = acc[ai][bj][m][1];
                    float s = (a[0] * a[0] + a[1] * a[1]) + (a[2] * a[2] + a[3] * a[3]) + (c[0] * c[0] + c[1] * c[1]) + (c[2] * c[2] + c[3] * c[3]);
                    s += __shfl_xor(s, 16); s += __shfl_xor(s, 32); wm[bj] = fmaxf(wm[bj], s); }
#pragma unroll
        for (int bj = 0; bj < 2; ++bj) { float v = wm[bj]; v = fmaxf(v, __shfl_xor(v, 1)); v = fmaxf(v, __shfl_xor(v, 2)); v = fmaxf(v, __shfl_xor(v, 4)); v = fmaxf(v, __shfl_xor(v, 8));
            if (lane == 0) atomicMax(nslot + (u.pn * 2 + bj) * 4 + wc, __float_as_uint(v)); }
    }
    template <int MODE> __device__ __forceinline__ void put(const f32x4 (&acc)[2][2][4][2], bf16_t* base, int ld, int row0, int col0, const float* bias) const {
        f32x4 bv[2][2];
#pragma unroll
        for (int bj = 0; bj < 2; ++bj)
#pragma unroll
            for (int n = 0; n < 2; ++n) bv[bj][n] = (MODE == 2) ? *(const f32x4*)(bias + bj * HALF + 4 * n) : (f32x4){0.f, 0.f, 0.f, 0.f};
#pragma unroll
        for (int ai = 0; ai < 2; ++ai)
#pragma unroll
            for (int m = 0; m < 4; ++m) { bf16_t* rowp = base + (size_t)(row0 + ai * HALF + m * 16) * ld + col0;
#pragma unroll
                for (int bj = 0; bj < 2; ++bj) { f32x4 v0 = acc[ai][bj][m][0], v1 = acc[ai][bj][m][1];
#pragma unroll
                    for (int e = 0; e < 4; ++e) { v0[e] = act_<MODE>(v0[e], bv[bj][0][e]); v1[e] = act_<MODE>(v1[e], bv[bj][1][e]); }
                    u32x4 w; w.x = cvt_pk_bf16(v0[0], v0[1]); w.y = cvt_pk_bf16(v0[2], v0[3]); w.z = cvt_pk_bf16(v1[0], v1[1]); w.w = cvt_pk_bf16(v1[2], v1[3]);
                    *(u32x4*)(rowp + bj * HALF) = w; } }
    }
    __device__ __forceinline__ void operator()(const f32x4 (&acc)[2][2][4][2], const Unit& u, int wr, int wc, int fr, int fq) const {
        const int row0 = u.pm * BM + wr * 64 + fr, col0 = u.pn * BM + wc * 32 + 8 * fq;
        if (u.z == 1) { put<0>(acc, O1, ldc1, row0, col0, nullptr); return; }
        const int t = u.pn;
        if (t < 8 || (t >= 20 && t < 28)) norms(acc, u, wc, fr + 16 * fq);
        const bool is_silu = (t >= 12 && t < 16) || (t >= 32 && t < 36) || (t >= 40 && t < 44);
        if (t >= gate_tile0 && t < 68) put<2>(acc, O, ldc, row0, col0, bgate + (col0 - gate_tile0 * BM));
        else if (is_silu) put<1>(acc, O, ldc, row0, col0, nullptr);
        else put<0>(acc, O, ldc, row0, col0, nullptr);
    }
};
struct EpiMerge {
    static constexpr bool PERM = true, AFTER_DRAIN = false, KEEP_ACC = true, I8 = false; typedef f32x4 acc_t;
    const bf16_t* G; int ldg;
    bf16_t* O; int ldc;
    __device__ __forceinline__ static void unpack8(const u32x4 gw, f32x4& g0, f32x4& g1) {
        g0[0] = __uint_as_float(gw.x << 16); g0[1] = __uint_as_float(gw.x & 0xffff0000u); g0[2] = __uint_as_float(gw.y << 16); g0[3] = __uint_as_float(gw.y & 0xffff0000u);
        g1[0] = __uint_as_float(gw.z << 16); g1[1] = __uint_as_float(gw.z & 0xffff0000u); g1[2] = __uint_as_float(gw.w << 16); g1[3] = __uint_as_float(gw.w & 0xffff0000u); }
    __device__ __forceinline__ void operator()(f32x4 (&acc)[2][2][4][2], const Unit& u, int wr, int wc, int fr, int fq) const {
        const int row0 = u.pm * BM + wr * 64 + fr, col0 = u.pn * BM + wc * 32 + 8 * fq;
#pragma unroll
        for (int ai = 0; ai < 2; ++ai) {
            u32x4 ga[4][2], gb[4][2];
#pragma unroll
            for (int m = 0; m < 4; ++m)
#pragma unroll
                for (int bj = 0; bj < 2; ++bj) { const bf16_t* gp = G + (size_t)(row0 + ai * HALF + m * 16) * ldg + (size_t)u.z * 2048 + col0 + bj * HALF;
                    ga[m][bj] = *(const u32x4*)gp; gb[m][bj] = (u.z < 2) ? *(const u32x4*)(gp + 2048) : (u32x4){0u, 0u, 0u, 0u}; }
#pragma unroll
            for (int m = 0; m < 4; ++m) { const size_t row = (size_t)(row0 + ai * HALF + m * 16);
#pragma unroll
                for (int bj = 0; bj < 2; ++bj) { const int col = col0 + bj * HALF;
                    f32x4 a0, a1; unpack8(ga[m][bj], a0, a1);
                    f32x4 r0, r1;
                    if (u.z < 2) { f32x4 n0, n1; unpack8(gb[m][bj], n0, n1);
#pragma unroll
                        for (int e = 0; e < 4; ++e) { const float d0 = fmaxf(n0[e], 1e-30f), d1 = fmaxf(n1[e], 1e-30f);
                            const float x0 = (u.z == 0) ? a0[e] : fmaxf(a0[e], 1e-30f), x1 = (u.z == 0) ? a1[e] : fmaxf(a1[e], 1e-30f);
                            r0[e] = x0 * __builtin_amdgcn_rcpf(d0); r1[e] = x1 * __builtin_amdgcn_rcpf(d1); }
                        acc[ai][bj][m][0] *= r0; acc[ai][bj][m][1] *= r1;
                    } else {
#pragma unroll
                        for (int e = 0; e < 4; ++e) { r0[e] = fmaxf(a0[e], 1e-30f); r1[e] = fmaxf(a1[e], 1e-30f); }
                        const f32x4 v0 = acc[ai][bj][m][0] * r0, v1 = acc[ai][bj][m][1] * r1;
                        u32x4 w; w.x = cvt_pk_bf16(v0[0], v0[1]); w.y = cvt_pk_bf16(v0[2], v0[3]); w.z = cvt_pk_bf16(v1[0], v1[1]); w.w = cvt_pk_bf16(v1[2], v1[3]);
                        *(u32x4*)(O + row * ldc + col) = w;
                        acc[ai][bj][m][0] = (f32x4){0.f, 0.f, 0.f, 0.f}; acc[ai][bj][m][1] = (f32x4){0.f, 0.f, 0.f, 0.f}; } } }
        }
    }
};
struct EpiOut {
    static constexpr bool PERM = false, AFTER_DRAIN = false, KEEP_ACC = false, I8 = false; typedef f32x4 acc_t;
    const float* X; float* Y; int ldc; float* part; int M;
    __device__ __forceinline__ void operator()(const f32x4 (&acc)[2][2][4][2], const Unit& u, int wr, int wc, int fr, int fq) const {
        const int row0 = u.pm * BM + wr * 64 + fr, col0 = u.pn * BM + wc * 32 + 4 * fq;
#pragma unroll
        for (int ai = 0; ai < 2; ++ai) {
            f32x4 xv[4][2][2];
#pragma unroll
            for (int m = 0; m < 4; ++m)
#pragma unroll
                for (int bj = 0; bj < 2; ++bj)
#pragma unroll
                    for (int n = 0; n < 2; ++n) xv[m][bj][n] = *(const f32x4*)(X + (size_t)(row0 + ai * HALF + m * 16) * ldc + col0 + bj * HALF + n * 16);
#pragma unroll
            for (int m = 0; m < 4; ++m) { const size_t row = (size_t)(row0 + ai * HALF + m * 16); float ss = 0.f;
#pragma unroll
                for (int bj = 0; bj < 2; ++bj)
#pragma unroll
                    for (int n = 0; n < 2; ++n) { const size_t off = row * ldc + col0 + bj * HALF + n * 16;
                        const f32x4 y = xv[m][bj][n] + acc[ai][bj][m][n]; *(f32x4*)(Y + off) = y;
                        ss += (y[0] * y[0] + y[1] * y[1]) + (y[2] * y[2] + y[3] * y[3]); }
                ss += __shfl_xor(ss, 16); ss += __shfl_xor(ss, 32);
                if (fq == 0) part[(size_t)(u.pn * 4 + wc) * M + row] = ss; }
        }
    }
};
struct EpiProj8 {
    static constexpr bool PERM = true, AFTER_DRAIN = false, KEEP_ACC = false, I8 = true; typedef i32x4 acc_t;
    bf16_t* O; int ldc; const float* bgate; int gate_tile0; unsigned* nslot; const float* sA; const float* sB;
    template <int MODE, bool NORMS> __device__ __forceinline__ void put(const i32x4 (&acc)[2][2][4][2], const Unit& u, int row0, int col0, int wc, int lane) const {
        f32x4 bv[2][2], cs[2][2]; float rs[2][4];
#pragma unroll
        for (int bj = 0; bj < 2; ++bj)
#pragma unroll
            for (int n = 0; n < 2; ++n) { cs[bj][n] = *(const f32x4*)(sB + col0 + bj * HALF + 4 * n) * (1.f / 127.f);
                bv[bj][n] = (MODE == 2) ? *(const f32x4*)(bgate + (col0 - gate_tile0 * BM) + bj * HALF + 4 * n) : (f32x4){0.f, 0.f, 0.f, 0.f}; }
#pragma unroll
        for (int ai = 0; ai < 2; ++ai)
#pragma unroll
            for (int m = 0; m < 4; ++m) rs[ai][m] = sA[row0 + ai * HALF + m * 16];
        float wm[2] = {0.f, 0.f};
#pragma unroll
        for (int ai = 0; ai < 2; ++ai)
#pragma unroll
            for (int m = 0; m < 4; ++m) { bf16_t* rowp = O + (size_t)(row0 + ai * HALF + m * 16) * ldc + col0;
#pragma unroll
                for (int bj = 0; bj < 2; ++bj) { f32x4 v0, v1;
#pragma unroll
                    for (int e = 0; e < 4; ++e) { v0[e] = (float)acc[ai][bj][m][0][e] * (rs[ai][m] * cs[bj][0][e]); v1[e] = (float)acc[ai][bj][m][1][e] * (rs[ai][m] * cs[bj][1][e]); }
                    if (NORMS) { float sq = (v0[0] * v0[0] + v0[1] * v0[1]) + (v0[2] * v0[2] + v0[3] * v0[3]) + (v1[0] * v1[0] + v1[1] * v1[1]) + (v1[2] * v1[2] + v1[3] * v1[3]);
                        sq += __shfl_xor(sq, 16); sq += __shfl_xor(sq, 32); wm[bj] = fmaxf(wm[bj], sq); }
#pragma unroll
                    for (int e = 0; e < 4; ++e) { v0[e] = act_<MODE>(v0[e], bv[bj][0][e]); v1[e] = act_<MODE>(v1[e], bv[bj][1][e]); }
                    u32x4 w; w.x = cvt_pk_bf16(v0[0], v0[1]); w.y = cvt_pk_bf16(v0[2], v0[3]); w.z = cvt_pk_bf16(v1[0], v1[1]); w.w = cvt_pk_bf16(v1[2], v1[3]);
                    *(u32x4*)(rowp + bj * HALF) = w; } }
        if (NORMS) {
#pragma unroll
            for (int bj = 0; bj < 2; ++bj) { float v = wm[bj]; v = fmaxf(v, __shfl_xor(v, 1)); v = fmaxf(v, __shfl_xor(v, 2)); v = fmaxf(v, __shfl_xor(v, 4)); v = fmaxf(v, __shfl_xor(v, 8));
                if (lane == 0) atomicMax(nslot + (u.pn * 2 + bj) * 4 + wc, __float_as_uint(v)); } }
    }
    __device__ __forceinline__ void operator()(const i32x4 (&acc)[2][2][4][2], const Unit& u, int wr, int wc, int fr, int fq) const {
        const int row0 = u.pm * BM + wr * 64 + fr, col0 = u.pn * BM + wc * 32 + 8 * fq, t = u.pn, lane = fr + 16 * fq;
        const bool is_silu = (t >= 12 && t < 16) || (t >= 32 && t < 36) || (t >= 40 && t < 44);
        if (t >= gate_tile0 && t < 68) put<2, false>(acc, u, row0, col0, wc, lane);
        else if (is_silu) put<1, false>(acc, u, row0, col0, wc, lane);
        else if (t < 8 || (t >= 20 && t < 28)) put<0, true>(acc, u, row0, col0, wc, lane);
        else put<0, false>(acc, u, row0, col0, wc, lane);
    }
};
struct ProjOrder8 {
    StaticOrder so;
    __device__ void init(int M, int G, int c) { so.init(M, 64 * BM, G, c); }
    __device__ bool next(int i, Unit& u) const { if (!so.next(i, u)) return false; if (u.pn >= 16) u.pn += 4; return true; }
    __device__ __forceinline__ void a_ready(const Unit&) const {}
    __device__ __forceinline__ void done(const Unit&) const {}
};
struct ProjOrderB {
    int G, c;
    __device__ void init(int G_, int c_) { G = G_; c = c_; }
    __device__ bool next(int i, Unit& u) const { const int L = i * G + c; if (L >= 168) return false;
        if (L < 160) { const int t = L >> 5; u.pm = L & 31; u.pn = (t < 4) ? 16 + t : 68; u.z = 0; } else { u.pm = 0; u.pn = L - 160; u.z = 1; } return true; }
    __device__ __forceinline__ void a_ready(const Unit&) const {}
    __device__ __forceinline__ void done(const Unit&) const {}
};
struct ProjOrder {
    StaticOrder so; int nmain, extra;
    __device__ void init(int M, int N, int G, int c) { so.init(M, N, G, c); nmain = (so.nwg - c + G - 1) / G; extra = (c >= G - 8) ? c - (G - 8) : -1; }
    __device__ bool next(int i, Unit& u) const {
        if (i < nmain) return so.next(i, u);
        if (i == nmain && extra >= 0) { u.pm = 0; u.pn = extra; u.z = 1; return true; }
        return false;
    }
    __device__ __forceinline__ void a_ready(const Unit&) const {}
    __device__ __forceinline__ void done(const Unit&) const {}
};
struct MergeOrder {
    StaticOrder so;
    __device__ void init(int M, int N, int G, int c) { so.init(M, N, G, c); }
    __device__ bool next(int i, Unit& u) const { if (i >= 3) return false; if (!so.next(0, u)) return false; u.z = i; return true; }
    __device__ __forceinline__ void a_ready(const Unit&) const {}
    __device__ __forceinline__ void done(const Unit&) const {}
};

template <class Epi, class Sched, bool ALIGN_EPI = false, bool SP2 = false>
__device__ __forceinline__ void gemm_phase(PG8_LAS unsigned char* lds, const Gemm g, const Sched& S, const Epi& E, const int wid  ) {
    const int lane = lane_id_v(), tid = wid * 64 + lane, wr = wid >> 2, wc = wid & 3, fr = lane & 15, fq = lane >> 4;
    const int K = g.K, nt = K / BK;
    unsigned voffA[2], voffB[2];
#pragma unroll
    for (int i = 0; i < 2; ++i) { int R, C; stage_rc(tid * 16 + i * 8192, R, C); const int Rb = Epi::PERM ? ((R & ~31) + perm32(R & 31)) : R;
        voffA[i] = (unsigned)(R * K + C) * 2u; voffB[i] = (unsigned)(Rb * K + C) * 2u; }
    const size_t kstep = (size_t)(BK * 2);
    const size_t hstep = (size_t)HALF * K * 2;
    const size_t tstep = 2 * hstep;
    const unsigned ldsw = (unsigned)wid * 1024u;
    const int aoff = lds_byte(wr * 64 + fr, fq * 8), boff = lds_byte(wc * 32 + fr, fq * 8);
#define PG8_SA(b, h) (((b) * 2 + (h)) * HTB)
#define PG8_SB(b, h) ((4 + (b) * 2 + (h)) * HTB)
#define PG8_STAGE(bufoff, gbase, voff) do { _Pragma("unroll") for (int _i = 0; _i < 2; ++_i) \
        __builtin_amdgcn_global_load_lds((const unsigned*)((const char*)(gbase) + (voff)[_i]), (PG8_LAS unsigned*)(lds + (bufoff) + ldsw + _i * 8192), 16, 0, 0); } while (0)
#define PG8_LDA(dst, b, h) do { _Pragma("unroll") for (int m = 0; m < 4; ++m) _Pragma("unroll") for (int k = 0; k < 2; ++k) dst[m][k] = *(const PG8_LAS bf16x8*)(lds + PG8_SA(b, h) + aoff + m * 2048 + k * 1024); } while (0)
#define PG8_LDB(dst, b, h) do { _Pragma("unroll") for (int n = 0; n < 2; ++n) _Pragma("unroll") for (int k = 0; k < 2; ++k) dst[n][k] = *(const PG8_LAS bf16x8*)(lds + PG8_SB(b, h) + boff + n * 2048 + k * 1024); } while (0)
#define PG8_MMA(ai, bj, At, Bt) do { __builtin_amdgcn_s_setprio(1); _Pragma("unroll") for (int m = 0; m < 4; ++m) _Pragma("unroll") for (int n = 0; n < 2; ++n) _Pragma("unroll") for (int k = 0; k < 2; ++k) \
        { if constexpr (Epi::I8) acc[ai][bj][m][n] = __builtin_amdgcn_mfma_i32_16x16x64_i8(__builtin_bit_cast(i32x4, Bt[n][k]), __builtin_bit_cast(i32x4, At[m][k]), acc[ai][bj][m][n], 0, 0, 0); \
          else acc[ai][bj][m][n] = __builtin_amdgcn_mfma_f32_16x16x32_bf16(Bt[n][k], At[m][k], acc[ai][bj][m][n], 0, 0, 0); } __builtin_amdgcn_s_setprio(0); } while (0)
#define PG8_WAIT_V(n) asm volatile("s_waitcnt vmcnt(" #n ")" ::: "memory")
#define PG8_WAIT_L(n) asm volatile("s_waitcnt lgkmcnt(" #n ")" ::: "memory")
#define PG8_BAR __builtin_amdgcn_s_barrier()
#define PG8_SCHED __builtin_amdgcn_sched_barrier(0)
    Unit cur, nxt; int ui = 0;
    if (!S.next(0, cur)) return;
    typedef typename Epi::acc_t acc_t;
    acc_t acc[2][2][4][2];
#pragma unroll
    for (int a = 0; a < 2; ++a)
#pragma unroll
        for (int b = 0; b < 2; ++b)
#pragma unroll
            for (int m = 0; m < 4; ++m)
#pragma unroll
                for (int n = 0; n < 2; ++n) acc[a][b][m][n] = acc_t{};
    bf16x8 At[4][2], B0[2][2], B1[2][2];
    const char* cA = (const char*)g.A + (long)cur.z * g.zA + (size_t)cur.pm * tstep; const char* cB = (const char*)g.Bt + (long)cur.z * g.zB + (size_t)cur.pn * tstep;
    S.a_ready(cur);
    if constexpr (SP2) {
        PG8_STAGE(PG8_SB(0, 0), cB, voffB); PG8_STAGE(PG8_SB(0, 1), cB + hstep, voffB); PG8_STAGE(PG8_SA(0, 0), cA, voffA); PG8_STAGE(PG8_SA(0, 1), cA + hstep, voffA);
        if (wr == 1) PG8_BAR;
        PG8_WAIT_V(2); PG8_BAR;
        PG8_STAGE(PG8_SB(1, 0), cB + kstep, voffB); PG8_STAGE(PG8_SA(1, 0), cA + kstep, voffA); PG8_STAGE(PG8_SB(1, 1), cB + hstep + kstep, voffB);
        PG8_WAIT_V(6); PG8_BAR;
    } else {
        PG8_STAGE(PG8_SB(0, 0), cB, voffB); PG8_STAGE(PG8_SA(0, 0), cA, voffA); PG8_STAGE(PG8_SB(0, 1), cB + hstep, voffB); PG8_STAGE(PG8_SA(0, 1), cA + hstep, voffA);
        if (wr == 1) PG8_BAR;
        PG8_WAIT_V(4); PG8_BAR;
        PG8_STAGE(PG8_SB(1, 0), cB + kstep, voffB); PG8_STAGE(PG8_SA(1, 0), cA + kstep, voffA); PG8_STAGE(PG8_SB(1, 1), cB + hstep + kstep, voffB);
        PG8_WAIT_V(6); PG8_BAR;
    }
    for (;;) {
        const bool has_next = S.next(ui + 1, nxt);
        const char* nA = has_next ? (const char*)g.A + (long)nxt.z * g.zA + (size_t)nxt.pm * tstep : cA; const char* nB = has_next ? (const char*)g.Bt + (long)nxt.z * g.zB + (size_t)nxt.pn * tstep : cB;
        for (int t = 0; t < nt; t += 2) {
            const bool last = (t == nt - 2);
            const char* a1 = cA + (size_t)(t + 1) * kstep;
            const char* a2 = last ? nA : cA + (size_t)(t + 2) * kstep; const char* b2 = last ? nB : cB + (size_t)(t + 2) * kstep;
            const char* a3 = a2 + kstep; const char* b3 = b2 + kstep;
            if (last && has_next) S.a_ready(nxt);
            if constexpr (SP2) {
            PG8_LDB(B0, 0, 0); PG8_LDB(B1, 0, 1); PG8_SCHED; PG8_LDA(At, 0, 0); PG8_STAGE(PG8_SA(1, 1), a1 + hstep, voffA);
            PG8_WAIT_V(8); PG8_WAIT_L(0); PG8_BAR; PG8_MMA(0, 0, At, B0); PG8_MMA(0, 1, At, B1); PG8_BAR; PG8_SCHED;
            PG8_LDA(At, 0, 1); PG8_STAGE(PG8_SB(0, 0), b2, voffB); PG8_STAGE(PG8_SB(0, 1), b2 + hstep, voffB); PG8_STAGE(PG8_SA(0, 0), a2, voffA);
            PG8_WAIT_V(8); PG8_WAIT_L(0); PG8_BAR; PG8_MMA(1, 0, At, B0); PG8_MMA(1, 1, At, B1); PG8_BAR; PG8_SCHED;
            PG8_LDB(B0, 1, 0); PG8_LDB(B1, 1, 1); PG8_SCHED; PG8_LDA(At, 1, 0); PG8_STAGE(PG8_SA(0, 1), a2 + hstep, voffA);
            PG8_WAIT_V(8); PG8_WAIT_L(0); PG8_BAR; PG8_MMA(0, 0, At, B0); PG8_MMA(0, 1, At, B1); PG8_BAR; PG8_SCHED;
            PG8_LDA(At, 1, 1); PG8_STAGE(PG8_SB(1, 0), b3, voffB); PG8_STAGE(PG8_SB(1, 1), b3 + hstep, voffB); PG8_STAGE(PG8_SA(1, 0), a3, voffA);
            PG8_WAIT_V(8); PG8_WAIT_L(0); PG8_BAR; PG8_MMA(1, 0, At, B0); PG8_MMA(1, 1, At, B1); PG8_BAR; PG8_SCHED;
            } else {
            PG8_LDB(B0, 0, 0); PG8_SCHED; PG8_LDA(At, 0, 0); PG8_STAGE(PG8_SA(1, 1), a1 + hstep, voffA);
            PG8_WAIT_L(8); PG8_BAR; PG8_WAIT_L(0); PG8_MMA(0, 0, At, B0); PG8_BAR; PG8_SCHED;
            PG8_LDB(B1, 0, 1); PG8_STAGE(PG8_SB(0, 0), b2, voffB);
            PG8_BAR; PG8_WAIT_L(0); PG8_MMA(0, 1, At, B1); PG8_BAR;
            PG8_LDA(At, 0, 1); PG8_STAGE(PG8_SA(0, 0), a2, voffA);
            PG8_BAR; PG8_WAIT_L(0); PG8_MMA(1, 0, At, B0); PG8_BAR; PG8_SCHED;
            PG8_STAGE(PG8_SB(0, 1), b2 + hstep, voffB);
            PG8_WAIT_V(6); PG8_BAR; PG8_MMA(1, 1, At, B1); PG8_BAR;
            PG8_LDB(B0, 1, 0); PG8_SCHED; PG8_LDA(At, 1, 0); PG8_STAGE(PG8_SA(0, 1), a2 + hstep, voffA);
            PG8_WAIT_L(8); PG8_BAR; PG8_WAIT_L(0); PG8_MMA(0, 0, At, B0); PG8_BAR; PG8_SCHED;
            PG8_LDB(B1, 1, 1); PG8_STAGE(PG8_SB(1, 0), b3, voffB);
            PG8_BAR; PG8_WAIT_L(0); PG8_MMA(0, 1, At, B1); PG8_BAR;
            PG8_LDA(At, 1, 1); PG8_STAGE(PG8_SA(1, 0), a3, voffA);
            PG8_BAR; PG8_WAIT_L(0); PG8_MMA(1, 0, At, B0); PG8_BAR; PG8_SCHED;
            PG8_STAGE(PG8_SB(1, 1), b3 + hstep, voffB);
            PG8_WAIT_V(6); PG8_BAR; PG8_MMA(1, 1, At, B1); PG8_BAR;
            }
        }
        if constexpr (ALIGN_EPI) { if (wr == 0) PG8_BAR; }
        if constexpr (!Epi::AFTER_DRAIN) { E(acc, cur, wr, wc, fr, fq); S.done(cur); }
        if (!has_next) break;
        if constexpr (!Epi::KEEP_ACC) {
#pragma unroll
        for (int a = 0; a < 2; ++a)
#pragma unroll
            for (int b = 0; b < 2; ++b)
#pragma unroll
                for (int m = 0; m < 4; ++m)
#pragma unroll
                    for (int n = 0; n < 2; ++n) acc[a][b][m][n] = acc_t{};
        }
        cur = nxt; cA = nA; cB = nB; ++ui;
        if constexpr (ALIGN_EPI) { if (wr == 1) PG8_BAR; }
    }
    PG8_WAIT_V(0);
    if constexpr (!ALIGN_EPI) { if (wr == 0) PG8_BAR; }
    PG8_BAR;
    if constexpr (Epi::AFTER_DRAIN) { E.fused(acc, cur, wr, wc, fr, fq, lds, wid, lane); S.done(cur); }
#undef PG8_SA
#undef PG8_SB
#undef PG8_STAGE
#undef PG8_LDA
#undef PG8_LDB
#undef PG8_MMA
#undef PG8_WAIT_V
#undef PG8_WAIT_L
#undef PG8_BAR
#undef PG8_SCHED
}
}

constexpr int S = 8192, DM = 2048, DIN = 17488, NPAD = 17664, NMEM = 256;
constexpr int C_QA = 0, C_KA = 1024, C_VA = 2048, C_ZA = 3072, C_QI = 4096, C_QB = 5120, C_KB = 6144, C_VB = 7168, C_ZB = 8192, C_QM = 9216, C_ZM = 10240, C_GL = 11264, C_KI = 17408, C_WI = 17472;
constexpr int TOPK = 256;
constexpr float RMS_EPS = 1e-6f;
constexpr size_t MiB = 1u << 20;
constexpr size_t WS_CTL = 0;
constexpr size_t WS_WTIN = 1 * MiB;
constexpr size_t WS_U = 1 * MiB;
constexpr size_t WS_WTMKV = 70 * MiB;
constexpr size_t WS_WTBR = 78 * MiB;
constexpr size_t WS_WTOUT = 90 * MiB;
constexpr size_t WS_MEMN = 98 * MiB;
constexpr size_t WS_MKV = 99 * MiB;
constexpr size_t WS_PROJ = 100 * MiB;
constexpr size_t WS_SC = 376 * MiB;
constexpr size_t WS_MERGED = 376 * MiB;
constexpr size_t WS_H = 376 * MiB;
constexpr size_t WS_W8 = 408 * MiB;
constexpr size_t WS_H8 = 444 * MiB;
constexpr size_t WS_SA = 461 * MiB;
constexpr size_t WS_SB = 462 * MiB;
constexpr size_t WS_SEL = 508 * MiB;
constexpr size_t WS_PART = 516 * MiB;
constexpr size_t WS_END = 517 * MiB;

typedef unsigned short bf16_t;
typedef unsigned u32x4 __attribute__((ext_vector_type(4)));
typedef unsigned u32x2 __attribute__((ext_vector_type(2)));
typedef float f32x4 __attribute__((ext_vector_type(4)));
#define LAS __attribute__((address_space(3)))
__device__ __forceinline__ float bf2f(unsigned short u) { return __uint_as_float((unsigned)u << 16); }
__device__ __forceinline__ float bflo(unsigned w) { return __uint_as_float(w << 16); }
__device__ __forceinline__ float bfhi(unsigned w) { return __uint_as_float(w & 0xffff0000u); }
__device__ __forceinline__ unsigned f2bf(float f) { unsigned u = __float_as_uint(f); return (u + 0x7fffu + ((u >> 16) & 1u)) >> 16; }
__device__ __forceinline__ unsigned pk2(float lo, float hi) { return f2bf(lo) | (f2bf(hi) << 16); }
__device__ __forceinline__ float wave_sum(float v) {
#pragma unroll
    for (int o = 1; o < 64; o <<= 1) v += __shfl_xor(v, o);
    return v;
}
__device__ __forceinline__ size_t sc_off(int r) { const size_t i = (size_t)(r >> 8); return 65536ull * (i * (i + 1) / 2) + (size_t)(r & 255) * 256ull * (i + 1); }

struct Args { const float* in[17]; float* out; unsigned char* ws; int ph_lo, ph_hi; };

template <bool MAPIN>
__device__ __forceinline__ void transpose_item(const float* __restrict__ W, int K, int srcN, bf16_t* WT, LAS float* scr, int item, int ndst, int lane) {
    const int nblk = ndst / 32, kb = item / nblk, nb = item % nblk, k0 = 64 * kb, n0 = 32 * nb;
    const int n = n0 + (lane & 31);
    int src = n;
    if (MAPIN) { src = (n < 5120) ? n : (n < 17408) ? n + 80 : (n < 17488) ? n - 17408 + 5120 : -1; }
    float tv[32];
#pragma unroll
    for (int i = 0; i < 32; ++i) { const int kk = 2 * i + (lane >> 5); tv[i] = (src >= 0) ? W[(size_t)(k0 + kk) * srcN + src] : 0.f; }
#pragma unroll
    for (int i = 0; i < 32; ++i) { const int kk = 2 * i + (lane >> 5); scr[kk * 33 + (lane & 31)] = tv[i]; }
    asm volatile("s_waitcnt lgkmcnt(0)" ::: "memory");
    const int c = lane & 7;
#pragma unroll
    for (int j = 0; j < 4; ++j) { const int nn = (lane >> 3) + 8 * j; const LAS float* s = scr + (8 * c) * 33 + nn;
        u32x4 o; o.x = pk2(s[0 * 33], s[1 * 33]); o.y = pk2(s[2 * 33], s[3 * 33]); o.z = pk2(s[4 * 33], s[5 * 33]); o.w = pk2(s[6 * 33], s[7 * 33]);
        *(u32x4*)(WT + (size_t)(n0 + nn) * K + k0 + 8 * c) = o; }
    asm volatile("s_waitcnt lgkmcnt(0)" ::: "memory");
}
__device__ __forceinline__ void rms_row_to_bf16(const float* __restrict__ xrow, const float* __restrict__ g, bf16_t* orow, int lane) {
    const f32x4* xr = (const f32x4*)xrow + lane; const f32x4* gr = (const f32x4*)g + lane;
    f32x4 v[8]; float s = 0.f;
#pragma unroll
    for (int j = 0; j < 8; ++j) { v[j] = xr[64 * j]; s += (v[j].x * v[j].x + v[j].y * v[j].y) + (v[j].z * v[j].z + v[j].w * v[j].w); }
    const float rs = 1.0f / sqrtf(wave_sum(s) * (1.f / DM) + RMS_EPS);
    u32x2* o8 = (u32x2*)orow + lane;
#pragma unroll
    for (int j = 0; j < 8; ++j) { const f32x4 gg = gr[64 * j]; u32x2 w; w.x = pk2(v[j].x * rs * gg.x, v[j].y * rs * gg.y); w.y = pk2(v[j].z * rs * gg.z, v[j].w * rs * gg.w); o8[64 * j] = w; }
}
__device__ __forceinline__ void colmax_item(const float* __restrict__ W, unsigned* CM, int item, int lane) {
    const int nblk = NPAD / 32, kb = item / nblk, nb = item % nblk, k0 = 64 * kb, n = 32 * nb + (lane & 31);
    const int src = (n < 5120) ? n : (n < 17408) ? n + 80 : (n < 17488) ? n - 17408 + 5120 : -1;
    const int srcc = src < 0 ? 0 : src;
    if (n >= 4096 && n < 5120) return;
    if (n >= 17408) return;
    float tv[32];
#pragma unroll
    for (int i = 0; i < 32; ++i) { const int kk = 2 * i + (lane >> 5); tv[i] = W[(size_t)(k0 + kk) * DIN + srcc]; }
#pragma unroll
    for (int i = 0; i < 32; ++i) tv[i] = (src >= 0) ? tv[i] : 0.f;
    float m = 0.f;
#pragma unroll
    for (int i = 0; i < 32; ++i) m = fmaxf(m, fabsf(tv[i]));
    m = fmaxf(m, __shfl_xor(m, 32));
    if (lane < 32) atomicMax(CM + n, __float_as_uint(m));
}
__device__ __forceinline__ void quant_item(const float* __restrict__ W, const unsigned* CM, signed char* W8, bf16_t* WT, LAS float* scr, int item, int lane) {
    const int nblk = NPAD / 32, kb = item / nblk, nb = item % nblk, k0 = 64 * kb, n0 = 32 * nb, n = n0 + (lane & 31);
    const int src = (n < 5120) ? n : (n < 17408) ? n + 80 : (n < 17488) ? n - 17408 + 5120 : -1;
    const int srcc = src < 0 ? 0 : src;
    const bool isb = (n0 >= 4096 && n0 < 5120) || n0 >= 17408;
    float tv[32];
#pragma unroll
    for (int i = 0; i < 32; ++i) { const int kk = 2 * i + (lane >> 5); tv[i] = W[(size_t)(k0 + kk) * DIN + srcc]; }
#pragma unroll
    for (int i = 0; i < 32; ++i) tv[i] = (src >= 0) ? tv[i] : 0.f;
    float q = 1.f;
    if (!isb) { const float cm = __uint_as_float(__hip_atomic_load(CM + n, __ATOMIC_RELAXED, __HIP_MEMORY_SCOPE_AGENT)); q = cm > 0.f ? 127.f / cm : 0.f; }
#pragma unroll
    for (int i = 0; i < 32; ++i) { const int kk = 2 * i + (lane >> 5); scr[kk * 33 + (lane & 31)] = isb ? tv[i] : rintf(tv[i] * q); }
    asm volatile("s_waitcnt lgkmcnt(0)" ::: "memory");
    const int c = lane & 7;
#pragma unroll
    for (int j = 0; j < 4; ++j) { const int nn = (lane >> 3) + 8 * j; const LAS float* p = scr + (8 * c) * 33 + nn;
        if (isb) { u32x4 o; o.x = pk2(p[0 * 33], p[1 * 33]); o.y = pk2(p[2 * 33], p[3 * 33]); o.z = pk2(p[4 * 33], p[5 * 33]); o.w = pk2(p[6 * 33], p[7 * 33]);
            *(u32x4*)(WT + (size_t)(n0 + nn) * DM + k0 + 8 * c) = o; }
        else { u32x2 o;
            o.x = ((unsigned)(int)p[0 * 33] & 0xffu) | (((unsigned)(int)p[1 * 33] & 0xffu) << 8) | (((unsigned)(int)p[2 * 33] & 0xffu) << 16) | (((unsigned)(int)p[3 * 33] & 0xffu) << 24);
            o.y = ((unsigned)(int)p[4 * 33] & 0xffu) | (((unsigned)(int)p[5 * 33] & 0xffu) << 8) | (((unsigned)(int)p[6 * 33] & 0xffu) << 16) | (((unsigned)(int)p[7 * 33] & 0xffu) << 24);
            *(u32x2*)(W8 + (size_t)(n0 + nn) * DM + k0 + 8 * c) = o; } }
    asm volatile("s_waitcnt lgkmcnt(0)" ::: "memory");
}
__device__ __forceinline__ void rms_row_quant(const float* __restrict__ xrow, const float* __restrict__ g, bf16_t* orow, signed char* o8row, float* sA, int lane) {
    const f32x4* xr = (const f32x4*)xrow + lane; const f32x4* gr = (const f32x4*)g + lane;
    f32x4 v[8]; float s = 0.f;
#pragma unroll
    for (int j = 0; j < 8; ++j) { v[j] = xr[64 * j]; s += (v[j].x * v[j].x + v[j].y * v[j].y) + (v[j].z * v[j].z + v[j].w * v[j].w); }
    const float rs = 1.0f / sqrtf(wave_sum(s) * (1.f / DM) + RMS_EPS);
    float mx = 0.f;
#pragma unroll
    for (int j = 0; j < 8; ++j) { const f32x4 gg = gr[64 * j]; v[j].x = v[j].x * rs * gg.x; v[j].y = v[j].y * rs * gg.y; v[j].z = v[j].z * rs * gg.z; v[j].w = v[j].w * rs * gg.w;
        mx = fmaxf(mx, fmaxf(fmaxf(fabsf(v[j].x), fabsf(v[j].y)), fmaxf(fabsf(v[j].z), fabsf(v[j].w)))); }
#pragma unroll
    for (int o = 1; o < 64; o <<= 1) mx = fmaxf(mx, __shfl_xor(mx, o));
    const float q = mx > 0.f ? 127.f / mx : 0.f;
    if (lane == 0) *sA = mx * (1.f / 127.f);
    u32x2* o16 = (u32x2*)orow + lane; unsigned* o8 = (unsigned*)o8row + lane;
#pragma unroll
    for (int j = 0; j < 8; ++j) { u32x2 w; w.x = pk2(v[j].x, v[j].y); w.y = pk2(v[j].z, v[j].w); o16[64 * j] = w;
        o8[64 * j] = ((unsigned)(int)rintf(v[j].x * q) & 0xffu) | (((unsigned)(int)rintf(v[j].y * q) & 0xffu) << 8) | (((unsigned)(int)rintf(v[j].z * q) & 0xffu) << 16) | (((unsigned)(int)rintf(v[j].w * q) & 0xffu) << 24); }
}
__device__ __forceinline__ void p0_prologue_a(const Args& a, LAS unsigned char* lds, int blk, int nblk, const int wave) {
    const int lane = lane_id_v(), tid = wave * 64 + lane;
    LAS float* scr = (LAS float*)(lds + wave * 16384);
    const int gw = blk * 8 + wave, NGW = nblk * 8;
    unsigned char* ws = a.ws;
    constexpr int I_IN = (DM / 64) * (NPAD / 32), I_MKV = (DM / 64) * (2048 / 32), I_BR = (1024 / 64) * (2048 / 32), I_OUT = (DM / 64) * (2048 / 32);
    constexpr int NITEMS = I_IN + I_MKV + 3 * I_BR + I_OUT;
    for (int it = gw; it < NITEMS; it += NGW) {
        int r = it;
        if (r < I_IN) { colmax_item(a.in[3], (unsigned*)(ws + WS_SB), r, lane); continue; } r -= I_IN;
        if (r < I_MKV) { transpose_item<false>(a.in[11], DM, 2048, (bf16_t*)(ws + WS_WTMKV), scr, r, 2048, lane); continue; } r -= I_MKV;
        if (r < 3 * I_BR) { const int z = r / I_BR; transpose_item<false>(a.in[12 + z], 1024, 2048, (bf16_t*)(ws + WS_WTBR) + (size_t)z * 2048 * 1024, scr, r % I_BR, 2048, lane); continue; } r -= 3 * I_BR;
        transpose_item<false>(a.in[15], DM, 2048, (bf16_t*)(ws + WS_WTOUT), scr, r, 2048, lane);
    }
    bf16_t* H = (bf16_t*)(ws + WS_H);
    for (int m = gw; m < S + NMEM; m += NGW) {
        if (m < S) rms_row_quant(a.in[0] + (size_t)m * DM, a.in[2], H + (size_t)m * DM, (signed char*)(ws + WS_H8) + (size_t)m * DM, (float*)(ws + WS_SA) + m, lane);
        else rms_row_to_bf16(a.in[1] + (size_t)(m - S) * DM, a.in[10], (bf16_t*)(ws + WS_MEMN) + (size_t)(m - S) * DM, lane);
    }
    if (blk == 0) { for (int i = tid; i < 640; i += 512) ((unsigned*)(ws + WS_CTL + 1024))[i] = 0u; }
    if (blk == 0 && wave == 0) {
        const float s1 = wave_sum(a.in[5][lane] * a.in[6][lane]), s2 = wave_sum(a.in[7][lane] * a.in[8][lane]);
        if (lane == 0) ((float*)(ws + WS_CTL))[0] = expf(s1) - expf(s2) + 0.2f;
    }
}
__device__ __forceinline__ void p0_prologue_b(const Args& a, LAS unsigned char* lds, int blk, int nblk, const int wave) {
    const int lane = lane_id_v();
    LAS float* scr = (LAS float*)(lds + wave * 16384);
    const int gw = blk * 8 + wave, NGW = nblk * 8;
    unsigned char* ws = a.ws;
    constexpr int I_IN = (DM / 64) * (NPAD / 32);
    for (int it = gw; it < I_IN; it += NGW) quant_item(a.in[3], (const unsigned*)(ws + WS_SB), (signed char*)(ws + WS_W8), (bf16_t*)(ws + WS_WTIN), scr, it, lane);
}

__device__ __forceinline__ void idx_scores_naive(const bf16_t* __restrict__ PROJ, float* SC, LAS unsigned char* lds, int blk, int nblk, const int wave) {
    const int lane = lane_id_v(), tid = wave * 64 + lane;
    LAS float* qs = (LAS float*)lds + wave * 1088;
    constexpr int NITEM = 128 * 129 / 2;
    for (int it = blk; it < NITEM; it += nblk) {
        int kb = 0, rem = it; while (rem >= 128 - kb) { rem -= 128 - kb; ++kb; }
        const int qc = kb + rem, s = 64 * kb + lane;
        float kreg[64];
        { const u32x4* kp = (const u32x4*)(PROJ + (size_t)s * NPAD + C_KI);
#pragma unroll
          for (int i = 0; i < 8; ++i) { const u32x4 w = kp[i]; kreg[8 * i + 0] = bflo(w.x); kreg[8 * i + 1] = bfhi(w.x); kreg[8 * i + 2] = bflo(w.y); kreg[8 * i + 3] = bfhi(w.y);
              kreg[8 * i + 4] = bflo(w.z); kreg[8 * i + 5] = bfhi(w.z); kreg[8 * i + 6] = bflo(w.w); kreg[8 * i + 7] = bfhi(w.w); } }
        for (int qq = 0; qq < 8; ++qq) {
            const int q = 64 * qc + wave * 8 + qq;
            { const u32x4* qp = (const u32x4*)(PROJ + (size_t)q * NPAD + C_QI) + 2 * lane;
              const u32x4 w0 = qp[0], w1 = qp[1];
              LAS f32x4* dst = (LAS f32x4*)(qs + 16 * lane);
              dst[0] = (f32x4){bflo(w0.x), bfhi(w0.x), bflo(w0.y), bfhi(w0.y)}; dst[1] = (f32x4){bflo(w0.z), bfhi(w0.z), bflo(w0.w), bfhi(w0.w)};
              dst[2] = (f32x4){bflo(w1.x), bfhi(w1.x), bflo(w1.y), bfhi(w1.y)}; dst[3] = (f32x4){bflo(w1.z), bfhi(w1.z), bflo(w1.w), bfhi(w1.w)};
              if (lane < 16) qs[1024 + lane] = bf2f(PROJ[(size_t)q * NPAD + C_WI + lane]) * 0.25f; }
            asm volatile("s_waitcnt lgkmcnt(0)" ::: "memory"); __builtin_amdgcn_wave_barrier();
            float score = 0.f;
            for (int j = 0; j < 16; ++j) {
                float acc = 0.f; const LAS f32x4* qj = (const LAS f32x4*)(qs + 64 * j);
#pragma unroll
                for (int d = 0; d < 16; ++d) { const f32x4 qv = qj[d]; acc += qv.x * kreg[4 * d] + qv.y * kreg[4 * d + 1] + qv.z * kreg[4 * d + 2] + qv.w * kreg[4 * d + 3]; }
                score += fmaxf(acc * 0.125f, 0.f) * qs[1024 + j];
            }
            if (s <= q) SC[sc_off(q) + s] = score;
            asm volatile("s_waitcnt lgkmcnt(0)" ::: "memory"); __builtin_amdgcn_wave_barrier();
        }
    }
}
__device__ __forceinline__ unsigned ordkey(float f) { const unsigned u = __float_as_uint(f); return (u & 0x80000000u) ? ~u : (u | 0x80000000u); }
template <int NR, int NL> __device__ __forceinline__ bool topk_row(const float* __restrict__ row, int n, int lane, LAS u32x4* xl, unsigned long long& w0, unsigned long long& w1, unsigned& Tout, int& need_out) {
#pragma unroll
    for (int q = 0; q < NL / 4; ++q) { u32x4 v;
#pragma unroll
        for (int e = 0; e < 4; ++e) { const int i = 4096 + (4 * q + e) * 64 + lane; v[e] = (ordkey(*(const float*)((const char*)row + 4u * (unsigned)min(i, n - 1))) >> 1) & (unsigned)((i - n) >> 31); }
        xl[q * 64 + lane] = v;
        if ((q & 3) == 3) __builtin_amdgcn_sched_barrier(0); }
    unsigned u[NR];
#pragma unroll
    for (int k = 0; k < NR; ++k) { const int i = k * 64 + lane; u[k] = (ordkey(*(const float*)((const char*)row + 4u * (unsigned)min(i, n - 1))) >> 1) & (unsigned)((i - n) >> 31);
        if ((k & 15) == 15) __builtin_amdgcn_sched_barrier(0); }
    unsigned T = 0u; bool cut = false;
    for (int bit = 30; bit >= 0; --bit) {
        const unsigned cand = T | (1u << bit); unsigned lt = 0u;
        asm volatile("" ::: "memory");
#pragma unroll
        for (int k = 0; k < NR; ++k) lt += (u[k] - cand) >> 31;
#pragma unroll
        for (int q = 0; q < NL / 4; ++q) { const u32x4 v = xl[q * 64 + lane]; lt += ((v[0] - cand) >> 31) + ((v[1] - cand) >> 31) + ((v[2] - cand) >> 31) + ((v[3] - cand) >> 31);
            if ((q & 3) == 3) __builtin_amdgcn_sched_barrier(0); }
#pragma unroll
        for (int o = 1; o < 64; o <<= 1) lt += __shfl_xor(lt, o);
        const int ge = (int)((NR + NL) * 64 - lt);
        if (ge >= TOPK) T = cand;
        if (ge == TOPK) { cut = true; break; }
    }
    unsigned c_hi = 0u, c_lt = 0u;
#pragma unroll
    for (int k = 0; k < NR; ++k) { c_hi += (T - u[k]) >> 31; c_lt += (u[k] - T) >> 31; }
#pragma unroll
    for (int q = 0; q < NL / 4; ++q) { const u32x4 v = xl[q * 64 + lane];
#pragma unroll
        for (int e = 0; e < 4; ++e) { c_hi += (T - v[e]) >> 31; c_lt += (v[e] - T) >> 31; } }
#pragma unroll
    for (int o = 1; o < 64; o <<= 1) { c_hi += __shfl_xor(c_hi, o); c_lt += __shfl_xor(c_lt, o); }
    const int need = TOPK - (int)c_hi, c_eq = (NR + NL) * 64 - (int)c_lt - (int)c_hi;
    Tout = T; need_out = need;
    if (!cut && c_eq != need) return false;
    int ln; asm volatile("v_mbcnt_lo_u32_b32 %0, -1, 0\n\tv_mbcnt_hi_u32_b32 %0, -1, %0" : "=v"(ln));
#pragma unroll
    for (int k = 0; k < NR; ++k) {
        const unsigned long long bs = __ballot(u[k] >= T);
        if (k == ln) w0 = bs;
        __builtin_amdgcn_sched_barrier(0); }
#pragma unroll
    for (int q = 0; q < NL / 4; ++q) { const u32x4 v = xl[q * 64 + lane];
#pragma unroll
        for (int e = 0; e < 4; ++e) { const unsigned long long bs = __ballot(v[e] >= T);
            if (4 * q + e == ln) w1 = bs;
            __builtin_amdgcn_sched_barrier(0); } }
    return true;
}
__device__ __forceinline__ void topk_select(const float* SC, int* SEL, LAS unsigned char* lds, int blk, int nblk, const int wave) {
    const int lane = lane_id_v();
    LAS u32x4* xl = (LAS u32x4*)(lds + wave * 16384);
    for (int r = blk * 8 + wave; r < S; r += nblk * 8) {
        const int n = r + 1; unsigned long long* mrow = (unsigned long long*)SEL + (size_t)r * 128;
        unsigned long long w0 = 0ull, w1 = 0ull;
        const int nwords = 4 * ((r >> 8) + 1);
        if (n <= TOPK) { const int lo = 64 * lane; w0 = (r < lo) ? 0ull : ((r - lo >= 63) ? ~0ull : ((2ull << (r - lo)) - 1ull)); }
        else { const float* row = SC + sc_off(r);
            unsigned T; int need; bool ok;
            if (n <= 2048) ok = topk_row<32, 0>(row, n, lane, xl, w0, w1, T, need); else if (n <= 4096) ok = topk_row<64, 0>(row, n, lane, xl, w0, w1, T, need); else ok = topk_row<64, 64>(row, n, lane, xl, w0, w1, T, need);
            if (!ok) { int eqc = 0; const unsigned long long lt = (lane == 0) ? 0ull : (~0ull >> (64 - lane));
                for (int base = 0, it = 0; base < n; base += 64, ++it) {
                    const int i = base + lane; const unsigned v = (i < n) ? (ordkey(row[i]) >> 1) : 0u;
                    const bool gt = v > T, eq = (i < n) && (v == T);
                    const unsigned long long be = __ballot(eq);
                    const bool take = gt || (eq && (eqc + __builtin_popcountll(be & lt) < need));
                    const unsigned long long bs = __ballot(take);
                    if ((it & 63) == lane) { if (it < 64) w0 = bs; else w1 = bs; }
                    eqc += __builtin_popcountll(be); } } }
        if (lane < nwords) mrow[lane] = w0;
        if (64 + lane < nwords) mrow[64 + lane] = w1;
    }
}
template <int DQ, int DV, bool GATHER>
__device__ __forceinline__ void naive_attn(const bf16_t* __restrict__ qp, const bf16_t* __restrict__ kb, const bf16_t* __restrict__ vb, size_t kvpitch,
                                           int nkeys, int nmax, const int* __restrict__ sel, int r, float scale, float slope, float (&o)[DV / 8]) {
    constexpr int QN = DQ / 8, VN = DV / 8;
    float q[QN];
#pragma unroll
    for (int i = 0; i < QN / 2; ++i) { const unsigned w = ((const unsigned*)qp)[i]; q[2 * i] = bflo(w) * scale; q[2 * i + 1] = bfhi(w) * scale; }
#pragma unroll
    for (int i = 0; i < VN; ++i) o[i] = 0.f;
    float m = -1e30f, l = 0.f;
    for (int i = 0; i < nmax; ++i) {
        bool valid = i < nkeys; int key = i;
        if (GATHER) { key = sel[valid ? i : 0]; valid = valid && key >= 0; }
        if (!valid) key = 0;
        const unsigned* kp = (const unsigned*)(kb + (size_t)key * kvpitch);
        float d = 0.f;
#pragma unroll
        for (int j = 0; j < QN / 2; ++j) { const unsigned w = kp[j]; d += q[2 * j] * bflo(w) + q[2 * j + 1] * bfhi(w); }
        d += __shfl_xor(d, 1); d += __shfl_xor(d, 2); d += __shfl_xor(d, 4);
        const float logit = d - slope * (float)(r - key);
        if (valid) {
            if (logit > m) { const float c = __expf(m - logit); l *= c;
#pragma unroll
                for (int j = 0; j < VN; ++j) o[j] *= c;
                m = logit; }
            const float p = __expf(logit - m); l += p;
            const unsigned* vp = (const unsigned*)(vb + (size_t)key * kvpitch);
#pragma unroll
            for (int j = 0; j < VN / 2; ++j) { const unsigned w = vp[j]; o[2 * j] += p * bflo(w); o[2 * j + 1] += p * bfhi(w); }
        }
    }
    const float il = 1.0f / l;
#pragma unroll
    for (int j = 0; j < VN; ++j) o[j] *= il;
}
__device__ __forceinline__ void attn_b_naive(const Args& a, int blk, int nblk, const int wave) {
    const int lane = lane_id_v(), tid = wave * 64 + lane, sub = lane & 7;
    const bf16_t* PROJ = (const bf16_t*)(a.ws + WS_PROJ); bf16_t* UB = (bf16_t*)(a.ws + WS_U) + (size_t)1 * S * 1024;
    const float lam = ((const float*)(a.ws + WS_CTL))[0];
    for (int wi = blk * 8 + wave; wi < 1024 * 8; wi += nblk * 8) {
        const int h = wi & 7, rg = wi >> 3, r = rg * 8 + (lane >> 3), nmax = rg * 8 + 8;
        const float slope = exp2f(-(float)(h + 1));
        float o0[16], o1[16];
        const bf16_t* rowp = PROJ + (size_t)r * NPAD;
        naive_attn<64, 128, false>(rowp + C_QB + h * 128 + sub * 8, PROJ + C_KB + h * 128 + sub * 8, PROJ + C_VB + h * 128 + sub * 16, NPAD, r + 1, nmax, nullptr, r, 0.125f, slope, o0);
        naive_attn<64, 128, false>(rowp + C_QB + h * 128 + 64 + sub * 8, PROJ + C_KB + h * 128 + 64 + sub * 8, PROJ + C_VB + h * 128 + sub * 16, NPAD, r + 1, nmax, nullptr, r, 0.125f, slope, o1);
        float ss = 0.f;
#pragma unroll
        for (int j = 0; j < 16; ++j) { o0[j] -= lam * o1[j]; ss += o0[j] * o0[j]; }
        ss += __shfl_xor(ss, 1); ss += __shfl_xor(ss, 2); ss += __shfl_xor(ss, 4);
        const float rs = 1.0f / sqrtf(ss * (1.f / 128.f) + RMS_EPS) * 0.8f;
        const float* g = a.in[9] + sub * 16; const bf16_t* zp = rowp + C_ZB + h * 128 + sub * 16;
        unsigned w[8];
#pragma unroll
        for (int j = 0; j < 8; ++j) w[j] = pk2(o0[2 * j] * rs * g[2 * j] * bf2f(zp[2 * j]), o0[2 * j + 1] * rs * g[2 * j + 1] * bf2f(zp[2 * j + 1]));
        u32x4* dst = (u32x4*)(UB + (size_t)r * 1024 + h * 128 + sub * 16);
        dst[0] = (u32x4){w[0], w[1], w[2], w[3]}; dst[1] = (u32x4){w[4], w[5], w[6], w[7]};
    }
}
__device__ __forceinline__ void attn_m_naive(const Args& a, int blk, int nblk, const int wave) {
    const int lane = lane_id_v(), tid = wave * 64 + lane, sub = lane & 7;
    const bf16_t* PROJ = (const bf16_t*)(a.ws + WS_PROJ); const bf16_t* MKV = (const bf16_t*)(a.ws + WS_MKV); bf16_t* UM = (bf16_t*)(a.ws + WS_U) + (size_t)2 * S * 1024;
    for (int wi = blk * 8 + wave; wi < 1024 * 4; wi += nblk * 8) {
        const int h = wi & 3, rg = wi >> 2, r = rg * 8 + (lane >> 3);
        float o[32];
        const bf16_t* rowp = PROJ + (size_t)r * NPAD;
        naive_attn<256, 256, false>(rowp + C_QM + h * 256 + sub * 32, MKV + h * 256 + sub * 32, MKV + 1024 + h * 256 + sub * 32, 2048, NMEM, NMEM, nullptr, 0, 0.0625f, 0.f, o);
        const bf16_t* zp = rowp + C_ZM + h * 256 + sub * 32;
        u32x4* dst = (u32x4*)(UM + (size_t)r * 1024 + h * 256 + sub * 32);
#pragma unroll
        for (int j = 0; j < 4; ++j) { u32x4 w;
            w.x = pk2(o[8 * j + 0] * bf2f(zp[8 * j + 0]), o[8 * j + 1] * bf2f(zp[8 * j + 1])); w.y = pk2(o[8 * j + 2] * bf2f(zp[8 * j + 2]), o[8 * j + 3] * bf2f(zp[8 * j + 3]));
            w.z = pk2(o[8 * j + 4] * bf2f(zp[8 * j + 4]), o[8 * j + 5] * bf2f(zp[8 * j + 5])); w.w = pk2(o[8 * j + 6] * bf2f(zp[8 * j + 6]), o[8 * j + 7] * bf2f(zp[8 * j + 7]));
            dst[j] = w; }
    }
}
__device__ __forceinline__ void attn_a_naive(const Args& a, int blk, int nblk, const int wave) {
    const int lane = lane_id_v(), tid = wave * 64 + lane, sub = lane & 7;
    const bf16_t* PROJ = (const bf16_t*)(a.ws + WS_PROJ); const int* SEL = (const int*)(a.ws + WS_SEL); bf16_t* UA = (bf16_t*)(a.ws + WS_U);
    for (int wi = blk * 8 + wave; wi < 1024 * 8; wi += nblk * 8) {
        const int h = wi & 7, rg = wi >> 3, r = rg * 8 + (lane >> 3);
        const float slope = exp2f(-(float)(h + 1));
        float o[16];
        const bf16_t* rowp = PROJ + (size_t)r * NPAD;
        naive_attn<128, 128, true>(rowp + C_QA + h * 128 + sub * 16, PROJ + C_KA + h * 128 + sub * 16, PROJ + C_VA + h * 128 + sub * 16, NPAD, TOPK, TOPK, SEL + (size_t)r * TOPK, r, 0.08838834764831845f, slope, o);
        const bf16_t* zp = rowp + C_ZA + h * 128 + sub * 16;
        unsigned w[8];
#pragma unroll
        for (int j = 0; j < 8; ++j) w[j] = pk2(o[2 * j] * bf2f(zp[2 * j]), o[2 * j + 1] * bf2f(zp[2 * j + 1]));
        u32x4* dst = (u32x4*)(UA + (size_t)r * 1024 + h * 128 + sub * 16);
        dst[0] = (u32x4){w[0], w[1], w[2], w[3]}; dst[1] = (u32x4){w[4], w[5], w[6], w[7]};
    }
}
__device__ __forceinline__ void final_norm(const Args& a, int blk, int nblk, const int wave) {
    const int lane = lane_id_v(), tid = wave * 64 + lane;
    const float* part = (const float*)(a.ws + WS_PART); const f32x4* g = (const f32x4*)a.in[16] + lane;
    for (int r = blk * 8 + wave; r < S; r += nblk * 8) {
        float s = (lane < 32) ? part[(size_t)lane * S + r] : 0.f;
        const float rs = 1.0f / sqrtf(wave_sum(s) * (1.f / DM) + RMS_EPS);
        f32x4* y = (f32x4*)(a.out + (size_t)r * DM) + lane;
#pragma unroll
        for (int j = 0; j < 8; ++j) { f32x4 v = y[64 * j]; const f32x4 gg = g[64 * j]; v = v * rs * gg; y[64 * j] = v; }
    }
}


namespace att {
typedef short bf16x8 __attribute__((ext_vector_type(8)));
typedef short s16x4 __attribute__((ext_vector_type(4)));
typedef float f32x16 __attribute__((ext_vector_type(16)));
typedef float f32x2_t __attribute__((ext_vector_type(2)));
typedef __bf16 bf16x2_t __attribute__((ext_vector_type(2)));
constexpr int SHM_V = 16384, SHM_K = 16384;
constexpr float LOG2E = 1.4426950408889634f;
constexpr float THR2 = 8.f * LOG2E;
#define KSWZ(row, colB) ((row) * 256 + ((colB) ^ (((row) & 7) << 4)))
#define SBAR() __builtin_amdgcn_sched_barrier(0)
__device__ __forceinline__ int crow(int r, int hi) { return (r & 3) + 8 * (r >> 2) + 4 * hi; }
__device__ __forceinline__ unsigned cvtpk(float lo, float hi) { f32x2_t v = {lo, hi}; bf16x2_t b = __builtin_convertvector(v, bf16x2_t); return __builtin_bit_cast(unsigned, b); }
__device__ __forceinline__ int v_st(int k, int c) { const int kk = (k & ~0xC) | ((k & 4) << 1) | ((k & 8) >> 1); return ((kk >> 3) * 4 + (c >> 5)) * 512 + ((kk & 7) * 32 + (c & 31)) * 2; }
__device__ __forceinline__ int v_rd_base(int lane) { return ((lane & 3) << 3) | (((lane >> 2) & 3) << 6) | (((lane >> 4) & 1) << 5) | (((lane >> 5) & 1) << 8); }
constexpr int v_rd_off(int d0, int ks, int half) { return d0 * 512 + ks * 4096 + half * 2048; }
typedef short v4i16_t __attribute__((ext_vector_type(4)));
__device__ __forceinline__ s16x4 tr_read(LAS const unsigned char* p) { return __builtin_bit_cast(s16x4, __builtin_amdgcn_ds_read_tr16_b64_v4i16((LAS v4i16_t*)p)); }

template <int NQ> __device__ __forceinline__ void qkt(f32x16& p0, f32x16& p1, LAS const unsigned char* Ks, const bf16x8* qr, int cbyte0, int r32, int hi) {
  p0 = f32x16{}; p1 = f32x16{};
#pragma unroll
  for (int d0 = 0; d0 < NQ; ++d0) { const int cb = cbyte0 + (d0 * 16 + hi * 8) * 2;
    const bf16x8 b0 = *(LAS const bf16x8*)(Ks + KSWZ(r32, cb));
    const bf16x8 b1 = *(LAS const bf16x8*)(Ks + KSWZ(32 + r32, cb));
    p0 = __builtin_amdgcn_mfma_f32_32x32x16_bf16(b0, qr[d0], p0, 0, 0, 0);
    p1 = __builtin_amdgcn_mfma_f32_32x32x16_bf16(b1, qr[d0], p1, 0, 0, 0); }
}
template <int NQ> __device__ __forceinline__ void qkt_l(f32x16& p0, f32x16& p1, LAS const unsigned char* Ks, LAS const unsigned char* Qs, int cbyte0, int r32, int hi) {
  p0 = f32x16{}; p1 = f32x16{};
  asm volatile("" : "+v"(Qs));
#pragma unroll
  for (int d0 = 0; d0 < NQ; ++d0) { const int cb = cbyte0 + (d0 * 16 + hi * 8) * 2;
    const bf16x8 q = *(LAS const bf16x8*)(Qs + d0 * 1024);
    const bf16x8 b0 = *(LAS const bf16x8*)(Ks + KSWZ(r32, cb));
    const bf16x8 b1 = *(LAS const bf16x8*)(Ks + KSWZ(32 + r32, cb));
    p0 = __builtin_amdgcn_mfma_f32_32x32x16_bf16(b0, q, p0, 0, 0, 0);
    p1 = __builtin_amdgcn_mfma_f32_32x32x16_bf16(b1, q, p1, 0, 0, 0); }
}
template <int D0> __device__ __forceinline__ void pv_one(f32x16& od, LAS const unsigned char* vb, bf16x8 pa0, bf16x8 pa1, bf16x8 pa2, bf16x8 pa3) {
  const s16x4 l0 = tr_read(vb + v_rd_off(D0, 0, 0)), h0 = tr_read(vb + v_rd_off(D0, 0, 1)), l1 = tr_read(vb + v_rd_off(D0, 1, 0)), h1 = tr_read(vb + v_rd_off(D0, 1, 1));
  const s16x4 l2 = tr_read(vb + v_rd_off(D0, 2, 0)), h2 = tr_read(vb + v_rd_off(D0, 2, 1)), l3 = tr_read(vb + v_rd_off(D0, 3, 0)), h3 = tr_read(vb + v_rd_off(D0, 3, 1));
#define PK(L, H) (bf16x8){L[0], L[1], L[2], L[3], H[0], H[1], H[2], H[3]}
  od = __builtin_amdgcn_mfma_f32_32x32x16_bf16(pa0, PK(l0, h0), od, 0, 0, 0);
  od = __builtin_amdgcn_mfma_f32_32x32x16_bf16(pa1, PK(l1, h1), od, 0, 0, 0);
  od = __builtin_amdgcn_mfma_f32_32x32x16_bf16(pa2, PK(l2, h2), od, 0, 0, 0);
  od = __builtin_amdgcn_mfma_f32_32x32x16_bf16(pa3, PK(l3, h3), od, 0, 0, 0);
#undef PK
}
__device__ __forceinline__ void pv_d0(f32x16* o, LAS const unsigned char* vb, bf16x8 pa0, bf16x8 pa1, bf16x8 pa2, bf16x8 pa3) {
  pv_one<0>(o[0], vb, pa0, pa1, pa2, pa3); pv_one<1>(o[1], vb, pa0, pa1, pa2, pa3); pv_one<2>(o[2], vb, pa0, pa1, pa2, pa3); pv_one<3>(o[3], vb, pa0, pa1, pa2, pa3);
}
template <bool CAUSAL> __device__ __forceinline__ void partialSM(f32x16& p0, f32x16& p1, float& m_reg, float& alpha, const float (&cs)[16], float base, int lim, float C, float slope2, int delta) {
  const float tb0 = slope2 * (float)delta + base, tb1 = slope2 * (float)(delta + 32) + base;
#pragma unroll
  for (int r = 0; r < 16; ++r) { p0[r] = fmaf(p0[r], C, cs[r]); p1[r] = fmaf(p1[r], C, cs[r]); }
  if (CAUSAL && delta + 63 > 0) {
    const int l0 = lim - delta, l1 = l0 - 32;
#pragma unroll
    for (int r = 0; r < 16; ++r) { const int K = (r & 3) + 8 * (r >> 2); if (K > l0) p0[r] = -INFINITY; if (K > l1) p1[r] = -INFINITY; }
  }
  float pm0 = p0[0], pm1 = p1[0];
#pragma unroll
  for (int r = 1; r < 16; ++r) { pm0 = fmaxf(pm0, p0[r]); pm1 = fmaxf(pm1, p1[r]); }
  float pmax = fmaxf(pm0 + tb0, pm1 + tb1);
  { auto rr = __builtin_amdgcn_permlane32_swap(__float_as_uint(pmax), __float_as_uint(pmax), false, false);
    pmax = fmaxf(__uint_as_float(rr[0]), __uint_as_float(rr[1])); }
  float mn;
  if (__builtin_expect(__all(pmax - m_reg <= THR2), 1)) { mn = m_reg; alpha = 1.f; }
  else { mn = fmaxf(m_reg, pmax); alpha = __builtin_amdgcn_exp2f(m_reg - mn); m_reg = mn; }
  const float a0 = tb0 - mn, a1 = tb1 - mn;
#pragma unroll
  for (int r = 0; r < 16; ++r) { p0[r] += a0; p1[r] += a1; }
#pragma unroll
  for (int r = 0; r < 16; ++r) p0[r] = __builtin_amdgcn_exp2f(p0[r]);
}
__device__ __forceinline__ void finishSM(f32x16& p0, f32x16& p1, float alpha, float& l_reg, bf16x8& pa0, bf16x8& pa1, bf16x8& pa2, bf16x8& pa3) {
#pragma unroll
  for (int r = 0; r < 16; ++r) p1[r] = __builtin_amdgcn_exp2f(p1[r]);
  float ps = 0;
#pragma unroll
  for (int r = 0; r < 16; ++r) ps += p0[r];
#pragma unroll
  for (int r = 0; r < 16; ++r) ps += p1[r];
  { auto rr = __builtin_amdgcn_permlane32_swap(__float_as_uint(ps), __float_as_uint(ps), false, false);
    ps = __uint_as_float(rr[0]) + __uint_as_float(rr[1]); }
  l_reg = l_reg * alpha + ps;
#define PK4(P, BASE, OUT) do { unsigned a0 = cvtpk(P[BASE + 0], P[BASE + 1]), a1 = cvtpk(P[BASE + 2], P[BASE + 3]);   \
    unsigned b0 = cvtpk(P[BASE + 4], P[BASE + 5]), b1 = cvtpk(P[BASE + 6], P[BASE + 7]);                              \
    auto r0 = __builtin_amdgcn_permlane32_swap(a0, b0, false, false); auto r1 = __builtin_amdgcn_permlane32_swap(a1, b1, false, false); \
    u32x4 w = {r0[0], r1[0], r0[1], r1[1]}; OUT = __builtin_bit_cast(bf16x8, w); } while (0)
  PK4(p0, 0, pa0); PK4(p0, 8, pa1); PK4(p1, 0, pa2); PK4(p1, 8, pa3);
#undef PK4
}

__device__ __forceinline__ void attn_b_unit(const bf16_t* __restrict__ PROJ, bf16_t* UB, const float* __restrict__ gsub, float lam, int h, int qb, int jmin, LAS unsigned char* lds, const int wid) {
  const int lane = lane_id_v(), tid = wid * 64 + lane, r32 = lane & 31, hi = lane >> 5, comp = wid >> 2, wq = wid & 3;
  const int R0 = qb * 128, qrow0 = R0 + wq * 32, NT = 2 * qb + 2, NTe = NT - jmin;
  LAS unsigned char* V_lds = lds; LAS unsigned char* K_lds = lds + 2 * SHM_V;
  LAS float* ws = (LAS float*)(lds + 2 * SHM_V + 2 * SHM_K) + wid * 64; LAS float* li_l = ws; LAS float* al_l = ws + 32;
  LAS float* xch = (LAS float*)(lds + 2 * SHM_V + 2 * SHM_K + 2048);
  const float slope2 = __builtin_amdgcn_exp2f(-(float)(h + 1)) * LOG2E, C = 0.125f * LOG2E;
  float cs[16];
#pragma unroll
  for (int r = 0; r < 16; ++r) cs[r] = __uint_as_float(__builtin_amdgcn_readfirstlane(__float_as_uint(slope2 * (float)((r & 3) + 8 * (r >> 2)))));
  const float base = slope2 * (float)(4 * hi - r32); const int lim = r32 - 4 * hi;
  float m_reg = -1e30f, l_reg = 0; f32x16 o[4] = {};
  LAS unsigned char* Qs = lds + 2 * SHM_V + 2 * SHM_K + 2048 + wid * 4096 + lane * 16;
  { const unsigned qo = ((unsigned)(qrow0 + r32) * (unsigned)NPAD + (unsigned)(C_QB + h * 128 + comp * 64 + hi * 8)) * 2u;
#pragma unroll
    for (int d0 = 0; d0 < 4; ++d0) *(LAS bf16x8*)(Qs + d0 * 1024) = *(const bf16x8*)((const char*)PROJ + (qo + 32u * d0)); }
  const unsigned offK = (unsigned)((tid >> 4) * NPAD + C_KB + h * 128 + (tid & 15) * 8) * 2u, offV = offK + (unsigned)(C_VB - C_KB) * 2u;
  const int sr = tid >> 4, sc = (tid & 15) * 8, vst0 = v_st(sr, sc), vst1 = v_st(32 + sr, sc), cq = comp * 128;
  LAS const unsigned char* vb0 = V_lds + v_rd_base(lane);
  struct { bf16x8 vs0, vs1, ks0, ks1; } sr_[2];
#define KEY0(t) (64 * (NT - 1 - (t)))
#define GLD16(off) (*(const bf16x8*)((const char*)PROJ + (unsigned)(off)))
#define SLOAD(i, k0) do { const unsigned kb_ = (unsigned)(k0) * (unsigned)(NPAD * 2); sr_[i].vs0 = GLD16(offV + kb_); sr_[i].vs1 = GLD16(offV + kb_ + 32u * NPAD * 2u); \
    sr_[i].ks0 = GLD16(offK + kb_); sr_[i].ks1 = GLD16(offK + kb_ + 32u * NPAD * 2u); } while (0)
#define SWRITE(b) do { *(LAS bf16x8*)(V_lds + (b) * SHM_V + vst0) = sr_[b].vs0; *(LAS bf16x8*)(V_lds + (b) * SHM_V + vst1) = sr_[b].vs1; const int kc = sc * 2; \
    *(LAS bf16x8*)(K_lds + (b) * SHM_K + KSWZ(sr, kc)) = sr_[b].ks0; *(LAS bf16x8*)(K_lds + (b) * SHM_K + KSWZ(32 + sr, kc)) = sr_[b].ks1; } while (0)
#define RESC(a) do { if (__any((a) < 1.f)) { if (hi == 0) al_l[r32] = (a); asm volatile("s_waitcnt lgkmcnt(0)" ::: "memory"); \
    _Pragma("unroll") for (int d = 0; d < 4; ++d) _Pragma("unroll") for (int r = 0; r < 16; ++r) o[d][r] *= al_l[crow(r, hi)]; } } while (0)
  f32x16 pA0, pA1, pB0, pB1; float alA, alB; bf16x8 pa0, pa1, pa2, pa3;
  SLOAD(0, KEY0(0)); SWRITE(0); __syncthreads();
  qkt_l<4>(pA0, pA1, K_lds, Qs, cq, r32, hi); partialSM<true>(pA0, pA1, m_reg, alA, cs, base, lim, C, slope2, KEY0(0) - qrow0);
  SLOAD(1, KEY0(1)); if (2 < NTe) SLOAD(0, KEY0(2));
  SWRITE(1); __syncthreads();
  for (int j = 1; j + 1 < NTe; j += 2) {
    SBAR(); qkt_l<4>(pB0, pB1, K_lds + SHM_K, Qs, cq, r32, hi);
    finishSM(pA0, pA1, alA, l_reg, pa0, pa1, pa2, pa3); SBAR();
    SLOAD(1, KEY0(j + 2)); SBAR();
    pv_d0(o, vb0, pa0, pa1, pa2, pa3); partialSM<true>(pB0, pB1, m_reg, alB, cs, base, lim, C, slope2, KEY0(j) - qrow0);
    __syncthreads(); SWRITE(0);
    RESC(alB); __syncthreads();
    SBAR(); qkt_l<4>(pA0, pA1, K_lds, Qs, cq, r32, hi);
    finishSM(pB0, pB1, alB, l_reg, pa0, pa1, pa2, pa3); SBAR();
    SLOAD(0, KEY0(min(j + 3, NTe - 1))); SBAR();
    pv_d0(o, vb0 + SHM_V, pa0, pa1, pa2, pa3); partialSM<true>(pA0, pA1, m_reg, alA, cs, base, lim, C, slope2, KEY0(j + 1) - qrow0);
    __syncthreads(); SWRITE(1);
    RESC(alA); __syncthreads();
  }
  SBAR(); qkt_l<4>(pB0, pB1, K_lds + SHM_K, Qs, cq, r32, hi);
  finishSM(pA0, pA1, alA, l_reg, pa0, pa1, pa2, pa3); SBAR();
  pv_d0(o, vb0, pa0, pa1, pa2, pa3); partialSM<true>(pB0, pB1, m_reg, alB, cs, base, lim, C, slope2, KEY0(NTe - 1) - qrow0);
  __syncthreads(); RESC(alB);
  finishSM(pB0, pB1, alB, l_reg, pa0, pa1, pa2, pa3); SBAR();
  pv_d0(o, vb0 + SHM_V, pa0, pa1, pa2, pa3);
#undef KEY0
#undef SLOAD
#undef GLD16
#undef SWRITE
#undef RESC
  if (hi == 0) li_l[r32] = l_reg; asm volatile("s_waitcnt lgkmcnt(0)" ::: "memory");
  float rli[16];
#pragma unroll
  for (int r = 0; r < 16; ++r) rli[r] = __builtin_amdgcn_rcpf(li_l[crow(r, hi)]);
  __syncthreads();
  if (comp == 1) {
#pragma unroll
    for (int d0 = 0; d0 < 4; ++d0)
#pragma unroll
      for (int r = 0; r < 16; ++r) xch[(wq * 64 + d0 * 16 + r) * 64 + lane] = o[d0][r] * rli[r] * lam;
  }
  __syncthreads();
  if (comp == 0) {
    float ss[16];
#pragma unroll
    for (int r = 0; r < 16; ++r) ss[r] = 0.f;
#pragma unroll
    for (int d0 = 0; d0 < 4; ++d0)
#pragma unroll
      for (int r = 0; r < 16; ++r) { const float d = o[d0][r] * rli[r] - xch[(wq * 64 + d0 * 16 + r) * 64 + lane]; o[d0][r] = d; ss[r] += d * d; }
#pragma unroll
    for (int r = 0; r < 16; ++r) { float s = ss[r]; s += __shfl_xor(s, 1); s += __shfl_xor(s, 2); s += __shfl_xor(s, 4); s += __shfl_xor(s, 8); s += __shfl_xor(s, 16);
      ss[r] = 0.8f / sqrtf(s * (1.f / 128.f) + RMS_EPS); }
    bf16_t zv[4][16];
#pragma unroll
    for (int d0 = 0; d0 < 4; ++d0)
#pragma unroll
      for (int r = 0; r < 16; ++r) zv[d0][r] = PROJ[(size_t)(qrow0 + crow(r, hi)) * NPAD + C_ZB + h * 128 + d0 * 32 + r32];
#pragma unroll
    for (int d0 = 0; d0 < 4; ++d0) { const int col = d0 * 32 + r32; const float g = gsub[col];
#pragma unroll
      for (int r = 0; r < 16; ++r) { const size_t row = (size_t)(qrow0 + crow(r, hi));
        UB[row * 1024 + h * 128 + col] = (bf16_t)f2bf(o[d0][r] * ss[r] * g * bf2f(zv[d0][r])); } }
  }
  __syncthreads();
}
template <bool DUMMY> __device__ __forceinline__ void partialSM_A(f32x16& p0, f32x16& p1, float& m_reg, float& alpha, const float (&cs)[16], float base, float C, float slope2, int delta, unsigned long long mw, int hi) {
  const float tb0 = slope2 * (float)delta + base, tb1 = slope2 * (float)(delta + 32) + base;
  const unsigned wl = (unsigned)mw >> (4 * hi), wh = (unsigned)(mw >> 32) >> (4 * hi);
#pragma unroll
  for (int r = 0; r < 16; ++r) { const int K = (r & 3) + 8 * (r >> 2);
    const float y0 = fmaf(p0[r], C, cs[r]), y1 = fmaf(p1[r], C, cs[r]);
    const unsigned t0 = (unsigned)((int)(wl << (31 - K)) >> 31), t1 = (unsigned)((int)(wh << (31 - K)) >> 31);
    p0[r] = __uint_as_float((__float_as_uint(y0) & t0) | (~t0 & 0xff800000u));
    p1[r] = __uint_as_float((__float_as_uint(y1) & t1) | (~t1 & 0xff800000u)); }
  float pm0 = p0[0], pm1 = p1[0];
#pragma unroll
  for (int r = 1; r < 16; ++r) { pm0 = fmaxf(pm0, p0[r]); pm1 = fmaxf(pm1, p1[r]); }
  float pmax = fmaxf(pm0 + tb0, pm1 + tb1);
  { auto rr = __builtin_amdgcn_permlane32_swap(__float_as_uint(pmax), __float_as_uint(pmax), false, false);
    pmax = fmaxf(__uint_as_float(rr[0]), __uint_as_float(rr[1])); }
  float mn;
  if (__builtin_expect(__all(pmax - m_reg <= THR2), 1)) { mn = m_reg; alpha = 1.f; }
  else { mn = fmaxf(m_reg, pmax); alpha = __builtin_amdgcn_exp2f(m_reg - mn); m_reg = mn; }
  const float a0 = tb0 - mn, a1 = tb1 - mn;
#pragma unroll
  for (int r = 0; r < 16; ++r) { p0[r] += a0; p1[r] += a1; }
#pragma unroll
  for (int r = 0; r < 16; ++r) p0[r] = __builtin_amdgcn_exp2f(p0[r]);
}
__device__ __forceinline__ void attn_a_unit(const bf16_t* __restrict__ PROJ, const unsigned long long* __restrict__ MASK, bf16_t* UA, int h, int qb, int jmin, LAS unsigned char* lds, const int wid) {
  const int lane = lane_id_v(), tid = wid * 64 + lane, r32 = lane & 31, hi = lane >> 5;
  const int R0 = qb * 256, qrow0 = R0 + wid * 32, NT = 4 * qb + 4, NTe = NT - jmin;
  LAS unsigned char* V_lds = lds; LAS unsigned char* K_lds = lds + 2 * SHM_V;
  LAS float* ws = (LAS float*)(lds + 2 * SHM_V + 2 * SHM_K) + wid * 64; LAS float* li_l = ws; LAS float* al_l = ws + 32;
  const float slope2 = __builtin_amdgcn_exp2f(-(float)(h + 1)) * LOG2E, C = 0.08838834764831845f * LOG2E;
  float cs[16];
#pragma unroll
  for (int r = 0; r < 16; ++r) cs[r] = __uint_as_float(__builtin_amdgcn_readfirstlane(__float_as_uint(slope2 * (float)((r & 3) + 8 * (r >> 2)))));
  const float base = slope2 * (float)(4 * hi - r32);
  float m_reg = -1e30f, l_reg = 0; f32x16 o[4] = {}; bf16x8 qr[8];
  { const bf16_t* Qw = PROJ + (size_t)(qrow0 + r32) * NPAD + C_QA + h * 128 + hi * 8;
#pragma unroll
    for (int d0 = 0; d0 < 8; ++d0) qr[d0] = *(const bf16x8*)(Qw + d0 * 16); }
  const unsigned offK = (unsigned)((tid >> 4) * NPAD + C_KA + h * 128 + (tid & 15) * 8) * 2u, offV = offK + (unsigned)(C_VA - C_KA) * 2u;
  const unsigned moff = (unsigned)(qrow0 + r32) * 1024u;
#define MLD(tj) (*(const unsigned long long*)((const char*)MASK + (moff + 8u * (unsigned)(tj))))
  const int sr = tid >> 4, sc = (tid & 15) * 8, vst0 = v_st(sr, sc), vst1 = v_st(32 + sr, sc);
  LAS const unsigned char* vb0 = V_lds + v_rd_base(lane);
  struct { bf16x8 vs0, vs1, ks0, ks1; } sr_;
#define TJ(t) (NT - 1 - (t))
#define KEY0(t) (64 * TJ(t))
#define GLD16(off) (*(const bf16x8*)((const char*)PROJ + (unsigned)(off)))
#define SLOAD(k0) do { const unsigned kb_ = (unsigned)(k0) * (unsigned)(NPAD * 2); sr_.vs0 = GLD16(offV + kb_); sr_.vs1 = GLD16(offV + kb_ + 32u * NPAD * 2u); \
    sr_.ks0 = GLD16(offK + kb_); sr_.ks1 = GLD16(offK + kb_ + 32u * NPAD * 2u); } while (0)
#define SWRITE(b) do { *(LAS bf16x8*)(V_lds + (b) * SHM_V + vst0) = sr_.vs0; *(LAS bf16x8*)(V_lds + (b) * SHM_V + vst1) = sr_.vs1; const int kc = sc * 2; \
    *(LAS bf16x8*)(K_lds + (b) * SHM_K + KSWZ(sr, kc)) = sr_.ks0; *(LAS bf16x8*)(K_lds + (b) * SHM_K + KSWZ(32 + sr, kc)) = sr_.ks1; } while (0)
#define RESC(a) do { if (__any((a) < 1.f)) { if (hi == 0) al_l[r32] = (a); asm volatile("s_waitcnt lgkmcnt(0)" ::: "memory"); \
    _Pragma("unroll") for (int d = 0; d < 4; ++d) _Pragma("unroll") for (int r = 0; r < 16; ++r) o[d][r] *= al_l[crow(r, hi)]; } } while (0)
  f32x16 pA0, pA1, pB0, pB1; float alA, alB; bf16x8 pa0, pa1, pa2, pa3; unsigned long long mwA, mwB;
  SLOAD(KEY0(0)); mwA = MLD(TJ(0)); SWRITE(0); __syncthreads();
  qkt<8>(pA0, pA1, K_lds, qr, 0, r32, hi); partialSM_A<true>(pA0, pA1, m_reg, alA, cs, base, C, slope2, KEY0(0) - qrow0, mwA, hi);
  SLOAD(KEY0(1)); mwB = MLD(TJ(1)); SWRITE(1); __syncthreads();
  for (int j = 1; j + 1 < NTe; j += 2) {
    SBAR(); qkt<8>(pB0, pB1, K_lds + SHM_K, qr, 0, r32, hi);
    finishSM(pA0, pA1, alA, l_reg, pa0, pa1, pa2, pa3); SBAR();
    SLOAD(KEY0(j + 1)); mwA = MLD(TJ(j + 1)); SBAR();
    pv_d0(o, vb0, pa0, pa1, pa2, pa3); partialSM_A<true>(pB0, pB1, m_reg, alB, cs, base, C, slope2, KEY0(j) - qrow0, mwB, hi);
    __syncthreads(); SWRITE(0);
    RESC(alB); __syncthreads();
    SBAR(); qkt<8>(pA0, pA1, K_lds, qr, 0, r32, hi);
    finishSM(pB0, pB1, alB, l_reg, pa0, pa1, pa2, pa3); SBAR();
    SLOAD(KEY0(j + 2)); mwB = MLD(TJ(j + 2)); SBAR();
    pv_d0(o, vb0 + SHM_V, pa0, pa1, pa2, pa3); partialSM_A<true>(pA0, pA1, m_reg, alA, cs, base, C, slope2, KEY0(j + 1) - qrow0, mwA, hi);
    __syncthreads(); SWRITE(1);
    RESC(alA); __syncthreads();
  }
  SBAR(); qkt<8>(pB0, pB1, K_lds + SHM_K, qr, 0, r32, hi);
  finishSM(pA0, pA1, alA, l_reg, pa0, pa1, pa2, pa3); SBAR();
  pv_d0(o, vb0, pa0, pa1, pa2, pa3); partialSM_A<true>(pB0, pB1, m_reg, alB, cs, base, C, slope2, KEY0(NTe - 1) - qrow0, mwB, hi);
  __syncthreads(); RESC(alB);
  finishSM(pB0, pB1, alB, l_reg, pa0, pa1, pa2, pa3); SBAR();
  pv_d0(o, vb0 + SHM_V, pa0, pa1, pa2, pa3);
#undef TJ
#undef MLD
#undef KEY0
#undef SLOAD
#undef GLD16
#undef SWRITE
#undef RESC
  if (hi == 0) li_l[r32] = l_reg; asm volatile("s_waitcnt lgkmcnt(0)" ::: "memory");
  float rli[16];
#pragma unroll
  for (int r = 0; r < 16; ++r) rli[r] = __builtin_amdgcn_rcpf(li_l[crow(r, hi)]);
  { bf16_t zv[4][16];
#pragma unroll
  for (int d0 = 0; d0 < 4; ++d0)
#pragma unroll
    for (int r = 0; r < 16; ++r) zv[d0][r] = PROJ[(size_t)(qrow0 + crow(r, hi)) * NPAD + C_ZA + h * 128 + d0 * 32 + r32];
#pragma unroll
  for (int d0 = 0; d0 < 4; ++d0) { const int col = h * 128 + d0 * 32 + r32;
#pragma unroll
    for (int r = 0; r < 16; ++r) { const size_t row = (size_t)(qrow0 + crow(r, hi));
      UA[row * 1024 + col] = (bf16_t)f2bf(o[d0][r] * rli[r] * bf2f(zv[d0][r])); } } }
  __syncthreads();
}
template <int NQ, bool ACC> __device__ __forceinline__ void qkt_acc(f32x16& p0, f32x16& p1, LAS const unsigned char* Ks, const bf16x8* qr, int r32, int hi) {
  if (!ACC) { p0 = f32x16{}; p1 = f32x16{}; }
#pragma unroll
  for (int d0 = 0; d0 < NQ; ++d0) { const int cb = (d0 * 16 + hi * 8) * 2;
    const bf16x8 b0 = *(LAS const bf16x8*)(Ks + KSWZ(r32, cb));
    const bf16x8 b1 = *(LAS const bf16x8*)(Ks + KSWZ(32 + r32, cb));
    p0 = __builtin_amdgcn_mfma_f32_32x32x16_bf16(b0, qr[d0], p0, 0, 0, 0);
    p1 = __builtin_amdgcn_mfma_f32_32x32x16_bf16(b1, qr[d0], p1, 0, 0, 0); }
}
__device__ __forceinline__ void attn_m_unit(const bf16_t* __restrict__ PROJ, const bf16_t* __restrict__ MKV, bf16_t* UM, int h, int qb, int vh, LAS unsigned char* lds, const int wid) {
  const int lane = lane_id_v(), tid = wid * 64 + lane, r32 = lane & 31, hi = lane >> 5;
  const int qrow0 = qb * 256 + wid * 32;
  LAS unsigned char* V_lds = lds; LAS unsigned char* K_lds = lds + 2 * SHM_V;
  LAS float* ws = (LAS float*)(lds + 2 * SHM_V + 2 * SHM_K) + wid * 64; LAS float* li_l = ws; LAS float* al_l = ws + 32;
  const float C = 0.0625f * LOG2E;
  const float cs[16] = {0.f, 0.f, 0.f, 0.f, 0.f, 0.f, 0.f, 0.f, 0.f, 0.f, 0.f, 0.f, 0.f, 0.f, 0.f, 0.f};
  float m_reg = -1e30f, l_reg = 0; f32x16 o[4] = {}; bf16x8 qr[16];
  { const unsigned qo = ((unsigned)(qrow0 + r32) * (unsigned)NPAD + (unsigned)(C_QM + h * 256 + hi * 8)) * 2u;
#pragma unroll
    for (int d0 = 0; d0 < 16; ++d0) qr[d0] = *(const bf16x8*)((const char*)PROJ + (qo + 32u * d0)); }
  const int sr = tid >> 4, sc = (tid & 15) * 8, vst0 = v_st(sr, sc), vst1 = v_st(32 + sr, sc);
  const unsigned offK = (unsigned)(sr * 2048 + h * 256 + sc) * 2u, offV = offK + (unsigned)(1024 + vh * 128) * 2u;
  LAS const unsigned char* vb0 = V_lds + v_rd_base(lane);
#define GLD16(off) (*(const bf16x8*)((const char*)MKV + (unsigned)(off)))
  for (int t = 0; t < 4; ++t) {
    const unsigned kb_ = (unsigned)(64 * t) * 4096u;
    const bf16x8 ka0 = GLD16(offK + kb_), ka1 = GLD16(offK + kb_ + 32u * 4096u), kb0 = GLD16(offK + kb_ + 256u), kb1 = GLD16(offK + kb_ + 32u * 4096u + 256u);
    const bf16x8 vs0 = GLD16(offV + kb_), vs1 = GLD16(offV + kb_ + 32u * 4096u);
    const int kc = sc * 2;
    *(LAS bf16x8*)(K_lds + KSWZ(sr, kc)) = ka0; *(LAS bf16x8*)(K_lds + KSWZ(32 + sr, kc)) = ka1;
    *(LAS bf16x8*)(K_lds + SHM_K + KSWZ(sr, kc)) = kb0; *(LAS bf16x8*)(K_lds + SHM_K + KSWZ(32 + sr, kc)) = kb1;
    *(LAS bf16x8*)(V_lds + vst0) = vs0; *(LAS bf16x8*)(V_lds + vst1) = vs1;
    __syncthreads();
    f32x16 p0, p1; float al; bf16x8 pa0, pa1, pa2, pa3;
    qkt_acc<8, false>(p0, p1, K_lds, qr, r32, hi); qkt_acc<8, true>(p0, p1, K_lds + SHM_K, qr + 8, r32, hi);
    partialSM<false>(p0, p1, m_reg, al, cs, 0.f, 0, C, 0.f, 0);
    if (__any(al < 1.f)) { if (hi == 0) al_l[r32] = al; asm volatile("s_waitcnt lgkmcnt(0)" ::: "memory");
#pragma unroll
      for (int d = 0; d < 4; ++d)
#pragma unroll
        for (int r = 0; r < 16; ++r) o[d][r] *= al_l[crow(r, hi)]; }
    finishSM(p0, p1, al, l_reg, pa0, pa1, pa2, pa3);
    pv_d0(o, vb0, pa0, pa1, pa2, pa3);
    __syncthreads();
  }
#undef GLD16
  if (hi == 0) li_l[r32] = l_reg; asm volatile("s_waitcnt lgkmcnt(0)" ::: "memory");
  float rli[16];
#pragma unroll
  for (int r = 0; r < 16; ++r) rli[r] = __builtin_amdgcn_rcpf(li_l[crow(r, hi)]);
  { bf16_t zv[4][16];
#pragma unroll
  for (int d0 = 0; d0 < 4; ++d0)
#pragma unroll
    for (int r = 0; r < 16; ++r) zv[d0][r] = PROJ[(size_t)(qrow0 + crow(r, hi)) * NPAD + C_ZM + h * 256 + vh * 128 + d0 * 32 + r32];
#pragma unroll
  for (int d0 = 0; d0 < 4; ++d0) { const int col = h * 256 + vh * 128 + d0 * 32 + r32;
#pragma unroll
    for (int r = 0; r < 16; ++r) { const size_t row = (size_t)(qrow0 + crow(r, hi));
      UM[row * 1024 + col] = (bf16_t)f2bf(o[d0][r] * rli[r] * bf2f(zv[d0][r])); } } }
  __syncthreads();
}
__device__ __forceinline__ void attn_m_phase(const Args& a, LAS unsigned char* lds, int blk, int nblk, const int wid) {
  const bf16_t* PROJ = (const bf16_t*)(a.ws + WS_PROJ); const bf16_t* MKV = (const bf16_t*)(a.ws + WS_MKV); bf16_t* UM = (bf16_t*)(a.ws + WS_U) + (size_t)2 * S * 1024;
  for (int u = blk; u < 256; u += nblk) attn_m_unit(PROJ, MKV, UM, u & 3, u >> 3, (u >> 2) & 1, lds, wid);
}
__device__ __forceinline__ float slot_sum(const unsigned* ns, int tile, int bj, int wc0, int nwc) { float s = 0.f;
  for (int w = 0; w < nwc; ++w) s += __uint_as_float(__hip_atomic_load(ns + (tile * 2 + bj) * 4 + wc0 + w, __ATOMIC_RELAXED, __HIP_MEMORY_SCOPE_AGENT)); return s; }
__device__ __forceinline__ int window_jmin(float q2k2, float scale, int h, int R0, int NT) {
  const float slope2 = __builtin_amdgcn_exp2f(-(float)(h + 1)) * LOG2E, L = sqrtf(q2k2) * scale * LOG2E * 1.02f, D = (2.f * L + 48.f) / slope2;
  const float x = ((float)R0 - D - 63.f) * (1.f / 64.f);
  int jm = (int)floorf(x) - 1; jm = jm < 0 ? 0 : jm; jm &= ~1; return jm > NT - 2 ? NT - 2 : jm;
}
__device__ __forceinline__ int jmin_b(const unsigned* ns, int h, int qb) {
  const int bj = h & 1; float m = 0.f;
  for (int c = 0; c < 2; ++c) { const float v = slot_sum(ns, 20 + (h >> 1), bj, 2 * c, 2) * slot_sum(ns, 24 + (h >> 1), bj, 2 * c, 2); m = fmaxf(m, v); }
  return window_jmin(m, 0.125f, h, qb * 128, 2 * qb + 2);
}
constexpr int NUNITS_AB = 512;
__device__ __forceinline__ void build_order(const unsigned* ns, unsigned* order, LAS unsigned char* lds, const int lane) {
  LAS int* cost = (LAS int*)lds;
  for (int u = lane; u < NUNITS_AB; u += 64) { int jm, cst;
    { const int h = u & 7, qb = u >> 3; jm = jmin_b(ns, h, qb); cst = 2 * qb + 2 - jm; }
    cost[u] = cst; cost[NUNITS_AB + u] = jm; }
  asm volatile("s_waitcnt lgkmcnt(0)" ::: "memory"); __builtin_amdgcn_wave_barrier();
  for (int u = lane; u < NUNITS_AB; u += 64) { const int cu = cost[u]; int rank = 0;
    for (int v = 0; v < NUNITS_AB; ++v) { const int cv = cost[v]; rank += (cv > cu || (cv == cu && v < u)) ? 1 : 0; }
    order[rank] = (unsigned)u | ((unsigned)cost[NUNITS_AB + u] << 16); }
}
__device__ __forceinline__ void attn_ab_phase(const Args& a, LAS unsigned char* lds, int blk, int nblk, const int wid) {
  const bf16_t* PROJ = (const bf16_t*)(a.ws + WS_PROJ); bf16_t* UA = (bf16_t*)(a.ws + WS_U); bf16_t* UB = UA + (size_t)S * 1024;
  { const unsigned long long* MASK = (const unsigned long long*)(a.ws + WS_SEL);
    for (int u = blk; u < 256; u += nblk) attn_a_unit(PROJ, MASK, UA, u & 7, 31 - (u >> 3), 0, lds, wid); }
  const unsigned* order = (const unsigned*)(a.ws + WS_CTL + 4096); unsigned* qctr = (unsigned*)(a.ws + WS_CTL + 320);
  LAS unsigned* slot = (LAS unsigned*)(lds + 147456 - 64);
  for (;;) {
    if (wid == 0) { if (lane_id_v() == 0) slot[0] = __hip_atomic_fetch_add(qctr, 1u, __ATOMIC_RELAXED, __HIP_MEMORY_SCOPE_AGENT); }
    __syncthreads();
    const unsigned i = slot[0];
    __syncthreads();
    if (i >= 512u) break;
    const unsigned e = order[i]; const int u = (int)(e & 0xffffu), jm = (int)(e >> 16);
    attn_b_unit(PROJ, UB, a.in[9], ((const float*)(a.ws + WS_CTL))[0], u & 7, u >> 3, jm, lds, wid);
  }
}
#undef KSWZ
#undef SBAR
}


namespace idx {
typedef short bf16x8 __attribute__((ext_vector_type(8)));
typedef float f32x16 __attribute__((ext_vector_type(16)));
constexpr int NUNIT = 8 * (16 * 17 / 2);
__device__ __forceinline__ void scores_phase(const bf16_t* __restrict__ PROJ, float* SC, unsigned* uctr, LAS unsigned char* lds, int blk, int nblk, const int wid) {
  const int lane = lane_id_v(), tid = wid * 64 + lane, n32 = lane & 31, hi = lane >> 5;
  const int skey = tid >> 3, schunk = tid & 7;
  const int swr = skey * 128 + ((schunk ^ (skey & 7)) << 4);
  LAS unsigned* uslot = (LAS unsigned*)(lds + 147456 - 64);
  for (;;) {
    if (wid == 0) { if (lane_id_v() == 0) uslot[0] = __hip_atomic_fetch_add(uctr, 1u, __ATOMIC_RELAXED, __HIP_MEMORY_SCOPE_AGENT); }
    __syncthreads();
    const int u = NUNIT - 1 - (int)uslot[0];
    __syncthreads();
    if (u < 0) break;
    int g = 0, rem = u; while (rem >= 8 * (g + 1)) { rem -= 8 * (g + 1); ++g; }
    const int qc = 8 * g + rem / (g + 1), kc = rem % (g + 1);
    const int q0 = 64 * qc + 8 * wid, k_begin = 512 * kc, k_end = min(512 * kc + 512, 64 * qc + 64), ntile = (k_end - k_begin) / 64;
    bf16x8 af[4][4]; float w[4][16];
    const int head = (n32 & 3) + 4 * (n32 >> 3), qbit = (n32 >> 2) & 1;
#pragma unroll
    for (int t = 0; t < 4; ++t) {
      const bf16_t* qp = PROJ + (size_t)(q0 + 2 * t + qbit) * NPAD + C_QI + head * 64 + hi * 8;
#pragma unroll
      for (int ks = 0; ks < 4; ++ks) af[t][ks] = *(const bf16x8*)(qp + ks * 16);
      const bf16_t* wp = PROJ + (size_t)(q0 + 2 * t + hi) * NPAD + C_WI;
      const u32x4 w0 = *(const u32x4*)wp, w1 = *(const u32x4*)(wp + 8);
      const unsigned ww[8] = {w0.x, w0.y, w0.z, w0.w, w1.x, w1.y, w1.z, w1.w};
#pragma unroll
      for (int i = 0; i < 8; ++i) { w[t][2 * i] = bflo(ww[i]) * 0.03125f; w[t][2 * i + 1] = bfhi(ww[i]) * 0.03125f; }
    }
    u32x4 st = *(const u32x4*)(PROJ + (size_t)(k_begin + skey) * NPAD + C_KI + schunk * 8);
    __syncthreads();
    *(LAS u32x4*)(lds + swr) = st;
    __syncthreads();
    for (int tl = 0; tl < ntile; ++tl) {
      LAS const unsigned char* kb = lds + (tl & 1) * 8192;
      if (tl + 1 < ntile) st = *(const u32x4*)(PROJ + (size_t)(k_begin + 64 * (tl + 1) + skey) * NPAD + C_KI + schunk * 8);
#pragma unroll
      for (int kh = 0; kh < 2; ++kh) {
        const int krow = kh * 32 + n32;
        bf16x8 bfr[4];
#pragma unroll
        for (int ks = 0; ks < 4; ++ks) bfr[ks] = *(LAS const bf16x8*)(kb + krow * 128 + (((2 * ks + hi) ^ (krow & 7)) << 4));
        const int s = k_begin + 64 * tl + krow;
#pragma unroll
        for (int t = 0; t < 4; ++t) {
          f32x16 acc = {};
#pragma unroll
          for (int ks = 0; ks < 4; ++ks) acc = __builtin_amdgcn_mfma_f32_32x32x16_bf16(af[t][ks], bfr[ks], acc, 0, 0, 0);
          float sc = 0.f;
#pragma unroll
          for (int r = 0; r < 16; ++r) sc = fmaf(fmaxf(acc[r], 0.f), w[t][r], sc);
          const int q = q0 + 2 * t + hi;
          if (s <= q) SC[sc_off(q) + s] = sc;
        }
      }
      if (tl + 1 < ntile) { *(LAS u32x4*)(lds + ((tl + 1) & 1) * 8192 + swr) = st; }
      __syncthreads();
    }
  }
}
}

#ifdef DBG_STAGE
__device__ __forceinline__ void dbg_dump(const Args& a, int blk, int nblk) {
    const bf16_t* PROJ = (const bf16_t*)(a.ws + WS_PROJ);
    for (size_t idx = (size_t)blk * 512 + threadIdx.x; idx < (size_t)S * DM; idx += (size_t)nblk * 512) {
        const int r = (int)(idx / DM), c = (int)(idx % DM); float v = 0.f;
#if DBG_STAGE == 1 && defined(DBG_WEIGHTS)
        for (int z = 0; z < 3; ++z) v += bf2f(((const bf16_t*)(a.ws + WS_WTBR))[((size_t)z * 2048 + (r & 2047)) * 1024 + (c & 1023)]);
        v += bf2f(((const bf16_t*)(a.ws + WS_WTOUT))[(size_t)(r & 2047) * 2048 + c]);
#elif DBG_STAGE == 1 && defined(DBG_GATES)
        for (int j = 0; j < 3; ++j) v += bf2f(PROJ[(size_t)r * NPAD + C_GL + c + 2048 * j]);
#elif DBG_STAGE == 1
        for (int j = 0; j < 8; ++j) v += bf2f(PROJ[(size_t)r * NPAD + c + 2048 * j]);
        if (c < 1280) v += bf2f(PROJ[(size_t)r * NPAD + 16384 + c]);
        if (r < 256) v += bf2f(((const bf16_t*)(a.ws + WS_MKV))[(size_t)r * 2048 + c]);
        for (int z = 0; z < 3; ++z) v += bf2f(((const bf16_t*)(a.ws + WS_WTBR))[((size_t)z * 2048 + (r & 2047)) * 1024 + (c & 1023)]);
        v += bf2f(((const bf16_t*)(a.ws + WS_WTOUT))[(size_t)(r & 2047) * 2048 + c]);
#elif DBG_STAGE == 2
        if (c < 1024) v = bf2f(((const bf16_t*)(a.ws + WS_U))[(size_t)(S + r) * 1024 + c]) + bf2f(((const bf16_t*)(a.ws + WS_U))[(size_t)(2 * S + r) * 1024 + c]);
        else { const float* row = (const float*)(a.ws + WS_SC) + sc_off(r); for (int j = c - 1024; j <= r; j += 1024) v += row[j]; }
#elif DBG_STAGE == 3
        if (c < 256) v = (float)((const int*)(a.ws + WS_SEL))[(size_t)r * 256 + c];
#elif DBG_STAGE == 4
        if (c < 1024) v = bf2f(((const bf16_t*)(a.ws + WS_U))[(size_t)r * 1024 + c]);
#elif DBG_STAGE == 5
        v = bf2f(((const bf16_t*)(a.ws + WS_MERGED))[(size_t)r * DM + c]);
#endif
        a.out[idx] = v;
    }
}
#endif

#define RLX_AGENT __ATOMIC_RELAXED, __HIP_MEMORY_SCOPE_AGENT
#define XB_TMO      128
#define XB_XCNT(j)  (256  + 64 * (j))
#define XB_XSUB(j)  (1280 + 64 * (j))
#define XB_XGEN(j)  (2304 + 64 * (j))
#define XB_TOP      3328
#define XB_TOPGEN   3392
#define XCD_BAR_WORDS 3456
#define XB_SPIN_CAP (1u << 18)

__device__ __forceinline__ unsigned xb_ld(unsigned* p)              { return __hip_atomic_load(p, __ATOMIC_RELAXED, __HIP_MEMORY_SCOPE_AGENT); }
__device__ __forceinline__ unsigned xb_add(unsigned* p, unsigned v) { return __hip_atomic_fetch_add(p, v, __ATOMIC_RELAXED, __HIP_MEMORY_SCOPE_AGENT); }
__device__ __forceinline__ unsigned xb_xcc_id() { return (unsigned)__builtin_amdgcn_s_getreg((3 << 11) | 20) & 0xFu; }
#define XB_SPIN(cond, bar) do { unsigned _sp = 0; while (cond) { __builtin_amdgcn_s_sleep(1); \
    if ((++_sp & 255u) == 0u) { if (xb_ld(&(bar)[XB_TMO])) break; if (_sp > XB_SPIN_CAP) { atomicAdd(&(bar)[XB_TMO], 1u); break; } } } } while (0)

struct XcdBarrier {
    unsigned* bar; unsigned x;
    volatile LAS unsigned* st;
};

__device__ __forceinline__ XcdBarrier xcd_barrier_post(unsigned* bar, volatile LAS unsigned* st, bool leader) {
    XcdBarrier b; b.bar = bar; b.x = xb_xcc_id(); b.st = st;
    if (leader) (void)xb_add(&bar[XB_XCNT(b.x)], 1u);
    return b;
}
__device__ __forceinline__ void xcd_barrier_complete(unsigned* bar, unsigned x, unsigned& nloc, unsigned& nx) {
    const unsigned G = gridDim.x * gridDim.y * gridDim.z;
    unsigned sum, cnt, mine, sp = 0u;
    for (;;) {
        sum = 0u; cnt = 0u; mine = 0u;
#pragma unroll
        for (unsigned j = 0; j < 16; ++j) { const unsigned c = xb_ld(&bar[XB_XCNT(j)]); sum += c; cnt += (c > 0u) ? 1u : 0u; mine = (j == x) ? c : mine; }
        if (sum == G) break;
        __builtin_amdgcn_s_sleep(1);
        if ((++sp & 255u) == 0u) { if (xb_ld(&bar[XB_TMO])) break; if (sp > XB_SPIN_CAP) { atomicAdd(&bar[XB_TMO], 1u); break; } }
    }
    nloc = mine > 0u ? mine : 1u; nx = cnt > 0u ? cnt : 1u;
}

__device__ __forceinline__ void xcd_barrier(const XcdBarrier& b, bool leader) {
    asm volatile("s_waitcnt vmcnt(0)" ::: "memory");
    __syncthreads();
    if (leader) {
        unsigned* bar = b.bar;
        __builtin_amdgcn_s_waitcnt(0);
        unsigned nloc = b.st[0], nx = b.st[1];
        if (nloc == 0u) { xcd_barrier_complete(bar, b.x, nloc, nx); b.st[0] = nloc; b.st[1] = nx; }
        const unsigned old = xb_add(&bar[XB_XSUB(b.x)], 1u);
        const unsigned gen = old / nloc;
        if (old + 1u == (gen + 1u) * nloc) {
            __builtin_amdgcn_fence(__ATOMIC_RELEASE, "agent");
            asm volatile("s_waitcnt vmcnt(0)" ::: "memory");
            const unsigned og = xb_add(&bar[XB_TOP], 1u);
            const unsigned tg = og / nx;
            if (og + 1u == (tg + 1u) * nx) xb_add(&bar[XB_TOPGEN], 1u);
            else XB_SPIN(xb_ld(&bar[XB_TOPGEN]) == tg, bar);
            __builtin_amdgcn_fence(__ATOMIC_ACQUIRE, "agent");
            xb_add(&bar[XB_XGEN(b.x)], 1u);
            asm volatile("s_waitcnt vmcnt(0)" ::: "memory");
        } else {
            XB_SPIN(xb_ld(&bar[XB_XGEN(b.x)]) == gen, bar);
            __builtin_amdgcn_fence(__ATOMIC_ACQUIRE, "agent");
            asm volatile("s_waitcnt vmcnt(0)" ::: "memory");
        }
    }
    __syncthreads();
}

__device__ __forceinline__ void grid_bar(unsigned* cnt, unsigned target, const int wave) {
    asm volatile("s_waitcnt vmcnt(0)" ::: "memory");
    __syncthreads();
    if (wave == 0) {
        if (lane_id_v() == 0) {
            __builtin_amdgcn_fence(__ATOMIC_RELEASE, "agent");
            asm volatile("s_waitcnt vmcnt(0)" ::: "memory");
            __hip_atomic_fetch_add(cnt, 1u, __ATOMIC_RELAXED, __HIP_MEMORY_SCOPE_AGENT);
            while (__hip_atomic_load(cnt, __ATOMIC_RELAXED, __HIP_MEMORY_SCOPE_AGENT) < target) __builtin_amdgcn_s_sleep(2);
            __builtin_amdgcn_fence(__ATOMIC_ACQUIRE, "agent");
            asm volatile("s_waitcnt vmcnt(0)" ::: "memory");
        }
    }
    __syncthreads();
}

constexpr int LDS_BYTES = 147456;
constexpr int NPHASE = 8;
__global__ void __launch_bounds__(512, 2) fwd(Args a) {
    extern __shared__ __attribute__((aligned(16))) unsigned char lds_raw[];
    LAS unsigned char* lds = (LAS unsigned char*)lds_raw;
    cg::grid_group grid = cg::this_grid();
    const int blk = blockIdx.x, nblk = gridDim.x, wave = __builtin_amdgcn_readfirstlane(threadIdx.x >> 6);
    unsigned char* ws = a.ws;
    const bf16_t* PROJ = (const bf16_t*)(ws + WS_PROJ);
    volatile LAS unsigned* xst = (volatile LAS unsigned*)(lds + 147456 - 128);
    if (wave == 0) { if (lane_id_v() == 0) { xst[0] = 0u; xst[1] = 0u; } }
    __syncthreads();
    (void)xcd_barrier_post((unsigned*)(ws + WS_CTL + 16384), xst, wave == 0 && lane_id_v() == 0);
#define IN(k) (a.ph_lo <= (k) && (k) < a.ph_hi)
#define SEAM(k) do { if (IN(k) && IN((k) + 1)) { { XcdBarrier xb_; xb_.bar = (unsigned*)(ws + WS_CTL + 16384); xb_.x = xb_xcc_id(); xb_.st = (volatile LAS unsigned*)(lds + 147456 - 128); xcd_barrier(xb_, wave == 0 && lane_id_v() == 0); } } } while (0)
    if (IN(0)) { p0_prologue_a(a, lds, blk, nblk, wave); grid.sync();
                 p0_prologue_b(a, lds, blk, nblk, wave); } SEAM(0);
    if (IN(1)) {
        {
            pg8::Gemm g8{(const bf16_t*)(ws + WS_H8), (const bf16_t*)(ws + WS_W8), S, 64 * 256, DM / 2, 0, 0};
            pg8::ProjOrder8 so; so.init(S, nblk, blk);
            pg8::EpiProj8 E{(bf16_t*)(ws + WS_PROJ), NPAD, a.in[4], C_GL / 256, (unsigned*)(ws + WS_CTL + 1024), (const float*)(ws + WS_SA), (const float*)(ws + WS_SB)};
            pg8::gemm_phase<pg8::EpiProj8, pg8::ProjOrder8, true, true>(lds, g8, so, E, wave); }
        __syncthreads();
        {
            pg8::Gemm g{(const bf16_t*)(ws + WS_H), (const bf16_t*)(ws + WS_WTIN), S, NPAD, DM, (long)WS_MEMN - (long)WS_H, (long)WS_WTMKV - (long)WS_WTIN};
            pg8::ProjOrderB so; so.init(nblk, blk);
            pg8::EpiProj E{(bf16_t*)(ws + WS_PROJ), NPAD, (bf16_t*)(ws + WS_MKV), 2048, a.in[4], C_GL / 256, (unsigned*)(ws + WS_CTL + 1024)};
            pg8::gemm_phase<pg8::EpiProj, pg8::ProjOrderB, false, true>(lds, g, so, E, wave); }
    } SEAM(1);
    if (IN(2)) { idx::scores_phase(PROJ, (float*)(ws + WS_SC), (unsigned*)(ws + WS_CTL + 448), lds, blk, nblk, wave); __syncthreads(); att::attn_m_phase(a, lds, blk, nblk, wave); } SEAM(2);
    if (IN(3)) { if (blk == nblk - 1) { if (wave == 7) att::build_order((const unsigned*)(ws + WS_CTL + 1024), (unsigned*)(ws + WS_CTL + 4096), lds + 131072, lane_id_v()); }
                 topk_select((const float*)(ws + WS_SC), (int*)(ws + WS_SEL), lds, blk, nblk, wave); } SEAM(3);
    if (IN(4)) { att::attn_ab_phase(a, lds, blk, nblk, wave); } SEAM(4);
    if (IN(5)) {
        pg8::Gemm g{(const bf16_t*)(ws + WS_U), (const bf16_t*)(ws + WS_WTBR), S, DM, 1024, (long)S * 1024 * 2, (long)2048 * 1024 * 2};
        pg8::MergeOrder so; so.init(S, DM, nblk, blk);
        pg8::EpiMerge E{PROJ + C_GL, NPAD, (bf16_t*)(ws + WS_MERGED), DM};
        pg8::gemm_phase<pg8::EpiMerge, pg8::MergeOrder, true, true>(lds, g, so, E, wave);
    } SEAM(5);
    if (IN(6)) {
        pg8::Gemm g{(const bf16_t*)(ws + WS_MERGED), (const bf16_t*)(ws + WS_WTOUT), S, DM, DM, 0, 0};
        pg8::StaticOrder so; so.init(S, DM, nblk, blk);
        pg8::EpiOut E{a.in[0], a.out, DM, (float*)(ws + WS_PART), S};
        pg8::gemm_phase<pg8::EpiOut, pg8::StaticOrder, false, true>(lds, g, so, E, wave);
    } SEAM(6);
    if (IN(7)) { final_norm(a, blk, nblk, wave); }
#ifdef DBG_STAGE
    if (IN(8)) { dbg_dump(a, blk, nblk); }
#endif
#undef IN
#undef SEAM
}

#ifndef N_LAUNCH_MODE
#define N_LAUNCH_MODE 0
#endif
extern "C" void kernel_launch(void* const* d_in, const int* in_sizes, int n_in, void* d_out, int out_size, void* d_ws, size_t ws_size, hipStream_t stream) {
    static int grid = 0;
    if (grid == 0) {
        if (n_in != 17 || in_sizes[0] != S * DM || in_sizes[3] != DM * DIN || out_size != S * DM || ws_size < WS_END) {
            fprintf(stderr, "kernel_launch: unexpected shapes (n_in %d, in0 %d, in3 %d, out %d, ws %zu < %zu)\n", n_in, n_in > 0 ? in_sizes[0] : -1, n_in > 3 ? in_sizes[3] : -1, out_size, ws_size, (size_t)WS_END); grid = -1; return; }
        int dev = 0, cus = 0, per_cu = 0;
        (void)hipGetDevice(&dev); (void)hipDeviceGetAttribute(&cus, hipDeviceAttributeMultiprocessorCount, dev);
        if (hipFuncSetAttribute((const void*)fwd, hipFuncAttributeMaxDynamicSharedMemorySize, LDS_BYTES) != hipSuccess) { fprintf(stderr, "kernel_launch: hipFuncSetAttribute failed\n"); grid = -1; return; }
        if (hipOccupancyMaxActiveBlocksPerMultiprocessor(&per_cu, (const void*)fwd, 512, LDS_BYTES) != hipSuccess || per_cu < 1) { fprintf(stderr, "kernel_launch: occupancy query gave %d\n", per_cu); per_cu = 1; }
        (void)hipGetLastError();
        grid = cus * 1;
        if (grid > cus * per_cu) grid = cus * per_cu;
        if (grid < 8) grid = -1;
    }
    if (grid < 0) return;
    Args a{};
    for (int i = 0; i < 17; ++i) a.in[i] = (const float*)d_in[i];
    a.out = (float*)d_out; a.ws = (unsigned char*)d_ws;
#if N_LAUNCH_MODE == 1
    (void)hipMemsetAsync((unsigned char*)d_ws + WS_CTL + 256, 0, 256, stream);
    (void)hipMemsetAsync((unsigned char*)d_ws + WS_CTL + 16384, 0, 16384, stream);
    (void)hipMemsetAsync((unsigned char*)d_ws + WS_SB, 0, 17664 * 4, stream);
    a.ph_lo = 0; a.ph_hi = NPHASE;
    void* kargs[] = {&a};
    hipError_t e = hipLaunchCooperativeKernel((const void*)fwd, dim3(grid), dim3(512), kargs, LDS_BYTES, stream);
    if (e != hipSuccess) fprintf(stderr, "cooperative launch failed: %s (grid %d)\n", hipGetErrorString(e), grid);
#else
#ifdef DBG_STAGE
    #ifdef DBG_WEIGHTS
    constexpr int last_ph[6] = {0, 0, 2, 3, 4, 5};
#else
    constexpr int last_ph[6] = {0, 1, 2, 3, 4, 5};
#endif
    for (int p = 0; p <= last_ph[DBG_STAGE]; ++p) { a.ph_lo = p; a.ph_hi = p + 1; hipLaunchKernelGGL(fwd, dim3(grid), dim3(512), LDS_BYTES, stream, a); }
    a.ph_lo = 8; a.ph_hi = 9; hipLaunchKernelGGL(fwd, dim3(grid), dim3(512), LDS_BYTES, stream, a);
#else
    for (int p = 0; p < NPHASE; ++p) {
        a.ph_lo = p; a.ph_hi = p + 1;
        hipLaunchKernelGGL(fwd, dim3(grid), dim3(512), LDS_BYTES, stream, a);
    }
#endif
#endif
}
```

```cpp
#define N_LAUNCH_MODE 1
#include <hip/hip_runtime.h>
#include <hip/hip_cooperative_groups.h>
#include <cstdio>
#include <cstdint>
namespace cg = cooperative_groups;

__device__ __forceinline__ int lane_id_v() { int l; asm volatile("v_mbcnt_lo_u32_b32 %0, -1, 0\n\tv_mbcnt_hi_u32_b32 %0, -1, %0" : "=v"(l)); return l; }
namespace pg8 {
#define PG8_LAS __attribute__((address_space(3)))
typedef unsigned short bf16_t;
typedef short bf16x8 __attribute__((ext_vector_type(8)));
typedef float f32x4 __attribute__((ext_vector_type(4)));
typedef int i32x4 __attribute__((ext_vector_type(4)));
typedef unsigned u32x4 __attribute__((ext_vector_type(4)));
constexpr int BM = 256, BK = 64, HALF = 128, HTB = HALF * BK * 2  , STAGE_BYTES = 8 * HTB, NXCD = 8, WGM = 8;

__host__ __device__ __forceinline__ int lds_byte(int r, int c) { const int st = (r >> 4) * 2 + (c >> 5), rr = r & 15, cc = c & 31, ob = rr * 64 + cc * 2; return st * 1024 + (ob ^ (((ob >> 9) & 1) << 5)); }
__host__ __device__ __forceinline__ void stage_rc(int b, int& R, int& C) { const int st = b / 1024, sb = b % 1024, swz = sb ^ (((sb >> 9) & 1) << 5); R = (st >> 1) * 16 + swz / 64; C = (st & 1) * 32 + (swz % 64) / 2; }
__host__ __device__ __forceinline__ int perm32(int rho) { const int n = rho >> 4, i = rho & 15; return 8 * (i >> 2) + 4 * n + (i & 3); }

struct Unit { int pm, pn, z; };
struct Gemm { const bf16_t* A; const bf16_t* Bt; int M, N, K; long zA, zB; };

struct StaticOrder {
    int nM, nN, nwg, G, c;
    __host__ __device__ void init(int M, int N, int G_, int c_) { nM = M / BM; nN = N / BM; nwg = nM * nN; G = G_; c = c_; }
    __host__ __device__ bool next(int i, Unit& u) const {
        const long L = (long)i * G + c; if (L >= nwg) return false;
        int wgid = (int)L; { const int q = nwg / NXCD, r = nwg % NXCD, xcd = wgid % NXCD, off = wgid / NXCD; wgid = (xcd < r ? xcd * (q + 1) : r * (q + 1) + (xcd - r) * q) + off; }
        const int nig = WGM * nN, gid = wgid / nig, fm = gid * WGM, gsz = (nM - fm) < WGM ? (nM - fm) : WGM;
        u.pm = fm + ((wgid % nig) % gsz); u.pn = (wgid % nig) / gsz; u.z = 0; return true;
    }
    __device__ __forceinline__ void a_ready(const Unit&) const {}
    __device__ __forceinline__ void done(const Unit&) const {}
};

typedef float f32x2_t __attribute__((ext_vector_type(2))); typedef __bf16 bf16x2_t __attribute__((ext_vector_type(2)));
__device__ __forceinline__ unsigned cvt_pk_bf16(float lo, float hi) { f32x2_t v = {lo, hi}; bf16x2_t b = __builtin_convertvector(v, bf16x2_t); return __builtin_bit_cast(unsigned, b); }

__device__ __forceinline__ float bf2f(unsigned short u) { return __uint_as_float((unsigned)u << 16); }
__device__ __forceinline__ float sigmoidf_(float v) { return __builtin_amdgcn_rcpf(1.0f + __builtin_amdgcn_exp2f(-1.4426950408889634f * v)); }
template <int MODE> __device__ __forceinline__ float act_(float v, float b) {
    if (MODE == 1) return v * sigmoidf_(v);
    if (MODE == 2) return sigmoidf_(v + b);
    return v;
}
struct EpiProj {
    static constexpr bool PERM = true, AFTER_DRAIN = false, KEEP_ACC = false, I8 = false; typedef f32x4 acc_t;
    bf16_t* O; int ldc; bf16_t* O1; int ldc1; const float* bgate; int gate_tile0;
    unsigned* nslot;
    __device__ __forceinline__ void norms(const f32x4 (&acc)[2][2][4][2], const Unit& u, int wc, int lane) const {
        float wm[2] = {0.f, 0.f};
#pragma unroll
        for (int ai = 0; ai < 2; ++ai)
#pragma unroll
            for (int m = 0; m < 4; ++m)
#pragma unroll
                for (int bj = 0; bj < 2; ++bj) { const f32x4 a = acc[ai][bj][m][0], c = acc[ai][bj][m][1];
                    float s = (a[0] * a[0] + a[1] * a[1]) + (a[2] * a[2] + a[3] * a[3]) + (c[0] * c[0] + c[1] * c[1]) + (c[2] * c[2] + c[3] * c[3]);
                    s += __shfl_xor(s, 16); s += __shfl_xor(s, 32); wm[bj] = fmaxf(wm[bj], s); }
#pragma unroll
        for (int bj = 0; bj < 2; ++bj) { float v = wm[bj]; v = fmaxf(v, __shfl_xor(v, 1)); v = fmaxf(v, __shfl_xor(v, 2)); v = fmaxf(v, __shfl_xor(v, 4)); v = fmaxf(v, __shfl_xor(v, 8));
            if (lane == 0) atomicMax(nslot + (u.pn * 2 + bj) * 4 + wc, __float_as_uint(v)); }
    }
    template <int MODE> __device__ __forceinline__ void put(const f32x4 (&acc)[2][2][4][2], bf16_t* base, int ld, int row0, int col0, const float* bias) const {
        f32x4 bv[2][2];
#pragma unroll
        for (int bj = 0; bj < 2; ++bj)
#pragma unroll
            for (int n = 0; n < 2; ++n) bv[bj][n] = (MODE == 2) ? *(const f32x4*)(bias + bj * HALF + 4 * n) : (f32x4){0.f, 0.f, 0.f, 0.f};
#pragma unroll
        for (int ai = 0; ai < 2; ++ai)
#pragma unroll
            for (int m = 0; m < 4; ++m) { bf16_t* rowp = base + (size_t)(row0 + ai * HALF + m * 16) * ld + col0;
#pragma unroll
                for (int bj = 0; bj < 2; ++bj) { f32x4 v0 = acc[ai][bj][m][0], v1 = acc[ai][bj][m][1];
#pragma unroll
                    for (int e = 0; e < 4; ++e) { v0[e] = act_<MODE>(v0[e], bv[bj][0][e]); v1[e] = act_<MODE>(v1[e], bv[bj][1][e]); }
                    u32x4 w; w.x = cvt_pk_bf16(v0[0], v0[1]); w.y = cvt_pk_bf16(v0[2], v0[3]); w.z = cvt_pk_bf16(v1[0], v1[1]); w.w = cvt_pk_bf16(v1[2], v1[3]);
                    *(u32x4*)(rowp + bj * HALF) = w; } }
    }
    __device__ __forceinline__ void operator()(const f32x4 (&acc)[2][2][4][2], const Unit& u, int wr, int wc, int fr, int fq) const {
        const int row0 = u.pm * BM + wr * 64 + fr, col0 = u.pn * BM + wc * 32 + 8 * fq;
        if (u.z == 1) { put<0>(acc, O1, ldc1, row0, col0, nullptr); return; }
        const int t = u.pn;
        if (t < 8 || (t >= 20 && t < 28)) norms(acc, u, wc, fr + 16 * fq);
        const bool is_silu = (t >= 12 && t < 16) || (t >= 32 && t < 36) || (t >= 40 && t < 44);
        if (t >= gate_tile0 && t < 68) put<2>(acc, O, ldc, row0, col0, bgate + (col0 - gate_tile0 * BM));
        else if (is_silu) put<1>(acc, O, ldc, row0, col0, nullptr);
        else put<0>(acc, O, ldc, row0, col0, nullptr);
    }
};
struct EpiMerge {
    static constexpr bool PERM = true, AFTER_DRAIN = false, KEEP_ACC = true, I8 = false; typedef f32x4 acc_t;
    const bf16_t* G; int ldg;
    bf16_t* O; int ldc;
    __device__ __forceinline__ static void unpack8(const u32x4 gw, f32x4& g0, f32x4& g1) {
        g0[0] = __uint_as_float(gw.x << 16); g0[1] = __uint_as_float(gw.x & 0xffff0000u); g0[2] = __uint_as_float(gw.y << 16); g0[3] = __uint_as_float(gw.y & 0xffff0000u);
        g1[0] = __uint_as_float(gw.z << 16); g1[1] = __uint_as_float(gw.z & 0xffff0000u); g1[2] = __uint_as_float(gw.w << 16); g1[3] = __uint_as_float(gw.w & 0xffff0000u); }
    __device__ __forceinline__ void operator()(f32x4 (&acc)[2][2][4][2], const Unit& u, int wr, int wc, int fr, int fq) const {
        const int row0 = u.pm * BM + wr * 64 + fr, col0 = u.pn * BM + wc * 32 + 8 * fq;
#pragma unroll
        for (int ai = 0; ai < 2; ++ai) {
            u32x4 ga[4][2], gb[4][2];
#pragma unroll
            for (int m = 0; m < 4; ++m)
#pragma unroll
                for (int bj = 0; bj < 2; ++bj) { const bf16_t* gp = G + (size_t)(row0 + ai * HALF + m * 16) * ldg + (size_t)u.z * 2048 + col0 + bj * HALF;
                    ga[m][bj] = *(const u32x4*)gp; gb[m][bj] = (u.z < 2) ? *(const u32x4*)(gp + 2048) : (u32x4){0u, 0u, 0u, 0u}; }
#pragma unroll
            for (int m = 0; m < 4; ++m) { const size_t row = (size_t)(row0 + ai * HALF + m * 16);
#pragma unroll
                for (int bj = 0; bj < 2; ++bj) { const int col = col0 + bj * HALF;
                    f32x4 a0, a1; unpack8(ga[m][bj], a0, a1);
                    f32x4 r0, r1;
                    if (u.z < 2) { f32x4 n0, n1; unpack8(gb[m][bj], n0, n1);
#pragma unroll
                        for (int e = 0; e < 4; ++e) { const float d0 = fmaxf(n0[e], 1e-30f), d1 = fmaxf(n1[e], 1e-30f);
                            const float x0 = (u.z == 0) ? a0[e] : fmaxf(a0[e], 1e-30f), x1 = (u.z == 0) ? a1[e] : fmaxf(a1[e], 1e-30f);
                            r0[e] = x0 * __builtin_amdgcn_rcpf(d0); r1[e] = x1 * __builtin_amdgcn_rcpf(d1); }
                        acc[ai][bj][m][0] *= r0; acc[ai][bj][m][1] *= r1;
                    } else {
#pragma unroll
                        for (int e = 0; e < 4; ++e) { r0[e] = fmaxf(a0[e], 1e-30f); r1[e] = fmaxf(a1[e], 1e-30f); }
                        const f32x4 v0 = acc[ai][bj][m][0] * r0, v1 = acc[ai][bj][m][1] * r1;
                        u32x4 w; w.x = cvt_pk_bf16(v0[0], v0[1]); w.y = cvt_pk_bf16(v0[2], v0[3]); w.z = cvt_pk_bf16(v1[0], v1[1]); w.w = cvt_pk_bf16(v1[2], v1[3]);
                        *(u32x4*)(O + row * ldc + col) = w;
                        acc[ai][bj][m][0] = (f32x4){0.f, 0.f, 0.f, 0.f}; acc[ai][bj][m][1] = (f32x4){0.f, 0.f, 0.f, 0.f}; } } }
        }
    }
};
struct EpiOut {
    static constexpr bool PERM = false, AFTER_DRAIN = false, KEEP_ACC = false, I8 = false; typedef f32x4 acc_t;
    const float* X; float* Y; int ldc; float* part; int M;
    __device__ __forceinline__ void operator()(const f32x4 (&acc)[2][2][4][2], const Unit& u, int wr, int wc, int fr, int fq) const {
        const int row0 = u.pm * BM + wr * 64 + fr, col0 = u.pn * BM + wc * 32 + 4 * fq;
#pragma unroll
        for (int ai = 0; ai < 2; ++ai) {
            f32x4 xv[4][2][2];
#pragma unroll
            for (int m = 0; m < 4; ++m)
#pragma unroll
                for (int bj = 0; bj < 2; ++bj)
#pragma unroll
                    for (int n = 0; n < 2; ++n) xv[m][bj][n] = *(const f32x4*)(X + (size_t)(row0 + ai * HALF + m * 16) * ldc + col0 + bj * HALF + n * 16);
#pragma unroll
            for (int m = 0; m < 4; ++m) { const size_t row = (size_t)(row0 + ai * HALF + m * 16); float ss = 0.f;
#pragma unroll
                for (int bj = 0; bj < 2; ++bj)
#pragma unroll
                    for (int n = 0; n < 2; ++n) { const size_t off = row * ldc + col0 + bj * HALF + n * 16;
                        const f32x4 y = xv[m][bj][n] + acc[ai][bj][m][n]; *(f32x4*)(Y + off) = y;
                        ss += (y[0] * y[0] + y[1] * y[1]) + (y[2] * y[2] + y[3] * y[3]); }
                ss += __shfl_xor(ss, 16); ss += __shfl_xor(ss, 32);
                if (fq == 0) part[(size_t)(u.pn * 4 + wc) * M + row] = ss; }
        }
    }
};
struct EpiProj8 {
    static constexpr bool PERM = true, AFTER_DRAIN = false, KEEP_ACC = false, I8 = true; typedef i32x4 acc_t;
    bf16_t* O; int ldc; const float* bgate; int gate_tile0; unsigned* nslot; const float* sA; const float* sB;
    template <int MODE, bool NORMS> __device__ __forceinline__ void put(const i32x4 (&acc)[2][2][4][2], const Unit& u, int row0, int col0, int wc, int lane) const {
        f32x4 bv[2][2], cs[2][2]; float rs[2][4];
#pragma unroll
        for (int bj = 0; bj < 2; ++bj)
#pragma unroll
            for (int n = 0; n < 2; ++n) { cs[bj][n] = *(const f32x4*)(sB + col0 + bj * HALF + 4 * n) * (1.f / 127.f);
                bv[bj][n] = (MODE == 2) ? *(const f32x4*)(bgate + (col0 - gate_tile0 * BM) + bj * HALF + 4 * n) : (f32x4){0.f, 0.f, 0.f, 0.f}; }
#pragma unroll
        for (int ai = 0; ai < 2; ++ai)
#pragma unroll
            for (int m = 0; m < 4; ++m) rs[ai][m] = sA[row0 + ai * HALF + m * 16];
        float wm[2] = {0.f, 0.f};
#pragma unroll
        for (int ai = 0; ai < 2; ++ai)
#pragma unroll
            for (int m = 0; m < 4; ++m) { bf16_t* rowp = O + (size_t)(row0 + ai * HALF + m * 16) * ldc + col0;
#pragma unroll
                for (int bj = 0; bj < 2; ++bj) { f32x4 v0, v1;
#pragma unroll
                    for (int e = 0; e < 4; ++e) { v0[e] = (float)acc[ai][bj][m][0][e] * (rs[ai][m] * cs[bj][0][e]); v1[e] = (float)acc[ai][bj][m][1][e] * (rs[ai][m] * cs[bj][1][e]); }
                    if (NORMS) { float sq = (v0[0] * v0[0] + v0[1] * v0[1]) + (v0[2] * v0[2] + v0[3] * v0[3]) + (v1[0] * v1[0] + v1[1] * v1[1]) + (v1[2] * v1[2] + v1[3] * v1[3]);
                        sq += __shfl_xor(sq, 16); sq += __shfl_xor(sq, 32); wm[bj] = fmaxf(wm[bj], sq); }
#pragma unroll
                    for (int e = 0; e < 4; ++e) { v0[e] = act_<MODE>(v0[e], bv[bj][0][e]); v1[e] = act_<MODE>(v1[e], bv[bj][1][e]); }
                    u32x4 w; w.x = cvt_pk_bf16(v0[0], v0[1]); w.y = cvt_pk_bf16(v0[2], v0[3]); w.z = cvt_pk_bf16(v1[0], v1[1]); w.w = cvt_pk_bf16(v1[2], v1[3]);
                    *(u32x4*)(rowp + bj * HALF) = w; } }
        if (NORMS) {
#pragma unroll
            for (int bj = 0; bj < 2; ++bj) { float v = wm[bj]; v = fmaxf(v, __shfl_xor(v, 1)); v = fmaxf(v, __shfl_xor(v, 2)); v = fmaxf(v, __shfl_xor(v, 4)); v = fmaxf(v, __shfl_xor(v, 8));
                if (lane == 0) atomicMax(nslot + (u.pn * 2 + bj) * 4 + wc, __float_as_uint(v)); } }
    }
    __device__ __forceinline__ void operator()(const i32x4 (&acc)[2][2][4][2], const Unit& u, int wr, int wc, int fr, int fq) const {
        const int row0 = u.pm * BM + wr * 64 + fr, col0 = u.pn * BM + wc * 32 + 8 * fq, t = u.pn, lane = fr + 16 * fq;
        const bool is_silu = (t >= 12 && t < 16) || (t >= 32 && t < 36) || (t >= 40 && t < 44);
        if (t >= gate_tile0 && t < 68) put<2, false>(acc, u, row0, col0, wc, lane);
        else if (is_silu) put<1, false>(acc, u, row0, col0, wc, lane);
        else if (t < 8 || (t >= 20 && t < 28)) put<0, true>(acc, u, row0, col0, wc, lane);
        else put<0, false>(acc, u, row0, col0, wc, lane);
    }
};
struct ProjOrder8 {
    StaticOrder so;
    __device__ void init(int M, int G, int c) { so.init(M, 64 * BM, G, c); }
    __device__ bool next(int i, Unit& u) const { if (!so.next(i, u)) return false; if (u.pn >= 16) u.pn += 4; return true; }
    __device__ __forceinline__ void a_ready(const Unit&) const {}
    __device__ __forceinline__ void done(const Unit&) const {}
};
struct ProjOrderB {
    int G, c;
    __device__ void init(int G_, int c_) { G = G_; c = c_; }
    __device__ bool next(int i, Unit& u) const { const int L = i * G + c; if (L >= 168) return false;
        if (L < 160) { const int t = L >> 5; u.pm = L & 31; u.pn = (t < 4) ? 16 + t : 68; u.z = 0; } else { u.pm = 0; u.pn = L - 160; u.z = 1; } return true; }
    __device__ __forceinline__ void a_ready(const Unit&) const {}
    __device__ __forceinline__ void done(const Unit&) const {}
};
struct ProjOrder {
    StaticOrder so; int nmain, extra;
    __device__ void init(int M, int N, int G, int c) { so.init(M, N, G, c); nmain = (so.nwg - c + G - 1) / G; extra = (c >= G - 8) ? c - (G - 8) : -1; }
    __device__ bool next(int i, Unit& u) const {
        if (i < nmain) return so.next(i, u);
        if (i == nmain && extra >= 0) { u.pm = 0; u.pn = extra; u.z = 1; return true; }
        return false;
    }
    __device__ __forceinline__ void a_ready(const Unit&) const {}
    __device__ __forceinline__ void done(const Unit&) const {}
};
struct MergeOrder {
    StaticOrder so;
    __device__ void init(int M, int N, int G, int c) { so.init(M, N, G, c); }
    __device__ bool next(int i, Unit& u) const { if (i >= 3) return false; if (!so.next(0, u)) return false; u.z = i; return true; }
    __device__ __forceinline__ void a_ready(const Unit&) const {}
    __device__ __forceinline__ void done(const Unit&) const {}
};

template <class Epi, class Sched, bool ALIGN_EPI = false, bool SP2 = false>
__device__ __forceinline__ void gemm_phase(PG8_LAS unsigned char* lds, const Gemm g, const Sched& S, const Epi& E, const int wid  ) {
    const int lane = lane_id_v(), tid = wid * 64 + lane, wr = wid >> 2, wc = wid & 3, fr = lane & 15, fq = lane >> 4;
    const int K = g.K, nt = K / BK;
    unsigned voffA[2], voffB[2];
#pragma unroll
    for (int i = 0; i < 2; ++i) { int R, C; stage_rc(tid * 16 + i * 8192, R, C); const int Rb = Epi::PERM ? ((R & ~31) + perm32(R & 31)) : R;
        voffA[i] = (unsigned)(R * K + C) * 2u; voffB[i] = (unsigned)(Rb * K + C) * 2u; }
    const size_t kstep = (size_t)(BK * 2);
    const size_t hstep = (size_t)HALF * K * 2;
    const size_t tstep = 2 * hstep;
    const unsigned ldsw = (unsigned)wid * 1024u;
    const int aoff = lds_byte(wr * 64 + fr, fq * 8), boff = lds_byte(wc * 32 + fr, fq * 8);
#define PG8_SA(b, h) (((b) * 2 + (h)) * HTB)
#define PG8_SB(b, h) ((4 + (b) * 2 + (h)) * HTB)
#define PG8_STAGE(bufoff, gbase, voff) do { _Pragma("unroll") for (int _i = 0; _i < 2; ++_i) \
        __builtin_amdgcn_global_load_lds((const unsigned*)((const char*)(gbase) + (voff)[_i]), (PG8_LAS unsigned*)(lds + (bufoff) + ldsw + _i * 8192), 16, 0, 0); } while (0)
#define PG8_LDA(dst, b, h) do { _Pragma("unroll") for (int m = 0; m < 4; ++m) _Pragma("unroll") for (int k = 0; k < 2; ++k) dst[m][k] = *(const PG8_LAS bf16x8*)(lds + PG8_SA(b, h) + aoff + m * 2048 + k * 1024); } while (0)
#define PG8_LDB(dst, b, h) do { _Pragma("unroll") for (int n = 0; n < 2; ++n) _Pragma("unroll") for (int k = 0; k < 2; ++k) dst[n][k] = *(const PG8_LAS bf16x8*)(lds + PG8_SB(b, h) + boff + n * 2048 + k * 1024); } while (0)
#define PG8_MMA(ai, bj, At, Bt) do { __builtin_amdgcn_s_setprio(1); _Pragma("unroll") for (int m = 0; m < 4; ++m) _Pragma("unroll") for (int n = 0; n < 2; ++n) _Pragma("unroll") for (int k = 0; k < 2; ++k) \
        { if constexpr (Epi::I8) acc[ai][bj][m][n] = __builtin_amdgcn_mfma_i32_16x16x64_i8(__builtin_bit_cast(i32x4, Bt[n][k]), __builtin_bit_cast(i32x4, At[m][k]), acc[ai][bj][m][n], 0, 0, 0); \
          else acc[ai][bj][m][n] = __builtin_amdgcn_mfma_f32_16x16x32_bf16(Bt[n][k], At[m][k], acc[ai][bj][m][n], 0, 0, 0); } __builtin_amdgcn_s_setprio(0); } while (0)
#define PG8_WAIT_V(n) asm volatile("s_waitcnt vmcnt(" #n ")" ::: "memory")
#define PG8_WAIT_L(n) asm volatile("s_waitcnt lgkmcnt(" #n ")" ::: "memory")
#define PG8_BAR __builtin_amdgcn_s_barrier()
#define PG8_SCHED __builtin_amdgcn_sched_barrier(0)
    Unit cur, nxt; int ui = 0;
    if (!S.next(0, cur)) return;
    typedef typename Epi::acc_t acc_t;
    acc_t acc[2][2][4][2];
#pragma unroll
    for (int a = 0; a < 2; ++a)
#pragma unroll
        for (int b = 0; b < 2; ++b)
#pragma unroll
            for (int m = 0; m < 4; ++m)
#pragma unroll
                for (int n = 0; n < 2; ++n) acc[a][b][m][n] = acc_t{};
    bf16x8 At[4][2], B0[2][2], B1[2][2];
    const char* cA = (const char*)g.A + (long)cur.z * g.zA + (size_t)cur.pm * tstep; const char* cB = (const char*)g.Bt + (long)cur.z * g.zB + (size_t)cur.pn * tstep;
    S.a_ready(cur);
    if constexpr (SP2) {
        PG8_STAGE(PG8_SB(0, 0), cB, voffB); PG8_STAGE(PG8_SB(0, 1), cB + hstep, voffB); PG8_STAGE(PG8_SA(0, 0), cA, voffA); PG8_STAGE(PG8_SA(0, 1), cA + hstep, voffA);
        if (wr == 1) PG8_BAR;
        PG8_WAIT_V(2); PG8_BAR;
        PG8_STAGE(PG8_SB(1, 0), cB + kstep, voffB); PG8_STAGE(PG8_SA(1, 0), cA + kstep, voffA); PG8_STAGE(PG8_SB(1, 1), cB + hstep + kstep, voffB);
        PG8_WAIT_V(6); PG8_BAR;
    } else {
        PG8_STAGE(PG8_SB(0, 0), cB, voffB); PG8_STAGE(PG8_SA(0, 0), cA, voffA); PG8_STAGE(PG8_SB(0, 1), cB + hstep, voffB); PG8_STAGE(PG8_SA(0, 1), cA + hstep, voffA);
        if (wr == 1) PG8_BAR;
        PG8_WAIT_V(4); PG8_BAR;
        PG8_STAGE(PG8_SB(1, 0), cB + kstep, voffB); PG8_STAGE(PG8_SA(1, 0), cA + kstep, voffA); PG8_STAGE(PG8_SB(1, 1), cB + hstep + kstep, voffB);
        PG8_WAIT_V(6); PG8_BAR;
    }
    for (;;) {
        const bool has_next = S.next(ui + 1, nxt);
        const char* nA = has_next ? (const char*)g.A + (long)nxt.z * g.zA + (size_t)nxt.pm * tstep : cA; const char* nB = has_next ? (const char*)g.Bt + (long)nxt.z * g.zB + (size_t)nxt.pn * tstep : cB;
        for (int t = 0; t < nt; t += 2) {
            const bool last = (t == nt - 2);
            const char* a1 = cA + (size_t)(t + 1) * kstep;
            const char* a2 = last ? nA : cA + (size_t)(t + 2) * kstep; const char* b2 = last ? nB : cB + (size_t)(t + 2) * kstep;
            const char* a3 = a2 + kstep; const char* b3 = b2 + kstep;
            if (last && has_next) S.a_ready(nxt);
            if constexpr (SP2) {
            PG8_LDB(B0, 0, 0); PG8_LDB(B1, 0, 1); PG8_SCHED; PG8_LDA(At, 0, 0); PG8_STAGE(PG8_SA(1, 1), a1 + hstep, voffA);
            PG8_WAIT_V(8); PG8_WAIT_L(0); PG8_BAR; PG8_MMA(0, 0, At, B0); PG8_MMA(0, 1, At, B1); PG8_BAR; PG8_SCHED;
            PG8_LDA(At, 0, 1); PG8_STAGE(PG8_SB(0, 0), b2, voffB); PG8_STAGE(PG8_SB(0, 1), b2 + hstep, voffB); PG8_STAGE(PG8_SA(0, 0), a2, voffA);
            PG8_WAIT_V(8); PG8_WAIT_L(0); PG8_BAR; PG8_MMA(1, 0, At, B0); PG8_MMA(1, 1, At, B1); PG8_BAR; PG8_SCHED;
            PG8_LDB(B0, 1, 0); PG8_LDB(B1, 1, 1); PG8_SCHED; PG8_LDA(At, 1, 0); PG8_STAGE(PG8_SA(0, 1), a2 + hstep, voffA);
            PG8_WAIT_V(8); PG8_WAIT_L(0); PG8_BAR; PG8_MMA(0, 0, At, B0); PG8_MMA(0, 1, At, B1); PG8_BAR; PG8_SCHED;
            PG8_LDA(At, 1, 1); PG8_STAGE(PG8_SB(1, 0), b3, voffB); PG8_STAGE(PG8_SB(1, 1), b3 + hstep, voffB); PG8_STAGE(PG8_SA(1, 0), a3, voffA);
            PG8_WAIT_V(8); PG8_WAIT_L(0); PG8_BAR; PG8_MMA(1, 0, At, B0); PG8_MMA(1, 1, At, B1); PG8_BAR; PG8_SCHED;
            } else {
            PG8_LDB(B0, 0, 0); PG8_SCHED; PG8_LDA(At, 0, 0); PG8_STAGE(PG8_SA(1, 1), a1 + hstep, voffA);
            PG8_WAIT_L(8); PG8_BAR; PG8_WAIT_L(0); PG8_MMA(0, 0, At, B0); PG8_BAR; PG8_SCHED;
            PG8_LDB(B1, 0, 1); PG8_STAGE(PG8_SB(0, 0), b2, voffB);
            PG8_BAR; PG8_WAIT_L(0); PG8_MMA(0, 1, At, B1); PG8_BAR;
            PG8_LDA(At, 0, 1); PG8_STAGE(PG8_SA(0, 0), a2, voffA);
            PG8_BAR; PG8_WAIT_L(0); PG8_MMA(1, 0, At, B0); PG8_BAR; PG8_SCHED;
            PG8_STAGE(PG8_SB(0, 1), b2 + hstep, voffB);
            PG8_WAIT_V(6); PG8_BAR; PG8_MMA(1, 1, At, B1); PG8_BAR;
            PG8_LDB(B0, 1, 0); PG8_SCHED; PG8_LDA(At, 1, 0); PG8_STAGE(PG8_SA(0, 1), a2 + hstep, voffA);
            PG8_WAIT_L(8); PG8_BAR; PG8_WAIT_L(0); PG8_MMA(0, 0, At, B0); PG8_BAR; PG8_SCHED;
            PG8_LDB(B1, 1, 1); PG8_STAGE(PG8_SB(1, 0), b3, voffB);
            PG8_BAR; PG8_WAIT_L(0); PG8_MMA(0, 1, At, B1); PG8_BAR;
            PG8_LDA(At, 1, 1); PG8_STAGE(PG8_SA(1, 0), a3, voffA);
            PG8_BAR; PG8_WAIT_L(0); PG8_MMA(1, 0, At, B0); PG8_BAR; PG8_SCHED;
            PG8_STAGE(PG8_SB(1, 1), b3 + hstep, voffB);
            PG8_WAIT_V(6); PG8_BAR; PG8_MMA(1, 1, At, B1); PG8_BAR;
            }
        }
        if constexpr (ALIGN_EPI) { if (wr == 0) PG8_BAR; }
        if constexpr (!Epi::AFTER_DRAIN) { E(acc, cur, wr, wc, fr, fq); S.done(cur); }
        if (!has_next) break;
        if constexpr (!Epi::KEEP_ACC) {
#pragma unroll
        for (int a = 0; a < 2; ++a)
#pragma unroll
            for (int b = 0; b < 2; ++b)
#pragma unroll
                for (int m = 0; m < 4; ++m)
#pragma unroll
                    for (int n = 0; n < 2; ++n) acc[a][b][m][n] = acc_t{};
        }
        cur = nxt; cA = nA; cB = nB; ++ui;
        if constexpr (ALIGN_EPI) { if (wr == 1) PG8_BAR; }
    }
    PG8_WAIT_V(0);
    if constexpr (!ALIGN_EPI) { if (wr == 0) PG8_BAR; }
    PG8_BAR;
    if constexpr (Epi::AFTER_DRAIN) { E.fused(acc, cur, wr, wc, fr, fq, lds, wid, lane); S.done(cur); }
#undef PG8_SA
#undef PG8_SB
#undef PG8_STAGE
#undef PG8_LDA
#undef PG8_LDB
#undef PG8_MMA
#undef PG8_WAIT_V
#undef PG8_WAIT_L
#undef PG8_BAR
#undef PG8_SCHED
}
}

constexpr int S = 8192, DM = 2048, DIN = 17488, NPAD = 17664, NMEM = 256;
constexpr int C_QA = 0, C_KA = 1024, C_VA = 2048, C_ZA = 3072, C_QI = 4096, C_QB = 5120, C_KB = 6144, C_VB = 7168, C_ZB = 8192, C_QM = 9216, C_ZM = 10240, C_GL = 11264, C_KI = 17408, C_WI = 17472;
constexpr int TOPK = 256;
constexpr float RMS_EPS = 1e-6f;
constexpr size_t MiB = 1u << 20;
constexpr size_t WS_CTL = 0;
constexpr size_t WS_WTIN = 1 * MiB;
constexpr size_t WS_U = 1 * MiB;
constexpr size_t WS_WTMKV = 70 * MiB;
constexpr size_t WS_WTBR = 78 * MiB;
constexpr size_t WS_WTOUT = 90 * MiB;
constexpr size_t WS_MEMN = 98 * MiB;
constexpr size_t WS_MKV = 99 * MiB;
constexpr size_t WS_PROJ = 100 * MiB;
constexpr size_t WS_SC = 376 * MiB;
constexpr size_t WS_MERGED = 376 * MiB;
constexpr size_t WS_H = 376 * MiB;
constexpr size_t WS_W8 = 408 * MiB;
constexpr size_t WS_H8 = 444 * MiB;
constexpr size_t WS_SA = 461 * MiB;
constexpr size_t WS_SB = 32768;
constexpr size_t WS_SEL = 508 * MiB;
constexpr size_t WS_PART = 516 * MiB;
constexpr size_t WS_END = 517 * MiB;

typedef unsigned short bf16_t;
typedef unsigned u32x4 __attribute__((ext_vector_type(4)));
typedef unsigned u32x2 __attribute__((ext_vector_type(2)));
typedef float f32x4 __attribute__((ext_vector_type(4)));
#define LAS __attribute__((address_space(3)))
__device__ __forceinline__ float bf2f(unsigned short u) { return __uint_as_float((unsigned)u << 16); }
__device__ __forceinline__ float bflo(unsigned w) { return __uint_as_float(w << 16); }
__device__ __forceinline__ float bfhi(unsigned w) { return __uint_as_float(w & 0xffff0000u); }
__device__ __forceinline__ unsigned f2bf(float f) { unsigned u = __float_as_uint(f); return (u + 0x7fffu + ((u >> 16) & 1u)) >> 16; }
__device__ __forceinline__ unsigned pk2(float lo, float hi) { return f2bf(lo) | (f2bf(hi) << 16); }
__device__ __forceinline__ float wave_sum(float v) {
#pragma unroll
    for (int o = 1; o < 64; o <<= 1) v += __shfl_xor(v, o);
    return v;
}
__device__ __forceinline__ size_t sc_off(int r) { const size_t i = (size_t)(r >> 8); return 65536ull * (i * (i + 1) / 2) + (size_t)(r & 255) * 256ull * (i + 1); }

struct Args { const float* in[17]; float* out; unsigned char* ws; int ph_lo, ph_hi; };

template <bool MAPIN>
__device__ __forceinline__ void transpose_item(const float* __restrict__ W, int K, int srcN, bf16_t* WT, LAS float* scr, int item, int ndst, int lane) {
    const int nblk = ndst / 32, kb = item / nblk, nb = item % nblk, k0 = 64 * kb, n0 = 32 * nb;
    const int n = n0 + (lane & 31);
    int src = n;
    if (MAPIN) { src = (n < 5120) ? n : (n < 17408) ? n + 80 : (n < 17488) ? n - 17408 + 5120 : -1; }
    float tv[32];
#pragma unroll
    for (int i = 0; i < 32; ++i) { const int kk = 2 * i + (lane >> 5); tv[i] = (src >= 0) ? W[(size_t)(k0 + kk) * srcN + src] : 0.f; }
#pragma unroll
    for (int i = 0; i < 32; ++i) { const int kk = 2 * i + (lane >> 5); scr[kk * 33 + (lane & 31)] = tv[i]; }
    asm volatile("s_waitcnt lgkmcnt(0)" ::: "memory");
    const int c = lane & 7;
#pragma unroll
    for (int j = 0; j < 4; ++j) { const int nn = (lane >> 3) + 8 * j; const LAS float* s = scr + (8 * c) * 33 + nn;
        u32x4 o; o.x = pk2(s[0 * 33], s[1 * 33]); o.y = pk2(s[2 * 33], s[3 * 33]); o.z = pk2(s[4 * 33], s[5 * 33]); o.w = pk2(s[6 * 33], s[7 * 33]);
        *(u32x4*)(WT + (size_t)(n0 + nn) * K + k0 + 8 * c) = o; }
    asm volatile("s_waitcnt lgkmcnt(0)" ::: "memory");
}
__device__ __forceinline__ void rms_row_to_bf16(const float* __restrict__ xrow, const float* __restrict__ g, bf16_t* orow, int lane) {
    const f32x4* xr = (const f32x4*)xrow + lane; const f32x4* gr = (const f32x4*)g + lane;
    f32x4 v[8]; float s = 0.f;
#pragma unroll
    for (int j = 0; j < 8; ++j) { v[j] = xr[64 * j]; s += (v[j].x * v[j].x + v[j].y * v[j].y) + (v[j].z * v[j].z + v[j].w * v[j].w); }
    const float rs = 1.0f / sqrtf(wave_sum(s) * (1.f / DM) + RMS_EPS);
    u32x2* o8 = (u32x2*)orow + lane;
#pragma unroll
    for (int j = 0; j < 8; ++j) { const f32x4 gg = gr[64 * j]; u32x2 w; w.x = pk2(v[j].x * rs * gg.x, v[j].y * rs * gg.y); w.y = pk2(v[j].z * rs * gg.z, v[j].w * rs * gg.w); o8[64 * j] = w; }
}
__device__ __forceinline__ void colmax_item(const float* __restrict__ W, unsigned* CM, int item, int lane) {
    const int nblk = NPAD / 32, kb = item / nblk, nb = item % nblk, k0 = 64 * kb, n = 32 * nb + (lane & 31);
    const int src = (n < 5120) ? n : (n < 17408) ? n + 80 : (n < 17488) ? n - 17408 + 5120 : -1;
    const int srcc = src < 0 ? 0 : src;
    if (n >= 4096 && n < 5120) return;
    if (n >= 17408) return;
    float tv[32];
#pragma unroll
    for (int i = 0; i < 32; ++i) { const int kk = 2 * i + (lane >> 5); tv[i] = W[(size_t)(k0 + kk) * DIN + srcc]; }
#pragma unroll
    for (int i = 0; i < 32; ++i) tv[i] = (src >= 0) ? tv[i] : 0.f;
    float m = 0.f;
#pragma unroll
    for (int i = 0; i < 32; ++i) m = fmaxf(m, fabsf(tv[i]));
    m = fmaxf(m, __shfl_xor(m, 32));
    if (lane < 32) atomicMax(CM + n, __float_as_uint(m));
}
__device__ __forceinline__ void quant_item(const float* __restrict__ W, const unsigned* CM, signed char* W8, bf16_t* WT, LAS float* scr, int item, int lane) {
    const int nblk = NPAD / 32, kb = item / nblk, nb = item % nblk, k0 = 64 * kb, n0 = 32 * nb, n = n0 + (lane & 31);
    const int src = (n < 5120) ? n : (n < 17408) ? n + 80 : (n < 17488) ? n - 17408 + 5120 : -1;
    const int srcc = src < 0 ? 0 : src;
    const bool isb = (n0 >= 4096 && n0 < 5120) || n0 >= 17408;
    float tv[32];
#pragma unroll
    for (int i = 0; i < 32; ++i) { const int kk = 2 * i + (lane >> 5); tv[i] = W[(size_t)(k0 + kk) * DIN + srcc]; }
#pragma unroll
    for (int i = 0; i < 32; ++i) tv[i] = (src >= 0) ? tv[i] : 0.f;
    float q = 1.f;
    if (!isb) { const float cm = __uint_as_float(__hip_atomic_load(CM + n, __ATOMIC_RELAXED, __HIP_MEMORY_SCOPE_AGENT)); q = cm > 0.f ? 127.f / cm : 0.f; }
#pragma unroll
    for (int i = 0; i < 32; ++i) { const int kk = 2 * i + (lane >> 5); scr[kk * 33 + (lane & 31)] = isb ? tv[i] : rintf(tv[i] * q); }
    asm volatile("s_waitcnt lgkmcnt(0)" ::: "memory");
    const int c = lane & 7;
#pragma unroll
    for (int j = 0; j < 4; ++j) { const int nn = (lane >> 3) + 8 * j; const LAS float* p = scr + (8 * c) * 33 + nn;
        if (isb) { u32x4 o; o.x = pk2(p[0 * 33], p[1 * 33]); o.y = pk2(p[2 * 33], p[3 * 33]); o.z = pk2(p[4 * 33], p[5 * 33]); o.w = pk2(p[6 * 33], p[7 * 33]);
            *(u32x4*)(WT + (size_t)(n0 + nn) * DM + k0 + 8 * c) = o; }
        else { u32x2 o;
            o.x = ((unsigned)(int)p[0 * 33] & 0xffu) | (((unsigned)(int)p[1 * 33] & 0xffu) << 8) | (((unsigned)(int)p[2 * 33] & 0xffu) << 16) | (((unsigned)(int)p[3 * 33] & 0xffu) << 24);
            o.y = ((unsigned)(int)p[4 * 33] & 0xffu) | (((unsigned)(int)p[5 * 33] & 0xffu) << 8) | (((unsigned)(int)p[6 * 33] & 0xffu) << 16) | (((unsigned)(int)p[7 * 33] & 0xffu) << 24);
            *(u32x2*)(W8 + (size_t)(n0 + nn) * DM + k0 + 8 * c) = o; } }
    asm volatile("s_waitcnt lgkmcnt(0)" ::: "memory");
}
__device__ __forceinline__ void rms_row_quant(const float* __restrict__ xrow, const float* __restrict__ g, bf16_t* orow, signed char* o8row, float* sA, int lane) {
    const f32x4* xr = (const f32x4*)xrow + lane; const f32x4* gr = (const f32x4*)g + lane;
    f32x4 v[8]; float s = 0.f;
#pragma unroll
    for (int j = 0; j < 8; ++j) { v[j] = xr[64 * j]; s += (v[j].x * v[j].x + v[j].y * v[j].y) + (v[j].z * v[j].z + v[j].w * v[j].w); }
    const float rs = 1.0f / sqrtf(wave_sum(s) * (1.f / DM) + RMS_EPS);
    float mx = 0.f;
#pragma unroll
    for (int j = 0; j < 8; ++j) { const f32x4 gg = gr[64 * j]; v[j].x = v[j].x * rs * gg.x; v[j].y = v[j].y * rs * gg.y; v[j].z = v[j].z * rs * gg.z; v[j].w = v[j].w * rs * gg.w;
        mx = fmaxf(mx, fmaxf(fmaxf(fabsf(v[j].x), fabsf(v[j].y)), fmaxf(fabsf(v[j].z), fabsf(v[j].w)))); }
#pragma unroll
    for (int o = 1; o < 64; o <<= 1) mx = fmaxf(mx, __shfl_xor(mx, o));
    const float q = mx > 0.f ? 127.f / mx : 0.f;
    if (lane == 0) *sA = mx * (1.f / 127.f);
    u32x2* o16 = (u32x2*)orow + lane; unsigned* o8 = (unsigned*)o8row + lane;
#pragma unroll
    for (int j = 0; j < 8; ++j) { u32x2 w; w.x = pk2(v[j].x, v[j].y); w.y = pk2(v[j].z, v[j].w); o16[64 * j] = w;
        o8[64 * j] = ((unsigned)(int)rintf(v[j].x * q) & 0xffu) | (((unsigned)(int)rintf(v[j].y * q) & 0xffu) << 8) | (((unsigned)(int)rintf(v[j].z * q) & 0xffu) << 16) | (((unsigned)(int)rintf(v[j].w * q) & 0xffu) << 24); }
}
__device__ __forceinline__ void p0_prologue_a(const Args& a, LAS unsigned char* lds, int blk, int nblk, const int wave) {
    const int lane = lane_id_v(), tid = wave * 64 + lane;
    LAS float* scr = (LAS float*)(lds + wave * 16384);
    const int gw = blk * 8 + wave, NGW = nblk * 8;
    unsigned char* ws = a.ws;
    constexpr int I_IN = (DM / 64) * (NPAD / 32), I_MKV = (DM / 64) * (2048 / 32), I_BR = (1024 / 64) * (2048 / 32), I_OUT = (DM / 64) * (2048 / 32);
    constexpr int NITEMS = I_IN + I_MKV;
    for (int it = gw; it < NITEMS; it += NGW) {
        int r = it;
        if (r < I_IN) { colmax_item(a.in[3], (unsigned*)(ws + WS_SB), r, lane); continue; } r -= I_IN;
        transpose_item<false>(a.in[11], DM, 2048, (bf16_t*)(ws + WS_WTMKV), scr, r, 2048, lane);
    }
    bf16_t* H = (bf16_t*)(ws + WS_H);
    for (int m = gw; m < S + NMEM; m += NGW) {
        if (m < S) rms_row_quant(a.in[0] + (size_t)m * DM, a.in[2], H + (size_t)m * DM, (signed char*)(ws + WS_H8) + (size_t)m * DM, (float*)(ws + WS_SA) + m, lane);
        else rms_row_to_bf16(a.in[1] + (size_t)(m - S) * DM, a.in[10], (bf16_t*)(ws + WS_MEMN) + (size_t)(m - S) * DM, lane);
    }
    if (blk == 0 && wave == 0) {
        const float s1 = wave_sum(a.in[5][lane] * a.in[6][lane]), s2 = wave_sum(a.in[7][lane] * a.in[8][lane]);
        if (lane == 0) ((float*)(ws + WS_CTL))[0] = expf(s1) - expf(s2) + 0.2f;
    }
}
__device__ __forceinline__ void late_transposes(const Args& a, LAS unsigned char* lds, int widx, int nw, const int wave) {
    const int lane = lane_id_v();
    LAS float* scr = (LAS float*)(lds + wave * 16384);
    unsigned char* ws = a.ws;
    constexpr int I_BR = (1024 / 64) * (2048 / 32), I_OUT = (DM / 64) * (2048 / 32);
    for (int it = widx; it < 3 * I_BR + I_OUT; it += nw) {
        int r = it;
        if (r < 3 * I_BR) { const int z = r / I_BR; transpose_item<false>(a.in[12 + z], 1024, 2048, (bf16_t*)(ws + WS_WTBR) + (size_t)z * 2048 * 1024, scr, r % I_BR, 2048, lane); continue; } r -= 3 * I_BR;
        transpose_item<false>(a.in[15], DM, 2048, (bf16_t*)(ws + WS_WTOUT), scr, r, 2048, lane);
    }
}
__device__ __forceinline__ void p0_prologue_b(const Args& a, LAS unsigned char* lds, int blk, int nblk, const int wave) {
    const int lane = lane_id_v();
    LAS float* scr = (LAS float*)(lds + wave * 16384);
    const int gw = blk * 8 + wave, NGW = nblk * 8;
    unsigned char* ws = a.ws;
    constexpr int I_IN = (DM / 64) * (NPAD / 32);
    for (int it = gw; it < I_IN; it += NGW) quant_item(a.in[3], (const unsigned*)(ws + WS_SB), (signed char*)(ws + WS_W8), (bf16_t*)(ws + WS_WTIN), scr, it, lane);
}

__device__ __forceinline__ void idx_scores_naive(const bf16_t* __restrict__ PROJ, float* SC, LAS unsigned char* lds, int blk, int nblk, const int wave) {
    const int lane = lane_id_v(), tid = wave * 64 + lane;
    LAS float* qs = (LAS float*)lds + wave * 1088;
    constexpr int NITEM = 128 * 129 / 2;
    for (int it = blk; it < NITEM; it += nblk) {
        int kb = 0, rem = it; while (rem >= 128 - kb) { rem -= 128 - kb; ++kb; }
        const int qc = kb + rem, s = 64 * kb + lane;
        float kreg[64];
        { const u32x4* kp = (const u32x4*)(PROJ + (size_t)s * NPAD + C_KI);
#pragma unroll
          for (int i = 0; i < 8; ++i) { const u32x4 w = kp[i]; kreg[8 * i + 0] = bflo(w.x); kreg[8 * i + 1] = bfhi(w.x); kreg[8 * i + 2] = bflo(w.y); kreg[8 * i + 3] = bfhi(w.y);
              kreg[8 * i + 4] = bflo(w.z); kreg[8 * i + 5] = bfhi(w.z); kreg[8 * i + 6] = bflo(w.w); kreg[8 * i + 7] = bfhi(w.w); } }
        for (int qq = 0; qq < 8; ++qq) {
            const int q = 64 * qc + wave * 8 + qq;
            { const u32x4* qp = (const u32x4*)(PROJ + (size_t)q * NPAD + C_QI) + 2 * lane;
              const u32x4 w0 = qp[0], w1 = qp[1];
              LAS f32x4* dst = (LAS f32x4*)(qs + 16 * lane);
              dst[0] = (f32x4){bflo(w0.x), bfhi(w0.x), bflo(w0.y), bfhi(w0.y)}; dst[1] = (f32x4){bflo(w0.z), bfhi(w0.z), bflo(w0.w), bfhi(w0.w)};
              dst[2] = (f32x4){bflo(w1.x), bfhi(w1.x), bflo(w1.y), bfhi(w1.y)}; dst[3] = (f32x4){bflo(w1.z), bfhi(w1.z), bflo(w1.w), bfhi(w1.w)};
              if (lane < 16) qs[1024 + lane] = bf2f(PROJ[(size_t)q * NPAD + C_WI + lane]) * 0.25f; }
            asm volatile("s_waitcnt lgkmcnt(0)" ::: "memory"); __builtin_amdgcn_wave_barrier();
            float score = 0.f;
            for (int j = 0; j < 16; ++j) {
                float acc = 0.f; const LAS f32x4* qj = (const LAS f32x4*)(qs + 64 * j);
#pragma unroll
                for (int d = 0; d < 16; ++d) { const f32x4 qv = qj[d]; acc += qv.x * kreg[4 * d] + qv.y * kreg[4 * d + 1] + qv.z * kreg[4 * d + 2] + qv.w * kreg[4 * d + 3]; }
                score += fmaxf(acc * 0.125f, 0.f) * qs[1024 + j];
            }
            if (s <= q) SC[sc_off(q) + s] = score;
            asm volatile("s_waitcnt lgkmcnt(0)" ::: "memory"); __builtin_amdgcn_wave_barrier();
        }
    }
}
__device__ __forceinline__ unsigned ordkey(float f) { const unsigned u = __float_as_uint(f); return (u & 0x80000000u) ? ~u : (u | 0x80000000u); }
#define CNT_LT(acc, key, cnd) asm volatile("v_cmp_gt_u32 vcc, %2, %1\n\tv_addc_co_u32 %0, vcc, 0, %0, vcc" : "+v"(acc) : "v"(key), "v"(cnd) : "vcc")
template <int NR, int NL> __device__ __forceinline__ bool topk_row(const float* __restrict__ row, int n, int lane, LAS u32x4* xl, unsigned long long& w0, unsigned long long& w1, unsigned& Tout, int& need_out) {
#pragma unroll
    for (int q = 0; q < NL / 4; ++q) { u32x4 v;
#pragma unroll
        for (int e = 0; e < 4; ++e) { const int i = 4096 + (4 * q + e) * 64 + lane; v[e] = (ordkey(*(const float*)((const char*)row + 4u * (unsigned)min(i, n - 1))) >> 1) & (unsigned)((i - n) >> 31); }
        xl[q * 64 + lane] = v;
        if ((q & 3) == 3) __builtin_amdgcn_sched_barrier(0); }
    unsigned u[NR];
#pragma unroll
    for (int k = 0; k < NR; ++k) { const int i = k * 64 + lane; u[k] = (ordkey(*(const float*)((const char*)row + 4u * (unsigned)min(i, n - 1))) >> 1) & (unsigned)((i - n) >> 31);
        if ((k & 15) == 15) __builtin_amdgcn_sched_barrier(0); }
    unsigned T = 0u; bool cut = false;
    for (int bit = 30; bit >= 0; --bit) {
        const unsigned cand = T | (1u << bit); unsigned lt = 0u;
        asm volatile("" ::: "memory");
#pragma unroll
        for (int k = 0; k < NR; ++k) CNT_LT(lt, u[k], cand);
#pragma unroll
        for (int q = 0; q < NL / 4; ++q) { const u32x4 v = xl[q * 64 + lane]; CNT_LT(lt, v[0], cand); CNT_LT(lt, v[1], cand); CNT_LT(lt, v[2], cand); CNT_LT(lt, v[3], cand);
            if ((q & 3) == 3) __builtin_amdgcn_sched_barrier(0); }
#pragma unroll
        for (int o = 1; o < 64; o <<= 1) lt += __shfl_xor(lt, o);
        const int ge = (int)((NR + NL) * 64 - lt);
        if (ge >= TOPK) T = cand;
        if (ge == TOPK) { cut = true; break; }
    }
    unsigned c_hi = 0u, c_lt = 0u;
#pragma unroll
    for (int k = 0; k < NR; ++k) { c_hi += (T - u[k]) >> 31; c_lt += (u[k] - T) >> 31; }
#pragma unroll
    for (int q = 0; q < NL / 4; ++q) { const u32x4 v = xl[q * 64 + lane];
#pragma unroll
        for (int e = 0; e < 4; ++e) { c_hi += (T - v[e]) >> 31; c_lt += (v[e] - T) >> 31; } }
#pragma unroll
    for (int o = 1; o < 64; o <<= 1) { c_hi += __shfl_xor(c_hi, o); c_lt += __shfl_xor(c_lt, o); }
    const int need = TOPK - (int)c_hi, c_eq = (NR + NL) * 64 - (int)c_lt - (int)c_hi;
    Tout = T; need_out = need;
    if (!cut && c_eq != need) return false;
    int ln; asm volatile("v_mbcnt_lo_u32_b32 %0, -1, 0\n\tv_mbcnt_hi_u32_b32 %0, -1, %0" : "=v"(ln));
#pragma unroll
    for (int k = 0; k < NR; ++k) {
        const unsigned long long bs = __ballot(u[k] >= T);
        if (k == ln) w0 = bs;
        __builtin_amdgcn_sched_barrier(0); }
#pragma unroll
    for (int q = 0; q < NL / 4; ++q) { const u32x4 v = xl[q * 64 + lane];
#pragma unroll
        for (int e = 0; e < 4; ++e) { const unsigned long long bs = __ballot(v[e] >= T);
            if (4 * q + e == ln) w1 = bs;
            __builtin_amdgcn_sched_barrier(0); } }
    return true;
}
__device__ __forceinline__ void topk_select(const float* SC, int* SEL, LAS unsigned char* lds, int blk, int nblk, const int wave) {
    const int lane = lane_id_v();
    LAS u32x4* xl = (LAS u32x4*)(lds + wave * 16384);
    for (int r = blk * 8 + wave; r < S; r += nblk * 8) {
        const int n = r + 1; unsigned long long* mrow = (unsigned long long*)SEL + (size_t)r * 128;
        unsigned long long w0 = 0ull, w1 = 0ull;
        const int nwords = 4 * ((r >> 8) + 1);
        if (n <= TOPK) { const int lo = 64 * lane; w0 = (r < lo) ? 0ull : ((r - lo >= 63) ? ~0ull : ((2ull << (r - lo)) - 1ull)); }
        else { const float* row = SC + sc_off(r);
            unsigned T; int need; bool ok;
            if (n <= 2048) ok = topk_row<32, 0>(row, n, lane, xl, w0, w1, T, need); else if (n <= 4096) ok = topk_row<64, 0>(row, n, lane, xl, w0, w1, T, need); else ok = topk_row<64, 64>(row, n, lane, xl, w0, w1, T, need);
            if (!ok) { int eqc = 0; const unsigned long long lt = (lane == 0) ? 0ull : (~0ull >> (64 - lane));
                for (int base = 0, it = 0; base < n; base += 64, ++it) {
                    const int i = base + lane; const unsigned v = (i < n) ? (ordkey(row[i]) >> 1) : 0u;
                    const bool gt = v > T, eq = (i < n) && (v == T);
                    const unsigned long long be = __ballot(eq);
                    const bool take = gt || (eq && (eqc + __builtin_popcountll(be & lt) < need));
                    const unsigned long long bs = __ballot(take);
                    if ((it & 63) == lane) { if (it < 64) w0 = bs; else w1 = bs; }
                    eqc += __builtin_popcountll(be); } } }
        if (lane < nwords) mrow[lane] = w0;
        if (64 + lane < nwords) mrow[64 + lane] = w1;
    }
}
template <int DQ, int DV, bool GATHER>
__device__ __forceinline__ void naive_attn(const bf16_t* __restrict__ qp, const bf16_t* __restrict__ kb, const bf16_t* __restrict__ vb, size_t kvpitch,
                                           int nkeys, int nmax, const int* __restrict__ sel, int r, float scale, float slope, float (&o)[DV / 8]) {
    constexpr int QN = DQ / 8, VN = DV / 8;
    float q[QN];
#pragma unroll
    for (int i = 0; i < QN / 2; ++i) { const unsigned w = ((const unsigned*)qp)[i]; q[2 * i] = bflo(w) * scale; q[2 * i + 1] = bfhi(w) * scale; }
#pragma unroll
    for (int i = 0; i < VN; ++i) o[i] = 0.f;
    float m = -1e30f, l = 0.f;
    for (int i = 0; i < nmax; ++i) {
        bool valid = i < nkeys; int key = i;
        if (GATHER) { key = sel[valid ? i : 0]; valid = valid && key >= 0; }
        if (!valid) key = 0;
        const unsigned* kp = (const unsigned*)(kb + (size_t)key * kvpitch);
        float d = 0.f;
#pragma unroll
        for (int j = 0; j < QN / 2; ++j) { const unsigned w = kp[j]; d += q[2 * j] * bflo(w) + q[2 * j + 1] * bfhi(w); }
        d += __shfl_xor(d, 1); d += __shfl_xor(d, 2); d += __shfl_xor(d, 4);
        const float logit = d - slope * (float)(r - key);
        if (valid) {
            if (logit > m) { const float c = __expf(m - logit); l *= c;
#pragma unroll
                for (int j = 0; j < VN; ++j) o[j] *= c;
                m = logit; }
            const float p = __expf(logit - m); l += p;
            const unsigned* vp = (const unsigned*)(vb + (size_t)key * kvpitch);
#pragma unroll
            for (int j = 0; j < VN / 2; ++j) { const unsigned w = vp[j]; o[2 * j] += p * bflo(w); o[2 * j + 1] += p * bfhi(w); }
        }
    }
    const float il = 1.0f / l;
#pragma unroll
    for (int j = 0; j < VN; ++j) o[j] *= il;
}
__device__ __forceinline__ void attn_b_naive(const Args& a, int blk, int nblk, const int wave) {
    const int lane = lane_id_v(), tid = wave * 64 + lane, sub = lane & 7;
    const bf16_t* PROJ = (const bf16_t*)(a.ws + WS_PROJ); bf16_t* UB = (bf16_t*)(a.ws + WS_U) + (size_t)1 * S * 1024;
    const float lam = ((const float*)(a.ws + WS_CTL))[0];
    for (int wi = blk * 8 + wave; wi < 1024 * 8; wi += nblk * 8) {
        const int h = wi & 7, rg = wi >> 3, r = rg * 8 + (lane >> 3), nmax = rg * 8 + 8;
        const float slope = exp2f(-(float)(h + 1));
        float o0[16], o1[16];
        const bf16_t* rowp = PROJ + (size_t)r * NPAD;
        naive_attn<64, 128, false>(rowp + C_QB + h * 128 + sub * 8, PROJ + C_KB + h * 128 + sub * 8, PROJ + C_VB + h * 128 + sub * 16, NPAD, r + 1, nmax, nullptr, r, 0.125f, slope, o0);
        naive_attn<64, 128, false>(rowp + C_QB + h * 128 + 64 + sub * 8, PROJ + C_KB + h * 128 + 64 + sub * 8, PROJ + C_VB + h * 128 + sub * 16, NPAD, r + 1, nmax, nullptr, r, 0.125f, slope, o1);
        float ss = 0.f;
#pragma unroll
        for (int j = 0; j < 16; ++j) { o0[j] -= lam * o1[j]; ss += o0[j] * o0[j]; }
        ss += __shfl_xor(ss, 1); ss += __shfl_xor(ss, 2); ss += __shfl_xor(ss, 4);
        const float rs = 1.0f / sqrtf(ss * (1.f / 128.f) + RMS_EPS) * 0.8f;
        const float* g = a.in[9] + sub * 16; const bf16_t* zp = rowp + C_ZB + h * 128 + sub * 16;
        unsigned w[8];
#pragma unroll
        for (int j = 0; j < 8; ++j) w[j] = pk2(o0[2 * j] * rs * g[2 * j] * bf2f(zp[2 * j]), o0[2 * j + 1] * rs * g[2 * j + 1] * bf2f(zp[2 * j + 1]));
        u32x4* dst = (u32x4*)(UB + (size_t)r * 1024 + h * 128 + sub * 16);
        dst[0] = (u32x4){w[0], w[1], w[2], w[3]}; dst[1] = (u32x4){w[4], w[5], w[6], w[7]};
    }
}
__device__ __forceinline__ void attn_m_naive(const Args& a, int blk, int nblk, const int wave) {
    const int lane = lane_id_v(), tid = wave * 64 + lane, sub = lane & 7;
    const bf16_t* PROJ = (const bf16_t*)(a.ws + WS_PROJ); const bf16_t* MKV = (const bf16_t*)(a.ws + WS_MKV); bf16_t* UM = (bf16_t*)(a.ws + WS_U) + (size_t)2 * S * 1024;
    for (int wi = blk * 8 + wave; wi < 1024 * 4; wi += nblk * 8) {
        const int h = wi & 3, rg = wi >> 2, r = rg * 8 + (lane >> 3);
        float o[32];
        const bf16_t* rowp = PROJ + (size_t)r * NPAD;
        naive_attn<256, 256, false>(rowp + C_QM + h * 256 + sub * 32, MKV + h * 256 + sub * 32, MKV + 1024 + h * 256 + sub * 32, 2048, NMEM, NMEM, nullptr, 0, 0.0625f, 0.f, o);
        const bf16_t* zp = rowp + C_ZM + h * 256 + sub * 32;
        u32x4* dst = (u32x4*)(UM + (size_t)r * 1024 + h * 256 + sub * 32);
#pragma unroll
        for (int j = 0; j < 4; ++j) { u32x4 w;
            w.x = pk2(o[8 * j + 0] * bf2f(zp[8 * j + 0]), o[8 * j + 1] * bf2f(zp[8 * j + 1])); w.y = pk2(o[8 * j + 2] * bf2f(zp[8 * j + 2]), o[8 * j + 3] * bf2f(zp[8 * j + 3]));
            w.z = pk2(o[8 * j + 4] * bf2f(zp[8 * j + 4]), o[8 * j + 5] * bf2f(zp[8 * j + 5])); w.w = pk2(o[8 * j + 6] * bf2f(zp[8 * j + 6]), o[8 * j + 7] * bf2f(zp[8 * j + 7]));
            dst[j] = w; }
    }
}
__device__ __forceinline__ void attn_a_naive(const Args& a, int blk, int nblk, const int wave) {
    const int lane = lane_id_v(), tid = wave * 64 + lane, sub = lane & 7;
    const bf16_t* PROJ = (const bf16_t*)(a.ws + WS_PROJ); const int* SEL = (const int*)(a.ws + WS_SEL); bf16_t* UA = (bf16_t*)(a.ws + WS_U);
    for (int wi = blk * 8 + wave; wi < 1024 * 8; wi += nblk * 8) {
        const int h = wi & 7, rg = wi >> 3, r = rg * 8 + (lane >> 3);
        const float slope = exp2f(-(float)(h + 1));
        float o[16];
        const bf16_t* rowp = PROJ + (size_t)r * NPAD;
        naive_attn<128, 128, true>(rowp + C_QA + h * 128 + sub * 16, PROJ + C_KA + h * 128 + sub * 16, PROJ + C_VA + h * 128 + sub * 16, NPAD, TOPK, TOPK, SEL + (size_t)r * TOPK, r, 0.08838834764831845f, slope, o);
        const bf16_t* zp = rowp + C_ZA + h * 128 + sub * 16;
        unsigned w[8];
#pragma unroll
        for (int j = 0; j < 8; ++j) w[j] = pk2(o[2 * j] * bf2f(zp[2 * j]), o[2 * j + 1] * bf2f(zp[2 * j + 1]));
        u32x4* dst = (u32x4*)(UA + (size_t)r * 1024 + h * 128 + sub * 16);
        dst[0] = (u32x4){w[0], w[1], w[2], w[3]}; dst[1] = (u32x4){w[4], w[5], w[6], w[7]};
    }
}
__device__ __forceinline__ void final_norm(const Args& a, int blk, int nblk, const int wave) {
    const int lane = lane_id_v(), tid = wave * 64 + lane;
    const float* part = (const float*)(a.ws + WS_PART); const f32x4* g = (const f32x4*)a.in[16] + lane;
    for (int r = blk * 8 + wave; r < S; r += nblk * 8) {
        float s = (lane < 32) ? part[(size_t)lane * S + r] : 0.f;
        const float rs = 1.0f / sqrtf(wave_sum(s) * (1.f / DM) + RMS_EPS);
        f32x4* y = (f32x4*)(a.out + (size_t)r * DM) + lane;
#pragma unroll
        for (int j = 0; j < 8; ++j) { f32x4 v = y[64 * j]; const f32x4 gg = g[64 * j]; v = v * rs * gg; y[64 * j] = v; }
    }
}


namespace att {
typedef short bf16x8 __attribute__((ext_vector_type(8)));
typedef short s16x4 __attribute__((ext_vector_type(4)));
typedef float f32x16 __attribute__((ext_vector_type(16)));
typedef float f32x2_t __attribute__((ext_vector_type(2)));
typedef __bf16 bf16x2_t __attribute__((ext_vector_type(2)));
constexpr int SHM_V = 16384, SHM_K = 16384;
constexpr float LOG2E = 1.4426950408889634f;
constexpr float THR2 = 8.f * LOG2E;
#define KSWZ(row, colB) ((row) * 256 + ((colB) ^ (((row) & 7) << 4)))
#define SBAR() __builtin_amdgcn_sched_barrier(0)
__device__ __forceinline__ int crow(int r, int hi) { return (r & 3) + 8 * (r >> 2) + 4 * hi; }
__device__ __forceinline__ unsigned cvtpk(float lo, float hi) { f32x2_t v = {lo, hi}; bf16x2_t b = __builtin_convertvector(v, bf16x2_t); return __builtin_bit_cast(unsigned, b); }
__device__ __forceinline__ int v_st(int k, int c) { const int kk = (k & ~0xC) | ((k & 4) << 1) | ((k & 8) >> 1); return ((kk >> 3) * 4 + (c >> 5)) * 512 + ((kk & 7) * 32 + (c & 31)) * 2; }
__device__ __forceinline__ int v_rd_base(int lane) { return ((lane & 3) << 3) | (((lane >> 2) & 3) << 6) | (((lane >> 4) & 1) << 5) | (((lane >> 5) & 1) << 8); }
constexpr int v_rd_off(int d0, int ks, int half) { return d0 * 512 + ks * 4096 + half * 2048; }
typedef short v4i16_t __attribute__((ext_vector_type(4)));
__device__ __forceinline__ s16x4 tr_read(LAS const unsigned char* p) { return __builtin_bit_cast(s16x4, __builtin_amdgcn_ds_read_tr16_b64_v4i16((LAS v4i16_t*)p)); }

template <int NQ> __device__ __forceinline__ void qkt(f32x16& p0, f32x16& p1, LAS const unsigned char* Ks, const bf16x8* qr, int cbyte0, int r32, int hi) {
  p0 = f32x16{}; p1 = f32x16{};
#pragma unroll
  for (int d0 = 0; d0 < NQ; ++d0) { const int cb = cbyte0 + (d0 * 16 + hi * 8) * 2;
    const bf16x8 b0 = *(LAS const bf16x8*)(Ks + KSWZ(r32, cb));
    const bf16x8 b1 = *(LAS const bf16x8*)(Ks + KSWZ(32 + r32, cb));
    p0 = __builtin_amdgcn_mfma_f32_32x32x16_bf16(b0, qr[d0], p0, 0, 0, 0);
    p1 = __builtin_amdgcn_mfma_f32_32x32x16_bf16(b1, qr[d0], p1, 0, 0, 0); }
}
template <int NQ> __device__ __forceinline__ void qkt_l(f32x16& p0, f32x16& p1, LAS const unsigned char* Ks, LAS const unsigned char* Qs, int cbyte0, int r32, int hi) {
  p0 = f32x16{}; p1 = f32x16{};
  asm volatile("" : "+v"(Qs));
#pragma unroll
  for (int d0 = 0; d0 < NQ; ++d0) { const int cb = cbyte0 + (d0 * 16 + hi * 8) * 2;
    const bf16x8 q = *(LAS const bf16x8*)(Qs + d0 * 1024);
    const bf16x8 b0 = *(LAS const bf16x8*)(Ks + KSWZ(r32, cb));
    const bf16x8 b1 = *(LAS const bf16x8*)(Ks + KSWZ(32 + r32, cb));
    p0 = __builtin_amdgcn_mfma_f32_32x32x16_bf16(b0, q, p0, 0, 0, 0);
    p1 = __builtin_amdgcn_mfma_f32_32x32x16_bf16(b1, q, p1, 0, 0, 0); }
}
template <int D0> __device__ __forceinline__ void pv_one(f32x16& od, LAS const unsigned char* vb, bf16x8 pa0, bf16x8 pa1, bf16x8 pa2, bf16x8 pa3) {
  const s16x4 l0 = tr_read(vb + v_rd_off(D0, 0, 0)), h0 = tr_read(vb + v_rd_off(D0, 0, 1)), l1 = tr_read(vb + v_rd_off(D0, 1, 0)), h1 = tr_read(vb + v_rd_off(D0, 1, 1));
  const s16x4 l2 = tr_read(vb + v_rd_off(D0, 2, 0)), h2 = tr_read(vb + v_rd_off(D0, 2, 1)), l3 = tr_read(vb + v_rd_off(D0, 3, 0)), h3 = tr_read(vb + v_rd_off(D0, 3, 1));
#define PK(L, H) (bf16x8){L[0], L[1], L[2], L[3], H[0], H[1], H[2], H[3]}
  od = __builtin_amdgcn_mfma_f32_32x32x16_bf16(pa0, PK(l0, h0), od, 0, 0, 0);
  od = __builtin_amdgcn_mfma_f32_32x32x16_bf16(pa1, PK(l1, h1), od, 0, 0, 0);
  od = __builtin_amdgcn_mfma_f32_32x32x16_bf16(pa2, PK(l2, h2), od, 0, 0, 0);
  od = __builtin_amdgcn_mfma_f32_32x32x16_bf16(pa3, PK(l3, h3), od, 0, 0, 0);
#undef PK
}
__device__ __forceinline__ void pv_d0(f32x16* o, LAS const unsigned char* vb, bf16x8 pa0, bf16x8 pa1, bf16x8 pa2, bf16x8 pa3) {
  pv_one<0>(o[0], vb, pa0, pa1, pa2, pa3); pv_one<1>(o[1], vb, pa0, pa1, pa2, pa3); pv_one<2>(o[2], vb, pa0, pa1, pa2, pa3); pv_one<3>(o[3], vb, pa0, pa1, pa2, pa3);
}
template <bool CAUSAL> __device__ __forceinline__ void partialSM(f32x16& p0, f32x16& p1, float& m_reg, float& alpha, const float (&cs)[16], float base, int lim, float C, float slope2, int delta) {
  const float tb0 = slope2 * (float)delta + base, tb1 = slope2 * (float)(delta + 32) + base;
#pragma unroll
  for (int r = 0; r < 16; ++r) { p0[r] = fmaf(p0[r], C, cs[r]); p1[r] = fmaf(p1[r], C, cs[r]); }
  if (CAUSAL && delta + 63 > 0) {
    const int l0 = lim - delta, l1 = l0 - 32;
#pragma unroll
    for (int r = 0; r < 16; ++r) { const int K = (r & 3) + 8 * (r >> 2); if (K > l0) p0[r] = -INFINITY; if (K > l1) p1[r] = -INFINITY; }
  }
  float pm0 = p0[0], pm1 = p1[0];
#pragma unroll
  for (int r = 1; r < 16; ++r) { pm0 = fmaxf(pm0, p0[r]); pm1 = fmaxf(pm1, p1[r]); }
  float pmax = fmaxf(pm0 + tb0, pm1 + tb1);
  { auto rr = __builtin_amdgcn_permlane32_swap(__float_as_uint(pmax), __float_as_uint(pmax), false, false);
    pmax = fmaxf(__uint_as_float(rr[0]), __uint_as_float(rr[1])); }
  float mn;
  if (__builtin_expect(__all(pmax - m_reg <= THR2), 1)) { mn = m_reg; alpha = 1.f; }
  else { mn = fmaxf(m_reg, pmax); alpha = __builtin_amdgcn_exp2f(m_reg - mn); m_reg = mn; }
  const float a0 = tb0 - mn, a1 = tb1 - mn;
#pragma unroll
  for (int r = 0; r < 16; ++r) { p0[r] += a0; p1[r] += a1; }
#pragma unroll
  for (int r = 0; r < 16; ++r) p0[r] = __builtin_amdgcn_exp2f(p0[r]);
}
__device__ __forceinline__ void finishSM(f32x16& p0, f32x16& p1, float alpha, float& l_reg, bf16x8& pa0, bf16x8& pa1, bf16x8& pa2, bf16x8& pa3) {
#pragma unroll
  for (int r = 0; r < 16; ++r) p1[r] = __builtin_amdgcn_exp2f(p1[r]);
  float ps = 0;
#pragma unroll
  for (int r = 0; r < 16; ++r) ps += p0[r];
#pragma unroll
  for (int r = 0; r < 16; ++r) ps += p1[r];
  { auto rr = __builtin_amdgcn_permlane32_swap(__float_as_uint(ps), __float_as_uint(ps), false, false);
    ps = __uint_as_float(rr[0]) + __uint_as_float(rr[1]); }
  l_reg = l_reg * alpha + ps;
#define PK4(P, BASE, OUT) do { unsigned a0 = cvtpk(P[BASE + 0], P[BASE + 1]), a1 = cvtpk(P[BASE + 2], P[BASE + 3]);   \
    unsigned b0 = cvtpk(P[BASE + 4], P[BASE + 5]), b1 = cvtpk(P[BASE + 6], P[BASE + 7]);                              \
    auto r0 = __builtin_amdgcn_permlane32_swap(a0, b0, false, false); auto r1 = __builtin_amdgcn_permlane32_swap(a1, b1, false, false); \
    u32x4 w = {r0[0], r1[0], r0[1], r1[1]}; OUT = __builtin_bit_cast(bf16x8, w); } while (0)
  PK4(p0, 0, pa0); PK4(p0, 8, pa1); PK4(p1, 0, pa2); PK4(p1, 8, pa3);
#undef PK4
}

__device__ __forceinline__ void attn_b_unit(const bf16_t* __restrict__ PROJ, bf16_t* UB, const float* __restrict__ gsub, float lam, int h, int qb, int jmin, LAS unsigned char* lds, const int wid) {
  const int lane = lane_id_v(), tid = wid * 64 + lane, r32 = lane & 31, hi = lane >> 5, comp = wid >> 2, wq = wid & 3;
  const int R0 = qb * 128, qrow0 = R0 + wq * 32, NT = 2 * qb + 2, NTe = NT - jmin;
  LAS unsigned char* V_lds = lds; LAS unsigned char* K_lds = lds + 2 * SHM_V;
  LAS float* ws = (LAS float*)(lds + 2 * SHM_V + 2 * SHM_K) + wid * 64; LAS float* li_l = ws; LAS float* al_l = ws + 32;
  LAS float* xch = (LAS float*)(lds + 2 * SHM_V + 2 * SHM_K + 2048);
  const float slope2 = __builtin_amdgcn_exp2f(-(float)(h + 1)) * LOG2E, C = 0.125f * LOG2E;
  float cs[16];
#pragma unroll
  for (int r = 0; r < 16; ++r) cs[r] = __uint_as_float(__builtin_amdgcn_readfirstlane(__float_as_uint(slope2 * (float)((r & 3) + 8 * (r >> 2)))));
  const float base = slope2 * (float)(4 * hi - r32); const int lim = r32 - 4 * hi;
  float m_reg = -1e30f, l_reg = 0; f32x16 o[4] = {};
  LAS unsigned char* Qs = lds + 2 * SHM_V + 2 * SHM_K + 2048 + wid * 4096 + lane * 16;
  { const unsigned qo = ((unsigned)(qrow0 + r32) * (unsigned)NPAD + (unsigned)(C_QB + h * 128 + comp * 64 + hi * 8)) * 2u;
#pragma unroll
    for (int d0 = 0; d0 < 4; ++d0) *(LAS bf16x8*)(Qs + d0 * 1024) = *(const bf16x8*)((const char*)PROJ + (qo + 32u * d0)); }
  const unsigned offK = (unsigned)((tid >> 4) * NPAD + C_KB + h * 128 + (tid & 15) * 8) * 2u, offV = offK + (unsigned)(C_VB - C_KB) * 2u;
  const int sr = tid >> 4, sc = (tid & 15) * 8, vst0 = v_st(sr, sc), vst1 = v_st(32 + sr, sc), cq = comp * 128;
  LAS const unsigned char* vb0 = V_lds + v_rd_base(lane);
  struct { bf16x8 vs0, vs1, ks0, ks1; } sr_[2];
#define KEY0(t) (64 * (NT - 1 - (t)))
#define GLD16(off) (*(const bf16x8*)((const char*)PROJ + (unsigned)(off)))
#define SLOAD(i, k0) do { const unsigned kb_ = (unsigned)(k0) * (unsigned)(NPAD * 2); sr_[i].vs0 = GLD16(offV + kb_); sr_[i].vs1 = GLD16(offV + kb_ + 32u * NPAD * 2u); \
    sr_[i].ks0 = GLD16(offK + kb_); sr_[i].ks1 = GLD16(offK + kb_ + 32u * NPAD * 2u); } while (0)
#define SWRITE(b) do { *(LAS bf16x8*)(V_lds + (b) * SHM_V + vst0) = sr_[b].vs0; *(LAS bf16x8*)(V_lds + (b) * SHM_V + vst1) = sr_[b].vs1; const int kc = sc * 2; \
    *(LAS bf16x8*)(K_lds + (b) * SHM_K + KSWZ(sr, kc)) = sr_[b].ks0; *(LAS bf16x8*)(K_lds + (b) * SHM_K + KSWZ(32 + sr, kc)) = sr_[b].ks1; } while (0)
#define RESC(a) do { if (__any((a) < 1.f)) { if (hi == 0) al_l[r32] = (a); asm volatile("s_waitcnt lgkmcnt(0)" ::: "memory"); \
    _Pragma("unroll") for (int d = 0; d < 4; ++d) _Pragma("unroll") for (int r = 0; r < 16; ++r) o[d][r] *= al_l[crow(r, hi)]; } } while (0)
  f32x16 pA0, pA1, pB0, pB1; float alA, alB; bf16x8 pa0, pa1, pa2, pa3;
  SLOAD(0, KEY0(0)); SWRITE(0); __syncthreads();
  qkt_l<4>(pA0, pA1, K_lds, Qs, cq, r32, hi); partialSM<true>(pA0, pA1, m_reg, alA, cs, base, lim, C, slope2, KEY0(0) - qrow0);
  SLOAD(1, KEY0(1)); if (2 < NTe) SLOAD(0, KEY0(2));
  SWRITE(1); __syncthreads();
  for (int j = 1; j + 1 < NTe; j += 2) {
    SBAR(); qkt_l<4>(pB0, pB1, K_lds + SHM_K, Qs, cq, r32, hi);
    finishSM(pA0, pA1, alA, l_reg, pa0, pa1, pa2, pa3); SBAR();
    SLOAD(1, KEY0(j + 2)); SBAR();
    pv_d0(o, vb0, pa0, pa1, pa2, pa3); partialSM<true>(pB0, pB1, m_reg, alB, cs, base, lim, C, slope2, KEY0(j) - qrow0);
    __syncthreads(); SWRITE(0);
    RESC(alB); __syncthreads();
    SBAR(); qkt_l<4>(pA0, pA1, K_lds, Qs, cq, r32, hi);
    finishSM(pB0, pB1, alB, l_reg, pa0, pa1, pa2, pa3); SBAR();
    SLOAD(0, KEY0(min(j + 3, NTe - 1))); SBAR();
    pv_d0(o, vb0 + SHM_V, pa0, pa1, pa2, pa3); partialSM<true>(pA0, pA1, m_reg, alA, cs, base, lim, C, slope2, KEY0(j + 1) - qrow0);
    __syncthreads(); SWRITE(1);
    RESC(alA); __syncthreads();
  }
  SBAR(); qkt_l<4>(pB0, pB1, K_lds + SHM_K, Qs, cq, r32, hi);
  finishSM(pA0, pA1, alA, l_reg, pa0, pa1, pa2, pa3); SBAR();
  pv_d0(o, vb0, pa0, pa1, pa2, pa3); partialSM<true>(pB0, pB1, m_reg, alB, cs, base, lim, C, slope2, KEY0(NTe - 1) - qrow0);
  __syncthreads(); RESC(alB);
  finishSM(pB0, pB1, alB, l_reg, pa0, pa1, pa2, pa3); SBAR();
  pv_d0(o, vb0 + SHM_V, pa0, pa1, pa2, pa3);
#undef KEY0
#undef SLOAD
#undef GLD16
#undef SWRITE
#undef RESC
  if (hi == 0) li_l[r32] = l_reg; asm volatile("s_waitcnt lgkmcnt(0)" ::: "memory");
  float rli[16];
#pragma unroll
  for (int r = 0; r < 16; ++r) rli[r] = __builtin_amdgcn_rcpf(li_l[crow(r, hi)]);
  __syncthreads();
  if (comp == 1) {
#pragma unroll
    for (int d0 = 0; d0 < 4; ++d0)
#pragma unroll
      for (int r = 0; r < 16; ++r) xch[(wq * 64 + d0 * 16 + r) * 64 + lane] = o[d0][r] * rli[r] * lam;
  }
  __syncthreads();
  if (comp == 0) {
    float ss[16];
#pragma unroll
    for (int r = 0; r < 16; ++r) ss[r] = 0.f;
#pragma unroll
    for (int d0 = 0; d0 < 4; ++d0)
#pragma unroll
      for (int r = 0; r < 16; ++r) { const float d = o[d0][r] * rli[r] - xch[(wq * 64 + d0 * 16 + r) * 64 + lane]; o[d0][r] = d; ss[r] += d * d; }
#pragma unroll
    for (int r = 0; r < 16; ++r) { float s = ss[r]; s += __shfl_xor(s, 1); s += __shfl_xor(s, 2); s += __shfl_xor(s, 4); s += __shfl_xor(s, 8); s += __shfl_xor(s, 16);
      ss[r] = 0.8f / sqrtf(s * (1.f / 128.f) + RMS_EPS); }
    bf16_t zv[4][16];
#pragma unroll
    for (int d0 = 0; d0 < 4; ++d0)
#pragma unroll
      for (int r = 0; r < 16; ++r) zv[d0][r] = PROJ[(size_t)(qrow0 + crow(r, hi)) * NPAD + C_ZB + h * 128 + d0 * 32 + r32];
#pragma unroll
    for (int d0 = 0; d0 < 4; ++d0) { const int col = d0 * 32 + r32; const float g = gsub[col];
#pragma unroll
      for (int r = 0; r < 16; ++r) { const size_t row = (size_t)(qrow0 + crow(r, hi));
        UB[row * 1024 + h * 128 + col] = (bf16_t)f2bf(o[d0][r] * ss[r] * g * bf2f(zv[d0][r])); } }
  }
  __syncthreads();
}
template <bool DUMMY> __device__ __forceinline__ void partialSM_A(f32x16& p0, f32x16& p1, float& m_reg, float& alpha, const float (&cs)[16], float base, float C, float slope2, int delta, unsigned long long mw, int hi) {
  const float tb0 = slope2 * (float)delta + base, tb1 = slope2 * (float)(delta + 32) + base;
  const unsigned wl = (unsigned)mw >> (4 * hi), wh = (unsigned)(mw >> 32) >> (4 * hi);
#pragma unroll
  for (int r = 0; r < 16; ++r) { const int K = (r & 3) + 8 * (r >> 2);
    const float y0 = fmaf(p0[r], C, cs[r]), y1 = fmaf(p1[r], C, cs[r]);
    const unsigned t0 = (unsigned)((int)(wl << (31 - K)) >> 31), t1 = (unsigned)((int)(wh << (31 - K)) >> 31);
    p0[r] = __uint_as_float((__float_as_uint(y0) & t0) | (~t0 & 0xff800000u));
    p1[r] = __uint_as_float((__float_as_uint(y1) & t1) | (~t1 & 0xff800000u)); }
  float pm0 = p0[0], pm1 = p1[0];
#pragma unroll
  for (int r = 1; r < 16; ++r) { pm0 = fmaxf(pm0, p0[r]); pm1 = fmaxf(pm1, p1[r]); }
  float pmax = fmaxf(pm0 + tb0, pm1 + tb1);
  { auto rr = __builtin_amdgcn_permlane32_swap(__float_as_uint(pmax), __float_as_uint(pmax), false, false);
    pmax = fmaxf(__uint_as_float(rr[0]), __uint_as_float(rr[1])); }
  float mn;
  if (__builtin_expect(__all(pmax - m_reg <= THR2), 1)) { mn = m_reg; alpha = 1.f; }
  else { mn = fmaxf(m_reg, pmax); alpha = __builtin_amdgcn_exp2f(m_reg - mn); m_reg = mn; }
  const float a0 = tb0 - mn, a1 = tb1 - mn;
#pragma unroll
  for (int r = 0; r < 16; ++r) { p0[r] += a0; p1[r] += a1; }
#pragma unroll
  for (int r = 0; r < 16; ++r) p0[r] = __builtin_amdgcn_exp2f(p0[r]);
}
__device__ __forceinline__ void attn_a_unit(const bf16_t* __restrict__ PROJ, const unsigned long long* __restrict__ MASK, bf16_t* UA, int h, int qb, int jmin, LAS unsigned char* lds, const int wid) {
  const int lane = lane_id_v(), tid = wid * 64 + lane, r32 = lane & 31, hi = lane >> 5;
  const int R0 = qb * 256, qrow0 = R0 + wid * 32, NT = 4 * qb + 4, NTe = NT - jmin;
  LAS unsigned char* V_lds = lds; LAS unsigned char* K_lds = lds + 2 * SHM_V;
  LAS float* ws = (LAS float*)(lds + 2 * SHM_V + 2 * SHM_K) + wid * 64; LAS float* li_l = ws; LAS float* al_l = ws + 32;
  const float slope2 = __builtin_amdgcn_exp2f(-(float)(h + 1)) * LOG2E, C = 0.08838834764831845f * LOG2E;
  float cs[16];
#pragma unroll
  for (int r = 0; r < 16; ++r) cs[r] = __uint_as_float(__builtin_amdgcn_readfirstlane(__float_as_uint(slope2 * (float)((r & 3) + 8 * (r >> 2)))));
  const float base = slope2 * (float)(4 * hi - r32);
  float m_reg = -1e30f, l_reg = 0; f32x16 o[4] = {}; bf16x8 qr[8];
  { const bf16_t* Qw = PROJ + (size_t)(qrow0 + r32) * NPAD + C_QA + h * 128 + hi * 8;
#pragma unroll
    for (int d0 = 0; d0 < 8; ++d0) qr[d0] = *(const bf16x8*)(Qw + d0 * 16); }
  const unsigned offK = (unsigned)((tid >> 4) * NPAD + C_KA + h * 128 + (tid & 15) * 8) * 2u, offV = offK + (unsigned)(C_VA - C_KA) * 2u;
  const unsigned moff = (unsigned)(qrow0 + r32) * 1024u;
#define MLD(tj) (*(const unsigned long long*)((const char*)MASK + (moff + 8u * (unsigned)(tj))))
  const int sr = tid >> 4, sc = (tid & 15) * 8, vst0 = v_st(sr, sc), vst1 = v_st(32 + sr, sc);
  LAS const unsigned char* vb0 = V_lds + v_rd_base(lane);
  struct { bf16x8 vs0, vs1, ks0, ks1; } sr_;
#define TJ(t) (NT - 1 - (t))
#define KEY0(t) (64 * TJ(t))
#define GLD16(off) (*(const bf16x8*)((const char*)PROJ + (unsigned)(off)))
#define SLOAD(k0) do { const unsigned kb_ = (unsigned)(k0) * (unsigned)(NPAD * 2); sr_.vs0 = GLD16(offV + kb_); sr_.vs1 = GLD16(offV + kb_ + 32u * NPAD * 2u); \
    sr_.ks0 = GLD16(offK + kb_); sr_.ks1 = GLD16(offK + kb_ + 32u * NPAD * 2u); } while (0)
#define SWRITE(b) do { *(LAS bf16x8*)(V_lds + (b) * SHM_V + vst0) = sr_.vs0; *(LAS bf16x8*)(V_lds + (b) * SHM_V + vst1) = sr_.vs1; const int kc = sc * 2; \
    *(LAS bf16x8*)(K_lds + (b) * SHM_K + KSWZ(sr, kc)) = sr_.ks0; *(LAS bf16x8*)(K_lds + (b) * SHM_K + KSWZ(32 + sr, kc)) = sr_.ks1; } while (0)
#define RESC(a) do { if (__any((a) < 1.f)) { if (hi == 0) al_l[r32] = (a); asm volatile("s_waitcnt lgkmcnt(0)" ::: "memory"); \
    _Pragma("unroll") for (int d = 0; d < 4; ++d) _Pragma("unroll") for (int r = 0; r < 16; ++r) o[d][r] *= al_l[crow(r, hi)]; } } while (0)
  f32x16 pA0, pA1, pB0, pB1; float alA, alB; bf16x8 pa0, pa1, pa2, pa3; unsigned long long mwA, mwB;
  SLOAD(KEY0(0)); mwA = MLD(TJ(0)); SWRITE(0); __syncthreads();
  qkt<8>(pA0, pA1, K_lds, qr, 0, r32, hi); partialSM_A<true>(pA0, pA1, m_reg, alA, cs, base, C, slope2, KEY0(0) - qrow0, mwA, hi);
  SLOAD(KEY0(1)); mwB = MLD(TJ(1)); SWRITE(1); __syncthreads();
  for (int j = 1; j + 1 < NTe; j += 2) {
    SBAR(); qkt<8>(pB0, pB1, K_lds + SHM_K, qr, 0, r32, hi);
    finishSM(pA0, pA1, alA, l_reg, pa0, pa1, pa2, pa3); SBAR();
    SLOAD(KEY0(j + 1)); mwA = MLD(TJ(j + 1)); SBAR();
    pv_d0(o, vb0, pa0, pa1, pa2, pa3); partialSM_A<true>(pB0, pB1, m_reg, alB, cs, base, C, slope2, KEY0(j) - qrow0, mwB, hi);
    __syncthreads(); SWRITE(0);
    RESC(alB); __syncthreads();
    SBAR(); qkt<8>(pA0, pA1, K_lds, qr, 0, r32, hi);
    finishSM(pB0, pB1, alB, l_reg, pa0, pa1, pa2, pa3); SBAR();
    SLOAD(KEY0(j + 2)); mwB = MLD(TJ(j + 2)); SBAR();
    pv_d0(o, vb0 + SHM_V, pa0, pa1, pa2, pa3); partialSM_A<true>(pA0, pA1, m_reg, alA, cs, base, C, slope2, KEY0(j + 1) - qrow0, mwA, hi);
    __syncthreads(); SWRITE(1);
    RESC(alA); __syncthreads();
  }
  SBAR(); qkt<8>(pB0, pB1, K_lds + SHM_K, qr, 0, r32, hi);
  finishSM(pA0, pA1, alA, l_reg, pa0, pa1, pa2, pa3); SBAR();
  pv_d0(o, vb0, pa0, pa1, pa2, pa3); partialSM_A<true>(pB0, pB1, m_reg, alB, cs, base, C, slope2, KEY0(NTe - 1) - qrow0, mwB, hi);
  __syncthreads(); RESC(alB);
  finishSM(pB0, pB1, alB, l_reg, pa0, pa1, pa2, pa3); SBAR();
  pv_d0(o, vb0 + SHM_V, pa0, pa1, pa2, pa3);
#undef TJ
#undef MLD
#undef KEY0
#undef SLOAD
#undef GLD16
#undef SWRITE
#undef RESC
  if (hi == 0) li_l[r32] = l_reg; asm volatile("s_waitcnt lgkmcnt(0)" ::: "memory");
  float rli[16];
#pragma unroll
  for (int r = 0; r < 16; ++r) rli[r] = __builtin_amdgcn_rcpf(li_l[crow(r, hi)]);
  { bf16_t zv[4][16];
#pragma unroll
  for (int d0 = 0; d0 < 4; ++d0)
#pragma unroll
    for (int r = 0; r < 16; ++r) zv[d0][r] = PROJ[(size_t)(qrow0 + crow(r, hi)) * NPAD + C_ZA + h * 128 + d0 * 32 + r32];
#pragma unroll
  for (int d0 = 0; d0 < 4; ++d0) { const int col = h * 128 + d0 * 32 + r32;
#pragma unroll
    for (int r = 0; r < 16; ++r) { const size_t row = (size_t)(qrow0 + crow(r, hi));
      UA[row * 1024 + col] = (bf16_t)f2bf(o[d0][r] * rli[r] * bf2f(zv[d0][r])); } } }
  __syncthreads();
}
template <int NQ, bool ACC> __device__ __forceinline__ void qkt_acc(f32x16& p0, f32x16& p1, LAS const unsigned char* Ks, const bf16x8* qr, int r32, int hi) {
  if (!ACC) { p0 = f32x16{}; p1 = f32x16{}; }
#pragma unroll
  for (int d0 = 0; d0 < NQ; ++d0) { const int cb = (d0 * 16 + hi * 8) * 2;
    const bf16x8 b0 = *(LAS const bf16x8*)(Ks + KSWZ(r32, cb));
    const bf16x8 b1 = *(LAS const bf16x8*)(Ks + KSWZ(32 + r32, cb));
    p0 = __builtin_amdgcn_mfma_f32_32x32x16_bf16(b0, qr[d0], p0, 0, 0, 0);
    p1 = __builtin_amdgcn_mfma_f32_32x32x16_bf16(b1, qr[d0], p1, 0, 0, 0); }
}
__device__ __forceinline__ void attn_m_unit(const bf16_t* __restrict__ PROJ, const bf16_t* __restrict__ MKV, bf16_t* UM, int h, int qb, int vh, LAS unsigned char* lds, const int wid) {
  const int lane = lane_id_v(), tid = wid * 64 + lane, r32 = lane & 31, hi = lane >> 5;
  const int qrow0 = qb * 256 + wid * 32;
  LAS unsigned char* V_lds = lds; LAS unsigned char* K_lds = lds + 2 * SHM_V;
  LAS float* ws = (LAS float*)(lds + 2 * SHM_V + 2 * SHM_K) + wid * 64; LAS float* li_l = ws; LAS float* al_l = ws + 32;
  const float C = 0.0625f * LOG2E;
  const float cs[16] = {0.f, 0.f, 0.f, 0.f, 0.f, 0.f, 0.f, 0.f, 0.f, 0.f, 0.f, 0.f, 0.f, 0.f, 0.f, 0.f};
  float m_reg = -1e30f, l_reg = 0; f32x16 o[4] = {}; bf16x8 qr[16];
  { const unsigned qo = ((unsigned)(qrow0 + r32) * (unsigned)NPAD + (unsigned)(C_QM + h * 256 + hi * 8)) * 2u;
#pragma unroll
    for (int d0 = 0; d0 < 16; ++d0) qr[d0] = *(const bf16x8*)((const char*)PROJ + (qo + 32u * d0)); }
  const int sr = tid >> 4, sc = (tid & 15) * 8, vst0 = v_st(sr, sc), vst1 = v_st(32 + sr, sc);
  const unsigned offK = (unsigned)(sr * 2048 + h * 256 + sc) * 2u, offV = offK + (unsigned)(1024 + vh * 128) * 2u;
  LAS const unsigned char* vb0 = V_lds + v_rd_base(lane);
#define GLD16(off) (*(const bf16x8*)((const char*)MKV + (unsigned)(off)))
  for (int t = 0; t < 4; ++t) {
    const unsigned kb_ = (unsigned)(64 * t) * 4096u;
    const bf16x8 ka0 = GLD16(offK + kb_), ka1 = GLD16(offK + kb_ + 32u * 4096u), kb0 = GLD16(offK + kb_ + 256u), kb1 = GLD16(offK + kb_ + 32u * 4096u + 256u);
    const bf16x8 vs0 = GLD16(offV + kb_), vs1 = GLD16(offV + kb_ + 32u * 4096u);
    const int kc = sc * 2;
    *(LAS bf16x8*)(K_lds + KSWZ(sr, kc)) = ka0; *(LAS bf16x8*)(K_lds + KSWZ(32 + sr, kc)) = ka1;
    *(LAS bf16x8*)(K_lds + SHM_K + KSWZ(sr, kc)) = kb0; *(LAS bf16x8*)(K_lds + SHM_K + KSWZ(32 + sr, kc)) = kb1;
    *(LAS bf16x8*)(V_lds + vst0) = vs0; *(LAS bf16x8*)(V_lds + vst1) = vs1;
    __syncthreads();
    f32x16 p0, p1; float al; bf16x8 pa0, pa1, pa2, pa3;
    qkt_acc<8, false>(p0, p1, K_lds, qr, r32, hi); qkt_acc<8, true>(p0, p1, K_lds + SHM_K, qr + 8, r32, hi);
    partialSM<false>(p0, p1, m_reg, al, cs, 0.f, 0, C, 0.f, 0);
    if (__any(al < 1.f)) { if (hi == 0) al_l[r32] = al; asm volatile("s_waitcnt lgkmcnt(0)" ::: "memory");
#pragma unroll
      for (int d = 0; d < 4; ++d)
#pragma unroll
        for (int r = 0; r < 16; ++r) o[d][r] *= al_l[crow(r, hi)]; }
    finishSM(p0, p1, al, l_reg, pa0, pa1, pa2, pa3);
    pv_d0(o, vb0, pa0, pa1, pa2, pa3);
    __syncthreads();
  }
#undef GLD16
  if (hi == 0) li_l[r32] = l_reg; asm volatile("s_waitcnt lgkmcnt(0)" ::: "memory");
  float rli[16];
#pragma unroll
  for (int r = 0; r < 16; ++r) rli[r] = __builtin_amdgcn_rcpf(li_l[crow(r, hi)]);
  { bf16_t zv[4][16];
#pragma unroll
  for (int d0 = 0; d0 < 4; ++d0)
#pragma unroll
    for (int r = 0; r < 16; ++r) zv[d0][r] = PROJ[(size_t)(qrow0 + crow(r, hi)) * NPAD + C_ZM + h * 256 + vh * 128 + d0 * 32 + r32];
#pragma unroll
  for (int d0 = 0; d0 < 4; ++d0) { const int col = h * 256 + vh * 128 + d0 * 32 + r32;
#pragma unroll
    for (int r = 0; r < 16; ++r) { const size_t row = (size_t)(qrow0 + crow(r, hi));
      UM[row * 1024 + col] = (bf16_t)f2bf(o[d0][r] * rli[r] * bf2f(zv[d0][r])); } } }
  __syncthreads();
}
__device__ __forceinline__ void attn_m_phase(const Args& a, LAS unsigned char* lds, int blk, int nblk, const int wid) {
  const bf16_t* PROJ = (const bf16_t*)(a.ws + WS_PROJ); const bf16_t* MKV = (const bf16_t*)(a.ws + WS_MKV); bf16_t* UM = (bf16_t*)(a.ws + WS_U) + (size_t)2 * S * 1024;
  for (int u = blk; u < 256; u += nblk) attn_m_unit(PROJ, MKV, UM, u & 3, u >> 3, (u >> 2) & 1, lds, wid);
}
__device__ __forceinline__ float slot_sum(const unsigned* ns, int tile, int bj, int wc0, int nwc) { float s = 0.f;
  for (int w = 0; w < nwc; ++w) s += __uint_as_float(__hip_atomic_load(ns + (tile * 2 + bj) * 4 + wc0 + w, __ATOMIC_RELAXED, __HIP_MEMORY_SCOPE_AGENT)); return s; }
__device__ __forceinline__ int window_jmin(float q2k2, float scale, int h, int R0, int NT) {
  const float slope2 = __builtin_amdgcn_exp2f(-(float)(h + 1)) * LOG2E, L = sqrtf(q2k2) * scale * LOG2E * 1.02f, D = (2.f * L + 48.f) / slope2;
  const float x = ((float)R0 - D - 63.f) * (1.f / 64.f);
  int jm = (int)floorf(x) - 1; jm = jm < 0 ? 0 : jm; jm &= ~1; return jm > NT - 2 ? NT - 2 : jm;
}
__device__ __forceinline__ int jmin_b(const unsigned* ns, int h, int qb) {
  const int bj = h & 1; float m = 0.f;
  for (int c = 0; c < 2; ++c) { const float v = slot_sum(ns, 20 + (h >> 1), bj, 2 * c, 2) * slot_sum(ns, 24 + (h >> 1), bj, 2 * c, 2); m = fmaxf(m, v); }
  return window_jmin(m, 0.125f, h, qb * 128, 2 * qb + 2);
}
constexpr int NUNITS_AB = 512;
__device__ __forceinline__ void build_order(const unsigned* ns, unsigned* order, LAS unsigned char* lds, const int lane) {
  LAS int* cost = (LAS int*)lds;
  for (int u = lane; u < NUNITS_AB; u += 64) { int jm, cst;
    { const int h = u & 7, qb = u >> 3; jm = jmin_b(ns, h, qb); cst = 2 * qb + 2 - jm; }
    cost[u] = cst; cost[NUNITS_AB + u] = jm; }
  asm volatile("s_waitcnt lgkmcnt(0)" ::: "memory"); __builtin_amdgcn_wave_barrier();
  for (int u = lane; u < NUNITS_AB; u += 64) { const int cu = cost[u]; int rank = 0;
    for (int v = 0; v < NUNITS_AB; ++v) { const int cv = cost[v]; rank += (cv > cu || (cv == cu && v < u)) ? 1 : 0; }
    order[rank] = (unsigned)u | ((unsigned)cost[NUNITS_AB + u] << 16); }
}
__device__ __forceinline__ void attn_ab_phase(const Args& a, LAS unsigned char* lds, int blk, int nblk, const int wid) {
  const bf16_t* PROJ = (const bf16_t*)(a.ws + WS_PROJ); bf16_t* UA = (bf16_t*)(a.ws + WS_U); bf16_t* UB = UA + (size_t)S * 1024;
  { const unsigned long long* MASK = (const unsigned long long*)(a.ws + WS_SEL);
    for (int u = blk; u < 256; u += nblk) attn_a_unit(PROJ, MASK, UA, u & 7, 31 - (u >> 3), 0, lds, wid); }
  const unsigned* order = (const unsigned*)(a.ws + WS_CTL + 4096); unsigned* qctr = (unsigned*)(a.ws + WS_CTL + 320);
  LAS unsigned* slot = (LAS unsigned*)(lds + 147456 - 64);
  for (;;) {
    if (wid == 0) { if (lane_id_v() == 0) slot[0] = __hip_atomic_fetch_add(qctr, 1u, __ATOMIC_RELAXED, __HIP_MEMORY_SCOPE_AGENT); }
    __syncthreads();
    const unsigned i = slot[0];
    __syncthreads();
    if (i >= 512u) break;
    const unsigned e = order[i]; const int u = (int)(e & 0xffffu), jm = (int)(e >> 16);
    attn_b_unit(PROJ, UB, a.in[9], ((const float*)(a.ws + WS_CTL))[0], u & 7, u >> 3, jm, lds, wid);
  }
}
#undef KSWZ
#undef SBAR
}


namespace idx {
typedef short bf16x8 __attribute__((ext_vector_type(8)));
typedef float f32x16 __attribute__((ext_vector_type(16)));
constexpr int NUNIT = 8 * (16 * 17 / 2);
__device__ __forceinline__ void scores_phase(const bf16_t* __restrict__ PROJ, float* SC, unsigned* uctr, LAS unsigned char* lds, int blk, int nblk, const int wid) {
  const int lane = lane_id_v(), tid = wid * 64 + lane, n32 = lane & 31, hi = lane >> 5;
  const int skey = tid >> 3, schunk = tid & 7;
  const int swr = skey * 128 + ((schunk ^ (skey & 7)) << 4);
  LAS unsigned* uslot = (LAS unsigned*)(lds + 147456 - 64);
  for (;;) {
    if (wid == 0) { if (lane_id_v() == 0) uslot[0] = __hip_atomic_fetch_add(uctr, 1u, __ATOMIC_RELAXED, __HIP_MEMORY_SCOPE_AGENT); }
    __syncthreads();
    const int u = NUNIT - 1 - (int)uslot[0];
    __syncthreads();
    if (u < 0) break;
    int g = 0, rem = u; while (rem >= 8 * (g + 1)) { rem -= 8 * (g + 1); ++g; }
    const int qc = 8 * g + rem / (g + 1), kc = rem % (g + 1);
    const int q0 = 64 * qc + 8 * wid, k_begin = 512 * kc, k_end = min(512 * kc + 512, 64 * qc + 64), ntile = (k_end - k_begin) / 64;
    bf16x8 af[4][4]; float w[4][16];
    const int head = (n32 & 3) + 4 * (n32 >> 3), qbit = (n32 >> 2) & 1;
#pragma unroll
    for (int t = 0; t < 4; ++t) {
      const bf16_t* qp = PROJ + (size_t)(q0 + 2 * t + qbit) * NPAD + C_QI + head * 64 + hi * 8;
#pragma unroll
      for (int ks = 0; ks < 4; ++ks) af[t][ks] = *(const bf16x8*)(qp + ks * 16);
      const bf16_t* wp = PROJ + (size_t)(q0 + 2 * t + hi) * NPAD + C_WI;
      const u32x4 w0 = *(const u32x4*)wp, w1 = *(const u32x4*)(wp + 8);
      const unsigned ww[8] = {w0.x, w0.y, w0.z, w0.w, w1.x, w1.y, w1.z, w1.w};
#pragma unroll
      for (int i = 0; i < 8; ++i) { w[t][2 * i] = bflo(ww[i]) * 0.03125f; w[t][2 * i + 1] = bfhi(ww[i]) * 0.03125f; }
    }
    u32x4 st = *(const u32x4*)(PROJ + (size_t)(k_begin + skey) * NPAD + C_KI + schunk * 8);
    __syncthreads();
    *(LAS u32x4*)(lds + swr) = st;
    __syncthreads();
    for (int tl = 0; tl < ntile; ++tl) {
      LAS const unsigned char* kb = lds + (tl & 1) * 8192;
      if (tl + 1 < ntile) st = *(const u32x4*)(PROJ + (size_t)(k_begin + 64 * (tl + 1) + skey) * NPAD + C_KI + schunk * 8);
#pragma unroll
      for (int kh = 0; kh < 2; ++kh) {
        const int krow = kh * 32 + n32;
        bf16x8 bfr[4];
#pragma unroll
        for (int ks = 0; ks < 4; ++ks) bfr[ks] = *(LAS const bf16x8*)(kb + krow * 128 + (((2 * ks + hi) ^ (krow & 7)) << 4));
        const int s = k_begin + 64 * tl + krow;
#pragma unroll
        for (int t = 0; t < 4; ++t) {
          f32x16 acc = {};
#pragma unroll
          for (int ks = 0; ks < 4; ++ks) acc = __builtin_amdgcn_mfma_f32_32x32x16_bf16(af[t][ks], bfr[ks], acc, 0, 0, 0);
          float sc = 0.f;
#pragma unroll
          for (int r = 0; r < 16; ++r) sc = fmaf(fmaxf(acc[r], 0.f), w[t][r], sc);
          const int q = q0 + 2 * t + hi;
          if (s <= q) SC[sc_off(q) + s] = sc;
        }
      }
      if (tl + 1 < ntile) { *(LAS u32x4*)(lds + ((tl + 1) & 1) * 8192 + swr) = st; }
      __syncthreads();
    }
  }
}
}

#ifdef DBG_STAGE
__device__ __forceinline__ void dbg_dump(const Args& a, int blk, int nblk) {
    const bf16_t* PROJ = (const bf16_t*)(a.ws + WS_PROJ);
    for (size_t idx = (size_t)blk * 512 + threadIdx.x; idx < (size_t)S * DM; idx += (size_t)nblk * 512) {
        const int r = (int)(idx / DM), c = (int)(idx % DM); float v = 0.f;
#if DBG_STAGE == 1 && defined(DBG_WEIGHTS)
        for (int z = 0; z < 3; ++z) v += bf2f(((const bf16_t*)(a.ws + WS_WTBR))[((size_t)z * 2048 + (r & 2047)) * 1024 + (c & 1023)]);
        v += bf2f(((const bf16_t*)(a.ws + WS_WTOUT))[(size_t)(r & 2047) * 2048 + c]);
#elif DBG_STAGE == 1 && defined(DBG_GATES)
        for (int j = 0; j < 3; ++j) v += bf2f(PROJ[(size_t)r * NPAD + C_GL + c + 2048 * j]);
#elif DBG_STAGE == 1
        for (int j = 0; j < 8; ++j) v += bf2f(PROJ[(size_t)r * NPAD + c + 2048 * j]);
        if (c < 1280) v += bf2f(PROJ[(size_t)r * NPAD + 16384 + c]);
        if (r < 256) v += bf2f(((const bf16_t*)(a.ws + WS_MKV))[(size_t)r * 2048 + c]);
        for (int z = 0; z < 3; ++z) v += bf2f(((const bf16_t*)(a.ws + WS_WTBR))[((size_t)z * 2048 + (r & 2047)) * 1024 + (c & 1023)]);
        v += bf2f(((const bf16_t*)(a.ws + WS_WTOUT))[(size_t)(r & 2047) * 2048 + c]);
#elif DBG_STAGE == 2
        if (c < 1024) v = bf2f(((const bf16_t*)(a.ws + WS_U))[(size_t)(S + r) * 1024 + c]) + bf2f(((const bf16_t*)(a.ws + WS_U))[(size_t)(2 * S + r) * 1024 + c]);
        else { const float* row = (const float*)(a.ws + WS_SC) + sc_off(r); for (int j = c - 1024; j <= r; j += 1024) v += row[j]; }
#elif DBG_STAGE == 3
        if (c < 256) v = (float)((const int*)(a.ws + WS_SEL))[(size_t)r * 256 + c];
#elif DBG_STAGE == 4
        if (c < 1024) v = bf2f(((const bf16_t*)(a.ws + WS_U))[(size_t)r * 1024 + c]);
#elif DBG_STAGE == 5
        v = bf2f(((const bf16_t*)(a.ws + WS_MERGED))[(size_t)r * DM + c]);
#endif
        a.out[idx] = v;
    }
}
#endif

#define RLX_AGENT __ATOMIC_RELAXED, __HIP_MEMORY_SCOPE_AGENT
#define XB_TMO      128
#define XB_XCNT(j)  (256  + 64 * (j))
#define XB_XSUB(j)  (1280 + 64 * (j))
#define XB_XGEN(j)  (2304 + 64 * (j))
#define XB_TOP      3328
#define XB_TOPGEN   3392
#define XCD_BAR_WORDS 3456
#define XB_SPIN_CAP (1u << 18)

__device__ __forceinline__ unsigned xb_ld(unsigned* p)              { return __hip_atomic_load(p, __ATOMIC_RELAXED, __HIP_MEMORY_SCOPE_AGENT); }
__device__ __forceinline__ unsigned xb_add(unsigned* p, unsigned v) { return __hip_atomic_fetch_add(p, v, __ATOMIC_RELAXED, __HIP_MEMORY_SCOPE_AGENT); }
__device__ __forceinline__ unsigned xb_xcc_id() { return (unsigned)__builtin_amdgcn_s_getreg((3 << 11) | 20) & 0xFu; }
#define XB_SPIN(cond, bar) do { unsigned _sp = 0; while (cond) { __builtin_amdgcn_s_sleep(1); \
    if ((++_sp & 255u) == 0u) { if (xb_ld(&(bar)[XB_TMO])) break; if (_sp > XB_SPIN_CAP) { atomicAdd(&(bar)[XB_TMO], 1u); break; } } } } while (0)

struct XcdBarrier {
    unsigned* bar; unsigned x;
    volatile LAS unsigned* st;
};

__device__ __forceinline__ XcdBarrier xcd_barrier_post(unsigned* bar, volatile LAS unsigned* st, bool leader) {
    XcdBarrier b; b.bar = bar; b.x = xb_xcc_id(); b.st = st;
    if (leader) (void)xb_add(&bar[XB_XCNT(b.x)], 1u);
    return b;
}
__device__ __forceinline__ void xcd_barrier_complete(unsigned* bar, unsigned x, unsigned& nloc, unsigned& nx) {
    const unsigned G = gridDim.x * gridDim.y * gridDim.z;
    unsigned sum, cnt, mine, sp = 0u;
    for (;;) {
        sum = 0u; cnt = 0u; mine = 0u;
#pragma unroll
        for (unsigned j = 0; j < 16; ++j) { const unsigned c = xb_ld(&bar[XB_XCNT(j)]); sum += c; cnt += (c > 0u) ? 1u : 0u; mine = (j == x) ? c : mine; }
        if (sum == G) break;
        __builtin_amdgcn_s_sleep(1);
        if ((++sp & 255u) == 0u) { if (xb_ld(&bar[XB_TMO])) break; if (sp > XB_SPIN_CAP) { atomicAdd(&bar[XB_TMO], 1u); break; } }
    }
    nloc = mine > 0u ? mine : 1u; nx = cnt > 0u ? cnt : 1u;
}

__device__ __forceinline__ void xcd_barrier(const XcdBarrier& b, bool leader) {
    asm volatile("s_waitcnt vmcnt(0)" ::: "memory");
    __syncthreads();
    if (leader) {
        unsigned* bar = b.bar;
        __builtin_amdgcn_s_waitcnt(0);
        unsigned nloc = b.st[0], nx = b.st[1];
        if (nloc == 0u) { xcd_barrier_complete(bar, b.x, nloc, nx); b.st[0] = nloc; b.st[1] = nx; }
        const unsigned old = xb_add(&bar[XB_XSUB(b.x)], 1u);
        const unsigned gen = old / nloc;
        if (old + 1u == (gen + 1u) * nloc) {
            __builtin_amdgcn_fence(__ATOMIC_RELEASE, "agent");
            asm volatile("s_waitcnt vmcnt(0)" ::: "memory");
            const unsigned og = xb_add(&bar[XB_TOP], 1u);
            const unsigned tg = og / nx;
            if (og + 1u == (tg + 1u) * nx) xb_add(&bar[XB_TOPGEN], 1u);
            else XB_SPIN(xb_ld(&bar[XB_TOPGEN]) == tg, bar);
            __builtin_amdgcn_fence(__ATOMIC_ACQUIRE, "agent");
            xb_add(&bar[XB_XGEN(b.x)], 1u);
            asm volatile("s_waitcnt vmcnt(0)" ::: "memory");
        } else {
            XB_SPIN(xb_ld(&bar[XB_XGEN(b.x)]) == gen, bar);
            __builtin_amdgcn_fence(__ATOMIC_ACQUIRE, "agent");
            asm volatile("s_waitcnt vmcnt(0)" ::: "memory");
        }
    }
    __syncthreads();
}

__device__ __forceinline__ void grid_bar(unsigned* cnt, unsigned target, const int wave) {
    asm volatile("s_waitcnt vmcnt(0)" ::: "memory");
    __syncthreads();
    if (wave == 0) {
        if (lane_id_v() == 0) {
            __builtin_amdgcn_fence(__ATOMIC_RELEASE, "agent");
            asm volatile("s_waitcnt vmcnt(0)" ::: "memory");
            __hip_atomic_fetch_add(cnt, 1u, __ATOMIC_RELAXED, __HIP_MEMORY_SCOPE_AGENT);
            while (__hip_atomic_load(cnt, __ATOMIC_RELAXED, __HIP_MEMORY_SCOPE_AGENT) < target) __builtin_amdgcn_s_sleep(2);
            __builtin_amdgcn_fence(__ATOMIC_ACQUIRE, "agent");
            asm volatile("s_waitcnt vmcnt(0)" ::: "memory");
        }
    }
    __syncthreads();
}

constexpr int LDS_BYTES = 147456;
constexpr int NPHASE = 8;
__global__ void __launch_bounds__(512, 2) fwd(Args a) {
    extern __shared__ __attribute__((aligned(16))) unsigned char lds_raw[];
    LAS unsigned char* lds = (LAS unsigned char*)lds_raw;
    cg::grid_group grid = cg::this_grid();
    const int blk = blockIdx.x, nblk = gridDim.x, wave = __builtin_amdgcn_readfirstlane(threadIdx.x >> 6);
    if (a.ph_lo < 0) grid.sync();
    unsigned char* ws = a.ws;
    const bf16_t* PROJ = (const bf16_t*)(ws + WS_PROJ);
    volatile LAS unsigned* xst = (volatile LAS unsigned*)(lds + 147456 - 128);
    if (wave == 0) { if (lane_id_v() == 0) { xst[0] = 0u; xst[1] = 0u; } }
    __syncthreads();
    (void)xcd_barrier_post((unsigned*)(ws + WS_CTL + 16384), xst, wave == 0 && lane_id_v() == 0);
#define IN(k) (a.ph_lo <= (k) && (k) < a.ph_hi)
#define SEAMX() do { XcdBarrier xb_; xb_.bar = (unsigned*)(ws + WS_CTL + 16384); xb_.x = xb_xcc_id(); xb_.st = (volatile LAS unsigned*)(lds + 147456 - 128); xcd_barrier(xb_, wave == 0 && lane_id_v() == 0); } while (0)
#define SEAM(k) do { if (IN(k) && IN((k) + 1)) { { XcdBarrier xb_; xb_.bar = (unsigned*)(ws + WS_CTL + 16384); xb_.x = xb_xcc_id(); xb_.st = (volatile LAS unsigned*)(lds + 147456 - 128); xcd_barrier(xb_, wave == 0 && lane_id_v() == 0); } } } while (0)
    if (IN(0)) { p0_prologue_a(a, lds, blk, nblk, wave); SEAMX();
                 p0_prologue_b(a, lds, blk, nblk, wave); } SEAM(0);
    if (IN(1)) {
        {
            pg8::Gemm g8{(const bf16_t*)(ws + WS_H8), (const bf16_t*)(ws + WS_W8), S, 64 * 256, DM / 2, 0, 0};
            pg8::ProjOrder8 so; so.init(S, nblk, blk);
            pg8::EpiProj8 E{(bf16_t*)(ws + WS_PROJ), NPAD, a.in[4], C_GL / 256, (unsigned*)(ws + WS_CTL + 1024), (const float*)(ws + WS_SA), (const float*)(ws + WS_SB)};
            pg8::gemm_phase<pg8::EpiProj8, pg8::ProjOrder8, true, true>(lds, g8, so, E, wave); }
        __syncthreads();
        {
            pg8::Gemm g{(const bf16_t*)(ws + WS_H), (const bf16_t*)(ws + WS_WTIN), S, NPAD, DM, (long)WS_MEMN - (long)WS_H, (long)WS_WTMKV - (long)WS_WTIN};
            pg8::ProjOrderB so; so.init(nblk, blk);
            pg8::EpiProj E{(bf16_t*)(ws + WS_PROJ), NPAD, (bf16_t*)(ws + WS_MKV), 2048, a.in[4], C_GL / 256, (unsigned*)(ws + WS_CTL + 1024)};
            pg8::gemm_phase<pg8::EpiProj, pg8::ProjOrderB, false, true>(lds, g, so, E, wave);
            if (blk >= 168) late_transposes(a, lds, (blk - 168) * 8 + wave, (nblk - 168) * 8, wave); }
    } SEAM(1);
    if (IN(2)) { idx::scores_phase(PROJ, (float*)(ws + WS_SC), (unsigned*)(ws + WS_CTL + 448), lds, blk, nblk, wave); __syncthreads(); att::attn_m_phase(a, lds, blk, nblk, wave); } SEAM(2);
    if (IN(3)) { if (blk == nblk - 1) { if (wave == 7) att::build_order((const unsigned*)(ws + WS_CTL + 1024), (unsigned*)(ws + WS_CTL + 4096), lds + 131072, lane_id_v()); }
                 topk_select((const float*)(ws + WS_SC), (int*)(ws + WS_SEL), lds, blk, nblk, wave); } SEAM(3);
    if (IN(4)) { att::attn_ab_phase(a, lds, blk, nblk, wave); } SEAM(4);
    if (IN(5)) {
        pg8::Gemm g{(const bf16_t*)(ws + WS_U), (const bf16_t*)(ws + WS_WTBR), S, DM, 1024, (long)S * 1024 * 2, (long)2048 * 1024 * 2};
        pg8::MergeOrder so; so.init(S, DM, nblk, blk);
        pg8::EpiMerge E{PROJ + C_GL, NPAD, (bf16_t*)(ws + WS_MERGED), DM};
        pg8::gemm_phase<pg8::EpiMerge, pg8::MergeOrder, true, true>(lds, g, so, E, wave);
    } SEAM(5);
    if (IN(6)) {
        pg8::Gemm g{(const bf16_t*)(ws + WS_MERGED), (const bf16_t*)(ws + WS_WTOUT), S, DM, DM, 0, 0};
        pg8::StaticOrder so; so.init(S, DM, nblk, blk);
        pg8::EpiOut E{a.in[0], a.out, DM, (float*)(ws + WS_PART), S};
        pg8::gemm_phase<pg8::EpiOut, pg8::StaticOrder, false, true>(lds, g, so, E, wave);
    } SEAM(6);
    if (IN(7)) { final_norm(a, blk, nblk, wave); }
#ifdef DBG_STAGE
    if (IN(8)) { dbg_dump(a, blk, nblk); }
#endif
#undef IN
#undef SEAM
}

#ifndef N_LAUNCH_MODE
#define N_LAUNCH_MODE 0
#endif
extern "C" void kernel_launch(void* const* d_in, const int* in_sizes, int n_in, void* d_out, int out_size, void* d_ws, size_t ws_size, hipStream_t stream) {
    static int grid = 0;
    if (grid == 0) {
        if (n_in != 17 || in_sizes[0] != S * DM || in_sizes[3] != DM * DIN || out_size != S * DM || ws_size < WS_END) {
            fprintf(stderr, "kernel_launch: unexpected shapes (n_in %d, in0 %d, in3 %d, out %d, ws %zu < %zu)\n", n_in, n_in > 0 ? in_sizes[0] : -1, n_in > 3 ? in_sizes[3] : -1, out_size, ws_size, (size_t)WS_END); grid = -1; return; }
        int dev = 0, cus = 0, per_cu = 0;
        (void)hipGetDevice(&dev); (void)hipDeviceGetAttribute(&cus, hipDeviceAttributeMultiprocessorCount, dev);
        if (hipFuncSetAttribute((const void*)fwd, hipFuncAttributeMaxDynamicSharedMemorySize, LDS_BYTES) != hipSuccess) { fprintf(stderr, "kernel_launch: hipFuncSetAttribute failed\n"); grid = -1; return; }
        if (hipOccupancyMaxActiveBlocksPerMultiprocessor(&per_cu, (const void*)fwd, 512, LDS_BYTES) != hipSuccess || per_cu < 1) { fprintf(stderr, "kernel_launch: occupancy query gave %d\n", per_cu); per_cu = 1; }
        (void)hipGetLastError();
        grid = cus * 1;
        if (grid > cus * per_cu) grid = cus * per_cu;
        if (grid < 8) grid = -1;
    }
    if (grid < 0) return;
    Args a{};
    for (int i = 0; i < 17; ++i) a.in[i] = (const float*)d_in[i];
    a.out = (float*)d_out; a.ws = (unsigned char*)d_ws;
#if N_LAUNCH_MODE == 1
    (void)hipMemsetAsync((unsigned char*)d_ws + WS_CTL + 256, 0, 104192, stream);
    a.ph_lo = 0; a.ph_hi = NPHASE;
    void* kargs[] = {&a};
    hipError_t e = hipLaunchCooperativeKernel((const void*)fwd, dim3(grid), dim3(512), kargs, LDS_BYTES, stream);
    if (e != hipSuccess) fprintf(stderr, "cooperative launch failed: %s (grid %d)\n", hipGetErrorString(e), grid);
#else
#ifdef DBG_STAGE
    #ifdef DBG_WEIGHTS
    constexpr int last_ph[6] = {0, 0, 2, 3, 4, 5};
#else
    constexpr int last_ph[6] = {0, 1, 2, 3, 4, 5};
#endif
    for (int p = 0; p <= last_ph[DBG_STAGE]; ++p) { a.ph_lo = p; a.ph_hi = p + 1; hipLaunchKernelGGL(fwd, dim3(grid), dim3(512), LDS_BYTES, stream, a); }
    a.ph_lo = 8; a.ph_hi = 9; hipLaunchKernelGGL(fwd, dim3(grid), dim3(512), LDS_BYTES, stream, a);
#else
    for (int p = 0; p < NPHASE; ++p) {
        a.ph_lo = p; a.ph_hi = p + 1;
        hipLaunchKernelGGL(fwd, dim3(grid), dim3(512), LDS_BYTES, stream, a);
    }
#endif
#endif
}
```
